# Optimizing an MI355X kernel written in HIP

```python
import jax, jax.numpy as jnp
from jax import lax
import numpy as np

D_MODEL = 1024
BATCH = 1
SEQ = 16384
DEPTH = 4

GRID_W = 64
CTX_LEN = 256
EPS = 1e-6
MOD_INIT = 0.5

MLA_HEADS = 6
QK_NOPE = 64
QK_ROPE = 32
QK_DIM = QK_NOPE + QK_ROPE
V_HEAD = 64
Q_LORA = 256
KV_LORA = 128
MLA_WIDTH = MLA_HEADS * V_HEAD
ROPE_THETA = 10000.0
Q_BLOCK = 128

SSD_HEADS = 6
SSD_HEAD_DIM = 64
SSD_WIDTH = SSD_HEADS * SSD_HEAD_DIM
SSD_GROUPS = 2
SSD_STATE = 64
SSD_CONV = 4
SSD_CONV_DIM = SSD_WIDTH + 2 * SSD_GROUPS * SSD_STATE
SSD_CHUNK = 128

POOL_WINDOWS = (2, 4, 8, 16)
POOL_GROUP = 64
POOL_WIDTH = len(POOL_WINDOWS) * POOL_GROUP

MIX_WIDTH = MLA_WIDTH + SSD_WIDTH + POOL_WIDTH
IN_SPLITS = (Q_LORA, KV_LORA, QK_ROPE, SSD_WIDTH, SSD_CONV_DIM, 2 * SSD_HEADS, POOL_WIDTH)
IN_COLS = sum(IN_SPLITS)

N_EXPERTS = 32
TOP_K = 4
D_FF = 1024
SWIGLU_LIMIT = 7.0
SWIGLU_ALPHA = 1.702
MOE_BLOCK = 128

kernel_name = 'hybrid_mla_ssd_pool_moe_dit'


def rms_norm(x, g):
    xf = x.astype(jnp.float32)
    y = xf * lax.rsqrt(jnp.mean(xf * xf, axis=-1, keepdims=True) + EPS)
    return (y * g.astype(jnp.float32)).astype(x.dtype)


def modulate(x, g, shift, scale):
    return rms_norm(x, g) * (1 + scale) + shift


def axial_rope_angles(n):
    rows = n // GRID_W
    row = jnp.repeat(jnp.arange(rows), GRID_W).astype(jnp.float32)
    col = jnp.tile(jnp.arange(GRID_W), rows).astype(jnp.float32)
    n_freq = QK_ROPE // 4
    inv_freq = ROPE_THETA ** (-jnp.arange(n_freq, dtype=jnp.float32) / n_freq)
    ang = jnp.stack([row[:, None] * inv_freq, col[:, None] * inv_freq], axis=1)
    return jnp.cos(ang), jnp.sin(ang)


def apply_axial_rope(x, cos, sin):
    n_freq = QK_ROPE // 4
    xr = x.astype(jnp.float32).reshape(*x.shape[:-1], 2, 2, n_freq)
    x1, x2 = xr[..., 0, :], xr[..., 1, :]
    out = jnp.stack([x1 * cos - x2 * sin, x2 * cos + x1 * sin], axis=-2)
    return out.reshape(x.shape).astype(x.dtype)


def mla_queries(q_lat, lp, rope):
    B, n, _ = q_lat.shape
    q = (rms_norm(q_lat, lp['q_lat_g']) @ lp['w_uq']).reshape(B, n, MLA_HEADS, QK_DIM)
    q = rms_norm(q, lp['qn_g'])
    if rope is not None:
        q = jnp.concatenate([q[..., :QK_NOPE], apply_axial_rope(q[..., QK_NOPE:], *rope)], axis=-1)
    return q


def mla_keys_values(kv_lat, k_rope, lp, rope):
    B, n, _ = kv_lat.shape
    kv = (rms_norm(kv_lat, lp['kv_lat_g']) @ lp['w_ukv']).reshape(B, n, MLA_HEADS, QK_NOPE + V_HEAD)
    k_nope, v = kv[..., :QK_NOPE], kv[..., QK_NOPE:]
    k_r = jnp.broadcast_to(k_rope[:, :, None, :], (B, n, MLA_HEADS, QK_ROPE))
    k = rms_norm(jnp.concatenate([k_nope, k_r], axis=-1), lp['kn_g'])
    if rope is not None:
        k = jnp.concatenate([k[..., :QK_NOPE], apply_axial_rope(k[..., QK_NOPE:], *rope)], axis=-1)
    return k, v


def softmax_attend(q, k, v):
    s = jnp.einsum('bqhd,bkhd->bhqk', q, k).astype(jnp.float32) * (QK_DIM ** -0.5)
    p = jax.nn.softmax(s, axis=-1).astype(v.dtype)
    return jnp.einsum('bhqk,bkhd->bqhd', p, v)


def blocked_attend(q, k, v):
    B, n, H, dq = q.shape
    nb = n // Q_BLOCK
    qb = jnp.moveaxis(q.reshape(B, nb, Q_BLOCK, H, dq), 1, 0)
    o = lax.map(lambda qq: softmax_attend(qq, k, v), qb)
    return jnp.moveaxis(o, 0, 1).reshape(B, n, H * V_HEAD)


def centered_depthwise_conv(u, w, b):
    left = SSD_CONV // 2
    y = lax.conv_general_dilated(u, w[:, None, :].astype(u.dtype), window_strides=(1,),
                                 padding=[(left, SSD_CONV - 1 - left)],
                                 dimension_numbers=('NWC', 'WIO', 'NWC'),
                                 feature_group_count=u.shape[-1])
    return jax.nn.silu(y + b)


def ssd_chunk_scan(xs, dt, a, Bm, Cm, init):
    f32 = jnp.float32
    B, n, H, P = xs.shape
    L = SSD_CHUNK
    nc = n // L
    rep = H // SSD_GROUPS
    X = (xs.astype(f32) * dt[..., None]).reshape(B, nc, L, H, P)
    Bh = jnp.repeat(Bm.astype(f32), rep, axis=2).reshape(B, nc, L, H, SSD_STATE)
    Ch = jnp.repeat(Cm.astype(f32), rep, axis=2).reshape(B, nc, L, H, SSD_STATE)
    A = jnp.moveaxis((dt * a).reshape(B, nc, L, H), 3, 1)
    A_cs = jnp.cumsum(A, axis=-1)
    lower = jnp.arange(L)[:, None] >= jnp.arange(L)[None, :]
    decay = jnp.exp(jnp.where(lower, A_cs[..., :, None] - A_cs[..., None, :], -jnp.inf))
    scores = jnp.einsum('bclhn,bcshn->bhcls', Ch, Bh) * decay
    y_diag = jnp.einsum('bhcls,bcshp->bclhp', scores, X)
    states = jnp.einsum('bclhn,bhcl,bclhp->bchpn', Bh, jnp.exp(A_cs[..., -1:] - A_cs), X)
    chunk_decay = jnp.exp(A_cs[..., -1])

    def step(state, inp):
        st, dec = inp
        return state * dec[..., None, None] + st, state

    final, prev = lax.scan(step, init.astype(f32), (jnp.moveaxis(states, 1, 0), jnp.moveaxis(chunk_decay, 2, 0)))
    y_off = jnp.einsum('bclhn,cbhpn,bhcl->bclhp', Ch, prev, jnp.exp(A_cs))
    y = (y_diag + y_off).reshape(B, n, H, P)
    return y.astype(xs.dtype), final


def ssd_mix(xbc, dt_raw, z, init, lp):
    B, n, _ = xbc.shape
    gn = SSD_GROUPS * SSD_STATE
    xs = xbc[..., :SSD_WIDTH].reshape(B, n, SSD_HEADS, SSD_HEAD_DIM)
    Bm = xbc[..., SSD_WIDTH:SSD_WIDTH + gn].reshape(B, n, SSD_GROUPS, SSD_STATE)
    Cm = xbc[..., SSD_WIDTH + gn:].reshape(B, n, SSD_GROUPS, SSD_STATE)
    dt = jax.nn.softplus(dt_raw.astype(jnp.float32).reshape(B, n, 2, SSD_HEADS) + lp['dt_bias'].astype(jnp.float32))
    a = -jnp.exp(lp['a_log'].astype(jnp.float32))
    flip = lambda t: jnp.flip(t, axis=1)
    y_f, s_f = ssd_chunk_scan(xs, dt[:, :, 0], a[0], Bm, Cm, init[0])
    y_b, s_b = ssd_chunk_scan(flip(xs), flip(dt[:, :, 1]), a[1], flip(Bm), flip(Cm), init[1])
    y = y_f + flip(y_b) + lp['d_skip'][:, None] * xs
    y = rms_norm(y.reshape(B, n, SSD_WIDTH) * jax.nn.silu(z), lp['ssd_norm_g'])
    return y, (s_f, s_b)


def multiscale_pool(u, w, scale):
    B, n, _ = u.shape
    uf = u.astype(jnp.float32)
    cs = jnp.pad(jnp.cumsum(uf, axis=1), ((0, 0), (1, 0), (0, 0)))
    t = jnp.arange(n)
    outs = []
    for gi, win in enumerate(POOL_WINDOWS):
        lo = jnp.clip(t - win // 2, 0, n)
        hi = jnp.clip(t - win // 2 + win, 0, n)
        csg = cs[..., gi * POOL_GROUP:(gi + 1) * POOL_GROUP]
        mean = (csg[:, hi] - csg[:, lo]) / (hi - lo).astype(jnp.float32)[None, :, None]
        outs.append(mean - uf[..., gi * POOL_GROUP:(gi + 1) * POOL_GROUP])
    p = jnp.stack(outs, axis=2).astype(u.dtype)
    y = jnp.einsum('bngc,gcd->bngd', p, w).reshape(B, n, POOL_WIDTH)
    return y * scale


def token_mixers(h_lat, h_ctx, rope, lp, need_ctx):
    B, n, _ = h_lat.shape
    pts = np.cumsum(IN_SPLITS)[:-1].tolist()
    pl = jnp.split(h_lat @ lp['w_in'], pts, axis=-1)
    pc = jnp.split(h_ctx @ lp['w_in'], pts, axis=-1)
    k_c, v_c = mla_keys_values(pc[1], pc[2], lp, None)
    k_l, v_l = mla_keys_values(pl[1], pl[2], lp, rope)
    q_l = mla_queries(pl[0], lp, rope)
    att_l = blocked_attend(q_l, jnp.concatenate([k_c, k_l], axis=1), jnp.concatenate([v_c, v_l], axis=1))
    zero = jnp.zeros((B, SSD_HEADS, SSD_HEAD_DIM, SSD_STATE), jnp.float32)
    ssd_c, st_c = ssd_mix(centered_depthwise_conv(pc[4], lp['conv_w'], lp['conv_b']), pc[5], pc[3], (zero, zero), lp)
    ssd_l, _ = ssd_mix(centered_depthwise_conv(pl[4], lp['conv_w'], lp['conv_b']), pl[5], pl[3], st_c, lp)
    pool_l = multiscale_pool(pl[6], lp['pool_w'], lp['pool_scale'])
    out_l = jnp.concatenate([att_l, ssd_l, pool_l], axis=-1) @ lp['w_out']
    if not need_ctx:
        return out_l, None
    q_c = mla_queries(pc[0], lp, None)
    att_c = softmax_attend(q_c, k_c, v_c).reshape(B, h_ctx.shape[1], MLA_WIDTH)
    pool_c = multiscale_pool(pc[6], lp['pool_w'], lp['pool_scale'])
    out_c = jnp.concatenate([att_c, ssd_c, pool_c], axis=-1) @ lp['w_out']
    return out_l, out_c


def moe_ffn(h, router_w, router_b, w_gate, b_gate, w_up, b_up, w_down, b_down):
    tokens = h.reshape(-1, D_MODEL)
    n_assign = tokens.shape[0] * TOP_K
    logits = (tokens @ router_w).astype(jnp.float32) + router_b.astype(jnp.float32)
    top_logit, top_idx = lax.top_k(logits, TOP_K)
    top_w = jax.nn.softmax(top_logit, axis=-1)
    expert = top_idx.reshape(-1)
    token = jnp.arange(n_assign, dtype=jnp.int32) // TOP_K
    order = jnp.argsort(expert)
    e_sorted = expert[order]
    counts = jnp.bincount(expert, length=N_EXPERTS)
    padded = (counts + MOE_BLOCK - 1) // MOE_BLOCK * MOE_BLOCK
    start = jnp.cumsum(counts) - counts
    pad_end = jnp.cumsum(padded)
    pad_start = pad_end - padded
    dest = pad_start[e_sorted] + jnp.arange(n_assign) - start[e_sorted]
    n_blocks = -(-n_assign // MOE_BLOCK) + N_EXPERTS
    n_rows = n_blocks * MOE_BLOCK
    row_token = jnp.zeros((n_rows,), jnp.int32).at[dest].set(token[order])
    row_weight = jnp.zeros((n_rows,), jnp.float32).at[dest].set(top_w.reshape(-1)[order])
    block_expert = jnp.minimum(jnp.searchsorted(pad_end, jnp.arange(n_blocks) * MOE_BLOCK, side='right'), N_EXPERTS - 1)

    def expert_block(args):
        tok, e = args
        xb = tokens[tok]
        g = jnp.minimum(xb @ w_gate[e] + b_gate[e], SWIGLU_LIMIT)
        u = jnp.clip(xb @ w_up[e] + b_up[e], -SWIGLU_LIMIT, SWIGLU_LIMIT)
        return (g * jax.nn.sigmoid(SWIGLU_ALPHA * g) * (u + 1)) @ w_down[e] + b_down[e]

    out = lax.map(expert_block, (row_token.reshape(n_blocks, MOE_BLOCK), block_expert))
    out = out.reshape(n_rows, D_MODEL) * row_weight[:, None].astype(out.dtype)
    y = jnp.zeros_like(tokens).at[row_token].add(out)
    return y.reshape(h.shape)


def setup_inputs(seed: int = 0) -> dict:
    key = jax.random.key(seed)
    ks = iter(jax.random.split(key, 40))
    f32 = jnp.float32
    L = DEPTH

    def normal(shape, scale):
        return jax.random.normal(next(ks), shape, f32) * scale

    def gain(shape):
        return 1.0 + normal(shape, 0.1)

    x = normal((BATCH, SEQ, D_MODEL), 1.0)
    c = normal((BATCH, D_MODEL), 1.0)
    ctx = normal((BATCH, CTX_LEN, D_MODEL), 1.0)
    c_ctx = normal((D_MODEL,), 1.0)
    norm1_g = gain((L, D_MODEL))
    norm2_g = gain((L, D_MODEL))
    mod_w = normal((L, D_MODEL, 6 * D_MODEL), MOD_INIT * D_MODEL ** -0.5)
    mod_b = normal((L, 6 * D_MODEL), 0.02)
    w_in = normal((L, D_MODEL, IN_COLS), D_MODEL ** -0.5)
    dt_lo = sum(IN_SPLITS[:5])
    w_in = w_in.at[:, :, dt_lo:dt_lo + 2 * SSD_HEADS].multiply(0.1)
    mla_q_norm_g = gain((L, Q_LORA))
    mla_kv_norm_g = gain((L, KV_LORA))
    mla_w_uq = normal((L, Q_LORA, MLA_HEADS * QK_DIM), Q_LORA ** -0.5)
    mla_w_ukv = normal((L, KV_LORA, MLA_HEADS * (QK_NOPE + V_HEAD)), KV_LORA ** -0.5)
    mla_qn_g = gain((L, QK_DIM))
    mla_kn_g = gain((L, QK_DIM))
    ssd_conv_w = normal((L, SSD_CONV, SSD_CONV_DIM), SSD_CONV ** -0.5)
    ssd_conv_b = normal((L, SSD_CONV_DIM), 0.01)
    ssd_a_log = jnp.log(jax.random.uniform(next(ks), (L, 2, SSD_HEADS), f32, 1.0, 16.0))
    dt0 = jnp.exp(jax.random.uniform(next(ks), (L, 2, SSD_HEADS), f32, float(np.log(1e-3)), float(np.log(1e-1))))
    ssd_dt_bias = dt0 + jnp.log(-jnp.expm1(-dt0))
    ssd_d = gain((L, SSD_HEADS))
    ssd_norm_g = gain((L, SSD_WIDTH))
    pool_w = normal((L, len(POOL_WINDOWS), POOL_GROUP, POOL_GROUP), POOL_GROUP ** -0.5)
    pool_scale = gain((L, POOL_WIDTH))
    w_out = normal((L, MIX_WIDTH, D_MODEL), MIX_WIDTH ** -0.5)
    router_w = normal((L, D_MODEL, N_EXPERTS), D_MODEL ** -0.5)
    router_b = normal((L, N_EXPERTS), 0.01)
    moe_w_gate = normal((L, N_EXPERTS, D_MODEL, D_FF), D_MODEL ** -0.5)
    moe_b_gate = normal((L, N_EXPERTS, D_FF), 0.01)
    moe_w_up = normal((L, N_EXPERTS, D_MODEL, D_FF), D_MODEL ** -0.5)
    moe_b_up = normal((L, N_EXPERTS, D_FF), 0.01)
    moe_w_down = normal((L, N_EXPERTS, D_FF, D_MODEL), D_FF ** -0.5)
    moe_b_down = normal((L, N_EXPERTS, D_MODEL), 0.01)
    return {'x': x, 'c': c, 'ctx': ctx, 'c_ctx': c_ctx, 'norm1_g': norm1_g, 'norm2_g': norm2_g,
            'mod_w': mod_w, 'mod_b': mod_b, 'w_in': w_in, 'mla_q_norm_g': mla_q_norm_g,
            'mla_kv_norm_g': mla_kv_norm_g, 'mla_w_uq': mla_w_uq, 'mla_w_ukv': mla_w_ukv,
            'mla_qn_g': mla_qn_g, 'mla_kn_g': mla_kn_g, 'ssd_conv_w': ssd_conv_w, 'ssd_conv_b': ssd_conv_b,
            'ssd_a_log': ssd_a_log, 'ssd_dt_bias': ssd_dt_bias, 'ssd_d': ssd_d, 'ssd_norm_g': ssd_norm_g,
            'pool_w': pool_w, 'pool_scale': pool_scale, 'w_out': w_out, 'router_w': router_w,
            'router_b': router_b, 'moe_w_gate': moe_w_gate, 'moe_b_gate': moe_b_gate,
            'moe_w_up': moe_w_up, 'moe_b_up': moe_b_up, 'moe_w_down': moe_w_down, 'moe_b_down': moe_b_down}


def reference(x, c, ctx, c_ctx, norm1_g, norm2_g, mod_w, mod_b, w_in, mla_q_norm_g, mla_kv_norm_g,
              mla_w_uq, mla_w_ukv, mla_qn_g, mla_kn_g, ssd_conv_w, ssd_conv_b, ssd_a_log, ssd_dt_bias,
              ssd_d, ssd_norm_g, pool_w, pool_scale, w_out, router_w, router_b, moe_w_gate, moe_b_gate,
              moe_w_up, moe_b_up, moe_w_down, moe_b_down):
    n = x.shape[1]
    n_ctx = ctx.shape[1]
    cos, sin = axial_rope_angles(n)
    rope = (cos[None, :, None], sin[None, :, None])
    silu_c = jax.nn.silu(c)
    silu_cc = jax.nn.silu(c_ctx)
    for i in range(DEPTH):
        need_ctx = i < DEPTH - 1
        lp = {'w_in': w_in[i], 'q_lat_g': mla_q_norm_g[i], 'kv_lat_g': mla_kv_norm_g[i],
              'w_uq': mla_w_uq[i], 'w_ukv': mla_w_ukv[i], 'qn_g': mla_qn_g[i], 'kn_g': mla_kn_g[i],
              'conv_w': ssd_conv_w[i], 'conv_b': ssd_conv_b[i], 'a_log': ssd_a_log[i],
              'dt_bias': ssd_dt_bias[i], 'd_skip': ssd_d[i], 'ssd_norm_g': ssd_norm_g[i],
              'pool_w': pool_w[i], 'pool_scale': pool_scale[i], 'w_out': w_out[i]}
        m_l = [m[:, None, :] for m in jnp.split(silu_c @ mod_w[i] + mod_b[i], 6, axis=-1)]
        m_c = jnp.split(silu_cc @ mod_w[i] + mod_b[i], 6, axis=-1)
        h_l = modulate(x, norm1_g[i], m_l[0], m_l[1])
        h_c = modulate(ctx, norm1_g[i], m_c[0], m_c[1])
        mix_l, mix_c = token_mixers(h_l, h_c, rope, lp, need_ctx)
        x = x + m_l[2] * mix_l
        h_l = modulate(x, norm2_g[i], m_l[3], m_l[4])
        moe_args = (router_w[i], router_b[i], moe_w_gate[i], moe_b_gate[i], moe_w_up[i], moe_b_up[i],
                    moe_w_down[i], moe_b_down[i])
        if need_ctx:
            ctx = ctx + m_c[2] * mix_c
            h_c = modulate(ctx, norm2_g[i], m_c[3], m_c[4])
            f = moe_ffn(jnp.concatenate([h_c, h_l], axis=1), *moe_args)
            ctx = ctx + m_c[5] * f[:, :n_ctx]
            x = x + m_l[5] * f[:, n_ctx:]
        else:
            x = x + m_l[5] * moe_ffn(h_l, *moe_args)
    return x
```

```cpp
#include <hip/hip_runtime.h>
#include <stdint.h>

#ifndef NAIVE_H
#define NAIVE_H
#include <math.h>
#ifdef HOST_TEST
#define HD inline
#define HDC inline
#define ATOMIC_INC(p) ((*(p))++)
#define UNIFORM(x) (x)
#else
#define HD __device__ __forceinline__
#define HDC __host__ __device__ __forceinline__
#define ATOMIC_INC(p) atomicAdd((p), 1)
#define UNIFORM(x) __builtin_amdgcn_readfirstlane(x)
#endif

#ifndef CFG_D
#define CFG_D 1024
#define CFG_SEQ 16384
#define CFG_CTX 256
#define CFG_FF 1024
#define CFG_DEPTH 4
#endif
constexpr int D = CFG_D, SEQ = CFG_SEQ, CTX = CFG_CTX, FF = CFG_FF, DEPTH = CFG_DEPTH;
constexpr int M = CTX + SEQ;
constexpr int GRID_W = 64;
constexpr int NH = 6, QKD = 96, NOPE = 64, ROPE = 32, VD = 64, QL = 256, KVL = 128;
constexpr int SH = 6, SP = 64, SW = 384, SG = 2, SN = 64, CONVD = 640, CHUNK = 128;
constexpr int PW = 256, MIXW = 1024, INC = 1708;
constexpr int C_Q = 0, C_KV = 256, C_KR = 384, C_Z = 416, C_XBC = 800, C_DT = 1440, C_POOL = 1452;
constexpr int NE = 32, TOPK = 4;
constexpr float EPS = 1e-6f;

struct P {
    const float *x, *c, *ctx, *c_ctx, *norm1_g, *norm2_g, *mod_w, *mod_b, *w_in, *q_g, *kv_g, *w_uq, *w_ukv, *qn_g, *kn_g;
    const float *conv_w, *conv_b, *a_log, *dt_bias, *ssd_d, *ssd_norm_g, *pool_w, *pool_scale, *w_out, *router_w, *router_b;
    const float *wg, *bg, *wu, *bu, *wd, *bd;
    float* out;
    float *xres, *mod, *rs, *h, *proj, *qln, *kvln, *qraw, *kvraw, *q, *k, *v, *mixin, *xbc, *dt, *ydir, *poolp, *mix, *logits, *topw, *act, *down;
    int *topi, *cnt, *list;
};

HD float siluf(float x) { return x / (1.0f + expf(-x)); }
HD float sigmf(float x) { return 1.0f / (1.0f + expf(-x)); }
HD float softplusf(float x) { return x > 20.0f ? x : log1pf(expf(x)); }
HD const float* modv(const P& p, int l, int r, int j) { return p.mod + ((size_t)(l * 2 + (r < CTX ? 1 : 0)) * 6 + j) * D; }

enum { OP_COPY_IN = 0, OP_MODVEC, OP_ROWSTAT, OP_NORM1, OP_INPROJ, OP_LATNORM, OP_QRAW, OP_KVRAW, OP_QHEAD, OP_KHEAD, OP_ATTN, OP_CONV, OP_DT, OP_SSDSCAN, OP_SSDFIN,
       OP_POOLP, OP_POOLMM, OP_OUTPROJ, OP_RES1, OP_NORM2, OP_LOGITS, OP_ZEROCNT, OP_TOPK, OP_GATEUP, OP_DOWN, OP_COMBINE, OP_WRITE_OUT, OP_COUNT };

HDC long op_count(int op) {
    switch (op) {
        case OP_COPY_IN: return (long)M * D;
        case OP_MODVEC: return (long)DEPTH * 2 * 6 * D;
        case OP_ROWSTAT: return M;
        case OP_NORM1: case OP_NORM2: return (long)M * D;
        case OP_INPROJ: return (long)(M / 8) * INC;
        case OP_LATNORM: return 2L * M;
        case OP_QRAW: return (long)(M / 8) * (NH * QKD);
        case OP_KVRAW: return (long)(M / 8) * (NH * 128);
        case OP_QHEAD: case OP_KHEAD: return (long)M * NH;
        case OP_ATTN: return (long)M * NH;
        case OP_CONV: return (long)M * CONVD;
        case OP_DT: return (long)M * 12;
        case OP_SSDSCAN: return 2L * SH * SP;
        case OP_SSDFIN: return M;
        case OP_POOLP: return (long)M * PW;
        case OP_POOLMM: return (long)M * PW;
        case OP_OUTPROJ: return (long)(M / 8) * D;
        case OP_RES1: return (long)M * D;
        case OP_LOGITS: return (long)M * NE;
        case OP_ZEROCNT: return NE;
        case OP_TOPK: return M;
        case OP_GATEUP: return (long)NE * (M / 8) * FF;
        case OP_DOWN: return (long)NE * (M / 8) * D;
        case OP_COMBINE: return (long)M * D;
        case OP_WRITE_OUT: return (long)SEQ * D;
    }
    return 0;
}

HD void gemm8(const float* A, int lda, const float* B, int ldb, const float* bias, float* C, int ldc, int N, int K, long idx) {
    const int j = (int)(idx % N); const long r0 = (idx / N) * 8;
    float acc[8];
#pragma unroll
    for (int i = 0; i < 8; ++i) acc[i] = 0.f;
    const float* a = A + r0 * lda;
    for (int k = 0; k < K; ++k) {
        const float b = B[(size_t)k * ldb + j];
#pragma unroll
        for (int i = 0; i < 8; ++i) acc[i] += a[(size_t)i * lda + k] * b;
    }
    const float bv = bias ? bias[j] : 0.f;
#pragma unroll
    for (int i = 0; i < 8; ++i) C[(r0 + i) * ldc + j] = acc[i] + bv;
}

HD void sincos_rr(float angf, float& cs, float& sn) {
    const double x = (double)angf; const double n = rint(x * 0.63661977236758134308); const double y = (x - n * 1.57079632679489655800) - n * 6.123233995736766e-17; const double y2 = y * y;
    const double s = y * (1.0 + y2 * (-1.0 / 6 + y2 * (1.0 / 120 + y2 * (-1.0 / 5040 + y2 * (1.0 / 362880 + y2 * (-1.0 / 39916800))))));
    const double c = 1.0 + y2 * (-0.5 + y2 * (1.0 / 24 + y2 * (-1.0 / 720 + y2 * (1.0 / 40320 + y2 * (-1.0 / 3628800 + y2 * (1.0 / 479001600))))));
    const int q = ((int)n) & 3; const double cc = (q == 0) ? c : (q == 1) ? -s : (q == 2) ? -c : s; const double ss = (q == 0) ? s : (q == 1) ? c : (q == 2) ? -s : -c;
    cs = (float)cc; sn = (float)ss;
}
HD float rope_inv_freq(int f) { return f == 0 ? 1.0f : f == 1 ? 0.31622776f : f == 2 ? 0.1f : f == 3 ? 0.031622775f : f == 4 ? 0.01f : f == 5 ? 0.0031622776f : f == 6 ? 0.001f : 0.00031622776f; }
HD void rope_apply(float* v32, int t) {
    const float row = (float)(t / GRID_W), col = (float)(t % GRID_W);
#pragma unroll
    for (int a = 0; a < 2; ++a)
#pragma unroll
        for (int f = 0; f < 8; ++f) {
            const float ang = (a == 0 ? row : col) * rope_inv_freq(f);
            float cs, sn; sincos_rr(ang, cs, sn);
            const float x1 = v32[a * 16 + f], x2 = v32[a * 16 + 8 + f];
            v32[a * 16 + f] = x1 * cs - x2 * sn; v32[a * 16 + 8 + f] = x2 * cs + x1 * sn;
        }
}

HD void op_run(int op, const P& p, int l, long idx) {
    switch (op) {
    case OP_COPY_IN: { const long r = idx / D; const int c = (int)(idx % D); p.xres[idx] = r < CTX ? p.ctx[idx] : p.x[(r - CTX) * D + c]; } break;
    case OP_MODVEC: {
        const int j = (int)(idx % (6 * D)); const int which = (int)((idx / (6 * D)) % 2); const int ll = (int)(idx / (12 * D));
        const float* cv = which ? p.c_ctx : p.c; float s = 0.f;
        for (int k = 0; k < D; ++k) s += siluf(cv[k]) * p.mod_w[((size_t)ll * D + k) * (6 * D) + j];
        p.mod[idx] = s + p.mod_b[(size_t)ll * 6 * D + j];
    } break;
    case OP_ROWSTAT: { const float* xr = p.xres + idx * D; float s = 0.f; for (int k = 0; k < D; ++k) s += xr[k] * xr[k]; p.rs[idx] = 1.0f / sqrtf(s / D + EPS); } break;
    case OP_NORM1: case OP_NORM2: { const int r = (int)(idx / D), c = (int)(idx % D); const int o = op == OP_NORM1 ? 0 : 3;
        const float g = (op == OP_NORM1 ? p.norm1_g : p.norm2_g)[l * D + c];
        p.h[idx] = p.xres[idx] * p.rs[r] * g * (1.0f + modv(p, l, r, o + 1)[c]) + modv(p, l, r, o)[c]; } break;
    case OP_INPROJ: gemm8(p.h, D, p.w_in + (size_t)l * D * INC, INC, nullptr, p.proj, INC, INC, D, idx); break;
    case OP_LATNORM: {
        const int which = idx >= M; const long r = which ? idx - M : idx; const int n = which ? KVL : QL; const float* src = p.proj + r * INC + (which ? C_KV : C_Q);
        float s = 0.f; for (int k = 0; k < n; ++k) s += src[k] * src[k]; const float rs = 1.0f / sqrtf(s / n + EPS);
        float* dst = which ? p.kvln + r * KVL : p.qln + r * QL; const float* g = which ? p.kv_g + l * KVL : p.q_g + l * QL;
        for (int k = 0; k < n; ++k) dst[k] = src[k] * rs * g[k];
    } break;
    case OP_QRAW: gemm8(p.qln, QL, p.w_uq + (size_t)l * QL * (NH * QKD), NH * QKD, nullptr, p.qraw, NH * QKD, NH * QKD, QL, idx); break;
    case OP_KVRAW: gemm8(p.kvln, KVL, p.w_ukv + (size_t)l * KVL * (NH * 128), NH * 128, nullptr, p.kvraw, NH * 128, NH * 128, KVL, idx); break;
    case OP_QHEAD: { const int r = (int)(idx / NH), hh = (int)(idx % NH); const float* src = p.qraw + (size_t)r * (NH * QKD) + hh * QKD; float s = 0.f;
        for (int d = 0; d < QKD; ++d) s += src[d] * src[d]; const float rs = 1.0f / sqrtf(s / QKD + EPS);
        float* dst = p.q + ((size_t)r * NH + hh) * QKD; float rp[32];
        for (int d = 0; d < NOPE; ++d) dst[d] = src[d] * rs * p.qn_g[l * QKD + d];
#pragma unroll
        for (int d = 0; d < 32; ++d) rp[d] = src[NOPE + d] * rs * p.qn_g[l * QKD + NOPE + d];
        if (r >= CTX) rope_apply(rp, r - CTX);
#pragma unroll
        for (int d = 0; d < 32; ++d) dst[NOPE + d] = rp[d];
    } break;
    case OP_KHEAD: { const int r = (int)(idx / NH), hh = (int)(idx % NH); const float* kn = p.kvraw + (size_t)r * (NH * 128) + hh * 128; const float* kr = p.proj + (size_t)r * INC + C_KR; float s = 0.f;
        for (int d = 0; d < NOPE; ++d) s += kn[d] * kn[d];
        for (int d = 0; d < ROPE; ++d) s += kr[d] * kr[d];
        const float rs = 1.0f / sqrtf(s / QKD + EPS);
        float* dst = p.k + ((size_t)r * NH + hh) * QKD; float rp[32];
        for (int d = 0; d < NOPE; ++d) dst[d] = kn[d] * rs * p.kn_g[l * QKD + d];
#pragma unroll
        for (int d = 0; d < 32; ++d) rp[d] = kr[d] * rs * p.kn_g[l * QKD + NOPE + d];
        if (r >= CTX) rope_apply(rp, r - CTX);
#pragma unroll
        for (int d = 0; d < 32; ++d) dst[NOPE + d] = rp[d];
        float* vd = p.v + ((size_t)r * NH + hh) * VD;
        for (int d = 0; d < VD; ++d) vd[d] = kn[NOPE + d];
    } break;
    case OP_ATTN: {
        const int r = (int)(idx % M), hh = UNIFORM((int)(idx / M)); const int nk = r < CTX ? CTX : M;
        float qv[QKD], o[VD];
        const float* qp = p.q + ((size_t)r * NH + hh) * QKD; const float scale = 1.0f / sqrtf((float)QKD);
#pragma unroll
        for (int d = 0; d < QKD; ++d) qv[d] = qp[d] * scale;
#pragma unroll
        for (int d = 0; d < VD; ++d) o[d] = 0.f;
        float mx = -1e30f, lsum = 0.f;
        for (int kk = 0; kk < nk; ++kk) {
            const float* kp = p.k + ((size_t)kk * NH + hh) * QKD; const float* vp = p.v + ((size_t)kk * NH + hh) * VD; float s = 0.f;
#pragma unroll
            for (int d = 0; d < QKD; ++d) s += qv[d] * kp[d];
            const float mn = s > mx ? s : mx; const float corr = expf(mx - mn), pe = expf(s - mn);
            lsum = lsum * corr + pe; mx = mn;
#pragma unroll
            for (int d = 0; d < VD; ++d) o[d] = o[d] * corr + pe * vp[d];
        }
        const float inv = 1.0f / lsum; float* dst = p.mixin + (size_t)r * MIXW + hh * VD;
#pragma unroll
        for (int d = 0; d < VD; ++d) dst[d] = o[d] * inv;
    } break;
    case OP_CONV: { const int r = (int)(idx / CONVD), c = (int)(idx % CONVD); const int seg0 = r < CTX ? 0 : CTX, n = r < CTX ? CTX : SEQ, t = r - seg0; float y = p.conv_b[l * CONVD + c];
#pragma unroll
        for (int j = 0; j < 4; ++j) { const int tt = t - 2 + j; if (tt >= 0 && tt < n) y += p.conv_w[((size_t)l * 4 + j) * CONVD + c] * p.proj[(size_t)(seg0 + tt) * INC + C_XBC + c]; }
        p.xbc[idx] = siluf(y); } break;
    case OP_DT: { const int r = (int)(idx / 12), j = (int)(idx % 12); p.dt[idx] = softplusf(p.proj[(size_t)r * INC + C_DT + j] + p.dt_bias[l * 12 + j]); } break;
    case OP_SSDSCAN: {
        const int pp = (int)(idx % SP), hh = UNIFORM((int)((idx / SP) % SH)), dir = UNIFORM((int)(idx / (SP * SH))); const int g = hh / (SH / SG);
        const float a = -expf(p.a_log[l * 12 + dir * 6 + hh]); float st[SN];
#pragma unroll
        for (int n = 0; n < SN; ++n) st[n] = 0.f;
        for (int step = 0; step < M; ++step) {
            const int r = dir == 0 ? step : (step < CTX ? CTX - 1 - step : M - 1 - (step - CTX));
            const float dtv = p.dt[(size_t)r * 12 + dir * 6 + hh]; const float dA = expf(dtv * a); const float xv = p.xbc[(size_t)r * CONVD + hh * SP + pp] * dtv;
            const float* Bp = p.xbc + (size_t)r * CONVD + SW + g * SN; const float* Cp = p.xbc + (size_t)r * CONVD + SW + SG * SN + g * SN; float y = 0.f;
#pragma unroll
            for (int n = 0; n < SN; ++n) { st[n] = st[n] * dA + xv * Bp[n]; y += st[n] * Cp[n]; }
            p.ydir[((size_t)dir * M + r) * SW + hh * SP + pp] = y;
        }
    } break;
    case OP_SSDFIN: { const long r = idx; float ss = 0.f;
        for (int c = 0; c < SW; ++c) { const float y = p.ydir[r * SW + c] + p.ydir[((size_t)M + r) * SW + c] + p.ssd_d[l * SH + c / SP] * p.xbc[r * CONVD + c]; const float gv = y * siluf(p.proj[r * INC + C_Z + c]); ss += gv * gv; }
        const float rs = 1.0f / sqrtf(ss / SW + EPS);
        for (int c = 0; c < SW; ++c) { const float y = p.ydir[r * SW + c] + p.ydir[((size_t)M + r) * SW + c] + p.ssd_d[l * SH + c / SP] * p.xbc[r * CONVD + c]; const float gv = y * siluf(p.proj[r * INC + C_Z + c]);
            p.mixin[r * MIXW + NH * VD + c] = gv * rs * p.ssd_norm_g[l * SW + c]; }
    } break;
    case OP_POOLP: { const int r = (int)(idx / PW), c = (int)(idx % PW); const int gi = c / 64; const int win = 2 << gi; const int seg0 = r < CTX ? 0 : CTX, n = r < CTX ? CTX : SEQ, t = r - seg0;
        int lo = t - win / 2, hi = t - win / 2 + win; lo = lo < 0 ? 0 : lo; hi = hi > n ? n : hi; float s = 0.f;
        for (int tt = lo; tt < hi; ++tt) s += p.proj[(size_t)(seg0 + tt) * INC + C_POOL + c];
        p.poolp[idx] = s / (float)(hi - lo) - p.proj[(size_t)r * INC + C_POOL + c]; } break;
    case OP_POOLMM: { const int r = (int)(idx / PW), c = (int)(idx % PW); const int gi = c / 64, d = c % 64; float s = 0.f;
        for (int cc = 0; cc < 64; ++cc) s += p.poolp[(size_t)r * PW + gi * 64 + cc] * p.pool_w[(((size_t)l * 4 + gi) * 64 + cc) * 64 + d];
        p.mixin[(size_t)r * MIXW + NH * VD + SW + c] = s * p.pool_scale[l * PW + c]; } break;
    case OP_OUTPROJ: gemm8(p.mixin, MIXW, p.w_out + (size_t)l * MIXW * D, D, nullptr, p.mix, D, D, MIXW, idx); break;
    case OP_RES1: { const int r = (int)(idx / D), c = (int)(idx % D); p.xres[idx] += modv(p, l, r, 2)[c] * p.mix[idx]; } break;
    case OP_LOGITS: { const int r = (int)(idx / NE), e = (int)(idx % NE); const float* hr = p.h + (size_t)r * D; float s = 0.f;
        for (int k = 0; k < D; ++k) s += hr[k] * p.router_w[((size_t)l * D + k) * NE + e];
        p.logits[idx] = s + p.router_b[l * NE + e]; } break;
    case OP_ZEROCNT: p.cnt[idx] = 0; break;
    case OP_TOPK: { const long t = idx; float lg[NE];
#pragma unroll
        for (int e = 0; e < NE; ++e) lg[e] = p.logits[t * NE + e];
        int sel[4]; float sv[4];
#pragma unroll
        for (int kk = 0; kk < 4; ++kk) { float best = -3.0e38f; int bi = 0;
#pragma unroll
            for (int e = 0; e < NE; ++e) { bool taken = false;
#pragma unroll
                for (int q = 0; q < kk; ++q) taken = taken || (sel[q] == e);
                if (!taken && lg[e] > best) { best = lg[e]; bi = e; } }
            sel[kk] = bi; sv[kk] = best; }
        float es[4], sum = 0.f;
#pragma unroll
        for (int kk = 0; kk < 4; ++kk) { es[kk] = expf(sv[kk] - sv[0]); sum += es[kk]; }
#pragma unroll
        for (int kk = 0; kk < 4; ++kk) { p.topi[t * 4 + kk] = sel[kk]; p.topw[t * 4 + kk] = es[kk] / sum; const int pos = ATOMIC_INC(&p.cnt[sel[kk]]); p.list[(size_t)sel[kk] * M + pos] = (int)(t * 4 + kk); }
    } break;
    case OP_GATEUP: {
        const int j = (int)(idx % FF); const long rest = idx / FF; const int rb = (int)(rest % (M / 8)), e = (int)(rest / (M / 8)); const int cnt = p.cnt[e]; if (rb * 8 >= cnt) break;
        int a[8]; float g[8], u[8];
#pragma unroll
        for (int i = 0; i < 8; ++i) { a[i] = rb * 8 + i < cnt ? p.list[(size_t)e * M + rb * 8 + i] : -1; g[i] = 0.f; u[i] = 0.f; }
        const float* wgp = p.wg + ((size_t)l * NE + e) * D * FF + j; const float* wup = p.wu + ((size_t)l * NE + e) * D * FF + j;
        for (int k = 0; k < D; ++k) { const float gw = wgp[(size_t)k * FF], uw = wup[(size_t)k * FF];
#pragma unroll
            for (int i = 0; i < 8; ++i) { const float xv = p.h[(size_t)(a[i] < 0 ? 0 : a[i] / 4) * D + k]; g[i] += xv * gw; u[i] += xv * uw; } }
        const float bgv = p.bg[((size_t)l * NE + e) * FF + j], buv = p.bu[((size_t)l * NE + e) * FF + j];
#pragma unroll
        for (int i = 0; i < 8; ++i) if (a[i] >= 0) { float gv = g[i] + bgv; gv = gv < 7.0f ? gv : 7.0f; float uv = u[i] + buv; uv = uv < -7.0f ? -7.0f : (uv > 7.0f ? 7.0f : uv);
            p.act[(size_t)a[i] * FF + j] = gv * sigmf(1.702f * gv) * (uv + 1.0f); }
    } break;
    case OP_DOWN: {
        const int j = (int)(idx % D); const long rest = idx / D; const int rb = (int)(rest % (M / 8)), e = (int)(rest / (M / 8)); const int cnt = p.cnt[e]; if (rb * 8 >= cnt) break;
        int a[8]; float o[8];
#pragma unroll
        for (int i = 0; i < 8; ++i) { a[i] = rb * 8 + i < cnt ? p.list[(size_t)e * M + rb * 8 + i] : -1; o[i] = 0.f; }
        const float* wdp = p.wd + ((size_t)l * NE + e) * FF * D + j;
        for (int k = 0; k < FF; ++k) { const float w = wdp[(size_t)k * D];
#pragma unroll
            for (int i = 0; i < 8; ++i) o[i] += p.act[(size_t)(a[i] < 0 ? 0 : a[i]) * FF + k] * w; }
        const float bv = p.bd[((size_t)l * NE + e) * D + j];
#pragma unroll
        for (int i = 0; i < 8; ++i) if (a[i] >= 0) p.down[(size_t)a[i] * D + j] = o[i] + bv;
    } break;
    case OP_COMBINE: { const int r = (int)(idx / D), c = (int)(idx % D); float s = 0.f;
#pragma unroll
        for (int kk = 0; kk < 4; ++kk) s += p.topw[(size_t)r * 4 + kk] * p.down[((size_t)r * 4 + kk) * D + c];
        p.xres[idx] += modv(p, l, r, 5)[c] * s; } break;
    case OP_WRITE_OUT: p.out[idx] = p.xres[(size_t)CTX * D + idx]; break;
    }
}

static const int LAYER_OPS[] = { OP_ROWSTAT, OP_NORM1, OP_INPROJ, OP_LATNORM, OP_QRAW, OP_KVRAW, OP_QHEAD, OP_KHEAD, OP_ATTN, OP_CONV, OP_DT, OP_SSDSCAN, OP_SSDFIN, OP_POOLP, OP_POOLMM,
                                 OP_OUTPROJ, OP_RES1, OP_ROWSTAT, OP_NORM2, OP_LOGITS, OP_ZEROCNT, OP_TOPK, OP_GATEUP, OP_DOWN, OP_COMBINE };
constexpr int N_LAYER_OPS = sizeof(LAYER_OPS) / sizeof(int);
#endif

template <int OP> __device__ __forceinline__ void run_op(const P& p, int l) {
    const long n = op_count(OP); const long stride = (long)gridDim.x * blockDim.x;
    for (long i = (long)blockIdx.x * blockDim.x + threadIdx.x; i < n; i += stride) op_run(OP, p, l, i);
}
template <int OP> __global__ void __launch_bounds__(256) k_op(P p, int l) { run_op<OP>(p, l); }
template <int OP> static void launch_op(const P& p, int l, hipStream_t s) {
    const long n = op_count(OP); long g = (n + 255) / 256; if (g > 131072) g = 131072; if (g < 1) g = 1;
    hipLaunchKernelGGL(k_op<OP>, dim3((unsigned)g), dim3(256), 0, s, p, l);
}
static void launch_layer_op(int op, const P& p, int l, hipStream_t s) {
    switch (op) {
#define LOP(X) case X: launch_op<X>(p, l, s); break;
        LOP(OP_ROWSTAT) LOP(OP_NORM1) LOP(OP_INPROJ) LOP(OP_LATNORM) LOP(OP_QRAW) LOP(OP_KVRAW) LOP(OP_QHEAD) LOP(OP_KHEAD) LOP(OP_ATTN) LOP(OP_CONV) LOP(OP_DT) LOP(OP_SSDSCAN) LOP(OP_SSDFIN)
        LOP(OP_POOLP) LOP(OP_POOLMM) LOP(OP_OUTPROJ) LOP(OP_RES1) LOP(OP_NORM2) LOP(OP_LOGITS) LOP(OP_ZEROCNT) LOP(OP_TOPK) LOP(OP_GATEUP) LOP(OP_DOWN) LOP(OP_COMBINE)
#undef LOP
    }
}
static size_t carve(char*& cur, size_t bytes) { size_t a = (bytes + 255) & ~(size_t)255; cur += a; return a; }
static bool setup_params(P& p, void* const* d_in, void* d_out, void* d_ws, size_t ws_size) {
    const float** pp = (const float**)&p; for (int i = 0; i < 32; ++i) pp[i] = (const float*)d_in[i];
    p.out = (float*)d_out;
    char* cur = (char*)d_ws; char* base = cur;
#define CARVE(field, type, count) p.field = (type*)cur; carve(cur, (size_t)(count) * sizeof(type));
    CARVE(xres, float, (size_t)M * D) CARVE(mod, float, (size_t)DEPTH * 12 * D) CARVE(rs, float, M) CARVE(h, float, (size_t)M * D) CARVE(proj, float, (size_t)M * INC) CARVE(qln, float, (size_t)M * QL)
    CARVE(kvln, float, (size_t)M * KVL) CARVE(qraw, float, (size_t)M * NH * QKD) CARVE(kvraw, float, (size_t)M * NH * 128) CARVE(q, float, (size_t)M * NH * QKD) CARVE(k, float, (size_t)M * NH * QKD)
    CARVE(v, float, (size_t)M * NH * VD) CARVE(mixin, float, (size_t)M * MIXW) CARVE(xbc, float, (size_t)M * CONVD) CARVE(dt, float, (size_t)M * 12) CARVE(ydir, float, (size_t)2 * M * SW)
    CARVE(poolp, float, (size_t)M * PW) CARVE(mix, float, (size_t)M * D) CARVE(logits, float, (size_t)M * NE) CARVE(topw, float, (size_t)M * 4) CARVE(act, float, (size_t)M * 4 * FF)
    CARVE(down, float, (size_t)M * 4 * D) CARVE(topi, int, (size_t)M * 4) CARVE(cnt, int, NE) CARVE(list, int, (size_t)NE * M)
#undef CARVE
    return (size_t)(cur - base) <= ws_size;
}
extern "C" void kernel_launch(void* const* d_in, const int* in_sizes, int n_in, void* d_out, int out_size, void* d_ws, size_t ws_size, hipStream_t stream) {
    P p{};
    if (n_in < 32 || !setup_params(p, d_in, d_out, d_ws, ws_size)) return;
    launch_op<OP_COPY_IN>(p, 0, stream); launch_op<OP_MODVEC>(p, 0, stream);
    for (int l = 0; l < DEPTH; ++l) for (int i = 0; i < N_LAYER_OPS; ++i) launch_layer_op(LAYER_OPS[i], p, l, stream);
    launch_op<OP_WRITE_OUT>(p, 0, stream);
}
```

```cpp
#include <hip/hip_runtime.h>
#include <stdint.h>

#ifndef NAIVE_H
#define NAIVE_H
#include <math.h>
#ifdef HOST_TEST
#define HD inline
#define HDC inline
#define ATOMIC_INC(p) ((*(p))++)
#define UNIFORM(x) (x)
#else
#define HD __device__ __forceinline__
#define HDC __host__ __device__ __forceinline__
#define ATOMIC_INC(p) atomicAdd((p), 1)
#define UNIFORM(x) __builtin_amdgcn_readfirstlane(x)
#endif

#ifndef CFG_D
#define CFG_D 1024
#define CFG_SEQ 16384
#define CFG_CTX 256
#define CFG_FF 1024
#define CFG_DEPTH 4
#endif
constexpr int D = CFG_D, SEQ = CFG_SEQ, CTX = CFG_CTX, FF = CFG_FF, DEPTH = CFG_DEPTH;
constexpr int M = CTX + SEQ;
constexpr int GRID_W = 64;
constexpr int NH = 6, QKD = 96, NOPE = 64, ROPE = 32, VD = 64, QL = 256, KVL = 128;
constexpr int SH = 6, SP = 64, SW = 384, SG = 2, SN = 64, CONVD = 640, CHUNK = 128;
constexpr int PW = 256, MIXW = 1024, INC = 1708;
constexpr int C_Q = 0, C_KV = 256, C_KR = 384, C_Z = 416, C_XBC = 800, C_DT = 1440, C_POOL = 1452;
constexpr int NE = 32, TOPK = 4;
constexpr float EPS = 1e-6f;

struct P {
    const float *x, *c, *ctx, *c_ctx, *norm1_g, *norm2_g, *mod_w, *mod_b, *w_in, *q_g, *kv_g, *w_uq, *w_ukv, *qn_g, *kn_g;
    const float *conv_w, *conv_b, *a_log, *dt_bias, *ssd_d, *ssd_norm_g, *pool_w, *pool_scale, *w_out, *router_w, *router_b;
    const float *wg, *bg, *wu, *bu, *wd, *bd;
    float* out;
    float *xres, *mod, *rs, *h, *proj, *qln, *kvln, *qraw, *kvraw, *q, *k, *v, *mixin, *xbc, *dt, *ydir, *poolp, *mix, *logits, *topw, *act, *down;
    int *topi, *cnt, *list;
};

HD float siluf(float x) { return x / (1.0f + expf(-x)); }
HD float sigmf(float x) { return 1.0f / (1.0f + expf(-x)); }
HD float softplusf(float x) { return x > 20.0f ? x : log1pf(expf(x)); }
HD const float* modv(const P& p, int l, int r, int j) { return p.mod + ((size_t)(l * 2 + (r < CTX ? 1 : 0)) * 6 + j) * D; }

enum { OP_COPY_IN = 0, OP_MODVEC, OP_ROWSTAT, OP_NORM1, OP_INPROJ, OP_LATNORM, OP_QRAW, OP_KVRAW, OP_QHEAD, OP_KHEAD, OP_ATTN, OP_CONV, OP_DT, OP_SSDSCAN, OP_SSDFIN,
       OP_POOLP, OP_POOLMM, OP_OUTPROJ, OP_RES1, OP_NORM2, OP_LOGITS, OP_ZEROCNT, OP_TOPK, OP_GATEUP, OP_DOWN, OP_COMBINE, OP_WRITE_OUT, OP_COUNT };

HDC long op_count(int op) {
    switch (op) {
        case OP_COPY_IN: return (long)M * D;
        case OP_MODVEC: return (long)DEPTH * 2 * 6 * D;
        case OP_ROWSTAT: return M;
        case OP_NORM1: case OP_NORM2: return (long)M * D;
        case OP_INPROJ: return (long)(M / 8) * INC;
        case OP_LATNORM: return 2L * M;
        case OP_QRAW: return (long)(M / 8) * (NH * QKD);
        case OP_KVRAW: return (long)(M / 8) * (NH * 128);
        case OP_QHEAD: case OP_KHEAD: return (long)M * NH;
        case OP_ATTN: return (long)M * NH;
        case OP_CONV: return (long)M * CONVD;
        case OP_DT: return (long)M * 12;
        case OP_SSDSCAN: return 2L * SH * SP;
        case OP_SSDFIN: return M;
        case OP_POOLP: return (long)M * PW;
        case OP_POOLMM: return (long)M * PW;
        case OP_OUTPROJ: return (long)(M / 8) * D;
        case OP_RES1: return (long)M * D;
        case OP_LOGITS: return (long)M * NE;
        case OP_ZEROCNT: return NE;
        case OP_TOPK: return M;
        case OP_GATEUP: return (long)NE * (M / 8) * FF;
        case OP_DOWN: return (long)NE * (M / 8) * D;
        case OP_COMBINE: return (long)M * D;
        case OP_WRITE_OUT: return (long)SEQ * D;
    }
    return 0;
}

HD void gemm8(const float* A, int lda, const float* B, int ldb, const float* bias, float* C, int ldc, int N, int K, long idx) {
    const int j = (int)(idx % N); const long r0 = (idx / N) * 8;
    float acc[8];
#pragma unroll
    for (int i = 0; i < 8; ++i) acc[i] = 0.f;
    const float* a = A + r0 * lda;
    for (int k = 0; k < K; ++k) {
        const float b = B[(size_t)k * ldb + j];
#pragma unroll
        for (int i = 0; i < 8; ++i) acc[i] += a[(size_t)i * lda + k] * b;
    }
    const float bv = bias ? bias[j] : 0.f;
#pragma unroll
    for (int i = 0; i < 8; ++i) C[(r0 + i) * ldc + j] = acc[i] + bv;
}

HD void sincos_rr(float angf, float& cs, float& sn) {
    const double x = (double)angf; const double n = rint(x * 0.63661977236758134308); const double y = (x - n * 1.57079632679489655800) - n * 6.123233995736766e-17; const double y2 = y * y;
    const double s = y * (1.0 + y2 * (-1.0 / 6 + y2 * (1.0 / 120 + y2 * (-1.0 / 5040 + y2 * (1.0 / 362880 + y2 * (-1.0 / 39916800))))));
    const double c = 1.0 + y2 * (-0.5 + y2 * (1.0 / 24 + y2 * (-1.0 / 720 + y2 * (1.0 / 40320 + y2 * (-1.0 / 3628800 + y2 * (1.0 / 479001600))))));
    const int q = ((int)n) & 3; const double cc = (q == 0) ? c : (q == 1) ? -s : (q == 2) ? -c : s; const double ss = (q == 0) ? s : (q == 1) ? c : (q == 2) ? -s : -c;
    cs = (float)cc; sn = (float)ss;
}
HD float rope_inv_freq(int f) { return f == 0 ? 1.0f : f == 1 ? 0.31622776f : f == 2 ? 0.1f : f == 3 ? 0.031622775f : f == 4 ? 0.01f : f == 5 ? 0.0031622776f : f == 6 ? 0.001f : 0.00031622776f; }
HD void rope_apply(float* v32, int t) {
    const float row = (float)(t / GRID_W), col = (float)(t % GRID_W);
#pragma unroll
    for (int a = 0; a < 2; ++a)
#pragma unroll
        for (int f = 0; f < 8; ++f) {
            const float ang = (a == 0 ? row : col) * rope_inv_freq(f);
            float cs, sn; sincos_rr(ang, cs, sn);
            const float x1 = v32[a * 16 + f], x2 = v32[a * 16 + 8 + f];
            v32[a * 16 + f] = x1 * cs - x2 * sn; v32[a * 16 + 8 + f] = x2 * cs + x1 * sn;
        }
}

HD void op_run(int op, const P& p, int l, long idx) {
    switch (op) {
    case OP_COPY_IN: { const long r = idx / D; const int c = (int)(idx % D); p.xres[idx] = r < CTX ? p.ctx[idx] : p.x[(r - CTX) * D + c]; } break;
    case OP_MODVEC: {
        const int j = (int)(idx % (6 * D)); const int which = (int)((idx / (6 * D)) % 2); const int ll = (int)(idx / (12 * D));
        const float* cv = which ? p.c_ctx : p.c; float s = 0.f;
        for (int k = 0; k < D; ++k) s += siluf(cv[k]) * p.mod_w[((size_t)ll * D + k) * (6 * D) + j];
        p.mod[idx] = s + p.mod_b[(size_t)ll * 6 * D + j];
    } break;
    case OP_ROWSTAT: { const float* xr = p.xres + idx * D; float s = 0.f; for (int k = 0; k < D; ++k) s += xr[k] * xr[k]; p.rs[idx] = 1.0f / sqrtf(s / D + EPS); } break;
    case OP_NORM1: case OP_NORM2: { const int r = (int)(idx / D), c = (int)(idx % D); const int o = op == OP_NORM1 ? 0 : 3;
        const float g = (op == OP_NORM1 ? p.norm1_g : p.norm2_g)[l * D + c];
        p.h[idx] = p.xres[idx] * p.rs[r] * g * (1.0f + modv(p, l, r, o + 1)[c]) + modv(p, l, r, o)[c]; } break;
    case OP_INPROJ: gemm8(p.h, D, p.w_in + (size_t)l * D * INC, INC, nullptr, p.proj, INC, INC, D, idx); break;
    case OP_LATNORM: {
        const int which = idx >= M; const long r = which ? idx - M : idx; const int n = which ? KVL : QL; const float* src = p.proj + r * INC + (which ? C_KV : C_Q);
        float s = 0.f; for (int k = 0; k < n; ++k) s += src[k] * src[k]; const float rs = 1.0f / sqrtf(s / n + EPS);
        float* dst = which ? p.kvln + r * KVL : p.qln + r * QL; const float* g = which ? p.kv_g + l * KVL : p.q_g + l * QL;
        for (int k = 0; k < n; ++k) dst[k] = src[k] * rs * g[k];
    } break;
    case OP_QRAW: gemm8(p.qln, QL, p.w_uq + (size_t)l * QL * (NH * QKD), NH * QKD, nullptr, p.qraw, NH * QKD, NH * QKD, QL, idx); break;
    case OP_KVRAW: gemm8(p.kvln, KVL, p.w_ukv + (size_t)l * KVL * (NH * 128), NH * 128, nullptr, p.kvraw, NH * 128, NH * 128, KVL, idx); break;
    case OP_QHEAD: { const int r = (int)(idx / NH), hh = (int)(idx % NH); const float* src = p.qraw + (size_t)r * (NH * QKD) + hh * QKD; float s = 0.f;
        for (int d = 0; d < QKD; ++d) s += src[d] * src[d]; const float rs = 1.0f / sqrtf(s / QKD + EPS);
        float* dst = p.q + ((size_t)r * NH + hh) * QKD; float rp[32];
        for (int d = 0; d < NOPE; ++d) dst[d] = src[d] * rs * p.qn_g[l * QKD + d];
#pragma unroll
        for (int d = 0; d < 32; ++d) rp[d] = src[NOPE + d] * rs * p.qn_g[l * QKD + NOPE + d];
        if (r >= CTX) rope_apply(rp, r - CTX);
#pragma unroll
        for (int d = 0; d < 32; ++d) dst[NOPE + d] = rp[d];
    } break;
    case OP_KHEAD: { const int r = (int)(idx / NH), hh = (int)(idx % NH); const float* kn = p.kvraw + (size_t)r * (NH * 128) + hh * 128; const float* kr = p.proj + (size_t)r * INC + C_KR; float s = 0.f;
        for (int d = 0; d < NOPE; ++d) s += kn[d] * kn[d];
        for (int d = 0; d < ROPE; ++d) s += kr[d] * kr[d];
        const float rs = 1.0f / sqrtf(s / QKD + EPS);
        float* dst = p.k + ((size_t)r * NH + hh) * QKD; float rp[32];
        for (int d = 0; d < NOPE; ++d) dst[d] = kn[d] * rs * p.kn_g[l * QKD + d];
#pragma unroll
        for (int d = 0; d < 32; ++d) rp[d] = kr[d] * rs * p.kn_g[l * QKD + NOPE + d];
        if (r >= CTX) rope_apply(rp, r - CTX);
#pragma unroll
        for (int d = 0; d < 32; ++d) dst[NOPE + d] = rp[d];
        float* vd = p.v + ((size_t)r * NH + hh) * VD;
        for (int d = 0; d < VD; ++d) vd[d] = kn[NOPE + d];
    } break;
    case OP_ATTN: {
        const int r = (int)(idx % M), hh = UNIFORM((int)(idx / M)); const int nk = r < CTX ? CTX : M;
        float qv[QKD], o[VD];
        const float* qp = p.q + ((size_t)r * NH + hh) * QKD; const float scale = 1.0f / sqrtf((float)QKD);
#pragma unroll
        for (int d = 0; d < QKD; ++d) qv[d] = qp[d] * scale;
#pragma unroll
        for (int d = 0; d < VD; ++d) o[d] = 0.f;
        float mx = -1e30f, lsum = 0.f;
        for (int kk = 0; kk < nk; ++kk) {
            const float* kp = p.k + ((size_t)kk * NH + hh) * QKD; const float* vp = p.v + ((size_t)kk * NH + hh) * VD; float s = 0.f;
#pragma unroll
            for (int d = 0; d < QKD; ++d) s += qv[d] * kp[d];
            const float mn = s > mx ? s : mx; const float corr = expf(mx - mn), pe = expf(s - mn);
            lsum = lsum * corr + pe; mx = mn;
#pragma unroll
            for (int d = 0; d < VD; ++d) o[d] = o[d] * corr + pe * vp[d];
        }
        const float inv = 1.0f / lsum; float* dst = p.mixin + (size_t)r * MIXW + hh * VD;
#pragma unroll
        for (int d = 0; d < VD; ++d) dst[d] = o[d] * inv;
    } break;
    case OP_CONV: { const int r = (int)(idx / CONVD), c = (int)(idx % CONVD); const int seg0 = r < CTX ? 0 : CTX, n = r < CTX ? CTX : SEQ, t = r - seg0; float y = p.conv_b[l * CONVD + c];
#pragma unroll
        for (int j = 0; j < 4; ++j) { const int tt = t - 2 + j; if (tt >= 0 && tt < n) y += p.conv_w[((size_t)l * 4 + j) * CONVD + c] * p.proj[(size_t)(seg0 + tt) * INC + C_XBC + c]; }
        p.xbc[idx] = siluf(y); } break;
    case OP_DT: { const int r = (int)(idx / 12), j = (int)(idx % 12); p.dt[idx] = softplusf(p.proj[(size_t)r * INC + C_DT + j] + p.dt_bias[l * 12 + j]); } break;
    case OP_SSDSCAN: {
        const int pp = (int)(idx % SP), hh = UNIFORM((int)((idx / SP) % SH)), dir = UNIFORM((int)(idx / (SP * SH))); const int g = hh / (SH / SG);
        const float a = -expf(p.a_log[l * 12 + dir * 6 + hh]); float st[SN];
#pragma unroll
        for (int n = 0; n < SN; ++n) st[n] = 0.f;
        for (int step = 0; step < M; ++step) {
            const int r = dir == 0 ? step : (step < CTX ? CTX - 1 - step : M - 1 - (step - CTX));
            const float dtv = p.dt[(size_t)r * 12 + dir * 6 + hh]; const float dA = expf(dtv * a); const float xv = p.xbc[(size_t)r * CONVD + hh * SP + pp] * dtv;
            const float* Bp = p.xbc + (size_t)r * CONVD + SW + g * SN; const float* Cp = p.xbc + (size_t)r * CONVD + SW + SG * SN + g * SN; float y = 0.f;
#pragma unroll
            for (int n = 0; n < SN; ++n) { st[n] = st[n] * dA + xv * Bp[n]; y += st[n] * Cp[n]; }
            p.ydir[((size_t)dir * M + r) * SW + hh * SP + pp] = y;
        }
    } break;
    case OP_SSDFIN: { const long r = idx; float ss = 0.f;
        for (int c = 0; c < SW; ++c) { const float y = p.ydir[r * SW + c] + p.ydir[((size_t)M + r) * SW + c] + p.ssd_d[l * SH + c / SP] * p.xbc[r * CONVD + c]; const float gv = y * siluf(p.proj[r * INC + C_Z + c]); ss += gv * gv; }
        const float rs = 1.0f / sqrtf(ss / SW + EPS);
        for (int c = 0; c < SW; ++c) { const float y = p.ydir[r * SW + c] + p.ydir[((size_t)M + r) * SW + c] + p.ssd_d[l * SH + c / SP] * p.xbc[r * CONVD + c]; const float gv = y * siluf(p.proj[r * INC + C_Z + c]);
            p.mixin[r * MIXW + NH * VD + c] = gv * rs * p.ssd_norm_g[l * SW + c]; }
    } break;
    case OP_POOLP: { const int r = (int)(idx / PW), c = (int)(idx % PW); const int gi = c / 64; const int win = 2 << gi; const int seg0 = r < CTX ? 0 : CTX, n = r < CTX ? CTX : SEQ, t = r - seg0;
        int lo = t - win / 2, hi = t - win / 2 + win; lo = lo < 0 ? 0 : lo; hi = hi > n ? n : hi; float s = 0.f;
        for (int tt = lo; tt < hi; ++tt) s += p.proj[(size_t)(seg0 + tt) * INC + C_POOL + c];
        p.poolp[idx] = s / (float)(hi - lo) - p.proj[(size_t)r * INC + C_POOL + c]; } break;
    case OP_POOLMM: { const int r = (int)(idx / PW), c = (int)(idx % PW); const int gi = c / 64, d = c % 64; float s = 0.f;
        for (int cc = 0; cc < 64; ++cc) s += p.poolp[(size_t)r * PW + gi * 64 + cc] * p.pool_w[(((size_t)l * 4 + gi) * 64 + cc) * 64 + d];
        p.mixin[(size_t)r * MIXW + NH * VD + SW + c] = s * p.pool_scale[l * PW + c]; } break;
    case OP_OUTPROJ: gemm8(p.mixin, MIXW, p.w_out + (size_t)l * MIXW * D, D, nullptr, p.mix, D, D, MIXW, idx); break;
    case OP_RES1: { const int r = (int)(idx / D), c = (int)(idx % D); p.xres[idx] += modv(p, l, r, 2)[c] * p.mix[idx]; } break;
    case OP_LOGITS: { const int r = (int)(idx / NE), e = (int)(idx % NE); const float* hr = p.h + (size_t)r * D; float s = 0.f;
        for (int k = 0; k < D; ++k) s += hr[k] * p.router_w[((size_t)l * D + k) * NE + e];
        p.logits[idx] = s + p.router_b[l * NE + e]; } break;
    case OP_ZEROCNT: p.cnt[idx] = 0; break;
    case OP_TOPK: { const long t = idx; float lg[NE];
#pragma unroll
        for (int e = 0; e < NE; ++e) lg[e] = p.logits[t * NE + e];
        int sel[4]; float sv[4];
#pragma unroll
        for (int kk = 0; kk < 4; ++kk) { float best = -3.0e38f; int bi = 0;
#pragma unroll
            for (int e = 0; e < NE; ++e) { bool taken = false;
#pragma unroll
                for (int q = 0; q < kk; ++q) taken = taken || (sel[q] == e);
                if (!taken && lg[e] > best) { best = lg[e]; bi = e; } }
            sel[kk] = bi; sv[kk] = best; }
        float es[4], sum = 0.f;
#pragma unroll
        for (int kk = 0; kk < 4; ++kk) { es[kk] = expf(sv[kk] - sv[0]); sum += es[kk]; }
#pragma unroll
        for (int kk = 0; kk < 4; ++kk) { p.topi[t * 4 + kk] = sel[kk]; p.topw[t * 4 + kk] = es[kk] / sum; const int pos = ATOMIC_INC(&p.cnt[sel[kk]]); p.list[(size_t)sel[kk] * M + pos] = (int)(t * 4 + kk); }
    } break;
    case OP_GATEUP: {
        const int j = (int)(idx % FF); const long rest = idx / FF; const int rb = (int)(rest % (M / 8)), e = (int)(rest / (M / 8)); const int cnt = p.cnt[e]; if (rb * 8 >= cnt) break;
        int a[8]; float g[8], u[8];
#pragma unroll
        for (int i = 0; i < 8; ++i) { a[i] = rb * 8 + i < cnt ? p.list[(size_t)e * M + rb * 8 + i] : -1; g[i] = 0.f; u[i] = 0.f; }
        const float* wgp = p.wg + ((size_t)l * NE + e) * D * FF + j; const float* wup = p.wu + ((size_t)l * NE + e) * D * FF + j;
        for (int k = 0; k < D; ++k) { const float gw = wgp[(size_t)k * FF], uw = wup[(size_t)k * FF];
#pragma unroll
            for (int i = 0; i < 8; ++i) { const float xv = p.h[(size_t)(a[i] < 0 ? 0 : a[i] / 4) * D + k]; g[i] += xv * gw; u[i] += xv * uw; } }
        const float bgv = p.bg[((size_t)l * NE + e) * FF + j], buv = p.bu[((size_t)l * NE + e) * FF + j];
#pragma unroll
        for (int i = 0; i < 8; ++i) if (a[i] >= 0) { float gv = g[i] + bgv; gv = gv < 7.0f ? gv : 7.0f; float uv = u[i] + buv; uv = uv < -7.0f ? -7.0f : (uv > 7.0f ? 7.0f : uv);
            p.act[(size_t)a[i] * FF + j] = gv * sigmf(1.702f * gv) * (uv + 1.0f); }
    } break;
    case OP_DOWN: {
        const int j = (int)(idx % D); const long rest = idx / D; const int rb = (int)(rest % (M / 8)), e = (int)(rest / (M / 8)); const int cnt = p.cnt[e]; if (rb * 8 >= cnt) break;
        int a[8]; float o[8];
#pragma unroll
        for (int i = 0; i < 8; ++i) { a[i] = rb * 8 + i < cnt ? p.list[(size_t)e * M + rb * 8 + i] : -1; o[i] = 0.f; }
        const float* wdp = p.wd + ((size_t)l * NE + e) * FF * D + j;
        for (int k = 0; k < FF; ++k) { const float w = wdp[(size_t)k * D];
#pragma unroll
            for (int i = 0; i < 8; ++i) o[i] += p.act[(size_t)(a[i] < 0 ? 0 : a[i]) * FF + k] * w; }
        const float bv = p.bd[((size_t)l * NE + e) * D + j];
#pragma unroll
        for (int i = 0; i < 8; ++i) if (a[i] >= 0) p.down[(size_t)a[i] * D + j] = o[i] + bv;
    } break;
    case OP_COMBINE: { const int r = (int)(idx / D), c = (int)(idx % D); float s = 0.f;
#pragma unroll
        for (int kk = 0; kk < 4; ++kk) s += p.topw[(size_t)r * 4 + kk] * p.down[((size_t)r * 4 + kk) * D + c];
        p.xres[idx] += modv(p, l, r, 5)[c] * s; } break;
    case OP_WRITE_OUT: p.out[idx] = p.xres[(size_t)CTX * D + idx]; break;
    }
}

static const int LAYER_OPS[] = { OP_ROWSTAT, OP_NORM1, OP_INPROJ, OP_LATNORM, OP_QRAW, OP_KVRAW, OP_QHEAD, OP_KHEAD, OP_ATTN, OP_CONV, OP_DT, OP_SSDSCAN, OP_SSDFIN, OP_POOLP, OP_POOLMM,
                                 OP_OUTPROJ, OP_RES1, OP_ROWSTAT, OP_NORM2, OP_LOGITS, OP_ZEROCNT, OP_TOPK, OP_GATEUP, OP_DOWN, OP_COMBINE };
constexpr int N_LAYER_OPS = sizeof(LAYER_OPS) / sizeof(int);
#endif

#define XB_TMO      128
#define XB_XCNT(j)  (256  + 64 * (j))
#define XB_XSUB(j)  (1280 + 64 * (j))
#define XB_XGEN(j)  (2304 + 64 * (j))
#define XB_TOP      3328
#define XB_TOPGEN   3392
#define XCD_BAR_WORDS 3456
#define XB_SPIN_CAP (1u << 22)
#define LAS __attribute__((address_space(3)))

__device__ __forceinline__ unsigned xb_ld(unsigned* p)              { return __hip_atomic_load(p, __ATOMIC_RELAXED, __HIP_MEMORY_SCOPE_AGENT); }
__device__ __forceinline__ unsigned xb_add(unsigned* p, unsigned v) { return __hip_atomic_fetch_add(p, v, __ATOMIC_RELAXED, __HIP_MEMORY_SCOPE_AGENT); }
__device__ __forceinline__ unsigned xb_xcc_id() { return (unsigned)__builtin_amdgcn_s_getreg((3 << 11) | 20) & 0xFu; }
#define XB_SPIN(cond, bar) do { unsigned _sp = 0; while (cond) { __builtin_amdgcn_s_sleep(1); \
    if ((++_sp & 255u) == 0u) { if (xb_ld(&(bar)[XB_TMO])) break; if (_sp > XB_SPIN_CAP) { atomicAdd(&(bar)[XB_TMO], 1u); break; } } } } while (0)

struct XcdBarrier {
    unsigned* bar; unsigned x;
    volatile LAS unsigned* st;
};

__device__ __forceinline__ XcdBarrier xcd_barrier_post(unsigned* bar, volatile LAS unsigned* st) {
    XcdBarrier b; b.bar = bar; b.x = xb_xcc_id(); b.st = st;
    if (threadIdx.x == 0) (void)xb_add(&bar[XB_XCNT(b.x)], 1u);
    return b;
}
__device__ __forceinline__ void xcd_barrier_complete(unsigned* bar, unsigned x, unsigned& nloc, unsigned& nx) {
    const unsigned G = gridDim.x * gridDim.y * gridDim.z;
    unsigned sum, cnt, mine, sp = 0u;
    for (;;) {
        sum = 0u; cnt = 0u; mine = 0u;
#pragma unroll
        for (unsigned j = 0; j < 16; ++j) { const unsigned c = xb_ld(&bar[XB_XCNT(j)]); sum += c; cnt += (c > 0u) ? 1u : 0u; mine = (j == x) ? c : mine; }
        if (sum == G) break;
        __builtin_amdgcn_s_sleep(1);
        if ((++sp & 255u) == 0u) { if (xb_ld(&bar[XB_TMO])) break; if (sp > XB_SPIN_CAP) { atomicAdd(&bar[XB_TMO], 1u); break; } }
    }
    nloc = mine > 0u ? mine : 1u; nx = cnt > 0u ? cnt : 1u;
}

__device__ __forceinline__ void xcd_barrier(const XcdBarrier& b) {
    asm volatile("s_waitcnt vmcnt(0)" ::: "memory");
    __syncthreads();
    if (threadIdx.x == 0) {
        unsigned* bar = b.bar;
        __builtin_amdgcn_s_waitcnt(0);
        unsigned nloc = b.st[0], nx = b.st[1];
        if (nloc == 0u) { xcd_barrier_complete(bar, b.x, nloc, nx); b.st[0] = nloc; b.st[1] = nx; }
        const unsigned old = xb_add(&bar[XB_XSUB(b.x)], 1u);
        const unsigned gen = old / nloc;
        if (old + 1u == (gen + 1u) * nloc) {
            __builtin_amdgcn_fence(__ATOMIC_RELEASE, "agent");
            asm volatile("s_waitcnt vmcnt(0)" ::: "memory");
            const unsigned og = xb_add(&bar[XB_TOP], 1u);
            const unsigned tg = og / nx;
            if (og + 1u == (tg + 1u) * nx) xb_add(&bar[XB_TOPGEN], 1u);
            else XB_SPIN(xb_ld(&bar[XB_TOPGEN]) == tg, bar);
            __builtin_amdgcn_fence(__ATOMIC_ACQUIRE, "agent");
            xb_add(&bar[XB_XGEN(b.x)], 1u);
            asm volatile("s_waitcnt vmcnt(0)" ::: "memory");
        } else {
            XB_SPIN(xb_ld(&bar[XB_XGEN(b.x)]) == gen, bar);
            __builtin_amdgcn_fence(__ATOMIC_ACQUIRE, "agent");
            asm volatile("s_waitcnt vmcnt(0)" ::: "memory");
        }
    }
    __syncthreads();
}


template <int OP> __device__ __forceinline__ void run_op(const P& p, int l) {
    const long n = op_count(OP); const long stride = (long)gridDim.x * blockDim.x;
    for (long i = (long)blockIdx.x * blockDim.x + threadIdx.x; i < n; i += stride) op_run(OP, p, l, i);
}
struct KArgs { P p; unsigned* bar; };
#define PH(OPX) do { run_op<OPX>(p, l); xcd_barrier(xb); } while (0)
__global__ void __launch_bounds__(512, 2) k_mega(KArgs a) {
    __shared__ uint4 xb_words;
    if (threadIdx.x == 0) xb_words = make_uint4(0u, 0u, 0u, 0u);
    __syncthreads();
    XcdBarrier xb = xcd_barrier_post(a.bar, (volatile LAS unsigned*)&xb_words);
    const P& p = a.p;
    { const int l = 0; run_op<OP_COPY_IN>(p, l); PH(OP_MODVEC); }
    for (int l = 0; l < DEPTH; ++l) {
        PH(OP_ROWSTAT); PH(OP_NORM1); PH(OP_INPROJ); PH(OP_LATNORM);
        run_op<OP_QRAW>(p, l); PH(OP_KVRAW);
        run_op<OP_QHEAD>(p, l); run_op<OP_KHEAD>(p, l); run_op<OP_CONV>(p, l); run_op<OP_DT>(p, l); PH(OP_POOLP);
        run_op<OP_ATTN>(p, l); run_op<OP_POOLMM>(p, l); PH(OP_SSDSCAN);
        PH(OP_SSDFIN); PH(OP_OUTPROJ); PH(OP_RES1); PH(OP_ROWSTAT); PH(OP_NORM2);
        run_op<OP_ZEROCNT>(p, l); PH(OP_LOGITS); PH(OP_TOPK); PH(OP_GATEUP); PH(OP_DOWN); PH(OP_COMBINE);
    }
    { const int l = 0; run_op<OP_WRITE_OUT>(p, l); }
}
static size_t carve(char*& cur, size_t bytes) { size_t a = (bytes + 255) & ~(size_t)255; cur += a; return a; }
static bool setup_params(P& p, unsigned*& bar, void* const* d_in, void* d_out, void* d_ws, size_t ws_size) {
    const float** pp = (const float**)&p; for (int i = 0; i < 32; ++i) pp[i] = (const float*)d_in[i];
    p.out = (float*)d_out;
    char* cur = (char*)d_ws; char* base = cur;
    bar = (unsigned*)cur; carve(cur, XCD_BAR_WORDS * sizeof(unsigned));
#define CARVE(field, type, count) p.field = (type*)cur; carve(cur, (size_t)(count) * sizeof(type));
    CARVE(xres, float, (size_t)M * D) CARVE(mod, float, (size_t)DEPTH * 12 * D) CARVE(rs, float, M) CARVE(h, float, (size_t)M * D) CARVE(proj, float, (size_t)M * INC) CARVE(qln, float, (size_t)M * QL)
    CARVE(kvln, float, (size_t)M * KVL) CARVE(qraw, float, (size_t)M * NH * QKD) CARVE(kvraw, float, (size_t)M * NH * 128) CARVE(q, float, (size_t)M * NH * QKD) CARVE(k, float, (size_t)M * NH * QKD)
    CARVE(v, float, (size_t)M * NH * VD) CARVE(mixin, float, (size_t)M * MIXW) CARVE(xbc, float, (size_t)M * CONVD) CARVE(dt, float, (size_t)M * 12) CARVE(ydir, float, (size_t)2 * M * SW)
    CARVE(poolp, float, (size_t)M * PW) CARVE(mix, float, (size_t)M * D) CARVE(logits, float, (size_t)M * NE) CARVE(topw, float, (size_t)M * 4) CARVE(act, float, (size_t)M * 4 * FF)
    CARVE(down, float, (size_t)M * 4 * D) CARVE(topi, int, (size_t)M * 4) CARVE(cnt, int, NE) CARVE(list, int, (size_t)NE * M)
#undef CARVE
    return (size_t)(cur - base) <= ws_size;
}
extern "C" void kernel_launch(void* const* d_in, const int* in_sizes, int n_in, void* d_out, int out_size, void* d_ws, size_t ws_size, hipStream_t stream) {
    KArgs a{};
    if (n_in < 32 || !setup_params(a.p, a.bar, d_in, d_out, d_ws, ws_size)) return;
    static int grid = 0;
    if (!grid) { int dev = 0, cus = 0, per_cu = 0; hipGetDevice(&dev); hipDeviceGetAttribute(&cus, hipDeviceAttributeMultiprocessorCount, dev);
        hipOccupancyMaxActiveBlocksPerMultiprocessor(&per_cu, k_mega, 512, 0); grid = cus * (per_cu < 1 ? per_cu : 1); }
    if (grid <= 0) return;
    hipMemsetAsync(a.bar, 0, XCD_BAR_WORDS * sizeof(unsigned), stream);
    hipLaunchKernelGGL(k_mega, dim3(grid), dim3(512), 0, stream, a);
}
```

```cpp
#include <hip/hip_runtime.h>
#include <stdint.h>
#define CHECK_ATTN 0

#ifndef NAIVE_H
#define NAIVE_H
#include <math.h>
#ifdef HOST_TEST
#define HD inline
#define HDC inline
#define ATOMIC_INC(p) ((*(p))++)
#define UNIFORM(x) (x)
#else
#define HD __device__ __forceinline__
#define HDC __host__ __device__ __forceinline__
#define ATOMIC_INC(p) atomicAdd((p), 1)
#define UNIFORM(x) __builtin_amdgcn_readfirstlane(x)
#endif

#ifndef CFG_D
#define CFG_D 1024
#define CFG_SEQ 16384
#define CFG_CTX 256
#define CFG_FF 1024
#define CFG_DEPTH 4
#endif
constexpr int D = CFG_D, SEQ = CFG_SEQ, CTX = CFG_CTX, FF = CFG_FF, DEPTH = CFG_DEPTH;
constexpr int M = CTX + SEQ;
constexpr int GRID_W = 64;
constexpr int NH = 6, QKD = 96, NOPE = 64, ROPE = 32, VD = 64, QL = 256, KVL = 128;
constexpr int SH = 6, SP = 64, SW = 384, SG = 2, SN = 64, CONVD = 640, CHUNK = 128;
constexpr int PW = 256, MIXW = 1024, INC = 1708;
constexpr int C_Q = 0, C_KV = 256, C_KR = 384, C_Z = 416, C_XBC = 800, C_DT = 1440, C_POOL = 1452;
constexpr int NE = 32, TOPK = 4;
constexpr float EPS = 1e-6f;

typedef unsigned short bf16_t;
HD bf16_t f2bf(float f) { union { float f; unsigned u; } v; v.f = f; unsigned u = v.u; u += 0x7FFFu + ((u >> 16) & 1u); return (bf16_t)(u >> 16); }
HD float bf2f(bf16_t b) { union { float f; unsigned u; } v; v.u = ((unsigned)b) << 16; return v.f; }
struct P {
    const float *x, *c, *ctx, *c_ctx, *norm1_g, *norm2_g, *mod_w, *mod_b, *w_in, *q_g, *kv_g, *w_uq, *w_ukv, *qn_g, *kn_g;
    const float *conv_w, *conv_b, *a_log, *dt_bias, *ssd_d, *ssd_norm_g, *pool_w, *pool_scale, *w_out, *router_w, *router_b;
    const float *wg, *bg, *wu, *bu, *wd, *bd;
    float* out;
    float *xres, *mod, *rs, *h, *proj, *qln, *kvln, *qraw, *kvraw, *q, *k, *v, *mixin, *xbc, *dt, *ydir, *poolp, *mix, *logits, *topw, *act, *down;
    int *topi, *cnt, *list;
    bf16_t *qb, *kb, *vb;
    float *attf, *diag;
};

HD float siluf(float x) { return x / (1.0f + expf(-x)); }
HD float sigmf(float x) { return 1.0f / (1.0f + expf(-x)); }
HD float softplusf(float x) { return x > 20.0f ? x : log1pf(expf(x)); }
HD const float* modv(const P& p, int l, int r, int j) { return p.mod + ((size_t)(l * 2 + (r < CTX ? 1 : 0)) * 6 + j) * D; }

enum { OP_COPY_IN = 0, OP_MODVEC, OP_ROWSTAT, OP_NORM1, OP_INPROJ, OP_LATNORM, OP_QRAW, OP_KVRAW, OP_QHEAD, OP_KHEAD, OP_ATTN, OP_CONV, OP_DT, OP_SSDSCAN, OP_SSDFIN,
       OP_POOLP, OP_POOLMM, OP_OUTPROJ, OP_RES1, OP_NORM2, OP_LOGITS, OP_ZEROCNT, OP_TOPK, OP_GATEUP, OP_DOWN, OP_COMBINE, OP_WRITE_OUT, OP_COUNT };

HDC long op_count(int op) {
    switch (op) {
        case OP_COPY_IN: return (long)M * D;
        case OP_MODVEC: return (long)DEPTH * 2 * 6 * D;
        case OP_ROWSTAT: return M;
        case OP_NORM1: case OP_NORM2: return (long)M * D;
        case OP_INPROJ: return (long)(M / 8) * INC;
        case OP_LATNORM: return 2L * M;
        case OP_QRAW: return (long)(M / 8) * (NH * QKD);
        case OP_KVRAW: return (long)(M / 8) * (NH * 128);
        case OP_QHEAD: case OP_KHEAD: return (long)M * NH;
        case OP_ATTN: return (long)M * NH;
        case OP_CONV: return (long)M * CONVD;
        case OP_DT: return (long)M * 12;
        case OP_SSDSCAN: return 2L * SH * SP;
        case OP_SSDFIN: return M;
        case OP_POOLP: return (long)M * PW;
        case OP_POOLMM: return (long)M * PW;
        case OP_OUTPROJ: return (long)(M / 8) * D;
        case OP_RES1: return (long)M * D;
        case OP_LOGITS: return (long)M * NE;
        case OP_ZEROCNT: return NE;
        case OP_TOPK: return M;
        case OP_GATEUP: return (long)NE * (M / 8) * FF;
        case OP_DOWN: return (long)NE * (M / 8) * D;
        case OP_COMBINE: return (long)M * D;
        case OP_WRITE_OUT: return (long)SEQ * D;
    }
    return 0;
}

HD void gemm8(const float* A, int lda, const float* B, int ldb, const float* bias, float* C, int ldc, int N, int K, long idx) {
    const int j = (int)(idx % N); const long r0 = (idx / N) * 8;
    float acc[8];
#pragma unroll
    for (int i = 0; i < 8; ++i) acc[i] = 0.f;
    const float* a = A + r0 * lda;
    for (int k = 0; k < K; ++k) {
        const float b = B[(size_t)k * ldb + j];
#pragma unroll
        for (int i = 0; i < 8; ++i) acc[i] += a[(size_t)i * lda + k] * b;
    }
    const float bv = bias ? bias[j] : 0.f;
#pragma unroll
    for (int i = 0; i < 8; ++i) C[(r0 + i) * ldc + j] = acc[i] + bv;
}

HD void sincos_rr(float angf, float& cs, float& sn) {
    const double x = (double)angf; const double n = rint(x * 0.63661977236758134308); const double y = (x - n * 1.57079632679489655800) - n * 6.123233995736766e-17; const double y2 = y * y;
    const double s = y * (1.0 + y2 * (-1.0 / 6 + y2 * (1.0 / 120 + y2 * (-1.0 / 5040 + y2 * (1.0 / 362880 + y2 * (-1.0 / 39916800))))));
    const double c = 1.0 + y2 * (-0.5 + y2 * (1.0 / 24 + y2 * (-1.0 / 720 + y2 * (1.0 / 40320 + y2 * (-1.0 / 3628800 + y2 * (1.0 / 479001600))))));
    const int q = ((int)n) & 3; const double cc = (q == 0) ? c : (q == 1) ? -s : (q == 2) ? -c : s; const double ss = (q == 0) ? s : (q == 1) ? c : (q == 2) ? -s : -c;
    cs = (float)cc; sn = (float)ss;
}
HD float rope_inv_freq(int f) { return f == 0 ? 1.0f : f == 1 ? 0.31622776f : f == 2 ? 0.1f : f == 3 ? 0.031622775f : f == 4 ? 0.01f : f == 5 ? 0.0031622776f : f == 6 ? 0.001f : 0.00031622776f; }
HD void rope_apply(float* v32, int t) {
    const float row = (float)(t / GRID_W), col = (float)(t % GRID_W);
#pragma unroll
    for (int a = 0; a < 2; ++a)
#pragma unroll
        for (int f = 0; f < 8; ++f) {
            const float ang = (a == 0 ? row : col) * rope_inv_freq(f);
            float cs, sn; sincos_rr(ang, cs, sn);
            const float x1 = v32[a * 16 + f], x2 = v32[a * 16 + 8 + f];
            v32[a * 16 + f] = x1 * cs - x2 * sn; v32[a * 16 + 8 + f] = x2 * cs + x1 * sn;
        }
}

HD void op_run(int op, const P& p, int l, long idx) {
    switch (op) {
    case OP_COPY_IN: { const long r = idx / D; const int c = (int)(idx % D); p.xres[idx] = r < CTX ? p.ctx[idx] : p.x[(r - CTX) * D + c]; } break;
    case OP_MODVEC: {
        const int j = (int)(idx % (6 * D)); const int which = (int)((idx / (6 * D)) % 2); const int ll = (int)(idx / (12 * D));
        const float* cv = which ? p.c_ctx : p.c; float s = 0.f;
        for (int k = 0; k < D; ++k) s += siluf(cv[k]) * p.mod_w[((size_t)ll * D + k) * (6 * D) + j];
        p.mod[idx] = s + p.mod_b[(size_t)ll * 6 * D + j];
    } break;
    case OP_ROWSTAT: { const float* xr = p.xres + idx * D; float s = 0.f; for (int k = 0; k < D; ++k) s += xr[k] * xr[k]; p.rs[idx] = 1.0f / sqrtf(s / D + EPS); } break;
    case OP_NORM1: case OP_NORM2: { const int r = (int)(idx / D), c = (int)(idx % D); const int o = op == OP_NORM1 ? 0 : 3;
        const float g = (op == OP_NORM1 ? p.norm1_g : p.norm2_g)[l * D + c];
        p.h[idx] = p.xres[idx] * p.rs[r] * g * (1.0f + modv(p, l, r, o + 1)[c]) + modv(p, l, r, o)[c]; } break;
    case OP_INPROJ: gemm8(p.h, D, p.w_in + (size_t)l * D * INC, INC, nullptr, p.proj, INC, INC, D, idx); break;
    case OP_LATNORM: {
        const int which = idx >= M; const long r = which ? idx - M : idx; const int n = which ? KVL : QL; const float* src = p.proj + r * INC + (which ? C_KV : C_Q);
        float s = 0.f; for (int k = 0; k < n; ++k) s += src[k] * src[k]; const float rs = 1.0f / sqrtf(s / n + EPS);
        float* dst = which ? p.kvln + r * KVL : p.qln + r * QL; const float* g = which ? p.kv_g + l * KVL : p.q_g + l * QL;
        for (int k = 0; k < n; ++k) dst[k] = src[k] * rs * g[k];
    } break;
    case OP_QRAW: gemm8(p.qln, QL, p.w_uq + (size_t)l * QL * (NH * QKD), NH * QKD, nullptr, p.qraw, NH * QKD, NH * QKD, QL, idx); break;
    case OP_KVRAW: gemm8(p.kvln, KVL, p.w_ukv + (size_t)l * KVL * (NH * 128), NH * 128, nullptr, p.kvraw, NH * 128, NH * 128, KVL, idx); break;
    case OP_QHEAD: { const int r = (int)(idx / NH), hh = (int)(idx % NH); const float* src = p.qraw + (size_t)r * (NH * QKD) + hh * QKD; float s = 0.f;
        for (int d = 0; d < QKD; ++d) s += src[d] * src[d]; const float rs = 1.0f / sqrtf(s / QKD + EPS);
        float* dst = p.q + ((size_t)r * NH + hh) * QKD; float rp[32];
        for (int d = 0; d < NOPE; ++d) dst[d] = src[d] * rs * p.qn_g[l * QKD + d];
#pragma unroll
        for (int d = 0; d < 32; ++d) rp[d] = src[NOPE + d] * rs * p.qn_g[l * QKD + NOPE + d];
        if (r >= CTX) rope_apply(rp, r - CTX);
#pragma unroll
        for (int d = 0; d < 32; ++d) dst[NOPE + d] = rp[d];
        bf16_t* db = p.qb + ((size_t)r * NH + hh) * QKD;
        for (int d = 0; d < QKD; ++d) db[d] = f2bf(dst[d]);
    } break;
    case OP_KHEAD: { const int r = (int)(idx / NH), hh = (int)(idx % NH); const float* kn = p.kvraw + (size_t)r * (NH * 128) + hh * 128; const float* kr = p.proj + (size_t)r * INC + C_KR; float s = 0.f;
        for (int d = 0; d < NOPE; ++d) s += kn[d] * kn[d];
        for (int d = 0; d < ROPE; ++d) s += kr[d] * kr[d];
        const float rs = 1.0f / sqrtf(s / QKD + EPS);
        float* dst = p.k + ((size_t)r * NH + hh) * QKD; float rp[32];
        for (int d = 0; d < NOPE; ++d) dst[d] = kn[d] * rs * p.kn_g[l * QKD + d];
#pragma unroll
        for (int d = 0; d < 32; ++d) rp[d] = kr[d] * rs * p.kn_g[l * QKD + NOPE + d];
        if (r >= CTX) rope_apply(rp, r - CTX);
#pragma unroll
        for (int d = 0; d < 32; ++d) dst[NOPE + d] = rp[d];
        float* vd = p.v + ((size_t)r * NH + hh) * VD;
        for (int d = 0; d < VD; ++d) vd[d] = kn[NOPE + d];
        bf16_t* db = p.kb + ((size_t)r * NH + hh) * QKD; bf16_t* vdb = p.vb + ((size_t)r * NH + hh) * VD;
        for (int d = 0; d < QKD; ++d) db[d] = f2bf(dst[d]);
        for (int d = 0; d < VD; ++d) vdb[d] = f2bf(kn[NOPE + d]);
    } break;
    case OP_ATTN: {
        const int r = (int)(idx % M), hh = UNIFORM((int)(idx / M)); const int nk = r < CTX ? CTX : M;
        float qv[QKD];
        const float* qp = p.q + ((size_t)r * NH + hh) * QKD; const float scale = 1.0f / sqrtf((float)QKD);
#pragma unroll
        for (int d = 0; d < QKD; ++d) qv[d] = qp[d] * scale;
        for (int half = 0; half < 2; ++half) {
            float o[32];
#pragma unroll
            for (int d = 0; d < 32; ++d) o[d] = 0.f;
            float mx = -1e30f, lsum = 0.f;
            for (int kk = 0; kk < nk; ++kk) {
                const float* kp = p.k + ((size_t)kk * NH + hh) * QKD; const float* vp = p.v + ((size_t)kk * NH + hh) * VD + half * 32; float s = 0.f;
#pragma unroll
                for (int d = 0; d < QKD; ++d) s += qv[d] * kp[d];
                const float mn = s > mx ? s : mx; const float corr = expf(mx - mn), pe = expf(s - mn);
                lsum = lsum * corr + pe; mx = mn;
#pragma unroll
                for (int d = 0; d < 32; ++d) o[d] = o[d] * corr + pe * vp[d];
            }
            const float inv = 1.0f / lsum; float* dst = p.mixin + (size_t)r * MIXW + hh * VD + half * 32;
#pragma unroll
            for (int d = 0; d < 32; ++d) dst[d] = o[d] * inv;
        }
    } break;
    case OP_CONV: { const int r = (int)(idx / CONVD), c = (int)(idx % CONVD); const int seg0 = r < CTX ? 0 : CTX, n = r < CTX ? CTX : SEQ, t = r - seg0; float y = p.conv_b[l * CONVD + c];
#pragma unroll
        for (int j = 0; j < 4; ++j) { const int tt = t - 2 + j; if (tt >= 0 && tt < n) y += p.conv_w[((size_t)l * 4 + j) * CONVD + c] * p.proj[(size_t)(seg0 + tt) * INC + C_XBC + c]; }
        p.xbc[idx] = siluf(y); } break;
    case OP_DT: { const int r = (int)(idx / 12), j = (int)(idx % 12); p.dt[idx] = softplusf(p.proj[(size_t)r * INC + C_DT + j] + p.dt_bias[l * 12 + j]); } break;
    case OP_SSDSCAN: {
        const int pp = (int)(idx % SP), hh = UNIFORM((int)((idx / SP) % SH)), dir = UNIFORM((int)(idx / (SP * SH))); const int g = hh / (SH / SG);
        const float a = -expf(p.a_log[l * 12 + dir * 6 + hh]); float st[SN];
#pragma unroll
        for (int n = 0; n < SN; ++n) st[n] = 0.f;
        for (int step = 0; step < M; ++step) {
            const int r = dir == 0 ? step : (step < CTX ? CTX - 1 - step : M - 1 - (step - CTX));
            const float dtv = p.dt[(size_t)r * 12 + dir * 6 + hh]; const float dA = expf(dtv * a); const float xv = p.xbc[(size_t)r * CONVD + hh * SP + pp] * dtv;
            const float* Bp = p.xbc + (size_t)r * CONVD + SW + g * SN; const float* Cp = p.xbc + (size_t)r * CONVD + SW + SG * SN + g * SN; float y = 0.f;
#pragma unroll
            for (int n = 0; n < SN; ++n) { st[n] = st[n] * dA + xv * Bp[n]; y += st[n] * Cp[n]; }
            p.ydir[((size_t)dir * M + r) * SW + hh * SP + pp] = y;
        }
    } break;
    case OP_SSDFIN: { const long r = idx; float ss = 0.f;
        for (int c = 0; c < SW; ++c) { const float y = p.ydir[r * SW + c] + p.ydir[((size_t)M + r) * SW + c] + p.ssd_d[l * SH + c / SP] * p.xbc[r * CONVD + c]; const float gv = y * siluf(p.proj[r * INC + C_Z + c]); ss += gv * gv; }
        const float rs = 1.0f / sqrtf(ss / SW + EPS);
        for (int c = 0; c < SW; ++c) { const float y = p.ydir[r * SW + c] + p.ydir[((size_t)M + r) * SW + c] + p.ssd_d[l * SH + c / SP] * p.xbc[r * CONVD + c]; const float gv = y * siluf(p.proj[r * INC + C_Z + c]);
            p.mixin[r * MIXW + NH * VD + c] = gv * rs * p.ssd_norm_g[l * SW + c]; }
    } break;
    case OP_POOLP: { const int r = (int)(idx / PW), c = (int)(idx % PW); const int gi = c / 64; const int win = 2 << gi; const int seg0 = r < CTX ? 0 : CTX, n = r < CTX ? CTX : SEQ, t = r - seg0;
        int lo = t - win / 2, hi = t - win / 2 + win; lo = lo < 0 ? 0 : lo; hi = hi > n ? n : hi; float s = 0.f;
        for (int tt = lo; tt < hi; ++tt) s += p.proj[(size_t)(seg0 + tt) * INC + C_POOL + c];
        p.poolp[idx] = s / (float)(hi - lo) - p.proj[(size_t)r * INC + C_POOL + c]; } break;
    case OP_POOLMM: { const int r = (int)(idx / PW), c = (int)(idx % PW); const int gi = c / 64, d = c % 64; float s = 0.f;
        for (int cc = 0; cc < 64; ++cc) s += p.poolp[(size_t)r * PW + gi * 64 + cc] * p.pool_w[(((size_t)l * 4 + gi) * 64 + cc) * 64 + d];
        p.mixin[(size_t)r * MIXW + NH * VD + SW + c] = s * p.pool_scale[l * PW + c]; } break;
    case OP_OUTPROJ: gemm8(p.mixin, MIXW, p.w_out + (size_t)l * MIXW * D, D, nullptr, p.mix, D, D, MIXW, idx); break;
    case OP_RES1: { const int r = (int)(idx / D), c = (int)(idx % D); p.xres[idx] += modv(p, l, r, 2)[c] * p.mix[idx]; } break;
    case OP_LOGITS: { const int r = (int)(idx / NE), e = (int)(idx % NE); const float* hr = p.h + (size_t)r * D; float s = 0.f;
        for (int k = 0; k < D; ++k) s += hr[k] * p.router_w[((size_t)l * D + k) * NE + e];
        p.logits[idx] = s + p.router_b[l * NE + e]; } break;
    case OP_ZEROCNT: p.cnt[idx] = 0; break;
    case OP_TOPK: { const long t = idx; float lg[NE];
#pragma unroll
        for (int e = 0; e < NE; ++e) lg[e] = p.logits[t * NE + e];
        int sel[4]; float sv[4];
#pragma unroll
        for (int kk = 0; kk < 4; ++kk) { float best = -3.0e38f; int bi = 0;
#pragma unroll
            for (int e = 0; e < NE; ++e) { bool taken = false;
#pragma unroll
                for (int q = 0; q < kk; ++q) taken = taken || (sel[q] == e);
                if (!taken && lg[e] > best) { best = lg[e]; bi = e; } }
            sel[kk] = bi; sv[kk] = best; }
        float es[4], sum = 0.f;
#pragma unroll
        for (int kk = 0; kk < 4; ++kk) { es[kk] = expf(sv[kk] - sv[0]); sum += es[kk]; }
#pragma unroll
        for (int kk = 0; kk < 4; ++kk) { p.topi[t * 4 + kk] = sel[kk]; p.topw[t * 4 + kk] = es[kk] / sum; const int pos = ATOMIC_INC(&p.cnt[sel[kk]]); p.list[(size_t)sel[kk] * M + pos] = (int)(t * 4 + kk); }
    } break;
    case OP_GATEUP: {
        const int j = (int)(idx % FF); const long rest = idx / FF; const int rb = (int)(rest % (M / 8)), e = (int)(rest / (M / 8)); const int cnt = p.cnt[e]; if (rb * 8 >= cnt) break;
        int a[8]; float g[8], u[8];
#pragma unroll
        for (int i = 0; i < 8; ++i) { a[i] = rb * 8 + i < cnt ? p.list[(size_t)e * M + rb * 8 + i] : -1; g[i] = 0.f; u[i] = 0.f; }
        const float* wgp = p.wg + ((size_t)l * NE + e) * D * FF + j; const float* wup = p.wu + ((size_t)l * NE + e) * D * FF + j;
        for (int k = 0; k < D; ++k) { const float gw = wgp[(size_t)k * FF], uw = wup[(size_t)k * FF];
#pragma unroll
            for (int i = 0; i < 8; ++i) { const float xv = p.h[(size_t)(a[i] < 0 ? 0 : a[i] / 4) * D + k]; g[i] += xv * gw; u[i] += xv * uw; } }
        const float bgv = p.bg[((size_t)l * NE + e) * FF + j], buv = p.bu[((size_t)l * NE + e) * FF + j];
#pragma unroll
        for (int i = 0; i < 8; ++i) if (a[i] >= 0) { float gv = g[i] + bgv; gv = gv < 7.0f ? gv : 7.0f; float uv = u[i] + buv; uv = uv < -7.0f ? -7.0f : (uv > 7.0f ? 7.0f : uv);
            p.act[(size_t)a[i] * FF + j] = gv * sigmf(1.702f * gv) * (uv + 1.0f); }
    } break;
    case OP_DOWN: {
        const int j = (int)(idx % D); const long rest = idx / D; const int rb = (int)(rest % (M / 8)), e = (int)(rest / (M / 8)); const int cnt = p.cnt[e]; if (rb * 8 >= cnt) break;
        int a[8]; float o[8];
#pragma unroll
        for (int i = 0; i < 8; ++i) { a[i] = rb * 8 + i < cnt ? p.list[(size_t)e * M + rb * 8 + i] : -1; o[i] = 0.f; }
        const float* wdp = p.wd + ((size_t)l * NE + e) * FF * D + j;
        for (int k = 0; k < FF; ++k) { const float w = wdp[(size_t)k * D];
#pragma unroll
            for (int i = 0; i < 8; ++i) o[i] += p.act[(size_t)(a[i] < 0 ? 0 : a[i]) * FF + k] * w; }
        const float bv = p.bd[((size_t)l * NE + e) * D + j];
#pragma unroll
        for (int i = 0; i < 8; ++i) if (a[i] >= 0) p.down[(size_t)a[i] * D + j] = o[i] + bv;
    } break;
    case OP_COMBINE: { const int r = (int)(idx / D), c = (int)(idx % D); float s = 0.f;
#pragma unroll
        for (int kk = 0; kk < 4; ++kk) s += p.topw[(size_t)r * 4 + kk] * p.down[((size_t)r * 4 + kk) * D + c];
        p.xres[idx] += modv(p, l, r, 5)[c] * s; } break;
    case OP_WRITE_OUT: p.out[idx] = p.xres[(size_t)CTX * D + idx]; break;
    }
}

static const int LAYER_OPS[] = { OP_ROWSTAT, OP_NORM1, OP_INPROJ, OP_LATNORM, OP_QRAW, OP_KVRAW, OP_QHEAD, OP_KHEAD, OP_ATTN, OP_CONV, OP_DT, OP_SSDSCAN, OP_SSDFIN, OP_POOLP, OP_POOLMM,
                                 OP_OUTPROJ, OP_RES1, OP_ROWSTAT, OP_NORM2, OP_LOGITS, OP_ZEROCNT, OP_TOPK, OP_GATEUP, OP_DOWN, OP_COMBINE };
constexpr int N_LAYER_OPS = sizeof(LAYER_OPS) / sizeof(int);
#endif

#define XB_TMO      128
#define XB_XCNT(j)  (256  + 64 * (j))
#define XB_XSUB(j)  (1280 + 64 * (j))
#define XB_XGEN(j)  (2304 + 64 * (j))
#define XB_TOP      3328
#define XB_TOPGEN   3392
#define XCD_BAR_WORDS 3456
#define XB_SPIN_CAP (1u << 22)
#define LAS __attribute__((address_space(3)))

__device__ __forceinline__ unsigned xb_ld(unsigned* p)              { return __hip_atomic_load(p, __ATOMIC_RELAXED, __HIP_MEMORY_SCOPE_AGENT); }
__device__ __forceinline__ unsigned xb_add(unsigned* p, unsigned v) { return __hip_atomic_fetch_add(p, v, __ATOMIC_RELAXED, __HIP_MEMORY_SCOPE_AGENT); }
__device__ __forceinline__ unsigned xb_xcc_id() { return (unsigned)__builtin_amdgcn_s_getreg((3 << 11) | 20) & 0xFu; }
#define XB_SPIN(cond, bar) do { unsigned _sp = 0; while (cond) { __builtin_amdgcn_s_sleep(1); \
    if ((++_sp & 255u) == 0u) { if (xb_ld(&(bar)[XB_TMO])) break; if (_sp > XB_SPIN_CAP) { atomicAdd(&(bar)[XB_TMO], 1u); break; } } } } while (0)

struct XcdBarrier {
    unsigned* bar; unsigned x;
    volatile LAS unsigned* st;
};

__device__ __forceinline__ XcdBarrier xcd_barrier_post(unsigned* bar, volatile LAS unsigned* st) {
    XcdBarrier b; b.bar = bar; b.x = xb_xcc_id(); b.st = st;
    if (threadIdx.x == 0) (void)xb_add(&bar[XB_XCNT(b.x)], 1u);
    return b;
}
__device__ __forceinline__ void xcd_barrier_complete(unsigned* bar, unsigned x, unsigned& nloc, unsigned& nx) {
    const unsigned G = gridDim.x * gridDim.y * gridDim.z;
    unsigned sum, cnt, mine, sp = 0u;
    for (;;) {
        sum = 0u; cnt = 0u; mine = 0u;
#pragma unroll
        for (unsigned j = 0; j < 16; ++j) { const unsigned c = xb_ld(&bar[XB_XCNT(j)]); sum += c; cnt += (c > 0u) ? 1u : 0u; mine = (j == x) ? c : mine; }
        if (sum == G) break;
        __builtin_amdgcn_s_sleep(1);
        if ((++sp & 255u) == 0u) { if (xb_ld(&bar[XB_TMO])) break; if (sp > XB_SPIN_CAP) { atomicAdd(&bar[XB_TMO], 1u); break; } }
    }
    nloc = mine > 0u ? mine : 1u; nx = cnt > 0u ? cnt : 1u;
}

__device__ __forceinline__ void xcd_barrier(const XcdBarrier& b) {
    asm volatile("s_waitcnt vmcnt(0)" ::: "memory");
    __syncthreads();
    if (threadIdx.x == 0) {
        unsigned* bar = b.bar;
        __builtin_amdgcn_s_waitcnt(0);
        unsigned nloc = b.st[0], nx = b.st[1];
        if (nloc == 0u) { xcd_barrier_complete(bar, b.x, nloc, nx); b.st[0] = nloc; b.st[1] = nx; }
        const unsigned old = xb_add(&bar[XB_XSUB(b.x)], 1u);
        const unsigned gen = old / nloc;
        if (old + 1u == (gen + 1u) * nloc) {
            __builtin_amdgcn_fence(__ATOMIC_RELEASE, "agent");
            asm volatile("s_waitcnt vmcnt(0)" ::: "memory");
            const unsigned og = xb_add(&bar[XB_TOP], 1u);
            const unsigned tg = og / nx;
            if (og + 1u == (tg + 1u) * nx) xb_add(&bar[XB_TOPGEN], 1u);
            else XB_SPIN(xb_ld(&bar[XB_TOPGEN]) == tg, bar);
            __builtin_amdgcn_fence(__ATOMIC_ACQUIRE, "agent");
            xb_add(&bar[XB_XGEN(b.x)], 1u);
            asm volatile("s_waitcnt vmcnt(0)" ::: "memory");
        } else {
            XB_SPIN(xb_ld(&bar[XB_XGEN(b.x)]) == gen, bar);
            __builtin_amdgcn_fence(__ATOMIC_ACQUIRE, "agent");
            asm volatile("s_waitcnt vmcnt(0)" ::: "memory");
        }
    }
    __syncthreads();
}


namespace at {
typedef unsigned short bf16_t;
using bf16x8 = __attribute__((ext_vector_type(8))) short;
using s16x4  = __attribute__((ext_vector_type(4))) short;
using f32x16 = __attribute__((ext_vector_type(16))) float;
using u32x4  = __attribute__((ext_vector_type(4))) unsigned;
constexpr int DQ = 96, DV = 64, NW = 8, QBLK = 32, KVBLK = 64;
constexpr int LDQ = 6 * DQ, LDK = 6 * DQ, LDV = 6 * DV;
constexpr float SCALE = 0.10206207261596575f;
constexpr float THR = 8.f;
constexpr int KROW = 208;
constexpr int SHM_K = KVBLK * KROW, SHM_V = KVBLK * DV * 2;
constexpr int SHM_ATTN = 2 * SHM_V + 2 * SHM_K + NW * 64 * 4;
#define AT_SBAR() __builtin_amdgcn_sched_barrier(0)
__device__ __forceinline__ int crow(int r, int hi) { return (r & 3) + 8 * (r >> 2) + 4 * hi; }
__device__ __forceinline__ unsigned cvtpk(float lo, float hi) { unsigned r; asm volatile("v_cvt_pk_bf16_f32 %0, %1, %2" : "=v"(r) : "v"(lo), "v"(hi)); return r; }

__device__ __forceinline__ void partialSM(f32x16& p0, f32x16& p1, float& m_reg, float& mn, float& alpha) {
  constexpr float C = SCALE * 1.4426950408889634f;
  float pmax = p0[0];
#pragma unroll
  for (int r = 1; r < 16; ++r) pmax = fmaxf(pmax, p0[r]);
#pragma unroll
  for (int r = 0; r < 16; ++r) pmax = fmaxf(pmax, p1[r]);
  { auto rr = __builtin_amdgcn_permlane32_swap(__float_as_uint(pmax), __float_as_uint(pmax), false, false);
    pmax = fmaxf(__uint_as_float(rr[0]), __uint_as_float(rr[1])); }
  if (__builtin_expect(__all(pmax - m_reg <= THR / SCALE), 1)) { mn = m_reg; alpha = 1.f; }
  else { mn = fmaxf(m_reg, pmax); alpha = __builtin_amdgcn_exp2f((m_reg - mn) * C); m_reg = mn; }
  float mnC = -mn * C;
#pragma unroll
  for (int r = 0; r < 16; ++r) p0[r] = fmaf(p0[r], C, mnC);
#pragma unroll
  for (int r = 0; r < 16; ++r) p1[r] = fmaf(p1[r], C, mnC);
#pragma unroll
  for (int r = 0; r < 16; ++r) p0[r] = __builtin_amdgcn_exp2f(p0[r]);
}
__device__ __forceinline__ void finishSM(f32x16& p0, f32x16& p1, float alpha, float& l_reg, bf16x8& pa0, bf16x8& pa1, bf16x8& pa2, bf16x8& pa3) {
#pragma unroll
  for (int r = 0; r < 16; ++r) p1[r] = __builtin_amdgcn_exp2f(p1[r]);
  float ps = 0;
#pragma unroll
  for (int r = 0; r < 16; ++r) ps += p0[r];
#pragma unroll
  for (int r = 0; r < 16; ++r) ps += p1[r];
  { auto rr = __builtin_amdgcn_permlane32_swap(__float_as_uint(ps), __float_as_uint(ps), false, false);
    ps = __uint_as_float(rr[0]) + __uint_as_float(rr[1]); }
  l_reg = l_reg * alpha + ps;
#define AT_PK4(P, BASE, OUT) do { unsigned a0 = cvtpk(P[BASE + 0], P[BASE + 1]), a1 = cvtpk(P[BASE + 2], P[BASE + 3]);   \
    unsigned b0 = cvtpk(P[BASE + 4], P[BASE + 5]), b1 = cvtpk(P[BASE + 6], P[BASE + 7]);                              \
    auto r0 = __builtin_amdgcn_permlane32_swap(a0, b0, false, false); auto r1 = __builtin_amdgcn_permlane32_swap(a1, b1, false, false); \
    u32x4 w = {r0[0], r1[0], r0[1], r1[1]}; OUT = *reinterpret_cast<bf16x8*>(&w); } while (0)
  AT_PK4(p0, 0, pa0); AT_PK4(p0, 8, pa1); AT_PK4(p1, 0, pa2); AT_PK4(p1, 8, pa3);
#undef AT_PK4
}
__device__ __forceinline__ void qkt(f32x16& p0, f32x16& p1, const char* Ks, const bf16x8* qr, int r32, int hi) {
  p0 = f32x16{}; p1 = f32x16{};
#pragma unroll
  for (int d0 = 0; d0 < 6; ++d0) { const int cb = (d0 * 16 + hi * 8) * 2;
    bf16x8 b0 = *reinterpret_cast<const bf16x8*>(Ks + r32 * KROW + cb);
    bf16x8 b1 = *reinterpret_cast<const bf16x8*>(Ks + (32 + r32) * KROW + cb);
    p0 = __builtin_amdgcn_mfma_f32_32x32x16_bf16(b0, qr[d0], p0, 0, 0, 0);
    p1 = __builtin_amdgcn_mfma_f32_32x32x16_bf16(b1, qr[d0], p1, 0, 0, 0); }
}
__device__ __forceinline__ int v_st(int k, int c) { const int kk = (k & ~0xC) | ((k & 4) << 1) | ((k & 8) >> 1); return ((kk >> 3) * 2 + (c >> 5)) * 512 + ((kk & 7) * 32 + (c & 31)) * 2; }
__device__ __forceinline__ int v_rd_base(int lane) { return ((lane & 3) << 3) | (((lane >> 2) & 3) << 6) | (((lane >> 4) & 1) << 5) | (((lane >> 5) & 1) << 8); }
constexpr int v_rd_off(int d0, int ks, int half) { return d0 * 512 + ks * 2048 + half * 1024; }
template <int OFF> __device__ __forceinline__ s16x4 tr_read(int vb) {
  s16x4 r; asm volatile("ds_read_b64_tr_b16 %0, %1 offset:%2" : "=&v"(r) : "v"(vb), "i"(OFF) : "memory"); return r;
}
template <int D0> __device__ __forceinline__ void pv_one(f32x16& od, int vb, bf16x8 pa0, bf16x8 pa1, bf16x8 pa2, bf16x8 pa3) {
  const s16x4 l0 = tr_read<v_rd_off(D0, 0, 0)>(vb), h0 = tr_read<v_rd_off(D0, 0, 1)>(vb), l1 = tr_read<v_rd_off(D0, 1, 0)>(vb), h1 = tr_read<v_rd_off(D0, 1, 1)>(vb);
  const s16x4 l2 = tr_read<v_rd_off(D0, 2, 0)>(vb), h2 = tr_read<v_rd_off(D0, 2, 1)>(vb), l3 = tr_read<v_rd_off(D0, 3, 0)>(vb), h3 = tr_read<v_rd_off(D0, 3, 1)>(vb);
  asm volatile("s_waitcnt lgkmcnt(0)" ::: "memory"); AT_SBAR();
#define AT_PK(L, H) (bf16x8){L[0], L[1], L[2], L[3], H[0], H[1], H[2], H[3]}
  od = __builtin_amdgcn_mfma_f32_32x32x16_bf16(pa0, AT_PK(l0, h0), od, 0, 0, 0);
  od = __builtin_amdgcn_mfma_f32_32x32x16_bf16(pa1, AT_PK(l1, h1), od, 0, 0, 0);
  od = __builtin_amdgcn_mfma_f32_32x32x16_bf16(pa2, AT_PK(l2, h2), od, 0, 0, 0);
  od = __builtin_amdgcn_mfma_f32_32x32x16_bf16(pa3, AT_PK(l3, h3), od, 0, 0, 0);
#undef AT_PK
}
__device__ __forceinline__ void pv_d0(f32x16* o, int vb, bf16x8 pa0, bf16x8 pa1, bf16x8 pa2, bf16x8 pa3) {
  pv_one<0>(o[0], vb, pa0, pa1, pa2, pa3); pv_one<1>(o[1], vb, pa0, pa1, pa2, pa3);
}
__device__ __forceinline__ void attn_body(const bf16_t* __restrict__ Qb, const bf16_t* __restrict__ Kh, const bf16_t* __restrict__ Vh, float* __restrict__ Ob, int ldo, int seq, char* lds) {
  const int tid = threadIdx.x, wid = tid >> 6, lane = tid & 63, r32 = lane & 31, hi = lane >> 5;
  char* V_lds = lds; char* K_lds = lds + 2 * SHM_V;
  float* ws = (float*)(lds + 2 * SHM_V + 2 * SHM_K) + wid * 64; float* li_l = ws; float* al_l = ws + 32;
  float m_reg = -1e30f, l_reg = 0; f32x16 o[2] = {}; bf16x8 qr[6];
  const bf16_t* Qw = Qb + (long)(wid * QBLK + r32) * LDQ + hi * 8;
#pragma unroll
  for (int d0 = 0; d0 < 6; ++d0) qr[d0] = *reinterpret_cast<const bf16x8*>(Qw + d0 * 16);
  const int kr0 = tid / 12, kc0 = tid % 12, c1 = 512 + (tid & 255), kr1 = c1 / 12, kc1 = c1 % 12, vr = tid >> 3, vc = (tid & 7) * 8;
  const bool k1on = tid < 256;
  const int kst0 = kr0 * KROW + kc0 * 16, kst1 = kr1 * KROW + kc1 * 16, vst = v_st(vr, vc);
  const long kg0 = (long)kr0 * LDK + kc0 * 8, kg1 = (long)kr1 * LDK + kc1 * 8, vg = (long)vr * LDV + vc;
  const int vb0 = (int)(uintptr_t)V_lds + v_rd_base(lane);
  struct { bf16x8 vs, ks0, ks1; } sr_[2];
#define AT_SLOAD(i, k0) do { sr_[i].vs = *reinterpret_cast<const bf16x8*>(Vh + (long)(k0) * LDV + vg); \
    sr_[i].ks0 = *reinterpret_cast<const bf16x8*>(Kh + (long)(k0) * LDK + kg0); sr_[i].ks1 = *reinterpret_cast<const bf16x8*>(Kh + (long)(k0) * LDK + kg1); } while (0)
#define AT_SWRITE(b, i) do { *(bf16x8*)(V_lds + (b) * SHM_V + vst) = sr_[i].vs; *(bf16x8*)(K_lds + (b) * SHM_K + kst0) = sr_[i].ks0; \
    if (k1on) *(bf16x8*)(K_lds + (b) * SHM_K + kst1) = sr_[i].ks1; } while (0)
#define AT_SWAIT() asm volatile("s_waitcnt vmcnt(3)" ::: "memory")
#define AT_RESC(a) do { if (__any((a) < 1.f)) { if (hi == 0) al_l[r32] = (a); asm volatile("s_waitcnt lgkmcnt(0)" ::: "memory"); \
    _Pragma("unroll") for (int d = 0; d < 2; ++d) _Pragma("unroll") for (int r = 0; r < 16; ++r) o[d][r] *= al_l[crow(r, hi)]; } } while (0)
  f32x16 pA0, pA1, pB0, pB1; float mnA, mnB, alA, alB; bf16x8 pa0, pa1, pa2, pa3; const int NT = seq / KVBLK;
  constexpr int SE = 0, SO = 1;
  AT_SLOAD(SE, 0); asm volatile("s_waitcnt vmcnt(0)" ::: "memory"); AT_SWRITE(0, SE); __syncthreads();
  qkt(pA0, pA1, K_lds, qr, r32, hi); partialSM(pA0, pA1, m_reg, mnA, alA);
  AT_SLOAD(SO, KVBLK); if (2 < NT) AT_SLOAD(SE, 2 * KVBLK);
  AT_SWAIT(); AT_SWRITE(1, SO); __syncthreads();
  for (int j = 1; j + 1 < NT; j += 2) {
    AT_SBAR(); qkt(pB0, pB1, K_lds + SHM_K, qr, r32, hi);
    finishSM(pA0, pA1, alA, l_reg, pa0, pa1, pa2, pa3); AT_SBAR();
    AT_SLOAD(SO, (j + 2) * KVBLK); AT_SBAR();
    pv_d0(o, vb0, pa0, pa1, pa2, pa3); partialSM(pB0, pB1, m_reg, mnB, alB);
    __syncthreads(); AT_SWAIT(); AT_SWRITE(0, SE);
    AT_RESC(alB); __syncthreads();
    AT_SBAR(); qkt(pA0, pA1, K_lds, qr, r32, hi);
    finishSM(pB0, pB1, alB, l_reg, pa0, pa1, pa2, pa3); AT_SBAR();
    if (j + 3 < NT) AT_SLOAD(SE, (j + 3) * KVBLK); AT_SBAR();
    pv_d0(o, vb0 + SHM_V, pa0, pa1, pa2, pa3); partialSM(pA0, pA1, m_reg, mnA, alA);
    __syncthreads(); AT_SWAIT(); AT_SWRITE(1, SO);
    AT_RESC(alA); __syncthreads();
  }
  AT_SBAR(); qkt(pB0, pB1, K_lds + SHM_K, qr, r32, hi);
  finishSM(pA0, pA1, alA, l_reg, pa0, pa1, pa2, pa3); AT_SBAR();
  pv_d0(o, vb0, pa0, pa1, pa2, pa3); partialSM(pB0, pB1, m_reg, mnB, alB);
  __syncthreads(); AT_RESC(alB);
  finishSM(pB0, pB1, alB, l_reg, pa0, pa1, pa2, pa3); AT_SBAR();
  pv_d0(o, vb0 + SHM_V, pa0, pa1, pa2, pa3);
  if (hi == 0) li_l[r32] = l_reg; asm volatile("s_waitcnt lgkmcnt(0)" ::: "memory");
  float rli[16];
#pragma unroll
  for (int r = 0; r < 16; ++r) rli[r] = __builtin_amdgcn_rcpf(li_l[crow(r, hi)]);
  float* Ow = Ob + (long)(wid * QBLK) * ldo;
#pragma unroll
  for (int r = 0; r < 16; ++r) { const int orow = crow(r, hi);
#pragma unroll
    for (int d0 = 0; d0 < 2; ++d0) Ow[(long)orow * ldo + d0 * 32 + r32] = o[d0][r] * rli[r]; }
#undef AT_SLOAD
#undef AT_SWRITE
#undef AT_SWAIT
#undef AT_RESC
}
}

#ifndef CHECK_ATTN
#define CHECK_ATTN 0
#endif
template <int OP> __device__ __forceinline__ void run_op(const P& p, int l) {
    const long n = op_count(OP); const long stride = (long)gridDim.x * blockDim.x;
    int i0 = blockIdx.x * blockDim.x + threadIdx.x; asm volatile("" : "+v"(i0));
    for (long i = i0; i < n; i += stride) op_run(OP, p, l, i);
}
struct KArgs { P p; unsigned* bar; };
constexpr int LDS_BYTES = 65536;
#define PH(OPX) do { run_op<OPX>(p, l); xcd_barrier(xb); } while (0)

__device__ __forceinline__ void attn_phase(const P& p, float* O, int ldo, char* lds) {
    constexpr int NQT = M / 256, NU = NH * NQT;
    for (int u = blockIdx.x; u < NU; u += gridDim.x) {
        const int hh = u / NQT, qt = u % NQT; const int seq = qt == 0 ? CTX : M;
        __syncthreads();
        at::attn_body(p.qb + (size_t)qt * 256 * at::LDQ + hh * at::DQ, p.kb + hh * at::DQ, p.vb + hh * at::DV, O + (size_t)qt * 256 * ldo + hh * at::DV, ldo, seq, lds);
    }
    __syncthreads();
}
__device__ __forceinline__ void chk_accum(const float* a, int lda, const float* b, int ldb, int ncols, float* diag) {
    float sd = 0.f, sr = 0.f; const long n = (long)M * ncols; const long stride = (long)gridDim.x * blockDim.x;
    for (long i = (long)blockIdx.x * blockDim.x + threadIdx.x; i < n; i += stride) { const long r = i / ncols; const int c = (int)(i % ncols);
        const float x = a[r * lda + c], y = b[r * ldb + c]; sd += (x - y) * (x - y); sr += y * y; }
    for (int o = 32; o >= 1; o >>= 1) { sd += __shfl_xor(sd, o); sr += __shfl_xor(sr, o); }
    if ((threadIdx.x & 63) == 0) { atomicAdd(diag, sd); atomicAdd(diag + 1, sr); }
}
__global__ void __launch_bounds__(512, 2) k_mega(KArgs a) {
    extern __shared__ __attribute__((aligned(16))) char lds[];
    uint4* xbw = (uint4*)(lds + LDS_BYTES - 16);
    if (threadIdx.x == 0) *xbw = make_uint4(0u, 0u, 0u, 0u);
    __syncthreads();
    XcdBarrier xb = xcd_barrier_post(a.bar, (volatile LAS unsigned*)xbw);
    const P& p = a.p;
    { const int l = 0; run_op<OP_COPY_IN>(p, l); if (blockIdx.x == 0 && threadIdx.x < 4) p.diag[threadIdx.x] = 0.f; PH(OP_MODVEC); }
    for (int l = 0; l < DEPTH; ++l) {
        PH(OP_ROWSTAT); PH(OP_NORM1); PH(OP_INPROJ); PH(OP_LATNORM);
        run_op<OP_QRAW>(p, l); PH(OP_KVRAW);
        run_op<OP_QHEAD>(p, l); run_op<OP_KHEAD>(p, l); run_op<OP_CONV>(p, l); run_op<OP_DT>(p, l); PH(OP_POOLP);
#if CHECK_ATTN
        attn_phase(p, p.attf, NH * VD, lds); run_op<OP_ATTN>(p, l);
#else
        attn_phase(p, p.mixin, MIXW, lds);
#endif
        run_op<OP_POOLMM>(p, l); PH(OP_SSDSCAN);
#if CHECK_ATTN
        chk_accum(p.attf, NH * VD, p.mixin, MIXW, NH * VD, p.diag);
#endif
        PH(OP_SSDFIN); PH(OP_OUTPROJ); PH(OP_RES1); PH(OP_ROWSTAT); PH(OP_NORM2);
        run_op<OP_ZEROCNT>(p, l); PH(OP_LOGITS); PH(OP_TOPK); PH(OP_GATEUP); PH(OP_DOWN); PH(OP_COMBINE);
    }
    {
        float sc = 1.0f;
#if CHECK_ATTN
        sc = 1.0f + 10.0f * sqrtf(p.diag[0] / p.diag[1]);
#endif
        const long n = (long)SEQ * D; const long stride = (long)gridDim.x * blockDim.x;
        for (long i = (long)blockIdx.x * blockDim.x + threadIdx.x; i < n; i += stride) p.out[i] = p.xres[(size_t)CTX * D + i] * sc;
    }
}
static size_t carve(char*& cur, size_t bytes) { size_t a = (bytes + 255) & ~(size_t)255; cur += a; return a; }
static bool setup_params(P& p, unsigned*& bar, void* const* d_in, void* d_out, void* d_ws, size_t ws_size) {
    const float** pp = (const float**)&p; for (int i = 0; i < 32; ++i) pp[i] = (const float*)d_in[i];
    p.out = (float*)d_out;
    char* cur = (char*)d_ws; char* base = cur;
    bar = (unsigned*)cur; carve(cur, XCD_BAR_WORDS * sizeof(unsigned));
#define CARVE(field, type, count) p.field = (type*)cur; carve(cur, (size_t)(count) * sizeof(type));
    CARVE(xres, float, (size_t)M * D) CARVE(mod, float, (size_t)DEPTH * 12 * D) CARVE(rs, float, M) CARVE(h, float, (size_t)M * D) CARVE(proj, float, (size_t)M * INC) CARVE(qln, float, (size_t)M * QL)
    CARVE(kvln, float, (size_t)M * KVL) CARVE(qraw, float, (size_t)M * NH * QKD) CARVE(kvraw, float, (size_t)M * NH * 128) CARVE(q, float, (size_t)M * NH * QKD) CARVE(k, float, (size_t)M * NH * QKD)
    CARVE(v, float, (size_t)M * NH * VD) CARVE(mixin, float, (size_t)M * MIXW) CARVE(xbc, float, (size_t)M * CONVD) CARVE(dt, float, (size_t)M * 12) CARVE(ydir, float, (size_t)2 * M * SW)
    CARVE(poolp, float, (size_t)M * PW) CARVE(mix, float, (size_t)M * D) CARVE(logits, float, (size_t)M * NE) CARVE(topw, float, (size_t)M * 4) CARVE(act, float, (size_t)M * 4 * FF)
    CARVE(down, float, (size_t)M * 4 * D) CARVE(topi, int, (size_t)M * 4) CARVE(cnt, int, NE) CARVE(list, int, (size_t)NE * M)
    CARVE(qb, bf16_t, (size_t)M * NH * QKD) CARVE(kb, bf16_t, (size_t)M * NH * QKD) CARVE(vb, bf16_t, (size_t)M * NH * VD) CARVE(attf, float, (size_t)M * NH * VD) CARVE(diag, float, 64)
#undef CARVE
    return (size_t)(cur - base) <= ws_size;
}
extern "C" void kernel_launch(void* const* d_in, const int* in_sizes, int n_in, void* d_out, int out_size, void* d_ws, size_t ws_size, hipStream_t stream) {
    KArgs a{};
    if (n_in < 32 || !setup_params(a.p, a.bar, d_in, d_out, d_ws, ws_size)) return;
    static int grid = 0;
    if (!grid) { int dev = 0, cus = 0, per_cu = 0; (void)hipGetDevice(&dev); (void)hipDeviceGetAttribute(&cus, hipDeviceAttributeMultiprocessorCount, dev);
        (void)hipFuncSetAttribute((const void*)k_mega, hipFuncAttributeMaxDynamicSharedMemorySize, LDS_BYTES);
        (void)hipOccupancyMaxActiveBlocksPerMultiprocessor(&per_cu, k_mega, 512, LDS_BYTES); grid = cus * (per_cu < 1 ? per_cu : 1); }
    if (grid <= 0) return;
    (void)hipMemsetAsync(a.bar, 0, XCD_BAR_WORDS * sizeof(unsigned), stream);
    hipLaunchKernelGGL(k_mega, dim3(grid), dim3(512), LDS_BYTES, stream, a);
}
```

```cpp
#include <hip/hip_runtime.h>
#include <stdint.h>
#define CHECK_GEMM 0

#ifndef NAIVE_H
#define NAIVE_H
#include <math.h>
#ifdef HOST_TEST
#define HD inline
#define HDC inline
#define ATOMIC_INC(p) ((*(p))++)
#define UNIFORM(x) (x)
#else
#define HD __device__ __forceinline__
#define HDC __host__ __device__ __forceinline__
#define ATOMIC_INC(p) atomicAdd((p), 1)
#define UNIFORM(x) __builtin_amdgcn_readfirstlane(x)
#endif

#ifndef CFG_D
#define CFG_D 1024
#define CFG_SEQ 16384
#define CFG_CTX 256
#define CFG_FF 1024
#define CFG_DEPTH 4
#endif
constexpr int D = CFG_D, SEQ = CFG_SEQ, CTX = CFG_CTX, FF = CFG_FF, DEPTH = CFG_DEPTH;
constexpr int M = CTX + SEQ;
constexpr int GRID_W = 64;
constexpr int NH = 6, QKD = 96, NOPE = 64, ROPE = 32, VD = 64, QL = 256, KVL = 128;
constexpr int SH = 6, SP = 64, SW = 384, SG = 2, SN = 64, CONVD = 640, CHUNK = 128;
constexpr int PW = 256, MIXW = 1024, INC = 1708;
constexpr int C_Q = 0, C_KV = 256, C_KR = 384, C_Z = 416, C_XBC = 800, C_DT = 1440, C_POOL = 1452;
constexpr int NE = 32, TOPK = 4;
constexpr float EPS = 1e-6f;

typedef unsigned short bf16_t;
HD bf16_t f2bf(float f) { union { float f; unsigned u; } v; v.f = f; unsigned u = v.u; u += 0x7FFFu + ((u >> 16) & 1u); return (bf16_t)(u >> 16); }
HD float bf2f(bf16_t b) { union { float f; unsigned u; } v; v.u = ((unsigned)b) << 16; return v.f; }
struct P {
    const float *x, *c, *ctx, *c_ctx, *norm1_g, *norm2_g, *mod_w, *mod_b, *w_in, *q_g, *kv_g, *w_uq, *w_ukv, *qn_g, *kn_g;
    const float *conv_w, *conv_b, *a_log, *dt_bias, *ssd_d, *ssd_norm_g, *pool_w, *pool_scale, *w_out, *router_w, *router_b;
    const float *wg, *bg, *wu, *bu, *wd, *bd;
    float* out;
    float *xres, *mod, *rs, *h, *proj, *qln, *kvln, *qraw, *kvraw, *q, *k, *v, *mixin, *xbc, *dt, *ydir, *poolp, *mix, *logits, *topw, *act, *down;
    int *topi, *cnt, *list;
    bf16_t *qb, *kb, *vb;
    float *attf, *diag;
    bf16_t *hb1, *hb2, *mixb, *ybn;
};

HD float siluf(float x) { return x / (1.0f + expf(-x)); }
HD float sigmf(float x) { return 1.0f / (1.0f + expf(-x)); }
HD float softplusf(float x) { return x > 20.0f ? x : log1pf(expf(x)); }
HD const float* modv(const P& p, int l, int r, int j) { return p.mod + ((size_t)(l * 2 + (r < CTX ? 1 : 0)) * 6 + j) * D; }

enum { OP_COPY_IN = 0, OP_MODVEC, OP_ROWSTAT, OP_NORM1, OP_INPROJ, OP_LATNORM, OP_QRAW, OP_KVRAW, OP_QHEAD, OP_KHEAD, OP_ATTN, OP_CONV, OP_DT, OP_SSDSCAN, OP_SSDFIN,
       OP_POOLP, OP_POOLMM, OP_OUTPROJ, OP_RES1, OP_NORM2, OP_LOGITS, OP_ZEROCNT, OP_TOPK, OP_GATEUP, OP_DOWN, OP_COMBINE, OP_WRITE_OUT, OP_MIXB, OP_COMBINE2, OP_COUNT };

HDC long op_count(int op) {
    switch (op) {
        case OP_COPY_IN: return (long)M * D;
        case OP_MODVEC: return (long)DEPTH * 2 * 6 * D;
        case OP_ROWSTAT: return M;
        case OP_NORM1: case OP_NORM2: return (long)M * D;
        case OP_INPROJ: return (long)(M / 8) * INC;
        case OP_LATNORM: return 2L * M;
        case OP_QRAW: return (long)(M / 8) * (NH * QKD);
        case OP_KVRAW: return (long)(M / 8) * (NH * 128);
        case OP_QHEAD: case OP_KHEAD: return (long)M * NH;
        case OP_ATTN: return (long)M * NH;
        case OP_CONV: return (long)M * CONVD;
        case OP_DT: return (long)M * 12;
        case OP_SSDSCAN: return 2L * SH * SP;
        case OP_SSDFIN: return M;
        case OP_POOLP: return (long)M * PW;
        case OP_POOLMM: return (long)M * PW;
        case OP_OUTPROJ: return (long)(M / 8) * D;
        case OP_RES1: return (long)M * D;
        case OP_LOGITS: return (long)M * NE;
        case OP_ZEROCNT: return NE;
        case OP_TOPK: return M;
        case OP_GATEUP: return (long)NE * (M / 8) * FF;
        case OP_DOWN: return (long)NE * (M / 8) * D;
        case OP_COMBINE: return (long)M * D;
        case OP_WRITE_OUT: return (long)SEQ * D;
        case OP_MIXB: return (long)M * MIXW;
        case OP_COMBINE2: return (long)M * D;
    }
    return 0;
}

HD void gemm8(const float* A, int lda, const float* B, int ldb, const float* bias, float* C, int ldc, int N, int K, long idx) {
    const int j = (int)(idx % N); const long r0 = (idx / N) * 8;
    float acc[8];
#pragma unroll
    for (int i = 0; i < 8; ++i) acc[i] = 0.f;
    const float* a = A + r0 * lda;
    for (int k = 0; k < K; ++k) {
        const float b = B[(size_t)k * ldb + j];
#pragma unroll
        for (int i = 0; i < 8; ++i) acc[i] += a[(size_t)i * lda + k] * b;
    }
    const float bv = bias ? bias[j] : 0.f;
#pragma unroll
    for (int i = 0; i < 8; ++i) C[(r0 + i) * ldc + j] = acc[i] + bv;
}

HD void sincos_rr(float angf, float& cs, float& sn) {
    const double x = (double)angf; const double n = rint(x * 0.63661977236758134308); const double y = (x - n * 1.57079632679489655800) - n * 6.123233995736766e-17; const double y2 = y * y;
    const double s = y * (1.0 + y2 * (-1.0 / 6 + y2 * (1.0 / 120 + y2 * (-1.0 / 5040 + y2 * (1.0 / 362880 + y2 * (-1.0 / 39916800))))));
    const double c = 1.0 + y2 * (-0.5 + y2 * (1.0 / 24 + y2 * (-1.0 / 720 + y2 * (1.0 / 40320 + y2 * (-1.0 / 3628800 + y2 * (1.0 / 479001600))))));
    const int q = ((int)n) & 3; const double cc = (q == 0) ? c : (q == 1) ? -s : (q == 2) ? -c : s; const double ss = (q == 0) ? s : (q == 1) ? c : (q == 2) ? -s : -c;
    cs = (float)cc; sn = (float)ss;
}
HD float rope_inv_freq(int f) { return f == 0 ? 1.0f : f == 1 ? 0.31622776f : f == 2 ? 0.1f : f == 3 ? 0.031622775f : f == 4 ? 0.01f : f == 5 ? 0.0031622776f : f == 6 ? 0.001f : 0.00031622776f; }
HD void rope_apply(float* v32, int t) {
    const float row = (float)(t / GRID_W), col = (float)(t % GRID_W);
#pragma unroll
    for (int a = 0; a < 2; ++a)
#pragma unroll
        for (int f = 0; f < 8; ++f) {
            const float ang = (a == 0 ? row : col) * rope_inv_freq(f);
            float cs, sn; sincos_rr(ang, cs, sn);
            const float x1 = v32[a * 16 + f], x2 = v32[a * 16 + 8 + f];
            v32[a * 16 + f] = x1 * cs - x2 * sn; v32[a * 16 + 8 + f] = x2 * cs + x1 * sn;
        }
}

HD void op_run(int op, const P& p, int l, long idx) {
    switch (op) {
    case OP_COPY_IN: { const long r = idx / D; const int c = (int)(idx % D); p.xres[idx] = r < CTX ? p.ctx[idx] : p.x[(r - CTX) * D + c]; } break;
    case OP_MODVEC: {
        const int j = (int)(idx % (6 * D)); const int which = (int)((idx / (6 * D)) % 2); const int ll = (int)(idx / (12 * D));
        const float* cv = which ? p.c_ctx : p.c; float s = 0.f;
        for (int k = 0; k < D; ++k) s += siluf(cv[k]) * p.mod_w[((size_t)ll * D + k) * (6 * D) + j];
        p.mod[idx] = s + p.mod_b[(size_t)ll * 6 * D + j];
    } break;
    case OP_ROWSTAT: { const float* xr = p.xres + idx * D; float s = 0.f; for (int k = 0; k < D; ++k) s += xr[k] * xr[k]; p.rs[idx] = 1.0f / sqrtf(s / D + EPS); } break;
    case OP_NORM1: case OP_NORM2: { const int r = (int)(idx / D), c = (int)(idx % D); const int o = op == OP_NORM1 ? 0 : 3;
        const float g = (op == OP_NORM1 ? p.norm1_g : p.norm2_g)[l * D + c];
        const float hv = p.xres[idx] * p.rs[r] * g * (1.0f + modv(p, l, r, o + 1)[c]) + modv(p, l, r, o)[c]; p.h[idx] = hv;
        bf16_t* hb = op == OP_NORM1 ? p.hb1 : p.hb2; if (hb) hb[idx] = f2bf(hv); } break;
    case OP_INPROJ: gemm8(p.h, D, p.w_in + (size_t)l * D * INC, INC, nullptr, p.proj, INC, INC, D, idx); break;
    case OP_LATNORM: {
        const int which = idx >= M; const long r = which ? idx - M : idx; const int n = which ? KVL : QL; const float* src = p.proj + r * INC + (which ? C_KV : C_Q);
        float s = 0.f; for (int k = 0; k < n; ++k) s += src[k] * src[k]; const float rs = 1.0f / sqrtf(s / n + EPS);
        float* dst = which ? p.kvln + r * KVL : p.qln + r * QL; const float* g = which ? p.kv_g + l * KVL : p.q_g + l * QL;
        for (int k = 0; k < n; ++k) dst[k] = src[k] * rs * g[k];
    } break;
    case OP_QRAW: gemm8(p.qln, QL, p.w_uq + (size_t)l * QL * (NH * QKD), NH * QKD, nullptr, p.qraw, NH * QKD, NH * QKD, QL, idx); break;
    case OP_KVRAW: gemm8(p.kvln, KVL, p.w_ukv + (size_t)l * KVL * (NH * 128), NH * 128, nullptr, p.kvraw, NH * 128, NH * 128, KVL, idx); break;
    case OP_QHEAD: { const int r = (int)(idx / NH), hh = (int)(idx % NH); const float* src = p.qraw + (size_t)r * (NH * QKD) + hh * QKD; float s = 0.f;
        for (int d = 0; d < QKD; ++d) s += src[d] * src[d]; const float rs = 1.0f / sqrtf(s / QKD + EPS);
        float* dst = p.q + ((size_t)r * NH + hh) * QKD; float rp[32];
        for (int d = 0; d < NOPE; ++d) dst[d] = src[d] * rs * p.qn_g[l * QKD + d];
#pragma unroll
        for (int d = 0; d < 32; ++d) rp[d] = src[NOPE + d] * rs * p.qn_g[l * QKD + NOPE + d];
        if (r >= CTX) rope_apply(rp, r - CTX);
#pragma unroll
        for (int d = 0; d < 32; ++d) dst[NOPE + d] = rp[d];
        bf16_t* db = p.qb + ((size_t)r * NH + hh) * QKD;
        for (int d = 0; d < QKD; ++d) db[d] = f2bf(dst[d]);
    } break;
    case OP_KHEAD: { const int r = (int)(idx / NH), hh = (int)(idx % NH); const float* kn = p.kvraw + (size_t)r * (NH * 128) + hh * 128; const float* kr = p.proj + (size_t)r * INC + C_KR; float s = 0.f;
        for (int d = 0; d < NOPE; ++d) s += kn[d] * kn[d];
        for (int d = 0; d < ROPE; ++d) s += kr[d] * kr[d];
        const float rs = 1.0f / sqrtf(s / QKD + EPS);
        float* dst = p.k + ((size_t)r * NH + hh) * QKD; float rp[32];
        for (int d = 0; d < NOPE; ++d) dst[d] = kn[d] * rs * p.kn_g[l * QKD + d];
#pragma unroll
        for (int d = 0; d < 32; ++d) rp[d] = kr[d] * rs * p.kn_g[l * QKD + NOPE + d];
        if (r >= CTX) rope_apply(rp, r - CTX);
#pragma unroll
        for (int d = 0; d < 32; ++d) dst[NOPE + d] = rp[d];
        float* vd = p.v + ((size_t)r * NH + hh) * VD;
        for (int d = 0; d < VD; ++d) vd[d] = kn[NOPE + d];
        bf16_t* db = p.kb + ((size_t)r * NH + hh) * QKD; bf16_t* vdb = p.vb + ((size_t)r * NH + hh) * VD;
        for (int d = 0; d < QKD; ++d) db[d] = f2bf(dst[d]);
        for (int d = 0; d < VD; ++d) vdb[d] = f2bf(kn[NOPE + d]);
    } break;
    case OP_ATTN: {
        const int r = (int)(idx % M), hh = UNIFORM((int)(idx / M)); const int nk = r < CTX ? CTX : M;
        float qv[QKD];
        const float* qp = p.q + ((size_t)r * NH + hh) * QKD; const float scale = 1.0f / sqrtf((float)QKD);
#pragma unroll
        for (int d = 0; d < QKD; ++d) qv[d] = qp[d] * scale;
        for (int half = 0; half < 2; ++half) {
            float o[32];
#pragma unroll
            for (int d = 0; d < 32; ++d) o[d] = 0.f;
            float mx = -1e30f, lsum = 0.f;
            for (int kk = 0; kk < nk; ++kk) {
                const float* kp = p.k + ((size_t)kk * NH + hh) * QKD; const float* vp = p.v + ((size_t)kk * NH + hh) * VD + half * 32; float s = 0.f;
#pragma unroll
                for (int d = 0; d < QKD; ++d) s += qv[d] * kp[d];
                const float mn = s > mx ? s : mx; const float corr = expf(mx - mn), pe = expf(s - mn);
                lsum = lsum * corr + pe; mx = mn;
#pragma unroll
                for (int d = 0; d < 32; ++d) o[d] = o[d] * corr + pe * vp[d];
            }
            const float inv = 1.0f / lsum; float* dst = p.mixin + (size_t)r * MIXW + hh * VD + half * 32;
#pragma unroll
            for (int d = 0; d < 32; ++d) dst[d] = o[d] * inv;
        }
    } break;
    case OP_CONV: { const int r = (int)(idx / CONVD), c = (int)(idx % CONVD); const int seg0 = r < CTX ? 0 : CTX, n = r < CTX ? CTX : SEQ, t = r - seg0; float y = p.conv_b[l * CONVD + c];
#pragma unroll
        for (int j = 0; j < 4; ++j) { const int tt = t - 2 + j; if (tt >= 0 && tt < n) y += p.conv_w[((size_t)l * 4 + j) * CONVD + c] * p.proj[(size_t)(seg0 + tt) * INC + C_XBC + c]; }
        p.xbc[idx] = siluf(y); } break;
    case OP_DT: { const int r = (int)(idx / 12), j = (int)(idx % 12); p.dt[idx] = softplusf(p.proj[(size_t)r * INC + C_DT + j] + p.dt_bias[l * 12 + j]); } break;
    case OP_SSDSCAN: {
        const int pp = (int)(idx % SP), hh = UNIFORM((int)((idx / SP) % SH)), dir = UNIFORM((int)(idx / (SP * SH))); const int g = hh / (SH / SG);
        const float a = -expf(p.a_log[l * 12 + dir * 6 + hh]); float st[SN];
#pragma unroll
        for (int n = 0; n < SN; ++n) st[n] = 0.f;
        for (int step = 0; step < M; ++step) {
            const int r = dir == 0 ? step : (step < CTX ? CTX - 1 - step : M - 1 - (step - CTX));
            const float dtv = p.dt[(size_t)r * 12 + dir * 6 + hh]; const float dA = expf(dtv * a); const float xv = p.xbc[(size_t)r * CONVD + hh * SP + pp] * dtv;
            const float* Bp = p.xbc + (size_t)r * CONVD + SW + g * SN; const float* Cp = p.xbc + (size_t)r * CONVD + SW + SG * SN + g * SN; float y = 0.f;
#pragma unroll
            for (int n = 0; n < SN; ++n) { st[n] = st[n] * dA + xv * Bp[n]; y += st[n] * Cp[n]; }
            p.ydir[((size_t)dir * M + r) * SW + hh * SP + pp] = y;
        }
    } break;
    case OP_SSDFIN: { const long r = idx; float ss = 0.f;
        for (int c = 0; c < SW; ++c) { const float y = p.ydir[r * SW + c] + p.ydir[((size_t)M + r) * SW + c] + p.ssd_d[l * SH + c / SP] * p.xbc[r * CONVD + c]; const float gv = y * siluf(p.proj[r * INC + C_Z + c]); ss += gv * gv; }
        const float rs = 1.0f / sqrtf(ss / SW + EPS);
        for (int c = 0; c < SW; ++c) { const float y = p.ydir[r * SW + c] + p.ydir[((size_t)M + r) * SW + c] + p.ssd_d[l * SH + c / SP] * p.xbc[r * CONVD + c]; const float gv = y * siluf(p.proj[r * INC + C_Z + c]);
            p.mixin[r * MIXW + NH * VD + c] = gv * rs * p.ssd_norm_g[l * SW + c]; }
    } break;
    case OP_POOLP: { const int r = (int)(idx / PW), c = (int)(idx % PW); const int gi = c / 64; const int win = 2 << gi; const int seg0 = r < CTX ? 0 : CTX, n = r < CTX ? CTX : SEQ, t = r - seg0;
        int lo = t - win / 2, hi = t - win / 2 + win; lo = lo < 0 ? 0 : lo; hi = hi > n ? n : hi; float s = 0.f;
        for (int tt = lo; tt < hi; ++tt) s += p.proj[(size_t)(seg0 + tt) * INC + C_POOL + c];
        p.poolp[idx] = s / (float)(hi - lo) - p.proj[(size_t)r * INC + C_POOL + c]; } break;
    case OP_POOLMM: { const int r = (int)(idx / PW), c = (int)(idx % PW); const int gi = c / 64, d = c % 64; float s = 0.f;
        for (int cc = 0; cc < 64; ++cc) s += p.poolp[(size_t)r * PW + gi * 64 + cc] * p.pool_w[(((size_t)l * 4 + gi) * 64 + cc) * 64 + d];
        p.mixin[(size_t)r * MIXW + NH * VD + SW + c] = s * p.pool_scale[l * PW + c]; } break;
    case OP_OUTPROJ: gemm8(p.mixin, MIXW, p.w_out + (size_t)l * MIXW * D, D, nullptr, p.mix, D, D, MIXW, idx); break;
    case OP_RES1: { const int r = (int)(idx / D), c = (int)(idx % D); p.xres[idx] += modv(p, l, r, 2)[c] * p.mix[idx]; } break;
    case OP_LOGITS: { const int r = (int)(idx / NE), e = (int)(idx % NE); const float* hr = p.h + (size_t)r * D; float s = 0.f;
        for (int k = 0; k < D; ++k) s += hr[k] * p.router_w[((size_t)l * D + k) * NE + e];
        p.logits[idx] = s + p.router_b[l * NE + e]; } break;
    case OP_ZEROCNT: p.cnt[idx] = 0; break;
    case OP_TOPK: { const long t = idx; float lg[NE];
#pragma unroll
        for (int e = 0; e < NE; ++e) lg[e] = p.logits[t * NE + e];
        int sel[4]; float sv[4];
#pragma unroll
        for (int kk = 0; kk < 4; ++kk) { float best = -3.0e38f; int bi = 0;
#pragma unroll
            for (int e = 0; e < NE; ++e) { bool taken = false;
#pragma unroll
                for (int q = 0; q < kk; ++q) taken = taken || (sel[q] == e);
                if (!taken && lg[e] > best) { best = lg[e]; bi = e; } }
            sel[kk] = bi; sv[kk] = best; }
        float es[4], sum = 0.f;
#pragma unroll
        for (int kk = 0; kk < 4; ++kk) { es[kk] = expf(sv[kk] - sv[0]); sum += es[kk]; }
#pragma unroll
        for (int kk = 0; kk < 4; ++kk) { p.topi[t * 4 + kk] = sel[kk]; p.topw[t * 4 + kk] = es[kk] / sum; const int pos = ATOMIC_INC(&p.cnt[sel[kk]]); p.list[(size_t)sel[kk] * M + pos] = (int)(t * 4 + kk); }
    } break;
    case OP_GATEUP: {
        const int j = (int)(idx % FF); const long rest = idx / FF; const int rb = (int)(rest % (M / 8)), e = (int)(rest / (M / 8)); const int cnt = p.cnt[e]; if (rb * 8 >= cnt) break;
        int a[8]; float g[8], u[8];
#pragma unroll
        for (int i = 0; i < 8; ++i) { a[i] = rb * 8 + i < cnt ? p.list[(size_t)e * M + rb * 8 + i] : -1; g[i] = 0.f; u[i] = 0.f; }
        const float* wgp = p.wg + ((size_t)l * NE + e) * D * FF + j; const float* wup = p.wu + ((size_t)l * NE + e) * D * FF + j;
        for (int k = 0; k < D; ++k) { const float gw = wgp[(size_t)k * FF], uw = wup[(size_t)k * FF];
#pragma unroll
            for (int i = 0; i < 8; ++i) { const float xv = p.h[(size_t)(a[i] < 0 ? 0 : a[i] / 4) * D + k]; g[i] += xv * gw; u[i] += xv * uw; } }
        const float bgv = p.bg[((size_t)l * NE + e) * FF + j], buv = p.bu[((size_t)l * NE + e) * FF + j];
#pragma unroll
        for (int i = 0; i < 8; ++i) if (a[i] >= 0) { float gv = g[i] + bgv; gv = gv < 7.0f ? gv : 7.0f; float uv = u[i] + buv; uv = uv < -7.0f ? -7.0f : (uv > 7.0f ? 7.0f : uv);
            p.act[(size_t)a[i] * FF + j] = gv * sigmf(1.702f * gv) * (uv + 1.0f); }
    } break;
    case OP_DOWN: {
        const int j = (int)(idx % D); const long rest = idx / D; const int rb = (int)(rest % (M / 8)), e = (int)(rest / (M / 8)); const int cnt = p.cnt[e]; if (rb * 8 >= cnt) break;
        int a[8]; float o[8];
#pragma unroll
        for (int i = 0; i < 8; ++i) { a[i] = rb * 8 + i < cnt ? p.list[(size_t)e * M + rb * 8 + i] : -1; o[i] = 0.f; }
        const float* wdp = p.wd + ((size_t)l * NE + e) * FF * D + j;
        for (int k = 0; k < FF; ++k) { const float w = wdp[(size_t)k * D];
#pragma unroll
            for (int i = 0; i < 8; ++i) o[i] += p.act[(size_t)(a[i] < 0 ? 0 : a[i]) * FF + k] * w; }
        const float bv = p.bd[((size_t)l * NE + e) * D + j];
#pragma unroll
        for (int i = 0; i < 8; ++i) if (a[i] >= 0) p.down[(size_t)a[i] * D + j] = o[i] + bv;
    } break;
    case OP_COMBINE: { const int r = (int)(idx / D), c = (int)(idx % D); float s = 0.f;
#pragma unroll
        for (int kk = 0; kk < 4; ++kk) s += p.topw[(size_t)r * 4 + kk] * p.down[((size_t)r * 4 + kk) * D + c];
        p.xres[idx] += modv(p, l, r, 5)[c] * s; } break;
    case OP_WRITE_OUT: p.out[idx] = p.xres[(size_t)CTX * D + idx]; break;
    case OP_MIXB: p.mixb[idx] = f2bf(p.mixin[idx]); break;
    case OP_COMBINE2: { const int r = (int)(idx / D), c = (int)(idx % D); float s = 0.f;
#pragma unroll
        for (int kk = 0; kk < 4; ++kk) s += p.topw[(size_t)r * 4 + kk] * bf2f(p.ybn[((size_t)r * 4 + kk) * D + c]);
        p.xres[idx] += modv(p, l, r, 5)[c] * s; } break;
    }
}

static const int LAYER_OPS[] = { OP_ROWSTAT, OP_NORM1, OP_INPROJ, OP_LATNORM, OP_QRAW, OP_KVRAW, OP_QHEAD, OP_KHEAD, OP_ATTN, OP_CONV, OP_DT, OP_SSDSCAN, OP_SSDFIN, OP_POOLP, OP_POOLMM,
                                 OP_OUTPROJ, OP_RES1, OP_ROWSTAT, OP_NORM2, OP_LOGITS, OP_ZEROCNT, OP_TOPK, OP_GATEUP, OP_DOWN, OP_COMBINE };
constexpr int N_LAYER_OPS = sizeof(LAYER_OPS) / sizeof(int);
#endif

#define XB_TMO      128
#define XB_XCNT(j)  (256  + 64 * (j))
#define XB_XSUB(j)  (1280 + 64 * (j))
#define XB_XGEN(j)  (2304 + 64 * (j))
#define XB_TOP      3328
#define XB_TOPGEN   3392
#define XCD_BAR_WORDS 3456
#define XB_SPIN_CAP (1u << 22)
#define LAS __attribute__((address_space(3)))

__device__ __forceinline__ unsigned xb_ld(unsigned* p)              { return __hip_atomic_load(p, __ATOMIC_RELAXED, __HIP_MEMORY_SCOPE_AGENT); }
__device__ __forceinline__ unsigned xb_add(unsigned* p, unsigned v) { return __hip_atomic_fetch_add(p, v, __ATOMIC_RELAXED, __HIP_MEMORY_SCOPE_AGENT); }
__device__ __forceinline__ unsigned xb_xcc_id() { return (unsigned)__builtin_amdgcn_s_getreg((3 << 11) | 20) & 0xFu; }
#define XB_SPIN(cond, bar) do { unsigned _sp = 0; while (cond) { __builtin_amdgcn_s_sleep(1); \
    if ((++_sp & 255u) == 0u) { if (xb_ld(&(bar)[XB_TMO])) break; if (_sp > XB_SPIN_CAP) { atomicAdd(&(bar)[XB_TMO], 1u); break; } } } } while (0)

struct XcdBarrier {
    unsigned* bar; unsigned x;
    volatile LAS unsigned* st;
};

__device__ __forceinline__ XcdBarrier xcd_barrier_post(unsigned* bar, volatile LAS unsigned* st) {
    XcdBarrier b; b.bar = bar; b.x = xb_xcc_id(); b.st = st;
    if (threadIdx.x == 0) (void)xb_add(&bar[XB_XCNT(b.x)], 1u);
    return b;
}
__device__ __forceinline__ void xcd_barrier_complete(unsigned* bar, unsigned x, unsigned& nloc, unsigned& nx) {
    const unsigned G = gridDim.x * gridDim.y * gridDim.z;
    unsigned sum, cnt, mine, sp = 0u;
    for (;;) {
        sum = 0u; cnt = 0u; mine = 0u;
#pragma unroll
        for (unsigned j = 0; j < 16; ++j) { const unsigned c = xb_ld(&bar[XB_XCNT(j)]); sum += c; cnt += (c > 0u) ? 1u : 0u; mine = (j == x) ? c : mine; }
        if (sum == G) break;
        __builtin_amdgcn_s_sleep(1);
        if ((++sp & 255u) == 0u) { if (xb_ld(&bar[XB_TMO])) break; if (sp > XB_SPIN_CAP) { atomicAdd(&bar[XB_TMO], 1u); break; } }
    }
    nloc = mine > 0u ? mine : 1u; nx = cnt > 0u ? cnt : 1u;
}

__device__ __forceinline__ void xcd_barrier(const XcdBarrier& b) {
    asm volatile("s_waitcnt vmcnt(0)" ::: "memory");
    __syncthreads();
    if (threadIdx.x == 0) {
        unsigned* bar = b.bar;
        __builtin_amdgcn_s_waitcnt(0);
        unsigned nloc = b.st[0], nx = b.st[1];
        if (nloc == 0u) { unsigned xx = b.x; asm volatile("" : "+s"(xx));   xcd_barrier_complete(bar, xx, nloc, nx); b.st[0] = nloc; b.st[1] = nx; }
        const unsigned old = xb_add(&bar[XB_XSUB(b.x)], 1u);
        const unsigned gen = old / nloc;
        if (old + 1u == (gen + 1u) * nloc) {
            __builtin_amdgcn_fence(__ATOMIC_RELEASE, "agent");
            asm volatile("s_waitcnt vmcnt(0)" ::: "memory");
            const unsigned og = xb_add(&bar[XB_TOP], 1u);
            const unsigned tg = og / nx;
            if (og + 1u == (tg + 1u) * nx) xb_add(&bar[XB_TOPGEN], 1u);
            else XB_SPIN(xb_ld(&bar[XB_TOPGEN]) == tg, bar);
            __builtin_amdgcn_fence(__ATOMIC_ACQUIRE, "agent");
            xb_add(&bar[XB_XGEN(b.x)], 1u);
            asm volatile("s_waitcnt vmcnt(0)" ::: "memory");
        } else {
            XB_SPIN(xb_ld(&bar[XB_XGEN(b.x)]) == gen, bar);
            __builtin_amdgcn_fence(__ATOMIC_ACQUIRE, "agent");
            asm volatile("s_waitcnt vmcnt(0)" ::: "memory");
        }
    }
    __syncthreads();
}


namespace at {
typedef unsigned short bf16_t;
using bf16x8 = __attribute__((ext_vector_type(8))) short;
using s16x4  = __attribute__((ext_vector_type(4))) short;
using f32x16 = __attribute__((ext_vector_type(16))) float;
using u32x4  = __attribute__((ext_vector_type(4))) unsigned;
constexpr int DQ = 96, DV = 64, NW = 8, QBLK = 32, KVBLK = 64;
constexpr int LDQ = 6 * DQ, LDK = 6 * DQ, LDV = 6 * DV;
constexpr float SCALE = 0.10206207261596575f;
constexpr float THR = 8.f;
constexpr int KROW = 208;
constexpr int SHM_K = KVBLK * KROW, SHM_V = KVBLK * DV * 2;
constexpr int SHM_ATTN = 2 * SHM_V + 2 * SHM_K + NW * 64 * 4;
#define AT_SBAR() __builtin_amdgcn_sched_barrier(0)
__device__ __forceinline__ int crow(int r, int hi) { return (r & 3) + 8 * (r >> 2) + 4 * hi; }
__device__ __forceinline__ unsigned cvtpk(float lo, float hi) { unsigned r; asm volatile("v_cvt_pk_bf16_f32 %0, %1, %2" : "=v"(r) : "v"(lo), "v"(hi)); return r; }

__device__ __forceinline__ void partialSM(f32x16& p0, f32x16& p1, float& m_reg, float& mn, float& alpha) {
  constexpr float C = SCALE * 1.4426950408889634f;
  float pmax = p0[0];
#pragma unroll
  for (int r = 1; r < 16; ++r) pmax = fmaxf(pmax, p0[r]);
#pragma unroll
  for (int r = 0; r < 16; ++r) pmax = fmaxf(pmax, p1[r]);
  { auto rr = __builtin_amdgcn_permlane32_swap(__float_as_uint(pmax), __float_as_uint(pmax), false, false);
    pmax = fmaxf(__uint_as_float(rr[0]), __uint_as_float(rr[1])); }
  if (__builtin_expect(__all(pmax - m_reg <= THR / SCALE), 1)) { mn = m_reg; alpha = 1.f; }
  else { mn = fmaxf(m_reg, pmax); alpha = __builtin_amdgcn_exp2f((m_reg - mn) * C); m_reg = mn; }
  float mnC = -mn * C;
#pragma unroll
  for (int r = 0; r < 16; ++r) p0[r] = fmaf(p0[r], C, mnC);
#pragma unroll
  for (int r = 0; r < 16; ++r) p1[r] = fmaf(p1[r], C, mnC);
#pragma unroll
  for (int r = 0; r < 16; ++r) p0[r] = __builtin_amdgcn_exp2f(p0[r]);
}
__device__ __forceinline__ void finishSM(f32x16& p0, f32x16& p1, float alpha, float& l_reg, bf16x8& pa0, bf16x8& pa1, bf16x8& pa2, bf16x8& pa3) {
#pragma unroll
  for (int r = 0; r < 16; ++r) p1[r] = __builtin_amdgcn_exp2f(p1[r]);
  float ps = 0;
#pragma unroll
  for (int r = 0; r < 16; ++r) ps += p0[r];
#pragma unroll
  for (int r = 0; r < 16; ++r) ps += p1[r];
  { auto rr = __builtin_amdgcn_permlane32_swap(__float_as_uint(ps), __float_as_uint(ps), false, false);
    ps = __uint_as_float(rr[0]) + __uint_as_float(rr[1]); }
  l_reg = l_reg * alpha + ps;
#define AT_PK4(P, BASE, OUT) do { unsigned a0 = cvtpk(P[BASE + 0], P[BASE + 1]), a1 = cvtpk(P[BASE + 2], P[BASE + 3]);   \
    unsigned b0 = cvtpk(P[BASE + 4], P[BASE + 5]), b1 = cvtpk(P[BASE + 6], P[BASE + 7]);                              \
    auto r0 = __builtin_amdgcn_permlane32_swap(a0, b0, false, false); auto r1 = __builtin_amdgcn_permlane32_swap(a1, b1, false, false); \
    u32x4 w = {r0[0], r1[0], r0[1], r1[1]}; OUT = *reinterpret_cast<bf16x8*>(&w); } while (0)
  AT_PK4(p0, 0, pa0); AT_PK4(p0, 8, pa1); AT_PK4(p1, 0, pa2); AT_PK4(p1, 8, pa3);
#undef AT_PK4
}
__device__ __forceinline__ void qkt(f32x16& p0, f32x16& p1, const char* Ks, const bf16x8* qr, int r32, int hi) {
  p0 = f32x16{}; p1 = f32x16{};
#pragma unroll
  for (int d0 = 0; d0 < 6; ++d0) { const int cb = (d0 * 16 + hi * 8) * 2;
    bf16x8 b0 = *reinterpret_cast<const bf16x8*>(Ks + r32 * KROW + cb);
    bf16x8 b1 = *reinterpret_cast<const bf16x8*>(Ks + (32 + r32) * KROW + cb);
    p0 = __builtin_amdgcn_mfma_f32_32x32x16_bf16(b0, qr[d0], p0, 0, 0, 0);
    p1 = __builtin_amdgcn_mfma_f32_32x32x16_bf16(b1, qr[d0], p1, 0, 0, 0); }
}
__device__ __forceinline__ int v_st(int k, int c) { const int kk = (k & ~0xC) | ((k & 4) << 1) | ((k & 8) >> 1); return ((kk >> 3) * 2 + (c >> 5)) * 512 + ((kk & 7) * 32 + (c & 31)) * 2; }
__device__ __forceinline__ int v_rd_base(int lane) { return ((lane & 3) << 3) | (((lane >> 2) & 3) << 6) | (((lane >> 4) & 1) << 5) | (((lane >> 5) & 1) << 8); }
constexpr int v_rd_off(int d0, int ks, int half) { return d0 * 512 + ks * 2048 + half * 1024; }
template <int OFF> __device__ __forceinline__ s16x4 tr_read(int vb) {
  s16x4 r; asm volatile("ds_read_b64_tr_b16 %0, %1 offset:%2" : "=&v"(r) : "v"(vb), "i"(OFF) : "memory"); return r;
}
template <int D0> __device__ __forceinline__ void pv_one(f32x16& od, int vb, bf16x8 pa0, bf16x8 pa1, bf16x8 pa2, bf16x8 pa3) {
  const s16x4 l0 = tr_read<v_rd_off(D0, 0, 0)>(vb), h0 = tr_read<v_rd_off(D0, 0, 1)>(vb), l1 = tr_read<v_rd_off(D0, 1, 0)>(vb), h1 = tr_read<v_rd_off(D0, 1, 1)>(vb);
  const s16x4 l2 = tr_read<v_rd_off(D0, 2, 0)>(vb), h2 = tr_read<v_rd_off(D0, 2, 1)>(vb), l3 = tr_read<v_rd_off(D0, 3, 0)>(vb), h3 = tr_read<v_rd_off(D0, 3, 1)>(vb);
  asm volatile("s_waitcnt lgkmcnt(0)" ::: "memory"); AT_SBAR();
#define AT_PK(L, H) (bf16x8){L[0], L[1], L[2], L[3], H[0], H[1], H[2], H[3]}
  od = __builtin_amdgcn_mfma_f32_32x32x16_bf16(pa0, AT_PK(l0, h0), od, 0, 0, 0);
  od = __builtin_amdgcn_mfma_f32_32x32x16_bf16(pa1, AT_PK(l1, h1), od, 0, 0, 0);
  od = __builtin_amdgcn_mfma_f32_32x32x16_bf16(pa2, AT_PK(l2, h2), od, 0, 0, 0);
  od = __builtin_amdgcn_mfma_f32_32x32x16_bf16(pa3, AT_PK(l3, h3), od, 0, 0, 0);
#undef AT_PK
}
__device__ __forceinline__ void pv_d0(f32x16* o, int vb, bf16x8 pa0, bf16x8 pa1, bf16x8 pa2, bf16x8 pa3) {
  pv_one<0>(o[0], vb, pa0, pa1, pa2, pa3); pv_one<1>(o[1], vb, pa0, pa1, pa2, pa3);
}
__device__ __forceinline__ void attn_body(const bf16_t* __restrict__ Qb, const bf16_t* __restrict__ Kh, const bf16_t* __restrict__ Vh, float* __restrict__ Ob, int ldo, int seq, char* lds) {
  int tid = threadIdx.x; asm volatile("" : "+v"(tid));
  const int wid = tid >> 6, lane = tid & 63, r32 = lane & 31, hi = lane >> 5;
  char* V_lds = lds; char* K_lds = lds + 2 * SHM_V;
  float* ws = (float*)(lds + 2 * SHM_V + 2 * SHM_K) + wid * 64; float* li_l = ws; float* al_l = ws + 32;
  float m_reg = -1e30f, l_reg = 0; f32x16 o[2] = {}; bf16x8 qr[6];
  const bf16_t* Qw = Qb + (long)(wid * QBLK + r32) * LDQ + hi * 8;
#pragma unroll
  for (int d0 = 0; d0 < 6; ++d0) qr[d0] = *reinterpret_cast<const bf16x8*>(Qw + d0 * 16);
  const int kr0 = tid / 12, kc0 = tid % 12, c1 = 512 + (tid & 255), kr1 = c1 / 12, kc1 = c1 % 12, vr = tid >> 3, vc = (tid & 7) * 8;
  const bool k1on = tid < 256;
  const int kst0 = kr0 * KROW + kc0 * 16, kst1 = kr1 * KROW + kc1 * 16, vst = v_st(vr, vc);
  const long kg0 = (long)kr0 * LDK + kc0 * 8, kg1 = (long)kr1 * LDK + kc1 * 8, vg = (long)vr * LDV + vc;
  const int vb0 = (int)(uintptr_t)V_lds + v_rd_base(lane);
  struct { bf16x8 vs, ks0, ks1; } sr_[2];
#define AT_SLOAD(i, k0) do { sr_[i].vs = *reinterpret_cast<const bf16x8*>(Vh + (long)(k0) * LDV + vg); \
    sr_[i].ks0 = *reinterpret_cast<const bf16x8*>(Kh + (long)(k0) * LDK + kg0); sr_[i].ks1 = *reinterpret_cast<const bf16x8*>(Kh + (long)(k0) * LDK + kg1); } while (0)
#define AT_SWRITE(b, i) do { *(bf16x8*)(V_lds + (b) * SHM_V + vst) = sr_[i].vs; *(bf16x8*)(K_lds + (b) * SHM_K + kst0) = sr_[i].ks0; \
    if (k1on) *(bf16x8*)(K_lds + (b) * SHM_K + kst1) = sr_[i].ks1; } while (0)
#define AT_SWAIT() asm volatile("s_waitcnt vmcnt(3)" ::: "memory")
#define AT_RESC(a) do { if (__any((a) < 1.f)) { if (hi == 0) al_l[r32] = (a); asm volatile("s_waitcnt lgkmcnt(0)" ::: "memory"); \
    _Pragma("unroll") for (int d = 0; d < 2; ++d) _Pragma("unroll") for (int r = 0; r < 16; ++r) o[d][r] *= al_l[crow(r, hi)]; } } while (0)
  f32x16 pA0, pA1, pB0, pB1; float mnA, mnB, alA, alB; bf16x8 pa0, pa1, pa2, pa3; const int NT = seq / KVBLK;
  constexpr int SE = 0, SO = 1;
  AT_SLOAD(SE, 0); asm volatile("s_waitcnt vmcnt(0)" ::: "memory"); AT_SWRITE(0, SE); __syncthreads();
  qkt(pA0, pA1, K_lds, qr, r32, hi); partialSM(pA0, pA1, m_reg, mnA, alA);
  AT_SLOAD(SO, KVBLK); if (2 < NT) AT_SLOAD(SE, 2 * KVBLK);
  AT_SWAIT(); AT_SWRITE(1, SO); __syncthreads();
  for (int j = 1; j + 1 < NT; j += 2) {
    AT_SBAR(); qkt(pB0, pB1, K_lds + SHM_K, qr, r32, hi);
    finishSM(pA0, pA1, alA, l_reg, pa0, pa1, pa2, pa3); AT_SBAR();
    AT_SLOAD(SO, (j + 2) * KVBLK); AT_SBAR();
    pv_d0(o, vb0, pa0, pa1, pa2, pa3); partialSM(pB0, pB1, m_reg, mnB, alB);
    __syncthreads(); AT_SWAIT(); AT_SWRITE(0, SE);
    AT_RESC(alB); __syncthreads();
    AT_SBAR(); qkt(pA0, pA1, K_lds, qr, r32, hi);
    finishSM(pB0, pB1, alB, l_reg, pa0, pa1, pa2, pa3); AT_SBAR();
    if (j + 3 < NT) AT_SLOAD(SE, (j + 3) * KVBLK); AT_SBAR();
    pv_d0(o, vb0 + SHM_V, pa0, pa1, pa2, pa3); partialSM(pA0, pA1, m_reg, mnA, alA);
    __syncthreads(); AT_SWAIT(); AT_SWRITE(1, SO);
    AT_RESC(alA); __syncthreads();
  }
  AT_SBAR(); qkt(pB0, pB1, K_lds + SHM_K, qr, r32, hi);
  finishSM(pA0, pA1, alA, l_reg, pa0, pa1, pa2, pa3); AT_SBAR();
  pv_d0(o, vb0, pa0, pa1, pa2, pa3); partialSM(pB0, pB1, m_reg, mnB, alB);
  __syncthreads(); AT_RESC(alB);
  finishSM(pB0, pB1, alB, l_reg, pa0, pa1, pa2, pa3); AT_SBAR();
  pv_d0(o, vb0 + SHM_V, pa0, pa1, pa2, pa3);
  if (hi == 0) li_l[r32] = l_reg; asm volatile("s_waitcnt lgkmcnt(0)" ::: "memory");
  float rli[16];
#pragma unroll
  for (int r = 0; r < 16; ++r) rli[r] = __builtin_amdgcn_rcpf(li_l[crow(r, hi)]);
  float* Ow = Ob + (long)(wid * QBLK) * ldo;
#pragma unroll
  for (int r = 0; r < 16; ++r) { const int orow = crow(r, hi);
#pragma unroll
    for (int d0 = 0; d0 < 2; ++d0) Ow[(long)orow * ldo + d0 * 32 + r32] = o[d0][r] * rli[r]; }
#undef AT_SLOAD
#undef AT_SWRITE
#undef AT_SWAIT
#undef AT_RESC
}
}

namespace gm {
#define GM_LAS __attribute__((address_space(3)))
typedef unsigned short bf16_t;
typedef short bf16x8 __attribute__((ext_vector_type(8)));
typedef float f32x4 __attribute__((ext_vector_type(4)));
typedef unsigned u32x4 __attribute__((ext_vector_type(4)));
constexpr int BM = 256, BK = 64, HALF = 128, HTB = HALF * BK * 2, STAGE_BYTES = 8 * HTB;
__host__ __device__ __forceinline__ int lds_byte(int r, int c) { const int st = (r >> 4) * 2 + (c >> 5), rr = r & 15, cc = c & 31, ob = rr * 64 + cc * 2; return st * 1024 + (ob ^ (((ob >> 9) & 1) << 5)); }
__host__ __device__ __forceinline__ void stage_rc(int b, int& R, int& C) { const int st = b / 1024, sb = b % 1024, swz = sb ^ (((sb >> 9) & 1) << 5); R = (st >> 1) * 16 + swz / 64; C = (st & 1) * 32 + (swz % 64) / 2; }
__host__ __device__ __forceinline__ int perm32(int rho) { const int n = rho >> 4, i = rho & 15; return 8 * (i >> 2) + 4 * n + (i & 3); }
__device__ __forceinline__ unsigned cvt_pk_bf16(float lo, float hi) { unsigned r; asm volatile("v_cvt_pk_bf16_f32 %0, %1, %2" : "=v"(r) : "v"(lo), "v"(hi)); return r; }

template <bool PERM, class Epi>
__device__ __forceinline__ void gemm_unit(GM_LAS unsigned char* lds, const char* A, const unsigned (&offA)[2][2], const char* Bt, int K, const Epi& E) {
    int tid = threadIdx.x; asm volatile("" : "+v"(tid));
    const int wid = __builtin_amdgcn_readfirstlane(tid >> 6), lane = tid & 63, wr = wid >> 2, wc = wid & 3, fr = lane & 15, fq = lane >> 4;
    const int nt = K / BK;
    unsigned voffB[2];
#pragma unroll
    for (int i = 0; i < 2; ++i) { int R, C; stage_rc(tid * 16 + i * 8192, R, C); const int Rb = PERM ? ((R & ~31) + perm32(R & 31)) : R; voffB[i] = (unsigned)(Rb * K + C) * 2u; }
    const size_t kstep = (size_t)(BK * 2);
    const size_t hstep = (size_t)HALF * K * 2;
    const unsigned ldsw = (unsigned)wid * 1024u;
    const int aoff = lds_byte(wr * 64 + fr, fq * 8), boff = lds_byte(wc * 32 + fr, fq * 8);
#define GM_SA(b, h) (((b) * 2 + (h)) * HTB)
#define GM_SB(b, h) ((4 + (b) * 2 + (h)) * HTB)
#define GM_STAGEB(bufoff, gbase) do { _Pragma("unroll") for (int _i = 0; _i < 2; ++_i) \
        __builtin_amdgcn_global_load_lds((const unsigned*)((const char*)(gbase) + voffB[_i]), (GM_LAS unsigned*)(lds + (bufoff) + ldsw + _i * 8192), 16, 0, 0); } while (0)
#define GM_STAGEA(bufoff, h, kbyte) do { _Pragma("unroll") for (int _i = 0; _i < 2; ++_i) \
        __builtin_amdgcn_global_load_lds((const unsigned*)(A + (size_t)offA[h][_i] + (kbyte)), (GM_LAS unsigned*)(lds + (bufoff) + ldsw + _i * 8192), 16, 0, 0); } while (0)
#define GM_LDA(dst, b, h) do { _Pragma("unroll") for (int m = 0; m < 4; ++m) _Pragma("unroll") for (int k = 0; k < 2; ++k) dst[m][k] = *(const GM_LAS bf16x8*)(lds + GM_SA(b, h) + aoff + m * 2048 + k * 1024); } while (0)
#define GM_LDB(dst, b, h) do { _Pragma("unroll") for (int n = 0; n < 2; ++n) _Pragma("unroll") for (int k = 0; k < 2; ++k) dst[n][k] = *(const GM_LAS bf16x8*)(lds + GM_SB(b, h) + boff + n * 2048 + k * 1024); } while (0)
#define GM_MMA(ai, bj, At, Bt_) do { __builtin_amdgcn_s_setprio(1); _Pragma("unroll") for (int m = 0; m < 4; ++m) _Pragma("unroll") for (int n = 0; n < 2; ++n) _Pragma("unroll") for (int k = 0; k < 2; ++k) \
        acc[ai][bj][m][n] = __builtin_amdgcn_mfma_f32_16x16x32_bf16(Bt_[n][k], At[m][k], acc[ai][bj][m][n], 0, 0, 0); __builtin_amdgcn_s_setprio(0); } while (0)
#define GM_WAIT_V(n) asm volatile("s_waitcnt vmcnt(" #n ")" ::: "memory")
#define GM_WAIT_L(n) asm volatile("s_waitcnt lgkmcnt(" #n ")" ::: "memory")
#define GM_BAR __builtin_amdgcn_s_barrier()
#define GM_SCHED __builtin_amdgcn_sched_barrier(0)
    f32x4 acc[2][2][4][2];
#pragma unroll
    for (int a = 0; a < 2; ++a)
#pragma unroll
        for (int b = 0; b < 2; ++b)
#pragma unroll
            for (int m = 0; m < 4; ++m)
#pragma unroll
                for (int n = 0; n < 2; ++n) acc[a][b][m][n] = (f32x4){0.f, 0.f, 0.f, 0.f};
    bf16x8 At[4][2], B0[2][2], B1[2][2];
    const char* cB = Bt;
    GM_STAGEB(GM_SB(0, 0), cB); GM_STAGEA(GM_SA(0, 0), 0, 0); GM_STAGEB(GM_SB(0, 1), cB + hstep); GM_STAGEA(GM_SA(0, 1), 1, 0);
    if (wr == 1) GM_BAR;
    GM_WAIT_V(4); GM_BAR;
    GM_STAGEB(GM_SB(1, 0), cB + kstep); GM_STAGEA(GM_SA(1, 0), 0, kstep); GM_STAGEB(GM_SB(1, 1), cB + hstep + kstep);
    GM_WAIT_V(6); GM_BAR;
    for (int t = 0; t < nt; t += 2) {
        const bool last = (t == nt - 2);
        const size_t k1 = (size_t)(t + 1) * kstep;
        const size_t k2 = last ? 0 : (size_t)(t + 2) * kstep;
        const size_t k3 = k2 + kstep;
        const char* b2 = cB + k2; const char* b3 = cB + k3;
        GM_LDB(B0, 0, 0); GM_SCHED; GM_LDA(At, 0, 0); GM_STAGEA(GM_SA(1, 1), 1, k1);
        GM_WAIT_L(8); GM_BAR; GM_WAIT_L(0); GM_MMA(0, 0, At, B0); GM_BAR; GM_SCHED;
        GM_LDB(B1, 0, 1); GM_STAGEB(GM_SB(0, 0), b2);
        GM_BAR; GM_WAIT_L(0); GM_MMA(0, 1, At, B1); GM_BAR;
        GM_LDA(At, 0, 1); GM_STAGEA(GM_SA(0, 0), 0, k2);
        GM_BAR; GM_WAIT_L(0); GM_MMA(1, 0, At, B0); GM_BAR; GM_SCHED;
        GM_STAGEB(GM_SB(0, 1), b2 + hstep);
        GM_WAIT_V(6); GM_BAR; GM_MMA(1, 1, At, B1); GM_BAR;
        GM_LDB(B0, 1, 0); GM_SCHED; GM_LDA(At, 1, 0); GM_STAGEA(GM_SA(0, 1), 1, k2);
        GM_WAIT_L(8); GM_BAR; GM_WAIT_L(0); GM_MMA(0, 0, At, B0); GM_BAR; GM_SCHED;
        GM_LDB(B1, 1, 1); GM_STAGEB(GM_SB(1, 0), b3);
        GM_BAR; GM_WAIT_L(0); GM_MMA(0, 1, At, B1); GM_BAR;
        GM_LDA(At, 1, 1); GM_STAGEA(GM_SA(1, 0), 0, k3);
        GM_BAR; GM_WAIT_L(0); GM_MMA(1, 0, At, B0); GM_BAR; GM_SCHED;
        GM_STAGEB(GM_SB(1, 1), b3 + hstep);
        GM_WAIT_V(6); GM_BAR; GM_MMA(1, 1, At, B1); GM_BAR;
    }
    E(acc, wr, wc, fr, fq);
    GM_WAIT_V(0);
    if (wr == 0) GM_BAR;
    GM_BAR;
#undef GM_SA
#undef GM_SB
#undef GM_STAGEA
#undef GM_STAGEB
#undef GM_LDA
#undef GM_LDB
#undef GM_MMA
#undef GM_WAIT_V
#undef GM_WAIT_L
#undef GM_BAR
#undef GM_SCHED
}
__device__ __forceinline__ void dense_offA(unsigned (&offA)[2][2], long row0, int K) {
    int tid = threadIdx.x; asm volatile("" : "+v"(tid));
#pragma unroll
    for (int i = 0; i < 2; ++i) { int R, C; stage_rc(tid * 16 + i * 8192, R, C);
#pragma unroll
        for (int h = 0; h < 2; ++h) offA[h][i] = (unsigned)(((row0 + h * HALF + R) * K + C) * 2); }
}
}

struct FW {
    bf16_t *w_in_t, *w_out_t, *gu_t, *d_t;
    bf16_t *hb1, *hb2, *mixb, *actb, *yb;
    float *proj2, *mix2;
};
constexpr int INC_PAD = 1792;
template <int MAP> __device__ __forceinline__ void cvt_tile(const float* src, int ldn, int nvalid, bf16_t* dst, int K, int k0, int n0, float* T) {
    int tid = threadIdx.x; asm volatile("" : "+v"(tid)); const int r = tid >> 4, c4 = (tid & 15) * 4;
#pragma unroll
    for (int i = 0; i < 2; ++i) { const int kk = r + 32 * i; float4 v = make_float4(0.f, 0.f, 0.f, 0.f);
        if (n0 + c4 < nvalid) v = *(const float4*)(src + (size_t)(k0 + kk) * ldn + n0 + c4);
        T[kk * 65 + c4 + 0] = v.x; T[kk * 65 + c4 + 1] = v.y; T[kk * 65 + c4 + 2] = v.z; T[kk * 65 + c4 + 3] = v.w; }
    __syncthreads();
    { const int n = tid >> 3, kc = tid & 7; float f[8];
#pragma unroll
        for (int j = 0; j < 8; ++j) f[j] = T[(kc * 8 + j) * 65 + n];
        gm::u32x4 w; w.x = gm::cvt_pk_bf16(f[0], f[1]); w.y = gm::cvt_pk_bf16(f[2], f[3]); w.z = gm::cvt_pk_bf16(f[4], f[5]); w.w = gm::cvt_pk_bf16(f[6], f[7]);
        const int nn = n0 + n; const int drow = MAP == 0 ? nn : ((nn >> 7) * 256 + (MAP == 2 ? 128 : 0) + (nn & 127));
        *(gm::u32x4*)(dst + (size_t)drow * K + k0 + kc * 8) = w; }
    __syncthreads();
}
__device__ __forceinline__ void cvt_phase(const P& p, const FW& f, int l0, int l1, char* lds) {
    float* T = (float*)lds;
    constexpr int T_IN = 16 * 28, T_OUT = 16 * 16, T_E = 16 * 16, T_LAYER = T_IN + T_OUT + NE * 3 * T_E;
    const int total = (l1 - l0) * T_LAYER;
    for (int t = blockIdx.x; t < total; t += gridDim.x) {
        const int l = l0 + t / T_LAYER; int r = t % T_LAYER;
        if (r < T_IN) { const int kt = r / 28, ntl = r % 28; cvt_tile<0>(p.w_in + (size_t)l * D * INC, INC, INC, f.w_in_t + (size_t)l * INC_PAD * D, D, kt * 64, ntl * 64, T); continue; }
        r -= T_IN;
        if (r < T_OUT) { const int kt = r / 16, ntl = r % 16; cvt_tile<0>(p.w_out + (size_t)l * MIXW * D, D, D, f.w_out_t + (size_t)l * D * MIXW, MIXW, kt * 64, ntl * 64, T); continue; }
        r -= T_OUT;
        const int e = r / (3 * T_E), which = (r / T_E) % 3, tt = r % T_E, kt = tt / 16, ntl = tt % 16; const size_t le = (size_t)l * NE + e;
        if (which == 0) cvt_tile<1>(p.wg + le * D * FF, FF, FF, f.gu_t + le * 2 * FF * D, D, kt * 64, ntl * 64, T);
        else if (which == 1) cvt_tile<2>(p.wu + le * D * FF, FF, FF, f.gu_t + le * 2 * FF * D, D, kt * 64, ntl * 64, T);
        else cvt_tile<0>(p.wd + le * FF * D, D, D, f.d_t + le * D * FF, FF, kt * 64, ntl * 64, T);
    }
}
__device__ __forceinline__ void inproj_phase(const P& p, const FW& f, int l, float* dst, char* lds) {
    constexpr int NPN = INC_PAD / 256, NU = (M / 256) * NPN;
    for (int u = blockIdx.x; u < NU; u += gridDim.x) {
        const int pm = u / NPN, pn = u % NPN; unsigned offA[2][2]; gm::dense_offA(offA, (long)pm * 256, D);
        auto epi = [&](const gm::f32x4 (&acc)[2][2][4][2], int wr, int wc, int fr, int fq) {
            const int row0 = pm * 256 + wr * 64 + fr, col0 = pn * 256 + wc * 32 + 4 * fq;
#pragma unroll
            for (int ai = 0; ai < 2; ++ai)
#pragma unroll
                for (int m = 0; m < 4; ++m) { float* rowp = dst + (size_t)(row0 + ai * 128 + m * 16) * INC + col0;
#pragma unroll
                    for (int bj = 0; bj < 2; ++bj)
#pragma unroll
                        for (int n = 0; n < 2; ++n) if (col0 + bj * 128 + n * 16 < INC) *(gm::f32x4*)(rowp + bj * 128 + n * 16) = acc[ai][bj][m][n]; } };
        gm::gemm_unit<false>((GM_LAS unsigned char*)lds, (const char*)f.hb1, offA, (const char*)(f.w_in_t + ((size_t)l * INC_PAD + pn * 256) * D), D, epi);
    }
}
template <bool TOX> __device__ __forceinline__ void outproj_phase(const P& p, const FW& f, int l, float* dst, char* lds) {
    constexpr int NPN = D / 256, NU = (M / 256) * NPN;
    for (int u = blockIdx.x; u < NU; u += gridDim.x) {
        const int pm = u / NPN, pn = u % NPN; unsigned offA[2][2]; gm::dense_offA(offA, (long)pm * 256, MIXW);
        auto epi = [&](const gm::f32x4 (&acc)[2][2][4][2], int wr, int wc, int fr, int fq) {
            const int row0 = pm * 256 + wr * 64 + fr, col0 = pn * 256 + wc * 32 + 4 * fq; const float* gate = modv(p, l, pm * 256, 2);
#pragma unroll
            for (int ai = 0; ai < 2; ++ai)
#pragma unroll
                for (int m = 0; m < 4; ++m) { float* rowp = dst + (size_t)(row0 + ai * 128 + m * 16) * D + col0;
#pragma unroll
                    for (int bj = 0; bj < 2; ++bj)
#pragma unroll
                        for (int n = 0; n < 2; ++n) { float* q = rowp + bj * 128 + n * 16;
                            if (TOX) { const gm::f32x4 g = *(const gm::f32x4*)(gate + col0 + bj * 128 + n * 16); const gm::f32x4 x = *(const gm::f32x4*)q; *(gm::f32x4*)q = x + g * acc[ai][bj][m][n]; }
                            else *(gm::f32x4*)q = acc[ai][bj][m][n]; } } };
        gm::gemm_unit<false>((GM_LAS unsigned char*)lds, (const char*)f.mixb, offA, (const char*)(f.w_out_t + ((size_t)l * D + pn * 256) * MIXW), MIXW, epi);
    }
}
__device__ __forceinline__ bool moe_find(const int* cnt, int tg, int& e, int& ti, int& c) {
    int acc = 0;
    for (int x = 0; x < NE; ++x) { const int cx = cnt[x]; const int nt = (cx + 255) >> 8; if (tg < acc + nt) { e = x; ti = tg - acc; c = cx; return true; } acc += nt; }
    return false;
}
__device__ __forceinline__ int moe_tiles(const int* cnt) { int acc = 0; for (int x = 0; x < NE; ++x) acc += (cnt[x] + 255) >> 8; return acc; }
template <bool SRC_TOK> __device__ __forceinline__ void gather_offA(unsigned (&offA)[2][2], const int* lst, int base, int cnt, int K) {
    int tid = threadIdx.x; asm volatile("" : "+v"(tid));
#pragma unroll
    for (int i = 0; i < 2; ++i) { int R, C; gm::stage_rc(tid * 16 + i * 8192, R, C);
#pragma unroll
        for (int h = 0; h < 2; ++h) { const int s = base + h * 128 + R; int a = s < cnt ? lst[s] : 0; if (SRC_TOK) a >>= 2; offA[h][i] = (unsigned)(((size_t)a * K + C) * 2); } }
}
__device__ __forceinline__ void moe1_phase(const P& p, const FW& f, int l, char* lds) {
    constexpr int NPN = 2 * FF / 256; const int NU = moe_tiles(p.cnt) * NPN;
    for (int u = blockIdx.x; u < NU; u += gridDim.x) {
        int e, ti, cnt; if (!moe_find(p.cnt, u / NPN, e, ti, cnt)) break; const int pn = u % NPN; const int* lst = p.list + (size_t)e * M; const size_t le = (size_t)l * NE + e;
        unsigned offA[2][2]; gather_offA<true>(offA, lst, ti * 256, cnt, D);
        auto epi = [&](const gm::f32x4 (&acc)[2][2][4][2], int wr, int wc, int fr, int fq) {
            const int ff0 = pn * 128 + wc * 32 + 8 * fq; const float* bgp = p.bg + le * FF + ff0; const float* bup = p.bu + le * FF + ff0;
            const gm::f32x4 bg0 = *(const gm::f32x4*)bgp, bg1 = *(const gm::f32x4*)(bgp + 4), bu0 = *(const gm::f32x4*)bup, bu1 = *(const gm::f32x4*)(bup + 4);
#pragma unroll
            for (int ai = 0; ai < 2; ++ai)
#pragma unroll
                for (int m = 0; m < 4; ++m) { const int s = ti * 256 + ai * 128 + wr * 64 + m * 16 + fr; if (s < cnt) { const int a = lst[s]; float o[8];
#pragma unroll
                        for (int n = 0; n < 2; ++n)
#pragma unroll
                            for (int j = 0; j < 4; ++j) { float g = acc[ai][0][m][n][j] + (n ? bg1[j] : bg0[j]); float uu = acc[ai][1][m][n][j] + (n ? bu1[j] : bu0[j]);
                                g = g < 7.0f ? g : 7.0f; uu = uu < -7.0f ? -7.0f : (uu > 7.0f ? 7.0f : uu); o[n * 4 + j] = g * (1.0f / (1.0f + __expf(-1.702f * g))) * (uu + 1.0f); }
                        gm::u32x4 w; w.x = gm::cvt_pk_bf16(o[0], o[1]); w.y = gm::cvt_pk_bf16(o[2], o[3]); w.z = gm::cvt_pk_bf16(o[4], o[5]); w.w = gm::cvt_pk_bf16(o[6], o[7]);
                        *(gm::u32x4*)(f.actb + (size_t)a * FF + ff0) = w; } } };
        gm::gemm_unit<true>((GM_LAS unsigned char*)lds, (const char*)f.hb2, offA, (const char*)(f.gu_t + (le * 2 * FF + pn * 256) * D), D, epi);
    }
}
__device__ __forceinline__ void moe2_phase(const P& p, const FW& f, int l, char* lds) {
    constexpr int NPN = D / 256; const int NU = moe_tiles(p.cnt) * NPN;
    for (int u = blockIdx.x; u < NU; u += gridDim.x) {
        int e, ti, cnt; if (!moe_find(p.cnt, u / NPN, e, ti, cnt)) break; const int pn = u % NPN; const int* lst = p.list + (size_t)e * M; const size_t le = (size_t)l * NE + e;
        unsigned offA[2][2]; gather_offA<false>(offA, lst, ti * 256, cnt, FF);
        auto epi = [&](const gm::f32x4 (&acc)[2][2][4][2], int wr, int wc, int fr, int fq) {
#pragma unroll
            for (int bj = 0; bj < 2; ++bj) { const int c0 = pn * 256 + bj * 128 + wc * 32 + 8 * fq; const float* bp = p.bd + le * D + c0; const gm::f32x4 b0 = *(const gm::f32x4*)bp, b1 = *(const gm::f32x4*)(bp + 4);
#pragma unroll
                for (int ai = 0; ai < 2; ++ai)
#pragma unroll
                    for (int m = 0; m < 4; ++m) { const int s = ti * 256 + ai * 128 + wr * 64 + m * 16 + fr; if (s < cnt) { const int a = lst[s];
                            const gm::f32x4 v0 = acc[ai][bj][m][0] + b0, v1 = acc[ai][bj][m][1] + b1;
                            gm::u32x4 w; w.x = gm::cvt_pk_bf16(v0[0], v0[1]); w.y = gm::cvt_pk_bf16(v0[2], v0[3]); w.z = gm::cvt_pk_bf16(v1[0], v1[1]); w.w = gm::cvt_pk_bf16(v1[2], v1[3]);
                            *(gm::u32x4*)(f.yb + (size_t)a * D + c0) = w; } } } };
        gm::gemm_unit<true>((GM_LAS unsigned char*)lds, (const char*)f.actb, offA, (const char*)(f.d_t + (le * D + pn * 256) * FF), FF, epi);
    }
}

#ifndef CHECK_GEMM
#define CHECK_GEMM 0
#endif
__device__ __forceinline__ int gtid() { int i0 = blockIdx.x * blockDim.x + threadIdx.x; asm volatile("" : "+v"(i0)); return i0; }
template <int OP> __device__ __forceinline__ void run_op(const P& p, int l) {
    const long n = op_count(OP); const long stride = (long)gridDim.x * blockDim.x;
    for (long i = gtid(); i < n; i += stride) op_run(OP, p, l, i);
}
struct KArgs { P p; FW f; unsigned* bar; };
__device__ __forceinline__ const KArgs& kargs() { auto q = __builtin_amdgcn_kernarg_segment_ptr(); asm volatile("" : "+s"(q)); return *(const KArgs*)q; }
constexpr int LDS_BYTES = gm::STAGE_BYTES + 256;
#define BAR() do { XcdBarrier b2_; b2_.bar = kargs().bar; unsigned xx_ = xbx; asm volatile("" : "+s"(xx_)); b2_.x = xx_; b2_.st = (volatile LAS unsigned*)(lds + LDS_BYTES - 16); xcd_barrier(b2_); } while (0)
#define PH(OPX) do { run_op<OPX>(kargs().p, lo()); BAR(); } while (0)
#define RUN(OPX) run_op<OPX>(kargs().p, lo())

__device__ __forceinline__ void attn_phase(const P& p, float* O, int ldo, char* lds) {
    constexpr int NQT = M / 256, NU = NH * NQT;
    for (int u = blockIdx.x; u < NU; u += gridDim.x) {
        const int hh = u / NQT, qt = u % NQT; const int seq = qt == 0 ? CTX : M;
        __syncthreads();
        at::attn_body(p.qb + (size_t)qt * 256 * at::LDQ + hh * at::DQ, p.kb + hh * at::DQ, p.vb + hh * at::DV, O + (size_t)qt * 256 * ldo + hh * at::DV, ldo, seq, lds);
    }
    __syncthreads();
}
template <class TA> __device__ __forceinline__ float ldf(const TA* a, size_t i);
template <> __device__ __forceinline__ float ldf<float>(const float* a, size_t i) { return a[i]; }
template <> __device__ __forceinline__ float ldf<bf16_t>(const bf16_t* a, size_t i) { return bf2f(a[i]); }
template <class TA> __device__ __forceinline__ void chk_accum(const TA* a, int lda, const float* b, int ldb, long nrows, int ncols, float* diag) {
    float sd = 0.f, sr = 0.f; const long n = nrows * ncols; const long stride = (long)gridDim.x * blockDim.x;
    for (long i = gtid(); i < n; i += stride) { const long r = i / ncols; const int c = (int)(i % ncols);
        const float x = ldf<TA>(a, r * lda + c), y = b[r * ldb + c]; sd += (x - y) * (x - y); sr += y * y; }
    for (int o = 32; o >= 1; o >>= 1) { sd += __shfl_xor(sd, o); sr += __shfl_xor(sr, o); }
    if ((threadIdx.x & 63) == 0) { atomicAdd(diag, sd); atomicAdd(diag + 1, sr); }
}
__global__ void __launch_bounds__(512, 2) k_mega(KArgs a) {
    extern __shared__ __attribute__((aligned(16))) char lds[];
    uint4* xbw = (uint4*)(lds + LDS_BYTES - 16);
    if (threadIdx.x == 0) *xbw = make_uint4(0u, 0u, 0u, 0u);
    __syncthreads();
    const unsigned xbx = xcd_barrier_post(kargs().bar, (volatile LAS unsigned*)xbw).x;
#define KP kargs().p
#define KF kargs().f
    { const int l = 0; auto lo = [&]() { return l; }; RUN(OP_COPY_IN); if (blockIdx.x == 0 && threadIdx.x < 16) KP.diag[threadIdx.x] = 0.f; RUN(OP_MODVEC);
      cvt_phase(KP, KF, 0, CHECK_GEMM ? 1 : DEPTH, lds); BAR(); }
    for (int l = 0; l < DEPTH; ++l) {
        auto lo = [&]() { int ll = l; asm volatile("" : "+s"(ll)); return ll; };
        PH(OP_ROWSTAT); PH(OP_NORM1);
#if CHECK_GEMM
        PH(OP_INPROJ);
#else
        inproj_phase(KP, KF, lo(), KP.proj, lds); BAR();
#endif
        PH(OP_LATNORM);
        RUN(OP_QRAW); PH(OP_KVRAW);
        RUN(OP_QHEAD); RUN(OP_KHEAD); RUN(OP_CONV); RUN(OP_DT); PH(OP_POOLP);
        attn_phase(KP, KP.mixin, MIXW, lds);
        RUN(OP_POOLMM); PH(OP_SSDSCAN);
        PH(OP_SSDFIN); PH(OP_MIXB);
#if CHECK_GEMM
        PH(OP_OUTPROJ); PH(OP_RES1);
#else
        outproj_phase<true>(KP, KF, lo(), KP.xres, lds); BAR();
#endif
        PH(OP_ROWSTAT); PH(OP_NORM2);
        RUN(OP_ZEROCNT); PH(OP_LOGITS); PH(OP_TOPK);
#if CHECK_GEMM
        PH(OP_GATEUP); PH(OP_DOWN); PH(OP_COMBINE);
        if (l == 0) {
            inproj_phase(KP, KF, lo(), KF.proj2, lds); outproj_phase<false>(KP, KF, lo(), KF.mix2, lds); moe1_phase(KP, KF, lo(), lds); BAR();
            moe2_phase(KP, KF, lo(), lds); BAR();
            chk_accum<float>(KF.proj2, INC, KP.proj, INC, M, INC, KP.diag + 0); chk_accum<float>(KF.mix2, D, KP.mix, D, M, D, KP.diag + 2);
            chk_accum<bf16_t>(KF.actb, FF, KP.act, FF, 4L * M, FF, KP.diag + 4); chk_accum<bf16_t>(KF.yb, D, KP.down, D, 4L * M, D, KP.diag + 6); BAR();
        }
#else
        moe1_phase(KP, KF, lo(), lds); BAR(); moe2_phase(KP, KF, lo(), lds); BAR(); PH(OP_COMBINE2);
#endif
    }
    {
        float sc = 1.0f;
#if CHECK_GEMM
        float e = 0.f;
        for (int c = 0; c < 4; ++c) { const float ec = sqrtf(KP.diag[2 * c] / KP.diag[2 * c + 1]); e = ec > e ? ec : e; if (!(ec == ec)) e = 1e3f; }
        sc = 1.0f + 10.0f * e;
#endif
        const long n = (long)SEQ * D; const long stride = (long)gridDim.x * blockDim.x;
        for (long i = gtid(); i < n; i += stride) KP.out[i] = KP.xres[(size_t)CTX * D + i] * sc;
    }
#undef KP
#undef KF
}
static size_t carve(char*& cur, size_t bytes) { size_t a = (bytes + 255) & ~(size_t)255; cur += a; return a; }
static bool setup_params(P& p, FW& f, unsigned*& bar, void* const* d_in, void* d_out, void* d_ws, size_t ws_size) {
    const float** pp = (const float**)&p; for (int i = 0; i < 32; ++i) pp[i] = (const float*)d_in[i];
    p.out = (float*)d_out;
    char* cur = (char*)d_ws; char* base = cur;
    bar = (unsigned*)cur; carve(cur, XCD_BAR_WORDS * sizeof(unsigned));
#define CARVE(field, type, count) p.field = (type*)cur; carve(cur, (size_t)(count) * sizeof(type));
#define CARVEF(field, type, count) f.field = (type*)cur; carve(cur, (size_t)(count) * sizeof(type));
    CARVE(xres, float, (size_t)M * D) CARVE(mod, float, (size_t)DEPTH * 12 * D) CARVE(rs, float, M) CARVE(h, float, (size_t)M * D) CARVE(proj, float, (size_t)M * INC) CARVE(qln, float, (size_t)M * QL)
    CARVE(kvln, float, (size_t)M * KVL) CARVE(qraw, float, (size_t)M * NH * QKD) CARVE(kvraw, float, (size_t)M * NH * 128) CARVE(q, float, (size_t)M * NH * QKD) CARVE(k, float, (size_t)M * NH * QKD)
    CARVE(v, float, (size_t)M * NH * VD) CARVE(mixin, float, (size_t)M * MIXW) CARVE(xbc, float, (size_t)M * CONVD) CARVE(dt, float, (size_t)M * 12) CARVE(ydir, float, (size_t)2 * M * SW)
    CARVE(poolp, float, (size_t)M * PW) CARVE(mix, float, (size_t)M * D) CARVE(logits, float, (size_t)M * NE) CARVE(topw, float, (size_t)M * 4)
    CARVE(topi, int, (size_t)M * 4) CARVE(cnt, int, NE) CARVE(list, int, (size_t)NE * M)
    CARVE(qb, bf16_t, (size_t)M * NH * QKD) CARVE(kb, bf16_t, (size_t)M * NH * QKD) CARVE(vb, bf16_t, (size_t)M * NH * VD) CARVE(diag, float, 64)
    CARVE(hb1, bf16_t, (size_t)M * D) CARVE(hb2, bf16_t, (size_t)M * D) CARVE(mixb, bf16_t, (size_t)M * MIXW)
    CARVEF(actb, bf16_t, (size_t)4 * M * FF) CARVEF(yb, bf16_t, (size_t)4 * M * D)
    f.hb1 = p.hb1; f.hb2 = p.hb2; f.mixb = p.mixb; p.ybn = f.yb; p.attf = nullptr;
    const int nl = CHECK_GEMM ? 1 : DEPTH;
    CARVEF(w_in_t, bf16_t, (size_t)nl * INC_PAD * D) CARVEF(w_out_t, bf16_t, (size_t)nl * D * MIXW) CARVEF(gu_t, bf16_t, (size_t)nl * NE * 2 * FF * D) CARVEF(d_t, bf16_t, (size_t)nl * NE * D * FF)
#if CHECK_GEMM
    CARVE(act, float, (size_t)M * 4 * FF) CARVE(down, float, (size_t)M * 4 * D)
    f.proj2 = p.qraw; f.mix2 = p.qraw + (size_t)M * INC;
#else
    p.act = nullptr; p.down = nullptr; f.proj2 = nullptr; f.mix2 = nullptr;
#endif
#undef CARVE
#undef CARVEF
    return (size_t)(cur - base) <= ws_size;
}
extern "C" void kernel_launch(void* const* d_in, const int* in_sizes, int n_in, void* d_out, int out_size, void* d_ws, size_t ws_size, hipStream_t stream) {
    KArgs a{};
    if (n_in < 32 || !setup_params(a.p, a.f, a.bar, d_in, d_out, d_ws, ws_size)) return;
    static int grid = 0;
    if (!grid) { int dev = 0, cus = 0, per_cu = 0; (void)hipGetDevice(&dev); (void)hipDeviceGetAttribute(&cus, hipDeviceAttributeMultiprocessorCount, dev);
        (void)hipFuncSetAttribute((const void*)k_mega, hipFuncAttributeMaxDynamicSharedMemorySize, LDS_BYTES);
        (void)hipOccupancyMaxActiveBlocksPerMultiprocessor(&per_cu, k_mega, 512, LDS_BYTES); grid = cus * (per_cu < 1 ? per_cu : 1); }
    if (grid <= 0) return;
    (void)hipMemsetAsync(a.bar, 0, XCD_BAR_WORDS * sizeof(unsigned), stream);
    hipLaunchKernelGGL(k_mega, dim3(grid), dim3(512), LDS_BYTES, stream, a);
}
```

```cpp
#include <hip/hip_runtime.h>
#include <stdint.h>

#ifndef NAIVE_H
#define NAIVE_H
#include <math.h>
#ifdef HOST_TEST
#define HD inline
#define HDC inline
#define ATOMIC_INC(p) ((*(p))++)
#define UNIFORM(x) (x)
#else
#define HD __device__ __forceinline__
#define HDC __host__ __device__ __forceinline__
#define ATOMIC_INC(p) atomicAdd((p), 1)
#define UNIFORM(x) __builtin_amdgcn_readfirstlane(x)
#endif

#ifndef CFG_D
#define CFG_D 1024
#define CFG_SEQ 16384
#define CFG_CTX 256
#define CFG_FF 1024
#define CFG_DEPTH 4
#endif
constexpr int D = CFG_D, SEQ = CFG_SEQ, CTX = CFG_CTX, FF = CFG_FF, DEPTH = CFG_DEPTH;
constexpr int M = CTX + SEQ;
constexpr int GRID_W = 64;
constexpr int NH = 6, QKD = 96, NOPE = 64, ROPE = 32, VD = 64, QL = 256, KVL = 128;
constexpr int SH = 6, SP = 64, SW = 384, SG = 2, SN = 64, CONVD = 640, CHUNK = 128;
constexpr int PW = 256, MIXW = 1024, INC = 1708;
constexpr int C_Q = 0, C_KV = 256, C_KR = 384, C_Z = 416, C_XBC = 800, C_DT = 1440, C_POOL = 1452;
constexpr int NE = 32, TOPK = 4;
constexpr int NCH = M / CHUNK;
constexpr float EPS = 1e-6f;

typedef unsigned short bf16_t;
HD bf16_t f2bf(float f) { union { float f; unsigned u; } v; v.f = f; unsigned u = v.u; u += 0x7FFFu + ((u >> 16) & 1u); return (bf16_t)(u >> 16); }
HD float bf2f(bf16_t b) { union { float f; unsigned u; } v; v.u = ((unsigned)b) << 16; return v.f; }
struct P {
    const float *x, *c, *ctx, *c_ctx, *norm1_g, *norm2_g, *mod_w, *mod_b, *w_in, *q_g, *kv_g, *w_uq, *w_ukv, *qn_g, *kn_g;
    const float *conv_w, *conv_b, *a_log, *dt_bias, *ssd_d, *ssd_norm_g, *pool_w, *pool_scale, *w_out, *router_w, *router_b;
    const float *wg, *bg, *wu, *bu, *wd, *bd;
    float* out;
    float *xres, *mod, *rs, *h, *proj, *qln, *kvln, *qraw, *kvraw, *q, *k, *v, *mixin, *xbc, *dt, *ydir, *poolp, *mix, *logits, *topw, *act, *down;
    int *topi, *cnt, *list;
    bf16_t *qb, *kb, *vb;
    float *attf, *diag;
    float *cs, *cdec, *gmat, *st;
    bf16_t *hb1, *hb2, *mixb, *ybn;
};

HD float siluf(float x) { return x / (1.0f + expf(-x)); }
HD float sigmf(float x) { return 1.0f / (1.0f + expf(-x)); }
HD float softplusf(float x) { return x > 20.0f ? x : log1pf(expf(x)); }
HD const float* modv(const P& p, int l, int r, int j) { return p.mod + ((size_t)(l * 2 + (r < CTX ? 1 : 0)) * 6 + j) * D; }

enum { OP_COPY_IN = 0, OP_MODVEC, OP_ROWSTAT, OP_NORM1, OP_INPROJ, OP_LATNORM, OP_QRAW, OP_KVRAW, OP_QHEAD, OP_KHEAD, OP_ATTN, OP_CONV, OP_DT, OP_SSDSCAN, OP_SSDFIN,
       OP_POOLP, OP_POOLMM, OP_OUTPROJ, OP_RES1, OP_NORM2, OP_LOGITS, OP_ZEROCNT, OP_TOPK, OP_GATEUP, OP_DOWN, OP_COMBINE, OP_WRITE_OUT, OP_MIXB, OP_COMBINE2, OP_SSD_CS, OP_SSD_G, OP_SSD_YD, OP_SSD_ST, OP_SSD_CARRY, OP_SSD_YOFF, OP_COUNT };

HDC long op_count(int op) {
    switch (op) {
        case OP_COPY_IN: return (long)M * D;
        case OP_MODVEC: return (long)DEPTH * 2 * 6 * D;
        case OP_ROWSTAT: return M;
        case OP_NORM1: case OP_NORM2: return (long)M * D;
        case OP_INPROJ: return (long)(M / 8) * INC;
        case OP_LATNORM: return 2L * M;
        case OP_QRAW: return (long)(M / 8) * (NH * QKD);
        case OP_KVRAW: return (long)(M / 8) * (NH * 128);
        case OP_QHEAD: case OP_KHEAD: return (long)M * NH;
        case OP_ATTN: return (long)M * NH;
        case OP_CONV: return (long)M * CONVD;
        case OP_DT: return (long)M * 12;
        case OP_SSDSCAN: return 2L * SH * SP;
        case OP_SSDFIN: return M;
        case OP_POOLP: return (long)M * PW;
        case OP_POOLMM: return (long)M * PW;
        case OP_OUTPROJ: return (long)(M / 8) * D;
        case OP_RES1: return (long)M * D;
        case OP_LOGITS: return (long)M * NE;
        case OP_ZEROCNT: return NE;
        case OP_TOPK: return M;
        case OP_GATEUP: return (long)NE * (M / 8) * FF;
        case OP_DOWN: return (long)NE * (M / 8) * D;
        case OP_COMBINE: return (long)M * D;
        case OP_WRITE_OUT: return (long)SEQ * D;
        case OP_MIXB: return (long)M * MIXW;
        case OP_COMBINE2: return (long)M * D;
        case OP_SSD_CS: return 2L * NCH * SH;
        case OP_SSD_G: return (long)M * SG * CHUNK;
        case OP_SSD_YD: return (long)M * SW;
        case OP_SSD_ST: return 2L * NCH * SH * SP * SN;
        case OP_SSD_CARRY: return 2L * SH * SP * SN;
        case OP_SSD_YOFF: return (long)M * SW;
    }
    return 0;
}

HD void gemm8(const float* A, int lda, const float* B, int ldb, const float* bias, float* C, int ldc, int N, int K, long idx) {
    const int j = (int)(idx % N); const long r0 = (idx / N) * 8;
    float acc[8];
#pragma unroll
    for (int i = 0; i < 8; ++i) acc[i] = 0.f;
    const float* a = A + r0 * lda;
    for (int k = 0; k < K; ++k) {
        const float b = B[(size_t)k * ldb + j];
#pragma unroll
        for (int i = 0; i < 8; ++i) acc[i] += a[(size_t)i * lda + k] * b;
    }
    const float bv = bias ? bias[j] : 0.f;
#pragma unroll
    for (int i = 0; i < 8; ++i) C[(r0 + i) * ldc + j] = acc[i] + bv;
}

HD void sincos_rr(float angf, float& cs, float& sn) {
    const double x = (double)angf; const double n = rint(x * 0.63661977236758134308); const double y = (x - n * 1.57079632679489655800) - n * 6.123233995736766e-17; const double y2 = y * y;
    const double s = y * (1.0 + y2 * (-1.0 / 6 + y2 * (1.0 / 120 + y2 * (-1.0 / 5040 + y2 * (1.0 / 362880 + y2 * (-1.0 / 39916800))))));
    const double c = 1.0 + y2 * (-0.5 + y2 * (1.0 / 24 + y2 * (-1.0 / 720 + y2 * (1.0 / 40320 + y2 * (-1.0 / 3628800 + y2 * (1.0 / 479001600))))));
    const int q = ((int)n) & 3; const double cc = (q == 0) ? c : (q == 1) ? -s : (q == 2) ? -c : s; const double ss = (q == 0) ? s : (q == 1) ? c : (q == 2) ? -s : -c;
    cs = (float)cc; sn = (float)ss;
}
HD float rope_inv_freq(int f) { return f == 0 ? 1.0f : f == 1 ? 0.31622776f : f == 2 ? 0.1f : f == 3 ? 0.031622775f : f == 4 ? 0.01f : f == 5 ? 0.0031622776f : f == 6 ? 0.001f : 0.00031622776f; }
HD void rope_apply(float* v32, int t) {
    const float row = (float)(t / GRID_W), col = (float)(t % GRID_W);
#pragma unroll
    for (int a = 0; a < 2; ++a)
#pragma unroll
        for (int f = 0; f < 8; ++f) {
            const float ang = (a == 0 ? row : col) * rope_inv_freq(f);
            float cs, sn; sincos_rr(ang, cs, sn);
            const float x1 = v32[a * 16 + f], x2 = v32[a * 16 + 8 + f];
            v32[a * 16 + f] = x1 * cs - x2 * sn; v32[a * 16 + 8 + f] = x2 * cs + x1 * sn;
        }
}

HD void op_run(int op, const P& p, int l, long idx) {
    switch (op) {
    case OP_COPY_IN: { const long r = idx / D; const int c = (int)(idx % D); p.xres[idx] = r < CTX ? p.ctx[idx] : p.x[(r - CTX) * D + c]; } break;
    case OP_MODVEC: {
        const int j = (int)(idx % (6 * D)); const int which = (int)((idx / (6 * D)) % 2); const int ll = (int)(idx / (12 * D));
        const float* cv = which ? p.c_ctx : p.c; float s = 0.f;
        for (int k = 0; k < D; ++k) s += siluf(cv[k]) * p.mod_w[((size_t)ll * D + k) * (6 * D) + j];
        p.mod[idx] = s + p.mod_b[(size_t)ll * 6 * D + j];
    } break;
    case OP_ROWSTAT: { const float* xr = p.xres + idx * D; float s = 0.f; for (int k = 0; k < D; ++k) s += xr[k] * xr[k]; p.rs[idx] = 1.0f / sqrtf(s / D + EPS); } break;
    case OP_NORM1: case OP_NORM2: { const int r = (int)(idx / D), c = (int)(idx % D); const int o = op == OP_NORM1 ? 0 : 3;
        const float g = (op == OP_NORM1 ? p.norm1_g : p.norm2_g)[l * D + c];
        const float hv = p.xres[idx] * p.rs[r] * g * (1.0f + modv(p, l, r, o + 1)[c]) + modv(p, l, r, o)[c]; p.h[idx] = hv;
        bf16_t* hb = op == OP_NORM1 ? p.hb1 : p.hb2; if (hb) hb[idx] = f2bf(hv); } break;
    case OP_INPROJ: gemm8(p.h, D, p.w_in + (size_t)l * D * INC, INC, nullptr, p.proj, INC, INC, D, idx); break;
    case OP_LATNORM: {
        const int which = idx >= M; const long r = which ? idx - M : idx; const int n = which ? KVL : QL; const float* src = p.proj + r * INC + (which ? C_KV : C_Q);
        float s = 0.f; for (int k = 0; k < n; ++k) s += src[k] * src[k]; const float rs = 1.0f / sqrtf(s / n + EPS);
        float* dst = which ? p.kvln + r * KVL : p.qln + r * QL; const float* g = which ? p.kv_g + l * KVL : p.q_g + l * QL;
        for (int k = 0; k < n; ++k) dst[k] = src[k] * rs * g[k];
    } break;
    case OP_QRAW: gemm8(p.qln, QL, p.w_uq + (size_t)l * QL * (NH * QKD), NH * QKD, nullptr, p.qraw, NH * QKD, NH * QKD, QL, idx); break;
    case OP_KVRAW: gemm8(p.kvln, KVL, p.w_ukv + (size_t)l * KVL * (NH * 128), NH * 128, nullptr, p.kvraw, NH * 128, NH * 128, KVL, idx); break;
    case OP_QHEAD: { const int r = (int)(idx / NH), hh = (int)(idx % NH); const float* src = p.qraw + (size_t)r * (NH * QKD) + hh * QKD; float s = 0.f;
        for (int d = 0; d < QKD; ++d) s += src[d] * src[d]; const float rs = 1.0f / sqrtf(s / QKD + EPS);
        float* dst = p.q + ((size_t)r * NH + hh) * QKD; float rp[32];
        for (int d = 0; d < NOPE; ++d) dst[d] = src[d] * rs * p.qn_g[l * QKD + d];
#pragma unroll
        for (int d = 0; d < 32; ++d) rp[d] = src[NOPE + d] * rs * p.qn_g[l * QKD + NOPE + d];
        if (r >= CTX) rope_apply(rp, r - CTX);
#pragma unroll
        for (int d = 0; d < 32; ++d) dst[NOPE + d] = rp[d];
        bf16_t* db = p.qb + ((size_t)r * NH + hh) * QKD;
        for (int d = 0; d < QKD; ++d) db[d] = f2bf(dst[d]);
    } break;
    case OP_KHEAD: { const int r = (int)(idx / NH), hh = (int)(idx % NH); const float* kn = p.kvraw + (size_t)r * (NH * 128) + hh * 128; const float* kr = p.proj + (size_t)r * INC + C_KR; float s = 0.f;
        for (int d = 0; d < NOPE; ++d) s += kn[d] * kn[d];
        for (int d = 0; d < ROPE; ++d) s += kr[d] * kr[d];
        const float rs = 1.0f / sqrtf(s / QKD + EPS);
        float* dst = p.k + ((size_t)r * NH + hh) * QKD; float rp[32];
        for (int d = 0; d < NOPE; ++d) dst[d] = kn[d] * rs * p.kn_g[l * QKD + d];
#pragma unroll
        for (int d = 0; d < 32; ++d) rp[d] = kr[d] * rs * p.kn_g[l * QKD + NOPE + d];
        if (r >= CTX) rope_apply(rp, r - CTX);
#pragma unroll
        for (int d = 0; d < 32; ++d) dst[NOPE + d] = rp[d];
        float* vd = p.v + ((size_t)r * NH + hh) * VD;
        for (int d = 0; d < VD; ++d) vd[d] = kn[NOPE + d];
        bf16_t* db = p.kb + ((size_t)r * NH + hh) * QKD; bf16_t* vdb = p.vb + ((size_t)r * NH + hh) * VD;
        for (int d = 0; d < QKD; ++d) db[d] = f2bf(dst[d]);
        for (int d = 0; d < VD; ++d) vdb[d] = f2bf(kn[NOPE + d]);
    } break;
    case OP_ATTN: {
        const int r = (int)(idx % M), hh = UNIFORM((int)(idx / M)); const int nk = r < CTX ? CTX : M;
        float qv[QKD];
        const float* qp = p.q + ((size_t)r * NH + hh) * QKD; const float scale = 1.0f / sqrtf((float)QKD);
#pragma unroll
        for (int d = 0; d < QKD; ++d) qv[d] = qp[d] * scale;
        for (int half = 0; half < 2; ++half) {
            float o[32];
#pragma unroll
            for (int d = 0; d < 32; ++d) o[d] = 0.f;
            float mx = -1e30f, lsum = 0.f;
            for (int kk = 0; kk < nk; ++kk) {
                const float* kp = p.k + ((size_t)kk * NH + hh) * QKD; const float* vp = p.v + ((size_t)kk * NH + hh) * VD + half * 32; float s = 0.f;
#pragma unroll
                for (int d = 0; d < QKD; ++d) s += qv[d] * kp[d];
                const float mn = s > mx ? s : mx; const float corr = expf(mx - mn), pe = expf(s - mn);
                lsum = lsum * corr + pe; mx = mn;
#pragma unroll
                for (int d = 0; d < 32; ++d) o[d] = o[d] * corr + pe * vp[d];
            }
            const float inv = 1.0f / lsum; float* dst = p.mixin + (size_t)r * MIXW + hh * VD + half * 32;
#pragma unroll
            for (int d = 0; d < 32; ++d) dst[d] = o[d] * inv;
        }
    } break;
    case OP_CONV: { const int r = (int)(idx / CONVD), c = (int)(idx % CONVD); const int seg0 = r < CTX ? 0 : CTX, n = r < CTX ? CTX : SEQ, t = r - seg0; float y = p.conv_b[l * CONVD + c];
#pragma unroll
        for (int j = 0; j < 4; ++j) { const int tt = t - 2 + j; if (tt >= 0 && tt < n) y += p.conv_w[((size_t)l * 4 + j) * CONVD + c] * p.proj[(size_t)(seg0 + tt) * INC + C_XBC + c]; }
        p.xbc[idx] = siluf(y); } break;
    case OP_DT: { const int r = (int)(idx / 12), j = (int)(idx % 12); p.dt[idx] = softplusf(p.proj[(size_t)r * INC + C_DT + j] + p.dt_bias[l * 12 + j]); } break;
    case OP_SSDSCAN: {
        const int pp = (int)(idx % SP), hh = UNIFORM((int)((idx / SP) % SH)), dir = UNIFORM((int)(idx / (SP * SH))); const int g = hh / (SH / SG);
        const float a = -expf(p.a_log[l * 12 + dir * 6 + hh]); float st[SN];
#pragma unroll
        for (int n = 0; n < SN; ++n) st[n] = 0.f;
        for (int step = 0; step < M; ++step) {
            const int r = dir == 0 ? step : (step < CTX ? CTX - 1 - step : M - 1 - (step - CTX));
            const float dtv = p.dt[(size_t)r * 12 + dir * 6 + hh]; const float dA = expf(dtv * a); const float xv = p.xbc[(size_t)r * CONVD + hh * SP + pp] * dtv;
            const float* Bp = p.xbc + (size_t)r * CONVD + SW + g * SN; const float* Cp = p.xbc + (size_t)r * CONVD + SW + SG * SN + g * SN; float y = 0.f;
#pragma unroll
            for (int n = 0; n < SN; ++n) { st[n] = st[n] * dA + xv * Bp[n]; y += st[n] * Cp[n]; }
            p.ydir[((size_t)dir * M + r) * SW + hh * SP + pp] = y;
        }
    } break;
    case OP_SSDFIN: { const long r = idx; float ss = 0.f;
        for (int c = 0; c < SW; ++c) { const float y = p.ydir[r * SW + c] + p.ydir[((size_t)M + r) * SW + c] + p.ssd_d[l * SH + c / SP] * p.xbc[r * CONVD + c]; const float gv = y * siluf(p.proj[r * INC + C_Z + c]); ss += gv * gv; }
        const float rs = 1.0f / sqrtf(ss / SW + EPS);
        for (int c = 0; c < SW; ++c) { const float y = p.ydir[r * SW + c] + p.ydir[((size_t)M + r) * SW + c] + p.ssd_d[l * SH + c / SP] * p.xbc[r * CONVD + c]; const float gv = y * siluf(p.proj[r * INC + C_Z + c]);
            p.mixin[r * MIXW + NH * VD + c] = gv * rs * p.ssd_norm_g[l * SW + c]; }
    } break;
    case OP_POOLP: { const int r = (int)(idx / PW), c = (int)(idx % PW); const int gi = c / 64; const int win = 2 << gi; const int seg0 = r < CTX ? 0 : CTX, n = r < CTX ? CTX : SEQ, t = r - seg0;
        int lo = t - win / 2, hi = t - win / 2 + win; lo = lo < 0 ? 0 : lo; hi = hi > n ? n : hi; float s = 0.f;
        for (int tt = lo; tt < hi; ++tt) s += p.proj[(size_t)(seg0 + tt) * INC + C_POOL + c];
        p.poolp[idx] = s / (float)(hi - lo) - p.proj[(size_t)r * INC + C_POOL + c]; } break;
    case OP_POOLMM: { const int r = (int)(idx / PW), c = (int)(idx % PW); const int gi = c / 64, d = c % 64; float s = 0.f;
        for (int cc = 0; cc < 64; ++cc) s += p.poolp[(size_t)r * PW + gi * 64 + cc] * p.pool_w[(((size_t)l * 4 + gi) * 64 + cc) * 64 + d];
        p.mixin[(size_t)r * MIXW + NH * VD + SW + c] = s * p.pool_scale[l * PW + c]; } break;
    case OP_OUTPROJ: gemm8(p.mixin, MIXW, p.w_out + (size_t)l * MIXW * D, D, nullptr, p.mix, D, D, MIXW, idx); break;
    case OP_RES1: { const int r = (int)(idx / D), c = (int)(idx % D); p.xres[idx] += modv(p, l, r, 2)[c] * p.mix[idx]; } break;
    case OP_LOGITS: { const int r = (int)(idx / NE), e = (int)(idx % NE); const float* hr = p.h + (size_t)r * D; float s = 0.f;
        for (int k = 0; k < D; ++k) s += hr[k] * p.router_w[((size_t)l * D + k) * NE + e];
        p.logits[idx] = s + p.router_b[l * NE + e]; } break;
    case OP_ZEROCNT: p.cnt[idx] = 0; break;
    case OP_TOPK: { const long t = idx; float lg[NE];
#pragma unroll
        for (int e = 0; e < NE; ++e) lg[e] = p.logits[t * NE + e];
        int sel[4]; float sv[4];
#pragma unroll
        for (int kk = 0; kk < 4; ++kk) { float best = -3.0e38f; int bi = 0;
#pragma unroll
            for (int e = 0; e < NE; ++e) { bool taken = false;
#pragma unroll
                for (int q = 0; q < kk; ++q) taken = taken || (sel[q] == e);
                if (!taken && lg[e] > best) { best = lg[e]; bi = e; } }
            sel[kk] = bi; sv[kk] = best; }
        float es[4], sum = 0.f;
#pragma unroll
        for (int kk = 0; kk < 4; ++kk) { es[kk] = expf(sv[kk] - sv[0]); sum += es[kk]; }
#pragma unroll
        for (int kk = 0; kk < 4; ++kk) { p.topi[t * 4 + kk] = sel[kk]; p.topw[t * 4 + kk] = es[kk] / sum; const int pos = ATOMIC_INC(&p.cnt[sel[kk]]); p.list[(size_t)sel[kk] * M + pos] = (int)(t * 4 + kk); }
    } break;
    case OP_GATEUP: {
        const int j = (int)(idx % FF); const long rest = idx / FF; const int rb = (int)(rest % (M / 8)), e = (int)(rest / (M / 8)); const int cnt = p.cnt[e]; if (rb * 8 >= cnt) break;
        int a[8]; float g[8], u[8];
#pragma unroll
        for (int i = 0; i < 8; ++i) { a[i] = rb * 8 + i < cnt ? p.list[(size_t)e * M + rb * 8 + i] : -1; g[i] = 0.f; u[i] = 0.f; }
        const float* wgp = p.wg + ((size_t)l * NE + e) * D * FF + j; const float* wup = p.wu + ((size_t)l * NE + e) * D * FF + j;
        for (int k = 0; k < D; ++k) { const float gw = wgp[(size_t)k * FF], uw = wup[(size_t)k * FF];
#pragma unroll
            for (int i = 0; i < 8; ++i) { const float xv = p.h[(size_t)(a[i] < 0 ? 0 : a[i] / 4) * D + k]; g[i] += xv * gw; u[i] += xv * uw; } }
        const float bgv = p.bg[((size_t)l * NE + e) * FF + j], buv = p.bu[((size_t)l * NE + e) * FF + j];
#pragma unroll
        for (int i = 0; i < 8; ++i) if (a[i] >= 0) { float gv = g[i] + bgv; gv = gv < 7.0f ? gv : 7.0f; float uv = u[i] + buv; uv = uv < -7.0f ? -7.0f : (uv > 7.0f ? 7.0f : uv);
            p.act[(size_t)a[i] * FF + j] = gv * sigmf(1.702f * gv) * (uv + 1.0f); }
    } break;
    case OP_DOWN: {
        const int j = (int)(idx % D); const long rest = idx / D; const int rb = (int)(rest % (M / 8)), e = (int)(rest / (M / 8)); const int cnt = p.cnt[e]; if (rb * 8 >= cnt) break;
        int a[8]; float o[8];
#pragma unroll
        for (int i = 0; i < 8; ++i) { a[i] = rb * 8 + i < cnt ? p.list[(size_t)e * M + rb * 8 + i] : -1; o[i] = 0.f; }
        const float* wdp = p.wd + ((size_t)l * NE + e) * FF * D + j;
        for (int k = 0; k < FF; ++k) { const float w = wdp[(size_t)k * D];
#pragma unroll
            for (int i = 0; i < 8; ++i) o[i] += p.act[(size_t)(a[i] < 0 ? 0 : a[i]) * FF + k] * w; }
        const float bv = p.bd[((size_t)l * NE + e) * D + j];
#pragma unroll
        for (int i = 0; i < 8; ++i) if (a[i] >= 0) p.down[(size_t)a[i] * D + j] = o[i] + bv;
    } break;
    case OP_COMBINE: { const int r = (int)(idx / D), c = (int)(idx % D); float s = 0.f;
#pragma unroll
        for (int kk = 0; kk < 4; ++kk) s += p.topw[(size_t)r * 4 + kk] * p.down[((size_t)r * 4 + kk) * D + c];
        p.xres[idx] += modv(p, l, r, 5)[c] * s; } break;
    case OP_WRITE_OUT: p.out[idx] = p.xres[(size_t)CTX * D + idx]; break;
    case OP_MIXB: p.mixb[idx] = f2bf(p.mixin[idx]); break;
    case OP_SSD_CS: {
        const int hh = (int)(idx % SH), c = (int)((idx / SH) % NCH), dir = (int)(idx / (SH * NCH)); const float a = -expf(p.a_log[l * 12 + dir * 6 + hh]); float acc = 0.f;
        for (int i = 0; i < CHUNK; ++i) { const int r = c * CHUNK + (dir == 0 ? i : CHUNK - 1 - i); acc += p.dt[(size_t)r * 12 + dir * 6 + hh] * a; p.cs[((size_t)dir * M + r) * SH + hh] = acc; }
        p.cdec[idx] = expf(acc);
    } break;
    case OP_SSD_G: {
        const int s = (int)(idx % CHUNK), g = (int)((idx / CHUNK) % SG), r = (int)(idx / (CHUNK * SG)); const int r2 = (r / CHUNK) * CHUNK + s;
        const float* Cp = p.xbc + (size_t)r * CONVD + SW + SG * SN + g * SN; const float* Bp = p.xbc + (size_t)r2 * CONVD + SW + g * SN; float acc = 0.f;
        for (int n = 0; n < SN; ++n) acc += Cp[n] * Bp[n];
        p.gmat[idx] = acc;
    } break;
    case OP_SSD_YD: {
        const int cc = (int)(idx % SW), r = (int)(idx / SW); const int hh = cc / SP, g = hh / (SH / SG); const int c0 = (r / CHUNK) * CHUNK, lpos = r - c0;
        const float* G = p.gmat + ((size_t)r * SG + g) * CHUNK; const float csf = p.cs[(size_t)r * SH + hh], csb = p.cs[((size_t)M + r) * SH + hh]; float y = 0.f;
        for (int s = 0; s <= lpos; ++s) { const int r2 = c0 + s; y += G[s] * expf(csf - p.cs[(size_t)r2 * SH + hh]) * p.dt[(size_t)r2 * 12 + hh] * p.xbc[(size_t)r2 * CONVD + cc]; }
        for (int s = lpos; s < CHUNK; ++s) { const int r2 = c0 + s; y += G[s] * expf(csb - p.cs[((size_t)M + r2) * SH + hh]) * p.dt[(size_t)r2 * 12 + 6 + hh] * p.xbc[(size_t)r2 * CONVD + cc]; }
        p.ydir[idx] = y;
    } break;
    case OP_SSD_ST: {
        const int n = (int)(idx % SN), pp = (int)((idx / SN) % SP), hh = (int)((idx / (SN * SP)) % SH), c = (int)((idx / (SN * SP * SH)) % NCH), dir = (int)(idx / ((long)SN * SP * SH * NCH)); const int g = hh / (SH / SG);
        const int rend = c * CHUNK + (dir == 0 ? CHUNK - 1 : 0); const float cse = p.cs[((size_t)dir * M + rend) * SH + hh]; float acc = 0.f;
        for (int i = 0; i < CHUNK; ++i) { const int r = c * CHUNK + i; acc += p.xbc[(size_t)r * CONVD + SW + g * SN + n] * expf(cse - p.cs[((size_t)dir * M + r) * SH + hh]) * p.dt[(size_t)r * 12 + dir * 6 + hh] * p.xbc[(size_t)r * CONVD + hh * SP + pp]; }
        p.st[idx] = acc;
    } break;
    case OP_SSD_CARRY: {
        const int e = (int)(idx % (SP * SN)), hh = (int)((idx / (SP * SN)) % SH), dir = (int)(idx / ((long)SP * SN * SH)); float state = 0.f;
        for (int i = 0; i < NCH; ++i) { const int c = dir == 0 ? i : (i < CTX / CHUNK ? CTX / CHUNK - 1 - i : NCH - 1 - (i - CTX / CHUNK));
            const size_t o = (((size_t)dir * NCH + c) * SH + hh) * (SP * SN) + e; const float stc = p.st[o]; p.st[o] = state; state = state * p.cdec[((size_t)dir * NCH + c) * SH + hh] + stc; }
    } break;
    case OP_SSD_YOFF: {
        const int cc = (int)(idx % SW), r = (int)(idx / SW); const int hh = cc / SP, pp = cc % SP, g = hh / (SH / SG), c = r / CHUNK; const float* Cp = p.xbc + (size_t)r * CONVD + SW + SG * SN + g * SN;
        float y = 0.f;
#pragma unroll
        for (int dir = 0; dir < 2; ++dir) { const float* pv = p.st + ((((size_t)dir * NCH + c) * SH + hh) * SP + pp) * SN; float acc = 0.f;
            for (int n = 0; n < SN; ++n) acc += Cp[n] * pv[n];
            y += acc * expf(p.cs[((size_t)dir * M + r) * SH + hh]); }
        p.ydir[(size_t)M * SW + idx] = y;
    } break;
    case OP_COMBINE2: { const int r = (int)(idx / D), c = (int)(idx % D); float s = 0.f;
#pragma unroll
        for (int kk = 0; kk < 4; ++kk) s += p.topw[(size_t)r * 4 + kk] * bf2f(p.ybn[((size_t)r * 4 + kk) * D + c]);
        p.xres[idx] += modv(p, l, r, 5)[c] * s; } break;
    }
}

static const int LAYER_OPS[] = { OP_ROWSTAT, OP_NORM1, OP_INPROJ, OP_LATNORM, OP_QRAW, OP_KVRAW, OP_QHEAD, OP_KHEAD, OP_ATTN, OP_CONV, OP_DT, OP_SSDSCAN, OP_SSDFIN, OP_POOLP, OP_POOLMM,
                                 OP_OUTPROJ, OP_RES1, OP_ROWSTAT, OP_NORM2, OP_LOGITS, OP_ZEROCNT, OP_TOPK, OP_GATEUP, OP_DOWN, OP_COMBINE };
constexpr int N_LAYER_OPS = sizeof(LAYER_OPS) / sizeof(int);
#endif

#define XB_TMO      128
#define XB_XCNT(j)  (256  + 64 * (j))
#define XB_XSUB(j)  (1280 + 64 * (j))
#define XB_XGEN(j)  (2304 + 64 * (j))
#define XB_TOP      3328
#define XB_TOPGEN   3392
#define XCD_BAR_WORDS 3456
#define XB_SPIN_CAP (1u << 22)
#define LAS __attribute__((address_space(3)))

__device__ __forceinline__ unsigned xb_ld(unsigned* p)              { return __hip_atomic_load(p, __ATOMIC_RELAXED, __HIP_MEMORY_SCOPE_AGENT); }
__device__ __forceinline__ unsigned xb_add(unsigned* p, unsigned v) { return __hip_atomic_fetch_add(p, v, __ATOMIC_RELAXED, __HIP_MEMORY_SCOPE_AGENT); }
__device__ __forceinline__ unsigned xb_xcc_id() { return (unsigned)__builtin_amdgcn_s_getreg((3 << 11) | 20) & 0xFu; }
#define XB_SPIN(cond, bar) do { unsigned _sp = 0; while (cond) { __builtin_amdgcn_s_sleep(1); \
    if ((++_sp & 255u) == 0u) { if (xb_ld(&(bar)[XB_TMO])) break; if (_sp > XB_SPIN_CAP) { atomicAdd(&(bar)[XB_TMO], 1u); break; } } } } while (0)

struct XcdBarrier {
    unsigned* bar; unsigned x;
    volatile LAS unsigned* st;
};

__device__ __forceinline__ XcdBarrier xcd_barrier_post(unsigned* bar, volatile LAS unsigned* st) {
    XcdBarrier b; b.bar = bar; b.x = xb_xcc_id(); b.st = st;
    if (threadIdx.x == 0) (void)xb_add(&bar[XB_XCNT(b.x)], 1u);
    return b;
}
__device__ __forceinline__ void xcd_barrier_complete(unsigned* bar, unsigned x, unsigned& nloc, unsigned& nx) {
    const unsigned G = gridDim.x * gridDim.y * gridDim.z;
    unsigned sum, cnt, mine, sp = 0u;
    for (;;) {
        sum = 0u; cnt = 0u; mine = 0u;
#pragma unroll
        for (unsigned j = 0; j < 16; ++j) { const unsigned c = xb_ld(&bar[XB_XCNT(j)]); sum += c; cnt += (c > 0u) ? 1u : 0u; mine = (j == x) ? c : mine; }
        if (sum == G) break;
        __builtin_amdgcn_s_sleep(1);
        if ((++sp & 255u) == 0u) { if (xb_ld(&bar[XB_TMO])) break; if (sp > XB_SPIN_CAP) { atomicAdd(&bar[XB_TMO], 1u); break; } }
    }
    nloc = mine > 0u ? mine : 1u; nx = cnt > 0u ? cnt : 1u;
}

__device__ __forceinline__ void xcd_barrier(const XcdBarrier& b) {
    asm volatile("s_waitcnt vmcnt(0)" ::: "memory");
    __syncthreads();
    if (threadIdx.x == 0) {
        unsigned* bar = b.bar;
        __builtin_amdgcn_s_waitcnt(0);
        unsigned nloc = b.st[0], nx = b.st[1];
        if (nloc == 0u) { unsigned xx = b.x; asm volatile("" : "+s"(xx));   xcd_barrier_complete(bar, xx, nloc, nx); b.st[0] = nloc; b.st[1] = nx; }
        const unsigned old = xb_add(&bar[XB_XSUB(b.x)], 1u);
        const unsigned gen = old / nloc;
        if (old + 1u == (gen + 1u) * nloc) {
            __builtin_amdgcn_fence(__ATOMIC_RELEASE, "agent");
            asm volatile("s_waitcnt vmcnt(0)" ::: "memory");
            const unsigned og = xb_add(&bar[XB_TOP], 1u);
            const unsigned tg = og / nx;
            if (og + 1u == (tg + 1u) * nx) xb_add(&bar[XB_TOPGEN], 1u);
            else XB_SPIN(xb_ld(&bar[XB_TOPGEN]) == tg, bar);
            __builtin_amdgcn_fence(__ATOMIC_ACQUIRE, "agent");
            xb_add(&bar[XB_XGEN(b.x)], 1u);
            asm volatile("s_waitcnt vmcnt(0)" ::: "memory");
        } else {
            XB_SPIN(xb_ld(&bar[XB_XGEN(b.x)]) == gen, bar);
            __builtin_amdgcn_fence(__ATOMIC_ACQUIRE, "agent");
            asm volatile("s_waitcnt vmcnt(0)" ::: "memory");
        }
    }
    __syncthreads();
}


namespace at {
typedef unsigned short bf16_t;
using bf16x8 = __attribute__((ext_vector_type(8))) short;
using s16x4  = __attribute__((ext_vector_type(4))) short;
using f32x16 = __attribute__((ext_vector_type(16))) float;
using u32x4  = __attribute__((ext_vector_type(4))) unsigned;
constexpr int DQ = 96, DV = 64, NW = 8, QBLK = 32, KVBLK = 64;
constexpr int LDQ = 6 * DQ, LDK = 6 * DQ, LDV = 6 * DV;
constexpr float SCALE = 0.10206207261596575f;
constexpr float THR = 8.f;
constexpr int KROW = 208;
constexpr int SHM_K = KVBLK * KROW, SHM_V = KVBLK * DV * 2;
constexpr int SHM_ATTN = 2 * SHM_V + 2 * SHM_K + NW * 64 * 4;
#define AT_SBAR() __builtin_amdgcn_sched_barrier(0)
__device__ __forceinline__ int crow(int r, int hi) { return (r & 3) + 8 * (r >> 2) + 4 * hi; }
__device__ __forceinline__ unsigned cvtpk(float lo, float hi) { unsigned r; asm volatile("v_cvt_pk_bf16_f32 %0, %1, %2" : "=v"(r) : "v"(lo), "v"(hi)); return r; }

__device__ __forceinline__ void partialSM(f32x16& p0, f32x16& p1, float& m_reg, float& mn, float& alpha) {
  constexpr float C = SCALE * 1.4426950408889634f;
  float pmax = p0[0];
#pragma unroll
  for (int r = 1; r < 16; ++r) pmax = fmaxf(pmax, p0[r]);
#pragma unroll
  for (int r = 0; r < 16; ++r) pmax = fmaxf(pmax, p1[r]);
  { auto rr = __builtin_amdgcn_permlane32_swap(__float_as_uint(pmax), __float_as_uint(pmax), false, false);
    pmax = fmaxf(__uint_as_float(rr[0]), __uint_as_float(rr[1])); }
  if (__builtin_expect(__all(pmax - m_reg <= THR / SCALE), 1)) { mn = m_reg; alpha = 1.f; }
  else { mn = fmaxf(m_reg, pmax); alpha = __builtin_amdgcn_exp2f((m_reg - mn) * C); m_reg = mn; }
  float mnC = -mn * C;
#pragma unroll
  for (int r = 0; r < 16; ++r) p0[r] = fmaf(p0[r], C, mnC);
#pragma unroll
  for (int r = 0; r < 16; ++r) p1[r] = fmaf(p1[r], C, mnC);
#pragma unroll
  for (int r = 0; r < 16; ++r) p0[r] = __builtin_amdgcn_exp2f(p0[r]);
}
__device__ __forceinline__ void finishSM(f32x16& p0, f32x16& p1, float alpha, float& l_reg, bf16x8& pa0, bf16x8& pa1, bf16x8& pa2, bf16x8& pa3) {
#pragma unroll
  for (int r = 0; r < 16; ++r) p1[r] = __builtin_amdgcn_exp2f(p1[r]);
  float ps = 0;
#pragma unroll
  for (int r = 0; r < 16; ++r) ps += p0[r];
#pragma unroll
  for (int r = 0; r < 16; ++r) ps += p1[r];
  { auto rr = __builtin_amdgcn_permlane32_swap(__float_as_uint(ps), __float_as_uint(ps), false, false);
    ps = __uint_as_float(rr[0]) + __uint_as_float(rr[1]); }
  l_reg = l_reg * alpha + ps;
#define AT_PK4(P, BASE, OUT) do { unsigned a0 = cvtpk(P[BASE + 0], P[BASE + 1]), a1 = cvtpk(P[BASE + 2], P[BASE + 3]);   \
    unsigned b0 = cvtpk(P[BASE + 4], P[BASE + 5]), b1 = cvtpk(P[BASE + 6], P[BASE + 7]);                              \
    auto r0 = __builtin_amdgcn_permlane32_swap(a0, b0, false, false); auto r1 = __builtin_amdgcn_permlane32_swap(a1, b1, false, false); \
    u32x4 w = {r0[0], r1[0], r0[1], r1[1]}; OUT = *reinterpret_cast<bf16x8*>(&w); } while (0)
  AT_PK4(p0, 0, pa0); AT_PK4(p0, 8, pa1); AT_PK4(p1, 0, pa2); AT_PK4(p1, 8, pa3);
#undef AT_PK4
}
__device__ __forceinline__ void qkt(f32x16& p0, f32x16& p1, const char* Ks, const bf16x8* qr, int r32, int hi) {
  p0 = f32x16{}; p1 = f32x16{};
#pragma unroll
  for (int d0 = 0; d0 < 6; ++d0) { const int cb = (d0 * 16 + hi * 8) * 2;
    bf16x8 b0 = *reinterpret_cast<const bf16x8*>(Ks + r32 * KROW + cb);
    bf16x8 b1 = *reinterpret_cast<const bf16x8*>(Ks + (32 + r32) * KROW + cb);
    p0 = __builtin_amdgcn_mfma_f32_32x32x16_bf16(b0, qr[d0], p0, 0, 0, 0);
    p1 = __builtin_amdgcn_mfma_f32_32x32x16_bf16(b1, qr[d0], p1, 0, 0, 0); }
}
__device__ __forceinline__ int v_st(int k, int c) { const int kk = (k & ~0xC) | ((k & 4) << 1) | ((k & 8) >> 1); return ((kk >> 3) * 2 + (c >> 5)) * 512 + ((kk & 7) * 32 + (c & 31)) * 2; }
__device__ __forceinline__ int v_rd_base(int lane) { return ((lane & 3) << 3) | (((lane >> 2) & 3) << 6) | (((lane >> 4) & 1) << 5) | (((lane >> 5) & 1) << 8); }
constexpr int v_rd_off(int d0, int ks, int half) { return d0 * 512 + ks * 2048 + half * 1024; }
template <int OFF> __device__ __forceinline__ s16x4 tr_read(int vb) {
  s16x4 r; asm volatile("ds_read_b64_tr_b16 %0, %1 offset:%2" : "=&v"(r) : "v"(vb), "i"(OFF) : "memory"); return r;
}
template <int D0> __device__ __forceinline__ void pv_one(f32x16& od, int vb, bf16x8 pa0, bf16x8 pa1, bf16x8 pa2, bf16x8 pa3) {
  const s16x4 l0 = tr_read<v_rd_off(D0, 0, 0)>(vb), h0 = tr_read<v_rd_off(D0, 0, 1)>(vb), l1 = tr_read<v_rd_off(D0, 1, 0)>(vb), h1 = tr_read<v_rd_off(D0, 1, 1)>(vb);
  const s16x4 l2 = tr_read<v_rd_off(D0, 2, 0)>(vb), h2 = tr_read<v_rd_off(D0, 2, 1)>(vb), l3 = tr_read<v_rd_off(D0, 3, 0)>(vb), h3 = tr_read<v_rd_off(D0, 3, 1)>(vb);
  asm volatile("s_waitcnt lgkmcnt(0)" ::: "memory"); AT_SBAR();
#define AT_PK(L, H) (bf16x8){L[0], L[1], L[2], L[3], H[0], H[1], H[2], H[3]}
  od = __builtin_amdgcn_mfma_f32_32x32x16_bf16(pa0, AT_PK(l0, h0), od, 0, 0, 0);
  od = __builtin_amdgcn_mfma_f32_32x32x16_bf16(pa1, AT_PK(l1, h1), od, 0, 0, 0);
  od = __builtin_amdgcn_mfma_f32_32x32x16_bf16(pa2, AT_PK(l2, h2), od, 0, 0, 0);
  od = __builtin_amdgcn_mfma_f32_32x32x16_bf16(pa3, AT_PK(l3, h3), od, 0, 0, 0);
#undef AT_PK
}
__device__ __forceinline__ void pv_d0(f32x16* o, int vb, bf16x8 pa0, bf16x8 pa1, bf16x8 pa2, bf16x8 pa3) {
  pv_one<0>(o[0], vb, pa0, pa1, pa2, pa3); pv_one<1>(o[1], vb, pa0, pa1, pa2, pa3);
}
__device__ __forceinline__ void attn_body(const bf16_t* __restrict__ Qb, const bf16_t* __restrict__ Kh, const bf16_t* __restrict__ Vh, float* __restrict__ Ob, int ldo, int seq, char* lds) {
  int tid = threadIdx.x; asm volatile("" : "+v"(tid));
  const int wid = tid >> 6, lane = tid & 63, r32 = lane & 31, hi = lane >> 5;
  char* V_lds = lds; char* K_lds = lds + 2 * SHM_V;
  float* ws = (float*)(lds + 2 * SHM_V + 2 * SHM_K) + wid * 64; float* li_l = ws; float* al_l = ws + 32;
  float m_reg = -1e30f, l_reg = 0; f32x16 o[2] = {}; bf16x8 qr[6];
  const bf16_t* Qw = Qb + (long)(wid * QBLK + r32) * LDQ + hi * 8;
#pragma unroll
  for (int d0 = 0; d0 < 6; ++d0) qr[d0] = *reinterpret_cast<const bf16x8*>(Qw + d0 * 16);
  const int kr0 = tid / 12, kc0 = tid % 12, c1 = 512 + (tid & 255), kr1 = c1 / 12, kc1 = c1 % 12, vr = tid >> 3, vc = (tid & 7) * 8;
  const bool k1on = tid < 256;
  const int kst0 = kr0 * KROW + kc0 * 16, kst1 = kr1 * KROW + kc1 * 16, vst = v_st(vr, vc);
  const long kg0 = (long)kr0 * LDK + kc0 * 8, kg1 = (long)kr1 * LDK + kc1 * 8, vg = (long)vr * LDV + vc;
  const int vb0 = (int)(uintptr_t)V_lds + v_rd_base(lane);
  struct { bf16x8 vs, ks0, ks1; } sr_[2];
#define AT_SLOAD(i, k0) do { sr_[i].vs = *reinterpret_cast<const bf16x8*>(Vh + (long)(k0) * LDV + vg); \
    sr_[i].ks0 = *reinterpret_cast<const bf16x8*>(Kh + (long)(k0) * LDK + kg0); sr_[i].ks1 = *reinterpret_cast<const bf16x8*>(Kh + (long)(k0) * LDK + kg1); } while (0)
#define AT_SWRITE(b, i) do { *(bf16x8*)(V_lds + (b) * SHM_V + vst) = sr_[i].vs; *(bf16x8*)(K_lds + (b) * SHM_K + kst0) = sr_[i].ks0; \
    if (k1on) *(bf16x8*)(K_lds + (b) * SHM_K + kst1) = sr_[i].ks1; } while (0)
#define AT_SWAIT() asm volatile("s_waitcnt vmcnt(3)" ::: "memory")
#define AT_RESC(a) do { if (__any((a) < 1.f)) { if (hi == 0) al_l[r32] = (a); asm volatile("s_waitcnt lgkmcnt(0)" ::: "memory"); \
    _Pragma("unroll") for (int d = 0; d < 2; ++d) _Pragma("unroll") for (int r = 0; r < 16; ++r) o[d][r] *= al_l[crow(r, hi)]; } } while (0)
  f32x16 pA0, pA1, pB0, pB1; float mnA, mnB, alA, alB; bf16x8 pa0, pa1, pa2, pa3; const int NT = seq / KVBLK;
  constexpr int SE = 0, SO = 1;
  AT_SLOAD(SE, 0); asm volatile("s_waitcnt vmcnt(0)" ::: "memory"); AT_SWRITE(0, SE); __syncthreads();
  qkt(pA0, pA1, K_lds, qr, r32, hi); partialSM(pA0, pA1, m_reg, mnA, alA);
  AT_SLOAD(SO, KVBLK); if (2 < NT) AT_SLOAD(SE, 2 * KVBLK);
  AT_SWAIT(); AT_SWRITE(1, SO); __syncthreads();
  for (int j = 1; j + 1 < NT; j += 2) {
    AT_SBAR(); qkt(pB0, pB1, K_lds + SHM_K, qr, r32, hi);
    finishSM(pA0, pA1, alA, l_reg, pa0, pa1, pa2, pa3); AT_SBAR();
    AT_SLOAD(SO, (j + 2) * KVBLK); AT_SBAR();
    pv_d0(o, vb0, pa0, pa1, pa2, pa3); partialSM(pB0, pB1, m_reg, mnB, alB);
    __syncthreads(); AT_SWAIT(); AT_SWRITE(0, SE);
    AT_RESC(alB); __syncthreads();
    AT_SBAR(); qkt(pA0, pA1, K_lds, qr, r32, hi);
    finishSM(pB0, pB1, alB, l_reg, pa0, pa1, pa2, pa3); AT_SBAR();
    if (j + 3 < NT) AT_SLOAD(SE, (j + 3) * KVBLK); AT_SBAR();
    pv_d0(o, vb0 + SHM_V, pa0, pa1, pa2, pa3); partialSM(pA0, pA1, m_reg, mnA, alA);
    __syncthreads(); AT_SWAIT(); AT_SWRITE(1, SO);
    AT_RESC(alA); __syncthreads();
  }
  AT_SBAR(); qkt(pB0, pB1, K_lds + SHM_K, qr, r32, hi);
  finishSM(pA0, pA1, alA, l_reg, pa0, pa1, pa2, pa3); AT_SBAR();
  pv_d0(o, vb0, pa0, pa1, pa2, pa3); partialSM(pB0, pB1, m_reg, mnB, alB);
  __syncthreads(); AT_RESC(alB);
  finishSM(pB0, pB1, alB, l_reg, pa0, pa1, pa2, pa3); AT_SBAR();
  pv_d0(o, vb0 + SHM_V, pa0, pa1, pa2, pa3);
  if (hi == 0) li_l[r32] = l_reg; asm volatile("s_waitcnt lgkmcnt(0)" ::: "memory");
  float rli[16];
#pragma unroll
  for (int r = 0; r < 16; ++r) rli[r] = __builtin_amdgcn_rcpf(li_l[crow(r, hi)]);
  float* Ow = Ob + (long)(wid * QBLK) * ldo;
#pragma unroll
  for (int r = 0; r < 16; ++r) { const int orow = crow(r, hi);
#pragma unroll
    for (int d0 = 0; d0 < 2; ++d0) Ow[(long)orow * ldo + d0 * 32 + r32] = o[d0][r] * rli[r]; }
#undef AT_SLOAD
#undef AT_SWRITE
#undef AT_SWAIT
#undef AT_RESC
}
}

namespace gm {
#define GM_LAS __attribute__((address_space(3)))
typedef unsigned short bf16_t;
typedef short bf16x8 __attribute__((ext_vector_type(8)));
typedef float f32x4 __attribute__((ext_vector_type(4)));
typedef unsigned u32x4 __attribute__((ext_vector_type(4)));
constexpr int BM = 256, BK = 64, HALF = 128, HTB = HALF * BK * 2, STAGE_BYTES = 8 * HTB;
__host__ __device__ __forceinline__ int lds_byte(int r, int c) { const int st = (r >> 4) * 2 + (c >> 5), rr = r & 15, cc = c & 31, ob = rr * 64 + cc * 2; return st * 1024 + (ob ^ (((ob >> 9) & 1) << 5)); }
__host__ __device__ __forceinline__ void stage_rc(int b, int& R, int& C) { const int st = b / 1024, sb = b % 1024, swz = sb ^ (((sb >> 9) & 1) << 5); R = (st >> 1) * 16 + swz / 64; C = (st & 1) * 32 + (swz % 64) / 2; }
__host__ __device__ __forceinline__ int perm32(int rho) { const int n = rho >> 4, i = rho & 15; return 8 * (i >> 2) + 4 * n + (i & 3); }
__device__ __forceinline__ unsigned cvt_pk_bf16(float lo, float hi) { unsigned r; asm volatile("v_cvt_pk_bf16_f32 %0, %1, %2" : "=v"(r) : "v"(lo), "v"(hi)); return r; }

template <bool PERM, class Epi>
__device__ __forceinline__ void gemm_unit(GM_LAS unsigned char* lds, const char* A, const unsigned (&offA)[2][2], const char* Bt, int K, const Epi& E) {
    int tid = threadIdx.x; asm volatile("" : "+v"(tid));
    const int wid = __builtin_amdgcn_readfirstlane(tid >> 6), lane = tid & 63, wr = wid >> 2, wc = wid & 3, fr = lane & 15, fq = lane >> 4;
    const int nt = K / BK;
    unsigned voffB[2];
#pragma unroll
    for (int i = 0; i < 2; ++i) { int R, C; stage_rc(tid * 16 + i * 8192, R, C); const int Rb = PERM ? ((R & ~31) + perm32(R & 31)) : R; voffB[i] = (unsigned)(Rb * K + C) * 2u; }
    const size_t kstep = (size_t)(BK * 2);
    const size_t hstep = (size_t)HALF * K * 2;
    const unsigned ldsw = (unsigned)wid * 1024u;
    const int aoff = lds_byte(wr * 64 + fr, fq * 8), boff = lds_byte(wc * 32 + fr, fq * 8);
#define GM_SA(b, h) (((b) * 2 + (h)) * HTB)
#define GM_SB(b, h) ((4 + (b) * 2 + (h)) * HTB)
#define GM_STAGEB(bufoff, gbase) do { _Pragma("unroll") for (int _i = 0; _i < 2; ++_i) \
        __builtin_amdgcn_global_load_lds((const unsigned*)((const char*)(gbase) + voffB[_i]), (GM_LAS unsigned*)(lds + (bufoff) + ldsw + _i * 8192), 16, 0, 0); } while (0)
#define GM_STAGEA(bufoff, h, kbyte) do { _Pragma("unroll") for (int _i = 0; _i < 2; ++_i) \
        __builtin_amdgcn_global_load_lds((const unsigned*)(A + (size_t)offA[h][_i] + (kbyte)), (GM_LAS unsigned*)(lds + (bufoff) + ldsw + _i * 8192), 16, 0, 0); } while (0)
#define GM_LDA(dst, b, h) do { _Pragma("unroll") for (int m = 0; m < 4; ++m) _Pragma("unroll") for (int k = 0; k < 2; ++k) dst[m][k] = *(const GM_LAS bf16x8*)(lds + GM_SA(b, h) + aoff + m * 2048 + k * 1024); } while (0)
#define GM_LDB(dst, b, h) do { _Pragma("unroll") for (int n = 0; n < 2; ++n) _Pragma("unroll") for (int k = 0; k < 2; ++k) dst[n][k] = *(const GM_LAS bf16x8*)(lds + GM_SB(b, h) + boff + n * 2048 + k * 1024); } while (0)
#define GM_MMA(ai, bj, At, Bt_) do { __builtin_amdgcn_s_setprio(1); _Pragma("unroll") for (int m = 0; m < 4; ++m) _Pragma("unroll") for (int n = 0; n < 2; ++n) _Pragma("unroll") for (int k = 0; k < 2; ++k) \
        acc[ai][bj][m][n] = __builtin_amdgcn_mfma_f32_16x16x32_bf16(Bt_[n][k], At[m][k], acc[ai][bj][m][n], 0, 0, 0); __builtin_amdgcn_s_setprio(0); } while (0)
#define GM_WAIT_V(n) asm volatile("s_waitcnt vmcnt(" #n ")" ::: "memory")
#define GM_WAIT_L(n) asm volatile("s_waitcnt lgkmcnt(" #n ")" ::: "memory")
#define GM_BAR __builtin_amdgcn_s_barrier()
#define GM_SCHED __builtin_amdgcn_sched_barrier(0)
    f32x4 acc[2][2][4][2];
#pragma unroll
    for (int a = 0; a < 2; ++a)
#pragma unroll
        for (int b = 0; b < 2; ++b)
#pragma unroll
            for (int m = 0; m < 4; ++m)
#pragma unroll
                for (int n = 0; n < 2; ++n) acc[a][b][m][n] = (f32x4){0.f, 0.f, 0.f, 0.f};
    bf16x8 At[4][2], B0[2][2], B1[2][2];
    const char* cB = Bt;
    GM_STAGEB(GM_SB(0, 0), cB); GM_STAGEA(GM_SA(0, 0), 0, 0); GM_STAGEB(GM_SB(0, 1), cB + hstep); GM_STAGEA(GM_SA(0, 1), 1, 0);
    if (wr == 1) GM_BAR;
    GM_WAIT_V(4); GM_BAR;
    GM_STAGEB(GM_SB(1, 0), cB + kstep); GM_STAGEA(GM_SA(1, 0), 0, kstep); GM_STAGEB(GM_SB(1, 1), cB + hstep + kstep);
    GM_WAIT_V(6); GM_BAR;
    for (int t = 0; t < nt; t += 2) {
        const bool last = (t == nt - 2);
        const size_t k1 = (size_t)(t + 1) * kstep;
        const size_t k2 = last ? 0 : (size_t)(t + 2) * kstep;
        const size_t k3 = k2 + kstep;
        const char* b2 = cB + k2; const char* b3 = cB + k3;
        GM_LDB(B0, 0, 0); GM_SCHED; GM_LDA(At, 0, 0); GM_STAGEA(GM_SA(1, 1), 1, k1);
        GM_WAIT_L(8); GM_BAR; GM_WAIT_L(0); GM_MMA(0, 0, At, B0); GM_BAR; GM_SCHED;
        GM_LDB(B1, 0, 1); GM_STAGEB(GM_SB(0, 0), b2);
        GM_BAR; GM_WAIT_L(0); GM_MMA(0, 1, At, B1); GM_BAR;
        GM_LDA(At, 0, 1); GM_STAGEA(GM_SA(0, 0), 0, k2);
        GM_BAR; GM_WAIT_L(0); GM_MMA(1, 0, At, B0); GM_BAR; GM_SCHED;
        GM_STAGEB(GM_SB(0, 1), b2 + hstep);
        GM_WAIT_V(6); GM_BAR; GM_MMA(1, 1, At, B1); GM_BAR;
        GM_LDB(B0, 1, 0); GM_SCHED; GM_LDA(At, 1, 0); GM_STAGEA(GM_SA(0, 1), 1, k2);
        GM_WAIT_L(8); GM_BAR; GM_WAIT_L(0); GM_MMA(0, 0, At, B0); GM_BAR; GM_SCHED;
        GM_LDB(B1, 1, 1); GM_STAGEB(GM_SB(1, 0), b3);
        GM_BAR; GM_WAIT_L(0); GM_MMA(0, 1, At, B1); GM_BAR;
        GM_LDA(At, 1, 1); GM_STAGEA(GM_SA(1, 0), 0, k3);
        GM_BAR; GM_WAIT_L(0); GM_MMA(1, 0, At, B0); GM_BAR; GM_SCHED;
        GM_STAGEB(GM_SB(1, 1), b3 + hstep);
        GM_WAIT_V(6); GM_BAR; GM_MMA(1, 1, At, B1); GM_BAR;
    }
    E(acc, wr, wc, fr, fq);
    GM_WAIT_V(0);
    if (wr == 0) GM_BAR;
    GM_BAR;
#undef GM_SA
#undef GM_SB
#undef GM_STAGEA
#undef GM_STAGEB
#undef GM_LDA
#undef GM_LDB
#undef GM_MMA
#undef GM_WAIT_V
#undef GM_WAIT_L
#undef GM_BAR
#undef GM_SCHED
}
__device__ __forceinline__ void dense_offA(unsigned (&offA)[2][2], long row0, int K) {
    int tid = threadIdx.x; asm volatile("" : "+v"(tid));
#pragma unroll
    for (int i = 0; i < 2; ++i) { int R, C; stage_rc(tid * 16 + i * 8192, R, C);
#pragma unroll
        for (int h = 0; h < 2; ++h) offA[h][i] = (unsigned)(((row0 + h * HALF + R) * K + C) * 2); }
}
}

struct FW {
    bf16_t *w_in_t, *w_out_t, *gu_t, *d_t;
    bf16_t *hb1, *hb2, *mixb, *actb, *yb;
    float *proj2, *mix2;
};
constexpr int INC_PAD = 1792;
template <int MAP> __device__ __forceinline__ void cvt_tile(const float* src, int ldn, int nvalid, bf16_t* dst, int K, int k0, int n0, float* T) {
    int tid = threadIdx.x; asm volatile("" : "+v"(tid)); const int r = tid >> 4, c4 = (tid & 15) * 4;
#pragma unroll
    for (int i = 0; i < 2; ++i) { const int kk = r + 32 * i; float4 v = make_float4(0.f, 0.f, 0.f, 0.f);
        if (n0 + c4 < nvalid) v = *(const float4*)(src + (size_t)(k0 + kk) * ldn + n0 + c4);
        T[kk * 65 + c4 + 0] = v.x; T[kk * 65 + c4 + 1] = v.y; T[kk * 65 + c4 + 2] = v.z; T[kk * 65 + c4 + 3] = v.w; }
    __syncthreads();
    { const int n = tid >> 3, kc = tid & 7; float f[8];
#pragma unroll
        for (int j = 0; j < 8; ++j) f[j] = T[(kc * 8 + j) * 65 + n];
        gm::u32x4 w; w.x = gm::cvt_pk_bf16(f[0], f[1]); w.y = gm::cvt_pk_bf16(f[2], f[3]); w.z = gm::cvt_pk_bf16(f[4], f[5]); w.w = gm::cvt_pk_bf16(f[6], f[7]);
        const int nn = n0 + n; const int drow = MAP == 0 ? nn : ((nn >> 7) * 256 + (MAP == 2 ? 128 : 0) + (nn & 127));
        *(gm::u32x4*)(dst + (size_t)drow * K + k0 + kc * 8) = w; }
    __syncthreads();
}
__device__ __forceinline__ void cvt_phase(const P& p, const FW& f, int l0, int l1, char* lds) {
    float* T = (float*)lds;
    constexpr int T_IN = 16 * 28, T_OUT = 16 * 16, T_E = 16 * 16, T_LAYER = T_IN + T_OUT + NE * 3 * T_E;
    const int total = (l1 - l0) * T_LAYER;
    for (int t = blockIdx.x; t < total; t += gridDim.x) {
        const int l = l0 + t / T_LAYER; int r = t % T_LAYER;
        if (r < T_IN) { const int kt = r / 28, ntl = r % 28; cvt_tile<0>(p.w_in + (size_t)l * D * INC, INC, INC, f.w_in_t + (size_t)l * INC_PAD * D, D, kt * 64, ntl * 64, T); continue; }
        r -= T_IN;
        if (r < T_OUT) { const int kt = r / 16, ntl = r % 16; cvt_tile<0>(p.w_out + (size_t)l * MIXW * D, D, D, f.w_out_t + (size_t)l * D * MIXW, MIXW, kt * 64, ntl * 64, T); continue; }
        r -= T_OUT;
        const int e = r / (3 * T_E), which = (r / T_E) % 3, tt = r % T_E, kt = tt / 16, ntl = tt % 16; const size_t le = (size_t)l * NE + e;
        if (which == 0) cvt_tile<1>(p.wg + le * D * FF, FF, FF, f.gu_t + le * 2 * FF * D, D, kt * 64, ntl * 64, T);
        else if (which == 1) cvt_tile<2>(p.wu + le * D * FF, FF, FF, f.gu_t + le * 2 * FF * D, D, kt * 64, ntl * 64, T);
        else cvt_tile<0>(p.wd + le * FF * D, D, D, f.d_t + le * D * FF, FF, kt * 64, ntl * 64, T);
    }
}
__device__ __forceinline__ void inproj_phase(const P& p, const FW& f, int l, float* dst, char* lds) {
    constexpr int NPN = INC_PAD / 256, NU = (M / 256) * NPN;
    for (int u = blockIdx.x; u < NU; u += gridDim.x) {
        const int pm = u / NPN, pn = u % NPN; unsigned offA[2][2]; gm::dense_offA(offA, (long)pm * 256, D);
        auto epi = [&](const gm::f32x4 (&acc)[2][2][4][2], int wr, int wc, int fr, int fq) {
            const int row0 = pm * 256 + wr * 64 + fr, col0 = pn * 256 + wc * 32 + 4 * fq;
#pragma unroll
            for (int ai = 0; ai < 2; ++ai)
#pragma unroll
                for (int m = 0; m < 4; ++m) { float* rowp = dst + (size_t)(row0 + ai * 128 + m * 16) * INC + col0;
#pragma unroll
                    for (int bj = 0; bj < 2; ++bj)
#pragma unroll
                        for (int n = 0; n < 2; ++n) if (col0 + bj * 128 + n * 16 < INC) *(gm::f32x4*)(rowp + bj * 128 + n * 16) = acc[ai][bj][m][n]; } };
        gm::gemm_unit<false>((GM_LAS unsigned char*)lds, (const char*)f.hb1, offA, (const char*)(f.w_in_t + ((size_t)l * INC_PAD + pn * 256) * D), D, epi);
    }
}
template <bool TOX> __device__ __forceinline__ void outproj_phase(const P& p, const FW& f, int l, float* dst, char* lds) {
    constexpr int NPN = D / 256, NU = (M / 256) * NPN;
    for (int u = blockIdx.x; u < NU; u += gridDim.x) {
        const int pm = u / NPN, pn = u % NPN; unsigned offA[2][2]; gm::dense_offA(offA, (long)pm * 256, MIXW);
        auto epi = [&](const gm::f32x4 (&acc)[2][2][4][2], int wr, int wc, int fr, int fq) {
            const int row0 = pm * 256 + wr * 64 + fr, col0 = pn * 256 + wc * 32 + 4 * fq; const float* gate = modv(p, l, pm * 256, 2);
#pragma unroll
            for (int ai = 0; ai < 2; ++ai)
#pragma unroll
                for (int m = 0; m < 4; ++m) { float* rowp = dst + (size_t)(row0 + ai * 128 + m * 16) * D + col0;
#pragma unroll
                    for (int bj = 0; bj < 2; ++bj)
#pragma unroll
                        for (int n = 0; n < 2; ++n) { float* q = rowp + bj * 128 + n * 16;
                            if (TOX) { const gm::f32x4 g = *(const gm::f32x4*)(gate + col0 + bj * 128 + n * 16); const gm::f32x4 x = *(const gm::f32x4*)q; *(gm::f32x4*)q = x + g * acc[ai][bj][m][n]; }
                            else *(gm::f32x4*)q = acc[ai][bj][m][n]; } } };
        gm::gemm_unit<false>((GM_LAS unsigned char*)lds, (const char*)f.mixb, offA, (const char*)(f.w_out_t + ((size_t)l * D + pn * 256) * MIXW), MIXW, epi);
    }
}
__device__ __forceinline__ bool moe_find(const int* cnt, int tg, int& e, int& ti, int& c) {
    int acc = 0;
    for (int x = 0; x < NE; ++x) { const int cx = cnt[x]; const int nt = (cx + 255) >> 8; if (tg < acc + nt) { e = x; ti = tg - acc; c = cx; return true; } acc += nt; }
    return false;
}
__device__ __forceinline__ int moe_tiles(const int* cnt) { int acc = 0; for (int x = 0; x < NE; ++x) acc += (cnt[x] + 255) >> 8; return acc; }
template <bool SRC_TOK> __device__ __forceinline__ void gather_offA(unsigned (&offA)[2][2], const int* lst, int base, int cnt, int K) {
    int tid = threadIdx.x; asm volatile("" : "+v"(tid));
#pragma unroll
    for (int i = 0; i < 2; ++i) { int R, C; gm::stage_rc(tid * 16 + i * 8192, R, C);
#pragma unroll
        for (int h = 0; h < 2; ++h) { const int s = base + h * 128 + R; int a = s < cnt ? lst[s] : 0; if (SRC_TOK) a >>= 2; offA[h][i] = (unsigned)(((size_t)a * K + C) * 2); } }
}
__device__ __forceinline__ void moe1_phase(const P& p, const FW& f, int l, char* lds) {
    constexpr int NPN = 2 * FF / 256; const int NU = moe_tiles(p.cnt) * NPN;
    for (int u = blockIdx.x; u < NU; u += gridDim.x) {
        int e, ti, cnt; if (!moe_find(p.cnt, u / NPN, e, ti, cnt)) break; const int pn = u % NPN; const int* lst = p.list + (size_t)e * M; const size_t le = (size_t)l * NE + e;
        unsigned offA[2][2]; gather_offA<true>(offA, lst, ti * 256, cnt, D);
        auto epi = [&](const gm::f32x4 (&acc)[2][2][4][2], int wr, int wc, int fr, int fq) {
            const int ff0 = pn * 128 + wc * 32 + 8 * fq; const float* bgp = p.bg + le * FF + ff0; const float* bup = p.bu + le * FF + ff0;
            const gm::f32x4 bg0 = *(const gm::f32x4*)bgp, bg1 = *(const gm::f32x4*)(bgp + 4), bu0 = *(const gm::f32x4*)bup, bu1 = *(const gm::f32x4*)(bup + 4);
#pragma unroll
            for (int ai = 0; ai < 2; ++ai)
#pragma unroll
                for (int m = 0; m < 4; ++m) { const int s = ti * 256 + ai * 128 + wr * 64 + m * 16 + fr; if (s < cnt) { const int a = lst[s]; float o[8];
#pragma unroll
                        for (int n = 0; n < 2; ++n)
#pragma unroll
                            for (int j = 0; j < 4; ++j) { float g = acc[ai][0][m][n][j] + (n ? bg1[j] : bg0[j]); float uu = acc[ai][1][m][n][j] + (n ? bu1[j] : bu0[j]);
                                g = g < 7.0f ? g : 7.0f; uu = uu < -7.0f ? -7.0f : (uu > 7.0f ? 7.0f : uu); o[n * 4 + j] = g * (1.0f / (1.0f + __expf(-1.702f * g))) * (uu + 1.0f); }
                        gm::u32x4 w; w.x = gm::cvt_pk_bf16(o[0], o[1]); w.y = gm::cvt_pk_bf16(o[2], o[3]); w.z = gm::cvt_pk_bf16(o[4], o[5]); w.w = gm::cvt_pk_bf16(o[6], o[7]);
                        *(gm::u32x4*)(f.actb + (size_t)a * FF + ff0) = w; } } };
        gm::gemm_unit<true>((GM_LAS unsigned char*)lds, (const char*)f.hb2, offA, (const char*)(f.gu_t + (le * 2 * FF + pn * 256) * D), D, epi);
    }
}
__device__ __forceinline__ void moe2_phase(const P& p, const FW& f, int l, char* lds) {
    constexpr int NPN = D / 256; const int NU = moe_tiles(p.cnt) * NPN;
    for (int u = blockIdx.x; u < NU; u += gridDim.x) {
        int e, ti, cnt; if (!moe_find(p.cnt, u / NPN, e, ti, cnt)) break; const int pn = u % NPN; const int* lst = p.list + (size_t)e * M; const size_t le = (size_t)l * NE + e;
        unsigned offA[2][2]; gather_offA<false>(offA, lst, ti * 256, cnt, FF);
        auto epi = [&](const gm::f32x4 (&acc)[2][2][4][2], int wr, int wc, int fr, int fq) {
#pragma unroll
            for (int bj = 0; bj < 2; ++bj) { const int c0 = pn * 256 + bj * 128 + wc * 32 + 8 * fq; const float* bp = p.bd + le * D + c0; const gm::f32x4 b0 = *(const gm::f32x4*)bp, b1 = *(const gm::f32x4*)(bp + 4);
#pragma unroll
                for (int ai = 0; ai < 2; ++ai)
#pragma unroll
                    for (int m = 0; m < 4; ++m) { const int s = ti * 256 + ai * 128 + wr * 64 + m * 16 + fr; if (s < cnt) { const int a = lst[s];
                            const gm::f32x4 v0 = acc[ai][bj][m][0] + b0, v1 = acc[ai][bj][m][1] + b1;
                            gm::u32x4 w; w.x = gm::cvt_pk_bf16(v0[0], v0[1]); w.y = gm::cvt_pk_bf16(v0[2], v0[3]); w.z = gm::cvt_pk_bf16(v1[0], v1[1]); w.w = gm::cvt_pk_bf16(v1[2], v1[3]);
                            *(gm::u32x4*)(f.yb + (size_t)a * D + c0) = w; } } } };
        gm::gemm_unit<true>((GM_LAS unsigned char*)lds, (const char*)f.actb, offA, (const char*)(f.d_t + (le * D + pn * 256) * FF), FF, epi);
    }
}

#ifndef CHECK_GEMM
#define CHECK_GEMM 0
#endif
__device__ __forceinline__ int gtid() { int i0 = blockIdx.x * blockDim.x + threadIdx.x; asm volatile("" : "+v"(i0)); return i0; }
template <int OP> __device__ __forceinline__ void run_op(const P& p, int l) {
    const long n = op_count(OP); const long stride = (long)gridDim.x * blockDim.x;
    for (long i = gtid(); i < n; i += stride) op_run(OP, p, l, i);
}
struct KArgs { P p; FW f; unsigned* bar; };
__device__ __forceinline__ const KArgs& kargs() { auto q = __builtin_amdgcn_kernarg_segment_ptr(); asm volatile("" : "+s"(q)); return *(const KArgs*)q; }
constexpr int LDS_BYTES = gm::STAGE_BYTES + 256;
#define BAR() do { XcdBarrier b2_; b2_.bar = kargs().bar; unsigned xx_ = xbx; asm volatile("" : "+s"(xx_)); b2_.x = xx_; b2_.st = (volatile LAS unsigned*)(lds + LDS_BYTES - 16); xcd_barrier(b2_); } while (0)
#define PH(OPX) do { run_op<OPX>(kargs().p, lo()); BAR(); } while (0)
#define RUN(OPX) run_op<OPX>(kargs().p, lo())

__device__ __forceinline__ void attn_phase(const P& p, float* O, int ldo, char* lds) {
    constexpr int NQT = M / 256, NU = NH * NQT;
    for (int u = blockIdx.x; u < NU; u += gridDim.x) {
        const int hh = u / NQT, qt = u % NQT; const int seq = qt == 0 ? CTX : M;
        __syncthreads();
        at::attn_body(p.qb + (size_t)qt * 256 * at::LDQ + hh * at::DQ, p.kb + hh * at::DQ, p.vb + hh * at::DV, O + (size_t)qt * 256 * ldo + hh * at::DV, ldo, seq, lds);
    }
    __syncthreads();
}
template <class TA> __device__ __forceinline__ float ldf(const TA* a, size_t i);
template <> __device__ __forceinline__ float ldf<float>(const float* a, size_t i) { return a[i]; }
template <> __device__ __forceinline__ float ldf<bf16_t>(const bf16_t* a, size_t i) { return bf2f(a[i]); }
template <class TA> __device__ __forceinline__ void chk_accum(const TA* a, int lda, const float* b, int ldb, long nrows, int ncols, float* diag) {
    float sd = 0.f, sr = 0.f; const long n = nrows * ncols; const long stride = (long)gridDim.x * blockDim.x;
    for (long i = gtid(); i < n; i += stride) { const long r = i / ncols; const int c = (int)(i % ncols);
        const float x = ldf<TA>(a, r * lda + c), y = b[r * ldb + c]; sd += (x - y) * (x - y); sr += y * y; }
    for (int o = 32; o >= 1; o >>= 1) { sd += __shfl_xor(sd, o); sr += __shfl_xor(sr, o); }
    if ((threadIdx.x & 63) == 0) { atomicAdd(diag, sd); atomicAdd(diag + 1, sr); }
}
__global__ void __launch_bounds__(512, 2) k_mega(KArgs a) {
    extern __shared__ __attribute__((aligned(16))) char lds[];
    uint4* xbw = (uint4*)(lds + LDS_BYTES - 16);
    if (threadIdx.x == 0) *xbw = make_uint4(0u, 0u, 0u, 0u);
    __syncthreads();
    const unsigned xbx = xcd_barrier_post(kargs().bar, (volatile LAS unsigned*)xbw).x;
#define KP kargs().p
#define KF kargs().f
    { const int l = 0; auto lo = [&]() { return l; }; RUN(OP_COPY_IN); if (blockIdx.x == 0 && threadIdx.x < 16) KP.diag[threadIdx.x] = 0.f; RUN(OP_MODVEC);
      cvt_phase(KP, KF, 0, CHECK_GEMM ? 1 : DEPTH, lds); BAR(); }
    for (int l = 0; l < DEPTH; ++l) {
        auto lo = [&]() { int ll = l; asm volatile("" : "+s"(ll)); return ll; };
        PH(OP_ROWSTAT); PH(OP_NORM1);
#if CHECK_GEMM
        PH(OP_INPROJ);
#else
        inproj_phase(KP, KF, lo(), KP.proj, lds); BAR();
#endif
        PH(OP_LATNORM);
        RUN(OP_QRAW); PH(OP_KVRAW);
        RUN(OP_QHEAD); RUN(OP_KHEAD); RUN(OP_CONV); RUN(OP_DT); PH(OP_POOLP);
        RUN(OP_SSD_CS); RUN(OP_SSD_G); PH(OP_POOLMM);
        attn_phase(KP, KP.mixin, MIXW, lds);
        RUN(OP_SSD_YD); PH(OP_SSD_ST); PH(OP_SSD_CARRY); PH(OP_SSD_YOFF);
        PH(OP_SSDFIN); PH(OP_MIXB);
#if CHECK_GEMM
        PH(OP_OUTPROJ); PH(OP_RES1);
#else
        outproj_phase<true>(KP, KF, lo(), KP.xres, lds); BAR();
#endif
        PH(OP_ROWSTAT); PH(OP_NORM2);
        RUN(OP_ZEROCNT); PH(OP_LOGITS); PH(OP_TOPK);
#if CHECK_GEMM
        PH(OP_GATEUP); PH(OP_DOWN); PH(OP_COMBINE);
        if (l == 0) {
            inproj_phase(KP, KF, lo(), KF.proj2, lds); outproj_phase<false>(KP, KF, lo(), KF.mix2, lds); moe1_phase(KP, KF, lo(), lds); BAR();
            moe2_phase(KP, KF, lo(), lds); BAR();
            chk_accum<float>(KF.proj2, INC, KP.proj, INC, M, INC, KP.diag + 0); chk_accum<float>(KF.mix2, D, KP.mix, D, M, D, KP.diag + 2);
            chk_accum<bf16_t>(KF.actb, FF, KP.act, FF, 4L * M, FF, KP.diag + 4); chk_accum<bf16_t>(KF.yb, D, KP.down, D, 4L * M, D, KP.diag + 6); BAR();
        }
#else
        moe1_phase(KP, KF, lo(), lds); BAR(); moe2_phase(KP, KF, lo(), lds); BAR(); PH(OP_COMBINE2);
#endif
    }
    {
        float sc = 1.0f;
#if CHECK_GEMM
        float e = 0.f;
        for (int c = 0; c < 4; ++c) { const float ec = sqrtf(KP.diag[2 * c] / KP.diag[2 * c + 1]); e = ec > e ? ec : e; if (!(ec == ec)) e = 1e3f; }
        sc = 1.0f + 10.0f * e;
#endif
        const long n = (long)SEQ * D; const long stride = (long)gridDim.x * blockDim.x;
        for (long i = gtid(); i < n; i += stride) KP.out[i] = KP.xres[(size_t)CTX * D + i] * sc;
    }
#undef KP
#undef KF
}
static size_t carve(char*& cur, size_t bytes) { size_t a = (bytes + 255) & ~(size_t)255; cur += a; return a; }
static bool setup_params(P& p, FW& f, unsigned*& bar, void* const* d_in, void* d_out, void* d_ws, size_t ws_size) {
    const float** pp = (const float**)&p; for (int i = 0; i < 32; ++i) pp[i] = (const float*)d_in[i];
    p.out = (float*)d_out;
    char* cur = (char*)d_ws; char* base = cur;
    bar = (unsigned*)cur; carve(cur, XCD_BAR_WORDS * sizeof(unsigned));
#define CARVE(field, type, count) p.field = (type*)cur; carve(cur, (size_t)(count) * sizeof(type));
#define CARVEF(field, type, count) f.field = (type*)cur; carve(cur, (size_t)(count) * sizeof(type));
    CARVE(xres, float, (size_t)M * D) CARVE(mod, float, (size_t)DEPTH * 12 * D) CARVE(rs, float, M) CARVE(h, float, (size_t)M * D) CARVE(proj, float, (size_t)M * INC) CARVE(qln, float, (size_t)M * QL)
    CARVE(kvln, float, (size_t)M * KVL) CARVE(qraw, float, (size_t)M * NH * QKD) CARVE(kvraw, float, (size_t)M * NH * 128) CARVE(q, float, (size_t)M * NH * QKD) CARVE(k, float, (size_t)M * NH * QKD)
    CARVE(v, float, (size_t)M * NH * VD) CARVE(mixin, float, (size_t)M * MIXW) CARVE(xbc, float, (size_t)M * CONVD) CARVE(dt, float, (size_t)M * 12) CARVE(ydir, float, (size_t)2 * M * SW)
    CARVE(poolp, float, (size_t)M * PW) CARVE(mix, float, (size_t)M * D) CARVE(logits, float, (size_t)M * NE) CARVE(topw, float, (size_t)M * 4)
    CARVE(topi, int, (size_t)M * 4) CARVE(cnt, int, NE) CARVE(list, int, (size_t)NE * M)
    CARVE(qb, bf16_t, (size_t)M * NH * QKD) CARVE(kb, bf16_t, (size_t)M * NH * QKD) CARVE(vb, bf16_t, (size_t)M * NH * VD) CARVE(diag, float, 64)
    CARVE(cs, float, (size_t)2 * M * SH) CARVE(cdec, float, (size_t)2 * NCH * SH) CARVE(gmat, float, (size_t)M * SG * CHUNK) CARVE(st, float, (size_t)2 * NCH * SH * SP * SN)
    CARVE(hb1, bf16_t, (size_t)M * D) CARVE(hb2, bf16_t, (size_t)M * D) CARVE(mixb, bf16_t, (size_t)M * MIXW)
    CARVEF(actb, bf16_t, (size_t)4 * M * FF) CARVEF(yb, bf16_t, (size_t)4 * M * D)
    f.hb1 = p.hb1; f.hb2 = p.hb2; f.mixb = p.mixb; p.ybn = f.yb; p.attf = nullptr;
    const int nl = CHECK_GEMM ? 1 : DEPTH;
    CARVEF(w_in_t, bf16_t, (size_t)nl * INC_PAD * D) CARVEF(w_out_t, bf16_t, (size_t)nl * D * MIXW) CARVEF(gu_t, bf16_t, (size_t)nl * NE * 2 * FF * D) CARVEF(d_t, bf16_t, (size_t)nl * NE * D * FF)
#if CHECK_GEMM
    CARVE(act, float, (size_t)M * 4 * FF) CARVE(down, float, (size_t)M * 4 * D)
    f.proj2 = p.qraw; f.mix2 = p.qraw + (size_t)M * INC;
#else
    p.act = nullptr; p.down = nullptr; f.proj2 = nullptr; f.mix2 = nullptr;
#endif
#undef CARVE
#undef CARVEF
    return (size_t)(cur - base) <= ws_size;
}
extern "C" void kernel_launch(void* const* d_in, const int* in_sizes, int n_in, void* d_out, int out_size, void* d_ws, size_t ws_size, hipStream_t stream) {
    KArgs a{};
    if (n_in < 32 || !setup_params(a.p, a.f, a.bar, d_in, d_out, d_ws, ws_size)) return;
    static int grid = 0;
    if (!grid) { int dev = 0, cus = 0, per_cu = 0; (void)hipGetDevice(&dev); (void)hipDeviceGetAttribute(&cus, hipDeviceAttributeMultiprocessorCount, dev);
        (void)hipFuncSetAttribute((const void*)k_mega, hipFuncAttributeMaxDynamicSharedMemorySize, LDS_BYTES);
        (void)hipOccupancyMaxActiveBlocksPerMultiprocessor(&per_cu, k_mega, 512, LDS_BYTES); grid = cus * (per_cu < 1 ? per_cu : 1); }
    if (grid <= 0) return;
    (void)hipMemsetAsync(a.bar, 0, XCD_BAR_WORDS * sizeof(unsigned), stream);
    hipLaunchKernelGGL(k_mega, dim3(grid), dim3(512), LDS_BYTES, stream, a);
}
```

```cpp
#include <hip/hip_runtime.h>
#include <stdint.h>

#ifndef NAIVE_H
#define NAIVE_H
#include <math.h>
#ifdef HOST_TEST
#define HD inline
#define HDC inline
#define ATOMIC_INC(p) ((*(p))++)
#define UNIFORM(x) (x)
#else
#define HD __device__ __forceinline__
#define HDC __host__ __device__ __forceinline__
#define ATOMIC_INC(p) atomicAdd((p), 1)
#define UNIFORM(x) __builtin_amdgcn_readfirstlane(x)
#endif

#ifndef CFG_D
#define CFG_D 1024
#define CFG_SEQ 16384
#define CFG_CTX 256
#define CFG_FF 1024
#define CFG_DEPTH 4
#endif
constexpr int D = CFG_D, SEQ = CFG_SEQ, CTX = CFG_CTX, FF = CFG_FF, DEPTH = CFG_DEPTH;
constexpr int M = CTX + SEQ;
constexpr int GRID_W = 64;
constexpr int NH = 6, QKD = 96, NOPE = 64, ROPE = 32, VD = 64, QL = 256, KVL = 128;
constexpr int SH = 6, SP = 64, SW = 384, SG = 2, SN = 64, CONVD = 640, CHUNK = 128;
constexpr int PW = 256, MIXW = 1024, INC = 1708;
constexpr int C_Q = 0, C_KV = 256, C_KR = 384, C_Z = 416, C_XBC = 800, C_DT = 1440, C_POOL = 1452;
constexpr int NE = 32, TOPK = 4;
constexpr int NCH = M / CHUNK;
constexpr float EPS = 1e-6f;

typedef unsigned short bf16_t;
HD bf16_t f2bf(float f) { union { float f; unsigned u; } v; v.f = f; unsigned u = v.u; u += 0x7FFFu + ((u >> 16) & 1u); return (bf16_t)(u >> 16); }
HD float bf2f(bf16_t b) { union { float f; unsigned u; } v; v.u = ((unsigned)b) << 16; return v.f; }
struct P {
    const float *x, *c, *ctx, *c_ctx, *norm1_g, *norm2_g, *mod_w, *mod_b, *w_in, *q_g, *kv_g, *w_uq, *w_ukv, *qn_g, *kn_g;
    const float *conv_w, *conv_b, *a_log, *dt_bias, *ssd_d, *ssd_norm_g, *pool_w, *pool_scale, *w_out, *router_w, *router_b;
    const float *wg, *bg, *wu, *bu, *wd, *bd;
    float* out;
    float *xres, *mod, *rs, *h, *proj, *qln, *kvln, *qraw, *kvraw, *q, *k, *v, *mixin, *xbc, *dt, *ydir, *poolp, *mix, *logits, *topw, *act, *down;
    int *topi, *cnt, *list;
    bf16_t *qb, *kb, *vb;
    float *attf, *diag;
    float *cs, *cdec, *gmat, *st;
    bf16_t *hb1, *hb2, *mixb, *ybn;
};

HD float siluf(float x) { return x / (1.0f + expf(-x)); }
HD float sigmf(float x) { return 1.0f / (1.0f + expf(-x)); }
HD float softplusf(float x) { return x > 20.0f ? x : log1pf(expf(x)); }
HD const float* modv(const P& p, int l, int r, int j) { return p.mod + ((size_t)(l * 2 + (r < CTX ? 1 : 0)) * 6 + j) * D; }

enum { OP_COPY_IN = 0, OP_MODVEC, OP_ROWSTAT, OP_NORM1, OP_INPROJ, OP_LATNORM, OP_QRAW, OP_KVRAW, OP_QHEAD, OP_KHEAD, OP_ATTN, OP_CONV, OP_DT, OP_SSDSCAN, OP_SSDFIN,
       OP_POOLP, OP_POOLMM, OP_OUTPROJ, OP_RES1, OP_NORM2, OP_LOGITS, OP_ZEROCNT, OP_TOPK, OP_GATEUP, OP_DOWN, OP_COMBINE, OP_WRITE_OUT, OP_MIXB, OP_COMBINE2, OP_SSD_CS, OP_SSD_G, OP_SSD_YD, OP_SSD_ST, OP_SSD_CARRY, OP_SSD_YOFF, OP_COUNT };

HDC long op_count(int op) {
    switch (op) {
        case OP_COPY_IN: return (long)M * D;
        case OP_MODVEC: return (long)DEPTH * 2 * 6 * D;
        case OP_ROWSTAT: return M;
        case OP_NORM1: case OP_NORM2: return (long)M * D;
        case OP_INPROJ: return (long)(M / 8) * INC;
        case OP_LATNORM: return 2L * M;
        case OP_QRAW: return (long)(M / 8) * (NH * QKD);
        case OP_KVRAW: return (long)(M / 8) * (NH * 128);
        case OP_QHEAD: case OP_KHEAD: return (long)M * NH;
        case OP_ATTN: return (long)M * NH;
        case OP_CONV: return (long)M * CONVD;
        case OP_DT: return (long)M * 12;
        case OP_SSDSCAN: return 2L * SH * SP;
        case OP_SSDFIN: return M;
        case OP_POOLP: return (long)M * PW;
        case OP_POOLMM: return (long)M * PW;
        case OP_OUTPROJ: return (long)(M / 8) * D;
        case OP_RES1: return (long)M * D;
        case OP_LOGITS: return (long)M * NE;
        case OP_ZEROCNT: return NE;
        case OP_TOPK: return M;
        case OP_GATEUP: return (long)NE * (M / 8) * FF;
        case OP_DOWN: return (long)NE * (M / 8) * D;
        case OP_COMBINE: return (long)M * D;
        case OP_WRITE_OUT: return (long)SEQ * D;
        case OP_MIXB: return (long)M * MIXW;
        case OP_COMBINE2: return (long)M * D;
        case OP_SSD_CS: return 2L * NCH * SH;
        case OP_SSD_G: return (long)M * SG * CHUNK;
        case OP_SSD_YD: return (long)M * SW;
        case OP_SSD_ST: return 2L * NCH * SH * SP * SN;
        case OP_SSD_CARRY: return 2L * SH * SP * SN;
        case OP_SSD_YOFF: return (long)M * SW;
    }
    return 0;
}

HD void gemm8(const float* A, int lda, const float* B, int ldb, const float* bias, float* C, int ldc, int N, int K, long idx) {
    const int j = (int)(idx % N); const long r0 = (idx / N) * 8;
    float acc[8];
#pragma unroll
    for (int i = 0; i < 8; ++i) acc[i] = 0.f;
    const float* a = A + r0 * lda;
    for (int k = 0; k < K; ++k) {
        const float b = B[(size_t)k * ldb + j];
#pragma unroll
        for (int i = 0; i < 8; ++i) acc[i] += a[(size_t)i * lda + k] * b;
    }
    const float bv = bias ? bias[j] : 0.f;
#pragma unroll
    for (int i = 0; i < 8; ++i) C[(r0 + i) * ldc + j] = acc[i] + bv;
}

HD void sincos_rr(float angf, float& cs, float& sn) {
    const double x = (double)angf; const double n = rint(x * 0.63661977236758134308); const double y = (x - n * 1.57079632679489655800) - n * 6.123233995736766e-17; const double y2 = y * y;
    const double s = y * (1.0 + y2 * (-1.0 / 6 + y2 * (1.0 / 120 + y2 * (-1.0 / 5040 + y2 * (1.0 / 362880 + y2 * (-1.0 / 39916800))))));
    const double c = 1.0 + y2 * (-0.5 + y2 * (1.0 / 24 + y2 * (-1.0 / 720 + y2 * (1.0 / 40320 + y2 * (-1.0 / 3628800 + y2 * (1.0 / 479001600))))));
    const int q = ((int)n) & 3; const double cc = (q == 0) ? c : (q == 1) ? -s : (q == 2) ? -c : s; const double ss = (q == 0) ? s : (q == 1) ? c : (q == 2) ? -s : -c;
    cs = (float)cc; sn = (float)ss;
}
HD float rope_inv_freq(int f) { return f == 0 ? 1.0f : f == 1 ? 0.31622776f : f == 2 ? 0.1f : f == 3 ? 0.031622775f : f == 4 ? 0.01f : f == 5 ? 0.0031622776f : f == 6 ? 0.001f : 0.00031622776f; }
HD void rope_apply(float* v32, int t) {
    const float row = (float)(t / GRID_W), col = (float)(t % GRID_W);
#pragma unroll
    for (int a = 0; a < 2; ++a)
#pragma unroll
        for (int f = 0; f < 8; ++f) {
            const float ang = (a == 0 ? row : col) * rope_inv_freq(f);
            float cs, sn; sincos_rr(ang, cs, sn);
            const float x1 = v32[a * 16 + f], x2 = v32[a * 16 + 8 + f];
            v32[a * 16 + f] = x1 * cs - x2 * sn; v32[a * 16 + 8 + f] = x2 * cs + x1 * sn;
        }
}

HD void op_run(int op, const P& p, int l, long idx) {
    switch (op) {
    case OP_COPY_IN: { const long r = idx / D; const int c = (int)(idx % D); p.xres[idx] = r < CTX ? p.ctx[idx] : p.x[(r - CTX) * D + c]; } break;
    case OP_MODVEC: {
        const int j = (int)(idx % (6 * D)); const int which = (int)((idx / (6 * D)) % 2); const int ll = (int)(idx / (12 * D));
        const float* cv = which ? p.c_ctx : p.c; float s = 0.f;
        for (int k = 0; k < D; ++k) s += siluf(cv[k]) * p.mod_w[((size_t)ll * D + k) * (6 * D) + j];
        p.mod[idx] = s + p.mod_b[(size_t)ll * 6 * D + j];
    } break;
    case OP_ROWSTAT: { const float* xr = p.xres + idx * D; float s = 0.f; for (int k = 0; k < D; ++k) s += xr[k] * xr[k]; p.rs[idx] = 1.0f / sqrtf(s / D + EPS); } break;
    case OP_NORM1: case OP_NORM2: { const int r = (int)(idx / D), c = (int)(idx % D); const int o = op == OP_NORM1 ? 0 : 3;
        const float g = (op == OP_NORM1 ? p.norm1_g : p.norm2_g)[l * D + c];
        const float hv = p.xres[idx] * p.rs[r] * g * (1.0f + modv(p, l, r, o + 1)[c]) + modv(p, l, r, o)[c]; p.h[idx] = hv;
        bf16_t* hb = op == OP_NORM1 ? p.hb1 : p.hb2; if (hb) hb[idx] = f2bf(hv); } break;
    case OP_INPROJ: gemm8(p.h, D, p.w_in + (size_t)l * D * INC, INC, nullptr, p.proj, INC, INC, D, idx); break;
    case OP_LATNORM: {
        const int which = idx >= M; const long r = which ? idx - M : idx; const int n = which ? KVL : QL; const float* src = p.proj + r * INC + (which ? C_KV : C_Q);
        float s = 0.f; for (int k = 0; k < n; ++k) s += src[k] * src[k]; const float rs = 1.0f / sqrtf(s / n + EPS);
        float* dst = which ? p.kvln + r * KVL : p.qln + r * QL; const float* g = which ? p.kv_g + l * KVL : p.q_g + l * QL;
        for (int k = 0; k < n; ++k) dst[k] = src[k] * rs * g[k];
    } break;
    case OP_QRAW: gemm8(p.qln, QL, p.w_uq + (size_t)l * QL * (NH * QKD), NH * QKD, nullptr, p.qraw, NH * QKD, NH * QKD, QL, idx); break;
    case OP_KVRAW: gemm8(p.kvln, KVL, p.w_ukv + (size_t)l * KVL * (NH * 128), NH * 128, nullptr, p.kvraw, NH * 128, NH * 128, KVL, idx); break;
    case OP_QHEAD: { const int r = (int)(idx / NH), hh = (int)(idx % NH); const float* src = p.qraw + (size_t)r * (NH * QKD) + hh * QKD; float s = 0.f;
        for (int d = 0; d < QKD; ++d) s += src[d] * src[d]; const float rs = 1.0f / sqrtf(s / QKD + EPS);
        float* dst = p.q + ((size_t)r * NH + hh) * QKD; float rp[32];
        for (int d = 0; d < NOPE; ++d) dst[d] = src[d] * rs * p.qn_g[l * QKD + d];
#pragma unroll
        for (int d = 0; d < 32; ++d) rp[d] = src[NOPE + d] * rs * p.qn_g[l * QKD + NOPE + d];
        if (r >= CTX) rope_apply(rp, r - CTX);
#pragma unroll
        for (int d = 0; d < 32; ++d) dst[NOPE + d] = rp[d];
        bf16_t* db = p.qb + ((size_t)r * NH + hh) * QKD;
        for (int d = 0; d < QKD; ++d) db[d] = f2bf(dst[d]);
    } break;
    case OP_KHEAD: { const int r = (int)(idx / NH), hh = (int)(idx % NH); const float* kn = p.kvraw + (size_t)r * (NH * 128) + hh * 128; const float* kr = p.proj + (size_t)r * INC + C_KR; float s = 0.f;
        for (int d = 0; d < NOPE; ++d) s += kn[d] * kn[d];
        for (int d = 0; d < ROPE; ++d) s += kr[d] * kr[d];
        const float rs = 1.0f / sqrtf(s / QKD + EPS);
        float* dst = p.k + ((size_t)r * NH + hh) * QKD; float rp[32];
        for (int d = 0; d < NOPE; ++d) dst[d] = kn[d] * rs * p.kn_g[l * QKD + d];
#pragma unroll
        for (int d = 0; d < 32; ++d) rp[d] = kr[d] * rs * p.kn_g[l * QKD + NOPE + d];
        if (r >= CTX) rope_apply(rp, r - CTX);
#pragma unroll
        for (int d = 0; d < 32; ++d) dst[NOPE + d] = rp[d];
        float* vd = p.v + ((size_t)r * NH + hh) * VD;
        for (int d = 0; d < VD; ++d) vd[d] = kn[NOPE + d];
        bf16_t* db = p.kb + ((size_t)r * NH + hh) * QKD; bf16_t* vdb = p.vb + ((size_t)r * NH + hh) * VD;
        for (int d = 0; d < QKD; ++d) db[d] = f2bf(dst[d]);
        for (int d = 0; d < VD; ++d) vdb[d] = f2bf(kn[NOPE + d]);
    } break;
    case OP_ATTN: {
        const int r = (int)(idx % M), hh = UNIFORM((int)(idx / M)); const int nk = r < CTX ? CTX : M;
        float qv[QKD];
        const float* qp = p.q + ((size_t)r * NH + hh) * QKD; const float scale = 1.0f / sqrtf((float)QKD);
#pragma unroll
        for (int d = 0; d < QKD; ++d) qv[d] = qp[d] * scale;
        for (int half = 0; half < 2; ++half) {
            float o[32];
#pragma unroll
            for (int d = 0; d < 32; ++d) o[d] = 0.f;
            float mx = -1e30f, lsum = 0.f;
            for (int kk = 0; kk < nk; ++kk) {
                const float* kp = p.k + ((size_t)kk * NH + hh) * QKD; const float* vp = p.v + ((size_t)kk * NH + hh) * VD + half * 32; float s = 0.f;
#pragma unroll
                for (int d = 0; d < QKD; ++d) s += qv[d] * kp[d];
                const float mn = s > mx ? s : mx; const float corr = expf(mx - mn), pe = expf(s - mn);
                lsum = lsum * corr + pe; mx = mn;
#pragma unroll
                for (int d = 0; d < 32; ++d) o[d] = o[d] * corr + pe * vp[d];
            }
            const float inv = 1.0f / lsum; float* dst = p.mixin + (size_t)r * MIXW + hh * VD + half * 32;
#pragma unroll
            for (int d = 0; d < 32; ++d) dst[d] = o[d] * inv;
        }
    } break;
    case OP_CONV: { const int r = (int)(idx / CONVD), c = (int)(idx % CONVD); const int seg0 = r < CTX ? 0 : CTX, n = r < CTX ? CTX : SEQ, t = r - seg0; float y = p.conv_b[l * CONVD + c];
#pragma unroll
        for (int j = 0; j < 4; ++j) { const int tt = t - 2 + j; if (tt >= 0 && tt < n) y += p.conv_w[((size_t)l * 4 + j) * CONVD + c] * p.proj[(size_t)(seg0 + tt) * INC + C_XBC + c]; }
        p.xbc[idx] = siluf(y); } break;
    case OP_DT: { const int r = (int)(idx / 12), j = (int)(idx % 12); p.dt[idx] = softplusf(p.proj[(size_t)r * INC + C_DT + j] + p.dt_bias[l * 12 + j]); } break;
    case OP_SSDSCAN: {
        const int pp = (int)(idx % SP), hh = UNIFORM((int)((idx / SP) % SH)), dir = UNIFORM((int)(idx / (SP * SH))); const int g = hh / (SH / SG);
        const float a = -expf(p.a_log[l * 12 + dir * 6 + hh]); float st[SN];
#pragma unroll
        for (int n = 0; n < SN; ++n) st[n] = 0.f;
        for (int step = 0; step < M; ++step) {
            const int r = dir == 0 ? step : (step < CTX ? CTX - 1 - step : M - 1 - (step - CTX));
            const float dtv = p.dt[(size_t)r * 12 + dir * 6 + hh]; const float dA = expf(dtv * a); const float xv = p.xbc[(size_t)r * CONVD + hh * SP + pp] * dtv;
            const float* Bp = p.xbc + (size_t)r * CONVD + SW + g * SN; const float* Cp = p.xbc + (size_t)r * CONVD + SW + SG * SN + g * SN; float y = 0.f;
#pragma unroll
            for (int n = 0; n < SN; ++n) { st[n] = st[n] * dA + xv * Bp[n]; y += st[n] * Cp[n]; }
            p.ydir[((size_t)dir * M + r) * SW + hh * SP + pp] = y;
        }
    } break;
    case OP_SSDFIN: { const long r = idx; float ss = 0.f;
        for (int c = 0; c < SW; ++c) { const float y = p.ydir[r * SW + c] + p.ydir[((size_t)M + r) * SW + c] + p.ssd_d[l * SH + c / SP] * p.xbc[r * CONVD + c]; const float gv = y * siluf(p.proj[r * INC + C_Z + c]); ss += gv * gv; }
        const float rs = 1.0f / sqrtf(ss / SW + EPS);
        for (int c = 0; c < SW; ++c) { const float y = p.ydir[r * SW + c] + p.ydir[((size_t)M + r) * SW + c] + p.ssd_d[l * SH + c / SP] * p.xbc[r * CONVD + c]; const float gv = y * siluf(p.proj[r * INC + C_Z + c]);
            p.mixin[r * MIXW + NH * VD + c] = gv * rs * p.ssd_norm_g[l * SW + c]; }
    } break;
    case OP_POOLP: { const int r = (int)(idx / PW), c = (int)(idx % PW); const int gi = c / 64; const int win = 2 << gi; const int seg0 = r < CTX ? 0 : CTX, n = r < CTX ? CTX : SEQ, t = r - seg0;
        int lo = t - win / 2, hi = t - win / 2 + win; lo = lo < 0 ? 0 : lo; hi = hi > n ? n : hi; float s = 0.f;
        for (int tt = lo; tt < hi; ++tt) s += p.proj[(size_t)(seg0 + tt) * INC + C_POOL + c];
        p.poolp[idx] = s / (float)(hi - lo) - p.proj[(size_t)r * INC + C_POOL + c]; } break;
    case OP_POOLMM: { const int r = (int)(idx / PW), c = (int)(idx % PW); const int gi = c / 64, d = c % 64; float s = 0.f;
        for (int cc = 0; cc < 64; ++cc) s += p.poolp[(size_t)r * PW + gi * 64 + cc] * p.pool_w[(((size_t)l * 4 + gi) * 64 + cc) * 64 + d];
        p.mixin[(size_t)r * MIXW + NH * VD + SW + c] = s * p.pool_scale[l * PW + c]; } break;
    case OP_OUTPROJ: gemm8(p.mixin, MIXW, p.w_out + (size_t)l * MIXW * D, D, nullptr, p.mix, D, D, MIXW, idx); break;
    case OP_RES1: { const int r = (int)(idx / D), c = (int)(idx % D); p.xres[idx] += modv(p, l, r, 2)[c] * p.mix[idx]; } break;
    case OP_LOGITS: { const int r = (int)(idx / NE), e = (int)(idx % NE); const float* hr = p.h + (size_t)r * D; float s = 0.f;
        for (int k = 0; k < D; ++k) s += hr[k] * p.router_w[((size_t)l * D + k) * NE + e];
        p.logits[idx] = s + p.router_b[l * NE + e]; } break;
    case OP_ZEROCNT: p.cnt[idx] = 0; break;
    case OP_TOPK: { const long t = idx; float lg[NE];
#pragma unroll
        for (int e = 0; e < NE; ++e) lg[e] = p.logits[t * NE + e];
        int sel[4]; float sv[4];
#pragma unroll
        for (int kk = 0; kk < 4; ++kk) { float best = -3.0e38f; int bi = 0;
#pragma unroll
            for (int e = 0; e < NE; ++e) { bool taken = false;
#pragma unroll
                for (int q = 0; q < kk; ++q) taken = taken || (sel[q] == e);
                if (!taken && lg[e] > best) { best = lg[e]; bi = e; } }
            sel[kk] = bi; sv[kk] = best; }
        float es[4], sum = 0.f;
#pragma unroll
        for (int kk = 0; kk < 4; ++kk) { es[kk] = expf(sv[kk] - sv[0]); sum += es[kk]; }
#pragma unroll
        for (int kk = 0; kk < 4; ++kk) { p.topi[t * 4 + kk] = sel[kk]; p.topw[t * 4 + kk] = es[kk] / sum; const int pos = ATOMIC_INC(&p.cnt[sel[kk]]); p.list[(size_t)sel[kk] * M + pos] = (int)(t * 4 + kk); }
    } break;
    case OP_GATEUP: {
        const int j = (int)(idx % FF); const long rest = idx / FF; const int rb = (int)(rest % (M / 8)), e = (int)(rest / (M / 8)); const int cnt = p.cnt[e]; if (rb * 8 >= cnt) break;
        int a[8]; float g[8], u[8];
#pragma unroll
        for (int i = 0; i < 8; ++i) { a[i] = rb * 8 + i < cnt ? p.list[(size_t)e * M + rb * 8 + i] : -1; g[i] = 0.f; u[i] = 0.f; }
        const float* wgp = p.wg + ((size_t)l * NE + e) * D * FF + j; const float* wup = p.wu + ((size_t)l * NE + e) * D * FF + j;
        for (int k = 0; k < D; ++k) { const float gw = wgp[(size_t)k * FF], uw = wup[(size_t)k * FF];
#pragma unroll
            for (int i = 0; i < 8; ++i) { const float xv = p.h[(size_t)(a[i] < 0 ? 0 : a[i] / 4) * D + k]; g[i] += xv * gw; u[i] += xv * uw; } }
        const float bgv = p.bg[((size_t)l * NE + e) * FF + j], buv = p.bu[((size_t)l * NE + e) * FF + j];
#pragma unroll
        for (int i = 0; i < 8; ++i) if (a[i] >= 0) { float gv = g[i] + bgv; gv = gv < 7.0f ? gv : 7.0f; float uv = u[i] + buv; uv = uv < -7.0f ? -7.0f : (uv > 7.0f ? 7.0f : uv);
            p.act[(size_t)a[i] * FF + j] = gv * sigmf(1.702f * gv) * (uv + 1.0f); }
    } break;
    case OP_DOWN: {
        const int j = (int)(idx % D); const long rest = idx / D; const int rb = (int)(rest % (M / 8)), e = (int)(rest / (M / 8)); const int cnt = p.cnt[e]; if (rb * 8 >= cnt) break;
        int a[8]; float o[8];
#pragma unroll
        for (int i = 0; i < 8; ++i) { a[i] = rb * 8 + i < cnt ? p.list[(size_t)e * M + rb * 8 + i] : -1; o[i] = 0.f; }
        const float* wdp = p.wd + ((size_t)l * NE + e) * FF * D + j;
        for (int k = 0; k < FF; ++k) { const float w = wdp[(size_t)k * D];
#pragma unroll
            for (int i = 0; i < 8; ++i) o[i] += p.act[(size_t)(a[i] < 0 ? 0 : a[i]) * FF + k] * w; }
        const float bv = p.bd[((size_t)l * NE + e) * D + j];
#pragma unroll
        for (int i = 0; i < 8; ++i) if (a[i] >= 0) p.down[(size_t)a[i] * D + j] = o[i] + bv;
    } break;
    case OP_COMBINE: { const int r = (int)(idx / D), c = (int)(idx % D); float s = 0.f;
#pragma unroll
        for (int kk = 0; kk < 4; ++kk) s += p.topw[(size_t)r * 4 + kk] * p.down[((size_t)r * 4 + kk) * D + c];
        p.xres[idx] += modv(p, l, r, 5)[c] * s; } break;
    case OP_WRITE_OUT: p.out[idx] = p.xres[(size_t)CTX * D + idx]; break;
    case OP_MIXB: p.mixb[idx] = f2bf(p.mixin[idx]); break;
    case OP_SSD_CS: {
        const int hh = (int)(idx % SH), c = (int)((idx / SH) % NCH), dir = (int)(idx / (SH * NCH)); const float a = -expf(p.a_log[l * 12 + dir * 6 + hh]); float acc = 0.f;
        for (int i = 0; i < CHUNK; ++i) { const int r = c * CHUNK + (dir == 0 ? i : CHUNK - 1 - i); acc += p.dt[(size_t)r * 12 + dir * 6 + hh] * a; p.cs[((size_t)dir * M + r) * SH + hh] = acc; }
        p.cdec[idx] = expf(acc);
    } break;
    case OP_SSD_G: {
        const int s = (int)(idx % CHUNK), g = (int)((idx / CHUNK) % SG), r = (int)(idx / (CHUNK * SG)); const int r2 = (r / CHUNK) * CHUNK + s;
        const float* Cp = p.xbc + (size_t)r * CONVD + SW + SG * SN + g * SN; const float* Bp = p.xbc + (size_t)r2 * CONVD + SW + g * SN; float acc = 0.f;
        for (int n = 0; n < SN; ++n) acc += Cp[n] * Bp[n];
        p.gmat[idx] = acc;
    } break;
    case OP_SSD_YD: {
        const int cc = (int)(idx % SW), r = (int)(idx / SW); const int hh = cc / SP, g = hh / (SH / SG); const int c0 = (r / CHUNK) * CHUNK, lpos = r - c0;
        const float* G = p.gmat + ((size_t)r * SG + g) * CHUNK; const float csf = p.cs[(size_t)r * SH + hh], csb = p.cs[((size_t)M + r) * SH + hh]; float y = 0.f;
        for (int s = 0; s <= lpos; ++s) { const int r2 = c0 + s; y += G[s] * expf(csf - p.cs[(size_t)r2 * SH + hh]) * p.dt[(size_t)r2 * 12 + hh] * p.xbc[(size_t)r2 * CONVD + cc]; }
        for (int s = lpos; s < CHUNK; ++s) { const int r2 = c0 + s; y += G[s] * expf(csb - p.cs[((size_t)M + r2) * SH + hh]) * p.dt[(size_t)r2 * 12 + 6 + hh] * p.xbc[(size_t)r2 * CONVD + cc]; }
        p.ydir[idx] = y;
    } break;
    case OP_SSD_ST: {
        const int n = (int)(idx % SN), pp = (int)((idx / SN) % SP), hh = (int)((idx / (SN * SP)) % SH), c = (int)((idx / (SN * SP * SH)) % NCH), dir = (int)(idx / ((long)SN * SP * SH * NCH)); const int g = hh / (SH / SG);
        const int rend = c * CHUNK + (dir == 0 ? CHUNK - 1 : 0); const float cse = p.cs[((size_t)dir * M + rend) * SH + hh]; float acc = 0.f;
        for (int i = 0; i < CHUNK; ++i) { const int r = c * CHUNK + i; acc += p.xbc[(size_t)r * CONVD + SW + g * SN + n] * expf(cse - p.cs[((size_t)dir * M + r) * SH + hh]) * p.dt[(size_t)r * 12 + dir * 6 + hh] * p.xbc[(size_t)r * CONVD + hh * SP + pp]; }
        p.st[idx] = acc;
    } break;
    case OP_SSD_CARRY: {
        const int e = (int)(idx % (SP * SN)), hh = (int)((idx / (SP * SN)) % SH), dir = (int)(idx / ((long)SP * SN * SH)); float state = 0.f;
        for (int i = 0; i < NCH; ++i) { const int c = dir == 0 ? i : (i < CTX / CHUNK ? CTX / CHUNK - 1 - i : NCH - 1 - (i - CTX / CHUNK));
            const size_t o = (((size_t)dir * NCH + c) * SH + hh) * (SP * SN) + e; const float stc = p.st[o]; p.st[o] = state; state = state * p.cdec[((size_t)dir * NCH + c) * SH + hh] + stc; }
    } break;
    case OP_SSD_YOFF: {
        const int cc = (int)(idx % SW), r = (int)(idx / SW); const int hh = cc / SP, pp = cc % SP, g = hh / (SH / SG), c = r / CHUNK; const float* Cp = p.xbc + (size_t)r * CONVD + SW + SG * SN + g * SN;
        float y = 0.f;
#pragma unroll
        for (int dir = 0; dir < 2; ++dir) { const float* pv = p.st + ((((size_t)dir * NCH + c) * SH + hh) * SP + pp) * SN; float acc = 0.f;
            for (int n = 0; n < SN; ++n) acc += Cp[n] * pv[n];
            y += acc * expf(p.cs[((size_t)dir * M + r) * SH + hh]); }
        p.ydir[(size_t)M * SW + idx] = y;
    } break;
    case OP_COMBINE2: { const int r = (int)(idx / D), c = (int)(idx % D); float s = 0.f;
#pragma unroll
        for (int kk = 0; kk < 4; ++kk) s += p.topw[(size_t)r * 4 + kk] * bf2f(p.ybn[((size_t)r * 4 + kk) * D + c]);
        p.xres[idx] += modv(p, l, r, 5)[c] * s; } break;
    }
}

static const int LAYER_OPS[] = { OP_ROWSTAT, OP_NORM1, OP_INPROJ, OP_LATNORM, OP_QRAW, OP_KVRAW, OP_QHEAD, OP_KHEAD, OP_ATTN, OP_CONV, OP_DT, OP_SSDSCAN, OP_SSDFIN, OP_POOLP, OP_POOLMM,
                                 OP_OUTPROJ, OP_RES1, OP_ROWSTAT, OP_NORM2, OP_LOGITS, OP_ZEROCNT, OP_TOPK, OP_GATEUP, OP_DOWN, OP_COMBINE };
constexpr int N_LAYER_OPS = sizeof(LAYER_OPS) / sizeof(int);
#endif

#define XB_TMO      128
#define XB_XCNT(j)  (256  + 64 * (j))
#define XB_XSUB(j)  (1280 + 64 * (j))
#define XB_XGEN(j)  (2304 + 64 * (j))
#define XB_TOP      3328
#define XB_TOPGEN   3392
#define XCD_BAR_WORDS 3456
#define XB_SPIN_CAP (1u << 22)
#define LAS __attribute__((address_space(3)))

__device__ __forceinline__ unsigned xb_ld(unsigned* p)              { return __hip_atomic_load(p, __ATOMIC_RELAXED, __HIP_MEMORY_SCOPE_AGENT); }
__device__ __forceinline__ unsigned xb_add(unsigned* p, unsigned v) { return __hip_atomic_fetch_add(p, v, __ATOMIC_RELAXED, __HIP_MEMORY_SCOPE_AGENT); }
__device__ __forceinline__ unsigned xb_xcc_id() { return (unsigned)__builtin_amdgcn_s_getreg((3 << 11) | 20) & 0xFu; }
#define XB_SPIN(cond, bar) do { unsigned _sp = 0; while (cond) { __builtin_amdgcn_s_sleep(1); \
    if ((++_sp & 255u) == 0u) { if (xb_ld(&(bar)[XB_TMO])) break; if (_sp > XB_SPIN_CAP) { atomicAdd(&(bar)[XB_TMO], 1u); break; } } } } while (0)

struct XcdBarrier {
    unsigned* bar; unsigned x;
    volatile LAS unsigned* st;
};

__device__ __forceinline__ XcdBarrier xcd_barrier_post(unsigned* bar, volatile LAS unsigned* st) {
    XcdBarrier b; b.bar = bar; b.x = xb_xcc_id(); b.st = st;
    if (threadIdx.x == 0) (void)xb_add(&bar[XB_XCNT(b.x)], 1u);
    return b;
}
__device__ __forceinline__ void xcd_barrier_complete(unsigned* bar, unsigned x, unsigned& nloc, unsigned& nx) {
    const unsigned G = gridDim.x * gridDim.y * gridDim.z;
    unsigned sum, cnt, mine, sp = 0u;
    for (;;) {
        sum = 0u; cnt = 0u; mine = 0u;
#pragma unroll
        for (unsigned j = 0; j < 16; ++j) { const unsigned c = xb_ld(&bar[XB_XCNT(j)]); sum += c; cnt += (c > 0u) ? 1u : 0u; mine = (j == x) ? c : mine; }
        if (sum == G) break;
        __builtin_amdgcn_s_sleep(1);
        if ((++sp & 255u) == 0u) { if (xb_ld(&bar[XB_TMO])) break; if (sp > XB_SPIN_CAP) { atomicAdd(&bar[XB_TMO], 1u); break; } }
    }
    nloc = mine > 0u ? mine : 1u; nx = cnt > 0u ? cnt : 1u;
}

__device__ __forceinline__ void xcd_barrier(const XcdBarrier& b) {
    asm volatile("s_waitcnt vmcnt(0)" ::: "memory");
    __syncthreads();
    if (threadIdx.x == 0) {
        unsigned* bar = b.bar;
        __builtin_amdgcn_s_waitcnt(0);
        unsigned nloc = b.st[0], nx = b.st[1];
        if (nloc == 0u) { unsigned xx = b.x; asm volatile("" : "+s"(xx));   xcd_barrier_complete(bar, xx, nloc, nx); b.st[0] = nloc; b.st[1] = nx; }
        const unsigned old = xb_add(&bar[XB_XSUB(b.x)], 1u);
        const unsigned gen = old / nloc;
        if (old + 1u == (gen + 1u) * nloc) {
            __builtin_amdgcn_fence(__ATOMIC_RELEASE, "agent");
            asm volatile("s_waitcnt vmcnt(0)" ::: "memory");
            const unsigned og = xb_add(&bar[XB_TOP], 1u);
            const unsigned tg = og / nx;
            if (og + 1u == (tg + 1u) * nx) xb_add(&bar[XB_TOPGEN], 1u);
            else XB_SPIN(xb_ld(&bar[XB_TOPGEN]) == tg, bar);
            __builtin_amdgcn_fence(__ATOMIC_ACQUIRE, "agent");
            xb_add(&bar[XB_XGEN(b.x)], 1u);
            asm volatile("s_waitcnt vmcnt(0)" ::: "memory");
        } else {
            XB_SPIN(xb_ld(&bar[XB_XGEN(b.x)]) == gen, bar);
            __builtin_amdgcn_fence(__ATOMIC_ACQUIRE, "agent");
            asm volatile("s_waitcnt vmcnt(0)" ::: "memory");
        }
    }
    __syncthreads();
}


namespace at {
typedef unsigned short bf16_t;
using bf16x8 = __attribute__((ext_vector_type(8))) short;
using s16x4  = __attribute__((ext_vector_type(4))) short;
using f32x16 = __attribute__((ext_vector_type(16))) float;
using u32x4  = __attribute__((ext_vector_type(4))) unsigned;
constexpr int DQ = 96, DV = 64, NW = 8, QBLK = 32, KVBLK = 64;
constexpr int LDQ = 6 * DQ, LDK = 6 * DQ, LDV = 6 * DV;
constexpr float SCALE = 0.10206207261596575f;
constexpr float THR = 8.f;
constexpr int KROW = 208;
constexpr int SHM_K = KVBLK * KROW, SHM_V = KVBLK * DV * 2;
constexpr int SHM_ATTN = 2 * SHM_V + 2 * SHM_K + NW * 64 * 4;
#define AT_SBAR() __builtin_amdgcn_sched_barrier(0)
__device__ __forceinline__ int crow(int r, int hi) { return (r & 3) + 8 * (r >> 2) + 4 * hi; }
__device__ __forceinline__ unsigned cvtpk(float lo, float hi) { unsigned r; asm volatile("v_cvt_pk_bf16_f32 %0, %1, %2" : "=v"(r) : "v"(lo), "v"(hi)); return r; }

__device__ __forceinline__ void partialSM(f32x16& p0, f32x16& p1, float& m_reg, float& mn, float& alpha) {
  constexpr float C = SCALE * 1.4426950408889634f;
  float pmax = p0[0];
#pragma unroll
  for (int r = 1; r < 16; ++r) pmax = fmaxf(pmax, p0[r]);
#pragma unroll
  for (int r = 0; r < 16; ++r) pmax = fmaxf(pmax, p1[r]);
  { auto rr = __builtin_amdgcn_permlane32_swap(__float_as_uint(pmax), __float_as_uint(pmax), false, false);
    pmax = fmaxf(__uint_as_float(rr[0]), __uint_as_float(rr[1])); }
  if (__builtin_expect(__all(pmax - m_reg <= THR / SCALE), 1)) { mn = m_reg; alpha = 1.f; }
  else { mn = fmaxf(m_reg, pmax); alpha = __builtin_amdgcn_exp2f((m_reg - mn) * C); m_reg = mn; }
  float mnC = -mn * C;
#pragma unroll
  for (int r = 0; r < 16; ++r) p0[r] = fmaf(p0[r], C, mnC);
#pragma unroll
  for (int r = 0; r < 16; ++r) p1[r] = fmaf(p1[r], C, mnC);
#pragma unroll
  for (int r = 0; r < 16; ++r) p0[r] = __builtin_amdgcn_exp2f(p0[r]);
}
__device__ __forceinline__ void finishSM(f32x16& p0, f32x16& p1, float alpha, float& l_reg, bf16x8& pa0, bf16x8& pa1, bf16x8& pa2, bf16x8& pa3) {
#pragma unroll
  for (int r = 0; r < 16; ++r) p1[r] = __builtin_amdgcn_exp2f(p1[r]);
  float ps = 0;
#pragma unroll
  for (int r = 0; r < 16; ++r) ps += p0[r];
#pragma unroll
  for (int r = 0; r < 16; ++r) ps += p1[r];
  { auto rr = __builtin_amdgcn_permlane32_swap(__float_as_uint(ps), __float_as_uint(ps), false, false);
    ps = __uint_as_float(rr[0]) + __uint_as_float(rr[1]); }
  l_reg = l_reg * alpha + ps;
#define AT_PK4(P, BASE, OUT) do { unsigned a0 = cvtpk(P[BASE + 0], P[BASE + 1]), a1 = cvtpk(P[BASE + 2], P[BASE + 3]);   \
    unsigned b0 = cvtpk(P[BASE + 4], P[BASE + 5]), b1 = cvtpk(P[BASE + 6], P[BASE + 7]);                              \
    auto r0 = __builtin_amdgcn_permlane32_swap(a0, b0, false, false); auto r1 = __builtin_amdgcn_permlane32_swap(a1, b1, false, false); \
    u32x4 w = {r0[0], r1[0], r0[1], r1[1]}; OUT = *reinterpret_cast<bf16x8*>(&w); } while (0)
  AT_PK4(p0, 0, pa0); AT_PK4(p0, 8, pa1); AT_PK4(p1, 0, pa2); AT_PK4(p1, 8, pa3);
#undef AT_PK4
}
__device__ __forceinline__ void qkt(f32x16& p0, f32x16& p1, const char* Ks, const bf16x8* qr, int r32, int hi) {
  p0 = f32x16{}; p1 = f32x16{};
#pragma unroll
  for (int d0 = 0; d0 < 6; ++d0) { const int cb = (d0 * 16 + hi * 8) * 2;
    bf16x8 b0 = *reinterpret_cast<const bf16x8*>(Ks + r32 * KROW + cb);
    bf16x8 b1 = *reinterpret_cast<const bf16x8*>(Ks + (32 + r32) * KROW + cb);
    p0 = __builtin_amdgcn_mfma_f32_32x32x16_bf16(b0, qr[d0], p0, 0, 0, 0);
    p1 = __builtin_amdgcn_mfma_f32_32x32x16_bf16(b1, qr[d0], p1, 0, 0, 0); }
}
__device__ __forceinline__ int v_st(int k, int c) { const int kk = (k & ~0xC) | ((k & 4) << 1) | ((k & 8) >> 1); return ((kk >> 3) * 2 + (c >> 5)) * 512 + ((kk & 7) * 32 + (c & 31)) * 2; }
__device__ __forceinline__ int v_rd_base(int lane) { return ((lane & 3) << 3) | (((lane >> 2) & 3) << 6) | (((lane >> 4) & 1) << 5) | (((lane >> 5) & 1) << 8); }
constexpr int v_rd_off(int d0, int ks, int half) { return d0 * 512 + ks * 2048 + half * 1024; }
template <int OFF> __device__ __forceinline__ s16x4 tr_read(int vb) {
  s16x4 r; asm volatile("ds_read_b64_tr_b16 %0, %1 offset:%2" : "=&v"(r) : "v"(vb), "i"(OFF) : "memory"); return r;
}
template <int D0> __device__ __forceinline__ void pv_one(f32x16& od, int vb, bf16x8 pa0, bf16x8 pa1, bf16x8 pa2, bf16x8 pa3) {
  const s16x4 l0 = tr_read<v_rd_off(D0, 0, 0)>(vb), h0 = tr_read<v_rd_off(D0, 0, 1)>(vb), l1 = tr_read<v_rd_off(D0, 1, 0)>(vb), h1 = tr_read<v_rd_off(D0, 1, 1)>(vb);
  const s16x4 l2 = tr_read<v_rd_off(D0, 2, 0)>(vb), h2 = tr_read<v_rd_off(D0, 2, 1)>(vb), l3 = tr_read<v_rd_off(D0, 3, 0)>(vb), h3 = tr_read<v_rd_off(D0, 3, 1)>(vb);
  asm volatile("s_waitcnt lgkmcnt(0)" ::: "memory"); AT_SBAR();
#define AT_PK(L, H) (bf16x8){L[0], L[1], L[2], L[3], H[0], H[1], H[2], H[3]}
  od = __builtin_amdgcn_mfma_f32_32x32x16_bf16(pa0, AT_PK(l0, h0), od, 0, 0, 0);
  od = __builtin_amdgcn_mfma_f32_32x32x16_bf16(pa1, AT_PK(l1, h1), od, 0, 0, 0);
  od = __builtin_amdgcn_mfma_f32_32x32x16_bf16(pa2, AT_PK(l2, h2), od, 0, 0, 0);
  od = __builtin_amdgcn_mfma_f32_32x32x16_bf16(pa3, AT_PK(l3, h3), od, 0, 0, 0);
#undef AT_PK
}
__device__ __forceinline__ void pv_d0(f32x16* o, int vb, bf16x8 pa0, bf16x8 pa1, bf16x8 pa2, bf16x8 pa3) {
  pv_one<0>(o[0], vb, pa0, pa1, pa2, pa3); pv_one<1>(o[1], vb, pa0, pa1, pa2, pa3);
}
__device__ __forceinline__ void attn_body(const bf16_t* __restrict__ Qb, const bf16_t* __restrict__ Kh, const bf16_t* __restrict__ Vh, float* __restrict__ Ob, int ldo, int seq, char* lds) {
  int tid = threadIdx.x; asm volatile("" : "+v"(tid));
  const int wid = tid >> 6, lane = tid & 63, r32 = lane & 31, hi = lane >> 5;
  char* V_lds = lds; char* K_lds = lds + 2 * SHM_V;
  float* ws = (float*)(lds + 2 * SHM_V + 2 * SHM_K) + wid * 64; float* li_l = ws; float* al_l = ws + 32;
  float m_reg = -1e30f, l_reg = 0; f32x16 o[2] = {}; bf16x8 qr[6];
  const bf16_t* Qw = Qb + (long)(wid * QBLK + r32) * LDQ + hi * 8;
#pragma unroll
  for (int d0 = 0; d0 < 6; ++d0) qr[d0] = *reinterpret_cast<const bf16x8*>(Qw + d0 * 16);
  const int kr0 = tid / 12, kc0 = tid % 12, c1 = 512 + (tid & 255), kr1 = c1 / 12, kc1 = c1 % 12, vr = tid >> 3, vc = (tid & 7) * 8;
  const bool k1on = tid < 256;
  const int kst0 = kr0 * KROW + kc0 * 16, kst1 = kr1 * KROW + kc1 * 16, vst = v_st(vr, vc);
  const long kg0 = (long)kr0 * LDK + kc0 * 8, kg1 = (long)kr1 * LDK + kc1 * 8, vg = (long)vr * LDV + vc;
  const int vb0 = (int)(uintptr_t)V_lds + v_rd_base(lane);
  struct { bf16x8 vs, ks0, ks1; } sr_[2];
#define AT_SLOAD(i, k0) do { sr_[i].vs = *reinterpret_cast<const bf16x8*>(Vh + (long)(k0) * LDV + vg); \
    sr_[i].ks0 = *reinterpret_cast<const bf16x8*>(Kh + (long)(k0) * LDK + kg0); sr_[i].ks1 = *reinterpret_cast<const bf16x8*>(Kh + (long)(k0) * LDK + kg1); } while (0)
#define AT_SWRITE(b, i) do { *(bf16x8*)(V_lds + (b) * SHM_V + vst) = sr_[i].vs; *(bf16x8*)(K_lds + (b) * SHM_K + kst0) = sr_[i].ks0; \
    if (k1on) *(bf16x8*)(K_lds + (b) * SHM_K + kst1) = sr_[i].ks1; } while (0)
#define AT_SWAIT() asm volatile("s_waitcnt vmcnt(3)" ::: "memory")
#define AT_RESC(a) do { if (__any((a) < 1.f)) { if (hi == 0) al_l[r32] = (a); asm volatile("s_waitcnt lgkmcnt(0)" ::: "memory"); \
    _Pragma("unroll") for (int d = 0; d < 2; ++d) _Pragma("unroll") for (int r = 0; r < 16; ++r) o[d][r] *= al_l[crow(r, hi)]; } } while (0)
  f32x16 pA0, pA1, pB0, pB1; float mnA, mnB, alA, alB; bf16x8 pa0, pa1, pa2, pa3; const int NT = seq / KVBLK;
  constexpr int SE = 0, SO = 1;
  AT_SLOAD(SE, 0); asm volatile("s_waitcnt vmcnt(0)" ::: "memory"); AT_SWRITE(0, SE); __syncthreads();
  qkt(pA0, pA1, K_lds, qr, r32, hi); partialSM(pA0, pA1, m_reg, mnA, alA);
  AT_SLOAD(SO, KVBLK); if (2 < NT) AT_SLOAD(SE, 2 * KVBLK);
  AT_SWAIT(); AT_SWRITE(1, SO); __syncthreads();
  for (int j = 1; j + 1 < NT; j += 2) {
    AT_SBAR(); qkt(pB0, pB1, K_lds + SHM_K, qr, r32, hi);
    finishSM(pA0, pA1, alA, l_reg, pa0, pa1, pa2, pa3); AT_SBAR();
    AT_SLOAD(SO, (j + 2) * KVBLK); AT_SBAR();
    pv_d0(o, vb0, pa0, pa1, pa2, pa3); partialSM(pB0, pB1, m_reg, mnB, alB);
    __syncthreads(); AT_SWAIT(); AT_SWRITE(0, SE);
    AT_RESC(alB); __syncthreads();
    AT_SBAR(); qkt(pA0, pA1, K_lds, qr, r32, hi);
    finishSM(pB0, pB1, alB, l_reg, pa0, pa1, pa2, pa3); AT_SBAR();
    if (j + 3 < NT) AT_SLOAD(SE, (j + 3) * KVBLK); AT_SBAR();
    pv_d0(o, vb0 + SHM_V, pa0, pa1, pa2, pa3); partialSM(pA0, pA1, m_reg, mnA, alA);
    __syncthreads(); AT_SWAIT(); AT_SWRITE(1, SO);
    AT_RESC(alA); __syncthreads();
  }
  AT_SBAR(); qkt(pB0, pB1, K_lds + SHM_K, qr, r32, hi);
  finishSM(pA0, pA1, alA, l_reg, pa0, pa1, pa2, pa3); AT_SBAR();
  pv_d0(o, vb0, pa0, pa1, pa2, pa3); partialSM(pB0, pB1, m_reg, mnB, alB);
  __syncthreads(); AT_RESC(alB);
  finishSM(pB0, pB1, alB, l_reg, pa0, pa1, pa2, pa3); AT_SBAR();
  pv_d0(o, vb0 + SHM_V, pa0, pa1, pa2, pa3);
  if (hi == 0) li_l[r32] = l_reg; asm volatile("s_waitcnt lgkmcnt(0)" ::: "memory");
  float rli[16];
#pragma unroll
  for (int r = 0; r < 16; ++r) rli[r] = __builtin_amdgcn_rcpf(li_l[crow(r, hi)]);
  float* Ow = Ob + (long)(wid * QBLK) * ldo;
#pragma unroll
  for (int r = 0; r < 16; ++r) { const int orow = crow(r, hi);
#pragma unroll
    for (int d0 = 0; d0 < 2; ++d0) Ow[(long)orow * ldo + d0 * 32 + r32] = o[d0][r] * rli[r]; }
#undef AT_SLOAD
#undef AT_SWRITE
#undef AT_SWAIT
#undef AT_RESC
}
}

namespace gm {
#define GM_LAS __attribute__((address_space(3)))
typedef unsigned short bf16_t;
typedef short bf16x8 __attribute__((ext_vector_type(8)));
typedef float f32x4 __attribute__((ext_vector_type(4)));
typedef unsigned u32x4 __attribute__((ext_vector_type(4)));
constexpr int BM = 256, BK = 64, HALF = 128, HTB = HALF * BK * 2, STAGE_BYTES = 8 * HTB;
__host__ __device__ __forceinline__ int lds_byte(int r, int c) { const int st = (r >> 4) * 2 + (c >> 5), rr = r & 15, cc = c & 31, ob = rr * 64 + cc * 2; return st * 1024 + (ob ^ (((ob >> 9) & 1) << 5)); }
__host__ __device__ __forceinline__ void stage_rc(int b, int& R, int& C) { const int st = b / 1024, sb = b % 1024, swz = sb ^ (((sb >> 9) & 1) << 5); R = (st >> 1) * 16 + swz / 64; C = (st & 1) * 32 + (swz % 64) / 2; }
__host__ __device__ __forceinline__ int perm32(int rho) { const int n = rho >> 4, i = rho & 15; return 8 * (i >> 2) + 4 * n + (i & 3); }
__device__ __forceinline__ unsigned cvt_pk_bf16(float lo, float hi) { unsigned r; asm volatile("v_cvt_pk_bf16_f32 %0, %1, %2" : "=v"(r) : "v"(lo), "v"(hi)); return r; }

template <bool PERM, class Epi>
__device__ __forceinline__ void gemm_unit(GM_LAS unsigned char* lds, const char* A, const unsigned (&offA)[2][2], const char* Bt, int K, const Epi& E) {
    int tid = threadIdx.x; asm volatile("" : "+v"(tid));
    const int wid = __builtin_amdgcn_readfirstlane(tid >> 6), lane = tid & 63, wr = wid >> 2, wc = wid & 3, fr = lane & 15, fq = lane >> 4;
    const int nt = K / BK;
    unsigned voffB[2];
#pragma unroll
    for (int i = 0; i < 2; ++i) { int R, C; stage_rc(tid * 16 + i * 8192, R, C); const int Rb = PERM ? ((R & ~31) + perm32(R & 31)) : R; voffB[i] = (unsigned)(Rb * K + C) * 2u; }
    const size_t kstep = (size_t)(BK * 2);
    const size_t hstep = (size_t)HALF * K * 2;
    const unsigned ldsw = (unsigned)wid * 1024u;
    const int aoff = lds_byte(wr * 64 + fr, fq * 8), boff = lds_byte(wc * 32 + fr, fq * 8);
#define GM_SA(b, h) (((b) * 2 + (h)) * HTB)
#define GM_SB(b, h) ((4 + (b) * 2 + (h)) * HTB)
#define GM_STAGEB(bufoff, gbase) do { _Pragma("unroll") for (int _i = 0; _i < 2; ++_i) \
        __builtin_amdgcn_global_load_lds((const unsigned*)((const char*)(gbase) + voffB[_i]), (GM_LAS unsigned*)(lds + (bufoff) + ldsw + _i * 8192), 16, 0, 0); } while (0)
#define GM_STAGEA(bufoff, h, kbyte) do { _Pragma("unroll") for (int _i = 0; _i < 2; ++_i) \
        __builtin_amdgcn_global_load_lds((const unsigned*)(A + (size_t)offA[h][_i] + (kbyte)), (GM_LAS unsigned*)(lds + (bufoff) + ldsw + _i * 8192), 16, 0, 0); } while (0)
#define GM_LDA(dst, b, h) do { _Pragma("unroll") for (int m = 0; m < 4; ++m) _Pragma("unroll") for (int k = 0; k < 2; ++k) dst[m][k] = *(const GM_LAS bf16x8*)(lds + GM_SA(b, h) + aoff + m * 2048 + k * 1024); } while (0)
#define GM_LDB(dst, b, h) do { _Pragma("unroll") for (int n = 0; n < 2; ++n) _Pragma("unroll") for (int k = 0; k < 2; ++k) dst[n][k] = *(const GM_LAS bf16x8*)(lds + GM_SB(b, h) + boff + n * 2048 + k * 1024); } while (0)
#define GM_MMA(ai, bj, At, Bt_) do { __builtin_amdgcn_s_setprio(1); _Pragma("unroll") for (int m = 0; m < 4; ++m) _Pragma("unroll") for (int n = 0; n < 2; ++n) _Pragma("unroll") for (int k = 0; k < 2; ++k) \
        acc[ai][bj][m][n] = __builtin_amdgcn_mfma_f32_16x16x32_bf16(Bt_[n][k], At[m][k], acc[ai][bj][m][n], 0, 0, 0); __builtin_amdgcn_s_setprio(0); } while (0)
#define GM_WAIT_V(n) asm volatile("s_waitcnt vmcnt(" #n ")" ::: "memory")
#define GM_WAIT_L(n) asm volatile("s_waitcnt lgkmcnt(" #n ")" ::: "memory")
#define GM_BAR __builtin_amdgcn_s_barrier()
#define GM_SCHED __builtin_amdgcn_sched_barrier(0)
    f32x4 acc[2][2][4][2];
#pragma unroll
    for (int a = 0; a < 2; ++a)
#pragma unroll
        for (int b = 0; b < 2; ++b)
#pragma unroll
            for (int m = 0; m < 4; ++m)
#pragma unroll
                for (int n = 0; n < 2; ++n) acc[a][b][m][n] = (f32x4){0.f, 0.f, 0.f, 0.f};
    bf16x8 At[4][2], B0[2][2], B1[2][2];
    const char* cB = Bt;
    GM_STAGEB(GM_SB(0, 0), cB); GM_STAGEA(GM_SA(0, 0), 0, 0); GM_STAGEB(GM_SB(0, 1), cB + hstep); GM_STAGEA(GM_SA(0, 1), 1, 0);
    if (wr == 1) GM_BAR;
    GM_WAIT_V(4); GM_BAR;
    GM_STAGEB(GM_SB(1, 0), cB + kstep); GM_STAGEA(GM_SA(1, 0), 0, kstep); GM_STAGEB(GM_SB(1, 1), cB + hstep + kstep);
    GM_WAIT_V(6); GM_BAR;
    for (int t = 0; t < nt; t += 2) {
        const bool last = (t == nt - 2);
        const size_t k1 = (size_t)(t + 1) * kstep;
        const size_t k2 = last ? 0 : (size_t)(t + 2) * kstep;
        const size_t k3 = k2 + kstep;
        const char* b2 = cB + k2; const char* b3 = cB + k3;
        GM_LDB(B0, 0, 0); GM_SCHED; GM_LDA(At, 0, 0); GM_STAGEA(GM_SA(1, 1), 1, k1);
        GM_WAIT_L(8); GM_BAR; GM_WAIT_L(0); GM_MMA(0, 0, At, B0); GM_BAR; GM_SCHED;
        GM_LDB(B1, 0, 1); GM_STAGEB(GM_SB(0, 0), b2);
        GM_BAR; GM_WAIT_L(0); GM_MMA(0, 1, At, B1); GM_BAR;
        GM_LDA(At, 0, 1); GM_STAGEA(GM_SA(0, 0), 0, k2);
        GM_BAR; GM_WAIT_L(0); GM_MMA(1, 0, At, B0); GM_BAR; GM_SCHED;
        GM_STAGEB(GM_SB(0, 1), b2 + hstep);
        GM_WAIT_V(6); GM_BAR; GM_MMA(1, 1, At, B1); GM_BAR;
        GM_LDB(B0, 1, 0); GM_SCHED; GM_LDA(At, 1, 0); GM_STAGEA(GM_SA(0, 1), 1, k2);
        GM_WAIT_L(8); GM_BAR; GM_WAIT_L(0); GM_MMA(0, 0, At, B0); GM_BAR; GM_SCHED;
        GM_LDB(B1, 1, 1); GM_STAGEB(GM_SB(1, 0), b3);
        GM_BAR; GM_WAIT_L(0); GM_MMA(0, 1, At, B1); GM_BAR;
        GM_LDA(At, 1, 1); GM_STAGEA(GM_SA(1, 0), 0, k3);
        GM_BAR; GM_WAIT_L(0); GM_MMA(1, 0, At, B0); GM_BAR; GM_SCHED;
        GM_STAGEB(GM_SB(1, 1), b3 + hstep);
        GM_WAIT_V(6); GM_BAR; GM_MMA(1, 1, At, B1); GM_BAR;
    }
    E(acc, wr, wc, fr, fq);
    GM_WAIT_V(0);
    if (wr == 0) GM_BAR;
    GM_BAR;
#undef GM_SA
#undef GM_SB
#undef GM_STAGEA
#undef GM_STAGEB
#undef GM_LDA
#undef GM_LDB
#undef GM_MMA
#undef GM_WAIT_V
#undef GM_WAIT_L
#undef GM_BAR
#undef GM_SCHED
}
__device__ __forceinline__ void dense_offA(unsigned (&offA)[2][2], long row0, int K) {
    int tid = threadIdx.x; asm volatile("" : "+v"(tid));
#pragma unroll
    for (int i = 0; i < 2; ++i) { int R, C; stage_rc(tid * 16 + i * 8192, R, C);
#pragma unroll
        for (int h = 0; h < 2; ++h) offA[h][i] = (unsigned)(((row0 + h * HALF + R) * K + C) * 2); }
}
}

struct FW {
    bf16_t *w_in_t, *w_out_t, *gu_t, *d_t;
    bf16_t *hb1, *hb2, *mixb, *actb, *yb;
    float *proj2, *mix2;
};
constexpr int INC_PAD = 1792;
template <int MAP> __device__ __forceinline__ void cvt_tile(const float* src, int ldn, int nvalid, bf16_t* dst, int K, int k0, int n0, float* T) {
    int tid = threadIdx.x; asm volatile("" : "+v"(tid)); const int r = tid >> 4, c4 = (tid & 15) * 4;
#pragma unroll
    for (int i = 0; i < 2; ++i) { const int kk = r + 32 * i; float4 v = make_float4(0.f, 0.f, 0.f, 0.f);
        if (n0 + c4 < nvalid) v = *(const float4*)(src + (size_t)(k0 + kk) * ldn + n0 + c4);
        T[kk * 65 + c4 + 0] = v.x; T[kk * 65 + c4 + 1] = v.y; T[kk * 65 + c4 + 2] = v.z; T[kk * 65 + c4 + 3] = v.w; }
    __syncthreads();
    { const int n = tid >> 3, kc = tid & 7; float f[8];
#pragma unroll
        for (int j = 0; j < 8; ++j) f[j] = T[(kc * 8 + j) * 65 + n];
        gm::u32x4 w; w.x = gm::cvt_pk_bf16(f[0], f[1]); w.y = gm::cvt_pk_bf16(f[2], f[3]); w.z = gm::cvt_pk_bf16(f[4], f[5]); w.w = gm::cvt_pk_bf16(f[6], f[7]);
        const int nn = n0 + n; const int drow = MAP == 0 ? nn : ((nn >> 7) * 256 + (MAP == 2 ? 128 : 0) + (nn & 127));
        *(gm::u32x4*)(dst + (size_t)drow * K + k0 + kc * 8) = w; }
    __syncthreads();
}
__device__ __forceinline__ void cvt_phase(const P& p, const FW& f, int l0, int l1, char* lds) {
    float* T = (float*)lds;
    constexpr int T_IN = 16 * 28, T_OUT = 16 * 16, T_E = 16 * 16, T_LAYER = T_IN + T_OUT + NE * 3 * T_E;
    const int total = (l1 - l0) * T_LAYER;
    for (int t = blockIdx.x; t < total; t += gridDim.x) {
        const int l = l0 + t / T_LAYER; int r = t % T_LAYER;
        if (r < T_IN) { const int kt = r / 28, ntl = r % 28; cvt_tile<0>(p.w_in + (size_t)l * D * INC, INC, INC, f.w_in_t + (size_t)l * INC_PAD * D, D, kt * 64, ntl * 64, T); continue; }
        r -= T_IN;
        if (r < T_OUT) { const int kt = r / 16, ntl = r % 16; cvt_tile<0>(p.w_out + (size_t)l * MIXW * D, D, D, f.w_out_t + (size_t)l * D * MIXW, MIXW, kt * 64, ntl * 64, T); continue; }
        r -= T_OUT;
        const int e = r / (3 * T_E), which = (r / T_E) % 3, tt = r % T_E, kt = tt / 16, ntl = tt % 16; const size_t le = (size_t)l * NE + e;
        if (which == 0) cvt_tile<1>(p.wg + le * D * FF, FF, FF, f.gu_t + le * 2 * FF * D, D, kt * 64, ntl * 64, T);
        else if (which == 1) cvt_tile<2>(p.wu + le * D * FF, FF, FF, f.gu_t + le * 2 * FF * D, D, kt * 64, ntl * 64, T);
        else cvt_tile<0>(p.wd + le * FF * D, D, D, f.d_t + le * D * FF, FF, kt * 64, ntl * 64, T);
    }
}
__device__ __forceinline__ void inproj_phase(const P& p, const FW& f, int l, float* dst, char* lds) {
    constexpr int NPN = INC_PAD / 256, NU = (M / 256) * NPN;
    for (int u = blockIdx.x; u < NU; u += gridDim.x) {
        const int pm = u / NPN, pn = u % NPN; unsigned offA[2][2]; gm::dense_offA(offA, (long)pm * 256, D);
        auto epi = [&](const gm::f32x4 (&acc)[2][2][4][2], int wr, int wc, int fr, int fq) {
            const int row0 = pm * 256 + wr * 64 + fr, col0 = pn * 256 + wc * 32 + 4 * fq;
#pragma unroll
            for (int ai = 0; ai < 2; ++ai)
#pragma unroll
                for (int m = 0; m < 4; ++m) { float* rowp = dst + (size_t)(row0 + ai * 128 + m * 16) * INC + col0;
#pragma unroll
                    for (int bj = 0; bj < 2; ++bj)
#pragma unroll
                        for (int n = 0; n < 2; ++n) if (col0 + bj * 128 + n * 16 < INC) *(gm::f32x4*)(rowp + bj * 128 + n * 16) = acc[ai][bj][m][n]; } };
        gm::gemm_unit<false>((GM_LAS unsigned char*)lds, (const char*)f.hb1, offA, (const char*)(f.w_in_t + ((size_t)l * INC_PAD + pn * 256) * D), D, epi);
    }
}
template <bool TOX> __device__ __forceinline__ void outproj_phase(const P& p, const FW& f, int l, float* dst, char* lds) {
    constexpr int NPN = D / 256, NU = (M / 256) * NPN;
    for (int u = blockIdx.x; u < NU; u += gridDim.x) {
        const int pm = u / NPN, pn = u % NPN; unsigned offA[2][2]; gm::dense_offA(offA, (long)pm * 256, MIXW);
        auto epi = [&](const gm::f32x4 (&acc)[2][2][4][2], int wr, int wc, int fr, int fq) {
            const int row0 = pm * 256 + wr * 64 + fr, col0 = pn * 256 + wc * 32 + 4 * fq; const float* gate = modv(p, l, pm * 256, 2);
#pragma unroll
            for (int ai = 0; ai < 2; ++ai)
#pragma unroll
                for (int m = 0; m < 4; ++m) { float* rowp = dst + (size_t)(row0 + ai * 128 + m * 16) * D + col0;
#pragma unroll
                    for (int bj = 0; bj < 2; ++bj)
#pragma unroll
                        for (int n = 0; n < 2; ++n) { float* q = rowp + bj * 128 + n * 16;
                            if (TOX) { const gm::f32x4 g = *(const gm::f32x4*)(gate + col0 + bj * 128 + n * 16); const gm::f32x4 x = *(const gm::f32x4*)q; *(gm::f32x4*)q = x + g * acc[ai][bj][m][n]; }
                            else *(gm::f32x4*)q = acc[ai][bj][m][n]; } } };
        gm::gemm_unit<false>((GM_LAS unsigned char*)lds, (const char*)f.mixb, offA, (const char*)(f.w_out_t + ((size_t)l * D + pn * 256) * MIXW), MIXW, epi);
    }
}
__device__ __forceinline__ bool moe_find(const int* cnt, int tg, int& e, int& ti, int& c) {
    int acc = 0;
    for (int x = 0; x < NE; ++x) { const int cx = cnt[x]; const int nt = (cx + 255) >> 8; if (tg < acc + nt) { e = x; ti = tg - acc; c = cx; return true; } acc += nt; }
    return false;
}
__device__ __forceinline__ int moe_tiles(const int* cnt) { int acc = 0; for (int x = 0; x < NE; ++x) acc += (cnt[x] + 255) >> 8; return acc; }
template <bool SRC_TOK> __device__ __forceinline__ void gather_offA(unsigned (&offA)[2][2], const int* lst, int base, int cnt, int K) {
    int tid = threadIdx.x; asm volatile("" : "+v"(tid));
#pragma unroll
    for (int i = 0; i < 2; ++i) { int R, C; gm::stage_rc(tid * 16 + i * 8192, R, C);
#pragma unroll
        for (int h = 0; h < 2; ++h) { const int s = base + h * 128 + R; int a = s < cnt ? lst[s] : 0; if (SRC_TOK) a >>= 2; offA[h][i] = (unsigned)(((size_t)a * K + C) * 2); } }
}
__device__ __forceinline__ void moe1_phase(const P& p, const FW& f, int l, char* lds) {
    constexpr int NPN = 2 * FF / 256; const int NU = moe_tiles(p.cnt) * NPN;
    for (int u = blockIdx.x; u < NU; u += gridDim.x) {
        int e, ti, cnt; if (!moe_find(p.cnt, u / NPN, e, ti, cnt)) break; const int pn = u % NPN; const int* lst = p.list + (size_t)e * M; const size_t le = (size_t)l * NE + e;
        unsigned offA[2][2]; gather_offA<true>(offA, lst, ti * 256, cnt, D);
        auto epi = [&](const gm::f32x4 (&acc)[2][2][4][2], int wr, int wc, int fr, int fq) {
            const int ff0 = pn * 128 + wc * 32 + 8 * fq; const float* bgp = p.bg + le * FF + ff0; const float* bup = p.bu + le * FF + ff0;
            const gm::f32x4 bg0 = *(const gm::f32x4*)bgp, bg1 = *(const gm::f32x4*)(bgp + 4), bu0 = *(const gm::f32x4*)bup, bu1 = *(const gm::f32x4*)(bup + 4);
#pragma unroll
            for (int ai = 0; ai < 2; ++ai)
#pragma unroll
                for (int m = 0; m < 4; ++m) { const int s = ti * 256 + ai * 128 + wr * 64 + m * 16 + fr; if (s < cnt) { const int a = lst[s]; float o[8];
#pragma unroll
                        for (int n = 0; n < 2; ++n)
#pragma unroll
                            for (int j = 0; j < 4; ++j) { float g = acc[ai][0][m][n][j] + (n ? bg1[j] : bg0[j]); float uu = acc[ai][1][m][n][j] + (n ? bu1[j] : bu0[j]);
                                g = g < 7.0f ? g : 7.0f; uu = uu < -7.0f ? -7.0f : (uu > 7.0f ? 7.0f : uu); o[n * 4 + j] = g * (1.0f / (1.0f + __expf(-1.702f * g))) * (uu + 1.0f); }
                        gm::u32x4 w; w.x = gm::cvt_pk_bf16(o[0], o[1]); w.y = gm::cvt_pk_bf16(o[2], o[3]); w.z = gm::cvt_pk_bf16(o[4], o[5]); w.w = gm::cvt_pk_bf16(o[6], o[7]);
                        *(gm::u32x4*)(f.actb + (size_t)a * FF + ff0) = w; } } };
        gm::gemm_unit<true>((GM_LAS unsigned char*)lds, (const char*)f.hb2, offA, (const char*)(f.gu_t + (le * 2 * FF + pn * 256) * D), D, epi);
    }
}
__device__ __forceinline__ void moe2_phase(const P& p, const FW& f, int l, char* lds) {
    constexpr int NPN = D / 256; const int NU = moe_tiles(p.cnt) * NPN;
    for (int u = blockIdx.x; u < NU; u += gridDim.x) {
        int e, ti, cnt; if (!moe_find(p.cnt, u / NPN, e, ti, cnt)) break; const int pn = u % NPN; const int* lst = p.list + (size_t)e * M; const size_t le = (size_t)l * NE + e;
        unsigned offA[2][2]; gather_offA<false>(offA, lst, ti * 256, cnt, FF);
        auto epi = [&](const gm::f32x4 (&acc)[2][2][4][2], int wr, int wc, int fr, int fq) {
#pragma unroll
            for (int bj = 0; bj < 2; ++bj) { const int c0 = pn * 256 + bj * 128 + wc * 32 + 8 * fq; const float* bp = p.bd + le * D + c0; const gm::f32x4 b0 = *(const gm::f32x4*)bp, b1 = *(const gm::f32x4*)(bp + 4);
#pragma unroll
                for (int ai = 0; ai < 2; ++ai)
#pragma unroll
                    for (int m = 0; m < 4; ++m) { const int s = ti * 256 + ai * 128 + wr * 64 + m * 16 + fr; if (s < cnt) { const int a = lst[s];
                            const gm::f32x4 v0 = acc[ai][bj][m][0] + b0, v1 = acc[ai][bj][m][1] + b1;
                            gm::u32x4 w; w.x = gm::cvt_pk_bf16(v0[0], v0[1]); w.y = gm::cvt_pk_bf16(v0[2], v0[3]); w.z = gm::cvt_pk_bf16(v1[0], v1[1]); w.w = gm::cvt_pk_bf16(v1[2], v1[3]);
                            *(gm::u32x4*)(f.yb + (size_t)a * D + c0) = w; } } } };
        gm::gemm_unit<true>((GM_LAS unsigned char*)lds, (const char*)f.actb, offA, (const char*)(f.d_t + (le * D + pn * 256) * FF), FF, epi);
    }
}

namespace rw {
typedef float f32x4 __attribute__((ext_vector_type(4)));
typedef unsigned u32x2 __attribute__((ext_vector_type(2)));
constexpr int ROWS_PB = 65;
__device__ __forceinline__ float wave_sum(float v) {
#pragma unroll
    for (int o = 32; o >= 1; o >>= 1) v += __shfl_xor(v, o);
    return v;
}
__device__ __forceinline__ unsigned pk2(float lo, float hi) { unsigned r; asm volatile("v_cvt_pk_bf16_f32 %0, %1, %2" : "=v"(r) : "v"(lo), "v"(hi)); return r; }
__device__ __forceinline__ f32x4 bf4(u32x2 w) { f32x4 r; r[0] = __uint_as_float(w.x << 16); r[1] = __uint_as_float(w.x & 0xffff0000u); r[2] = __uint_as_float(w.y << 16); r[3] = __uint_as_float(w.y & 0xffff0000u); return r; }
__device__ __forceinline__ void norm_store(const f32x4 (&x)[4], const float* g, const float* shift, const float* scale, bf16_t* dst, int lane) {
    float ss = 0.f;
#pragma unroll
    for (int j = 0; j < 4; ++j) ss += x[j][0] * x[j][0] + x[j][1] * x[j][1] + x[j][2] * x[j][2] + x[j][3] * x[j][3];
    ss = wave_sum(ss); const float rs = 1.0f / sqrtf(ss * (1.0f / D) + EPS);
#pragma unroll
    for (int j = 0; j < 4; ++j) { const int c = 4 * lane + 256 * j; const f32x4 gv = *(const f32x4*)(g + c), sh = *(const f32x4*)(shift + c), sc = *(const f32x4*)(scale + c);
        const f32x4 o = x[j] * rs * gv * (1.0f + sc) + sh; u32x2 w; w.x = pk2(o[0], o[1]); w.y = pk2(o[2], o[3]); *(u32x2*)(dst + c) = w; }
}
__device__ __forceinline__ void first_norm_phase(const P& p) {
    int tid = threadIdx.x; asm volatile("" : "+v"(tid)); const int wid = tid >> 6, lane = tid & 63;
    for (int i = wid; i < ROWS_PB; i += 8) { const int r = blockIdx.x * ROWS_PB + i; if (r >= M) break;
        const float* src = r < CTX ? p.ctx + (size_t)r * D : p.x + (size_t)(r - CTX) * D; f32x4 x[4];
#pragma unroll
        for (int j = 0; j < 4; ++j) { x[j] = *(const f32x4*)(src + 4 * lane + 256 * j); *(f32x4*)(p.xres + (size_t)r * D + 4 * lane + 256 * j) = x[j]; }
        norm_store(x, p.norm1_g, modv(p, 0, r, 0), modv(p, 0, r, 1), p.hb1 + (size_t)r * D, lane); }
}
__device__ __forceinline__ void combine_phase(const P& p, int l) {
    int tid = threadIdx.x; asm volatile("" : "+v"(tid)); const int wid = tid >> 6, lane = tid & 63;
    for (int i = wid; i < ROWS_PB; i += 8) { const int r = blockIdx.x * ROWS_PB + i; if (r >= M) break;
        const f32x4 tw = *(const f32x4*)(p.topw + (size_t)r * 4); const float* gate = modv(p, l, r, 5); f32x4 x[4];
#pragma unroll
        for (int j = 0; j < 4; ++j) { const int c = 4 * lane + 256 * j; f32x4 s = {0.f, 0.f, 0.f, 0.f};
#pragma unroll
            for (int k = 0; k < 4; ++k) s += bf4(*(const u32x2*)(p.ybn + ((size_t)r * 4 + k) * D + c)) * tw[k];
            x[j] = *(const f32x4*)(p.xres + (size_t)r * D + c) + *(const f32x4*)(gate + c) * s; }
        if (l + 1 < DEPTH) {
#pragma unroll
            for (int j = 0; j < 4; ++j) *(f32x4*)(p.xres + (size_t)r * D + 4 * lane + 256 * j) = x[j];
            norm_store(x, p.norm1_g + (size_t)(l + 1) * D, modv(p, l + 1, r, 0), modv(p, l + 1, r, 1), p.hb1 + (size_t)r * D, lane);
        } else if (r >= CTX) {
#pragma unroll
            for (int j = 0; j < 4; ++j) *(f32x4*)(p.out + (size_t)(r - CTX) * D + 4 * lane + 256 * j) = x[j];
        } }
}
__device__ __forceinline__ void router_phase(const P& p, int l, char* lds) {
    int tid = threadIdx.x; asm volatile("" : "+v"(tid)); const int wid = tid >> 6, lane = tid & 63;
    float* WT = (float*)lds; float* bias2 = WT + 32 * 1024; int* lcnt = (int*)(bias2 + 64); int* lbase = lcnt + 32; int* rec = lbase + 32;
    const float* rwp = p.router_w + (size_t)l * D * NE;
    for (int i = tid; i < D * NE / 4; i += 512) { const int k = i >> 3, e4 = i & 7; const f32x4 v = *(const f32x4*)(rwp + (size_t)k * NE + e4 * 4);
#pragma unroll
        for (int q = 0; q < 4; ++q) WT[(e4 * 4 + q) * 1024 + (k ^ (e4 << 2))] = v[q]; }
    if (tid < 32) lcnt[tid] = 0;
    __syncthreads();
    {
#pragma unroll
        for (int v = 0; v < 2; ++v) { const float* sh = p.mod + ((size_t)(l * 2 + v) * 6 + 3) * D; f32x4 s[4];
#pragma unroll
            for (int j = 0; j < 4; ++j) s[j] = *(const f32x4*)(sh + 4 * lane + 256 * j);
#pragma unroll
            for (int q = 0; q < 4; ++q) { const int e = wid * 4 + q; float a = 0.f;
#pragma unroll
                for (int j = 0; j < 4; ++j) { const f32x4 w = *(const f32x4*)(WT + e * 1024 + ((4 * lane + 256 * j) ^ (((e >> 2) & 7) << 2))); a += w[0] * s[j][0] + w[1] * s[j][1] + w[2] * s[j][2] + w[3] * s[j][3]; }
                a = wave_sum(a); if (lane == 0) bias2[v * 32 + e] = a + p.router_b[l * NE + e]; } }
    }
    __syncthreads();
    const float* g2 = p.norm2_g + (size_t)l * D;
    for (int rp = wid; rp < (ROWS_PB + 1) / 2; rp += 8) {
        float acc[2][32]; float rsv[2]; int rr[2];
        f32x4 xg[2][4];
#pragma unroll
        for (int q = 0; q < 2; ++q) { const int il = 2 * rp + q; const int r = blockIdx.x * ROWS_PB + (il < ROWS_PB ? il : ROWS_PB - 1); rr[q] = r;
            const float* sc = modv(p, l, r, 4); const float* sh = modv(p, l, r, 3); float ss = 0.f; f32x4 x[4];
#pragma unroll
            for (int j = 0; j < 4; ++j) { x[j] = *(const f32x4*)(p.xres + (size_t)r * D + 4 * lane + 256 * j); ss += x[j][0] * x[j][0] + x[j][1] * x[j][1] + x[j][2] * x[j][2] + x[j][3] * x[j][3]; }
            ss = wave_sum(ss); const float rs = 1.0f / sqrtf(ss * (1.0f / D) + EPS); rsv[q] = rs;
#pragma unroll
            for (int j = 0; j < 4; ++j) { const int c = 4 * lane + 256 * j; xg[q][j] = x[j] * *(const f32x4*)(g2 + c) * (1.0f + *(const f32x4*)(sc + c));
                const f32x4 o = xg[q][j] * rs + *(const f32x4*)(sh + c); u32x2 w; w.x = pk2(o[0], o[1]); w.y = pk2(o[2], o[3]); if (il < ROWS_PB) *(u32x2*)(p.hb2 + (size_t)r * D + c) = w; }
        }
#pragma unroll
        for (int e = 0; e < 32; ++e) { float a0 = 0.f, a1 = 0.f;
#pragma unroll
            for (int j = 0; j < 4; ++j) { const f32x4 w = *(const f32x4*)(WT + e * 1024 + ((4 * lane + 256 * j) ^ (((e >> 2) & 7) << 2)));
                a0 += w[0] * xg[0][j][0] + w[1] * xg[0][j][1] + w[2] * xg[0][j][2] + w[3] * xg[0][j][3]; a1 += w[0] * xg[1][j][0] + w[1] * xg[1][j][1] + w[2] * xg[1][j][2] + w[3] * xg[1][j][3]; }
            acc[0][e] = a0; acc[1][e] = a1; }
        float v[64];
#pragma unroll
        for (int e = 0; e < 32; ++e) { v[e] = acc[0][e]; v[32 + e] = acc[1][e]; }
#pragma unroll
        for (int m = 32, n = 64; m >= 1; m >>= 1, n >>= 1) {
#pragma unroll
            for (int i = 0; i < n / 2; ++i) { const bool up = (lane & m) != 0; const float keep = up ? v[i + n / 2] : v[i], send = up ? v[i] : v[i + n / 2]; v[i] = keep + __shfl_xor(send, m); } }
        const int q = lane >> 5, e = lane & 31; const int r = rr[q]; const int il = 2 * rp + q;
        float logit = v[0] * rsv[q] + bias2[(r < CTX ? 32 : 0) + e];
        float cur = logit; int sel[4]; float sv[4];
#pragma unroll
        for (int k = 0; k < 4; ++k) { float mx = cur;
#pragma unroll
            for (int o = 16; o >= 1; o >>= 1) mx = fmaxf(mx, __shfl_xor(mx, o));
            const unsigned long long bal = __ballot(cur == mx); const unsigned half = (unsigned)(bal >> (q * 32)); const int win = __ffs(half) - 1;
            sel[k] = win; sv[k] = mx; if (e == win) cur = -3.0e38f; }
        if (e < 4 && il < ROWS_PB) {
            float es[4], sum = 0.f;
#pragma unroll
            for (int k = 0; k < 4; ++k) { es[k] = __expf(sv[k] - sv[0]); sum += es[k]; }
            const int myk = e; const int mye = myk == 0 ? sel[0] : myk == 1 ? sel[1] : myk == 2 ? sel[2] : sel[3]; const float myw = (myk == 0 ? es[0] : myk == 1 ? es[1] : myk == 2 ? es[2] : es[3]) / sum;
            p.topw[(size_t)r * 4 + myk] = myw; const int pos = atomicAdd(&lcnt[mye], 1); rec[il * 4 + myk] = mye | (pos << 8);
        }
    }
    __syncthreads();
    if (tid < 32) lbase[tid] = atomicAdd(&p.cnt[tid], lcnt[tid]);
    __syncthreads();
    if (tid < ROWS_PB * 4) { const int il = tid >> 2, k = tid & 3; const int r = blockIdx.x * ROWS_PB + il; const int rc = rec[tid]; const int e = rc & 255, pos = rc >> 8;
        p.list[(size_t)e * M + lbase[e] + pos] = r * 4 + k; }
    __syncthreads();
}
}

#ifndef CHECK_GEMM
#define CHECK_GEMM 0
#endif
__device__ __forceinline__ int gtid() { int t = threadIdx.x; asm volatile("" : "+v"(t)); return blockIdx.x * 512 + t; }
template <int OP> __device__ __forceinline__ void run_op(const P& p, int l) {
    const long n = op_count(OP); const long stride = (long)gridDim.x * blockDim.x;
    for (long i = gtid(); i < n; i += stride) op_run(OP, p, l, i);
}
struct KArgs { P p; FW f; unsigned* bar; };
__device__ __forceinline__ const KArgs& kargs() { auto q = __builtin_amdgcn_kernarg_segment_ptr(); asm volatile("" : "+s"(q)); return *(const KArgs*)q; }
constexpr int LDS_BYTES = gm::STAGE_BYTES + 4096;
#define BAR() do { XcdBarrier b2_; b2_.bar = kargs().bar; unsigned xx_ = xbx; asm volatile("" : "+s"(xx_)); b2_.x = xx_; b2_.st = (volatile LAS unsigned*)(lds + LDS_BYTES - 16); xcd_barrier(b2_); } while (0)
#define PH(OPX) do { run_op<OPX>(kargs().p, lo()); BAR(); } while (0)
#define RUN(OPX) run_op<OPX>(kargs().p, lo())

__device__ __forceinline__ void attn_phase(const P& p, float* O, int ldo, char* lds) {
    constexpr int NQT = M / 256, NU = NH * NQT;
    for (int u = blockIdx.x; u < NU; u += gridDim.x) {
        const int hh = u / NQT, qt = u % NQT; const int seq = qt == 0 ? CTX : M;
        __syncthreads();
        at::attn_body(p.qb + (size_t)qt * 256 * at::LDQ + hh * at::DQ, p.kb + hh * at::DQ, p.vb + hh * at::DV, O + (size_t)qt * 256 * ldo + hh * at::DV, ldo, seq, lds);
    }
    __syncthreads();
}
template <class TA> __device__ __forceinline__ float ldf(const TA* a, size_t i);
template <> __device__ __forceinline__ float ldf<float>(const float* a, size_t i) { return a[i]; }
template <> __device__ __forceinline__ float ldf<bf16_t>(const bf16_t* a, size_t i) { return bf2f(a[i]); }
template <class TA> __device__ __forceinline__ void chk_accum(const TA* a, int lda, const float* b, int ldb, long nrows, int ncols, float* diag) {
    float sd = 0.f, sr = 0.f; const long n = nrows * ncols; const long stride = (long)gridDim.x * blockDim.x;
    for (long i = gtid(); i < n; i += stride) { const long r = i / ncols; const int c = (int)(i % ncols);
        const float x = ldf<TA>(a, r * lda + c), y = b[r * ldb + c]; sd += (x - y) * (x - y); sr += y * y; }
    for (int o = 32; o >= 1; o >>= 1) { sd += __shfl_xor(sd, o); sr += __shfl_xor(sr, o); }
    if ((threadIdx.x & 63) == 0) { atomicAdd(diag, sd); atomicAdd(diag + 1, sr); }
}
#define LAYER_BODY(L) { const int l = (L); \
        auto lo = [&]() { int ll = l; asm volatile("" : "+s"(ll)); return ll; }; \
        if (blockIdx.x == 0 && threadIdx.x < NE) KP.cnt[threadIdx.x] = 0; \
        inproj_phase(KP, KF, lo(), KP.proj, lds); BAR(); \
        PH(OP_LATNORM); \
        RUN(OP_QRAW); PH(OP_KVRAW); \
        RUN(OP_QHEAD); RUN(OP_KHEAD); RUN(OP_CONV); RUN(OP_DT); PH(OP_POOLP); \
        RUN(OP_SSD_CS); RUN(OP_SSD_G); PH(OP_POOLMM); \
        attn_phase(KP, KP.mixin, MIXW, lds); \
        RUN(OP_SSD_YD); PH(OP_SSD_ST); PH(OP_SSD_CARRY); PH(OP_SSD_YOFF); \
        PH(OP_SSDFIN); PH(OP_MIXB); \
        outproj_phase<true>(KP, KF, lo(), KP.xres, lds); BAR(); \
        rw::router_phase(KP, lo(), lds); BAR(); \
        moe1_phase(KP, KF, lo(), lds); BAR(); moe2_phase(KP, KF, lo(), lds); BAR(); \
        rw::combine_phase(KP, lo()); BAR(); \
    }
__global__ void __launch_bounds__(512, 2) k_mega(KArgs a) {
    extern __shared__ __attribute__((aligned(16))) char lds[];
    uint4* xbw = (uint4*)(lds + LDS_BYTES - 16);
    if (threadIdx.x == 0) *xbw = make_uint4(0u, 0u, 0u, 0u);
    __syncthreads();
    const unsigned xbx = xcd_barrier_post(kargs().bar, (volatile LAS unsigned*)xbw).x;
#define KP kargs().p
#define KF kargs().f
    { const int l = 0; auto lo = [&]() { return l; }; if (blockIdx.x == 0 && threadIdx.x < 16) KP.diag[threadIdx.x] = 0.f; RUN(OP_MODVEC);
      cvt_phase(KP, KF, 0, DEPTH, lds); BAR(); rw::first_norm_phase(KP); BAR(); }
    LAYER_BODY(0) LAYER_BODY(1) LAYER_BODY(2) LAYER_BODY(3)
#undef KP
#undef KF
}
static size_t carve(char*& cur, size_t bytes) { size_t a = (bytes + 255) & ~(size_t)255; cur += a; return a; }
static bool setup_params(P& p, FW& f, unsigned*& bar, void* const* d_in, void* d_out, void* d_ws, size_t ws_size) {
    const float** pp = (const float**)&p; for (int i = 0; i < 32; ++i) pp[i] = (const float*)d_in[i];
    p.out = (float*)d_out;
    char* cur = (char*)d_ws; char* base = cur;
    bar = (unsigned*)cur; carve(cur, XCD_BAR_WORDS * sizeof(unsigned));
#define CARVE(field, type, count) p.field = (type*)cur; carve(cur, (size_t)(count) * sizeof(type));
#define CARVEF(field, type, count) f.field = (type*)cur; carve(cur, (size_t)(count) * sizeof(type));
    CARVE(xres, float, (size_t)M * D) CARVE(mod, float, (size_t)DEPTH * 12 * D) CARVE(rs, float, M) CARVE(h, float, (size_t)M * D) CARVE(proj, float, (size_t)M * INC) CARVE(qln, float, (size_t)M * QL)
    CARVE(kvln, float, (size_t)M * KVL) CARVE(qraw, float, (size_t)M * NH * QKD) CARVE(kvraw, float, (size_t)M * NH * 128) CARVE(q, float, (size_t)M * NH * QKD) CARVE(k, float, (size_t)M * NH * QKD)
    CARVE(v, float, (size_t)M * NH * VD) CARVE(mixin, float, (size_t)M * MIXW) CARVE(xbc, float, (size_t)M * CONVD) CARVE(dt, float, (size_t)M * 12) CARVE(ydir, float, (size_t)2 * M * SW)
    CARVE(poolp, float, (size_t)M * PW) CARVE(mix, float, (size_t)M * D) CARVE(logits, float, (size_t)M * NE) CARVE(topw, float, (size_t)M * 4)
    CARVE(topi, int, (size_t)M * 4) CARVE(cnt, int, NE) CARVE(list, int, (size_t)NE * M)
    CARVE(qb, bf16_t, (size_t)M * NH * QKD) CARVE(kb, bf16_t, (size_t)M * NH * QKD) CARVE(vb, bf16_t, (size_t)M * NH * VD) CARVE(diag, float, 64)
    CARVE(cs, float, (size_t)2 * M * SH) CARVE(cdec, float, (size_t)2 * NCH * SH) CARVE(gmat, float, (size_t)M * SG * CHUNK) CARVE(st, float, (size_t)2 * NCH * SH * SP * SN)
    CARVE(hb1, bf16_t, (size_t)M * D) CARVE(hb2, bf16_t, (size_t)M * D) CARVE(mixb, bf16_t, (size_t)M * MIXW)
    CARVEF(actb, bf16_t, (size_t)4 * M * FF) CARVEF(yb, bf16_t, (size_t)4 * M * D)
    f.hb1 = p.hb1; f.hb2 = p.hb2; f.mixb = p.mixb; p.ybn = f.yb; p.attf = nullptr;
    const int nl = DEPTH;
    CARVEF(w_in_t, bf16_t, (size_t)nl * INC_PAD * D) CARVEF(w_out_t, bf16_t, (size_t)nl * D * MIXW) CARVEF(gu_t, bf16_t, (size_t)nl * NE * 2 * FF * D) CARVEF(d_t, bf16_t, (size_t)nl * NE * D * FF)
#if CHECK_GEMM
    CARVE(act, float, (size_t)M * 4 * FF) CARVE(down, float, (size_t)M * 4 * D)
    f.proj2 = p.qraw; f.mix2 = p.qraw + (size_t)M * INC;
#else
    p.act = nullptr; p.down = nullptr; f.proj2 = nullptr; f.mix2 = nullptr;
#endif
#undef CARVE
#undef CARVEF
    return (size_t)(cur - base) <= ws_size;
}
extern "C" void kernel_launch(void* const* d_in, const int* in_sizes, int n_in, void* d_out, int out_size, void* d_ws, size_t ws_size, hipStream_t stream) {
    KArgs a{};
    if (n_in < 32 || !setup_params(a.p, a.f, a.bar, d_in, d_out, d_ws, ws_size)) return;
    static int grid = 0;
    if (!grid) { int dev = 0, cus = 0, per_cu = 0; (void)hipGetDevice(&dev); (void)hipDeviceGetAttribute(&cus, hipDeviceAttributeMultiprocessorCount, dev);
        (void)hipFuncSetAttribute((const void*)k_mega, hipFuncAttributeMaxDynamicSharedMemorySize, LDS_BYTES);
        (void)hipOccupancyMaxActiveBlocksPerMultiprocessor(&per_cu, k_mega, 512, LDS_BYTES); grid = cus * (per_cu < 1 ? per_cu : 1); }
    if (grid <= 0) return;
    (void)hipMemsetAsync(a.bar, 0, XCD_BAR_WORDS * sizeof(unsigned), stream);
    hipLaunchKernelGGL(k_mega, dim3(grid), dim3(512), LDS_BYTES, stream, a);
}
```

```cpp
#include <hip/hip_runtime.h>
#include <stdint.h>
#define CHECK_MLA 0

#ifndef NAIVE_H
#define NAIVE_H
#include <math.h>
#ifdef HOST_TEST
#define HD inline
#define HDC inline
#define ATOMIC_INC(p) ((*(p))++)
#define UNIFORM(x) (x)
#else
#define HD __device__ __forceinline__
#define HDC __host__ __device__ __forceinline__
#define ATOMIC_INC(p) atomicAdd((p), 1)
#define UNIFORM(x) __builtin_amdgcn_readfirstlane(x)
#endif

#ifndef CFG_D
#define CFG_D 1024
#define CFG_SEQ 16384
#define CFG_CTX 256
#define CFG_FF 1024
#define CFG_DEPTH 4
#endif
constexpr int D = CFG_D, SEQ = CFG_SEQ, CTX = CFG_CTX, FF = CFG_FF, DEPTH = CFG_DEPTH;
constexpr int M = CTX + SEQ;
constexpr int GRID_W = 64;
constexpr int NH = 6, QKD = 96, NOPE = 64, ROPE = 32, VD = 64, QL = 256, KVL = 128;
constexpr int SH = 6, SP = 64, SW = 384, SG = 2, SN = 64, CONVD = 640, CHUNK = 128;
constexpr int PW = 256, MIXW = 1024, INC = 1708;
constexpr int C_Q = 0, C_KV = 256, C_KR = 384, C_Z = 416, C_XBC = 800, C_DT = 1440, C_POOL = 1452;
constexpr int NE = 32, TOPK = 4;
constexpr int NCH = M / CHUNK;
constexpr float EPS = 1e-6f;

typedef unsigned short bf16_t;
HD bf16_t f2bf(float f) { union { float f; unsigned u; } v; v.f = f; unsigned u = v.u; u += 0x7FFFu + ((u >> 16) & 1u); return (bf16_t)(u >> 16); }
HD float bf2f(bf16_t b) { union { float f; unsigned u; } v; v.u = ((unsigned)b) << 16; return v.f; }
struct P {
    const float *x, *c, *ctx, *c_ctx, *norm1_g, *norm2_g, *mod_w, *mod_b, *w_in, *q_g, *kv_g, *w_uq, *w_ukv, *qn_g, *kn_g;
    const float *conv_w, *conv_b, *a_log, *dt_bias, *ssd_d, *ssd_norm_g, *pool_w, *pool_scale, *w_out, *router_w, *router_b;
    const float *wg, *bg, *wu, *bu, *wd, *bd;
    float* out;
    float *xres, *mod, *rs, *h, *proj, *qln, *kvln, *qraw, *kvraw, *q, *k, *v, *mixin, *xbc, *dt, *ydir, *poolp, *mix, *logits, *topw, *act, *down;
    int *topi, *cnt, *list;
    bf16_t *qb, *kb, *vb;
    float *attf, *diag;
    float *cs, *cdec, *gmat, *st;
    bf16_t *hb1, *hb2, *mixb, *ybn;
};

HD float siluf(float x) { return x / (1.0f + expf(-x)); }
HD float sigmf(float x) { return 1.0f / (1.0f + expf(-x)); }
HD float softplusf(float x) { return x > 20.0f ? x : log1pf(expf(x)); }
HD const float* modv(const P& p, int l, int r, int j) { return p.mod + ((size_t)(l * 2 + (r < CTX ? 1 : 0)) * 6 + j) * D; }

enum { OP_COPY_IN = 0, OP_MODVEC, OP_ROWSTAT, OP_NORM1, OP_INPROJ, OP_LATNORM, OP_QRAW, OP_KVRAW, OP_QHEAD, OP_KHEAD, OP_ATTN, OP_CONV, OP_DT, OP_SSDSCAN, OP_SSDFIN,
       OP_POOLP, OP_POOLMM, OP_OUTPROJ, OP_RES1, OP_NORM2, OP_LOGITS, OP_ZEROCNT, OP_TOPK, OP_GATEUP, OP_DOWN, OP_COMBINE, OP_WRITE_OUT, OP_MIXB, OP_COMBINE2, OP_SSD_CS, OP_SSD_G, OP_SSD_YD, OP_SSD_ST, OP_SSD_CARRY, OP_SSD_YOFF, OP_COUNT };

HDC long op_count(int op) {
    switch (op) {
        case OP_COPY_IN: return (long)M * D;
        case OP_MODVEC: return (long)DEPTH * 2 * 6 * D;
        case OP_ROWSTAT: return M;
        case OP_NORM1: case OP_NORM2: return (long)M * D;
        case OP_INPROJ: return (long)(M / 8) * INC;
        case OP_LATNORM: return 2L * M;
        case OP_QRAW: return (long)(M / 8) * (NH * QKD);
        case OP_KVRAW: return (long)(M / 8) * (NH * 128);
        case OP_QHEAD: case OP_KHEAD: return (long)M * NH;
        case OP_ATTN: return (long)M * NH;
        case OP_CONV: return (long)M * CONVD;
        case OP_DT: return (long)M * 12;
        case OP_SSDSCAN: return 2L * SH * SP;
        case OP_SSDFIN: return M;
        case OP_POOLP: return (long)M * PW;
        case OP_POOLMM: return (long)M * PW;
        case OP_OUTPROJ: return (long)(M / 8) * D;
        case OP_RES1: return (long)M * D;
        case OP_LOGITS: return (long)M * NE;
        case OP_ZEROCNT: return NE;
        case OP_TOPK: return M;
        case OP_GATEUP: return (long)NE * (M / 8) * FF;
        case OP_DOWN: return (long)NE * (M / 8) * D;
        case OP_COMBINE: return (long)M * D;
        case OP_WRITE_OUT: return (long)SEQ * D;
        case OP_MIXB: return (long)M * MIXW;
        case OP_COMBINE2: return (long)M * D;
        case OP_SSD_CS: return 2L * NCH * SH;
        case OP_SSD_G: return (long)M * SG * CHUNK;
        case OP_SSD_YD: return (long)M * SW;
        case OP_SSD_ST: return 2L * NCH * SH * SP * SN;
        case OP_SSD_CARRY: return 2L * SH * SP * SN;
        case OP_SSD_YOFF: return (long)M * SW;
    }
    return 0;
}

HD void gemm8(const float* A, int lda, const float* B, int ldb, const float* bias, float* C, int ldc, int N, int K, long idx) {
    const int j = (int)(idx % N); const long r0 = (idx / N) * 8;
    float acc[8];
#pragma unroll
    for (int i = 0; i < 8; ++i) acc[i] = 0.f;
    const float* a = A + r0 * lda;
    for (int k = 0; k < K; ++k) {
        const float b = B[(size_t)k * ldb + j];
#pragma unroll
        for (int i = 0; i < 8; ++i) acc[i] += a[(size_t)i * lda + k] * b;
    }
    const float bv = bias ? bias[j] : 0.f;
#pragma unroll
    for (int i = 0; i < 8; ++i) C[(r0 + i) * ldc + j] = acc[i] + bv;
}

HD void sincos_rr(float angf, float& cs, float& sn) {
    const double x = (double)angf; const double n = rint(x * 0.63661977236758134308); const double y = (x - n * 1.57079632679489655800) - n * 6.123233995736766e-17; const double y2 = y * y;
    const double s = y * (1.0 + y2 * (-1.0 / 6 + y2 * (1.0 / 120 + y2 * (-1.0 / 5040 + y2 * (1.0 / 362880 + y2 * (-1.0 / 39916800))))));
    const double c = 1.0 + y2 * (-0.5 + y2 * (1.0 / 24 + y2 * (-1.0 / 720 + y2 * (1.0 / 40320 + y2 * (-1.0 / 3628800 + y2 * (1.0 / 479001600))))));
    const int q = ((int)n) & 3; const double cc = (q == 0) ? c : (q == 1) ? -s : (q == 2) ? -c : s; const double ss = (q == 0) ? s : (q == 1) ? c : (q == 2) ? -s : -c;
    cs = (float)cc; sn = (float)ss;
}
HD float rope_inv_freq(int f) { return f == 0 ? 1.0f : f == 1 ? 0.31622776f : f == 2 ? 0.1f : f == 3 ? 0.031622775f : f == 4 ? 0.01f : f == 5 ? 0.0031622776f : f == 6 ? 0.001f : 0.00031622776f; }
HD void rope_apply(float* v32, int t) {
    const float row = (float)(t / GRID_W), col = (float)(t % GRID_W);
#pragma unroll
    for (int a = 0; a < 2; ++a)
#pragma unroll
        for (int f = 0; f < 8; ++f) {
            const float ang = (a == 0 ? row : col) * rope_inv_freq(f);
            float cs, sn; sincos_rr(ang, cs, sn);
            const float x1 = v32[a * 16 + f], x2 = v32[a * 16 + 8 + f];
            v32[a * 16 + f] = x1 * cs - x2 * sn; v32[a * 16 + 8 + f] = x2 * cs + x1 * sn;
        }
}

HD void op_run(int op, const P& p, int l, long idx) {
    switch (op) {
    case OP_COPY_IN: { const long r = idx / D; const int c = (int)(idx % D); p.xres[idx] = r < CTX ? p.ctx[idx] : p.x[(r - CTX) * D + c]; } break;
    case OP_MODVEC: {
        const int j = (int)(idx % (6 * D)); const int which = (int)((idx / (6 * D)) % 2); const int ll = (int)(idx / (12 * D));
        const float* cv = which ? p.c_ctx : p.c; float s = 0.f;
        for (int k = 0; k < D; ++k) s += siluf(cv[k]) * p.mod_w[((size_t)ll * D + k) * (6 * D) + j];
        p.mod[idx] = s + p.mod_b[(size_t)ll * 6 * D + j];
    } break;
    case OP_ROWSTAT: { const float* xr = p.xres + idx * D; float s = 0.f; for (int k = 0; k < D; ++k) s += xr[k] * xr[k]; p.rs[idx] = 1.0f / sqrtf(s / D + EPS); } break;
    case OP_NORM1: case OP_NORM2: { const int r = (int)(idx / D), c = (int)(idx % D); const int o = op == OP_NORM1 ? 0 : 3;
        const float g = (op == OP_NORM1 ? p.norm1_g : p.norm2_g)[l * D + c];
        const float hv = p.xres[idx] * p.rs[r] * g * (1.0f + modv(p, l, r, o + 1)[c]) + modv(p, l, r, o)[c]; p.h[idx] = hv;
        bf16_t* hb = op == OP_NORM1 ? p.hb1 : p.hb2; if (hb) hb[idx] = f2bf(hv); } break;
    case OP_INPROJ: gemm8(p.h, D, p.w_in + (size_t)l * D * INC, INC, nullptr, p.proj, INC, INC, D, idx); break;
    case OP_LATNORM: {
        const int which = idx >= M; const long r = which ? idx - M : idx; const int n = which ? KVL : QL; const float* src = p.proj + r * INC + (which ? C_KV : C_Q);
        float s = 0.f; for (int k = 0; k < n; ++k) s += src[k] * src[k]; const float rs = 1.0f / sqrtf(s / n + EPS);
        float* dst = which ? p.kvln + r * KVL : p.qln + r * QL; const float* g = which ? p.kv_g + l * KVL : p.q_g + l * QL;
        for (int k = 0; k < n; ++k) dst[k] = src[k] * rs * g[k];
    } break;
    case OP_QRAW: gemm8(p.qln, QL, p.w_uq + (size_t)l * QL * (NH * QKD), NH * QKD, nullptr, p.qraw, NH * QKD, NH * QKD, QL, idx); break;
    case OP_KVRAW: gemm8(p.kvln, KVL, p.w_ukv + (size_t)l * KVL * (NH * 128), NH * 128, nullptr, p.kvraw, NH * 128, NH * 128, KVL, idx); break;
    case OP_QHEAD: { const int r = (int)(idx / NH), hh = (int)(idx % NH); const float* src = p.qraw + (size_t)r * (NH * QKD) + hh * QKD; float s = 0.f;
        for (int d = 0; d < QKD; ++d) s += src[d] * src[d]; const float rs = 1.0f / sqrtf(s / QKD + EPS);
        float* dst = p.q + ((size_t)r * NH + hh) * QKD; float rp[32];
        for (int d = 0; d < NOPE; ++d) dst[d] = src[d] * rs * p.qn_g[l * QKD + d];
#pragma unroll
        for (int d = 0; d < 32; ++d) rp[d] = src[NOPE + d] * rs * p.qn_g[l * QKD + NOPE + d];
        if (r >= CTX) rope_apply(rp, r - CTX);
#pragma unroll
        for (int d = 0; d < 32; ++d) dst[NOPE + d] = rp[d];
        bf16_t* db = p.qb + ((size_t)r * NH + hh) * QKD;
        for (int d = 0; d < QKD; ++d) db[d] = f2bf(dst[d]);
    } break;
    case OP_KHEAD: { const int r = (int)(idx / NH), hh = (int)(idx % NH); const float* kn = p.kvraw + (size_t)r * (NH * 128) + hh * 128; const float* kr = p.proj + (size_t)r * INC + C_KR; float s = 0.f;
        for (int d = 0; d < NOPE; ++d) s += kn[d] * kn[d];
        for (int d = 0; d < ROPE; ++d) s += kr[d] * kr[d];
        const float rs = 1.0f / sqrtf(s / QKD + EPS);
        float* dst = p.k + ((size_t)r * NH + hh) * QKD; float rp[32];
        for (int d = 0; d < NOPE; ++d) dst[d] = kn[d] * rs * p.kn_g[l * QKD + d];
#pragma unroll
        for (int d = 0; d < 32; ++d) rp[d] = kr[d] * rs * p.kn_g[l * QKD + NOPE + d];
        if (r >= CTX) rope_apply(rp, r - CTX);
#pragma unroll
        for (int d = 0; d < 32; ++d) dst[NOPE + d] = rp[d];
        float* vd = p.v + ((size_t)r * NH + hh) * VD;
        for (int d = 0; d < VD; ++d) vd[d] = kn[NOPE + d];
        bf16_t* db = p.kb + ((size_t)r * NH + hh) * QKD; bf16_t* vdb = p.vb + ((size_t)r * NH + hh) * VD;
        for (int d = 0; d < QKD; ++d) db[d] = f2bf(dst[d]);
        for (int d = 0; d < VD; ++d) vdb[d] = f2bf(kn[NOPE + d]);
    } break;
    case OP_ATTN: {
        const int r = (int)(idx % M), hh = UNIFORM((int)(idx / M)); const int nk = r < CTX ? CTX : M;
        float qv[QKD];
        const float* qp = p.q + ((size_t)r * NH + hh) * QKD; const float scale = 1.0f / sqrtf((float)QKD);
#pragma unroll
        for (int d = 0; d < QKD; ++d) qv[d] = qp[d] * scale;
        for (int half = 0; half < 2; ++half) {
            float o[32];
#pragma unroll
            for (int d = 0; d < 32; ++d) o[d] = 0.f;
            float mx = -1e30f, lsum = 0.f;
            for (int kk = 0; kk < nk; ++kk) {
                const float* kp = p.k + ((size_t)kk * NH + hh) * QKD; const float* vp = p.v + ((size_t)kk * NH + hh) * VD + half * 32; float s = 0.f;
#pragma unroll
                for (int d = 0; d < QKD; ++d) s += qv[d] * kp[d];
                const float mn = s > mx ? s : mx; const float corr = expf(mx - mn), pe = expf(s - mn);
                lsum = lsum * corr + pe; mx = mn;
#pragma unroll
                for (int d = 0; d < 32; ++d) o[d] = o[d] * corr + pe * vp[d];
            }
            const float inv = 1.0f / lsum; float* dst = p.mixin + (size_t)r * MIXW + hh * VD + half * 32;
#pragma unroll
            for (int d = 0; d < 32; ++d) dst[d] = o[d] * inv;
        }
    } break;
    case OP_CONV: { const int r = (int)(idx / CONVD), c = (int)(idx % CONVD); const int seg0 = r < CTX ? 0 : CTX, n = r < CTX ? CTX : SEQ, t = r - seg0; float y = p.conv_b[l * CONVD + c];
#pragma unroll
        for (int j = 0; j < 4; ++j) { const int tt = t - 2 + j; if (tt >= 0 && tt < n) y += p.conv_w[((size_t)l * 4 + j) * CONVD + c] * p.proj[(size_t)(seg0 + tt) * INC + C_XBC + c]; }
        p.xbc[idx] = siluf(y); } break;
    case OP_DT: { const int r = (int)(idx / 12), j = (int)(idx % 12); p.dt[idx] = softplusf(p.proj[(size_t)r * INC + C_DT + j] + p.dt_bias[l * 12 + j]); } break;
    case OP_SSDSCAN: {
        const int pp = (int)(idx % SP), hh = UNIFORM((int)((idx / SP) % SH)), dir = UNIFORM((int)(idx / (SP * SH))); const int g = hh / (SH / SG);
        const float a = -expf(p.a_log[l * 12 + dir * 6 + hh]); float st[SN];
#pragma unroll
        for (int n = 0; n < SN; ++n) st[n] = 0.f;
        for (int step = 0; step < M; ++step) {
            const int r = dir == 0 ? step : (step < CTX ? CTX - 1 - step : M - 1 - (step - CTX));
            const float dtv = p.dt[(size_t)r * 12 + dir * 6 + hh]; const float dA = expf(dtv * a); const float xv = p.xbc[(size_t)r * CONVD + hh * SP + pp] * dtv;
            const float* Bp = p.xbc + (size_t)r * CONVD + SW + g * SN; const float* Cp = p.xbc + (size_t)r * CONVD + SW + SG * SN + g * SN; float y = 0.f;
#pragma unroll
            for (int n = 0; n < SN; ++n) { st[n] = st[n] * dA + xv * Bp[n]; y += st[n] * Cp[n]; }
            p.ydir[((size_t)dir * M + r) * SW + hh * SP + pp] = y;
        }
    } break;
    case OP_SSDFIN: { const long r = idx; float ss = 0.f;
        for (int c = 0; c < SW; ++c) { const float y = p.ydir[r * SW + c] + p.ydir[((size_t)M + r) * SW + c] + p.ssd_d[l * SH + c / SP] * p.xbc[r * CONVD + c]; const float gv = y * siluf(p.proj[r * INC + C_Z + c]); ss += gv * gv; }
        const float rs = 1.0f / sqrtf(ss / SW + EPS);
        for (int c = 0; c < SW; ++c) { const float y = p.ydir[r * SW + c] + p.ydir[((size_t)M + r) * SW + c] + p.ssd_d[l * SH + c / SP] * p.xbc[r * CONVD + c]; const float gv = y * siluf(p.proj[r * INC + C_Z + c]);
            p.mixin[r * MIXW + NH * VD + c] = gv * rs * p.ssd_norm_g[l * SW + c]; }
    } break;
    case OP_POOLP: { const int r = (int)(idx / PW), c = (int)(idx % PW); const int gi = c / 64; const int win = 2 << gi; const int seg0 = r < CTX ? 0 : CTX, n = r < CTX ? CTX : SEQ, t = r - seg0;
        int lo = t - win / 2, hi = t - win / 2 + win; lo = lo < 0 ? 0 : lo; hi = hi > n ? n : hi; float s = 0.f;
        for (int tt = lo; tt < hi; ++tt) s += p.proj[(size_t)(seg0 + tt) * INC + C_POOL + c];
        p.poolp[idx] = s / (float)(hi - lo) - p.proj[(size_t)r * INC + C_POOL + c]; } break;
    case OP_POOLMM: { const int r = (int)(idx / PW), c = (int)(idx % PW); const int gi = c / 64, d = c % 64; float s = 0.f;
        for (int cc = 0; cc < 64; ++cc) s += p.poolp[(size_t)r * PW + gi * 64 + cc] * p.pool_w[(((size_t)l * 4 + gi) * 64 + cc) * 64 + d];
        p.mixin[(size_t)r * MIXW + NH * VD + SW + c] = s * p.pool_scale[l * PW + c]; } break;
    case OP_OUTPROJ: gemm8(p.mixin, MIXW, p.w_out + (size_t)l * MIXW * D, D, nullptr, p.mix, D, D, MIXW, idx); break;
    case OP_RES1: { const int r = (int)(idx / D), c = (int)(idx % D); p.xres[idx] += modv(p, l, r, 2)[c] * p.mix[idx]; } break;
    case OP_LOGITS: { const int r = (int)(idx / NE), e = (int)(idx % NE); const float* hr = p.h + (size_t)r * D; float s = 0.f;
        for (int k = 0; k < D; ++k) s += hr[k] * p.router_w[((size_t)l * D + k) * NE + e];
        p.logits[idx] = s + p.router_b[l * NE + e]; } break;
    case OP_ZEROCNT: p.cnt[idx] = 0; break;
    case OP_TOPK: { const long t = idx; float lg[NE];
#pragma unroll
        for (int e = 0; e < NE; ++e) lg[e] = p.logits[t * NE + e];
        int sel[4]; float sv[4];
#pragma unroll
        for (int kk = 0; kk < 4; ++kk) { float best = -3.0e38f; int bi = 0;
#pragma unroll
            for (int e = 0; e < NE; ++e) { bool taken = false;
#pragma unroll
                for (int q = 0; q < kk; ++q) taken = taken || (sel[q] == e);
                if (!taken && lg[e] > best) { best = lg[e]; bi = e; } }
            sel[kk] = bi; sv[kk] = best; }
        float es[4], sum = 0.f;
#pragma unroll
        for (int kk = 0; kk < 4; ++kk) { es[kk] = expf(sv[kk] - sv[0]); sum += es[kk]; }
#pragma unroll
        for (int kk = 0; kk < 4; ++kk) { p.topi[t * 4 + kk] = sel[kk]; p.topw[t * 4 + kk] = es[kk] / sum; const int pos = ATOMIC_INC(&p.cnt[sel[kk]]); p.list[(size_t)sel[kk] * M + pos] = (int)(t * 4 + kk); }
    } break;
    case OP_GATEUP: {
        const int j = (int)(idx % FF); const long rest = idx / FF; const int rb = (int)(rest % (M / 8)), e = (int)(rest / (M / 8)); const int cnt = p.cnt[e]; if (rb * 8 >= cnt) break;
        int a[8]; float g[8], u[8];
#pragma unroll
        for (int i = 0; i < 8; ++i) { a[i] = rb * 8 + i < cnt ? p.list[(size_t)e * M + rb * 8 + i] : -1; g[i] = 0.f; u[i] = 0.f; }
        const float* wgp = p.wg + ((size_t)l * NE + e) * D * FF + j; const float* wup = p.wu + ((size_t)l * NE + e) * D * FF + j;
        for (int k = 0; k < D; ++k) { const float gw = wgp[(size_t)k * FF], uw = wup[(size_t)k * FF];
#pragma unroll
            for (int i = 0; i < 8; ++i) { const float xv = p.h[(size_t)(a[i] < 0 ? 0 : a[i] / 4) * D + k]; g[i] += xv * gw; u[i] += xv * uw; } }
        const float bgv = p.bg[((size_t)l * NE + e) * FF + j], buv = p.bu[((size_t)l * NE + e) * FF + j];
#pragma unroll
        for (int i = 0; i < 8; ++i) if (a[i] >= 0) { float gv = g[i] + bgv; gv = gv < 7.0f ? gv : 7.0f; float uv = u[i] + buv; uv = uv < -7.0f ? -7.0f : (uv > 7.0f ? 7.0f : uv);
            p.act[(size_t)a[i] * FF + j] = gv * sigmf(1.702f * gv) * (uv + 1.0f); }
    } break;
    case OP_DOWN: {
        const int j = (int)(idx % D); const long rest = idx / D; const int rb = (int)(rest % (M / 8)), e = (int)(rest / (M / 8)); const int cnt = p.cnt[e]; if (rb * 8 >= cnt) break;
        int a[8]; float o[8];
#pragma unroll
        for (int i = 0; i < 8; ++i) { a[i] = rb * 8 + i < cnt ? p.list[(size_t)e * M + rb * 8 + i] : -1; o[i] = 0.f; }
        const float* wdp = p.wd + ((size_t)l * NE + e) * FF * D + j;
        for (int k = 0; k < FF; ++k) { const float w = wdp[(size_t)k * D];
#pragma unroll
            for (int i = 0; i < 8; ++i) o[i] += p.act[(size_t)(a[i] < 0 ? 0 : a[i]) * FF + k] * w; }
        const float bv = p.bd[((size_t)l * NE + e) * D + j];
#pragma unroll
        for (int i = 0; i < 8; ++i) if (a[i] >= 0) p.down[(size_t)a[i] * D + j] = o[i] + bv;
    } break;
    case OP_COMBINE: { const int r = (int)(idx / D), c = (int)(idx % D); float s = 0.f;
#pragma unroll
        for (int kk = 0; kk < 4; ++kk) s += p.topw[(size_t)r * 4 + kk] * p.down[((size_t)r * 4 + kk) * D + c];
        p.xres[idx] += modv(p, l, r, 5)[c] * s; } break;
    case OP_WRITE_OUT: p.out[idx] = p.xres[(size_t)CTX * D + idx]; break;
    case OP_MIXB: p.mixb[idx] = f2bf(p.mixin[idx]); break;
    case OP_SSD_CS: {
        const int hh = (int)(idx % SH), c = (int)((idx / SH) % NCH), dir = (int)(idx / (SH * NCH)); const float a = -expf(p.a_log[l * 12 + dir * 6 + hh]); float acc = 0.f;
        for (int i = 0; i < CHUNK; ++i) { const int r = c * CHUNK + (dir == 0 ? i : CHUNK - 1 - i); acc += p.dt[(size_t)r * 12 + dir * 6 + hh] * a; p.cs[((size_t)dir * M + r) * SH + hh] = acc; }
        p.cdec[idx] = expf(acc);
    } break;
    case OP_SSD_G: {
        const int s = (int)(idx % CHUNK), g = (int)((idx / CHUNK) % SG), r = (int)(idx / (CHUNK * SG)); const int r2 = (r / CHUNK) * CHUNK + s;
        const float* Cp = p.xbc + (size_t)r * CONVD + SW + SG * SN + g * SN; const float* Bp = p.xbc + (size_t)r2 * CONVD + SW + g * SN; float acc = 0.f;
        for (int n = 0; n < SN; ++n) acc += Cp[n] * Bp[n];
        p.gmat[idx] = acc;
    } break;
    case OP_SSD_YD: {
        const int cc = (int)(idx % SW), r = (int)(idx / SW); const int hh = cc / SP, g = hh / (SH / SG); const int c0 = (r / CHUNK) * CHUNK, lpos = r - c0;
        const float* G = p.gmat + ((size_t)r * SG + g) * CHUNK; const float csf = p.cs[(size_t)r * SH + hh], csb = p.cs[((size_t)M + r) * SH + hh]; float y = 0.f;
        for (int s = 0; s <= lpos; ++s) { const int r2 = c0 + s; y += G[s] * expf(csf - p.cs[(size_t)r2 * SH + hh]) * p.dt[(size_t)r2 * 12 + hh] * p.xbc[(size_t)r2 * CONVD + cc]; }
        for (int s = lpos; s < CHUNK; ++s) { const int r2 = c0 + s; y += G[s] * expf(csb - p.cs[((size_t)M + r2) * SH + hh]) * p.dt[(size_t)r2 * 12 + 6 + hh] * p.xbc[(size_t)r2 * CONVD + cc]; }
        p.ydir[idx] = y;
    } break;
    case OP_SSD_ST: {
        const int n = (int)(idx % SN), pp = (int)((idx / SN) % SP), hh = (int)((idx / (SN * SP)) % SH), c = (int)((idx / (SN * SP * SH)) % NCH), dir = (int)(idx / ((long)SN * SP * SH * NCH)); const int g = hh / (SH / SG);
        const int rend = c * CHUNK + (dir == 0 ? CHUNK - 1 : 0); const float cse = p.cs[((size_t)dir * M + rend) * SH + hh]; float acc = 0.f;
        for (int i = 0; i < CHUNK; ++i) { const int r = c * CHUNK + i; acc += p.xbc[(size_t)r * CONVD + SW + g * SN + n] * expf(cse - p.cs[((size_t)dir * M + r) * SH + hh]) * p.dt[(size_t)r * 12 + dir * 6 + hh] * p.xbc[(size_t)r * CONVD + hh * SP + pp]; }
        p.st[idx] = acc;
    } break;
    case OP_SSD_CARRY: {
        const int e = (int)(idx % (SP * SN)), hh = (int)((idx / (SP * SN)) % SH), dir = (int)(idx / ((long)SP * SN * SH)); float state = 0.f;
        for (int i = 0; i < NCH; ++i) { const int c = dir == 0 ? i : (i < CTX / CHUNK ? CTX / CHUNK - 1 - i : NCH - 1 - (i - CTX / CHUNK));
            const size_t o = (((size_t)dir * NCH + c) * SH + hh) * (SP * SN) + e; const float stc = p.st[o]; p.st[o] = state; state = state * p.cdec[((size_t)dir * NCH + c) * SH + hh] + stc; }
    } break;
    case OP_SSD_YOFF: {
        const int cc = (int)(idx % SW), r = (int)(idx / SW); const int hh = cc / SP, pp = cc % SP, g = hh / (SH / SG), c = r / CHUNK; const float* Cp = p.xbc + (size_t)r * CONVD + SW + SG * SN + g * SN;
        float y = 0.f;
#pragma unroll
        for (int dir = 0; dir < 2; ++dir) { const float* pv = p.st + ((((size_t)dir * NCH + c) * SH + hh) * SP + pp) * SN; float acc = 0.f;
            for (int n = 0; n < SN; ++n) acc += Cp[n] * pv[n];
            y += acc * expf(p.cs[((size_t)dir * M + r) * SH + hh]); }
        p.ydir[(size_t)M * SW + idx] = y;
    } break;
    case OP_COMBINE2: { const int r = (int)(idx / D), c = (int)(idx % D); float s = 0.f;
#pragma unroll
        for (int kk = 0; kk < 4; ++kk) s += p.topw[(size_t)r * 4 + kk] * bf2f(p.ybn[((size_t)r * 4 + kk) * D + c]);
        p.xres[idx] += modv(p, l, r, 5)[c] * s; } break;
    }
}

static const int LAYER_OPS[] = { OP_ROWSTAT, OP_NORM1, OP_INPROJ, OP_LATNORM, OP_QRAW, OP_KVRAW, OP_QHEAD, OP_KHEAD, OP_ATTN, OP_CONV, OP_DT, OP_SSDSCAN, OP_SSDFIN, OP_POOLP, OP_POOLMM,
                                 OP_OUTPROJ, OP_RES1, OP_ROWSTAT, OP_NORM2, OP_LOGITS, OP_ZEROCNT, OP_TOPK, OP_GATEUP, OP_DOWN, OP_COMBINE };
constexpr int N_LAYER_OPS = sizeof(LAYER_OPS) / sizeof(int);
#endif

#define XB_TMO      128
#define XB_XCNT(j)  (256  + 64 * (j))
#define XB_XSUB(j)  (1280 + 64 * (j))
#define XB_XGEN(j)  (2304 + 64 * (j))
#define XB_TOP      3328
#define XB_TOPGEN   3392
#define XCD_BAR_WORDS 3456
#define XB_SPIN_CAP (1u << 22)
#define LAS __attribute__((address_space(3)))

__device__ __forceinline__ unsigned xb_ld(unsigned* p)              { return __hip_atomic_load(p, __ATOMIC_RELAXED, __HIP_MEMORY_SCOPE_AGENT); }
__device__ __forceinline__ unsigned xb_add(unsigned* p, unsigned v) { return __hip_atomic_fetch_add(p, v, __ATOMIC_RELAXED, __HIP_MEMORY_SCOPE_AGENT); }
__device__ __forceinline__ unsigned xb_xcc_id() { return (unsigned)__builtin_amdgcn_s_getreg((3 << 11) | 20) & 0xFu; }
#define XB_SPIN(cond, bar) do { unsigned _sp = 0; while (cond) { __builtin_amdgcn_s_sleep(1); \
    if ((++_sp & 255u) == 0u) { if (xb_ld(&(bar)[XB_TMO])) break; if (_sp > XB_SPIN_CAP) { atomicAdd(&(bar)[XB_TMO], 1u); break; } } } } while (0)

struct XcdBarrier {
    unsigned* bar; unsigned x;
    volatile LAS unsigned* st;
};

__device__ __forceinline__ XcdBarrier xcd_barrier_post(unsigned* bar, volatile LAS unsigned* st) {
    XcdBarrier b; b.bar = bar; b.x = xb_xcc_id(); b.st = st;
    if (threadIdx.x == 0) (void)xb_add(&bar[XB_XCNT(b.x)], 1u);
    return b;
}
__device__ __forceinline__ void xcd_barrier_complete(unsigned* bar, unsigned x, unsigned& nloc, unsigned& nx) {
    const unsigned G = gridDim.x * gridDim.y * gridDim.z;
    unsigned sum, cnt, mine, sp = 0u;
    for (;;) {
        sum = 0u; cnt = 0u; mine = 0u;
#pragma unroll
        for (unsigned j = 0; j < 16; ++j) { const unsigned c = xb_ld(&bar[XB_XCNT(j)]); sum += c; cnt += (c > 0u) ? 1u : 0u; mine = (j == x) ? c : mine; }
        if (sum == G) break;
        __builtin_amdgcn_s_sleep(1);
        if ((++sp & 255u) == 0u) { if (xb_ld(&bar[XB_TMO])) break; if (sp > XB_SPIN_CAP) { atomicAdd(&bar[XB_TMO], 1u); break; } }
    }
    nloc = mine > 0u ? mine : 1u; nx = cnt > 0u ? cnt : 1u;
}

__device__ __forceinline__ void xcd_barrier(const XcdBarrier& b) {
    asm volatile("s_waitcnt vmcnt(0)" ::: "memory");
    __syncthreads();
    if (threadIdx.x == 0) {
        unsigned* bar = b.bar;
        __builtin_amdgcn_s_waitcnt(0);
        unsigned nloc = b.st[0], nx = b.st[1];
        if (nloc == 0u) { unsigned xx = b.x; asm volatile("" : "+s"(xx));   xcd_barrier_complete(bar, xx, nloc, nx); b.st[0] = nloc; b.st[1] = nx; }
        const unsigned old = xb_add(&bar[XB_XSUB(b.x)], 1u);
        const unsigned gen = old / nloc;
        if (old + 1u == (gen + 1u) * nloc) {
            __builtin_amdgcn_fence(__ATOMIC_RELEASE, "agent");
            asm volatile("s_waitcnt vmcnt(0)" ::: "memory");
            const unsigned og = xb_add(&bar[XB_TOP], 1u);
            const unsigned tg = og / nx;
            if (og + 1u == (tg + 1u) * nx) xb_add(&bar[XB_TOPGEN], 1u);
            else XB_SPIN(xb_ld(&bar[XB_TOPGEN]) == tg, bar);
            __builtin_amdgcn_fence(__ATOMIC_ACQUIRE, "agent");
            xb_add(&bar[XB_XGEN(b.x)], 1u);
            asm volatile("s_waitcnt vmcnt(0)" ::: "memory");
        } else {
            XB_SPIN(xb_ld(&bar[XB_XGEN(b.x)]) == gen, bar);
            __builtin_amdgcn_fence(__ATOMIC_ACQUIRE, "agent");
            asm volatile("s_waitcnt vmcnt(0)" ::: "memory");
        }
    }
    __syncthreads();
}


namespace at {
typedef unsigned short bf16_t;
using bf16x8 = __attribute__((ext_vector_type(8))) short;
using s16x4  = __attribute__((ext_vector_type(4))) short;
using f32x16 = __attribute__((ext_vector_type(16))) float;
using u32x4  = __attribute__((ext_vector_type(4))) unsigned;
constexpr int DQ = 96, DV = 64, NW = 8, QBLK = 32, KVBLK = 64;
constexpr int LDQ = 6 * DQ, LDK = 6 * DQ, LDV = 6 * DV;
constexpr float SCALE = 0.10206207261596575f;
constexpr float THR = 8.f;
constexpr int KROW = 208;
constexpr int SHM_K = KVBLK * KROW, SHM_V = KVBLK * DV * 2;
constexpr int SHM_ATTN = 2 * SHM_V + 2 * SHM_K + NW * 64 * 4;
#define AT_SBAR() __builtin_amdgcn_sched_barrier(0)
__device__ __forceinline__ int crow(int r, int hi) { return (r & 3) + 8 * (r >> 2) + 4 * hi; }
__device__ __forceinline__ unsigned cvtpk(float lo, float hi) { unsigned r; asm volatile("v_cvt_pk_bf16_f32 %0, %1, %2" : "=v"(r) : "v"(lo), "v"(hi)); return r; }

__device__ __forceinline__ void partialSM(f32x16& p0, f32x16& p1, float& m_reg, float& mn, float& alpha) {
  constexpr float C = SCALE * 1.4426950408889634f;
  float pmax = p0[0];
#pragma unroll
  for (int r = 1; r < 16; ++r) pmax = fmaxf(pmax, p0[r]);
#pragma unroll
  for (int r = 0; r < 16; ++r) pmax = fmaxf(pmax, p1[r]);
  { auto rr = __builtin_amdgcn_permlane32_swap(__float_as_uint(pmax), __float_as_uint(pmax), false, false);
    pmax = fmaxf(__uint_as_float(rr[0]), __uint_as_float(rr[1])); }
  if (__builtin_expect(__all(pmax - m_reg <= THR / SCALE), 1)) { mn = m_reg; alpha = 1.f; }
  else { mn = fmaxf(m_reg, pmax); alpha = __builtin_amdgcn_exp2f((m_reg - mn) * C); m_reg = mn; }
  float mnC = -mn * C;
#pragma unroll
  for (int r = 0; r < 16; ++r) p0[r] = fmaf(p0[r], C, mnC);
#pragma unroll
  for (int r = 0; r < 16; ++r) p1[r] = fmaf(p1[r], C, mnC);
#pragma unroll
  for (int r = 0; r < 16; ++r) p0[r] = __builtin_amdgcn_exp2f(p0[r]);
}
__device__ __forceinline__ void finishSM(f32x16& p0, f32x16& p1, float alpha, float& l_reg, bf16x8& pa0, bf16x8& pa1, bf16x8& pa2, bf16x8& pa3) {
#pragma unroll
  for (int r = 0; r < 16; ++r) p1[r] = __builtin_amdgcn_exp2f(p1[r]);
  float ps = 0;
#pragma unroll
  for (int r = 0; r < 16; ++r) ps += p0[r];
#pragma unroll
  for (int r = 0; r < 16; ++r) ps += p1[r];
  { auto rr = __builtin_amdgcn_permlane32_swap(__float_as_uint(ps), __float_as_uint(ps), false, false);
    ps = __uint_as_float(rr[0]) + __uint_as_float(rr[1]); }
  l_reg = l_reg * alpha + ps;
#define AT_PK4(P, BASE, OUT) do { unsigned a0 = cvtpk(P[BASE + 0], P[BASE + 1]), a1 = cvtpk(P[BASE + 2], P[BASE + 3]);   \
    unsigned b0 = cvtpk(P[BASE + 4], P[BASE + 5]), b1 = cvtpk(P[BASE + 6], P[BASE + 7]);                              \
    auto r0 = __builtin_amdgcn_permlane32_swap(a0, b0, false, false); auto r1 = __builtin_amdgcn_permlane32_swap(a1, b1, false, false); \
    u32x4 w = {r0[0], r1[0], r0[1], r1[1]}; OUT = *reinterpret_cast<bf16x8*>(&w); } while (0)
  AT_PK4(p0, 0, pa0); AT_PK4(p0, 8, pa1); AT_PK4(p1, 0, pa2); AT_PK4(p1, 8, pa3);
#undef AT_PK4
}
__device__ __forceinline__ void qkt(f32x16& p0, f32x16& p1, const char* Ks, const bf16x8* qr, int r32, int hi) {
  p0 = f32x16{}; p1 = f32x16{};
#pragma unroll
  for (int d0 = 0; d0 < 6; ++d0) { const int cb = (d0 * 16 + hi * 8) * 2;
    bf16x8 b0 = *reinterpret_cast<const bf16x8*>(Ks + r32 * KROW + cb);
    bf16x8 b1 = *reinterpret_cast<const bf16x8*>(Ks + (32 + r32) * KROW + cb);
    p0 = __builtin_amdgcn_mfma_f32_32x32x16_bf16(b0, qr[d0], p0, 0, 0, 0);
    p1 = __builtin_amdgcn_mfma_f32_32x32x16_bf16(b1, qr[d0], p1, 0, 0, 0); }
}
__device__ __forceinline__ int v_st(int k, int c) { const int kk = (k & ~0xC) | ((k & 4) << 1) | ((k & 8) >> 1); return ((kk >> 3) * 2 + (c >> 5)) * 512 + ((kk & 7) * 32 + (c & 31)) * 2; }
__device__ __forceinline__ int v_rd_base(int lane) { return ((lane & 3) << 3) | (((lane >> 2) & 3) << 6) | (((lane >> 4) & 1) << 5) | (((lane >> 5) & 1) << 8); }
constexpr int v_rd_off(int d0, int ks, int half) { return d0 * 512 + ks * 2048 + half * 1024; }
template <int OFF> __device__ __forceinline__ s16x4 tr_read(int vb) {
  s16x4 r; asm volatile("ds_read_b64_tr_b16 %0, %1 offset:%2" : "=&v"(r) : "v"(vb), "i"(OFF) : "memory"); return r;
}
template <int D0> __device__ __forceinline__ void pv_one(f32x16& od, int vb, bf16x8 pa0, bf16x8 pa1, bf16x8 pa2, bf16x8 pa3) {
  const s16x4 l0 = tr_read<v_rd_off(D0, 0, 0)>(vb), h0 = tr_read<v_rd_off(D0, 0, 1)>(vb), l1 = tr_read<v_rd_off(D0, 1, 0)>(vb), h1 = tr_read<v_rd_off(D0, 1, 1)>(vb);
  const s16x4 l2 = tr_read<v_rd_off(D0, 2, 0)>(vb), h2 = tr_read<v_rd_off(D0, 2, 1)>(vb), l3 = tr_read<v_rd_off(D0, 3, 0)>(vb), h3 = tr_read<v_rd_off(D0, 3, 1)>(vb);
  asm volatile("s_waitcnt lgkmcnt(0)" ::: "memory"); AT_SBAR();
#define AT_PK(L, H) (bf16x8){L[0], L[1], L[2], L[3], H[0], H[1], H[2], H[3]}
  od = __builtin_amdgcn_mfma_f32_32x32x16_bf16(pa0, AT_PK(l0, h0), od, 0, 0, 0);
  od = __builtin_amdgcn_mfma_f32_32x32x16_bf16(pa1, AT_PK(l1, h1), od, 0, 0, 0);
  od = __builtin_amdgcn_mfma_f32_32x32x16_bf16(pa2, AT_PK(l2, h2), od, 0, 0, 0);
  od = __builtin_amdgcn_mfma_f32_32x32x16_bf16(pa3, AT_PK(l3, h3), od, 0, 0, 0);
#undef AT_PK
}
__device__ __forceinline__ void pv_d0(f32x16* o, int vb, bf16x8 pa0, bf16x8 pa1, bf16x8 pa2, bf16x8 pa3) {
  pv_one<0>(o[0], vb, pa0, pa1, pa2, pa3); pv_one<1>(o[1], vb, pa0, pa1, pa2, pa3);
}
__device__ __forceinline__ void attn_body(const bf16_t* __restrict__ Qb, const bf16_t* __restrict__ Kh, const bf16_t* __restrict__ Vh, float* __restrict__ Ob, int ldo, int seq, char* lds) {
  int tid = threadIdx.x; asm volatile("" : "+v"(tid));
  const int wid = tid >> 6, lane = tid & 63, r32 = lane & 31, hi = lane >> 5;
  char* V_lds = lds; char* K_lds = lds + 2 * SHM_V;
  float* ws = (float*)(lds + 2 * SHM_V + 2 * SHM_K) + wid * 64; float* li_l = ws; float* al_l = ws + 32;
  float m_reg = -1e30f, l_reg = 0; f32x16 o[2] = {}; bf16x8 qr[6];
  const bf16_t* Qw = Qb + (long)(wid * QBLK + r32) * LDQ + hi * 8;
#pragma unroll
  for (int d0 = 0; d0 < 6; ++d0) qr[d0] = *reinterpret_cast<const bf16x8*>(Qw + d0 * 16);
  const int kr0 = tid / 12, kc0 = tid % 12, c1 = 512 + (tid & 255), kr1 = c1 / 12, kc1 = c1 % 12, vr = tid >> 3, vc = (tid & 7) * 8;
  const bool k1on = tid < 256;
  const int kst0 = kr0 * KROW + kc0 * 16, kst1 = kr1 * KROW + kc1 * 16, vst = v_st(vr, vc);
  const long kg0 = (long)kr0 * LDK + kc0 * 8, kg1 = (long)kr1 * LDK + kc1 * 8, vg = (long)vr * LDV + vc;
  const int vb0 = (int)(uintptr_t)V_lds + v_rd_base(lane);
  struct { bf16x8 vs, ks0, ks1; } sr_[2];
#define AT_SLOAD(i, k0) do { sr_[i].vs = *reinterpret_cast<const bf16x8*>(Vh + (long)(k0) * LDV + vg); \
    sr_[i].ks0 = *reinterpret_cast<const bf16x8*>(Kh + (long)(k0) * LDK + kg0); sr_[i].ks1 = *reinterpret_cast<const bf16x8*>(Kh + (long)(k0) * LDK + kg1); } while (0)
#define AT_SWRITE(b, i) do { *(bf16x8*)(V_lds + (b) * SHM_V + vst) = sr_[i].vs; *(bf16x8*)(K_lds + (b) * SHM_K + kst0) = sr_[i].ks0; \
    if (k1on) *(bf16x8*)(K_lds + (b) * SHM_K + kst1) = sr_[i].ks1; } while (0)
#define AT_SWAIT() asm volatile("s_waitcnt vmcnt(3)" ::: "memory")
#define AT_RESC(a) do { if (__any((a) < 1.f)) { if (hi == 0) al_l[r32] = (a); asm volatile("s_waitcnt lgkmcnt(0)" ::: "memory"); \
    _Pragma("unroll") for (int d = 0; d < 2; ++d) _Pragma("unroll") for (int r = 0; r < 16; ++r) o[d][r] *= al_l[crow(r, hi)]; } } while (0)
  f32x16 pA0, pA1, pB0, pB1; float mnA, mnB, alA, alB; bf16x8 pa0, pa1, pa2, pa3; const int NT = seq / KVBLK;
  constexpr int SE = 0, SO = 1;
  AT_SLOAD(SE, 0); asm volatile("s_waitcnt vmcnt(0)" ::: "memory"); AT_SWRITE(0, SE); __syncthreads();
  qkt(pA0, pA1, K_lds, qr, r32, hi); partialSM(pA0, pA1, m_reg, mnA, alA);
  AT_SLOAD(SO, KVBLK); if (2 < NT) AT_SLOAD(SE, 2 * KVBLK);
  AT_SWAIT(); AT_SWRITE(1, SO); __syncthreads();
  for (int j = 1; j + 1 < NT; j += 2) {
    AT_SBAR(); qkt(pB0, pB1, K_lds + SHM_K, qr, r32, hi);
    finishSM(pA0, pA1, alA, l_reg, pa0, pa1, pa2, pa3); AT_SBAR();
    AT_SLOAD(SO, (j + 2) * KVBLK); AT_SBAR();
    pv_d0(o, vb0, pa0, pa1, pa2, pa3); partialSM(pB0, pB1, m_reg, mnB, alB);
    __syncthreads(); AT_SWAIT(); AT_SWRITE(0, SE);
    AT_RESC(alB); __syncthreads();
    AT_SBAR(); qkt(pA0, pA1, K_lds, qr, r32, hi);
    finishSM(pB0, pB1, alB, l_reg, pa0, pa1, pa2, pa3); AT_SBAR();
    if (j + 3 < NT) AT_SLOAD(SE, (j + 3) * KVBLK); AT_SBAR();
    pv_d0(o, vb0 + SHM_V, pa0, pa1, pa2, pa3); partialSM(pA0, pA1, m_reg, mnA, alA);
    __syncthreads(); AT_SWAIT(); AT_SWRITE(1, SO);
    AT_RESC(alA); __syncthreads();
  }
  AT_SBAR(); qkt(pB0, pB1, K_lds + SHM_K, qr, r32, hi);
  finishSM(pA0, pA1, alA, l_reg, pa0, pa1, pa2, pa3); AT_SBAR();
  pv_d0(o, vb0, pa0, pa1, pa2, pa3); partialSM(pB0, pB1, m_reg, mnB, alB);
  __syncthreads(); AT_RESC(alB);
  finishSM(pB0, pB1, alB, l_reg, pa0, pa1, pa2, pa3); AT_SBAR();
  pv_d0(o, vb0 + SHM_V, pa0, pa1, pa2, pa3);
  if (hi == 0) li_l[r32] = l_reg; asm volatile("s_waitcnt lgkmcnt(0)" ::: "memory");
  float rli[16];
#pragma unroll
  for (int r = 0; r < 16; ++r) rli[r] = __builtin_amdgcn_rcpf(li_l[crow(r, hi)]);
  float* Ow = Ob + (long)(wid * QBLK) * ldo;
#pragma unroll
  for (int r = 0; r < 16; ++r) { const int orow = crow(r, hi);
#pragma unroll
    for (int d0 = 0; d0 < 2; ++d0) Ow[(long)orow * ldo + d0 * 32 + r32] = o[d0][r] * rli[r]; }
#undef AT_SLOAD
#undef AT_SWRITE
#undef AT_SWAIT
#undef AT_RESC
}
}

namespace gm {
#define GM_LAS __attribute__((address_space(3)))
typedef unsigned short bf16_t;
typedef short bf16x8 __attribute__((ext_vector_type(8)));
typedef float f32x4 __attribute__((ext_vector_type(4)));
typedef unsigned u32x4 __attribute__((ext_vector_type(4)));
constexpr int BM = 256, BK = 64, HALF = 128, HTB = HALF * BK * 2, STAGE_BYTES = 8 * HTB;
__host__ __device__ __forceinline__ int lds_byte(int r, int c) { const int st = (r >> 4) * 2 + (c >> 5), rr = r & 15, cc = c & 31, ob = rr * 64 + cc * 2; return st * 1024 + (ob ^ (((ob >> 9) & 1) << 5)); }
__host__ __device__ __forceinline__ void stage_rc(int b, int& R, int& C) { const int st = b / 1024, sb = b % 1024, swz = sb ^ (((sb >> 9) & 1) << 5); R = (st >> 1) * 16 + swz / 64; C = (st & 1) * 32 + (swz % 64) / 2; }
__host__ __device__ __forceinline__ int perm32(int rho) { const int n = rho >> 4, i = rho & 15; return 8 * (i >> 2) + 4 * n + (i & 3); }
__device__ __forceinline__ unsigned cvt_pk_bf16(float lo, float hi) { unsigned r; asm volatile("v_cvt_pk_bf16_f32 %0, %1, %2" : "=v"(r) : "v"(lo), "v"(hi)); return r; }

template <bool PERM, class Epi>
__device__ __forceinline__ void gemm_unit(GM_LAS unsigned char* lds, const char* A, const unsigned (&offA)[2][2], const char* Bt, int K, const Epi& E) {
    int tid = threadIdx.x; asm volatile("" : "+v"(tid));
    const int wid = __builtin_amdgcn_readfirstlane(tid >> 6), lane = tid & 63, wr = wid >> 2, wc = wid & 3, fr = lane & 15, fq = lane >> 4;
    const int nt = K / BK;
    unsigned voffB[2];
#pragma unroll
    for (int i = 0; i < 2; ++i) { int R, C; stage_rc(tid * 16 + i * 8192, R, C); const int Rb = PERM ? ((R & ~31) + perm32(R & 31)) : R; voffB[i] = (unsigned)(Rb * K + C) * 2u; }
    const size_t kstep = (size_t)(BK * 2);
    const size_t hstep = (size_t)HALF * K * 2;
    const unsigned ldsw = (unsigned)wid * 1024u;
    const int aoff = lds_byte(wr * 64 + fr, fq * 8), boff = lds_byte(wc * 32 + fr, fq * 8);
#define GM_SA(b, h) (((b) * 2 + (h)) * HTB)
#define GM_SB(b, h) ((4 + (b) * 2 + (h)) * HTB)
#define GM_STAGEB(bufoff, gbase) do { _Pragma("unroll") for (int _i = 0; _i < 2; ++_i) \
        __builtin_amdgcn_global_load_lds((const unsigned*)((const char*)(gbase) + voffB[_i]), (GM_LAS unsigned*)(lds + (bufoff) + ldsw + _i * 8192), 16, 0, 0); } while (0)
#define GM_STAGEA(bufoff, h, kbyte) do { _Pragma("unroll") for (int _i = 0; _i < 2; ++_i) \
        __builtin_amdgcn_global_load_lds((const unsigned*)(A + (size_t)offA[h][_i] + (kbyte)), (GM_LAS unsigned*)(lds + (bufoff) + ldsw + _i * 8192), 16, 0, 0); } while (0)
#define GM_LDA(dst, b, h) do { _Pragma("unroll") for (int m = 0; m < 4; ++m) _Pragma("unroll") for (int k = 0; k < 2; ++k) dst[m][k] = *(const GM_LAS bf16x8*)(lds + GM_SA(b, h) + aoff + m * 2048 + k * 1024); } while (0)
#define GM_LDB(dst, b, h) do { _Pragma("unroll") for (int n = 0; n < 2; ++n) _Pragma("unroll") for (int k = 0; k < 2; ++k) dst[n][k] = *(const GM_LAS bf16x8*)(lds + GM_SB(b, h) + boff + n * 2048 + k * 1024); } while (0)
#define GM_MMA(ai, bj, At, Bt_) do { __builtin_amdgcn_s_setprio(1); _Pragma("unroll") for (int m = 0; m < 4; ++m) _Pragma("unroll") for (int n = 0; n < 2; ++n) _Pragma("unroll") for (int k = 0; k < 2; ++k) \
        acc[ai][bj][m][n] = __builtin_amdgcn_mfma_f32_16x16x32_bf16(Bt_[n][k], At[m][k], acc[ai][bj][m][n], 0, 0, 0); __builtin_amdgcn_s_setprio(0); } while (0)
#define GM_WAIT_V(n) asm volatile("s_waitcnt vmcnt(" #n ")" ::: "memory")
#define GM_WAIT_L(n) asm volatile("s_waitcnt lgkmcnt(" #n ")" ::: "memory")
#define GM_BAR __builtin_amdgcn_s_barrier()
#define GM_SCHED __builtin_amdgcn_sched_barrier(0)
    f32x4 acc[2][2][4][2];
#pragma unroll
    for (int a = 0; a < 2; ++a)
#pragma unroll
        for (int b = 0; b < 2; ++b)
#pragma unroll
            for (int m = 0; m < 4; ++m)
#pragma unroll
                for (int n = 0; n < 2; ++n) acc[a][b][m][n] = (f32x4){0.f, 0.f, 0.f, 0.f};
    bf16x8 At[4][2], B0[2][2], B1[2][2];
    const char* cB = Bt;
    GM_STAGEB(GM_SB(0, 0), cB); GM_STAGEA(GM_SA(0, 0), 0, 0); GM_STAGEB(GM_SB(0, 1), cB + hstep); GM_STAGEA(GM_SA(0, 1), 1, 0);
    if (wr == 1) GM_BAR;
    GM_WAIT_V(4); GM_BAR;
    GM_STAGEB(GM_SB(1, 0), cB + kstep); GM_STAGEA(GM_SA(1, 0), 0, kstep); GM_STAGEB(GM_SB(1, 1), cB + hstep + kstep);
    GM_WAIT_V(6); GM_BAR;
    for (int t = 0; t < nt; t += 2) {
        const bool last = (t == nt - 2);
        const size_t k1 = (size_t)(t + 1) * kstep;
        const size_t k2 = last ? 0 : (size_t)(t + 2) * kstep;
        const size_t k3 = k2 + kstep;
        const char* b2 = cB + k2; const char* b3 = cB + k3;
        GM_LDB(B0, 0, 0); GM_SCHED; GM_LDA(At, 0, 0); GM_STAGEA(GM_SA(1, 1), 1, k1);
        GM_WAIT_L(8); GM_BAR; GM_WAIT_L(0); GM_MMA(0, 0, At, B0); GM_BAR; GM_SCHED;
        GM_LDB(B1, 0, 1); GM_STAGEB(GM_SB(0, 0), b2);
        GM_BAR; GM_WAIT_L(0); GM_MMA(0, 1, At, B1); GM_BAR;
        GM_LDA(At, 0, 1); GM_STAGEA(GM_SA(0, 0), 0, k2);
        GM_BAR; GM_WAIT_L(0); GM_MMA(1, 0, At, B0); GM_BAR; GM_SCHED;
        GM_STAGEB(GM_SB(0, 1), b2 + hstep);
        GM_WAIT_V(6); GM_BAR; GM_MMA(1, 1, At, B1); GM_BAR;
        GM_LDB(B0, 1, 0); GM_SCHED; GM_LDA(At, 1, 0); GM_STAGEA(GM_SA(0, 1), 1, k2);
        GM_WAIT_L(8); GM_BAR; GM_WAIT_L(0); GM_MMA(0, 0, At, B0); GM_BAR; GM_SCHED;
        GM_LDB(B1, 1, 1); GM_STAGEB(GM_SB(1, 0), b3);
        GM_BAR; GM_WAIT_L(0); GM_MMA(0, 1, At, B1); GM_BAR;
        GM_LDA(At, 1, 1); GM_STAGEA(GM_SA(1, 0), 0, k3);
        GM_BAR; GM_WAIT_L(0); GM_MMA(1, 0, At, B0); GM_BAR; GM_SCHED;
        GM_STAGEB(GM_SB(1, 1), b3 + hstep);
        GM_WAIT_V(6); GM_BAR; GM_MMA(1, 1, At, B1); GM_BAR;
    }
    E(acc, wr, wc, fr, fq);
    GM_WAIT_V(0);
    if (wr == 0) GM_BAR;
    GM_BAR;
#undef GM_SA
#undef GM_SB
#undef GM_STAGEA
#undef GM_STAGEB
#undef GM_LDA
#undef GM_LDB
#undef GM_MMA
#undef GM_WAIT_V
#undef GM_WAIT_L
#undef GM_BAR
#undef GM_SCHED
}
__device__ __forceinline__ void dense_offA(unsigned (&offA)[2][2], long row0, int K) {
    int tid = threadIdx.x; asm volatile("" : "+v"(tid));
#pragma unroll
    for (int i = 0; i < 2; ++i) { int R, C; stage_rc(tid * 16 + i * 8192, R, C);
#pragma unroll
        for (int h = 0; h < 2; ++h) offA[h][i] = (unsigned)(((row0 + h * HALF + R) * K + C) * 2); }
}
}

struct FW {
    bf16_t *w_in_t, *w_out_t, *gu_t, *d_t;
    bf16_t *hb1, *hb2, *mixb, *actb, *yb;
    float *proj2, *mix2;
    bf16_t *w_uq_t, *w_ukv_t;
    float *ropec, *ropes;
    bf16_t *qb2, *kb2, *vb2;
};
constexpr int INC_PAD = 1792;
template <int MAP> __device__ __forceinline__ void cvt_tile(const float* src, int ldn, int nvalid, bf16_t* dst, int K, int k0, int n0, float* T) {
    int tid = threadIdx.x; asm volatile("" : "+v"(tid)); const int r = tid >> 4, c4 = (tid & 15) * 4;
#pragma unroll
    for (int i = 0; i < 2; ++i) { const int kk = r + 32 * i; float4 v = make_float4(0.f, 0.f, 0.f, 0.f);
        if (n0 + c4 < nvalid) v = *(const float4*)(src + (size_t)(k0 + kk) * ldn + n0 + c4);
        T[kk * 65 + c4 + 0] = v.x; T[kk * 65 + c4 + 1] = v.y; T[kk * 65 + c4 + 2] = v.z; T[kk * 65 + c4 + 3] = v.w; }
    __syncthreads();
    { const int n = tid >> 3, kc = tid & 7; float f[8];
#pragma unroll
        for (int j = 0; j < 8; ++j) f[j] = T[(kc * 8 + j) * 65 + n];
        gm::u32x4 w; w.x = gm::cvt_pk_bf16(f[0], f[1]); w.y = gm::cvt_pk_bf16(f[2], f[3]); w.z = gm::cvt_pk_bf16(f[4], f[5]); w.w = gm::cvt_pk_bf16(f[6], f[7]);
        const int nn = n0 + n; const int drow = MAP == 0 ? nn : ((nn >> 7) * 256 + (MAP == 2 ? 128 : 0) + (nn & 127));
        *(gm::u32x4*)(dst + (size_t)drow * K + k0 + kc * 8) = w; }
    __syncthreads();
}
__device__ __forceinline__ void cvt_phase(const P& p, const FW& f, int l0, int l1, char* lds) {
    float* T = (float*)lds;
    constexpr int T_IN = 16 * 28, T_OUT = 16 * 16, T_E = 16 * 16, T_UQ = 4 * 9, T_UKV = 2 * 12, T_LAYER = T_IN + T_OUT + T_UQ + T_UKV + NE * 3 * T_E;
    const int total = (l1 - l0) * T_LAYER;
    if (blockIdx.x == gridDim.x - 1) for (int i = threadIdx.x; i < 256 * 8; i += 512) { float cs, sn; sincos_rr((float)(i >> 3) * rope_inv_freq(i & 7), cs, sn); f.ropec[i] = cs; f.ropes[i] = sn; }
    for (int t = blockIdx.x; t < total; t += gridDim.x) {
        const int l = l0 + t / T_LAYER; int r = t % T_LAYER;
        if (r < T_IN) { const int kt = r / 28, ntl = r % 28; cvt_tile<0>(p.w_in + (size_t)l * D * INC, INC, INC, f.w_in_t + (size_t)l * INC_PAD * D, D, kt * 64, ntl * 64, T); continue; }
        r -= T_IN;
        if (r < T_OUT) { const int kt = r / 16, ntl = r % 16; cvt_tile<0>(p.w_out + (size_t)l * MIXW * D, D, D, f.w_out_t + (size_t)l * D * MIXW, MIXW, kt * 64, ntl * 64, T); continue; }
        r -= T_OUT;
        if (r < T_UQ) { const int kt = r / 9, ntl = r % 9; cvt_tile<0>(p.w_uq + (size_t)l * QL * NH * QKD, NH * QKD, NH * QKD, f.w_uq_t + (size_t)l * NH * QKD * QL, QL, kt * 64, ntl * 64, T); continue; }
        r -= T_UQ;
        if (r < T_UKV) { const int kt = r / 12, ntl = r % 12; cvt_tile<0>(p.w_ukv + (size_t)l * KVL * NH * 128, NH * 128, NH * 128, f.w_ukv_t + (size_t)l * NH * 128 * KVL, KVL, kt * 64, ntl * 64, T); continue; }
        r -= T_UKV;
        const int e = r / (3 * T_E), which = (r / T_E) % 3, tt = r % T_E, kt = tt / 16, ntl = tt % 16; const size_t le = (size_t)l * NE + e;
        if (which == 0) cvt_tile<1>(p.wg + le * D * FF, FF, FF, f.gu_t + le * 2 * FF * D, D, kt * 64, ntl * 64, T);
        else if (which == 1) cvt_tile<2>(p.wu + le * D * FF, FF, FF, f.gu_t + le * 2 * FF * D, D, kt * 64, ntl * 64, T);
        else cvt_tile<0>(p.wd + le * FF * D, D, D, f.d_t + le * D * FF, FF, kt * 64, ntl * 64, T);
    }
}
__device__ __forceinline__ void inproj_phase(const P& p, const FW& f, int l, float* dst, char* lds) {
    constexpr int NPN = INC_PAD / 256, NU = (M / 256) * NPN;
    for (int u = blockIdx.x; u < NU; u += gridDim.x) {
        const int pm = u / NPN, pn = u % NPN; unsigned offA[2][2]; gm::dense_offA(offA, (long)pm * 256, D);
        auto epi = [&](const gm::f32x4 (&acc)[2][2][4][2], int wr, int wc, int fr, int fq) {
            const int row0 = pm * 256 + wr * 64 + fr, col0 = pn * 256 + wc * 32 + 4 * fq;
#pragma unroll
            for (int ai = 0; ai < 2; ++ai)
#pragma unroll
                for (int m = 0; m < 4; ++m) { float* rowp = dst + (size_t)(row0 + ai * 128 + m * 16) * INC + col0;
#pragma unroll
                    for (int bj = 0; bj < 2; ++bj)
#pragma unroll
                        for (int n = 0; n < 2; ++n) if (col0 + bj * 128 + n * 16 < INC) *(gm::f32x4*)(rowp + bj * 128 + n * 16) = acc[ai][bj][m][n]; } };
        gm::gemm_unit<false>((GM_LAS unsigned char*)lds, (const char*)f.hb1, offA, (const char*)(f.w_in_t + ((size_t)l * INC_PAD + pn * 256) * D), D, epi);
    }
}
template <bool TOX> __device__ __forceinline__ void outproj_phase(const P& p, const FW& f, int l, float* dst, char* lds) {
    constexpr int NPN = D / 256, NU = (M / 256) * NPN;
    for (int u = blockIdx.x; u < NU; u += gridDim.x) {
        const int pm = u / NPN, pn = u % NPN; unsigned offA[2][2]; gm::dense_offA(offA, (long)pm * 256, MIXW);
        auto epi = [&](const gm::f32x4 (&acc)[2][2][4][2], int wr, int wc, int fr, int fq) {
            const int row0 = pm * 256 + wr * 64 + fr, col0 = pn * 256 + wc * 32 + 4 * fq; const float* gate = modv(p, l, pm * 256, 2);
#pragma unroll
            for (int ai = 0; ai < 2; ++ai)
#pragma unroll
                for (int m = 0; m < 4; ++m) { float* rowp = dst + (size_t)(row0 + ai * 128 + m * 16) * D + col0;
#pragma unroll
                    for (int bj = 0; bj < 2; ++bj)
#pragma unroll
                        for (int n = 0; n < 2; ++n) { float* q = rowp + bj * 128 + n * 16;
                            if (TOX) { const gm::f32x4 g = *(const gm::f32x4*)(gate + col0 + bj * 128 + n * 16); const gm::f32x4 x = *(const gm::f32x4*)q; *(gm::f32x4*)q = x + g * acc[ai][bj][m][n]; }
                            else *(gm::f32x4*)q = acc[ai][bj][m][n]; } } };
        gm::gemm_unit<false>((GM_LAS unsigned char*)lds, (const char*)f.mixb, offA, (const char*)(f.w_out_t + ((size_t)l * D + pn * 256) * MIXW), MIXW, epi);
    }
}
__device__ __forceinline__ bool moe_find(const int* cnt, int tg, int& e, int& ti, int& c) {
    int acc = 0;
    for (int x = 0; x < NE; ++x) { const int cx = cnt[x]; const int nt = (cx + 255) >> 8; if (tg < acc + nt) { e = x; ti = tg - acc; c = cx; return true; } acc += nt; }
    return false;
}
__device__ __forceinline__ int moe_tiles(const int* cnt) { int acc = 0; for (int x = 0; x < NE; ++x) acc += (cnt[x] + 255) >> 8; return acc; }
template <bool SRC_TOK> __device__ __forceinline__ void gather_offA(unsigned (&offA)[2][2], const int* lst, int base, int cnt, int K) {
    int tid = threadIdx.x; asm volatile("" : "+v"(tid));
#pragma unroll
    for (int i = 0; i < 2; ++i) { int R, C; gm::stage_rc(tid * 16 + i * 8192, R, C);
#pragma unroll
        for (int h = 0; h < 2; ++h) { const int s = base + h * 128 + R; int a = s < cnt ? lst[s] : 0; if (SRC_TOK) a >>= 2; offA[h][i] = (unsigned)(((size_t)a * K + C) * 2); } }
}
__device__ __forceinline__ void moe1_phase(const P& p, const FW& f, int l, char* lds) {
    constexpr int NPN = 2 * FF / 256; const int NU = moe_tiles(p.cnt) * NPN;
    for (int u = blockIdx.x; u < NU; u += gridDim.x) {
        int e, ti, cnt; if (!moe_find(p.cnt, u / NPN, e, ti, cnt)) break; const int pn = u % NPN; const int* lst = p.list + (size_t)e * M; const size_t le = (size_t)l * NE + e;
        unsigned offA[2][2]; gather_offA<true>(offA, lst, ti * 256, cnt, D);
        auto epi = [&](const gm::f32x4 (&acc)[2][2][4][2], int wr, int wc, int fr, int fq) {
            const int ff0 = pn * 128 + wc * 32 + 8 * fq; const float* bgp = p.bg + le * FF + ff0; const float* bup = p.bu + le * FF + ff0;
            const gm::f32x4 bg0 = *(const gm::f32x4*)bgp, bg1 = *(const gm::f32x4*)(bgp + 4), bu0 = *(const gm::f32x4*)bup, bu1 = *(const gm::f32x4*)(bup + 4);
#pragma unroll
            for (int ai = 0; ai < 2; ++ai)
#pragma unroll
                for (int m = 0; m < 4; ++m) { const int s = ti * 256 + ai * 128 + wr * 64 + m * 16 + fr; if (s < cnt) { const int a = lst[s]; float o[8];
#pragma unroll
                        for (int n = 0; n < 2; ++n)
#pragma unroll
                            for (int j = 0; j < 4; ++j) { float g = acc[ai][0][m][n][j] + (n ? bg1[j] : bg0[j]); float uu = acc[ai][1][m][n][j] + (n ? bu1[j] : bu0[j]);
                                g = g < 7.0f ? g : 7.0f; uu = uu < -7.0f ? -7.0f : (uu > 7.0f ? 7.0f : uu); o[n * 4 + j] = g * (1.0f / (1.0f + __expf(-1.702f * g))) * (uu + 1.0f); }
                        gm::u32x4 w; w.x = gm::cvt_pk_bf16(o[0], o[1]); w.y = gm::cvt_pk_bf16(o[2], o[3]); w.z = gm::cvt_pk_bf16(o[4], o[5]); w.w = gm::cvt_pk_bf16(o[6], o[7]);
                        *(gm::u32x4*)(f.actb + (size_t)a * FF + ff0) = w; } } };
        gm::gemm_unit<true>((GM_LAS unsigned char*)lds, (const char*)f.hb2, offA, (const char*)(f.gu_t + (le * 2 * FF + pn * 256) * D), D, epi);
    }
}
__device__ __forceinline__ void moe2_phase(const P& p, const FW& f, int l, char* lds) {
    constexpr int NPN = D / 256; const int NU = moe_tiles(p.cnt) * NPN;
    for (int u = blockIdx.x; u < NU; u += gridDim.x) {
        int e, ti, cnt; if (!moe_find(p.cnt, u / NPN, e, ti, cnt)) break; const int pn = u % NPN; const int* lst = p.list + (size_t)e * M; const size_t le = (size_t)l * NE + e;
        unsigned offA[2][2]; gather_offA<false>(offA, lst, ti * 256, cnt, FF);
        auto epi = [&](const gm::f32x4 (&acc)[2][2][4][2], int wr, int wc, int fr, int fq) {
#pragma unroll
            for (int bj = 0; bj < 2; ++bj) { const int c0 = pn * 256 + bj * 128 + wc * 32 + 8 * fq; const float* bp = p.bd + le * D + c0; const gm::f32x4 b0 = *(const gm::f32x4*)bp, b1 = *(const gm::f32x4*)(bp + 4);
#pragma unroll
                for (int ai = 0; ai < 2; ++ai)
#pragma unroll
                    for (int m = 0; m < 4; ++m) { const int s = ti * 256 + ai * 128 + wr * 64 + m * 16 + fr; if (s < cnt) { const int a = lst[s];
                            const gm::f32x4 v0 = acc[ai][bj][m][0] + b0, v1 = acc[ai][bj][m][1] + b1;
                            gm::u32x4 w; w.x = gm::cvt_pk_bf16(v0[0], v0[1]); w.y = gm::cvt_pk_bf16(v0[2], v0[3]); w.z = gm::cvt_pk_bf16(v1[0], v1[1]); w.w = gm::cvt_pk_bf16(v1[2], v1[3]);
                            *(gm::u32x4*)(f.yb + (size_t)a * D + c0) = w; } } } };
        gm::gemm_unit<true>((GM_LAS unsigned char*)lds, (const char*)f.actb, offA, (const char*)(f.d_t + (le * D + pn * 256) * FF), FF, epi);
    }
}

namespace rw {
typedef float f32x4 __attribute__((ext_vector_type(4)));
typedef unsigned u32x2 __attribute__((ext_vector_type(2)));
constexpr int ROWS_PB = 65;
__device__ __forceinline__ float wave_sum(float v) {
#pragma unroll
    for (int o = 32; o >= 1; o >>= 1) v += __shfl_xor(v, o);
    return v;
}
__device__ __forceinline__ unsigned pk2(float lo, float hi) { unsigned r; asm volatile("v_cvt_pk_bf16_f32 %0, %1, %2" : "=v"(r) : "v"(lo), "v"(hi)); return r; }
__device__ __forceinline__ f32x4 bf4(u32x2 w) { f32x4 r; r[0] = __uint_as_float(w.x << 16); r[1] = __uint_as_float(w.x & 0xffff0000u); r[2] = __uint_as_float(w.y << 16); r[3] = __uint_as_float(w.y & 0xffff0000u); return r; }
__device__ __forceinline__ void norm_store(const f32x4 (&x)[4], const float* g, const float* shift, const float* scale, bf16_t* dst, int lane) {
    float ss = 0.f;
#pragma unroll
    for (int j = 0; j < 4; ++j) ss += x[j][0] * x[j][0] + x[j][1] * x[j][1] + x[j][2] * x[j][2] + x[j][3] * x[j][3];
    ss = wave_sum(ss); const float rs = 1.0f / sqrtf(ss * (1.0f / D) + EPS);
#pragma unroll
    for (int j = 0; j < 4; ++j) { const int c = 4 * lane + 256 * j; const f32x4 gv = *(const f32x4*)(g + c), sh = *(const f32x4*)(shift + c), sc = *(const f32x4*)(scale + c);
        const f32x4 o = x[j] * rs * gv * (1.0f + sc) + sh; u32x2 w; w.x = pk2(o[0], o[1]); w.y = pk2(o[2], o[3]); *(u32x2*)(dst + c) = w; }
}
__device__ __forceinline__ void first_norm_phase(const P& p) {
    int tid = threadIdx.x; asm volatile("" : "+v"(tid)); const int wid = tid >> 6, lane = tid & 63;
    for (int i = wid; i < ROWS_PB; i += 8) { const int r = blockIdx.x * ROWS_PB + i; if (r >= M) break;
        const float* src = r < CTX ? p.ctx + (size_t)r * D : p.x + (size_t)(r - CTX) * D; f32x4 x[4];
#pragma unroll
        for (int j = 0; j < 4; ++j) { x[j] = *(const f32x4*)(src + 4 * lane + 256 * j); *(f32x4*)(p.xres + (size_t)r * D + 4 * lane + 256 * j) = x[j]; }
        norm_store(x, p.norm1_g, modv(p, 0, r, 0), modv(p, 0, r, 1), p.hb1 + (size_t)r * D, lane); }
}
__device__ __forceinline__ void combine_phase(const P& p, int l) {
    int tid = threadIdx.x; asm volatile("" : "+v"(tid)); const int wid = tid >> 6, lane = tid & 63;
    for (int i = wid; i < ROWS_PB; i += 8) { const int r = blockIdx.x * ROWS_PB + i; if (r >= M) break;
        const f32x4 tw = *(const f32x4*)(p.topw + (size_t)r * 4); const float* gate = modv(p, l, r, 5); f32x4 x[4];
#pragma unroll
        for (int j = 0; j < 4; ++j) { const int c = 4 * lane + 256 * j; f32x4 s = {0.f, 0.f, 0.f, 0.f};
#pragma unroll
            for (int k = 0; k < 4; ++k) s += bf4(*(const u32x2*)(p.ybn + ((size_t)r * 4 + k) * D + c)) * tw[k];
            x[j] = *(const f32x4*)(p.xres + (size_t)r * D + c) + *(const f32x4*)(gate + c) * s; }
        if (l + 1 < DEPTH) {
#pragma unroll
            for (int j = 0; j < 4; ++j) *(f32x4*)(p.xres + (size_t)r * D + 4 * lane + 256 * j) = x[j];
            norm_store(x, p.norm1_g + (size_t)(l + 1) * D, modv(p, l + 1, r, 0), modv(p, l + 1, r, 1), p.hb1 + (size_t)r * D, lane);
        } else if (r >= CTX) {
#pragma unroll
            for (int j = 0; j < 4; ++j) *(f32x4*)(p.out + (size_t)(r - CTX) * D + 4 * lane + 256 * j) = x[j];
        } }
}
__device__ __forceinline__ void router_phase(const P& p, int l, char* lds) {
    int tid = threadIdx.x; asm volatile("" : "+v"(tid)); const int wid = tid >> 6, lane = tid & 63;
    float* WT = (float*)lds; float* bias2 = WT + 32 * 1024; int* lcnt = (int*)(bias2 + 64); int* lbase = lcnt + 32; int* rec = lbase + 32;
    const float* rwp = p.router_w + (size_t)l * D * NE;
    for (int i = tid; i < D * NE / 4; i += 512) { const int k = i >> 3, e4 = i & 7; const f32x4 v = *(const f32x4*)(rwp + (size_t)k * NE + e4 * 4);
#pragma unroll
        for (int q = 0; q < 4; ++q) WT[(e4 * 4 + q) * 1024 + (k ^ (e4 << 2))] = v[q]; }
    if (tid < 32) lcnt[tid] = 0;
    __syncthreads();
    {
#pragma unroll
        for (int v = 0; v < 2; ++v) { const float* sh = p.mod + ((size_t)(l * 2 + v) * 6 + 3) * D; f32x4 s[4];
#pragma unroll
            for (int j = 0; j < 4; ++j) s[j] = *(const f32x4*)(sh + 4 * lane + 256 * j);
#pragma unroll
            for (int q = 0; q < 4; ++q) { const int e = wid * 4 + q; float a = 0.f;
#pragma unroll
                for (int j = 0; j < 4; ++j) { const f32x4 w = *(const f32x4*)(WT + e * 1024 + ((4 * lane + 256 * j) ^ (((e >> 2) & 7) << 2))); a += w[0] * s[j][0] + w[1] * s[j][1] + w[2] * s[j][2] + w[3] * s[j][3]; }
                a = wave_sum(a); if (lane == 0) bias2[v * 32 + e] = a + p.router_b[l * NE + e]; } }
    }
    __syncthreads();
    const float* g2 = p.norm2_g + (size_t)l * D;
    for (int rp = wid; rp < (ROWS_PB + 1) / 2; rp += 8) {
        float acc[2][32]; float rsv[2]; int rr[2];
        f32x4 xg[2][4];
#pragma unroll
        for (int q = 0; q < 2; ++q) { const int il = 2 * rp + q; const int r = blockIdx.x * ROWS_PB + (il < ROWS_PB ? il : ROWS_PB - 1); rr[q] = r;
            const float* sc = modv(p, l, r, 4); const float* sh = modv(p, l, r, 3); float ss = 0.f; f32x4 x[4];
#pragma unroll
            for (int j = 0; j < 4; ++j) { x[j] = *(const f32x4*)(p.xres + (size_t)r * D + 4 * lane + 256 * j); ss += x[j][0] * x[j][0] + x[j][1] * x[j][1] + x[j][2] * x[j][2] + x[j][3] * x[j][3]; }
            ss = wave_sum(ss); const float rs = 1.0f / sqrtf(ss * (1.0f / D) + EPS); rsv[q] = rs;
#pragma unroll
            for (int j = 0; j < 4; ++j) { const int c = 4 * lane + 256 * j; xg[q][j] = x[j] * *(const f32x4*)(g2 + c) * (1.0f + *(const f32x4*)(sc + c));
                const f32x4 o = xg[q][j] * rs + *(const f32x4*)(sh + c); u32x2 w; w.x = pk2(o[0], o[1]); w.y = pk2(o[2], o[3]); if (il < ROWS_PB) *(u32x2*)(p.hb2 + (size_t)r * D + c) = w; }
        }
#pragma unroll
        for (int e = 0; e < 32; ++e) { float a0 = 0.f, a1 = 0.f;
#pragma unroll
            for (int j = 0; j < 4; ++j) { const f32x4 w = *(const f32x4*)(WT + e * 1024 + ((4 * lane + 256 * j) ^ (((e >> 2) & 7) << 2)));
                a0 += w[0] * xg[0][j][0] + w[1] * xg[0][j][1] + w[2] * xg[0][j][2] + w[3] * xg[0][j][3]; a1 += w[0] * xg[1][j][0] + w[1] * xg[1][j][1] + w[2] * xg[1][j][2] + w[3] * xg[1][j][3]; }
            acc[0][e] = a0; acc[1][e] = a1; }
        float v[64];
#pragma unroll
        for (int e = 0; e < 32; ++e) { v[e] = acc[0][e]; v[32 + e] = acc[1][e]; }
#pragma unroll
        for (int m = 32, n = 64; m >= 1; m >>= 1, n >>= 1) {
#pragma unroll
            for (int i = 0; i < n / 2; ++i) { const bool up = (lane & m) != 0; const float keep = up ? v[i + n / 2] : v[i], send = up ? v[i] : v[i + n / 2]; v[i] = keep + __shfl_xor(send, m); } }
        const int q = lane >> 5, e = lane & 31; const int r = rr[q]; const int il = 2 * rp + q;
        float logit = v[0] * rsv[q] + bias2[(r < CTX ? 32 : 0) + e];
        float cur = logit; int sel[4]; float sv[4];
#pragma unroll
        for (int k = 0; k < 4; ++k) { float mx = cur;
#pragma unroll
            for (int o = 16; o >= 1; o >>= 1) mx = fmaxf(mx, __shfl_xor(mx, o));
            const unsigned long long bal = __ballot(cur == mx); const unsigned half = (unsigned)(bal >> (q * 32)); const int win = __ffs(half) - 1;
            sel[k] = win; sv[k] = mx; if (e == win) cur = -3.0e38f; }
        if (e < 4 && il < ROWS_PB) {
            float es[4], sum = 0.f;
#pragma unroll
            for (int k = 0; k < 4; ++k) { es[k] = __expf(sv[k] - sv[0]); sum += es[k]; }
            const int myk = e; const int mye = myk == 0 ? sel[0] : myk == 1 ? sel[1] : myk == 2 ? sel[2] : sel[3]; const float myw = (myk == 0 ? es[0] : myk == 1 ? es[1] : myk == 2 ? es[2] : es[3]) / sum;
            p.topw[(size_t)r * 4 + myk] = myw; const int pos = atomicAdd(&lcnt[mye], 1); rec[il * 4 + myk] = mye | (pos << 8);
        }
    }
    __syncthreads();
    if (tid < 32) lbase[tid] = atomicAdd(&p.cnt[tid], lcnt[tid]);
    __syncthreads();
    if (tid < ROWS_PB * 4) { const int il = tid >> 2, k = tid & 3; const int r = blockIdx.x * ROWS_PB + il; const int rc = rec[tid]; const int e = rc & 255, pos = rc >> 8;
        p.list[(size_t)e * M + lbase[e] + pos] = r * 4 + k; }
    __syncthreads();
}
}

namespace ml {
typedef short bf16x8 __attribute__((ext_vector_type(8)));
typedef float f32x4 __attribute__((ext_vector_type(4)));
typedef unsigned u32x2 __attribute__((ext_vector_type(2)));
constexpr int RB = 65, MT = 5;
constexpr int AQ_STRIDE = QL * 2 + 16, AKV_STRIDE = KVL * 2 + 16;
constexpr int OFF_AQ = 0, OFF_AKV = OFF_AQ + 80 * AQ_STRIDE, OFF_KRS = OFF_AKV + 80 * AKV_STRIDE, OFF_KSS = OFF_KRS + 80 * 32 * 4, LDS_MLA = OFF_KSS + 80 * 4;
struct MW { const bf16_t* w_uq_t; const bf16_t* w_ukv_t; const float* ropec; const float* ropes; const float* proj; int ldp; bf16_t* qb; bf16_t* kb; bf16_t* vb; };
__device__ __forceinline__ void mla_phase(const P& p, const MW& w, int l, char* lds) {
    int tid = threadIdx.x; asm volatile("" : "+v"(tid)); const int wid = __builtin_amdgcn_readfirstlane(tid >> 6), lane = tid & 63, fr = lane & 15, fq = lane >> 4;
    const int row0 = blockIdx.x * RB;
    for (int i = wid; i < 80; i += 8) {
        char* aq = lds + OFF_AQ + i * AQ_STRIDE; char* akv = lds + OFF_AKV + i * AKV_STRIDE; float* krs = (float*)(lds + OFF_KRS) + i * 32;
        if (i < RB && row0 + i < M) { const float* pr = w.proj + (size_t)(row0 + i) * w.ldp;
            { const f32x4 x = *(const f32x4*)(pr + C_Q + 4 * lane); float ss = rw::wave_sum(x[0] * x[0] + x[1] * x[1] + x[2] * x[2] + x[3] * x[3]); const float rs = 1.0f / sqrtf(ss * (1.0f / QL) + EPS);
              const f32x4 g = *(const f32x4*)(p.q_g + l * QL + 4 * lane); const f32x4 o = x * rs * g; u32x2 v; v.x = rw::pk2(o[0], o[1]); v.y = rw::pk2(o[2], o[3]); *(u32x2*)(aq + 8 * lane) = v; }
            { f32x4 x = {0.f, 0.f, 0.f, 0.f}; if (lane < 32) x = *(const f32x4*)(pr + C_KV + 4 * lane); float ss = rw::wave_sum(x[0] * x[0] + x[1] * x[1] + x[2] * x[2] + x[3] * x[3]); const float rs = 1.0f / sqrtf(ss * (1.0f / KVL) + EPS);
              if (lane < 32) { const f32x4 g = *(const f32x4*)(p.kv_g + l * KVL + 4 * lane); const f32x4 o = x * rs * g; u32x2 v; v.x = rw::pk2(o[0], o[1]); v.y = rw::pk2(o[2], o[3]); *(u32x2*)(akv + 8 * lane) = v; } }
            { f32x4 x = {0.f, 0.f, 0.f, 0.f}; if (lane < 8) { x = *(const f32x4*)(pr + C_KR + 4 * lane); *(f32x4*)(krs + 4 * lane) = x; }
              const float ss = rw::wave_sum(x[0] * x[0] + x[1] * x[1] + x[2] * x[2] + x[3] * x[3]); if (lane == 0) ((float*)(lds + OFF_KSS))[i] = ss; }
        } else {
            u32x2 z; z.x = 0u; z.y = 0u; *(u32x2*)(aq + 8 * lane) = z; if (lane < 32) *(u32x2*)(akv + 8 * lane) = z; if (lane < 32) krs[lane] = 0.f; if (lane == 0) ((float*)(lds + OFF_KSS))[i] = 0.f;
        }
    }
    __syncthreads();
    if (wid < 6) {
        const int hh = wid; f32x4 acc[MT][6];
#pragma unroll
        for (int mt = 0; mt < MT; ++mt)
#pragma unroll
            for (int nt = 0; nt < 6; ++nt) acc[mt][nt] = (f32x4){0.f, 0.f, 0.f, 0.f};
        const bf16_t* wb = w.w_uq_t + (size_t)(hh * QKD + fr) * QL + 8 * fq;
#pragma unroll 1
        for (int ks = 0; ks < QL / 32; ++ks) { bf16x8 b[6], a[MT];
#pragma unroll
            for (int nt = 0; nt < 6; ++nt) b[nt] = *(const bf16x8*)(wb + (size_t)nt * 16 * QL + ks * 32);
#pragma unroll
            for (int mt = 0; mt < MT; ++mt) a[mt] = *(const bf16x8*)(lds + OFF_AQ + (mt * 16 + fr) * AQ_STRIDE + (ks * 32 + 8 * fq) * 2);
#pragma unroll
            for (int mt = 0; mt < MT; ++mt)
#pragma unroll
                for (int nt = 0; nt < 6; ++nt) acc[mt][nt] = __builtin_amdgcn_mfma_f32_16x16x32_bf16(b[nt], a[mt], acc[mt][nt], 0, 0, 0); }
        f32x4 gq[6];
#pragma unroll
        for (int nt = 0; nt < 6; ++nt) gq[nt] = *(const f32x4*)(p.qn_g + l * QKD + nt * 16 + 4 * fq);
#pragma unroll
        for (int mt = 0; mt < MT; ++mt) { const int il = mt * 16 + fr; const int r = row0 + il; const bool ok = il < RB && r < M; float ss = 0.f;
#pragma unroll
            for (int nt = 0; nt < 6; ++nt) ss += acc[mt][nt][0] * acc[mt][nt][0] + acc[mt][nt][1] * acc[mt][nt][1] + acc[mt][nt][2] * acc[mt][nt][2] + acc[mt][nt][3] * acc[mt][nt][3];
            ss += __shfl_xor(ss, 16); ss += __shfl_xor(ss, 32); const float rs = 1.0f / sqrtf(ss * (1.0f / QKD) + EPS);
            const bool lat = r >= CTX; const int t = lat ? r - CTX : 0;
#pragma unroll
            for (int nt = 0; nt < 6; ++nt) { f32x4 v = acc[mt][nt] * rs * gq[nt];
                if (nt >= 4) { f32x4 other; other[0] = __shfl_xor(v[0], 32); other[1] = __shfl_xor(v[1], 32); other[2] = __shfl_xor(v[2], 32); other[3] = __shfl_xor(v[3], 32);
                    if (lat && ok) { const int pos = (nt == 4) ? (t / GRID_W) : (t % GRID_W); const f32x4 cs = *(const f32x4*)(w.ropec + (size_t)pos * 8 + 4 * (fq & 1)), sn = *(const f32x4*)(w.ropes + (size_t)pos * 8 + 4 * (fq & 1));
                        v = (fq >> 1) ? (v * cs + other * sn) : (v * cs - other * sn); } }
                if (ok) { u32x2 o; o.x = rw::pk2(v[0], v[1]); o.y = rw::pk2(v[2], v[3]); *(u32x2*)(w.qb + ((size_t)r * NH + hh) * QKD + nt * 16 + 4 * fq) = o; } } }
    } else {
        for (int hs = 0; hs < 3; ++hs) { const int hh = (wid - 6) * 3 + hs;
#pragma unroll
          for (int pass = 0; pass < 2; ++pass) { f32x4 acc[MT][4];
#pragma unroll
            for (int mt = 0; mt < MT; ++mt)
#pragma unroll
                for (int nt = 0; nt < 4; ++nt) acc[mt][nt] = (f32x4){0.f, 0.f, 0.f, 0.f};
            const bf16_t* wb = w.w_ukv_t + (size_t)(hh * 128 + pass * 64 + fr) * KVL + 8 * fq;
#pragma unroll 1
            for (int ks = 0; ks < KVL / 32; ++ks) { bf16x8 b[4], a[MT];
#pragma unroll
                for (int nt = 0; nt < 4; ++nt) b[nt] = *(const bf16x8*)(wb + (size_t)nt * 16 * KVL + ks * 32);
#pragma unroll
                for (int mt = 0; mt < MT; ++mt) a[mt] = *(const bf16x8*)(lds + OFF_AKV + (mt * 16 + fr) * AKV_STRIDE + (ks * 32 + 8 * fq) * 2);
#pragma unroll
                for (int mt = 0; mt < MT; ++mt)
#pragma unroll
                    for (int nt = 0; nt < 4; ++nt) acc[mt][nt] = __builtin_amdgcn_mfma_f32_16x16x32_bf16(b[nt], a[mt], acc[mt][nt], 0, 0, 0); }
            if (pass == 0) {
                f32x4 gk[4], gr[2], gro[2];
#pragma unroll
                for (int nt = 0; nt < 4; ++nt) gk[nt] = *(const f32x4*)(p.kn_g + l * QKD + nt * 16 + 4 * fq);
#pragma unroll
                for (int a = 0; a < 2; ++a) { gr[a] = *(const f32x4*)(p.kn_g + l * QKD + NOPE + a * 16 + 4 * fq); gro[a] = *(const f32x4*)(p.kn_g + l * QKD + NOPE + a * 16 + ((4 * fq) ^ 8)); }
#pragma unroll
                for (int mt = 0; mt < MT; ++mt) { const int il = mt * 16 + fr; const int r = row0 + il; const bool ok = il < RB && r < M; float ss = 0.f;
#pragma unroll
                    for (int nt = 0; nt < 4; ++nt) ss += acc[mt][nt][0] * acc[mt][nt][0] + acc[mt][nt][1] * acc[mt][nt][1] + acc[mt][nt][2] * acc[mt][nt][2] + acc[mt][nt][3] * acc[mt][nt][3];
                    ss += __shfl_xor(ss, 16); ss += __shfl_xor(ss, 32); ss += ((const float*)(lds + OFF_KSS))[il]; const float rs = 1.0f / sqrtf(ss * (1.0f / QKD) + EPS);
                    const bool lat = r >= CTX; const int t = lat ? r - CTX : 0;
                    if (ok) {
                        bf16_t* kd = w.kb + ((size_t)r * NH + hh) * QKD; const float* krs = (const float*)(lds + OFF_KRS) + il * 32;
#pragma unroll
                        for (int nt = 0; nt < 4; ++nt) { const f32x4 v = acc[mt][nt] * rs * gk[nt]; u32x2 o; o.x = rw::pk2(v[0], v[1]); o.y = rw::pk2(v[2], v[3]); *(u32x2*)(kd + nt * 16 + 4 * fq) = o; }
#pragma unroll
                        for (int a = 0; a < 2; ++a) { f32x4 v = *(const f32x4*)(krs + a * 16 + 4 * fq) * rs * gr[a]; const f32x4 other = *(const f32x4*)(krs + a * 16 + ((4 * fq) ^ 8)) * rs * gro[a];
                            if (lat) { const int pos = (a == 0) ? (t / GRID_W) : (t % GRID_W); const f32x4 cs = *(const f32x4*)(w.ropec + (size_t)pos * 8 + 4 * (fq & 1)), sn = *(const f32x4*)(w.ropes + (size_t)pos * 8 + 4 * (fq & 1));
                                v = (fq >> 1) ? (v * cs + other * sn) : (v * cs - other * sn); }
                            u32x2 o; o.x = rw::pk2(v[0], v[1]); o.y = rw::pk2(v[2], v[3]); *(u32x2*)(kd + NOPE + a * 16 + 4 * fq) = o; }
                    } }
            } else {
#pragma unroll
                for (int mt = 0; mt < MT; ++mt) { const int il = mt * 16 + fr; const int r = row0 + il; const bool ok = il < RB && r < M;
                    if (ok) { bf16_t* vd = w.vb + ((size_t)r * NH + hh) * VD;
#pragma unroll
                        for (int nt = 0; nt < 4; ++nt) { const f32x4 v = acc[mt][nt]; u32x2 o; o.x = rw::pk2(v[0], v[1]); o.y = rw::pk2(v[2], v[3]); *(u32x2*)(vd + nt * 16 + 4 * fq) = o; } } }
            }
          }
        }
    }
    __syncthreads();
}
}

#ifndef CHECK_MLA
#define CHECK_MLA 0
#endif
__device__ __forceinline__ int gtid() { int t = threadIdx.x; asm volatile("" : "+v"(t)); return blockIdx.x * 512 + t; }
template <int OP> __device__ __forceinline__ void run_op(const P& p, int l) {
    const long n = op_count(OP); const long stride = (long)gridDim.x * blockDim.x;
    for (long i = gtid(); i < n; i += stride) op_run(OP, p, l, i);
}
struct KArgs { P p; FW f; unsigned* bar; };
__device__ __forceinline__ const KArgs& kargs() { auto q = __builtin_amdgcn_kernarg_segment_ptr(); asm volatile("" : "+s"(q)); return *(const KArgs*)q; }
constexpr int LDS_BYTES = gm::STAGE_BYTES + 4096;
#define BAR() do { XcdBarrier b2_; b2_.bar = kargs().bar; unsigned xx_ = xbx; asm volatile("" : "+s"(xx_)); b2_.x = xx_; b2_.st = (volatile LAS unsigned*)(lds + LDS_BYTES - 16); xcd_barrier(b2_); } while (0)
#define PH(OPX) do { run_op<OPX>(kargs().p, lo()); BAR(); } while (0)
#define RUN(OPX) run_op<OPX>(kargs().p, lo())

__device__ __forceinline__ void attn_phase(const P& p, float* O, int ldo, char* lds) {
    constexpr int NQT = M / 256, NU = NH * NQT;
    for (int u = blockIdx.x; u < NU; u += gridDim.x) {
        const int hh = u / NQT, qt = u % NQT; const int seq = qt == 0 ? CTX : M;
        __syncthreads();
        at::attn_body(p.qb + (size_t)qt * 256 * at::LDQ + hh * at::DQ, p.kb + hh * at::DQ, p.vb + hh * at::DV, O + (size_t)qt * 256 * ldo + hh * at::DV, ldo, seq, lds);
    }
    __syncthreads();
}
template <class TA> __device__ __forceinline__ float ldf(const TA* a, size_t i);
template <> __device__ __forceinline__ float ldf<float>(const float* a, size_t i) { return a[i]; }
template <> __device__ __forceinline__ float ldf<bf16_t>(const bf16_t* a, size_t i) { return bf2f(a[i]); }
template <class TA, class TB> __device__ __forceinline__ void chk_accum(const TA* a, int lda, const TB* b, int ldb, long nrows, int ncols, float* diag) {
    float sd = 0.f, sr = 0.f; const long n = nrows * ncols; const long stride = (long)gridDim.x * blockDim.x;
    for (long i = gtid(); i < n; i += stride) { const long r = i / ncols; const int c = (int)(i % ncols);
        const float x = ldf<TA>(a, r * lda + c), y = ldf<TB>(b, r * ldb + c); sd += (x - y) * (x - y); sr += y * y; }
    for (int o = 32; o >= 1; o >>= 1) { sd += __shfl_xor(sd, o); sr += __shfl_xor(sr, o); }
    if ((threadIdx.x & 63) == 0) { atomicAdd(diag, sd); atomicAdd(diag + 1, sr); }
}
#define MLA_CALL(QB, KB, VB) { const int ll_ = lo(); ml::MW mw_; mw_.qb = (QB); mw_.kb = (KB); mw_.vb = (VB); mw_.w_uq_t = KF.w_uq_t + (size_t)ll_ * NH * QKD * QL; mw_.w_ukv_t = KF.w_ukv_t + (size_t)ll_ * NH * 128 * KVL; \
        mw_.ropec = KF.ropec; mw_.ropes = KF.ropes; mw_.proj = KP.proj; mw_.ldp = INC; ml::mla_phase(KP, mw_, ll_, lds); }
#if CHECK_MLA
#define MLA_STEP PH(OP_LATNORM); RUN(OP_QRAW); PH(OP_KVRAW); RUN(OP_QHEAD); RUN(OP_KHEAD); if (l == 0) { MLA_CALL(KF.qb2, KF.kb2, KF.vb2) } BAR(); \
        if (l == 0) { chk_accum<bf16_t, bf16_t>(KF.qb2, NH * QKD, KP.qb, NH * QKD, M, NH * QKD, KP.diag + 0); chk_accum<bf16_t, bf16_t>(KF.kb2, NH * QKD, KP.kb, NH * QKD, M, NH * QKD, KP.diag + 2); chk_accum<bf16_t, bf16_t>(KF.vb2, NH * VD, KP.vb, NH * VD, M, NH * VD, KP.diag + 4); }
#else
#define MLA_STEP MLA_CALL(KP.qb, KP.kb, KP.vb) BAR();
#endif
#define LAYER_BODY(L) { const int l = (L); \
        auto lo = [&]() { int ll = l; asm volatile("" : "+s"(ll)); return ll; }; \
        if (blockIdx.x == 0 && threadIdx.x < NE) KP.cnt[threadIdx.x] = 0; \
        inproj_phase(KP, KF, lo(), KP.proj, lds); BAR(); \
        MLA_STEP \
        RUN(OP_CONV); RUN(OP_DT); PH(OP_POOLP); \
        RUN(OP_SSD_CS); RUN(OP_SSD_G); PH(OP_POOLMM); \
        attn_phase(KP, KP.mixin, MIXW, lds); \
        RUN(OP_SSD_YD); PH(OP_SSD_ST); PH(OP_SSD_CARRY); PH(OP_SSD_YOFF); \
        PH(OP_SSDFIN); PH(OP_MIXB); \
        outproj_phase<true>(KP, KF, lo(), KP.xres, lds); BAR(); \
        rw::router_phase(KP, lo(), lds); BAR(); \
        moe1_phase(KP, KF, lo(), lds); BAR(); moe2_phase(KP, KF, lo(), lds); BAR(); \
        rw::combine_phase(KP, lo()); BAR(); \
    }
__global__ void __launch_bounds__(512, 2) k_mega(KArgs a) {
    extern __shared__ __attribute__((aligned(16))) char lds[];
    uint4* xbw = (uint4*)(lds + LDS_BYTES - 16);
    if (threadIdx.x == 0) *xbw = make_uint4(0u, 0u, 0u, 0u);
    __syncthreads();
    const unsigned xbx = xcd_barrier_post(kargs().bar, (volatile LAS unsigned*)xbw).x;
#define KP kargs().p
#define KF kargs().f
    { const int l = 0; auto lo = [&]() { return l; }; if (blockIdx.x == 0 && threadIdx.x < 16) KP.diag[threadIdx.x] = 0.f; RUN(OP_MODVEC);
      cvt_phase(KP, KF, 0, DEPTH, lds); BAR(); rw::first_norm_phase(KP); BAR(); }
    LAYER_BODY(0) LAYER_BODY(1) LAYER_BODY(2) LAYER_BODY(3)
#if CHECK_MLA
    {
        float e = 0.f;
        for (int c = 0; c < 3; ++c) { const float ec = sqrtf(KP.diag[2 * c] / KP.diag[2 * c + 1]); e = ec > e ? ec : e; if (!(ec == ec)) e = 1e3f; }
        const float sc = 1.0f + 10.0f * e; const long n = (long)SEQ * D; const long stride = (long)gridDim.x * blockDim.x;
        for (long i = gtid(); i < n; i += stride) KP.out[i] *= sc;
    }
#endif
#undef KP
#undef KF
}
static size_t carve(char*& cur, size_t bytes) { size_t a = (bytes + 255) & ~(size_t)255; cur += a; return a; }
static bool setup_params(P& p, FW& f, unsigned*& bar, void* const* d_in, void* d_out, void* d_ws, size_t ws_size) {
    const float** pp = (const float**)&p; for (int i = 0; i < 32; ++i) pp[i] = (const float*)d_in[i];
    p.out = (float*)d_out;
    char* cur = (char*)d_ws; char* base = cur;
    bar = (unsigned*)cur; carve(cur, XCD_BAR_WORDS * sizeof(unsigned));
#define CARVE(field, type, count) p.field = (type*)cur; carve(cur, (size_t)(count) * sizeof(type));
#define CARVEF(field, type, count) f.field = (type*)cur; carve(cur, (size_t)(count) * sizeof(type));
    CARVE(xres, float, (size_t)M * D) CARVE(mod, float, (size_t)DEPTH * 12 * D) CARVE(rs, float, M) CARVE(h, float, (size_t)M * D) CARVE(proj, float, (size_t)M * INC) CARVE(qln, float, (size_t)M * QL)
    CARVE(kvln, float, (size_t)M * KVL) CARVE(qraw, float, (size_t)M * NH * QKD) CARVE(kvraw, float, (size_t)M * NH * 128) CARVE(q, float, (size_t)M * NH * QKD) CARVE(k, float, (size_t)M * NH * QKD)
    CARVE(v, float, (size_t)M * NH * VD) CARVE(mixin, float, (size_t)M * MIXW) CARVE(xbc, float, (size_t)M * CONVD) CARVE(dt, float, (size_t)M * 12) CARVE(ydir, float, (size_t)2 * M * SW)
    CARVE(poolp, float, (size_t)M * PW) CARVE(mix, float, (size_t)M * D) CARVE(logits, float, (size_t)M * NE) CARVE(topw, float, (size_t)M * 4)
    CARVE(topi, int, (size_t)M * 4) CARVE(cnt, int, NE) CARVE(list, int, (size_t)NE * M)
    CARVE(qb, bf16_t, (size_t)M * NH * QKD) CARVE(kb, bf16_t, (size_t)M * NH * QKD) CARVE(vb, bf16_t, (size_t)M * NH * VD) CARVE(diag, float, 64)
    CARVE(cs, float, (size_t)2 * M * SH) CARVE(cdec, float, (size_t)2 * NCH * SH) CARVE(gmat, float, (size_t)M * SG * CHUNK) CARVE(st, float, (size_t)2 * NCH * SH * SP * SN)
    CARVE(hb1, bf16_t, (size_t)M * D) CARVE(hb2, bf16_t, (size_t)M * D) CARVE(mixb, bf16_t, (size_t)M * MIXW)
    CARVEF(actb, bf16_t, (size_t)4 * M * FF) CARVEF(yb, bf16_t, (size_t)4 * M * D)
    f.hb1 = p.hb1; f.hb2 = p.hb2; f.mixb = p.mixb; p.ybn = f.yb; p.attf = nullptr;
    const int nl = DEPTH;
    CARVEF(w_uq_t, bf16_t, (size_t)nl * NH * QKD * QL) CARVEF(w_ukv_t, bf16_t, (size_t)nl * NH * 128 * KVL) CARVEF(ropec, float, 256 * 8) CARVEF(ropes, float, 256 * 8)
    CARVEF(qb2, bf16_t, (size_t)M * NH * QKD) CARVEF(kb2, bf16_t, (size_t)M * NH * QKD) CARVEF(vb2, bf16_t, (size_t)M * NH * VD)
    CARVEF(w_in_t, bf16_t, (size_t)nl * INC_PAD * D) CARVEF(w_out_t, bf16_t, (size_t)nl * D * MIXW) CARVEF(gu_t, bf16_t, (size_t)nl * NE * 2 * FF * D) CARVEF(d_t, bf16_t, (size_t)nl * NE * D * FF)
    p.act = nullptr; p.down = nullptr; f.proj2 = nullptr; f.mix2 = nullptr;
#undef CARVE
#undef CARVEF
    return (size_t)(cur - base) <= ws_size;
}
extern "C" void kernel_launch(void* const* d_in, const int* in_sizes, int n_in, void* d_out, int out_size, void* d_ws, size_t ws_size, hipStream_t stream) {
    KArgs a{};
    if (n_in < 32 || !setup_params(a.p, a.f, a.bar, d_in, d_out, d_ws, ws_size)) return;
    static int grid = 0;
    if (!grid) { int dev = 0, cus = 0, per_cu = 0; (void)hipGetDevice(&dev); (void)hipDeviceGetAttribute(&cus, hipDeviceAttributeMultiprocessorCount, dev);
        (void)hipFuncSetAttribute((const void*)k_mega, hipFuncAttributeMaxDynamicSharedMemorySize, LDS_BYTES);
        (void)hipOccupancyMaxActiveBlocksPerMultiprocessor(&per_cu, k_mega, 512, LDS_BYTES); grid = cus * (per_cu < 1 ? per_cu : 1); }
    if (grid <= 0) return;
    (void)hipMemsetAsync(a.bar, 0, XCD_BAR_WORDS * sizeof(unsigned), stream);
    hipLaunchKernelGGL(k_mega, dim3(grid), dim3(512), LDS_BYTES, stream, a);
}
```

```cpp
#include <hip/hip_runtime.h>
#include <stdint.h>
#define CHECK_SSD 0
#include <stdlib.h>
#include <stdio.h>

#ifndef NAIVE_H
#define NAIVE_H
#include <math.h>
#ifdef HOST_TEST
#define HD inline
#define HDC inline
#define ATOMIC_INC(p) ((*(p))++)
#define UNIFORM(x) (x)
#else
#define HD __device__ __forceinline__
#define HDC __host__ __device__ __forceinline__
#define ATOMIC_INC(p) atomicAdd((p), 1)
#define UNIFORM(x) __builtin_amdgcn_readfirstlane(x)
#endif

#ifndef CFG_D
#define CFG_D 1024
#define CFG_SEQ 16384
#define CFG_CTX 256
#define CFG_FF 1024
#define CFG_DEPTH 4
#endif
constexpr int D = CFG_D, SEQ = CFG_SEQ, CTX = CFG_CTX, FF = CFG_FF, DEPTH = CFG_DEPTH;
constexpr int M = CTX + SEQ;
constexpr int GRID_W = 64;
constexpr int NH = 6, QKD = 96, NOPE = 64, ROPE = 32, VD = 64, QL = 256, KVL = 128;
constexpr int SH = 6, SP = 64, SW = 384, SG = 2, SN = 64, CONVD = 640, CHUNK = 128;
constexpr int PW = 256, MIXW = 1024, INC = 1708;
constexpr int C_Q = 0, C_KV = 256, C_KR = 384, C_Z = 416, C_XBC = 800, C_DT = 1440, C_POOL = 1452;
constexpr int NE = 32, TOPK = 4;
constexpr int NCH = M / CHUNK;
constexpr float EPS = 1e-6f;

typedef unsigned short bf16_t;
HD bf16_t f2bf(float f) { union { float f; unsigned u; } v; v.f = f; unsigned u = v.u; u += 0x7FFFu + ((u >> 16) & 1u); return (bf16_t)(u >> 16); }
HD float bf2f(bf16_t b) { union { float f; unsigned u; } v; v.u = ((unsigned)b) << 16; return v.f; }
struct P {
    const float *x, *c, *ctx, *c_ctx, *norm1_g, *norm2_g, *mod_w, *mod_b, *w_in, *q_g, *kv_g, *w_uq, *w_ukv, *qn_g, *kn_g;
    const float *conv_w, *conv_b, *a_log, *dt_bias, *ssd_d, *ssd_norm_g, *pool_w, *pool_scale, *w_out, *router_w, *router_b;
    const float *wg, *bg, *wu, *bu, *wd, *bd;
    float* out;
    float *xres, *mod, *rs, *h, *proj, *qln, *kvln, *qraw, *kvraw, *q, *k, *v, *mixin, *xbc, *dt, *ydir, *poolp, *mix, *logits, *topw, *act, *down;
    int *topi, *cnt, *list;
    bf16_t *qb, *kb, *vb;
    float *attf, *diag;
    float *cs, *cdec, *gmat, *st;
    bf16_t *hb1, *hb2, *mixb, *ybn;
};

HD float siluf(float x) { return x / (1.0f + expf(-x)); }
HD float sigmf(float x) { return 1.0f / (1.0f + expf(-x)); }
HD float softplusf(float x) { return x > 20.0f ? x : log1pf(expf(x)); }
HD const float* modv(const P& p, int l, int r, int j) { return p.mod + ((size_t)(l * 2 + (r < CTX ? 1 : 0)) * 6 + j) * D; }

enum { OP_COPY_IN = 0, OP_MODVEC, OP_ROWSTAT, OP_NORM1, OP_INPROJ, OP_LATNORM, OP_QRAW, OP_KVRAW, OP_QHEAD, OP_KHEAD, OP_ATTN, OP_CONV, OP_DT, OP_SSDSCAN, OP_SSDFIN,
       OP_POOLP, OP_POOLMM, OP_OUTPROJ, OP_RES1, OP_NORM2, OP_LOGITS, OP_ZEROCNT, OP_TOPK, OP_GATEUP, OP_DOWN, OP_COMBINE, OP_WRITE_OUT, OP_MIXB, OP_COMBINE2, OP_SSD_CS, OP_SSD_G, OP_SSD_YD, OP_SSD_ST, OP_SSD_CARRY, OP_SSD_YOFF, OP_COUNT };

HDC long op_count(int op) {
    switch (op) {
        case OP_COPY_IN: return (long)M * D;
        case OP_MODVEC: return (long)DEPTH * 2 * 6 * D;
        case OP_ROWSTAT: return M;
        case OP_NORM1: case OP_NORM2: return (long)M * D;
        case OP_INPROJ: return (long)(M / 8) * INC;
        case OP_LATNORM: return 2L * M;
        case OP_QRAW: return (long)(M / 8) * (NH * QKD);
        case OP_KVRAW: return (long)(M / 8) * (NH * 128);
        case OP_QHEAD: case OP_KHEAD: return (long)M * NH;
        case OP_ATTN: return (long)M * NH;
        case OP_CONV: return (long)M * CONVD;
        case OP_DT: return (long)M * 12;
        case OP_SSDSCAN: return 2L * SH * SP;
        case OP_SSDFIN: return M;
        case OP_POOLP: return (long)M * PW;
        case OP_POOLMM: return (long)M * PW;
        case OP_OUTPROJ: return (long)(M / 8) * D;
        case OP_RES1: return (long)M * D;
        case OP_LOGITS: return (long)M * NE;
        case OP_ZEROCNT: return NE;
        case OP_TOPK: return M;
        case OP_GATEUP: return (long)NE * (M / 8) * FF;
        case OP_DOWN: return (long)NE * (M / 8) * D;
        case OP_COMBINE: return (long)M * D;
        case OP_WRITE_OUT: return (long)SEQ * D;
        case OP_MIXB: return (long)M * MIXW;
        case OP_COMBINE2: return (long)M * D;
        case OP_SSD_CS: return 2L * NCH * SH;
        case OP_SSD_G: return (long)M * SG * CHUNK;
        case OP_SSD_YD: return (long)M * SW;
        case OP_SSD_ST: return 2L * NCH * SH * SP * SN;
        case OP_SSD_CARRY: return 2L * SH * SP * SN;
        case OP_SSD_YOFF: return (long)M * SW;
    }
    return 0;
}

HD void gemm8(const float* A, int lda, const float* B, int ldb, const float* bias, float* C, int ldc, int N, int K, long idx) {
    const int j = (int)(idx % N); const long r0 = (idx / N) * 8;
    float acc[8];
#pragma unroll
    for (int i = 0; i < 8; ++i) acc[i] = 0.f;
    const float* a = A + r0 * lda;
    for (int k = 0; k < K; ++k) {
        const float b = B[(size_t)k * ldb + j];
#pragma unroll
        for (int i = 0; i < 8; ++i) acc[i] += a[(size_t)i * lda + k] * b;
    }
    const float bv = bias ? bias[j] : 0.f;
#pragma unroll
    for (int i = 0; i < 8; ++i) C[(r0 + i) * ldc + j] = acc[i] + bv;
}

HD void sincos_rr(float angf, float& cs, float& sn) {
    const double x = (double)angf; const double n = rint(x * 0.63661977236758134308); const double y = (x - n * 1.57079632679489655800) - n * 6.123233995736766e-17; const double y2 = y * y;
    const double s = y * (1.0 + y2 * (-1.0 / 6 + y2 * (1.0 / 120 + y2 * (-1.0 / 5040 + y2 * (1.0 / 362880 + y2 * (-1.0 / 39916800))))));
    const double c = 1.0 + y2 * (-0.5 + y2 * (1.0 / 24 + y2 * (-1.0 / 720 + y2 * (1.0 / 40320 + y2 * (-1.0 / 3628800 + y2 * (1.0 / 479001600))))));
    const int q = ((int)n) & 3; const double cc = (q == 0) ? c : (q == 1) ? -s : (q == 2) ? -c : s; const double ss = (q == 0) ? s : (q == 1) ? c : (q == 2) ? -s : -c;
    cs = (float)cc; sn = (float)ss;
}
HD float rope_inv_freq(int f) { return f == 0 ? 1.0f : f == 1 ? 0.31622776f : f == 2 ? 0.1f : f == 3 ? 0.031622775f : f == 4 ? 0.01f : f == 5 ? 0.0031622776f : f == 6 ? 0.001f : 0.00031622776f; }
HD void rope_apply(float* v32, int t) {
    const float row = (float)(t / GRID_W), col = (float)(t % GRID_W);
#pragma unroll
    for (int a = 0; a < 2; ++a)
#pragma unroll
        for (int f = 0; f < 8; ++f) {
            const float ang = (a == 0 ? row : col) * rope_inv_freq(f);
            float cs, sn; sincos_rr(ang, cs, sn);
            const float x1 = v32[a * 16 + f], x2 = v32[a * 16 + 8 + f];
            v32[a * 16 + f] = x1 * cs - x2 * sn; v32[a * 16 + 8 + f] = x2 * cs + x1 * sn;
        }
}

HD void op_run(int op, const P& p, int l, long idx) {
    switch (op) {
    case OP_COPY_IN: { const long r = idx / D; const int c = (int)(idx % D); p.xres[idx] = r < CTX ? p.ctx[idx] : p.x[(r - CTX) * D + c]; } break;
    case OP_MODVEC: {
        const int j = (int)(idx % (6 * D)); const int which = (int)((idx / (6 * D)) % 2); const int ll = (int)(idx / (12 * D));
        const float* cv = which ? p.c_ctx : p.c; float s = 0.f;
        for (int k = 0; k < D; ++k) s += siluf(cv[k]) * p.mod_w[((size_t)ll * D + k) * (6 * D) + j];
        p.mod[idx] = s + p.mod_b[(size_t)ll * 6 * D + j];
    } break;
    case OP_ROWSTAT: { const float* xr = p.xres + idx * D; float s = 0.f; for (int k = 0; k < D; ++k) s += xr[k] * xr[k]; p.rs[idx] = 1.0f / sqrtf(s / D + EPS); } break;
    case OP_NORM1: case OP_NORM2: { const int r = (int)(idx / D), c = (int)(idx % D); const int o = op == OP_NORM1 ? 0 : 3;
        const float g = (op == OP_NORM1 ? p.norm1_g : p.norm2_g)[l * D + c];
        const float hv = p.xres[idx] * p.rs[r] * g * (1.0f + modv(p, l, r, o + 1)[c]) + modv(p, l, r, o)[c]; p.h[idx] = hv;
        bf16_t* hb = op == OP_NORM1 ? p.hb1 : p.hb2; if (hb) hb[idx] = f2bf(hv); } break;
    case OP_INPROJ: gemm8(p.h, D, p.w_in + (size_t)l * D * INC, INC, nullptr, p.proj, INC, INC, D, idx); break;
    case OP_LATNORM: {
        const int which = idx >= M; const long r = which ? idx - M : idx; const int n = which ? KVL : QL; const float* src = p.proj + r * INC + (which ? C_KV : C_Q);
        float s = 0.f; for (int k = 0; k < n; ++k) s += src[k] * src[k]; const float rs = 1.0f / sqrtf(s / n + EPS);
        float* dst = which ? p.kvln + r * KVL : p.qln + r * QL; const float* g = which ? p.kv_g + l * KVL : p.q_g + l * QL;
        for (int k = 0; k < n; ++k) dst[k] = src[k] * rs * g[k];
    } break;
    case OP_QRAW: gemm8(p.qln, QL, p.w_uq + (size_t)l * QL * (NH * QKD), NH * QKD, nullptr, p.qraw, NH * QKD, NH * QKD, QL, idx); break;
    case OP_KVRAW: gemm8(p.kvln, KVL, p.w_ukv + (size_t)l * KVL * (NH * 128), NH * 128, nullptr, p.kvraw, NH * 128, NH * 128, KVL, idx); break;
    case OP_QHEAD: { const int r = (int)(idx / NH), hh = (int)(idx % NH); const float* src = p.qraw + (size_t)r * (NH * QKD) + hh * QKD; float s = 0.f;
        for (int d = 0; d < QKD; ++d) s += src[d] * src[d]; const float rs = 1.0f / sqrtf(s / QKD + EPS);
        float* dst = p.q + ((size_t)r * NH + hh) * QKD; float rp[32];
        for (int d = 0; d < NOPE; ++d) dst[d] = src[d] * rs * p.qn_g[l * QKD + d];
#pragma unroll
        for (int d = 0; d < 32; ++d) rp[d] = src[NOPE + d] * rs * p.qn_g[l * QKD + NOPE + d];
        if (r >= CTX) rope_apply(rp, r - CTX);
#pragma unroll
        for (int d = 0; d < 32; ++d) dst[NOPE + d] = rp[d];
        bf16_t* db = p.qb + ((size_t)r * NH + hh) * QKD;
        for (int d = 0; d < QKD; ++d) db[d] = f2bf(dst[d]);
    } break;
    case OP_KHEAD: { const int r = (int)(idx / NH), hh = (int)(idx % NH); const float* kn = p.kvraw + (size_t)r * (NH * 128) + hh * 128; const float* kr = p.proj + (size_t)r * INC + C_KR; float s = 0.f;
        for (int d = 0; d < NOPE; ++d) s += kn[d] * kn[d];
        for (int d = 0; d < ROPE; ++d) s += kr[d] * kr[d];
        const float rs = 1.0f / sqrtf(s / QKD + EPS);
        float* dst = p.k + ((size_t)r * NH + hh) * QKD; float rp[32];
        for (int d = 0; d < NOPE; ++d) dst[d] = kn[d] * rs * p.kn_g[l * QKD + d];
#pragma unroll
        for (int d = 0; d < 32; ++d) rp[d] = kr[d] * rs * p.kn_g[l * QKD + NOPE + d];
        if (r >= CTX) rope_apply(rp, r - CTX);
#pragma unroll
        for (int d = 0; d < 32; ++d) dst[NOPE + d] = rp[d];
        float* vd = p.v + ((size_t)r * NH + hh) * VD;
        for (int d = 0; d < VD; ++d) vd[d] = kn[NOPE + d];
        bf16_t* db = p.kb + ((size_t)r * NH + hh) * QKD; bf16_t* vdb = p.vb + ((size_t)r * NH + hh) * VD;
        for (int d = 0; d < QKD; ++d) db[d] = f2bf(dst[d]);
        for (int d = 0; d < VD; ++d) vdb[d] = f2bf(kn[NOPE + d]);
    } break;
    case OP_ATTN: {
        const int r = (int)(idx % M), hh = UNIFORM((int)(idx / M)); const int nk = r < CTX ? CTX : M;
        float qv[QKD];
        const float* qp = p.q + ((size_t)r * NH + hh) * QKD; const float scale = 1.0f / sqrtf((float)QKD);
#pragma unroll
        for (int d = 0; d < QKD; ++d) qv[d] = qp[d] * scale;
        for (int half = 0; half < 2; ++half) {
            float o[32];
#pragma unroll
            for (int d = 0; d < 32; ++d) o[d] = 0.f;
            float mx = -1e30f, lsum = 0.f;
            for (int kk = 0; kk < nk; ++kk) {
                const float* kp = p.k + ((size_t)kk * NH + hh) * QKD; const float* vp = p.v + ((size_t)kk * NH + hh) * VD + half * 32; float s = 0.f;
#pragma unroll
                for (int d = 0; d < QKD; ++d) s += qv[d] * kp[d];
                const float mn = s > mx ? s : mx; const float corr = expf(mx - mn), pe = expf(s - mn);
                lsum = lsum * corr + pe; mx = mn;
#pragma unroll
                for (int d = 0; d < 32; ++d) o[d] = o[d] * corr + pe * vp[d];
            }
            const float inv = 1.0f / lsum; float* dst = p.mixin + (size_t)r * MIXW + hh * VD + half * 32;
#pragma unroll
            for (int d = 0; d < 32; ++d) dst[d] = o[d] * inv;
        }
    } break;
    case OP_CONV: { const int r = (int)(idx / CONVD), c = (int)(idx % CONVD); const int seg0 = r < CTX ? 0 : CTX, n = r < CTX ? CTX : SEQ, t = r - seg0; float y = p.conv_b[l * CONVD + c];
#pragma unroll
        for (int j = 0; j < 4; ++j) { const int tt = t - 2 + j; if (tt >= 0 && tt < n) y += p.conv_w[((size_t)l * 4 + j) * CONVD + c] * p.proj[(size_t)(seg0 + tt) * INC + C_XBC + c]; }
        p.xbc[idx] = siluf(y); } break;
    case OP_DT: { const int r = (int)(idx / 12), j = (int)(idx % 12); p.dt[idx] = softplusf(p.proj[(size_t)r * INC + C_DT + j] + p.dt_bias[l * 12 + j]); } break;
    case OP_SSDSCAN: {
        const int pp = (int)(idx % SP), hh = UNIFORM((int)((idx / SP) % SH)), dir = UNIFORM((int)(idx / (SP * SH))); const int g = hh / (SH / SG);
        const float a = -expf(p.a_log[l * 12 + dir * 6 + hh]); float st[SN];
#pragma unroll
        for (int n = 0; n < SN; ++n) st[n] = 0.f;
        for (int step = 0; step < M; ++step) {
            const int r = dir == 0 ? step : (step < CTX ? CTX - 1 - step : M - 1 - (step - CTX));
            const float dtv = p.dt[(size_t)r * 12 + dir * 6 + hh]; const float dA = expf(dtv * a); const float xv = p.xbc[(size_t)r * CONVD + hh * SP + pp] * dtv;
            const float* Bp = p.xbc + (size_t)r * CONVD + SW + g * SN; const float* Cp = p.xbc + (size_t)r * CONVD + SW + SG * SN + g * SN; float y = 0.f;
#pragma unroll
            for (int n = 0; n < SN; ++n) { st[n] = st[n] * dA + xv * Bp[n]; y += st[n] * Cp[n]; }
            p.ydir[((size_t)dir * M + r) * SW + hh * SP + pp] = y;
        }
    } break;
    case OP_SSDFIN: { const long r = idx; float ss = 0.f;
        for (int c = 0; c < SW; ++c) { const float y = p.ydir[r * SW + c] + p.ydir[((size_t)M + r) * SW + c] + p.ssd_d[l * SH + c / SP] * p.xbc[r * CONVD + c]; const float gv = y * siluf(p.proj[r * INC + C_Z + c]); ss += gv * gv; }
        const float rs = 1.0f / sqrtf(ss / SW + EPS);
        for (int c = 0; c < SW; ++c) { const float y = p.ydir[r * SW + c] + p.ydir[((size_t)M + r) * SW + c] + p.ssd_d[l * SH + c / SP] * p.xbc[r * CONVD + c]; const float gv = y * siluf(p.proj[r * INC + C_Z + c]);
            p.mixin[r * MIXW + NH * VD + c] = gv * rs * p.ssd_norm_g[l * SW + c]; }
    } break;
    case OP_POOLP: { const int r = (int)(idx / PW), c = (int)(idx % PW); const int gi = c / 64; const int win = 2 << gi; const int seg0 = r < CTX ? 0 : CTX, n = r < CTX ? CTX : SEQ, t = r - seg0;
        int lo = t - win / 2, hi = t - win / 2 + win; lo = lo < 0 ? 0 : lo; hi = hi > n ? n : hi; float s = 0.f;
        for (int tt = lo; tt < hi; ++tt) s += p.proj[(size_t)(seg0 + tt) * INC + C_POOL + c];
        p.poolp[idx] = s / (float)(hi - lo) - p.proj[(size_t)r * INC + C_POOL + c]; } break;
    case OP_POOLMM: { const int r = (int)(idx / PW), c = (int)(idx % PW); const int gi = c / 64, d = c % 64; float s = 0.f;
        for (int cc = 0; cc < 64; ++cc) s += p.poolp[(size_t)r * PW + gi * 64 + cc] * p.pool_w[(((size_t)l * 4 + gi) * 64 + cc) * 64 + d];
        p.mixin[(size_t)r * MIXW + NH * VD + SW + c] = s * p.pool_scale[l * PW + c]; } break;
    case OP_OUTPROJ: gemm8(p.mixin, MIXW, p.w_out + (size_t)l * MIXW * D, D, nullptr, p.mix, D, D, MIXW, idx); break;
    case OP_RES1: { const int r = (int)(idx / D), c = (int)(idx % D); p.xres[idx] += modv(p, l, r, 2)[c] * p.mix[idx]; } break;
    case OP_LOGITS: { const int r = (int)(idx / NE), e = (int)(idx % NE); const float* hr = p.h + (size_t)r * D; float s = 0.f;
        for (int k = 0; k < D; ++k) s += hr[k] * p.router_w[((size_t)l * D + k) * NE + e];
        p.logits[idx] = s + p.router_b[l * NE + e]; } break;
    case OP_ZEROCNT: p.cnt[idx] = 0; break;
    case OP_TOPK: { const long t = idx; float lg[NE];
#pragma unroll
        for (int e = 0; e < NE; ++e) lg[e] = p.logits[t * NE + e];
        int sel[4]; float sv[4];
#pragma unroll
        for (int kk = 0; kk < 4; ++kk) { float best = -3.0e38f; int bi = 0;
#pragma unroll
            for (int e = 0; e < NE; ++e) { bool taken = false;
#pragma unroll
                for (int q = 0; q < kk; ++q) taken = taken || (sel[q] == e);
                if (!taken && lg[e] > best) { best = lg[e]; bi = e; } }
            sel[kk] = bi; sv[kk] = best; }
        float es[4], sum = 0.f;
#pragma unroll
        for (int kk = 0; kk < 4; ++kk) { es[kk] = expf(sv[kk] - sv[0]); sum += es[kk]; }
#pragma unroll
        for (int kk = 0; kk < 4; ++kk) { p.topi[t * 4 + kk] = sel[kk]; p.topw[t * 4 + kk] = es[kk] / sum; const int pos = ATOMIC_INC(&p.cnt[sel[kk]]); p.list[(size_t)sel[kk] * M + pos] = (int)(t * 4 + kk); }
    } break;
    case OP_GATEUP: {
        const int j = (int)(idx % FF); const long rest = idx / FF; const int rb = (int)(rest % (M / 8)), e = (int)(rest / (M / 8)); const int cnt = p.cnt[e]; if (rb * 8 >= cnt) break;
        int a[8]; float g[8], u[8];
#pragma unroll
        for (int i = 0; i < 8; ++i) { a[i] = rb * 8 + i < cnt ? p.list[(size_t)e * M + rb * 8 + i] : -1; g[i] = 0.f; u[i] = 0.f; }
        const float* wgp = p.wg + ((size_t)l * NE + e) * D * FF + j; const float* wup = p.wu + ((size_t)l * NE + e) * D * FF + j;
        for (int k = 0; k < D; ++k) { const float gw = wgp[(size_t)k * FF], uw = wup[(size_t)k * FF];
#pragma unroll
            for (int i = 0; i < 8; ++i) { const float xv = p.h[(size_t)(a[i] < 0 ? 0 : a[i] / 4) * D + k]; g[i] += xv * gw; u[i] += xv * uw; } }
        const float bgv = p.bg[((size_t)l * NE + e) * FF + j], buv = p.bu[((size_t)l * NE + e) * FF + j];
#pragma unroll
        for (int i = 0; i < 8; ++i) if (a[i] >= 0) { float gv = g[i] + bgv; gv = gv < 7.0f ? gv : 7.0f; float uv = u[i] + buv; uv = uv < -7.0f ? -7.0f : (uv > 7.0f ? 7.0f : uv);
            p.act[(size_t)a[i] * FF + j] = gv * sigmf(1.702f * gv) * (uv + 1.0f); }
    } break;
    case OP_DOWN: {
        const int j = (int)(idx % D); const long rest = idx / D; const int rb = (int)(rest % (M / 8)), e = (int)(rest / (M / 8)); const int cnt = p.cnt[e]; if (rb * 8 >= cnt) break;
        int a[8]; float o[8];
#pragma unroll
        for (int i = 0; i < 8; ++i) { a[i] = rb * 8 + i < cnt ? p.list[(size_t)e * M + rb * 8 + i] : -1; o[i] = 0.f; }
        const float* wdp = p.wd + ((size_t)l * NE + e) * FF * D + j;
        for (int k = 0; k < FF; ++k) { const float w = wdp[(size_t)k * D];
#pragma unroll
            for (int i = 0; i < 8; ++i) o[i] += p.act[(size_t)(a[i] < 0 ? 0 : a[i]) * FF + k] * w; }
        const float bv = p.bd[((size_t)l * NE + e) * D + j];
#pragma unroll
        for (int i = 0; i < 8; ++i) if (a[i] >= 0) p.down[(size_t)a[i] * D + j] = o[i] + bv;
    } break;
    case OP_COMBINE: { const int r = (int)(idx / D), c = (int)(idx % D); float s = 0.f;
#pragma unroll
        for (int kk = 0; kk < 4; ++kk) s += p.topw[(size_t)r * 4 + kk] * p.down[((size_t)r * 4 + kk) * D + c];
        p.xres[idx] += modv(p, l, r, 5)[c] * s; } break;
    case OP_WRITE_OUT: p.out[idx] = p.xres[(size_t)CTX * D + idx]; break;
    case OP_MIXB: p.mixb[idx] = f2bf(p.mixin[idx]); break;
    case OP_SSD_CS: {
        const int hh = (int)(idx % SH), c = (int)((idx / SH) % NCH), dir = (int)(idx / (SH * NCH)); const float a = -expf(p.a_log[l * 12 + dir * 6 + hh]); float acc = 0.f;
        for (int i = 0; i < CHUNK; ++i) { const int r = c * CHUNK + (dir == 0 ? i : CHUNK - 1 - i); acc += p.dt[(size_t)r * 12 + dir * 6 + hh] * a; p.cs[((size_t)dir * M + r) * SH + hh] = acc; }
        p.cdec[idx] = expf(acc);
    } break;
    case OP_SSD_G: {
        const int s = (int)(idx % CHUNK), g = (int)((idx / CHUNK) % SG), r = (int)(idx / (CHUNK * SG)); const int r2 = (r / CHUNK) * CHUNK + s;
        const float* Cp = p.xbc + (size_t)r * CONVD + SW + SG * SN + g * SN; const float* Bp = p.xbc + (size_t)r2 * CONVD + SW + g * SN; float acc = 0.f;
        for (int n = 0; n < SN; ++n) acc += Cp[n] * Bp[n];
        p.gmat[idx] = acc;
    } break;
    case OP_SSD_YD: {
        const int cc = (int)(idx % SW), r = (int)(idx / SW); const int hh = cc / SP, g = hh / (SH / SG); const int c0 = (r / CHUNK) * CHUNK, lpos = r - c0;
        const float* G = p.gmat + ((size_t)r * SG + g) * CHUNK; const float csf = p.cs[(size_t)r * SH + hh], csb = p.cs[((size_t)M + r) * SH + hh]; float y = 0.f;
        for (int s = 0; s <= lpos; ++s) { const int r2 = c0 + s; y += G[s] * expf(csf - p.cs[(size_t)r2 * SH + hh]) * p.dt[(size_t)r2 * 12 + hh] * p.xbc[(size_t)r2 * CONVD + cc]; }
        for (int s = lpos; s < CHUNK; ++s) { const int r2 = c0 + s; y += G[s] * expf(csb - p.cs[((size_t)M + r2) * SH + hh]) * p.dt[(size_t)r2 * 12 + 6 + hh] * p.xbc[(size_t)r2 * CONVD + cc]; }
        p.ydir[idx] = y;
    } break;
    case OP_SSD_ST: {
        const int n = (int)(idx % SN), pp = (int)((idx / SN) % SP), hh = (int)((idx / (SN * SP)) % SH), c = (int)((idx / (SN * SP * SH)) % NCH), dir = (int)(idx / ((long)SN * SP * SH * NCH)); const int g = hh / (SH / SG);
        const int rend = c * CHUNK + (dir == 0 ? CHUNK - 1 : 0); const float cse = p.cs[((size_t)dir * M + rend) * SH + hh]; float acc = 0.f;
        for (int i = 0; i < CHUNK; ++i) { const int r = c * CHUNK + i; acc += p.xbc[(size_t)r * CONVD + SW + g * SN + n] * expf(cse - p.cs[((size_t)dir * M + r) * SH + hh]) * p.dt[(size_t)r * 12 + dir * 6 + hh] * p.xbc[(size_t)r * CONVD + hh * SP + pp]; }
        p.st[idx] = acc;
    } break;
    case OP_SSD_CARRY: {
        const int e = (int)(idx % (SP * SN)), hh = (int)((idx / (SP * SN)) % SH), dir = (int)(idx / ((long)SP * SN * SH)); float state = 0.f;
        for (int i = 0; i < NCH; ++i) { const int c = dir == 0 ? i : (i < CTX / CHUNK ? CTX / CHUNK - 1 - i : NCH - 1 - (i - CTX / CHUNK));
            const size_t o = (((size_t)dir * NCH + c) * SH + hh) * (SP * SN) + e; const float stc = p.st[o]; p.st[o] = state; state = state * p.cdec[((size_t)dir * NCH + c) * SH + hh] + stc; }
    } break;
    case OP_SSD_YOFF: {
        const int cc = (int)(idx % SW), r = (int)(idx / SW); const int hh = cc / SP, pp = cc % SP, g = hh / (SH / SG), c = r / CHUNK; const float* Cp = p.xbc + (size_t)r * CONVD + SW + SG * SN + g * SN;
        float y = 0.f;
#pragma unroll
        for (int dir = 0; dir < 2; ++dir) { const float* pv = p.st + ((((size_t)dir * NCH + c) * SH + hh) * SP + pp) * SN; float acc = 0.f;
            for (int n = 0; n < SN; ++n) acc += Cp[n] * pv[n];
            y += acc * expf(p.cs[((size_t)dir * M + r) * SH + hh]); }
        p.ydir[(size_t)M * SW + idx] = y;
    } break;
    case OP_COMBINE2: { const int r = (int)(idx / D), c = (int)(idx % D); float s = 0.f;
#pragma unroll
        for (int kk = 0; kk < 4; ++kk) s += p.topw[(size_t)r * 4 + kk] * bf2f(p.ybn[((size_t)r * 4 + kk) * D + c]);
        p.xres[idx] += modv(p, l, r, 5)[c] * s; } break;
    }
}

static const int LAYER_OPS[] = { OP_ROWSTAT, OP_NORM1, OP_INPROJ, OP_LATNORM, OP_QRAW, OP_KVRAW, OP_QHEAD, OP_KHEAD, OP_ATTN, OP_CONV, OP_DT, OP_SSDSCAN, OP_SSDFIN, OP_POOLP, OP_POOLMM,
                                 OP_OUTPROJ, OP_RES1, OP_ROWSTAT, OP_NORM2, OP_LOGITS, OP_ZEROCNT, OP_TOPK, OP_GATEUP, OP_DOWN, OP_COMBINE };
constexpr int N_LAYER_OPS = sizeof(LAYER_OPS) / sizeof(int);
#endif

#define XB_TMO      128
#define XB_XCNT(j)  (256  + 64 * (j))
#define XB_XSUB(j)  (1280 + 64 * (j))
#define XB_XGEN(j)  (2304 + 64 * (j))
#define XB_TOP      3328
#define XB_TOPGEN   3392
#define XCD_BAR_WORDS 3456
#define XB_SPIN_CAP (1u << 22)
#define LAS __attribute__((address_space(3)))

__device__ __forceinline__ unsigned xb_ld(unsigned* p)              { return __hip_atomic_load(p, __ATOMIC_RELAXED, __HIP_MEMORY_SCOPE_AGENT); }
__device__ __forceinline__ unsigned xb_add(unsigned* p, unsigned v) { return __hip_atomic_fetch_add(p, v, __ATOMIC_RELAXED, __HIP_MEMORY_SCOPE_AGENT); }
__device__ __forceinline__ unsigned xb_xcc_id() { return (unsigned)__builtin_amdgcn_s_getreg((3 << 11) | 20) & 0xFu; }
#define XB_SPIN(cond, bar) do { unsigned _sp = 0; while (cond) { __builtin_amdgcn_s_sleep(1); \
    if ((++_sp & 255u) == 0u) { if (xb_ld(&(bar)[XB_TMO])) break; if (_sp > XB_SPIN_CAP) { atomicAdd(&(bar)[XB_TMO], 1u); break; } } } } while (0)

struct XcdBarrier {
    unsigned* bar; unsigned x;
    volatile LAS unsigned* st;
};

__device__ __forceinline__ XcdBarrier xcd_barrier_post(unsigned* bar, volatile LAS unsigned* st) {
    XcdBarrier b; b.bar = bar; b.x = xb_xcc_id(); b.st = st;
    if (threadIdx.x == 0) (void)xb_add(&bar[XB_XCNT(b.x)], 1u);
    return b;
}
__device__ __forceinline__ void xcd_barrier_complete(unsigned* bar, unsigned x, unsigned& nloc, unsigned& nx) {
    const unsigned G = gridDim.x * gridDim.y * gridDim.z;
    unsigned sum, cnt, mine, sp = 0u;
    for (;;) {
        sum = 0u; cnt = 0u; mine = 0u;
#pragma unroll
        for (unsigned j = 0; j < 16; ++j) { const unsigned c = xb_ld(&bar[XB_XCNT(j)]); sum += c; cnt += (c > 0u) ? 1u : 0u; mine = (j == x) ? c : mine; }
        if (sum == G) break;
        __builtin_amdgcn_s_sleep(1);
        if ((++sp & 255u) == 0u) { if (xb_ld(&bar[XB_TMO])) break; if (sp > XB_SPIN_CAP) { atomicAdd(&bar[XB_TMO], 1u); break; } }
    }
    nloc = mine > 0u ? mine : 1u; nx = cnt > 0u ? cnt : 1u;
}

__device__ __forceinline__ void xcd_barrier(const XcdBarrier& b) {
    asm volatile("s_waitcnt vmcnt(0)" ::: "memory");
    __syncthreads();
    if (threadIdx.x == 0) {
        unsigned* bar = b.bar;
        __builtin_amdgcn_s_waitcnt(0);
        unsigned nloc = b.st[0], nx = b.st[1];
        if (nloc == 0u) { unsigned xx = b.x; asm volatile("" : "+s"(xx));   xcd_barrier_complete(bar, xx, nloc, nx); b.st[0] = nloc; b.st[1] = nx; }
        const unsigned old = xb_add(&bar[XB_XSUB(b.x)], 1u);
        const unsigned gen = old / nloc;
        if (old + 1u == (gen + 1u) * nloc) {
            __builtin_amdgcn_fence(__ATOMIC_RELEASE, "agent");
            asm volatile("s_waitcnt vmcnt(0)" ::: "memory");
            const unsigned og = xb_add(&bar[XB_TOP], 1u);
            const unsigned tg = og / nx;
            if (og + 1u == (tg + 1u) * nx) xb_add(&bar[XB_TOPGEN], 1u);
            else XB_SPIN(xb_ld(&bar[XB_TOPGEN]) == tg, bar);
            __builtin_amdgcn_fence(__ATOMIC_ACQUIRE, "agent");
            xb_add(&bar[XB_XGEN(b.x)], 1u);
            asm volatile("s_waitcnt vmcnt(0)" ::: "memory");
        } else {
            XB_SPIN(xb_ld(&bar[XB_XGEN(b.x)]) == gen, bar);
            __builtin_amdgcn_fence(__ATOMIC_ACQUIRE, "agent");
            asm volatile("s_waitcnt vmcnt(0)" ::: "memory");
        }
    }
    __syncthreads();
}


namespace at {
typedef unsigned short bf16_t;
using bf16x8 = __attribute__((ext_vector_type(8))) short;
using s16x4  = __attribute__((ext_vector_type(4))) short;
using f32x16 = __attribute__((ext_vector_type(16))) float;
using u32x4  = __attribute__((ext_vector_type(4))) unsigned;
constexpr int DQ = 96, DV = 64, NW = 8, QBLK = 32, KVBLK = 64;
constexpr int LDQ = 6 * DQ, LDK = 6 * DQ, LDV = 6 * DV;
constexpr float SCALE = 0.10206207261596575f;
constexpr float THR = 8.f;
constexpr int KROW = 208;
constexpr int SHM_K = KVBLK * KROW, SHM_V = KVBLK * DV * 2;
constexpr int SHM_ATTN = 2 * SHM_V + 2 * SHM_K + NW * 64 * 4;
#define AT_SBAR() __builtin_amdgcn_sched_barrier(0)
__device__ __forceinline__ int crow(int r, int hi) { return (r & 3) + 8 * (r >> 2) + 4 * hi; }
__device__ __forceinline__ unsigned cvtpk(float lo, float hi) { unsigned r; asm volatile("v_cvt_pk_bf16_f32 %0, %1, %2" : "=v"(r) : "v"(lo), "v"(hi)); return r; }

__device__ __forceinline__ void partialSM(f32x16& p0, f32x16& p1, float& m_reg, float& mn, float& alpha) {
  constexpr float C = SCALE * 1.4426950408889634f;
  float pmax = p0[0];
#pragma unroll
  for (int r = 1; r < 16; ++r) pmax = fmaxf(pmax, p0[r]);
#pragma unroll
  for (int r = 0; r < 16; ++r) pmax = fmaxf(pmax, p1[r]);
  { auto rr = __builtin_amdgcn_permlane32_swap(__float_as_uint(pmax), __float_as_uint(pmax), false, false);
    pmax = fmaxf(__uint_as_float(rr[0]), __uint_as_float(rr[1])); }
  if (__builtin_expect(__all(pmax - m_reg <= THR / SCALE), 1)) { mn = m_reg; alpha = 1.f; }
  else { mn = fmaxf(m_reg, pmax); alpha = __builtin_amdgcn_exp2f((m_reg - mn) * C); m_reg = mn; }
  float mnC = -mn * C;
#pragma unroll
  for (int r = 0; r < 16; ++r) p0[r] = fmaf(p0[r], C, mnC);
#pragma unroll
  for (int r = 0; r < 16; ++r) p1[r] = fmaf(p1[r], C, mnC);
#pragma unroll
  for (int r = 0; r < 16; ++r) p0[r] = __builtin_amdgcn_exp2f(p0[r]);
}
__device__ __forceinline__ void finishSM(f32x16& p0, f32x16& p1, float alpha, float& l_reg, bf16x8& pa0, bf16x8& pa1, bf16x8& pa2, bf16x8& pa3) {
#pragma unroll
  for (int r = 0; r < 16; ++r) p1[r] = __builtin_amdgcn_exp2f(p1[r]);
  float ps = 0;
#pragma unroll
  for (int r = 0; r < 16; ++r) ps += p0[r];
#pragma unroll
  for (int r = 0; r < 16; ++r) ps += p1[r];
  { auto rr = __builtin_amdgcn_permlane32_swap(__float_as_uint(ps), __float_as_uint(ps), false, false);
    ps = __uint_as_float(rr[0]) + __uint_as_float(rr[1]); }
  l_reg = l_reg * alpha + ps;
#define AT_PK4(P, BASE, OUT) do { unsigned a0 = cvtpk(P[BASE + 0], P[BASE + 1]), a1 = cvtpk(P[BASE + 2], P[BASE + 3]);   \
    unsigned b0 = cvtpk(P[BASE + 4], P[BASE + 5]), b1 = cvtpk(P[BASE + 6], P[BASE + 7]);                              \
    auto r0 = __builtin_amdgcn_permlane32_swap(a0, b0, false, false); auto r1 = __builtin_amdgcn_permlane32_swap(a1, b1, false, false); \
    u32x4 w = {r0[0], r1[0], r0[1], r1[1]}; OUT = *reinterpret_cast<bf16x8*>(&w); } while (0)
  AT_PK4(p0, 0, pa0); AT_PK4(p0, 8, pa1); AT_PK4(p1, 0, pa2); AT_PK4(p1, 8, pa3);
#undef AT_PK4
}
__device__ __forceinline__ void qkt(f32x16& p0, f32x16& p1, const char* Ks, const bf16x8* qr, int r32, int hi) {
  p0 = f32x16{}; p1 = f32x16{};
#pragma unroll
  for (int d0 = 0; d0 < 6; ++d0) { const int cb = (d0 * 16 + hi * 8) * 2;
    bf16x8 b0 = *reinterpret_cast<const bf16x8*>(Ks + r32 * KROW + cb);
    bf16x8 b1 = *reinterpret_cast<const bf16x8*>(Ks + (32 + r32) * KROW + cb);
    p0 = __builtin_amdgcn_mfma_f32_32x32x16_bf16(b0, qr[d0], p0, 0, 0, 0);
    p1 = __builtin_amdgcn_mfma_f32_32x32x16_bf16(b1, qr[d0], p1, 0, 0, 0); }
}
__device__ __forceinline__ int v_st(int k, int c) { const int kk = (k & ~0xC) | ((k & 4) << 1) | ((k & 8) >> 1); return ((kk >> 3) * 2 + (c >> 5)) * 512 + ((kk & 7) * 32 + (c & 31)) * 2; }
__device__ __forceinline__ int v_rd_base(int lane) { return ((lane & 3) << 3) | (((lane >> 2) & 3) << 6) | (((lane >> 4) & 1) << 5) | (((lane >> 5) & 1) << 8); }
constexpr int v_rd_off(int d0, int ks, int half) { return d0 * 512 + ks * 2048 + half * 1024; }
template <int OFF> __device__ __forceinline__ s16x4 tr_read(int vb) {
  s16x4 r; asm volatile("ds_read_b64_tr_b16 %0, %1 offset:%2" : "=&v"(r) : "v"(vb), "i"(OFF) : "memory"); return r;
}
template <int D0> __device__ __forceinline__ void pv_one(f32x16& od, int vb, bf16x8 pa0, bf16x8 pa1, bf16x8 pa2, bf16x8 pa3) {
  const s16x4 l0 = tr_read<v_rd_off(D0, 0, 0)>(vb), h0 = tr_read<v_rd_off(D0, 0, 1)>(vb), l1 = tr_read<v_rd_off(D0, 1, 0)>(vb), h1 = tr_read<v_rd_off(D0, 1, 1)>(vb);
  const s16x4 l2 = tr_read<v_rd_off(D0, 2, 0)>(vb), h2 = tr_read<v_rd_off(D0, 2, 1)>(vb), l3 = tr_read<v_rd_off(D0, 3, 0)>(vb), h3 = tr_read<v_rd_off(D0, 3, 1)>(vb);
  asm volatile("s_waitcnt lgkmcnt(0)" ::: "memory"); AT_SBAR();
#define AT_PK(L, H) (bf16x8){L[0], L[1], L[2], L[3], H[0], H[1], H[2], H[3]}
  od = __builtin_amdgcn_mfma_f32_32x32x16_bf16(pa0, AT_PK(l0, h0), od, 0, 0, 0);
  od = __builtin_amdgcn_mfma_f32_32x32x16_bf16(pa1, AT_PK(l1, h1), od, 0, 0, 0);
  od = __builtin_amdgcn_mfma_f32_32x32x16_bf16(pa2, AT_PK(l2, h2), od, 0, 0, 0);
  od = __builtin_amdgcn_mfma_f32_32x32x16_bf16(pa3, AT_PK(l3, h3), od, 0, 0, 0);
#undef AT_PK
}
__device__ __forceinline__ void pv_d0(f32x16* o, int vb, bf16x8 pa0, bf16x8 pa1, bf16x8 pa2, bf16x8 pa3) {
  pv_one<0>(o[0], vb, pa0, pa1, pa2, pa3); pv_one<1>(o[1], vb, pa0, pa1, pa2, pa3);
}
__device__ __forceinline__ void attn_body(const bf16_t* __restrict__ Qb, const bf16_t* __restrict__ Kh, const bf16_t* __restrict__ Vh, float* __restrict__ Ob, int ldo, int seq, char* lds) {
  int tid = threadIdx.x; asm volatile("" : "+v"(tid));
  const int wid = tid >> 6, lane = tid & 63, r32 = lane & 31, hi = lane >> 5;
  char* V_lds = lds; char* K_lds = lds + 2 * SHM_V;
  float* ws = (float*)(lds + 2 * SHM_V + 2 * SHM_K) + wid * 64; float* li_l = ws; float* al_l = ws + 32;
  float m_reg = -1e30f, l_reg = 0; f32x16 o[2] = {}; bf16x8 qr[6];
  const bf16_t* Qw = Qb + (long)(wid * QBLK + r32) * LDQ + hi * 8;
#pragma unroll
  for (int d0 = 0; d0 < 6; ++d0) qr[d0] = *reinterpret_cast<const bf16x8*>(Qw + d0 * 16);
  const int kr0 = tid / 12, kc0 = tid % 12, c1 = 512 + (tid & 255), kr1 = c1 / 12, kc1 = c1 % 12, vr = tid >> 3, vc = (tid & 7) * 8;
  const bool k1on = tid < 256;
  const int kst0 = kr0 * KROW + kc0 * 16, kst1 = kr1 * KROW + kc1 * 16, vst = v_st(vr, vc);
  const long kg0 = (long)kr0 * LDK + kc0 * 8, kg1 = (long)kr1 * LDK + kc1 * 8, vg = (long)vr * LDV + vc;
  const int vb0 = (int)(uintptr_t)V_lds + v_rd_base(lane);
  struct { bf16x8 vs, ks0, ks1; } sr_[2];
#define AT_SLOAD(i, k0) do { sr_[i].vs = *reinterpret_cast<const bf16x8*>(Vh + (long)(k0) * LDV + vg); \
    sr_[i].ks0 = *reinterpret_cast<const bf16x8*>(Kh + (long)(k0) * LDK + kg0); sr_[i].ks1 = *reinterpret_cast<const bf16x8*>(Kh + (long)(k0) * LDK + kg1); } while (0)
#define AT_SWRITE(b, i) do { *(bf16x8*)(V_lds + (b) * SHM_V + vst) = sr_[i].vs; *(bf16x8*)(K_lds + (b) * SHM_K + kst0) = sr_[i].ks0; \
    if (k1on) *(bf16x8*)(K_lds + (b) * SHM_K + kst1) = sr_[i].ks1; } while (0)
#define AT_SWAIT() asm volatile("s_waitcnt vmcnt(3)" ::: "memory")
#define AT_RESC(a) do { if (__any((a) < 1.f)) { if (hi == 0) al_l[r32] = (a); asm volatile("s_waitcnt lgkmcnt(0)" ::: "memory"); \
    _Pragma("unroll") for (int d = 0; d < 2; ++d) _Pragma("unroll") for (int r = 0; r < 16; ++r) o[d][r] *= al_l[crow(r, hi)]; } } while (0)
  f32x16 pA0, pA1, pB0, pB1; float mnA, mnB, alA, alB; bf16x8 pa0, pa1, pa2, pa3; const int NT = seq / KVBLK;
  constexpr int SE = 0, SO = 1;
  AT_SLOAD(SE, 0); asm volatile("s_waitcnt vmcnt(0)" ::: "memory"); AT_SWRITE(0, SE); __syncthreads();
  qkt(pA0, pA1, K_lds, qr, r32, hi); partialSM(pA0, pA1, m_reg, mnA, alA);
  AT_SLOAD(SO, KVBLK); if (2 < NT) AT_SLOAD(SE, 2 * KVBLK);
  AT_SWAIT(); AT_SWRITE(1, SO); __syncthreads();
  for (int j = 1; j + 1 < NT; j += 2) {
    AT_SBAR(); qkt(pB0, pB1, K_lds + SHM_K, qr, r32, hi);
    finishSM(pA0, pA1, alA, l_reg, pa0, pa1, pa2, pa3); AT_SBAR();
    AT_SLOAD(SO, (j + 2) * KVBLK); AT_SBAR();
    pv_d0(o, vb0, pa0, pa1, pa2, pa3); partialSM(pB0, pB1, m_reg, mnB, alB);
    __syncthreads(); AT_SWAIT(); AT_SWRITE(0, SE);
    AT_RESC(alB); __syncthreads();
    AT_SBAR(); qkt(pA0, pA1, K_lds, qr, r32, hi);
    finishSM(pB0, pB1, alB, l_reg, pa0, pa1, pa2, pa3); AT_SBAR();
    if (j + 3 < NT) AT_SLOAD(SE, (j + 3) * KVBLK); AT_SBAR();
    pv_d0(o, vb0 + SHM_V, pa0, pa1, pa2, pa3); partialSM(pA0, pA1, m_reg, mnA, alA);
    __syncthreads(); AT_SWAIT(); AT_SWRITE(1, SO);
    AT_RESC(alA); __syncthreads();
  }
  AT_SBAR(); qkt(pB0, pB1, K_lds + SHM_K, qr, r32, hi);
  finishSM(pA0, pA1, alA, l_reg, pa0, pa1, pa2, pa3); AT_SBAR();
  pv_d0(o, vb0, pa0, pa1, pa2, pa3); partialSM(pB0, pB1, m_reg, mnB, alB);
  __syncthreads(); AT_RESC(alB);
  finishSM(pB0, pB1, alB, l_reg, pa0, pa1, pa2, pa3); AT_SBAR();
  pv_d0(o, vb0 + SHM_V, pa0, pa1, pa2, pa3);
  if (hi == 0) li_l[r32] = l_reg; asm volatile("s_waitcnt lgkmcnt(0)" ::: "memory");
  float rli[16];
#pragma unroll
  for (int r = 0; r < 16; ++r) rli[r] = __builtin_amdgcn_rcpf(li_l[crow(r, hi)]);
  float* Ow = Ob + (long)(wid * QBLK) * ldo;
#pragma unroll
  for (int r = 0; r < 16; ++r) { const int orow = crow(r, hi);
#pragma unroll
    for (int d0 = 0; d0 < 2; ++d0) Ow[(long)orow * ldo + d0 * 32 + r32] = o[d0][r] * rli[r]; }
#undef AT_SLOAD
#undef AT_SWRITE
#undef AT_SWAIT
#undef AT_RESC
}
}

namespace gm {
#define GM_LAS __attribute__((address_space(3)))
typedef unsigned short bf16_t;
typedef short bf16x8 __attribute__((ext_vector_type(8)));
typedef float f32x4 __attribute__((ext_vector_type(4)));
typedef unsigned u32x4 __attribute__((ext_vector_type(4)));
constexpr int BM = 256, BK = 64, HALF = 128, HTB = HALF * BK * 2, STAGE_BYTES = 8 * HTB;
__host__ __device__ __forceinline__ int lds_byte(int r, int c) { const int st = (r >> 4) * 2 + (c >> 5), rr = r & 15, cc = c & 31, ob = rr * 64 + cc * 2; return st * 1024 + (ob ^ (((ob >> 9) & 1) << 5)); }
__host__ __device__ __forceinline__ void stage_rc(int b, int& R, int& C) { const int st = b / 1024, sb = b % 1024, swz = sb ^ (((sb >> 9) & 1) << 5); R = (st >> 1) * 16 + swz / 64; C = (st & 1) * 32 + (swz % 64) / 2; }
__host__ __device__ __forceinline__ int perm32(int rho) { const int n = rho >> 4, i = rho & 15; return 8 * (i >> 2) + 4 * n + (i & 3); }
__device__ __forceinline__ unsigned cvt_pk_bf16(float lo, float hi) { unsigned r; asm volatile("v_cvt_pk_bf16_f32 %0, %1, %2" : "=v"(r) : "v"(lo), "v"(hi)); return r; }

template <bool PERM, class Epi>
__device__ __forceinline__ void gemm_unit(GM_LAS unsigned char* lds, const char* A, const unsigned (&offA)[2][2], const char* Bt, int K, const Epi& E) {
    int tid = threadIdx.x; asm volatile("" : "+v"(tid));
    const int wid = __builtin_amdgcn_readfirstlane(tid >> 6), lane = tid & 63, wr = wid >> 2, wc = wid & 3, fr = lane & 15, fq = lane >> 4;
    const int nt = K / BK;
    unsigned voffB[2];
#pragma unroll
    for (int i = 0; i < 2; ++i) { int R, C; stage_rc(tid * 16 + i * 8192, R, C); const int Rb = PERM ? ((R & ~31) + perm32(R & 31)) : R; voffB[i] = (unsigned)(Rb * K + C) * 2u; }
    const size_t kstep = (size_t)(BK * 2);
    const size_t hstep = (size_t)HALF * K * 2;
    const unsigned ldsw = (unsigned)wid * 1024u;
    const int aoff = lds_byte(wr * 64 + fr, fq * 8), boff = lds_byte(wc * 32 + fr, fq * 8);
#define GM_SA(b, h) (((b) * 2 + (h)) * HTB)
#define GM_SB(b, h) ((4 + (b) * 2 + (h)) * HTB)
#define GM_STAGEB(bufoff, gbase) do { _Pragma("unroll") for (int _i = 0; _i < 2; ++_i) \
        __builtin_amdgcn_global_load_lds((const unsigned*)((const char*)(gbase) + voffB[_i]), (GM_LAS unsigned*)(lds + (bufoff) + ldsw + _i * 8192), 16, 0, 0); } while (0)
#define GM_STAGEA(bufoff, h, kbyte) do { _Pragma("unroll") for (int _i = 0; _i < 2; ++_i) \
        __builtin_amdgcn_global_load_lds((const unsigned*)(A + (size_t)offA[h][_i] + (kbyte)), (GM_LAS unsigned*)(lds + (bufoff) + ldsw + _i * 8192), 16, 0, 0); } while (0)
#define GM_LDA(dst, b, h) do { _Pragma("unroll") for (int m = 0; m < 4; ++m) _Pragma("unroll") for (int k = 0; k < 2; ++k) dst[m][k] = *(const GM_LAS bf16x8*)(lds + GM_SA(b, h) + aoff + m * 2048 + k * 1024); } while (0)
#define GM_LDB(dst, b, h) do { _Pragma("unroll") for (int n = 0; n < 2; ++n) _Pragma("unroll") for (int k = 0; k < 2; ++k) dst[n][k] = *(const GM_LAS bf16x8*)(lds + GM_SB(b, h) + boff + n * 2048 + k * 1024); } while (0)
#define GM_MMA(ai, bj, At, Bt_) do { __builtin_amdgcn_s_setprio(1); _Pragma("unroll") for (int m = 0; m < 4; ++m) _Pragma("unroll") for (int n = 0; n < 2; ++n) _Pragma("unroll") for (int k = 0; k < 2; ++k) \
        acc[ai][bj][m][n] = __builtin_amdgcn_mfma_f32_16x16x32_bf16(Bt_[n][k], At[m][k], acc[ai][bj][m][n], 0, 0, 0); __builtin_amdgcn_s_setprio(0); } while (0)
#define GM_WAIT_V(n) asm volatile("s_waitcnt vmcnt(" #n ")" ::: "memory")
#define GM_WAIT_L(n) asm volatile("s_waitcnt lgkmcnt(" #n ")" ::: "memory")
#define GM_BAR __builtin_amdgcn_s_barrier()
#define GM_SCHED __builtin_amdgcn_sched_barrier(0)
    f32x4 acc[2][2][4][2];
#pragma unroll
    for (int a = 0; a < 2; ++a)
#pragma unroll
        for (int b = 0; b < 2; ++b)
#pragma unroll
            for (int m = 0; m < 4; ++m)
#pragma unroll
                for (int n = 0; n < 2; ++n) acc[a][b][m][n] = (f32x4){0.f, 0.f, 0.f, 0.f};
    bf16x8 At[4][2], B0[2][2], B1[2][2];
    const char* cB = Bt;
    GM_STAGEB(GM_SB(0, 0), cB); GM_STAGEA(GM_SA(0, 0), 0, 0); GM_STAGEB(GM_SB(0, 1), cB + hstep); GM_STAGEA(GM_SA(0, 1), 1, 0);
    if (wr == 1) GM_BAR;
    GM_WAIT_V(4); GM_BAR;
    GM_STAGEB(GM_SB(1, 0), cB + kstep); GM_STAGEA(GM_SA(1, 0), 0, kstep); GM_STAGEB(GM_SB(1, 1), cB + hstep + kstep);
    GM_WAIT_V(6); GM_BAR;
    for (int t = 0; t < nt; t += 2) {
        const bool last = (t == nt - 2);
        const size_t k1 = (size_t)(t + 1) * kstep;
        const size_t k2 = last ? 0 : (size_t)(t + 2) * kstep;
        const size_t k3 = k2 + kstep;
        const char* b2 = cB + k2; const char* b3 = cB + k3;
        GM_LDB(B0, 0, 0); GM_SCHED; GM_LDA(At, 0, 0); GM_STAGEA(GM_SA(1, 1), 1, k1);
        GM_WAIT_L(8); GM_BAR; GM_WAIT_L(0); GM_MMA(0, 0, At, B0); GM_BAR; GM_SCHED;
        GM_LDB(B1, 0, 1); GM_STAGEB(GM_SB(0, 0), b2);
        GM_BAR; GM_WAIT_L(0); GM_MMA(0, 1, At, B1); GM_BAR;
        GM_LDA(At, 0, 1); GM_STAGEA(GM_SA(0, 0), 0, k2);
        GM_BAR; GM_WAIT_L(0); GM_MMA(1, 0, At, B0); GM_BAR; GM_SCHED;
        GM_STAGEB(GM_SB(0, 1), b2 + hstep);
        GM_WAIT_V(6); GM_BAR; GM_MMA(1, 1, At, B1); GM_BAR;
        GM_LDB(B0, 1, 0); GM_SCHED; GM_LDA(At, 1, 0); GM_STAGEA(GM_SA(0, 1), 1, k2);
        GM_WAIT_L(8); GM_BAR; GM_WAIT_L(0); GM_MMA(0, 0, At, B0); GM_BAR; GM_SCHED;
        GM_LDB(B1, 1, 1); GM_STAGEB(GM_SB(1, 0), b3);
        GM_BAR; GM_WAIT_L(0); GM_MMA(0, 1, At, B1); GM_BAR;
        GM_LDA(At, 1, 1); GM_STAGEA(GM_SA(1, 0), 0, k3);
        GM_BAR; GM_WAIT_L(0); GM_MMA(1, 0, At, B0); GM_BAR; GM_SCHED;
        GM_STAGEB(GM_SB(1, 1), b3 + hstep);
        GM_WAIT_V(6); GM_BAR; GM_MMA(1, 1, At, B1); GM_BAR;
    }
    E(acc, wr, wc, fr, fq);
    GM_WAIT_V(0);
    if (wr == 0) GM_BAR;
    GM_BAR;
#undef GM_SA
#undef GM_SB
#undef GM_STAGEA
#undef GM_STAGEB
#undef GM_LDA
#undef GM_LDB
#undef GM_MMA
#undef GM_WAIT_V
#undef GM_WAIT_L
#undef GM_BAR
#undef GM_SCHED
}
__device__ __forceinline__ void dense_offA(unsigned (&offA)[2][2], long row0, int K) {
    int tid = threadIdx.x; asm volatile("" : "+v"(tid));
#pragma unroll
    for (int i = 0; i < 2; ++i) { int R, C; stage_rc(tid * 16 + i * 8192, R, C);
#pragma unroll
        for (int h = 0; h < 2; ++h) offA[h][i] = (unsigned)(((row0 + h * HALF + R) * K + C) * 2); }
}
}

struct FW {
    bf16_t *w_in_t, *w_out_t, *gu_t, *d_t;
    bf16_t *hb1, *hb2, *mixb, *actb, *yb;
    float *proj2, *mix2;
    bf16_t *w_uq_t, *w_ukv_t;
    float *ropec, *ropes;
    bf16_t *qb2, *kb2, *vb2;
    float *yd2, *st2, *cdec2, *cs2; bf16_t *cg, *prevb, *ssdb2;
};
constexpr int INC_PAD = 1792;
template <int MAP> __device__ __forceinline__ void cvt_tile(const float* src, int ldn, int nvalid, bf16_t* dst, int K, int k0, int n0, float* T) {
    int tid = threadIdx.x; asm volatile("" : "+v"(tid)); const int r = tid >> 4, c4 = (tid & 15) * 4;
#pragma unroll
    for (int i = 0; i < 2; ++i) { const int kk = r + 32 * i; float4 v = make_float4(0.f, 0.f, 0.f, 0.f);
        if (n0 + c4 < nvalid) v = *(const float4*)(src + (size_t)(k0 + kk) * ldn + n0 + c4);
        T[kk * 65 + c4 + 0] = v.x; T[kk * 65 + c4 + 1] = v.y; T[kk * 65 + c4 + 2] = v.z; T[kk * 65 + c4 + 3] = v.w; }
    __syncthreads();
    { const int n = tid >> 3, kc = tid & 7; float f[8];
#pragma unroll
        for (int j = 0; j < 8; ++j) f[j] = T[(kc * 8 + j) * 65 + n];
        gm::u32x4 w; w.x = gm::cvt_pk_bf16(f[0], f[1]); w.y = gm::cvt_pk_bf16(f[2], f[3]); w.z = gm::cvt_pk_bf16(f[4], f[5]); w.w = gm::cvt_pk_bf16(f[6], f[7]);
        const int nn = n0 + n; const int drow = MAP == 0 ? nn : ((nn >> 7) * 256 + (MAP == 2 ? 128 : 0) + (nn & 127));
        *(gm::u32x4*)(dst + (size_t)drow * K + k0 + kc * 8) = w; }
    __syncthreads();
}
__device__ __forceinline__ void cvt_phase(const P& p, const FW& f, int l0, int l1, char* lds) {
    float* T = (float*)lds;
    constexpr int T_IN = 16 * 28, T_OUT = 16 * 16, T_E = 16 * 16, T_UQ = 4 * 9, T_UKV = 2 * 12, T_LAYER = T_IN + T_OUT + T_UQ + T_UKV + NE * 3 * T_E;
    const int total = (l1 - l0) * T_LAYER;
    if (blockIdx.x == gridDim.x - 1) for (int i = threadIdx.x; i < 256 * 8; i += 512) { float cs, sn; sincos_rr((float)(i >> 3) * rope_inv_freq(i & 7), cs, sn); f.ropec[i] = cs; f.ropes[i] = sn; }
    for (int t = blockIdx.x; t < total; t += gridDim.x) {
        const int l = l0 + t / T_LAYER; int r = t % T_LAYER;
        if (r < T_IN) { const int kt = r / 28, ntl = r % 28; cvt_tile<0>(p.w_in + (size_t)l * D * INC, INC, INC, f.w_in_t + (size_t)l * INC_PAD * D, D, kt * 64, ntl * 64, T); continue; }
        r -= T_IN;
        if (r < T_OUT) { const int kt = r / 16, ntl = r % 16; cvt_tile<0>(p.w_out + (size_t)l * MIXW * D, D, D, f.w_out_t + (size_t)l * D * MIXW, MIXW, kt * 64, ntl * 64, T); continue; }
        r -= T_OUT;
        if (r < T_UQ) { const int kt = r / 9, ntl = r % 9; cvt_tile<0>(p.w_uq + (size_t)l * QL * NH * QKD, NH * QKD, NH * QKD, f.w_uq_t + (size_t)l * NH * QKD * QL, QL, kt * 64, ntl * 64, T); continue; }
        r -= T_UQ;
        if (r < T_UKV) { const int kt = r / 12, ntl = r % 12; cvt_tile<0>(p.w_ukv + (size_t)l * KVL * NH * 128, NH * 128, NH * 128, f.w_ukv_t + (size_t)l * NH * 128 * KVL, KVL, kt * 64, ntl * 64, T); continue; }
        r -= T_UKV;
        const int e = r / (3 * T_E), which = (r / T_E) % 3, tt = r % T_E, kt = tt / 16, ntl = tt % 16; const size_t le = (size_t)l * NE + e;
        if (which == 0) cvt_tile<1>(p.wg + le * D * FF, FF, FF, f.gu_t + le * 2 * FF * D, D, kt * 64, ntl * 64, T);
        else if (which == 1) cvt_tile<2>(p.wu + le * D * FF, FF, FF, f.gu_t + le * 2 * FF * D, D, kt * 64, ntl * 64, T);
        else cvt_tile<0>(p.wd + le * FF * D, D, D, f.d_t + le * D * FF, FF, kt * 64, ntl * 64, T);
    }
}
__device__ __forceinline__ void inproj_phase(const P& p, const FW& f, int l, float* dst, char* lds) {
    constexpr int NPN = INC_PAD / 256, NU = (M / 256) * NPN;
    for (int u = blockIdx.x; u < NU; u += gridDim.x) {
        const int pm = u / NPN, pn = u % NPN; unsigned offA[2][2]; gm::dense_offA(offA, (long)pm * 256, D);
        auto epi = [&](const gm::f32x4 (&acc)[2][2][4][2], int wr, int wc, int fr, int fq) {
            const int row0 = pm * 256 + wr * 64 + fr, col0 = pn * 256 + wc * 32 + 4 * fq;
#pragma unroll
            for (int ai = 0; ai < 2; ++ai)
#pragma unroll
                for (int m = 0; m < 4; ++m) { float* rowp = dst + (size_t)(row0 + ai * 128 + m * 16) * INC + col0;
#pragma unroll
                    for (int bj = 0; bj < 2; ++bj)
#pragma unroll
                        for (int n = 0; n < 2; ++n) if (col0 + bj * 128 + n * 16 < INC) *(gm::f32x4*)(rowp + bj * 128 + n * 16) = acc[ai][bj][m][n]; } };
        gm::gemm_unit<false>((GM_LAS unsigned char*)lds, (const char*)f.hb1, offA, (const char*)(f.w_in_t + ((size_t)l * INC_PAD + pn * 256) * D), D, epi);
    }
}
template <bool TOX> __device__ __forceinline__ void outproj_phase(const P& p, const FW& f, int l, float* dst, char* lds) {
    constexpr int NPN = D / 256, NU = (M / 256) * NPN;
    for (int u = blockIdx.x; u < NU; u += gridDim.x) {
        const int pm = u / NPN, pn = u % NPN; unsigned offA[2][2]; gm::dense_offA(offA, (long)pm * 256, MIXW);
        auto epi = [&](const gm::f32x4 (&acc)[2][2][4][2], int wr, int wc, int fr, int fq) {
            const int row0 = pm * 256 + wr * 64 + fr, col0 = pn * 256 + wc * 32 + 4 * fq; const float* gate = modv(p, l, pm * 256, 2);
#pragma unroll
            for (int ai = 0; ai < 2; ++ai)
#pragma unroll
                for (int m = 0; m < 4; ++m) { float* rowp = dst + (size_t)(row0 + ai * 128 + m * 16) * D + col0;
#pragma unroll
                    for (int bj = 0; bj < 2; ++bj)
#pragma unroll
                        for (int n = 0; n < 2; ++n) { float* q = rowp + bj * 128 + n * 16;
                            if (TOX) { const gm::f32x4 g = *(const gm::f32x4*)(gate + col0 + bj * 128 + n * 16); const gm::f32x4 x = *(const gm::f32x4*)q; *(gm::f32x4*)q = x + g * acc[ai][bj][m][n]; }
                            else *(gm::f32x4*)q = acc[ai][bj][m][n]; } } };
        gm::gemm_unit<false>((GM_LAS unsigned char*)lds, (const char*)f.mixb, offA, (const char*)(f.w_out_t + ((size_t)l * D + pn * 256) * MIXW), MIXW, epi);
    }
}
__device__ __forceinline__ bool moe_find(const int* cnt, int tg, int& e, int& ti, int& c) {
    int acc = 0;
    for (int x = 0; x < NE; ++x) { const int cx = cnt[x]; const int nt = (cx + 255) >> 8; if (tg < acc + nt) { e = x; ti = tg - acc; c = cx; return true; } acc += nt; }
    return false;
}
__device__ __forceinline__ int moe_tiles(const int* cnt) { int acc = 0; for (int x = 0; x < NE; ++x) acc += (cnt[x] + 255) >> 8; return acc; }
template <bool SRC_TOK> __device__ __forceinline__ void gather_offA(unsigned (&offA)[2][2], const int* lst, int base, int cnt, int K) {
    int tid = threadIdx.x; asm volatile("" : "+v"(tid));
#pragma unroll
    for (int i = 0; i < 2; ++i) { int R, C; gm::stage_rc(tid * 16 + i * 8192, R, C);
#pragma unroll
        for (int h = 0; h < 2; ++h) { const int s = base + h * 128 + R; int a = s < cnt ? lst[s] : 0; if (SRC_TOK) a >>= 2; offA[h][i] = (unsigned)(((size_t)a * K + C) * 2); } }
}
__device__ __forceinline__ void moe1_phase(const P& p, const FW& f, int l, char* lds) {
    constexpr int NPN = 2 * FF / 256; const int NU = moe_tiles(p.cnt) * NPN;
    for (int u = blockIdx.x; u < NU; u += gridDim.x) {
        int e, ti, cnt; if (!moe_find(p.cnt, u / NPN, e, ti, cnt)) break; const int pn = u % NPN; const int* lst = p.list + (size_t)e * M; const size_t le = (size_t)l * NE + e;
        unsigned offA[2][2]; gather_offA<true>(offA, lst, ti * 256, cnt, D);
        auto epi = [&](const gm::f32x4 (&acc)[2][2][4][2], int wr, int wc, int fr, int fq) {
            const int ff0 = pn * 128 + wc * 32 + 8 * fq; const float* bgp = p.bg + le * FF + ff0; const float* bup = p.bu + le * FF + ff0;
            const gm::f32x4 bg0 = *(const gm::f32x4*)bgp, bg1 = *(const gm::f32x4*)(bgp + 4), bu0 = *(const gm::f32x4*)bup, bu1 = *(const gm::f32x4*)(bup + 4);
#pragma unroll
            for (int ai = 0; ai < 2; ++ai)
#pragma unroll
                for (int m = 0; m < 4; ++m) { const int s = ti * 256 + ai * 128 + wr * 64 + m * 16 + fr; if (s < cnt) { const int a = lst[s]; float o[8];
#pragma unroll
                        for (int n = 0; n < 2; ++n)
#pragma unroll
                            for (int j = 0; j < 4; ++j) { float g = acc[ai][0][m][n][j] + (n ? bg1[j] : bg0[j]); float uu = acc[ai][1][m][n][j] + (n ? bu1[j] : bu0[j]);
                                g = g < 7.0f ? g : 7.0f; uu = uu < -7.0f ? -7.0f : (uu > 7.0f ? 7.0f : uu); o[n * 4 + j] = g * (1.0f / (1.0f + __expf(-1.702f * g))) * (uu + 1.0f); }
                        gm::u32x4 w; w.x = gm::cvt_pk_bf16(o[0], o[1]); w.y = gm::cvt_pk_bf16(o[2], o[3]); w.z = gm::cvt_pk_bf16(o[4], o[5]); w.w = gm::cvt_pk_bf16(o[6], o[7]);
                        *(gm::u32x4*)(f.actb + (size_t)a * FF + ff0) = w; } } };
        gm::gemm_unit<true>((GM_LAS unsigned char*)lds, (const char*)f.hb2, offA, (const char*)(f.gu_t + (le * 2 * FF + pn * 256) * D), D, epi);
    }
}
__device__ __forceinline__ void moe2_phase(const P& p, const FW& f, int l, char* lds) {
    constexpr int NPN = D / 256; const int NU = moe_tiles(p.cnt) * NPN;
    for (int u = blockIdx.x; u < NU; u += gridDim.x) {
        int e, ti, cnt; if (!moe_find(p.cnt, u / NPN, e, ti, cnt)) break; const int pn = u % NPN; const int* lst = p.list + (size_t)e * M; const size_t le = (size_t)l * NE + e;
        unsigned offA[2][2]; gather_offA<false>(offA, lst, ti * 256, cnt, FF);
        auto epi = [&](const gm::f32x4 (&acc)[2][2][4][2], int wr, int wc, int fr, int fq) {
#pragma unroll
            for (int bj = 0; bj < 2; ++bj) { const int c0 = pn * 256 + bj * 128 + wc * 32 + 8 * fq; const float* bp = p.bd + le * D + c0; const gm::f32x4 b0 = *(const gm::f32x4*)bp, b1 = *(const gm::f32x4*)(bp + 4);
#pragma unroll
                for (int ai = 0; ai < 2; ++ai)
#pragma unroll
                    for (int m = 0; m < 4; ++m) { const int s = ti * 256 + ai * 128 + wr * 64 + m * 16 + fr; if (s < cnt) { const int a = lst[s];
                            const gm::f32x4 v0 = acc[ai][bj][m][0] + b0, v1 = acc[ai][bj][m][1] + b1;
                            gm::u32x4 w; w.x = gm::cvt_pk_bf16(v0[0], v0[1]); w.y = gm::cvt_pk_bf16(v0[2], v0[3]); w.z = gm::cvt_pk_bf16(v1[0], v1[1]); w.w = gm::cvt_pk_bf16(v1[2], v1[3]);
                            *(gm::u32x4*)(f.yb + (size_t)a * D + c0) = w; } } } };
        gm::gemm_unit<true>((GM_LAS unsigned char*)lds, (const char*)f.actb, offA, (const char*)(f.d_t + (le * D + pn * 256) * FF), FF, epi);
    }
}

namespace rw {
typedef float f32x4 __attribute__((ext_vector_type(4)));
typedef unsigned u32x2 __attribute__((ext_vector_type(2)));
constexpr int ROWS_PB = 65;
__device__ __forceinline__ float wave_sum(float v) {
#pragma unroll
    for (int o = 32; o >= 1; o >>= 1) v += __shfl_xor(v, o);
    return v;
}
__device__ __forceinline__ unsigned pk2(float lo, float hi) { unsigned r; asm volatile("v_cvt_pk_bf16_f32 %0, %1, %2" : "=v"(r) : "v"(lo), "v"(hi)); return r; }
__device__ __forceinline__ f32x4 bf4(u32x2 w) { f32x4 r; r[0] = __uint_as_float(w.x << 16); r[1] = __uint_as_float(w.x & 0xffff0000u); r[2] = __uint_as_float(w.y << 16); r[3] = __uint_as_float(w.y & 0xffff0000u); return r; }
__device__ __forceinline__ void norm_store(const f32x4 (&x)[4], const float* g, const float* shift, const float* scale, bf16_t* dst, int lane) {
    float ss = 0.f;
#pragma unroll
    for (int j = 0; j < 4; ++j) ss += x[j][0] * x[j][0] + x[j][1] * x[j][1] + x[j][2] * x[j][2] + x[j][3] * x[j][3];
    ss = wave_sum(ss); const float rs = 1.0f / sqrtf(ss * (1.0f / D) + EPS);
#pragma unroll
    for (int j = 0; j < 4; ++j) { const int c = 4 * lane + 256 * j; const f32x4 gv = *(const f32x4*)(g + c), sh = *(const f32x4*)(shift + c), sc = *(const f32x4*)(scale + c);
        const f32x4 o = x[j] * rs * gv * (1.0f + sc) + sh; u32x2 w; w.x = pk2(o[0], o[1]); w.y = pk2(o[2], o[3]); *(u32x2*)(dst + c) = w; }
}
__device__ __forceinline__ void first_norm_phase(const P& p) {
    int tid = threadIdx.x; asm volatile("" : "+v"(tid)); const int wid = tid >> 6, lane = tid & 63;
    for (int i = wid; i < ROWS_PB; i += 8) { const int r = blockIdx.x * ROWS_PB + i; if (r >= M) break;
        const float* src = r < CTX ? p.ctx + (size_t)r * D : p.x + (size_t)(r - CTX) * D; f32x4 x[4];
#pragma unroll
        for (int j = 0; j < 4; ++j) { x[j] = *(const f32x4*)(src + 4 * lane + 256 * j); *(f32x4*)(p.xres + (size_t)r * D + 4 * lane + 256 * j) = x[j]; }
        norm_store(x, p.norm1_g, modv(p, 0, r, 0), modv(p, 0, r, 1), p.hb1 + (size_t)r * D, lane); }
}
__device__ __forceinline__ void combine_phase(const P& p, int l) {
    int tid = threadIdx.x; asm volatile("" : "+v"(tid)); const int wid = tid >> 6, lane = tid & 63;
    for (int i = wid; i < ROWS_PB; i += 8) { const int r = blockIdx.x * ROWS_PB + i; if (r >= M) break;
        const f32x4 tw = *(const f32x4*)(p.topw + (size_t)r * 4); const float* gate = modv(p, l, r, 5); f32x4 x[4];
#pragma unroll
        for (int j = 0; j < 4; ++j) { const int c = 4 * lane + 256 * j; f32x4 s = {0.f, 0.f, 0.f, 0.f};
#pragma unroll
            for (int k = 0; k < 4; ++k) s += bf4(*(const u32x2*)(p.ybn + ((size_t)r * 4 + k) * D + c)) * tw[k];
            x[j] = *(const f32x4*)(p.xres + (size_t)r * D + c) + *(const f32x4*)(gate + c) * s; }
        if (l + 1 < DEPTH) {
#pragma unroll
            for (int j = 0; j < 4; ++j) *(f32x4*)(p.xres + (size_t)r * D + 4 * lane + 256 * j) = x[j];
            norm_store(x, p.norm1_g + (size_t)(l + 1) * D, modv(p, l + 1, r, 0), modv(p, l + 1, r, 1), p.hb1 + (size_t)r * D, lane);
        } else if (r >= CTX) {
#pragma unroll
            for (int j = 0; j < 4; ++j) *(f32x4*)(p.out + (size_t)(r - CTX) * D + 4 * lane + 256 * j) = x[j];
        } }
}
__device__ __forceinline__ void router_phase(const P& p, int l, char* lds) {
    int tid = threadIdx.x; asm volatile("" : "+v"(tid)); const int wid = tid >> 6, lane = tid & 63;
    float* WT = (float*)lds; float* bias2 = WT + 32 * 1024; int* lcnt = (int*)(bias2 + 64); int* lbase = lcnt + 32; int* rec = lbase + 32;
    const float* rwp = p.router_w + (size_t)l * D * NE;
    for (int i = tid; i < D * NE / 4; i += 512) { const int k = i >> 3, e4 = i & 7; const f32x4 v = *(const f32x4*)(rwp + (size_t)k * NE + e4 * 4);
#pragma unroll
        for (int q = 0; q < 4; ++q) WT[(e4 * 4 + q) * 1024 + (k ^ (e4 << 2))] = v[q]; }
    if (tid < 32) lcnt[tid] = 0;
    __syncthreads();
    {
#pragma unroll
        for (int v = 0; v < 2; ++v) { const float* sh = p.mod + ((size_t)(l * 2 + v) * 6 + 3) * D; f32x4 s[4];
#pragma unroll
            for (int j = 0; j < 4; ++j) s[j] = *(const f32x4*)(sh + 4 * lane + 256 * j);
#pragma unroll
            for (int q = 0; q < 4; ++q) { const int e = wid * 4 + q; float a = 0.f;
#pragma unroll
                for (int j = 0; j < 4; ++j) { const f32x4 w = *(const f32x4*)(WT + e * 1024 + ((4 * lane + 256 * j) ^ (((e >> 2) & 7) << 2))); a += w[0] * s[j][0] + w[1] * s[j][1] + w[2] * s[j][2] + w[3] * s[j][3]; }
                a = wave_sum(a); if (lane == 0) bias2[v * 32 + e] = a + p.router_b[l * NE + e]; } }
    }
    __syncthreads();
    const float* g2 = p.norm2_g + (size_t)l * D;
    for (int rp = wid; rp < (ROWS_PB + 1) / 2; rp += 8) {
        float acc[2][32]; float rsv[2]; int rr[2];
        f32x4 xg[2][4];
#pragma unroll
        for (int q = 0; q < 2; ++q) { const int il = 2 * rp + q; const int r = blockIdx.x * ROWS_PB + (il < ROWS_PB ? il : ROWS_PB - 1); rr[q] = r;
            const float* sc = modv(p, l, r, 4); const float* sh = modv(p, l, r, 3); float ss = 0.f; f32x4 x[4];
#pragma unroll
            for (int j = 0; j < 4; ++j) { x[j] = *(const f32x4*)(p.xres + (size_t)r * D + 4 * lane + 256 * j); ss += x[j][0] * x[j][0] + x[j][1] * x[j][1] + x[j][2] * x[j][2] + x[j][3] * x[j][3]; }
            ss = wave_sum(ss); const float rs = 1.0f / sqrtf(ss * (1.0f / D) + EPS); rsv[q] = rs;
#pragma unroll
            for (int j = 0; j < 4; ++j) { const int c = 4 * lane + 256 * j; xg[q][j] = x[j] * *(const f32x4*)(g2 + c) * (1.0f + *(const f32x4*)(sc + c));
                const f32x4 o = xg[q][j] * rs + *(const f32x4*)(sh + c); u32x2 w; w.x = pk2(o[0], o[1]); w.y = pk2(o[2], o[3]); if (il < ROWS_PB) *(u32x2*)(p.hb2 + (size_t)r * D + c) = w; }
        }
#pragma unroll
        for (int e = 0; e < 32; ++e) { float a0 = 0.f, a1 = 0.f;
#pragma unroll
            for (int j = 0; j < 4; ++j) { const f32x4 w = *(const f32x4*)(WT + e * 1024 + ((4 * lane + 256 * j) ^ (((e >> 2) & 7) << 2)));
                a0 += w[0] * xg[0][j][0] + w[1] * xg[0][j][1] + w[2] * xg[0][j][2] + w[3] * xg[0][j][3]; a1 += w[0] * xg[1][j][0] + w[1] * xg[1][j][1] + w[2] * xg[1][j][2] + w[3] * xg[1][j][3]; }
            acc[0][e] = a0; acc[1][e] = a1; }
        float v[64];
#pragma unroll
        for (int e = 0; e < 32; ++e) { v[e] = acc[0][e]; v[32 + e] = acc[1][e]; }
#pragma unroll
        for (int m = 32, n = 64; m >= 1; m >>= 1, n >>= 1) {
#pragma unroll
            for (int i = 0; i < n / 2; ++i) { const bool up = (lane & m) != 0; const float keep = up ? v[i + n / 2] : v[i], send = up ? v[i] : v[i + n / 2]; v[i] = keep + __shfl_xor(send, m); } }
        const int q = lane >> 5, e = lane & 31; const int r = rr[q]; const int il = 2 * rp + q;
        float logit = v[0] * rsv[q] + bias2[(r < CTX ? 32 : 0) + e];
        float cur = logit; int sel[4]; float sv[4];
#pragma unroll
        for (int k = 0; k < 4; ++k) { float mx = cur;
#pragma unroll
            for (int o = 16; o >= 1; o >>= 1) mx = fmaxf(mx, __shfl_xor(mx, o));
            const unsigned long long bal = __ballot(cur == mx); const unsigned half = (unsigned)(bal >> (q * 32)); const int win = __ffs(half) - 1;
            sel[k] = win; sv[k] = mx; if (e == win) cur = -3.0e38f; }
        if (e < 4 && il < ROWS_PB) {
            float es[4], sum = 0.f;
#pragma unroll
            for (int k = 0; k < 4; ++k) { es[k] = __expf(sv[k] - sv[0]); sum += es[k]; }
            const int myk = e; const int mye = myk == 0 ? sel[0] : myk == 1 ? sel[1] : myk == 2 ? sel[2] : sel[3]; const float myw = (myk == 0 ? es[0] : myk == 1 ? es[1] : myk == 2 ? es[2] : es[3]) / sum;
            p.topw[(size_t)r * 4 + myk] = myw; const int pos = atomicAdd(&lcnt[mye], 1); rec[il * 4 + myk] = mye | (pos << 8);
        }
    }
    __syncthreads();
    if (tid < 32) lbase[tid] = atomicAdd(&p.cnt[tid], lcnt[tid]);
    __syncthreads();
    if (tid < ROWS_PB * 4) { const int il = tid >> 2, k = tid & 3; const int r = blockIdx.x * ROWS_PB + il; const int rc = rec[tid]; const int e = rc & 255, pos = rc >> 8;
        p.list[(size_t)e * M + lbase[e] + pos] = r * 4 + k; }
    __syncthreads();
}
}

namespace ml {
typedef short bf16x8 __attribute__((ext_vector_type(8)));
typedef float f32x4 __attribute__((ext_vector_type(4)));
typedef unsigned u32x2 __attribute__((ext_vector_type(2)));
constexpr int RB = 65, MT = 5;
constexpr int AQ_STRIDE = QL * 2 + 16, AKV_STRIDE = KVL * 2 + 16;
constexpr int OFF_AQ = 0, OFF_AKV = OFF_AQ + 80 * AQ_STRIDE, OFF_KRS = OFF_AKV + 80 * AKV_STRIDE, OFF_KSS = OFF_KRS + 80 * 32 * 4, LDS_MLA = OFF_KSS + 80 * 4;
struct MW { const bf16_t* w_uq_t; const bf16_t* w_ukv_t; const float* ropec; const float* ropes; const float* proj; int ldp; bf16_t* qb; bf16_t* kb; bf16_t* vb; };
__device__ __forceinline__ void mla_phase(const P& p, const MW& w, int l, char* lds) {
    int tid = threadIdx.x; asm volatile("" : "+v"(tid)); const int wid = __builtin_amdgcn_readfirstlane(tid >> 6), lane = tid & 63, fr = lane & 15, fq = lane >> 4;
    const int row0 = blockIdx.x * RB;
    for (int i = wid; i < 80; i += 8) {
        char* aq = lds + OFF_AQ + i * AQ_STRIDE; char* akv = lds + OFF_AKV + i * AKV_STRIDE; float* krs = (float*)(lds + OFF_KRS) + i * 32;
        if (i < RB && row0 + i < M) { const float* pr = w.proj + (size_t)(row0 + i) * w.ldp;
            { const f32x4 x = *(const f32x4*)(pr + C_Q + 4 * lane); float ss = rw::wave_sum(x[0] * x[0] + x[1] * x[1] + x[2] * x[2] + x[3] * x[3]); const float rs = 1.0f / sqrtf(ss * (1.0f / QL) + EPS);
              const f32x4 g = *(const f32x4*)(p.q_g + l * QL + 4 * lane); const f32x4 o = x * rs * g; u32x2 v; v.x = rw::pk2(o[0], o[1]); v.y = rw::pk2(o[2], o[3]); *(u32x2*)(aq + 8 * lane) = v; }
            { f32x4 x = {0.f, 0.f, 0.f, 0.f}; if (lane < 32) x = *(const f32x4*)(pr + C_KV + 4 * lane); float ss = rw::wave_sum(x[0] * x[0] + x[1] * x[1] + x[2] * x[2] + x[3] * x[3]); const float rs = 1.0f / sqrtf(ss * (1.0f / KVL) + EPS);
              if (lane < 32) { const f32x4 g = *(const f32x4*)(p.kv_g + l * KVL + 4 * lane); const f32x4 o = x * rs * g; u32x2 v; v.x = rw::pk2(o[0], o[1]); v.y = rw::pk2(o[2], o[3]); *(u32x2*)(akv + 8 * lane) = v; } }
            { f32x4 x = {0.f, 0.f, 0.f, 0.f}; if (lane < 8) { x = *(const f32x4*)(pr + C_KR + 4 * lane); *(f32x4*)(krs + 4 * lane) = x; }
              const float ss = rw::wave_sum(x[0] * x[0] + x[1] * x[1] + x[2] * x[2] + x[3] * x[3]); if (lane == 0) ((float*)(lds + OFF_KSS))[i] = ss; }
        } else {
            u32x2 z; z.x = 0u; z.y = 0u; *(u32x2*)(aq + 8 * lane) = z; if (lane < 32) *(u32x2*)(akv + 8 * lane) = z; if (lane < 32) krs[lane] = 0.f; if (lane == 0) ((float*)(lds + OFF_KSS))[i] = 0.f;
        }
    }
    __syncthreads();
    if (wid < 6) {
        const int hh = wid; f32x4 acc[MT][6];
#pragma unroll
        for (int mt = 0; mt < MT; ++mt)
#pragma unroll
            for (int nt = 0; nt < 6; ++nt) acc[mt][nt] = (f32x4){0.f, 0.f, 0.f, 0.f};
        const bf16_t* wb = w.w_uq_t + (size_t)(hh * QKD + fr) * QL + 8 * fq;
#pragma unroll 1
        for (int ks = 0; ks < QL / 32; ++ks) { bf16x8 b[6], a[MT];
#pragma unroll
            for (int nt = 0; nt < 6; ++nt) b[nt] = *(const bf16x8*)(wb + (size_t)nt * 16 * QL + ks * 32);
#pragma unroll
            for (int mt = 0; mt < MT; ++mt) a[mt] = *(const bf16x8*)(lds + OFF_AQ + (mt * 16 + fr) * AQ_STRIDE + (ks * 32 + 8 * fq) * 2);
#pragma unroll
            for (int mt = 0; mt < MT; ++mt)
#pragma unroll
                for (int nt = 0; nt < 6; ++nt) acc[mt][nt] = __builtin_amdgcn_mfma_f32_16x16x32_bf16(b[nt], a[mt], acc[mt][nt], 0, 0, 0); }
        f32x4 gq[6];
#pragma unroll
        for (int nt = 0; nt < 6; ++nt) gq[nt] = *(const f32x4*)(p.qn_g + l * QKD + nt * 16 + 4 * fq);
#pragma unroll
        for (int mt = 0; mt < MT; ++mt) { const int il = mt * 16 + fr; const int r = row0 + il; const bool ok = il < RB && r < M; float ss = 0.f;
#pragma unroll
            for (int nt = 0; nt < 6; ++nt) ss += acc[mt][nt][0] * acc[mt][nt][0] + acc[mt][nt][1] * acc[mt][nt][1] + acc[mt][nt][2] * acc[mt][nt][2] + acc[mt][nt][3] * acc[mt][nt][3];
            ss += __shfl_xor(ss, 16); ss += __shfl_xor(ss, 32); const float rs = 1.0f / sqrtf(ss * (1.0f / QKD) + EPS);
            const bool lat = r >= CTX; const int t = lat ? r - CTX : 0;
#pragma unroll
            for (int nt = 0; nt < 6; ++nt) { f32x4 v = acc[mt][nt] * rs * gq[nt];
                if (nt >= 4) { f32x4 other; other[0] = __shfl_xor(v[0], 32); other[1] = __shfl_xor(v[1], 32); other[2] = __shfl_xor(v[2], 32); other[3] = __shfl_xor(v[3], 32);
                    if (lat && ok) { const int pos = (nt == 4) ? (t / GRID_W) : (t % GRID_W); const f32x4 cs = *(const f32x4*)(w.ropec + (size_t)pos * 8 + 4 * (fq & 1)), sn = *(const f32x4*)(w.ropes + (size_t)pos * 8 + 4 * (fq & 1));
                        v = (fq >> 1) ? (v * cs + other * sn) : (v * cs - other * sn); } }
                if (ok) { u32x2 o; o.x = rw::pk2(v[0], v[1]); o.y = rw::pk2(v[2], v[3]); *(u32x2*)(w.qb + ((size_t)r * NH + hh) * QKD + nt * 16 + 4 * fq) = o; } } }
    } else {
        for (int hs = 0; hs < 3; ++hs) { const int hh = (wid - 6) * 3 + hs;
#pragma unroll
          for (int pass = 0; pass < 2; ++pass) { f32x4 acc[MT][4];
#pragma unroll
            for (int mt = 0; mt < MT; ++mt)
#pragma unroll
                for (int nt = 0; nt < 4; ++nt) acc[mt][nt] = (f32x4){0.f, 0.f, 0.f, 0.f};
            const bf16_t* wb = w.w_ukv_t + (size_t)(hh * 128 + pass * 64 + fr) * KVL + 8 * fq;
#pragma unroll 1
            for (int ks = 0; ks < KVL / 32; ++ks) { bf16x8 b[4], a[MT];
#pragma unroll
                for (int nt = 0; nt < 4; ++nt) b[nt] = *(const bf16x8*)(wb + (size_t)nt * 16 * KVL + ks * 32);
#pragma unroll
                for (int mt = 0; mt < MT; ++mt) a[mt] = *(const bf16x8*)(lds + OFF_AKV + (mt * 16 + fr) * AKV_STRIDE + (ks * 32 + 8 * fq) * 2);
#pragma unroll
                for (int mt = 0; mt < MT; ++mt)
#pragma unroll
                    for (int nt = 0; nt < 4; ++nt) acc[mt][nt] = __builtin_amdgcn_mfma_f32_16x16x32_bf16(b[nt], a[mt], acc[mt][nt], 0, 0, 0); }
            if (pass == 0) {
                f32x4 gk[4], gr[2], gro[2];
#pragma unroll
                for (int nt = 0; nt < 4; ++nt) gk[nt] = *(const f32x4*)(p.kn_g + l * QKD + nt * 16 + 4 * fq);
#pragma unroll
                for (int a = 0; a < 2; ++a) { gr[a] = *(const f32x4*)(p.kn_g + l * QKD + NOPE + a * 16 + 4 * fq); gro[a] = *(const f32x4*)(p.kn_g + l * QKD + NOPE + a * 16 + ((4 * fq) ^ 8)); }
#pragma unroll
                for (int mt = 0; mt < MT; ++mt) { const int il = mt * 16 + fr; const int r = row0 + il; const bool ok = il < RB && r < M; float ss = 0.f;
#pragma unroll
                    for (int nt = 0; nt < 4; ++nt) ss += acc[mt][nt][0] * acc[mt][nt][0] + acc[mt][nt][1] * acc[mt][nt][1] + acc[mt][nt][2] * acc[mt][nt][2] + acc[mt][nt][3] * acc[mt][nt][3];
                    ss += __shfl_xor(ss, 16); ss += __shfl_xor(ss, 32); ss += ((const float*)(lds + OFF_KSS))[il]; const float rs = 1.0f / sqrtf(ss * (1.0f / QKD) + EPS);
                    const bool lat = r >= CTX; const int t = lat ? r - CTX : 0;
                    if (ok) {
                        bf16_t* kd = w.kb + ((size_t)r * NH + hh) * QKD; const float* krs = (const float*)(lds + OFF_KRS) + il * 32;
#pragma unroll
                        for (int nt = 0; nt < 4; ++nt) { const f32x4 v = acc[mt][nt] * rs * gk[nt]; u32x2 o; o.x = rw::pk2(v[0], v[1]); o.y = rw::pk2(v[2], v[3]); *(u32x2*)(kd + nt * 16 + 4 * fq) = o; }
#pragma unroll
                        for (int a = 0; a < 2; ++a) { f32x4 v = *(const f32x4*)(krs + a * 16 + 4 * fq) * rs * gr[a]; const f32x4 other = *(const f32x4*)(krs + a * 16 + ((4 * fq) ^ 8)) * rs * gro[a];
                            if (lat) { const int pos = (a == 0) ? (t / GRID_W) : (t % GRID_W); const f32x4 cs = *(const f32x4*)(w.ropec + (size_t)pos * 8 + 4 * (fq & 1)), sn = *(const f32x4*)(w.ropes + (size_t)pos * 8 + 4 * (fq & 1));
                                v = (fq >> 1) ? (v * cs + other * sn) : (v * cs - other * sn); }
                            u32x2 o; o.x = rw::pk2(v[0], v[1]); o.y = rw::pk2(v[2], v[3]); *(u32x2*)(kd + NOPE + a * 16 + 4 * fq) = o; }
                    } }
            } else {
#pragma unroll
                for (int mt = 0; mt < MT; ++mt) { const int il = mt * 16 + fr; const int r = row0 + il; const bool ok = il < RB && r < M;
                    if (ok) { bf16_t* vd = w.vb + ((size_t)r * NH + hh) * VD;
#pragma unroll
                        for (int nt = 0; nt < 4; ++nt) { const f32x4 v = acc[mt][nt]; u32x2 o; o.x = rw::pk2(v[0], v[1]); o.y = rw::pk2(v[2], v[3]); *(u32x2*)(vd + nt * 16 + 4 * fq) = o; } } }
            }
          }
        }
    }
    __syncthreads();
}
}

namespace sd {
typedef short bf16x8 __attribute__((ext_vector_type(8)));
typedef float f32x4 __attribute__((ext_vector_type(4)));
typedef unsigned u32x2 __attribute__((ext_vector_type(2)));
typedef unsigned u32x4 __attribute__((ext_vector_type(4)));
constexpr int SBS = 144, STS = 272;
constexpr int OFF_BM = 0, OFF_CM = OFF_BM + 128 * SBS, OFF_XT = OFF_CM + 128 * SBS, OFF_BTF = OFF_XT + 64 * STS, OFF_BTB = OFF_BTF + 64 * STS, OFF_L = OFF_BTB + 64 * STS, OFF_SC = OFF_L + 128 * STS, LDS_SSD = OFF_SC + 4 * 128 * 4;
struct SsdW { const float* proj; int ldp; float* yd; float* st; float* cdec; float* cs; bf16_t* cg; bf16_t* prevb; };
__device__ __forceinline__ bf16x8 ldfrag(const char* base, int row, int stride, int kbyte) { return *(const bf16x8*)(base + row * stride + kbyte); }
__device__ __forceinline__ float silu_f(float x) { return x / (1.0f + __expf(-x)); }
__device__ __forceinline__ void chunk_unit(const P& p, const SsdW& w, int l, int c, int hh, char* lds) {
    int tid = threadIdx.x; asm volatile("" : "+v"(tid)); const int wid = __builtin_amdgcn_readfirstlane(tid >> 6), lane = tid & 63, fr = lane & 15, fq = lane >> 4;
    const int R0 = c * CHUNK, g = hh / (SH / SG); const int seg0 = R0 < CTX ? 0 : CTX, seg1 = R0 < CTX ? CTX : M;
    float* csf = (float*)(lds + OFF_SC); float* csb = csf + 128; float* dtf = csb + 128; float* dtb = dtf + 128;
    if (tid < 256) { const int r = tid & 127, d = tid >> 7; const float v = softplusf(w.proj[(size_t)(R0 + r) * w.ldp + C_DT + d * 6 + hh] + p.dt_bias[l * 12 + d * 6 + hh]); (d ? dtb : dtf)[r] = v; }
    __syncthreads();
    if (wid < 2) {
        const int d = wid; const float a = -__expf(p.a_log[l * 12 + d * 6 + hh]); const float* dts = d ? dtb : dtf; float* cso = d ? csb : csf;
        const int i0 = 2 * lane, i1 = 2 * lane + 1; const int r0 = d ? 127 - i0 : i0, r1 = d ? 127 - i1 : i1;
        const float v0 = dts[r0] * a, v1 = dts[r1] * a; float s = v0 + v1;
#pragma unroll
        for (int o = 1; o < 64; o <<= 1) { const float t = __shfl_up(s, o); if (lane >= o) s += t; }
        const float excl = s - (v0 + v1); const float c0 = excl + v0, c1 = c0 + v1; cso[r0] = c0; cso[r1] = c1;
        w.cs[((size_t)d * M + R0 + r0) * SH + hh] = c0; w.cs[((size_t)d * M + R0 + r1) * SH + hh] = c1;
        if (lane == 63) w.cdec[((size_t)d * NCH + c) * SH + hh] = __expf(c1);
    }
    __syncthreads();
    {   const int col = tid & 63, l0 = (tid >> 6) * 16; const float cfe = csf[127], cbe = csb[0];
#pragma unroll
        for (int which = 0; which < 3; ++which) { const int cidx = which == 0 ? hh * SP + col : (which == 1 ? SW + g * SN + col : SW + SG * SN + g * SN + col);
            const float w0 = p.conv_w[((size_t)l * 4 + 0) * CONVD + cidx], w1 = p.conv_w[((size_t)l * 4 + 1) * CONVD + cidx], w2 = p.conv_w[((size_t)l * 4 + 2) * CONVD + cidx], w3 = p.conv_w[((size_t)l * 4 + 3) * CONVD + cidx], bb = p.conv_b[l * CONVD + cidx];
            float v[19];
#pragma unroll
            for (int i = 0; i < 19; ++i) { const int r = R0 + l0 - 2 + i; v[i] = (r >= seg0 && r < seg1) ? w.proj[(size_t)r * w.ldp + C_XBC + cidx] : 0.f; }
            float y[16];
#pragma unroll
            for (int i = 0; i < 16; ++i) y[i] = silu_f(bb + w0 * v[i] + w1 * v[i + 1] + w2 * v[i + 2] + w3 * v[i + 3]);
            if (which == 0) {
                u32x4 a, b; a.x = rw::pk2(y[0], y[1]); a.y = rw::pk2(y[2], y[3]); a.z = rw::pk2(y[4], y[5]); a.w = rw::pk2(y[6], y[7]); b.x = rw::pk2(y[8], y[9]); b.y = rw::pk2(y[10], y[11]); b.z = rw::pk2(y[12], y[13]); b.w = rw::pk2(y[14], y[15]);
                *(u32x4*)(lds + OFF_XT + col * STS + l0 * 2) = a; *(u32x4*)(lds + OFF_XT + col * STS + l0 * 2 + 16) = b;
            } else if (which == 1) {
                float yf[16], yb[16];
#pragma unroll
                for (int i = 0; i < 16; ++i) { *(bf16_t*)(lds + OFF_BM + (l0 + i) * SBS + col * 2) = f2bf(y[i]); yf[i] = y[i] * __expf(cfe - csf[l0 + i]) * dtf[l0 + i]; yb[i] = y[i] * __expf(cbe - csb[l0 + i]) * dtb[l0 + i]; }
                u32x4 a, b; a.x = rw::pk2(yf[0], yf[1]); a.y = rw::pk2(yf[2], yf[3]); a.z = rw::pk2(yf[4], yf[5]); a.w = rw::pk2(yf[6], yf[7]); b.x = rw::pk2(yf[8], yf[9]); b.y = rw::pk2(yf[10], yf[11]); b.z = rw::pk2(yf[12], yf[13]); b.w = rw::pk2(yf[14], yf[15]);
                *(u32x4*)(lds + OFF_BTF + col * STS + l0 * 2) = a; *(u32x4*)(lds + OFF_BTF + col * STS + l0 * 2 + 16) = b;
                a.x = rw::pk2(yb[0], yb[1]); a.y = rw::pk2(yb[2], yb[3]); a.z = rw::pk2(yb[4], yb[5]); a.w = rw::pk2(yb[6], yb[7]); b.x = rw::pk2(yb[8], yb[9]); b.y = rw::pk2(yb[10], yb[11]); b.z = rw::pk2(yb[12], yb[13]); b.w = rw::pk2(yb[14], yb[15]);
                *(u32x4*)(lds + OFF_BTB + col * STS + l0 * 2) = a; *(u32x4*)(lds + OFF_BTB + col * STS + l0 * 2 + 16) = b;
            } else {
#pragma unroll
                for (int i = 0; i < 16; ++i) { const bf16_t cv = f2bf(y[i]); *(bf16_t*)(lds + OFF_CM + (l0 + i) * SBS + col * 2) = cv; if (hh % (SH / SG) == 0) w.cg[((size_t)(R0 + l0 + i) * SG + g) * SN + col] = cv; }
            } }
    }
    __syncthreads();
    {   const int lt = wid, lrow = 16 * lt + fr; const bf16x8 c0 = ldfrag(lds + OFF_CM, lrow, SBS, 16 * fq), c1 = ldfrag(lds + OFF_CM, lrow, SBS, 64 + 16 * fq);
        const float cfl = csf[lrow], cbl = csb[lrow], Dh = p.ssd_d[l * SH + hh];
#pragma unroll
        for (int st = 0; st < 8; ++st) { const bf16x8 b0 = ldfrag(lds + OFF_BM, 16 * st + fr, SBS, 16 * fq), b1 = ldfrag(lds + OFF_BM, 16 * st + fr, SBS, 64 + 16 * fq);
            f32x4 acc = {0.f, 0.f, 0.f, 0.f}; acc = __builtin_amdgcn_mfma_f32_16x16x32_bf16(b0, c0, acc, 0, 0, 0); acc = __builtin_amdgcn_mfma_f32_16x16x32_bf16(b1, c1, acc, 0, 0, 0);
            const int s0 = 16 * st + 4 * fq; const f32x4 cfs = *(const f32x4*)(csf + s0), cbs = *(const f32x4*)(csb + s0), dfs = *(const f32x4*)(dtf + s0), dbs = *(const f32x4*)(dtb + s0); float o[4];
#pragma unroll
            for (int j = 0; j < 4; ++j) { const int s = s0 + j; const float ef = s <= lrow ? __expf(fminf(cfl - cfs[j], 0.f)) * dfs[j] : 0.f; const float eb = s >= lrow ? __expf(fminf(cbl - cbs[j], 0.f)) * dbs[j] : 0.f;
                o[j] = acc[j] * (ef + eb) + (s == lrow ? Dh : 0.f); }
            u32x2 pk; pk.x = rw::pk2(o[0], o[1]); pk.y = rw::pk2(o[2], o[3]); *(u32x2*)(lds + OFF_L + lrow * STS + s0 * 2) = pk; }
    }
    __syncthreads();
    {   const int lt = wid, lrow = 16 * lt + fr; bf16x8 lf[4];
#pragma unroll
        for (int ks = 0; ks < 4; ++ks) lf[ks] = ldfrag(lds + OFF_L, lrow, STS, 64 * ks + 16 * fq);
#pragma unroll
        for (int pt = 0; pt < 4; ++pt) { f32x4 acc = {0.f, 0.f, 0.f, 0.f};
#pragma unroll
            for (int ks = 0; ks < 4; ++ks) acc = __builtin_amdgcn_mfma_f32_16x16x32_bf16(ldfrag(lds + OFF_XT, 16 * pt + fr, STS, 64 * ks + 16 * fq), lf[ks], acc, 0, 0, 0);
            *(f32x4*)(w.yd + (size_t)(R0 + lrow) * SW + hh * SP + 16 * pt + 4 * fq) = acc; }
    }
    {   const int d = wid >> 2, ptile = wid & 3, prow = 16 * ptile + fr; bf16x8 xf[4]; const char* bt = lds + (d ? OFF_BTB : OFF_BTF);
#pragma unroll
        for (int ks = 0; ks < 4; ++ks) xf[ks] = ldfrag(lds + OFF_XT, prow, STS, 64 * ks + 16 * fq);
#pragma unroll
        for (int nt = 0; nt < 4; ++nt) { f32x4 acc = {0.f, 0.f, 0.f, 0.f};
#pragma unroll
            for (int ks = 0; ks < 4; ++ks) acc = __builtin_amdgcn_mfma_f32_16x16x32_bf16(ldfrag(bt, 16 * nt + fr, STS, 64 * ks + 16 * fq), xf[ks], acc, 0, 0, 0);
            *(f32x4*)(w.st + ((((size_t)d * NCH + c) * SH + hh) * SP + prow) * SN + 16 * nt + 4 * fq) = acc; }
    }
    __syncthreads();
}
__device__ __forceinline__ void carry_phase(const SsdW& w) {
    int tid = threadIdx.x; asm volatile("" : "+v"(tid));
    constexpr int PER = 2 * SH * SP * SN / 256;
    if (tid < PER) { const int eidx = blockIdx.x * PER + tid; if (eidx < 2 * SH * SP * SN) { const int dir = eidx / (SH * SP * SN), rem = eidx % (SH * SP * SN), hh = rem / (SP * SN), e = rem % (SP * SN); float state = 0.f;
        for (int b = 0; b < NCH / 13; ++b) { float sv[13], dv[13]; size_t ov[13];
#pragma unroll
            for (int j = 0; j < 13; ++j) { const int i = b * 13 + j; const int c = dir == 0 ? i : (i < CTX / CHUNK ? CTX / CHUNK - 1 - i : NCH - 1 - (i - CTX / CHUNK));
                ov[j] = (((size_t)dir * NCH + c) * SH + hh) * (SP * SN) + e; sv[j] = w.st[ov[j]]; dv[j] = w.cdec[((size_t)dir * NCH + c) * SH + hh]; }
#pragma unroll
            for (int j = 0; j < 13; ++j) { w.prevb[ov[j]] = f2bf(state); state = state * dv[j] + sv[j]; } } } }
}
__device__ __forceinline__ void final_phase(const P& p, const SsdW& w, int l, bf16_t* dst, int ldd) {
    int tid = threadIdx.x; asm volatile("" : "+v"(tid)); const int wid = __builtin_amdgcn_readfirstlane(tid >> 6), lane = tid & 63, fr = lane & 15, fq = lane >> 4;
    const int ltg = wid * gridDim.x + blockIdx.x; if (ltg >= M / 16) return;
    const int r = ltg * 16 + fr, c = (ltg * 16) / CHUNK;
    bf16x8 cf[2][2];
#pragma unroll
    for (int g = 0; g < 2; ++g)
#pragma unroll
        for (int ks = 0; ks < 2; ++ks) cf[g][ks] = *(const bf16x8*)(w.cg + ((size_t)r * SG + g) * SN + 32 * ks + 8 * fq);
    f32x4 gv[SH][4]; float ss = 0.f;
#pragma unroll
    for (int hh = 0; hh < SH; ++hh) { const int g = hh / (SH / SG); const float ef = __expf(w.cs[(size_t)r * SH + hh]), eb = __expf(w.cs[((size_t)M + r) * SH + hh]);
#pragma unroll
        for (int pt = 0; pt < 4; ++pt) { f32x4 af = {0.f, 0.f, 0.f, 0.f}, ab = {0.f, 0.f, 0.f, 0.f};
            const bf16_t* pf = w.prevb + ((((size_t)0 * NCH + c) * SH + hh) * SP + 16 * pt + fr) * SN + 8 * fq; const bf16_t* pb = w.prevb + ((((size_t)1 * NCH + c) * SH + hh) * SP + 16 * pt + fr) * SN + 8 * fq;
#pragma unroll
            for (int ks = 0; ks < 2; ++ks) { af = __builtin_amdgcn_mfma_f32_16x16x32_bf16(*(const bf16x8*)(pf + 32 * ks), cf[g][ks], af, 0, 0, 0); ab = __builtin_amdgcn_mfma_f32_16x16x32_bf16(*(const bf16x8*)(pb + 32 * ks), cf[g][ks], ab, 0, 0, 0); }
            const int col = hh * SP + 16 * pt + 4 * fq; const f32x4 yd = *(const f32x4*)(w.yd + (size_t)r * SW + col), z = *(const f32x4*)(w.proj + (size_t)r * w.ldp + C_Z + col);
            f32x4 y = yd + af * ef + ab * eb;
#pragma unroll
            for (int j = 0; j < 4; ++j) { y[j] *= silu_f(z[j]); ss += y[j] * y[j]; }
            gv[hh][pt] = y; } }
    ss += __shfl_xor(ss, 16); ss += __shfl_xor(ss, 32); const float rs = 1.0f / sqrtf(ss * (1.0f / SW) + EPS);
#pragma unroll
    for (int hh = 0; hh < SH; ++hh)
#pragma unroll
        for (int pt = 0; pt < 4; ++pt) { const int col = hh * SP + 16 * pt + 4 * fq; const f32x4 o = gv[hh][pt] * rs * *(const f32x4*)(p.ssd_norm_g + l * SW + col);
            u32x2 pk; pk.x = rw::pk2(o[0], o[1]); pk.y = rw::pk2(o[2], o[3]); *(u32x2*)(dst + (size_t)r * ldd + col) = pk; }
}
}

#ifndef CHECK_MLA
#define CHECK_MLA 0
#endif
#ifndef CHECK_SSD
#define CHECK_SSD 0
#endif
__device__ __forceinline__ int gtid() { int t = threadIdx.x; asm volatile("" : "+v"(t)); return blockIdx.x * 512 + t; }
template <int OP> __device__ __forceinline__ void run_op(const P& p, int l) {
    const long n = op_count(OP); const long stride = (long)gridDim.x * blockDim.x;
    for (long i = gtid(); i < n; i += stride) op_run(OP, p, l, i);
}
struct KArgs { P p; FW f; unsigned* bar; };
__device__ __forceinline__ const KArgs& kargs() { auto q = __builtin_amdgcn_kernarg_segment_ptr(); asm volatile("" : "+s"(q)); return *(const KArgs*)q; }
constexpr int LDS_BYTES = gm::STAGE_BYTES + 4096;
#define BAR() do { XcdBarrier b2_; b2_.bar = kargs().bar; unsigned xx_ = xbx; asm volatile("" : "+s"(xx_)); b2_.x = xx_; b2_.st = (volatile LAS unsigned*)(lds + LDS_BYTES - 16); xcd_barrier(b2_); } while (0)
#define PH(OPX) do { run_op<OPX>(kargs().p, lo()); BAR(); } while (0)
#define RUN(OPX) run_op<OPX>(kargs().p, lo())

__device__ __forceinline__ void attn_phase(const P& p, float* O, int ldo, char* lds) {
    constexpr int NQT = M / 256, NU = NH * NQT;
    for (int u = blockIdx.x; u < NU; u += gridDim.x) {
        const int hh = u / NQT, qt = u % NQT; const int seq = qt == 0 ? CTX : M;
        __syncthreads();
        at::attn_body(p.qb + (size_t)qt * 256 * at::LDQ + hh * at::DQ, p.kb + hh * at::DQ, p.vb + hh * at::DV, O + (size_t)qt * 256 * ldo + hh * at::DV, ldo, seq, lds);
    }
    __syncthreads();
}
template <class TA> __device__ __forceinline__ float ldf(const TA* a, size_t i);
template <> __device__ __forceinline__ float ldf<float>(const float* a, size_t i) { return a[i]; }
template <> __device__ __forceinline__ float ldf<bf16_t>(const bf16_t* a, size_t i) { return bf2f(a[i]); }
template <class TA, class TB> __device__ __forceinline__ void chk_accum(const TA* a, int lda, const TB* b, int ldb, long nrows, int ncols, float* diag) {
    float sd = 0.f, sr = 0.f; const long n = nrows * ncols; const long stride = (long)gridDim.x * blockDim.x;
    for (long i = gtid(); i < n; i += stride) { const long r = i / ncols; const int c = (int)(i % ncols);
        const float x = ldf<TA>(a, r * lda + c), y = ldf<TB>(b, r * ldb + c); sd += (x - y) * (x - y); sr += y * y; }
    for (int o = 32; o >= 1; o >>= 1) { sd += __shfl_xor(sd, o); sr += __shfl_xor(sr, o); }
    if ((threadIdx.x & 63) == 0) { atomicAdd(diag, sd); atomicAdd(diag + 1, sr); }
}
#define MLA_CALL(QB, KB, VB) { const int ll_ = lo(); ml::MW mw_; mw_.qb = (QB); mw_.kb = (KB); mw_.vb = (VB); mw_.w_uq_t = KF.w_uq_t + (size_t)ll_ * NH * QKD * QL; mw_.w_ukv_t = KF.w_ukv_t + (size_t)ll_ * NH * 128 * KVL; \
        mw_.ropec = KF.ropec; mw_.ropes = KF.ropes; mw_.proj = KP.proj; mw_.ldp = INC; ml::mla_phase(KP, mw_, ll_, lds); }
#if CHECK_MLA
#define MLA_STEP PH(OP_LATNORM); RUN(OP_QRAW); PH(OP_KVRAW); RUN(OP_QHEAD); RUN(OP_KHEAD); if (l == 0) { MLA_CALL(KF.qb2, KF.kb2, KF.vb2) } BAR(); \
        if (l == 0) { chk_accum<bf16_t, bf16_t>(KF.qb2, NH * QKD, KP.qb, NH * QKD, M, NH * QKD, KP.diag + 0); chk_accum<bf16_t, bf16_t>(KF.kb2, NH * QKD, KP.kb, NH * QKD, M, NH * QKD, KP.diag + 2); chk_accum<bf16_t, bf16_t>(KF.vb2, NH * VD, KP.vb, NH * VD, M, NH * VD, KP.diag + 4); }
#else
#define MLA_STEP MLA_CALL(KP.qb, KP.kb, KP.vb) BAR();
#endif
#define SSD_W(NAME) sd::SsdW NAME; NAME.proj = KP.proj; NAME.ldp = INC; NAME.yd = KF.yd2; NAME.st = KF.st2; NAME.cdec = KF.cdec2; NAME.cs = KF.cs2; NAME.cg = KF.cg; NAME.prevb = KF.prevb;
#define SSD_S1() { SSD_W(sw_) const int ll_ = lo(); for (int u = blockIdx.x; u < NCH * SH; u += gridDim.x) sd::chunk_unit(KP, sw_, ll_, u / SH, u % SH, lds); }
#define SSD_S2() { SSD_W(sw_) sd::carry_phase(sw_); }
#define SSD_S3(DST, LDD) { SSD_W(sw_) sd::final_phase(KP, sw_, lo(), (DST), (LDD)); }
#if CHECK_SSD
#define SSD_STEPS RUN(OP_CONV); RUN(OP_DT); PH(OP_POOLP); RUN(OP_SSD_CS); RUN(OP_SSD_G); PH(OP_POOLMM); attn_phase(KP, KP.mixin, MIXW, lds); RUN(OP_SSD_YD); PH(OP_SSD_ST); PH(OP_SSD_CARRY); PH(OP_SSD_YOFF); PH(OP_SSDFIN); \
        if (l == 0) { SSD_S1() BAR(); SSD_S2() BAR(); SSD_S3(KF.ssdb2, SW) BAR(); chk_accum<bf16_t, float>(KF.ssdb2, SW, KP.mixin + NH * VD, MIXW, M, SW, KP.diag + 0); } PH(OP_MIXB);
#else
#define SSD_STEPS RUN(OP_POOLP); SSD_S1() BAR(); RUN(OP_POOLMM); attn_phase(KP, KP.mixin, MIXW, lds); SSD_S2() BAR(); RUN(OP_MIXB); BAR(); SSD_S3(KP.mixb + NH * VD, MIXW) BAR();
#endif
#define LAYER_BODY(L) { const int l = (L); \
        auto lo = [&]() { int ll = l; asm volatile("" : "+s"(ll)); return ll; }; \
        if (blockIdx.x == 0 && threadIdx.x < NE) KP.cnt[threadIdx.x] = 0; \
        inproj_phase(KP, KF, lo(), KP.proj, lds); BAR(); \
        MLA_STEP \
        SSD_STEPS \
        outproj_phase<true>(KP, KF, lo(), KP.xres, lds); BAR(); \
        rw::router_phase(KP, lo(), lds); BAR(); \
        moe1_phase(KP, KF, lo(), lds); BAR(); moe2_phase(KP, KF, lo(), lds); BAR(); \
        rw::combine_phase(KP, lo()); BAR(); \
    }
__global__ void __launch_bounds__(512, 2) k_mega(KArgs a) {
    extern __shared__ __attribute__((aligned(16))) char lds[];
    uint4* xbw = (uint4*)(lds + LDS_BYTES - 16);
    if (threadIdx.x == 0) *xbw = make_uint4(0u, 0u, 0u, 0u);
    __syncthreads();
    const unsigned xbx = xcd_barrier_post(kargs().bar, (volatile LAS unsigned*)xbw).x;
#define KP kargs().p
#define KF kargs().f
    { const int l = 0; auto lo = [&]() { return l; }; if (blockIdx.x == 0 && threadIdx.x < 16) KP.diag[threadIdx.x] = 0.f; RUN(OP_MODVEC);
      cvt_phase(KP, KF, 0, DEPTH, lds); BAR(); rw::first_norm_phase(KP); BAR(); }
    LAYER_BODY(0) LAYER_BODY(1) LAYER_BODY(2) LAYER_BODY(3)
#if CHECK_MLA || CHECK_SSD
    {
        float e = 0.f;
        for (int c = 0; c < 3; ++c) { const float dn = KP.diag[2 * c + 1]; if (dn == 0.f && KP.diag[2 * c] == 0.f) continue; const float ec = sqrtf(KP.diag[2 * c] / dn); e = ec > e ? ec : e; if (!(ec == ec)) e = 1e3f; }
        const float sc = 1.0f + 10.0f * e; const long n = (long)SEQ * D; const long stride = (long)gridDim.x * blockDim.x;
        for (long i = gtid(); i < n; i += stride) KP.out[i] *= sc;
    }
#endif
#undef KP
#undef KF
}
static size_t carve(char*& cur, size_t bytes) { size_t a = (bytes + 255) & ~(size_t)255; cur += a; return a; }
static bool setup_params(P& p, FW& f, unsigned*& bar, void* const* d_in, void* d_out, void* d_ws, size_t ws_size) {
    const float** pp = (const float**)&p; for (int i = 0; i < 32; ++i) pp[i] = (const float*)d_in[i];
    p.out = (float*)d_out;
    char* cur = (char*)d_ws; char* base = cur;
    bar = (unsigned*)cur; carve(cur, XCD_BAR_WORDS * sizeof(unsigned));
#define CARVE(field, type, count) p.field = (type*)cur; carve(cur, (size_t)(count) * sizeof(type));
#define CARVEF(field, type, count) f.field = (type*)cur; carve(cur, (size_t)(count) * sizeof(type));
    CARVE(xres, float, (size_t)M * D) CARVE(mod, float, (size_t)DEPTH * 12 * D) CARVE(proj, float, (size_t)M * INC)
#if CHECK_MLA
    CARVE(qln, float, (size_t)M * QL) CARVE(kvln, float, (size_t)M * KVL) CARVE(qraw, float, (size_t)M * NH * QKD) CARVE(kvraw, float, (size_t)M * NH * 128) CARVE(q, float, (size_t)M * NH * QKD) CARVE(k, float, (size_t)M * NH * QKD) CARVE(v, float, (size_t)M * NH * VD)
    CARVEF(qb2, bf16_t, (size_t)M * NH * QKD) CARVEF(kb2, bf16_t, (size_t)M * NH * QKD) CARVEF(vb2, bf16_t, (size_t)M * NH * VD)
#endif
    CARVE(mixin, float, (size_t)M * MIXW) CARVE(xbc, float, (size_t)M * CONVD) CARVE(dt, float, (size_t)M * 12) CARVE(ydir, float, (size_t)2 * M * SW)
    CARVE(poolp, float, (size_t)M * PW) CARVE(topw, float, (size_t)M * 4)
    CARVE(topi, int, (size_t)M * 4) CARVE(cnt, int, NE) CARVE(list, int, (size_t)NE * M)
    CARVE(qb, bf16_t, (size_t)M * NH * QKD) CARVE(kb, bf16_t, (size_t)M * NH * QKD) CARVE(vb, bf16_t, (size_t)M * NH * VD) CARVE(diag, float, 64)
    CARVE(cs, float, (size_t)2 * M * SH) CARVE(cdec, float, (size_t)2 * NCH * SH) CARVE(gmat, float, (size_t)M * SG * CHUNK) CARVE(st, float, (size_t)2 * NCH * SH * SP * SN)
    CARVE(hb1, bf16_t, (size_t)M * D) CARVE(hb2, bf16_t, (size_t)M * D) CARVE(mixb, bf16_t, (size_t)M * MIXW)
    CARVEF(actb, bf16_t, (size_t)4 * M * FF) CARVEF(yb, bf16_t, (size_t)4 * M * D)
    f.hb1 = p.hb1; f.hb2 = p.hb2; f.mixb = p.mixb; p.ybn = f.yb; p.attf = nullptr;
    const int nl = DEPTH;
    CARVEF(w_uq_t, bf16_t, (size_t)nl * NH * QKD * QL) CARVEF(w_ukv_t, bf16_t, (size_t)nl * NH * 128 * KVL) CARVEF(ropec, float, 256 * 8) CARVEF(ropes, float, 256 * 8)
    CARVEF(yd2, float, (size_t)M * SW) CARVEF(st2, float, (size_t)2 * NCH * SH * SP * SN) CARVEF(cdec2, float, (size_t)2 * NCH * SH) CARVEF(cs2, float, (size_t)2 * M * SH)
    CARVEF(cg, bf16_t, (size_t)M * SG * SN) CARVEF(prevb, bf16_t, (size_t)2 * NCH * SH * SP * SN) CARVEF(ssdb2, bf16_t, (size_t)M * SW)
    CARVEF(w_in_t, bf16_t, (size_t)nl * INC_PAD * D) CARVEF(w_out_t, bf16_t, (size_t)nl * D * MIXW) CARVEF(gu_t, bf16_t, (size_t)nl * NE * 2 * FF * D) CARVEF(d_t, bf16_t, (size_t)nl * NE * D * FF)
    p.act = nullptr; p.down = nullptr; f.proj2 = nullptr; f.mix2 = nullptr;
#undef CARVE
#undef CARVEF
    if (getenv("KDEBUG")) fprintf(stderr, "ws used %zu of %zu\n", (size_t)(cur - base), ws_size);
    return (size_t)(cur - base) <= ws_size;
}
extern "C" void kernel_launch(void* const* d_in, const int* in_sizes, int n_in, void* d_out, int out_size, void* d_ws, size_t ws_size, hipStream_t stream) {
    KArgs a{};
    if (n_in < 32 || !setup_params(a.p, a.f, a.bar, d_in, d_out, d_ws, ws_size)) return;
    static int grid = 0;
    if (!grid) { int dev = 0, cus = 0, per_cu = 0; (void)hipGetDevice(&dev); (void)hipDeviceGetAttribute(&cus, hipDeviceAttributeMultiprocessorCount, dev);
        (void)hipFuncSetAttribute((const void*)k_mega, hipFuncAttributeMaxDynamicSharedMemorySize, LDS_BYTES);
        (void)hipOccupancyMaxActiveBlocksPerMultiprocessor(&per_cu, k_mega, 512, LDS_BYTES); grid = cus * (per_cu < 1 ? per_cu : 1); }
    if (grid <= 0) return;
    (void)hipMemsetAsync(a.bar, 0, XCD_BAR_WORDS * sizeof(unsigned), stream);
    hipLaunchKernelGGL(k_mega, dim3(grid), dim3(512), LDS_BYTES, stream, a);
}
```

```cpp
#include <hip/hip_runtime.h>
#include <stdint.h>
#include <stdlib.h>
#include <stdio.h>

#ifndef NAIVE_H
#define NAIVE_H
#include <math.h>
#ifdef HOST_TEST
#define HD inline
#define HDC inline
#define ATOMIC_INC(p) ((*(p))++)
#define UNIFORM(x) (x)
#else
#define HD __device__ __forceinline__
#define HDC __host__ __device__ __forceinline__
#define ATOMIC_INC(p) atomicAdd((p), 1)
#define UNIFORM(x) __builtin_amdgcn_readfirstlane(x)
#endif

#ifndef CFG_D
#define CFG_D 1024
#define CFG_SEQ 16384
#define CFG_CTX 256
#define CFG_FF 1024
#define CFG_DEPTH 4
#endif
constexpr int D = CFG_D, SEQ = CFG_SEQ, CTX = CFG_CTX, FF = CFG_FF, DEPTH = CFG_DEPTH;
constexpr int M = CTX + SEQ;
constexpr int GRID_W = 64;
constexpr int NH = 6, QKD = 96, NOPE = 64, ROPE = 32, VD = 64, QL = 256, KVL = 128;
constexpr int SH = 6, SP = 64, SW = 384, SG = 2, SN = 64, CONVD = 640, CHUNK = 128;
constexpr int PW = 256, MIXW = 1024, INC = 1708;
constexpr int C_Q = 0, C_KV = 256, C_KR = 384, C_Z = 416, C_XBC = 800, C_DT = 1440, C_POOL = 1452;
constexpr int NE = 32, TOPK = 4;
constexpr int NCH = M / CHUNK;
constexpr float EPS = 1e-6f;

typedef unsigned short bf16_t;
HD bf16_t f2bf(float f) { union { float f; unsigned u; } v; v.f = f; unsigned u = v.u; u += 0x7FFFu + ((u >> 16) & 1u); return (bf16_t)(u >> 16); }
HD float bf2f(bf16_t b) { union { float f; unsigned u; } v; v.u = ((unsigned)b) << 16; return v.f; }
struct P {
    const float *x, *c, *ctx, *c_ctx, *norm1_g, *norm2_g, *mod_w, *mod_b, *w_in, *q_g, *kv_g, *w_uq, *w_ukv, *qn_g, *kn_g;
    const float *conv_w, *conv_b, *a_log, *dt_bias, *ssd_d, *ssd_norm_g, *pool_w, *pool_scale, *w_out, *router_w, *router_b;
    const float *wg, *bg, *wu, *bu, *wd, *bd;
    float* out;
    float *xres, *mod, *rs, *h, *proj, *qln, *kvln, *qraw, *kvraw, *q, *k, *v, *mixin, *xbc, *dt, *ydir, *poolp, *mix, *logits, *topw, *act, *down;
    int *topi, *cnt, *list;
    bf16_t *qb, *kb, *vb;
    float *attf, *diag;
    float *cs, *cdec, *gmat, *st;
    bf16_t *hb1, *hb2, *mixb, *ybn;
};

HD float siluf(float x) { return x / (1.0f + expf(-x)); }
HD float sigmf(float x) { return 1.0f / (1.0f + expf(-x)); }
HD float softplusf(float x) { return x > 20.0f ? x : log1pf(expf(x)); }
HD const float* modv(const P& p, int l, int r, int j) { return p.mod + ((size_t)(l * 2 + (r < CTX ? 1 : 0)) * 6 + j) * D; }

enum { OP_COPY_IN = 0, OP_MODVEC, OP_ROWSTAT, OP_NORM1, OP_INPROJ, OP_LATNORM, OP_QRAW, OP_KVRAW, OP_QHEAD, OP_KHEAD, OP_ATTN, OP_CONV, OP_DT, OP_SSDSCAN, OP_SSDFIN,
       OP_POOLP, OP_POOLMM, OP_OUTPROJ, OP_RES1, OP_NORM2, OP_LOGITS, OP_ZEROCNT, OP_TOPK, OP_GATEUP, OP_DOWN, OP_COMBINE, OP_WRITE_OUT, OP_MIXB, OP_COMBINE2, OP_SSD_CS, OP_SSD_G, OP_SSD_YD, OP_SSD_ST, OP_SSD_CARRY, OP_SSD_YOFF, OP_COUNT };

HDC long op_count(int op) {
    switch (op) {
        case OP_COPY_IN: return (long)M * D;
        case OP_MODVEC: return (long)DEPTH * 2 * 6 * D;
        case OP_ROWSTAT: return M;
        case OP_NORM1: case OP_NORM2: return (long)M * D;
        case OP_INPROJ: return (long)(M / 8) * INC;
        case OP_LATNORM: return 2L * M;
        case OP_QRAW: return (long)(M / 8) * (NH * QKD);
        case OP_KVRAW: return (long)(M / 8) * (NH * 128);
        case OP_QHEAD: case OP_KHEAD: return (long)M * NH;
        case OP_ATTN: return (long)M * NH;
        case OP_CONV: return (long)M * CONVD;
        case OP_DT: return (long)M * 12;
        case OP_SSDSCAN: return 2L * SH * SP;
        case OP_SSDFIN: return M;
        case OP_POOLP: return (long)M * PW;
        case OP_POOLMM: return (long)M * PW;
        case OP_OUTPROJ: return (long)(M / 8) * D;
        case OP_RES1: return (long)M * D;
        case OP_LOGITS: return (long)M * NE;
        case OP_ZEROCNT: return NE;
        case OP_TOPK: return M;
        case OP_GATEUP: return (long)NE * (M / 8) * FF;
        case OP_DOWN: return (long)NE * (M / 8) * D;
        case OP_COMBINE: return (long)M * D;
        case OP_WRITE_OUT: return (long)SEQ * D;
        case OP_MIXB: return (long)M * MIXW;
        case OP_COMBINE2: return (long)M * D;
        case OP_SSD_CS: return 2L * NCH * SH;
        case OP_SSD_G: return (long)M * SG * CHUNK;
        case OP_SSD_YD: return (long)M * SW;
        case OP_SSD_ST: return 2L * NCH * SH * SP * SN;
        case OP_SSD_CARRY: return 2L * SH * SP * SN;
        case OP_SSD_YOFF: return (long)M * SW;
    }
    return 0;
}

HD void gemm8(const float* A, int lda, const float* B, int ldb, const float* bias, float* C, int ldc, int N, int K, long idx) {
    const int j = (int)(idx % N); const long r0 = (idx / N) * 8;
    float acc[8];
#pragma unroll
    for (int i = 0; i < 8; ++i) acc[i] = 0.f;
    const float* a = A + r0 * lda;
    for (int k = 0; k < K; ++k) {
        const float b = B[(size_t)k * ldb + j];
#pragma unroll
        for (int i = 0; i < 8; ++i) acc[i] += a[(size_t)i * lda + k] * b;
    }
    const float bv = bias ? bias[j] : 0.f;
#pragma unroll
    for (int i = 0; i < 8; ++i) C[(r0 + i) * ldc + j] = acc[i] + bv;
}

HD void sincos_rr(float angf, float& cs, float& sn) {
    const double x = (double)angf; const double n = rint(x * 0.63661977236758134308); const double y = (x - n * 1.57079632679489655800) - n * 6.123233995736766e-17; const double y2 = y * y;
    const double s = y * (1.0 + y2 * (-1.0 / 6 + y2 * (1.0 / 120 + y2 * (-1.0 / 5040 + y2 * (1.0 / 362880 + y2 * (-1.0 / 39916800))))));
    const double c = 1.0 + y2 * (-0.5 + y2 * (1.0 / 24 + y2 * (-1.0 / 720 + y2 * (1.0 / 40320 + y2 * (-1.0 / 3628800 + y2 * (1.0 / 479001600))))));
    const int q = ((int)n) & 3; const double cc = (q == 0) ? c : (q == 1) ? -s : (q == 2) ? -c : s; const double ss = (q == 0) ? s : (q == 1) ? c : (q == 2) ? -s : -c;
    cs = (float)cc; sn = (float)ss;
}
HD float rope_inv_freq(int f) { return f == 0 ? 1.0f : f == 1 ? 0.31622776f : f == 2 ? 0.1f : f == 3 ? 0.031622775f : f == 4 ? 0.01f : f == 5 ? 0.0031622776f : f == 6 ? 0.001f : 0.00031622776f; }
HD void rope_apply(float* v32, int t) {
    const float row = (float)(t / GRID_W), col = (float)(t % GRID_W);
#pragma unroll
    for (int a = 0; a < 2; ++a)
#pragma unroll
        for (int f = 0; f < 8; ++f) {
            const float ang = (a == 0 ? row : col) * rope_inv_freq(f);
            float cs, sn; sincos_rr(ang, cs, sn);
            const float x1 = v32[a * 16 + f], x2 = v32[a * 16 + 8 + f];
            v32[a * 16 + f] = x1 * cs - x2 * sn; v32[a * 16 + 8 + f] = x2 * cs + x1 * sn;
        }
}

HD void op_run(int op, const P& p, int l, long idx) {
    switch (op) {
    case OP_COPY_IN: { const long r = idx / D; const int c = (int)(idx % D); p.xres[idx] = r < CTX ? p.ctx[idx] : p.x[(r - CTX) * D + c]; } break;
    case OP_MODVEC: {
        const int j = (int)(idx % (6 * D)); const int which = (int)((idx / (6 * D)) % 2); const int ll = (int)(idx / (12 * D));
        const float* cv = which ? p.c_ctx : p.c; float s = 0.f;
        for (int k = 0; k < D; ++k) s += siluf(cv[k]) * p.mod_w[((size_t)ll * D + k) * (6 * D) + j];
        p.mod[idx] = s + p.mod_b[(size_t)ll * 6 * D + j];
    } break;
    case OP_ROWSTAT: { const float* xr = p.xres + idx * D; float s = 0.f; for (int k = 0; k < D; ++k) s += xr[k] * xr[k]; p.rs[idx] = 1.0f / sqrtf(s / D + EPS); } break;
    case OP_NORM1: case OP_NORM2: { const int r = (int)(idx / D), c = (int)(idx % D); const int o = op == OP_NORM1 ? 0 : 3;
        const float g = (op == OP_NORM1 ? p.norm1_g : p.norm2_g)[l * D + c];
        const float hv = p.xres[idx] * p.rs[r] * g * (1.0f + modv(p, l, r, o + 1)[c]) + modv(p, l, r, o)[c]; p.h[idx] = hv;
        bf16_t* hb = op == OP_NORM1 ? p.hb1 : p.hb2; if (hb) hb[idx] = f2bf(hv); } break;
    case OP_INPROJ: gemm8(p.h, D, p.w_in + (size_t)l * D * INC, INC, nullptr, p.proj, INC, INC, D, idx); break;
    case OP_LATNORM: {
        const int which = idx >= M; const long r = which ? idx - M : idx; const int n = which ? KVL : QL; const float* src = p.proj + r * INC + (which ? C_KV : C_Q);
        float s = 0.f; for (int k = 0; k < n; ++k) s += src[k] * src[k]; const float rs = 1.0f / sqrtf(s / n + EPS);
        float* dst = which ? p.kvln + r * KVL : p.qln + r * QL; const float* g = which ? p.kv_g + l * KVL : p.q_g + l * QL;
        for (int k = 0; k < n; ++k) dst[k] = src[k] * rs * g[k];
    } break;
    case OP_QRAW: gemm8(p.qln, QL, p.w_uq + (size_t)l * QL * (NH * QKD), NH * QKD, nullptr, p.qraw, NH * QKD, NH * QKD, QL, idx); break;
    case OP_KVRAW: gemm8(p.kvln, KVL, p.w_ukv + (size_t)l * KVL * (NH * 128), NH * 128, nullptr, p.kvraw, NH * 128, NH * 128, KVL, idx); break;
    case OP_QHEAD: { const int r = (int)(idx / NH), hh = (int)(idx % NH); const float* src = p.qraw + (size_t)r * (NH * QKD) + hh * QKD; float s = 0.f;
        for (int d = 0; d < QKD; ++d) s += src[d] * src[d]; const float rs = 1.0f / sqrtf(s / QKD + EPS);
        float* dst = p.q + ((size_t)r * NH + hh) * QKD; float rp[32];
        for (int d = 0; d < NOPE; ++d) dst[d] = src[d] * rs * p.qn_g[l * QKD + d];
#pragma unroll
        for (int d = 0; d < 32; ++d) rp[d] = src[NOPE + d] * rs * p.qn_g[l * QKD + NOPE + d];
        if (r >= CTX) rope_apply(rp, r - CTX);
#pragma unroll
        for (int d = 0; d < 32; ++d) dst[NOPE + d] = rp[d];
        bf16_t* db = p.qb + ((size_t)r * NH + hh) * QKD;
        for (int d = 0; d < QKD; ++d) db[d] = f2bf(dst[d]);
    } break;
    case OP_KHEAD: { const int r = (int)(idx / NH), hh = (int)(idx % NH); const float* kn = p.kvraw + (size_t)r * (NH * 128) + hh * 128; const float* kr = p.proj + (size_t)r * INC + C_KR; float s = 0.f;
        for (int d = 0; d < NOPE; ++d) s += kn[d] * kn[d];
        for (int d = 0; d < ROPE; ++d) s += kr[d] * kr[d];
        const float rs = 1.0f / sqrtf(s / QKD + EPS);
        float* dst = p.k + ((size_t)r * NH + hh) * QKD; float rp[32];
        for (int d = 0; d < NOPE; ++d) dst[d] = kn[d] * rs * p.kn_g[l * QKD + d];
#pragma unroll
        for (int d = 0; d < 32; ++d) rp[d] = kr[d] * rs * p.kn_g[l * QKD + NOPE + d];
        if (r >= CTX) rope_apply(rp, r - CTX);
#pragma unroll
        for (int d = 0; d < 32; ++d) dst[NOPE + d] = rp[d];
        float* vd = p.v + ((size_t)r * NH + hh) * VD;
        for (int d = 0; d < VD; ++d) vd[d] = kn[NOPE + d];
        bf16_t* db = p.kb + ((size_t)r * NH + hh) * QKD; bf16_t* vdb = p.vb + ((size_t)r * NH + hh) * VD;
        for (int d = 0; d < QKD; ++d) db[d] = f2bf(dst[d]);
        for (int d = 0; d < VD; ++d) vdb[d] = f2bf(kn[NOPE + d]);
    } break;
    case OP_ATTN: {
        const int r = (int)(idx % M), hh = UNIFORM((int)(idx / M)); const int nk = r < CTX ? CTX : M;
        float qv[QKD];
        const float* qp = p.q + ((size_t)r * NH + hh) * QKD; const float scale = 1.0f / sqrtf((float)QKD);
#pragma unroll
        for (int d = 0; d < QKD; ++d) qv[d] = qp[d] * scale;
        for (int half = 0; half < 2; ++half) {
            float o[32];
#pragma unroll
            for (int d = 0; d < 32; ++d) o[d] = 0.f;
            float mx = -1e30f, lsum = 0.f;
            for (int kk = 0; kk < nk; ++kk) {
                const float* kp = p.k + ((size_t)kk * NH + hh) * QKD; const float* vp = p.v + ((size_t)kk * NH + hh) * VD + half * 32; float s = 0.f;
#pragma unroll
                for (int d = 0; d < QKD; ++d) s += qv[d] * kp[d];
                const float mn = s > mx ? s : mx; const float corr = expf(mx - mn), pe = expf(s - mn);
                lsum = lsum * corr + pe; mx = mn;
#pragma unroll
                for (int d = 0; d < 32; ++d) o[d] = o[d] * corr + pe * vp[d];
            }
            const float inv = 1.0f / lsum; float* dst = p.mixin + (size_t)r * MIXW + hh * VD + half * 32;
#pragma unroll
            for (int d = 0; d < 32; ++d) dst[d] = o[d] * inv;
        }
    } break;
    case OP_CONV: { const int r = (int)(idx / CONVD), c = (int)(idx % CONVD); const int seg0 = r < CTX ? 0 : CTX, n = r < CTX ? CTX : SEQ, t = r - seg0; float y = p.conv_b[l * CONVD + c];
#pragma unroll
        for (int j = 0; j < 4; ++j) { const int tt = t - 2 + j; if (tt >= 0 && tt < n) y += p.conv_w[((size_t)l * 4 + j) * CONVD + c] * p.proj[(size_t)(seg0 + tt) * INC + C_XBC + c]; }
        p.xbc[idx] = siluf(y); } break;
    case OP_DT: { const int r = (int)(idx / 12), j = (int)(idx % 12); p.dt[idx] = softplusf(p.proj[(size_t)r * INC + C_DT + j] + p.dt_bias[l * 12 + j]); } break;
    case OP_SSDSCAN: {
        const int pp = (int)(idx % SP), hh = UNIFORM((int)((idx / SP) % SH)), dir = UNIFORM((int)(idx / (SP * SH))); const int g = hh / (SH / SG);
        const float a = -expf(p.a_log[l * 12 + dir * 6 + hh]); float st[SN];
#pragma unroll
        for (int n = 0; n < SN; ++n) st[n] = 0.f;
        for (int step = 0; step < M; ++step) {
            const int r = dir == 0 ? step : (step < CTX ? CTX - 1 - step : M - 1 - (step - CTX));
            const float dtv = p.dt[(size_t)r * 12 + dir * 6 + hh]; const float dA = expf(dtv * a); const float xv = p.xbc[(size_t)r * CONVD + hh * SP + pp] * dtv;
            const float* Bp = p.xbc + (size_t)r * CONVD + SW + g * SN; const float* Cp = p.xbc + (size_t)r * CONVD + SW + SG * SN + g * SN; float y = 0.f;
#pragma unroll
            for (int n = 0; n < SN; ++n) { st[n] = st[n] * dA + xv * Bp[n]; y += st[n] * Cp[n]; }
            p.ydir[((size_t)dir * M + r) * SW + hh * SP + pp] = y;
        }
    } break;
    case OP_SSDFIN: { const long r = idx; float ss = 0.f;
        for (int c = 0; c < SW; ++c) { const float y = p.ydir[r * SW + c] + p.ydir[((size_t)M + r) * SW + c] + p.ssd_d[l * SH + c / SP] * p.xbc[r * CONVD + c]; const float gv = y * siluf(p.proj[r * INC + C_Z + c]); ss += gv * gv; }
        const float rs = 1.0f / sqrtf(ss / SW + EPS);
        for (int c = 0; c < SW; ++c) { const float y = p.ydir[r * SW + c] + p.ydir[((size_t)M + r) * SW + c] + p.ssd_d[l * SH + c / SP] * p.xbc[r * CONVD + c]; const float gv = y * siluf(p.proj[r * INC + C_Z + c]);
            p.mixin[r * MIXW + NH * VD + c] = gv * rs * p.ssd_norm_g[l * SW + c]; }
    } break;
    case OP_POOLP: { const int r = (int)(idx / PW), c = (int)(idx % PW); const int gi = c / 64; const int win = 2 << gi; const int seg0 = r < CTX ? 0 : CTX, n = r < CTX ? CTX : SEQ, t = r - seg0;
        int lo = t - win / 2, hi = t - win / 2 + win; lo = lo < 0 ? 0 : lo; hi = hi > n ? n : hi; float s = 0.f;
        for (int tt = lo; tt < hi; ++tt) s += p.proj[(size_t)(seg0 + tt) * INC + C_POOL + c];
        p.poolp[idx] = s / (float)(hi - lo) - p.proj[(size_t)r * INC + C_POOL + c]; } break;
    case OP_POOLMM: { const int r = (int)(idx / PW), c = (int)(idx % PW); const int gi = c / 64, d = c % 64; float s = 0.f;
        for (int cc = 0; cc < 64; ++cc) s += p.poolp[(size_t)r * PW + gi * 64 + cc] * p.pool_w[(((size_t)l * 4 + gi) * 64 + cc) * 64 + d];
        p.mixin[(size_t)r * MIXW + NH * VD + SW + c] = s * p.pool_scale[l * PW + c]; } break;
    case OP_OUTPROJ: gemm8(p.mixin, MIXW, p.w_out + (size_t)l * MIXW * D, D, nullptr, p.mix, D, D, MIXW, idx); break;
    case OP_RES1: { const int r = (int)(idx / D), c = (int)(idx % D); p.xres[idx] += modv(p, l, r, 2)[c] * p.mix[idx]; } break;
    case OP_LOGITS: { const int r = (int)(idx / NE), e = (int)(idx % NE); const float* hr = p.h + (size_t)r * D; float s = 0.f;
        for (int k = 0; k < D; ++k) s += hr[k] * p.router_w[((size_t)l * D + k) * NE + e];
        p.logits[idx] = s + p.router_b[l * NE + e]; } break;
    case OP_ZEROCNT: p.cnt[idx] = 0; break;
    case OP_TOPK: { const long t = idx; float lg[NE];
#pragma unroll
        for (int e = 0; e < NE; ++e) lg[e] = p.logits[t * NE + e];
        int sel[4]; float sv[4];
#pragma unroll
        for (int kk = 0; kk < 4; ++kk) { float best = -3.0e38f; int bi = 0;
#pragma unroll
            for (int e = 0; e < NE; ++e) { bool taken = false;
#pragma unroll
                for (int q = 0; q < kk; ++q) taken = taken || (sel[q] == e);
                if (!taken && lg[e] > best) { best = lg[e]; bi = e; } }
            sel[kk] = bi; sv[kk] = best; }
        float es[4], sum = 0.f;
#pragma unroll
        for (int kk = 0; kk < 4; ++kk) { es[kk] = expf(sv[kk] - sv[0]); sum += es[kk]; }
#pragma unroll
        for (int kk = 0; kk < 4; ++kk) { p.topi[t * 4 + kk] = sel[kk]; p.topw[t * 4 + kk] = es[kk] / sum; const int pos = ATOMIC_INC(&p.cnt[sel[kk]]); p.list[(size_t)sel[kk] * M + pos] = (int)(t * 4 + kk); }
    } break;
    case OP_GATEUP: {
        const int j = (int)(idx % FF); const long rest = idx / FF; const int rb = (int)(rest % (M / 8)), e = (int)(rest / (M / 8)); const int cnt = p.cnt[e]; if (rb * 8 >= cnt) break;
        int a[8]; float g[8], u[8];
#pragma unroll
        for (int i = 0; i < 8; ++i) { a[i] = rb * 8 + i < cnt ? p.list[(size_t)e * M + rb * 8 + i] : -1; g[i] = 0.f; u[i] = 0.f; }
        const float* wgp = p.wg + ((size_t)l * NE + e) * D * FF + j; const float* wup = p.wu + ((size_t)l * NE + e) * D * FF + j;
        for (int k = 0; k < D; ++k) { const float gw = wgp[(size_t)k * FF], uw = wup[(size_t)k * FF];
#pragma unroll
            for (int i = 0; i < 8; ++i) { const float xv = p.h[(size_t)(a[i] < 0 ? 0 : a[i] / 4) * D + k]; g[i] += xv * gw; u[i] += xv * uw; } }
        const float bgv = p.bg[((size_t)l * NE + e) * FF + j], buv = p.bu[((size_t)l * NE + e) * FF + j];
#pragma unroll
        for (int i = 0; i < 8; ++i) if (a[i] >= 0) { float gv = g[i] + bgv; gv = gv < 7.0f ? gv : 7.0f; float uv = u[i] + buv; uv = uv < -7.0f ? -7.0f : (uv > 7.0f ? 7.0f : uv);
            p.act[(size_t)a[i] * FF + j] = gv * sigmf(1.702f * gv) * (uv + 1.0f); }
    } break;
    case OP_DOWN: {
        const int j = (int)(idx % D); const long rest = idx / D; const int rb = (int)(rest % (M / 8)), e = (int)(rest / (M / 8)); const int cnt = p.cnt[e]; if (rb * 8 >= cnt) break;
        int a[8]; float o[8];
#pragma unroll
        for (int i = 0; i < 8; ++i) { a[i] = rb * 8 + i < cnt ? p.list[(size_t)e * M + rb * 8 + i] : -1; o[i] = 0.f; }
        const float* wdp = p.wd + ((size_t)l * NE + e) * FF * D + j;
        for (int k = 0; k < FF; ++k) { const float w = wdp[(size_t)k * D];
#pragma unroll
            for (int i = 0; i < 8; ++i) o[i] += p.act[(size_t)(a[i] < 0 ? 0 : a[i]) * FF + k] * w; }
        const float bv = p.bd[((size_t)l * NE + e) * D + j];
#pragma unroll
        for (int i = 0; i < 8; ++i) if (a[i] >= 0) p.down[(size_t)a[i] * D + j] = o[i] + bv;
    } break;
    case OP_COMBINE: { const int r = (int)(idx / D), c = (int)(idx % D); float s = 0.f;
#pragma unroll
        for (int kk = 0; kk < 4; ++kk) s += p.topw[(size_t)r * 4 + kk] * p.down[((size_t)r * 4 + kk) * D + c];
        p.xres[idx] += modv(p, l, r, 5)[c] * s; } break;
    case OP_WRITE_OUT: p.out[idx] = p.xres[(size_t)CTX * D + idx]; break;
    case OP_MIXB: p.mixb[idx] = f2bf(p.mixin[idx]); break;
    case OP_SSD_CS: {
        const int hh = (int)(idx % SH), c = (int)((idx / SH) % NCH), dir = (int)(idx / (SH * NCH)); const float a = -expf(p.a_log[l * 12 + dir * 6 + hh]); float acc = 0.f;
        for (int i = 0; i < CHUNK; ++i) { const int r = c * CHUNK + (dir == 0 ? i : CHUNK - 1 - i); acc += p.dt[(size_t)r * 12 + dir * 6 + hh] * a; p.cs[((size_t)dir * M + r) * SH + hh] = acc; }
        p.cdec[idx] = expf(acc);
    } break;
    case OP_SSD_G: {
        const int s = (int)(idx % CHUNK), g = (int)((idx / CHUNK) % SG), r = (int)(idx / (CHUNK * SG)); const int r2 = (r / CHUNK) * CHUNK + s;
        const float* Cp = p.xbc + (size_t)r * CONVD + SW + SG * SN + g * SN; const float* Bp = p.xbc + (size_t)r2 * CONVD + SW + g * SN; float acc = 0.f;
        for (int n = 0; n < SN; ++n) acc += Cp[n] * Bp[n];
        p.gmat[idx] = acc;
    } break;
    case OP_SSD_YD: {
        const int cc = (int)(idx % SW), r = (int)(idx / SW); const int hh = cc / SP, g = hh / (SH / SG); const int c0 = (r / CHUNK) * CHUNK, lpos = r - c0;
        const float* G = p.gmat + ((size_t)r * SG + g) * CHUNK; const float csf = p.cs[(size_t)r * SH + hh], csb = p.cs[((size_t)M + r) * SH + hh]; float y = 0.f;
        for (int s = 0; s <= lpos; ++s) { const int r2 = c0 + s; y += G[s] * expf(csf - p.cs[(size_t)r2 * SH + hh]) * p.dt[(size_t)r2 * 12 + hh] * p.xbc[(size_t)r2 * CONVD + cc]; }
        for (int s = lpos; s < CHUNK; ++s) { const int r2 = c0 + s; y += G[s] * expf(csb - p.cs[((size_t)M + r2) * SH + hh]) * p.dt[(size_t)r2 * 12 + 6 + hh] * p.xbc[(size_t)r2 * CONVD + cc]; }
        p.ydir[idx] = y;
    } break;
    case OP_SSD_ST: {
        const int n = (int)(idx % SN), pp = (int)((idx / SN) % SP), hh = (int)((idx / (SN * SP)) % SH), c = (int)((idx / (SN * SP * SH)) % NCH), dir = (int)(idx / ((long)SN * SP * SH * NCH)); const int g = hh / (SH / SG);
        const int rend = c * CHUNK + (dir == 0 ? CHUNK - 1 : 0); const float cse = p.cs[((size_t)dir * M + rend) * SH + hh]; float acc = 0.f;
        for (int i = 0; i < CHUNK; ++i) { const int r = c * CHUNK + i; acc += p.xbc[(size_t)r * CONVD + SW + g * SN + n] * expf(cse - p.cs[((size_t)dir * M + r) * SH + hh]) * p.dt[(size_t)r * 12 + dir * 6 + hh] * p.xbc[(size_t)r * CONVD + hh * SP + pp]; }
        p.st[idx] = acc;
    } break;
    case OP_SSD_CARRY: {
        const int e = (int)(idx % (SP * SN)), hh = (int)((idx / (SP * SN)) % SH), dir = (int)(idx / ((long)SP * SN * SH)); float state = 0.f;
        for (int i = 0; i < NCH; ++i) { const int c = dir == 0 ? i : (i < CTX / CHUNK ? CTX / CHUNK - 1 - i : NCH - 1 - (i - CTX / CHUNK));
            const size_t o = (((size_t)dir * NCH + c) * SH + hh) * (SP * SN) + e; const float stc = p.st[o]; p.st[o] = state; state = state * p.cdec[((size_t)dir * NCH + c) * SH + hh] + stc; }
    } break;
    case OP_SSD_YOFF: {
        const int cc = (int)(idx % SW), r = (int)(idx / SW); const int hh = cc / SP, pp = cc % SP, g = hh / (SH / SG), c = r / CHUNK; const float* Cp = p.xbc + (size_t)r * CONVD + SW + SG * SN + g * SN;
        float y = 0.f;
#pragma unroll
        for (int dir = 0; dir < 2; ++dir) { const float* pv = p.st + ((((size_t)dir * NCH + c) * SH + hh) * SP + pp) * SN; float acc = 0.f;
            for (int n = 0; n < SN; ++n) acc += Cp[n] * pv[n];
            y += acc * expf(p.cs[((size_t)dir * M + r) * SH + hh]); }
        p.ydir[(size_t)M * SW + idx] = y;
    } break;
    case OP_COMBINE2: { const int r = (int)(idx / D), c = (int)(idx % D); float s = 0.f;
#pragma unroll
        for (int kk = 0; kk < 4; ++kk) s += p.topw[(size_t)r * 4 + kk] * bf2f(p.ybn[((size_t)r * 4 + kk) * D + c]);
        p.xres[idx] += modv(p, l, r, 5)[c] * s; } break;
    }
}

static const int LAYER_OPS[] = { OP_ROWSTAT, OP_NORM1, OP_INPROJ, OP_LATNORM, OP_QRAW, OP_KVRAW, OP_QHEAD, OP_KHEAD, OP_ATTN, OP_CONV, OP_DT, OP_SSDSCAN, OP_SSDFIN, OP_POOLP, OP_POOLMM,
                                 OP_OUTPROJ, OP_RES1, OP_ROWSTAT, OP_NORM2, OP_LOGITS, OP_ZEROCNT, OP_TOPK, OP_GATEUP, OP_DOWN, OP_COMBINE };
constexpr int N_LAYER_OPS = sizeof(LAYER_OPS) / sizeof(int);
#endif

#define XB_TMO      128
#define XB_XCNT(j)  (256  + 64 * (j))
#define XB_XSUB(j)  (1280 + 64 * (j))
#define XB_XGEN(j)  (2304 + 64 * (j))
#define XB_TOP      3328
#define XB_TOPGEN   3392
#define XCD_BAR_WORDS 3456
#define XB_SPIN_CAP (1u << 22)
#define LAS __attribute__((address_space(3)))

__device__ __forceinline__ unsigned xb_ld(unsigned* p)              { return __hip_atomic_load(p, __ATOMIC_RELAXED, __HIP_MEMORY_SCOPE_AGENT); }
__device__ __forceinline__ unsigned xb_add(unsigned* p, unsigned v) { return __hip_atomic_fetch_add(p, v, __ATOMIC_RELAXED, __HIP_MEMORY_SCOPE_AGENT); }
__device__ __forceinline__ unsigned xb_xcc_id() { return (unsigned)__builtin_amdgcn_s_getreg((3 << 11) | 20) & 0xFu; }
#define XB_SPIN(cond, bar) do { unsigned _sp = 0; while (cond) { __builtin_amdgcn_s_sleep(1); \
    if ((++_sp & 255u) == 0u) { if (xb_ld(&(bar)[XB_TMO])) break; if (_sp > XB_SPIN_CAP) { atomicAdd(&(bar)[XB_TMO], 1u); break; } } } } while (0)

struct XcdBarrier {
    unsigned* bar; unsigned x;
    volatile LAS unsigned* st;
};

__device__ __forceinline__ XcdBarrier xcd_barrier_post(unsigned* bar, volatile LAS unsigned* st) {
    XcdBarrier b; b.bar = bar; b.x = xb_xcc_id(); b.st = st;
    if (threadIdx.x == 0) (void)xb_add(&bar[XB_XCNT(b.x)], 1u);
    return b;
}
__device__ __forceinline__ void xcd_barrier_complete(unsigned* bar, unsigned x, unsigned& nloc, unsigned& nx) {
    const unsigned G = gridDim.x * gridDim.y * gridDim.z;
    unsigned sum, cnt, mine, sp = 0u;
    for (;;) {
        sum = 0u; cnt = 0u; mine = 0u;
#pragma unroll
        for (unsigned j = 0; j < 16; ++j) { const unsigned c = xb_ld(&bar[XB_XCNT(j)]); sum += c; cnt += (c > 0u) ? 1u : 0u; mine = (j == x) ? c : mine; }
        if (sum == G) break;
        __builtin_amdgcn_s_sleep(1);
        if ((++sp & 255u) == 0u) { if (xb_ld(&bar[XB_TMO])) break; if (sp > XB_SPIN_CAP) { atomicAdd(&bar[XB_TMO], 1u); break; } }
    }
    nloc = mine > 0u ? mine : 1u; nx = cnt > 0u ? cnt : 1u;
}

__device__ __forceinline__ void xcd_barrier(const XcdBarrier& b) {
    asm volatile("s_waitcnt vmcnt(0)" ::: "memory");
    __syncthreads();
    if (threadIdx.x == 0) {
        unsigned* bar = b.bar;
        __builtin_amdgcn_s_waitcnt(0);
        unsigned nloc = b.st[0], nx = b.st[1];
        if (nloc == 0u) { unsigned xx = b.x; asm volatile("" : "+s"(xx));   xcd_barrier_complete(bar, xx, nloc, nx); b.st[0] = nloc; b.st[1] = nx; }
        const unsigned old = xb_add(&bar[XB_XSUB(b.x)], 1u);
        const unsigned gen = old / nloc;
        if (old + 1u == (gen + 1u) * nloc) {
            __builtin_amdgcn_fence(__ATOMIC_RELEASE, "agent");
            asm volatile("s_waitcnt vmcnt(0)" ::: "memory");
            const unsigned og = xb_add(&bar[XB_TOP], 1u);
            const unsigned tg = og / nx;
            if (og + 1u == (tg + 1u) * nx) xb_add(&bar[XB_TOPGEN], 1u);
            else XB_SPIN(xb_ld(&bar[XB_TOPGEN]) == tg, bar);
            __builtin_amdgcn_fence(__ATOMIC_ACQUIRE, "agent");
            xb_add(&bar[XB_XGEN(b.x)], 1u);
            asm volatile("s_waitcnt vmcnt(0)" ::: "memory");
        } else {
            XB_SPIN(xb_ld(&bar[XB_XGEN(b.x)]) == gen, bar);
            __builtin_amdgcn_fence(__ATOMIC_ACQUIRE, "agent");
            asm volatile("s_waitcnt vmcnt(0)" ::: "memory");
        }
    }
    __syncthreads();
}


namespace at {
typedef unsigned short bf16_t;
using bf16x8 = __attribute__((ext_vector_type(8))) short;
using s16x4  = __attribute__((ext_vector_type(4))) short;
using f32x16 = __attribute__((ext_vector_type(16))) float;
using u32x4  = __attribute__((ext_vector_type(4))) unsigned;
constexpr int DQ = 96, DV = 64, NW = 8, QBLK = 32, KVBLK = 64;
constexpr int LDQ = 6 * DQ, LDK = 6 * DQ, LDV = 6 * DV;
constexpr float SCALE = 0.10206207261596575f;
constexpr float THR = 8.f;
constexpr int KROW = 208;
constexpr int SHM_K = KVBLK * KROW, SHM_V = KVBLK * DV * 2;
constexpr int SHM_ATTN = 2 * SHM_V + 2 * SHM_K + NW * 64 * 4;
#define AT_SBAR() __builtin_amdgcn_sched_barrier(0)
__device__ __forceinline__ int crow(int r, int hi) { return (r & 3) + 8 * (r >> 2) + 4 * hi; }
__device__ __forceinline__ unsigned cvtpk(float lo, float hi) { unsigned r; asm volatile("v_cvt_pk_bf16_f32 %0, %1, %2" : "=v"(r) : "v"(lo), "v"(hi)); return r; }

__device__ __forceinline__ void partialSM(f32x16& p0, f32x16& p1, float& m_reg, float& mn, float& alpha) {
  constexpr float C = SCALE * 1.4426950408889634f;
  float pmax = p0[0];
#pragma unroll
  for (int r = 1; r < 16; ++r) pmax = fmaxf(pmax, p0[r]);
#pragma unroll
  for (int r = 0; r < 16; ++r) pmax = fmaxf(pmax, p1[r]);
  { auto rr = __builtin_amdgcn_permlane32_swap(__float_as_uint(pmax), __float_as_uint(pmax), false, false);
    pmax = fmaxf(__uint_as_float(rr[0]), __uint_as_float(rr[1])); }
  if (__builtin_expect(__all(pmax - m_reg <= THR / SCALE), 1)) { mn = m_reg; alpha = 1.f; }
  else { mn = fmaxf(m_reg, pmax); alpha = __builtin_amdgcn_exp2f((m_reg - mn) * C); m_reg = mn; }
  float mnC = -mn * C;
#pragma unroll
  for (int r = 0; r < 16; ++r) p0[r] = fmaf(p0[r], C, mnC);
#pragma unroll
  for (int r = 0; r < 16; ++r) p1[r] = fmaf(p1[r], C, mnC);
#pragma unroll
  for (int r = 0; r < 16; ++r) p0[r] = __builtin_amdgcn_exp2f(p0[r]);
}
__device__ __forceinline__ void finishSM(f32x16& p0, f32x16& p1, float alpha, float& l_reg, bf16x8& pa0, bf16x8& pa1, bf16x8& pa2, bf16x8& pa3) {
#pragma unroll
  for (int r = 0; r < 16; ++r) p1[r] = __builtin_amdgcn_exp2f(p1[r]);
  float ps = 0;
#pragma unroll
  for (int r = 0; r < 16; ++r) ps += p0[r];
#pragma unroll
  for (int r = 0; r < 16; ++r) ps += p1[r];
  { auto rr = __builtin_amdgcn_permlane32_swap(__float_as_uint(ps), __float_as_uint(ps), false, false);
    ps = __uint_as_float(rr[0]) + __uint_as_float(rr[1]); }
  l_reg = l_reg * alpha + ps;
#define AT_PK4(P, BASE, OUT) do { unsigned a0 = cvtpk(P[BASE + 0], P[BASE + 1]), a1 = cvtpk(P[BASE + 2], P[BASE + 3]);   \
    unsigned b0 = cvtpk(P[BASE + 4], P[BASE + 5]), b1 = cvtpk(P[BASE + 6], P[BASE + 7]);                              \
    auto r0 = __builtin_amdgcn_permlane32_swap(a0, b0, false, false); auto r1 = __builtin_amdgcn_permlane32_swap(a1, b1, false, false); \
    u32x4 w = {r0[0], r1[0], r0[1], r1[1]}; OUT = *reinterpret_cast<bf16x8*>(&w); } while (0)
  AT_PK4(p0, 0, pa0); AT_PK4(p0, 8, pa1); AT_PK4(p1, 0, pa2); AT_PK4(p1, 8, pa3);
#undef AT_PK4
}
__device__ __forceinline__ void qkt(f32x16& p0, f32x16& p1, const char* Ks, const bf16x8* qr, int r32, int hi) {
  p0 = f32x16{}; p1 = f32x16{};
#pragma unroll
  for (int d0 = 0; d0 < 6; ++d0) { const int cb = (d0 * 16 + hi * 8) * 2;
    bf16x8 b0 = *reinterpret_cast<const bf16x8*>(Ks + r32 * KROW + cb);
    bf16x8 b1 = *reinterpret_cast<const bf16x8*>(Ks + (32 + r32) * KROW + cb);
    p0 = __builtin_amdgcn_mfma_f32_32x32x16_bf16(b0, qr[d0], p0, 0, 0, 0);
    p1 = __builtin_amdgcn_mfma_f32_32x32x16_bf16(b1, qr[d0], p1, 0, 0, 0); }
}
__device__ __forceinline__ int v_st(int k, int c) { const int kk = (k & ~0xC) | ((k & 4) << 1) | ((k & 8) >> 1); return ((kk >> 3) * 2 + (c >> 5)) * 512 + ((kk & 7) * 32 + (c & 31)) * 2; }
__device__ __forceinline__ int v_rd_base(int lane) { return ((lane & 3) << 3) | (((lane >> 2) & 3) << 6) | (((lane >> 4) & 1) << 5) | (((lane >> 5) & 1) << 8); }
constexpr int v_rd_off(int d0, int ks, int half) { return d0 * 512 + ks * 2048 + half * 1024; }
template <int OFF> __device__ __forceinline__ s16x4 tr_read(int vb) {
  s16x4 r; asm volatile("ds_read_b64_tr_b16 %0, %1 offset:%2" : "=&v"(r) : "v"(vb), "i"(OFF) : "memory"); return r;
}
template <int D0> __device__ __forceinline__ void pv_one(f32x16& od, int vb, bf16x8 pa0, bf16x8 pa1, bf16x8 pa2, bf16x8 pa3) {
  const s16x4 l0 = tr_read<v_rd_off(D0, 0, 0)>(vb), h0 = tr_read<v_rd_off(D0, 0, 1)>(vb), l1 = tr_read<v_rd_off(D0, 1, 0)>(vb), h1 = tr_read<v_rd_off(D0, 1, 1)>(vb);
  const s16x4 l2 = tr_read<v_rd_off(D0, 2, 0)>(vb), h2 = tr_read<v_rd_off(D0, 2, 1)>(vb), l3 = tr_read<v_rd_off(D0, 3, 0)>(vb), h3 = tr_read<v_rd_off(D0, 3, 1)>(vb);
  asm volatile("s_waitcnt lgkmcnt(0)" ::: "memory"); AT_SBAR();
#define AT_PK(L, H) (bf16x8){L[0], L[1], L[2], L[3], H[0], H[1], H[2], H[3]}
  od = __builtin_amdgcn_mfma_f32_32x32x16_bf16(pa0, AT_PK(l0, h0), od, 0, 0, 0);
  od = __builtin_amdgcn_mfma_f32_32x32x16_bf16(pa1, AT_PK(l1, h1), od, 0, 0, 0);
  od = __builtin_amdgcn_mfma_f32_32x32x16_bf16(pa2, AT_PK(l2, h2), od, 0, 0, 0);
  od = __builtin_amdgcn_mfma_f32_32x32x16_bf16(pa3, AT_PK(l3, h3), od, 0, 0, 0);
#undef AT_PK
}
__device__ __forceinline__ void pv_d0(f32x16* o, int vb, bf16x8 pa0, bf16x8 pa1, bf16x8 pa2, bf16x8 pa3) {
  pv_one<0>(o[0], vb, pa0, pa1, pa2, pa3); pv_one<1>(o[1], vb, pa0, pa1, pa2, pa3);
}
template <class TO> __device__ __forceinline__ void attn_body(const bf16_t* __restrict__ Qb, const bf16_t* __restrict__ Kh, const bf16_t* __restrict__ Vh, TO* __restrict__ Ob, int ldo, int seq, char* lds) {
  int tid = threadIdx.x; asm volatile("" : "+v"(tid));
  const int wid = tid >> 6, lane = tid & 63, r32 = lane & 31, hi = lane >> 5;
  char* V_lds = lds; char* K_lds = lds + 2 * SHM_V;
  float* ws = (float*)(lds + 2 * SHM_V + 2 * SHM_K) + wid * 64; float* li_l = ws; float* al_l = ws + 32;
  float m_reg = -1e30f, l_reg = 0; f32x16 o[2] = {}; bf16x8 qr[6];
  const bf16_t* Qw = Qb + (long)(wid * QBLK + r32) * LDQ + hi * 8;
#pragma unroll
  for (int d0 = 0; d0 < 6; ++d0) qr[d0] = *reinterpret_cast<const bf16x8*>(Qw + d0 * 16);
  const int kr0 = tid / 12, kc0 = tid % 12, c1 = 512 + (tid & 255), kr1 = c1 / 12, kc1 = c1 % 12, vr = tid >> 3, vc = (tid & 7) * 8;
  const bool k1on = tid < 256;
  const int kst0 = kr0 * KROW + kc0 * 16, kst1 = kr1 * KROW + kc1 * 16, vst = v_st(vr, vc);
  const long kg0 = (long)kr0 * LDK + kc0 * 8, kg1 = (long)kr1 * LDK + kc1 * 8, vg = (long)vr * LDV + vc;
  const int vb0 = (int)(uintptr_t)V_lds + v_rd_base(lane);
  struct { bf16x8 vs, ks0, ks1; } sr_[2];
#define AT_SLOAD(i, k0) do { sr_[i].vs = *reinterpret_cast<const bf16x8*>(Vh + (long)(k0) * LDV + vg); \
    sr_[i].ks0 = *reinterpret_cast<const bf16x8*>(Kh + (long)(k0) * LDK + kg0); sr_[i].ks1 = *reinterpret_cast<const bf16x8*>(Kh + (long)(k0) * LDK + kg1); } while (0)
#define AT_SWRITE(b, i) do { *(bf16x8*)(V_lds + (b) * SHM_V + vst) = sr_[i].vs; *(bf16x8*)(K_lds + (b) * SHM_K + kst0) = sr_[i].ks0; \
    if (k1on) *(bf16x8*)(K_lds + (b) * SHM_K + kst1) = sr_[i].ks1; } while (0)
#define AT_SWAIT() asm volatile("s_waitcnt vmcnt(3)" ::: "memory")
#define AT_RESC(a) do { if (__any((a) < 1.f)) { if (hi == 0) al_l[r32] = (a); asm volatile("s_waitcnt lgkmcnt(0)" ::: "memory"); \
    _Pragma("unroll") for (int d = 0; d < 2; ++d) _Pragma("unroll") for (int r = 0; r < 16; ++r) o[d][r] *= al_l[crow(r, hi)]; } } while (0)
  f32x16 pA0, pA1, pB0, pB1; float mnA, mnB, alA, alB; bf16x8 pa0, pa1, pa2, pa3; const int NT = seq / KVBLK;
  constexpr int SE = 0, SO = 1;
  AT_SLOAD(SE, 0); asm volatile("s_waitcnt vmcnt(0)" ::: "memory"); AT_SWRITE(0, SE); __syncthreads();
  qkt(pA0, pA1, K_lds, qr, r32, hi); partialSM(pA0, pA1, m_reg, mnA, alA);
  AT_SLOAD(SO, KVBLK); if (2 < NT) AT_SLOAD(SE, 2 * KVBLK);
  AT_SWAIT(); AT_SWRITE(1, SO); __syncthreads();
  for (int j = 1; j + 1 < NT; j += 2) {
    AT_SBAR(); qkt(pB0, pB1, K_lds + SHM_K, qr, r32, hi);
    finishSM(pA0, pA1, alA, l_reg, pa0, pa1, pa2, pa3); AT_SBAR();
    AT_SLOAD(SO, (j + 2) * KVBLK); AT_SBAR();
    pv_d0(o, vb0, pa0, pa1, pa2, pa3); partialSM(pB0, pB1, m_reg, mnB, alB);
    __syncthreads(); AT_SWAIT(); AT_SWRITE(0, SE);
    AT_RESC(alB); __syncthreads();
    AT_SBAR(); qkt(pA0, pA1, K_lds, qr, r32, hi);
    finishSM(pB0, pB1, alB, l_reg, pa0, pa1, pa2, pa3); AT_SBAR();
    if (j + 3 < NT) AT_SLOAD(SE, (j + 3) * KVBLK); AT_SBAR();
    pv_d0(o, vb0 + SHM_V, pa0, pa1, pa2, pa3); partialSM(pA0, pA1, m_reg, mnA, alA);
    __syncthreads(); AT_SWAIT(); AT_SWRITE(1, SO);
    AT_RESC(alA); __syncthreads();
  }
  AT_SBAR(); qkt(pB0, pB1, K_lds + SHM_K, qr, r32, hi);
  finishSM(pA0, pA1, alA, l_reg, pa0, pa1, pa2, pa3); AT_SBAR();
  pv_d0(o, vb0, pa0, pa1, pa2, pa3); partialSM(pB0, pB1, m_reg, mnB, alB);
  __syncthreads(); AT_RESC(alB);
  finishSM(pB0, pB1, alB, l_reg, pa0, pa1, pa2, pa3); AT_SBAR();
  pv_d0(o, vb0 + SHM_V, pa0, pa1, pa2, pa3);
  if (hi == 0) li_l[r32] = l_reg; asm volatile("s_waitcnt lgkmcnt(0)" ::: "memory");
  float rli[16];
#pragma unroll
  for (int r = 0; r < 16; ++r) rli[r] = __builtin_amdgcn_rcpf(li_l[crow(r, hi)]);
  TO* Ow = Ob + (long)(wid * QBLK) * ldo;
#pragma unroll
  for (int r = 0; r < 16; ++r) { const int orow = crow(r, hi);
#pragma unroll
    for (int d0 = 0; d0 < 2; ++d0) { const float val = o[d0][r] * rli[r]; if constexpr (sizeof(TO) == 2) Ow[(long)orow * ldo + d0 * 32 + r32] = (TO)(cvtpk(val, val) & 0xffffu); else Ow[(long)orow * ldo + d0 * 32 + r32] = val; } }
#undef AT_SLOAD
#undef AT_SWRITE
#undef AT_SWAIT
#undef AT_RESC
}
}

namespace gm {
#define GM_LAS __attribute__((address_space(3)))
typedef unsigned short bf16_t;
typedef short bf16x8 __attribute__((ext_vector_type(8)));
typedef float f32x4 __attribute__((ext_vector_type(4)));
typedef unsigned u32x4 __attribute__((ext_vector_type(4)));
constexpr int BM = 256, BK = 64, HALF = 128, HTB = HALF * BK * 2, STAGE_BYTES = 8 * HTB;
__host__ __device__ __forceinline__ int lds_byte(int r, int c) { const int st = (r >> 4) * 2 + (c >> 5), rr = r & 15, cc = c & 31, ob = rr * 64 + cc * 2; return st * 1024 + (ob ^ (((ob >> 9) & 1) << 5)); }
__host__ __device__ __forceinline__ void stage_rc(int b, int& R, int& C) { const int st = b / 1024, sb = b % 1024, swz = sb ^ (((sb >> 9) & 1) << 5); R = (st >> 1) * 16 + swz / 64; C = (st & 1) * 32 + (swz % 64) / 2; }
__host__ __device__ __forceinline__ int perm32(int rho) { const int n = rho >> 4, i = rho & 15; return 8 * (i >> 2) + 4 * n + (i & 3); }
__device__ __forceinline__ unsigned cvt_pk_bf16(float lo, float hi) { unsigned r; asm volatile("v_cvt_pk_bf16_f32 %0, %1, %2" : "=v"(r) : "v"(lo), "v"(hi)); return r; }

template <bool PERM, class Epi>
__device__ __forceinline__ void gemm_unit(GM_LAS unsigned char* lds, const char* A, const unsigned (&offA)[2][2], const char* Bt, int K, const Epi& E) {
    int tid = threadIdx.x; asm volatile("" : "+v"(tid));
    const int wid = __builtin_amdgcn_readfirstlane(tid >> 6), lane = tid & 63, wr = wid >> 2, wc = wid & 3, fr = lane & 15, fq = lane >> 4;
    const int nt = K / BK;
    unsigned voffB[2];
#pragma unroll
    for (int i = 0; i < 2; ++i) { int R, C; stage_rc(tid * 16 + i * 8192, R, C); const int Rb = PERM ? ((R & ~31) + perm32(R & 31)) : R; voffB[i] = (unsigned)(Rb * K + C) * 2u; }
    const size_t kstep = (size_t)(BK * 2);
    const size_t hstep = (size_t)HALF * K * 2;
    const unsigned ldsw = (unsigned)wid * 1024u;
    const int aoff = lds_byte(wr * 64 + fr, fq * 8), boff = lds_byte(wc * 32 + fr, fq * 8);
#define GM_SA(b, h) (((b) * 2 + (h)) * HTB)
#define GM_SB(b, h) ((4 + (b) * 2 + (h)) * HTB)
#define GM_STAGEB(bufoff, gbase) do { _Pragma("unroll") for (int _i = 0; _i < 2; ++_i) \
        __builtin_amdgcn_global_load_lds((const unsigned*)((const char*)(gbase) + voffB[_i]), (GM_LAS unsigned*)(lds + (bufoff) + ldsw + _i * 8192), 16, 0, 0); } while (0)
#define GM_STAGEA(bufoff, h, kbyte) do { _Pragma("unroll") for (int _i = 0; _i < 2; ++_i) \
        __builtin_amdgcn_global_load_lds((const unsigned*)(A + (size_t)offA[h][_i] + (kbyte)), (GM_LAS unsigned*)(lds + (bufoff) + ldsw + _i * 8192), 16, 0, 0); } while (0)
#define GM_LDA(dst, b, h) do { _Pragma("unroll") for (int m = 0; m < 4; ++m) _Pragma("unroll") for (int k = 0; k < 2; ++k) dst[m][k] = *(const GM_LAS bf16x8*)(lds + GM_SA(b, h) + aoff + m * 2048 + k * 1024); } while (0)
#define GM_LDB(dst, b, h) do { _Pragma("unroll") for (int n = 0; n < 2; ++n) _Pragma("unroll") for (int k = 0; k < 2; ++k) dst[n][k] = *(const GM_LAS bf16x8*)(lds + GM_SB(b, h) + boff + n * 2048 + k * 1024); } while (0)
#define GM_MMA(ai, bj, At, Bt_) do { __builtin_amdgcn_s_setprio(1); _Pragma("unroll") for (int m = 0; m < 4; ++m) _Pragma("unroll") for (int n = 0; n < 2; ++n) _Pragma("unroll") for (int k = 0; k < 2; ++k) \
        acc[ai][bj][m][n] = __builtin_amdgcn_mfma_f32_16x16x32_bf16(Bt_[n][k], At[m][k], acc[ai][bj][m][n], 0, 0, 0); __builtin_amdgcn_s_setprio(0); } while (0)
#define GM_WAIT_V(n) asm volatile("s_waitcnt vmcnt(" #n ")" ::: "memory")
#define GM_WAIT_L(n) asm volatile("s_waitcnt lgkmcnt(" #n ")" ::: "memory")
#define GM_BAR __builtin_amdgcn_s_barrier()
#define GM_SCHED __builtin_amdgcn_sched_barrier(0)
    f32x4 acc[2][2][4][2];
#pragma unroll
    for (int a = 0; a < 2; ++a)
#pragma unroll
        for (int b = 0; b < 2; ++b)
#pragma unroll
            for (int m = 0; m < 4; ++m)
#pragma unroll
                for (int n = 0; n < 2; ++n) acc[a][b][m][n] = (f32x4){0.f, 0.f, 0.f, 0.f};
    bf16x8 At[4][2], B0[2][2], B1[2][2];
    const char* cB = Bt;
    GM_STAGEB(GM_SB(0, 0), cB); GM_STAGEA(GM_SA(0, 0), 0, 0); GM_STAGEB(GM_SB(0, 1), cB + hstep); GM_STAGEA(GM_SA(0, 1), 1, 0);
    if (wr == 1) GM_BAR;
    GM_WAIT_V(4); GM_BAR;
    GM_STAGEB(GM_SB(1, 0), cB + kstep); GM_STAGEA(GM_SA(1, 0), 0, kstep); GM_STAGEB(GM_SB(1, 1), cB + hstep + kstep);
    GM_WAIT_V(6); GM_BAR;
    for (int t = 0; t < nt; t += 2) {
        const bool last = (t == nt - 2);
        const size_t k1 = (size_t)(t + 1) * kstep;
        const size_t k2 = last ? 0 : (size_t)(t + 2) * kstep;
        const size_t k3 = k2 + kstep;
        const char* b2 = cB + k2; const char* b3 = cB + k3;
        GM_LDB(B0, 0, 0); GM_SCHED; GM_LDA(At, 0, 0); GM_STAGEA(GM_SA(1, 1), 1, k1);
        GM_WAIT_L(8); GM_BAR; GM_WAIT_L(0); GM_MMA(0, 0, At, B0); GM_BAR; GM_SCHED;
        GM_LDB(B1, 0, 1); GM_STAGEB(GM_SB(0, 0), b2);
        GM_BAR; GM_WAIT_L(0); GM_MMA(0, 1, At, B1); GM_BAR;
        GM_LDA(At, 0, 1); GM_STAGEA(GM_SA(0, 0), 0, k2);
        GM_BAR; GM_WAIT_L(0); GM_MMA(1, 0, At, B0); GM_BAR; GM_SCHED;
        GM_STAGEB(GM_SB(0, 1), b2 + hstep);
        GM_WAIT_V(6); GM_BAR; GM_MMA(1, 1, At, B1); GM_BAR;
        GM_LDB(B0, 1, 0); GM_SCHED; GM_LDA(At, 1, 0); GM_STAGEA(GM_SA(0, 1), 1, k2);
        GM_WAIT_L(8); GM_BAR; GM_WAIT_L(0); GM_MMA(0, 0, At, B0); GM_BAR; GM_SCHED;
        GM_LDB(B1, 1, 1); GM_STAGEB(GM_SB(1, 0), b3);
        GM_BAR; GM_WAIT_L(0); GM_MMA(0, 1, At, B1); GM_BAR;
        GM_LDA(At, 1, 1); GM_STAGEA(GM_SA(1, 0), 0, k3);
        GM_BAR; GM_WAIT_L(0); GM_MMA(1, 0, At, B0); GM_BAR; GM_SCHED;
        GM_STAGEB(GM_SB(1, 1), b3 + hstep);
        GM_WAIT_V(6); GM_BAR; GM_MMA(1, 1, At, B1); GM_BAR;
    }
    E(acc, wr, wc, fr, fq);
    GM_WAIT_V(0);
    if (wr == 0) GM_BAR;
    GM_BAR;
#undef GM_SA
#undef GM_SB
#undef GM_STAGEA
#undef GM_STAGEB
#undef GM_LDA
#undef GM_LDB
#undef GM_MMA
#undef GM_WAIT_V
#undef GM_WAIT_L
#undef GM_BAR
#undef GM_SCHED
}
__device__ __forceinline__ void dense_offA(unsigned (&offA)[2][2], long row0, int K) {
    int tid = threadIdx.x; asm volatile("" : "+v"(tid));
#pragma unroll
    for (int i = 0; i < 2; ++i) { int R, C; stage_rc(tid * 16 + i * 8192, R, C);
#pragma unroll
        for (int h = 0; h < 2; ++h) offA[h][i] = (unsigned)(((row0 + h * HALF + R) * K + C) * 2); }
}
}

struct FW {
    bf16_t *w_in_t, *w_out_t, *gu_t, *d_t;
    bf16_t *hb1, *hb2, *mixb, *actb, *yb;
    float *proj2, *mix2;
    bf16_t *w_uq_t, *w_ukv_t;
    float *ropec, *ropes;
    bf16_t *qb2, *kb2, *vb2;
    float *yd2, *st2, *cdec2, *cs2; bf16_t *cg, *prevb, *ssdb2;
};
constexpr int INC_PAD = 1792;
template <int MAP> __device__ __forceinline__ void cvt_tile(const float* src, int ldn, int nvalid, bf16_t* dst, int K, int k0, int n0, float* T) {
    int tid = threadIdx.x; asm volatile("" : "+v"(tid)); const int r = tid >> 4, c4 = (tid & 15) * 4;
#pragma unroll
    for (int i = 0; i < 2; ++i) { const int kk = r + 32 * i; float4 v = make_float4(0.f, 0.f, 0.f, 0.f);
        if (n0 + c4 < nvalid) v = *(const float4*)(src + (size_t)(k0 + kk) * ldn + n0 + c4);
        T[kk * 65 + c4 + 0] = v.x; T[kk * 65 + c4 + 1] = v.y; T[kk * 65 + c4 + 2] = v.z; T[kk * 65 + c4 + 3] = v.w; }
    __syncthreads();
    { const int n = tid >> 3, kc = tid & 7; float f[8];
#pragma unroll
        for (int j = 0; j < 8; ++j) f[j] = T[(kc * 8 + j) * 65 + n];
        gm::u32x4 w; w.x = gm::cvt_pk_bf16(f[0], f[1]); w.y = gm::cvt_pk_bf16(f[2], f[3]); w.z = gm::cvt_pk_bf16(f[4], f[5]); w.w = gm::cvt_pk_bf16(f[6], f[7]);
        const int nn = n0 + n; const int drow = MAP == 0 ? nn : ((nn >> 7) * 256 + (MAP == 2 ? 128 : 0) + (nn & 127));
        *(gm::u32x4*)(dst + (size_t)drow * K + k0 + kc * 8) = w; }
    __syncthreads();
}
__device__ __forceinline__ void cvt_phase(const P& p, const FW& f, int l0, int l1, char* lds) {
    float* T = (float*)lds;
    constexpr int T_IN = 16 * 28, T_OUT = 16 * 16, T_E = 16 * 16, T_UQ = 4 * 9, T_UKV = 2 * 12, T_LAYER = T_IN + T_OUT + T_UQ + T_UKV + NE * 3 * T_E;
    const int total = (l1 - l0) * T_LAYER;
    if (blockIdx.x == gridDim.x - 1) for (int i = threadIdx.x; i < 256 * 8; i += 512) { float cs, sn; sincos_rr((float)(i >> 3) * rope_inv_freq(i & 7), cs, sn); f.ropec[i] = cs; f.ropes[i] = sn; }
    for (int t = blockIdx.x; t < total; t += gridDim.x) {
        const int l = l0 + t / T_LAYER; int r = t % T_LAYER;
        if (r < T_IN) { const int kt = r / 28, ntl = r % 28; cvt_tile<0>(p.w_in + (size_t)l * D * INC, INC, INC, f.w_in_t + (size_t)l * INC_PAD * D, D, kt * 64, ntl * 64, T); continue; }
        r -= T_IN;
        if (r < T_OUT) { const int kt = r / 16, ntl = r % 16; cvt_tile<0>(p.w_out + (size_t)l * MIXW * D, D, D, f.w_out_t + (size_t)l * D * MIXW, MIXW, kt * 64, ntl * 64, T); continue; }
        r -= T_OUT;
        if (r < T_UQ) { const int kt = r / 9, ntl = r % 9; cvt_tile<0>(p.w_uq + (size_t)l * QL * NH * QKD, NH * QKD, NH * QKD, f.w_uq_t + (size_t)l * NH * QKD * QL, QL, kt * 64, ntl * 64, T); continue; }
        r -= T_UQ;
        if (r < T_UKV) { const int kt = r / 12, ntl = r % 12; cvt_tile<0>(p.w_ukv + (size_t)l * KVL * NH * 128, NH * 128, NH * 128, f.w_ukv_t + (size_t)l * NH * 128 * KVL, KVL, kt * 64, ntl * 64, T); continue; }
        r -= T_UKV;
        const int e = r / (3 * T_E), which = (r / T_E) % 3, tt = r % T_E, kt = tt / 16, ntl = tt % 16; const size_t le = (size_t)l * NE + e;
        if (which == 0) cvt_tile<1>(p.wg + le * D * FF, FF, FF, f.gu_t + le * 2 * FF * D, D, kt * 64, ntl * 64, T);
        else if (which == 1) cvt_tile<2>(p.wu + le * D * FF, FF, FF, f.gu_t + le * 2 * FF * D, D, kt * 64, ntl * 64, T);
        else cvt_tile<0>(p.wd + le * FF * D, D, D, f.d_t + le * D * FF, FF, kt * 64, ntl * 64, T);
    }
}
__device__ __forceinline__ void inproj_phase(const P& p, const FW& f, int l, float* dst, char* lds) {
    constexpr int NPN = INC_PAD / 256, NU = (M / 256) * NPN;
    for (int u = blockIdx.x; u < NU; u += gridDim.x) {
        const int pm = u / NPN, pn = u % NPN; unsigned offA[2][2]; gm::dense_offA(offA, (long)pm * 256, D);
        auto epi = [&](const gm::f32x4 (&acc)[2][2][4][2], int wr, int wc, int fr, int fq) {
            const int row0 = pm * 256 + wr * 64 + fr, col0 = pn * 256 + wc * 32 + 4 * fq;
#pragma unroll
            for (int ai = 0; ai < 2; ++ai)
#pragma unroll
                for (int m = 0; m < 4; ++m) { float* rowp = dst + (size_t)(row0 + ai * 128 + m * 16) * INC + col0;
#pragma unroll
                    for (int bj = 0; bj < 2; ++bj)
#pragma unroll
                        for (int n = 0; n < 2; ++n) if (col0 + bj * 128 + n * 16 < INC) *(gm::f32x4*)(rowp + bj * 128 + n * 16) = acc[ai][bj][m][n]; } };
        gm::gemm_unit<false>((GM_LAS unsigned char*)lds, (const char*)f.hb1, offA, (const char*)(f.w_in_t + ((size_t)l * INC_PAD + pn * 256) * D), D, epi);
    }
}
template <bool TOX> __device__ __forceinline__ void outproj_phase(const P& p, const FW& f, int l, float* dst, char* lds) {
    constexpr int NPN = D / 256, NU = (M / 256) * NPN;
    for (int u = blockIdx.x; u < NU; u += gridDim.x) {
        const int pm = u / NPN, pn = u % NPN; unsigned offA[2][2]; gm::dense_offA(offA, (long)pm * 256, MIXW);
        auto epi = [&](const gm::f32x4 (&acc)[2][2][4][2], int wr, int wc, int fr, int fq) {
            const int row0 = pm * 256 + wr * 64 + fr, col0 = pn * 256 + wc * 32 + 4 * fq; const float* gate = modv(p, l, pm * 256, 2);
#pragma unroll
            for (int ai = 0; ai < 2; ++ai)
#pragma unroll
                for (int m = 0; m < 4; ++m) { float* rowp = dst + (size_t)(row0 + ai * 128 + m * 16) * D + col0;
#pragma unroll
                    for (int bj = 0; bj < 2; ++bj)
#pragma unroll
                        for (int n = 0; n < 2; ++n) { float* q = rowp + bj * 128 + n * 16;
                            if (TOX) { const gm::f32x4 g = *(const gm::f32x4*)(gate + col0 + bj * 128 + n * 16); const gm::f32x4 x = *(const gm::f32x4*)q; *(gm::f32x4*)q = x + g * acc[ai][bj][m][n]; }
                            else *(gm::f32x4*)q = acc[ai][bj][m][n]; } } };
        gm::gemm_unit<false>((GM_LAS unsigned char*)lds, (const char*)f.mixb, offA, (const char*)(f.w_out_t + ((size_t)l * D + pn * 256) * MIXW), MIXW, epi);
    }
}
__device__ __forceinline__ bool moe_find(const int* cnt, int tg, int& e, int& ti, int& c) {
    int acc = 0;
    for (int x = 0; x < NE; ++x) { const int cx = cnt[x]; const int nt = (cx + 255) >> 8; if (tg < acc + nt) { e = x; ti = tg - acc; c = cx; return true; } acc += nt; }
    return false;
}
__device__ __forceinline__ int moe_tiles(const int* cnt) { int acc = 0; for (int x = 0; x < NE; ++x) acc += (cnt[x] + 255) >> 8; return acc; }
template <bool SRC_TOK> __device__ __forceinline__ void gather_offA(unsigned (&offA)[2][2], const int* lst, int base, int cnt, int K) {
    int tid = threadIdx.x; asm volatile("" : "+v"(tid));
#pragma unroll
    for (int i = 0; i < 2; ++i) { int R, C; gm::stage_rc(tid * 16 + i * 8192, R, C);
#pragma unroll
        for (int h = 0; h < 2; ++h) { const int s = base + h * 128 + R; int a = s < cnt ? lst[s] : 0; if (SRC_TOK) a >>= 2; offA[h][i] = (unsigned)(((size_t)a * K + C) * 2); } }
}
__device__ __forceinline__ void moe1_phase(const P& p, const FW& f, int l, char* lds) {
    constexpr int NPN = 2 * FF / 256; const int NU = moe_tiles(p.cnt) * NPN;
    for (int u = blockIdx.x; u < NU; u += gridDim.x) {
        int e, ti, cnt; if (!moe_find(p.cnt, u / NPN, e, ti, cnt)) break; const int pn = u % NPN; const int* lst = p.list + (size_t)e * M; const size_t le = (size_t)l * NE + e;
        unsigned offA[2][2]; gather_offA<true>(offA, lst, ti * 256, cnt, D);
        auto epi = [&](const gm::f32x4 (&acc)[2][2][4][2], int wr, int wc, int fr, int fq) {
            const int ff0 = pn * 128 + wc * 32 + 8 * fq; const float* bgp = p.bg + le * FF + ff0; const float* bup = p.bu + le * FF + ff0;
            const gm::f32x4 bg0 = *(const gm::f32x4*)bgp, bg1 = *(const gm::f32x4*)(bgp + 4), bu0 = *(const gm::f32x4*)bup, bu1 = *(const gm::f32x4*)(bup + 4);
#pragma unroll
            for (int ai = 0; ai < 2; ++ai)
#pragma unroll
                for (int m = 0; m < 4; ++m) { const int s = ti * 256 + ai * 128 + wr * 64 + m * 16 + fr; if (s < cnt) { const int a = lst[s]; float o[8];
#pragma unroll
                        for (int n = 0; n < 2; ++n)
#pragma unroll
                            for (int j = 0; j < 4; ++j) { float g = acc[ai][0][m][n][j] + (n ? bg1[j] : bg0[j]); float uu = acc[ai][1][m][n][j] + (n ? bu1[j] : bu0[j]);
                                g = g < 7.0f ? g : 7.0f; uu = uu < -7.0f ? -7.0f : (uu > 7.0f ? 7.0f : uu); o[n * 4 + j] = g * (1.0f / (1.0f + __expf(-1.702f * g))) * (uu + 1.0f); }
                        gm::u32x4 w; w.x = gm::cvt_pk_bf16(o[0], o[1]); w.y = gm::cvt_pk_bf16(o[2], o[3]); w.z = gm::cvt_pk_bf16(o[4], o[5]); w.w = gm::cvt_pk_bf16(o[6], o[7]);
                        *(gm::u32x4*)(f.actb + (size_t)a * FF + ff0) = w; } } };
        gm::gemm_unit<true>((GM_LAS unsigned char*)lds, (const char*)f.hb2, offA, (const char*)(f.gu_t + (le * 2 * FF + pn * 256) * D), D, epi);
    }
}
__device__ __forceinline__ void moe2_phase(const P& p, const FW& f, int l, char* lds) {
    constexpr int NPN = D / 256; const int NU = moe_tiles(p.cnt) * NPN;
    for (int u = blockIdx.x; u < NU; u += gridDim.x) {
        int e, ti, cnt; if (!moe_find(p.cnt, u / NPN, e, ti, cnt)) break; const int pn = u % NPN; const int* lst = p.list + (size_t)e * M; const size_t le = (size_t)l * NE + e;
        unsigned offA[2][2]; gather_offA<false>(offA, lst, ti * 256, cnt, FF);
        auto epi = [&](const gm::f32x4 (&acc)[2][2][4][2], int wr, int wc, int fr, int fq) {
#pragma unroll
            for (int bj = 0; bj < 2; ++bj) { const int c0 = pn * 256 + bj * 128 + wc * 32 + 8 * fq; const float* bp = p.bd + le * D + c0; const gm::f32x4 b0 = *(const gm::f32x4*)bp, b1 = *(const gm::f32x4*)(bp + 4);
#pragma unroll
                for (int ai = 0; ai < 2; ++ai)
#pragma unroll
                    for (int m = 0; m < 4; ++m) { const int s = ti * 256 + ai * 128 + wr * 64 + m * 16 + fr; if (s < cnt) { const int a = lst[s];
                            const gm::f32x4 v0 = acc[ai][bj][m][0] + b0, v1 = acc[ai][bj][m][1] + b1;
                            gm::u32x4 w; w.x = gm::cvt_pk_bf16(v0[0], v0[1]); w.y = gm::cvt_pk_bf16(v0[2], v0[3]); w.z = gm::cvt_pk_bf16(v1[0], v1[1]); w.w = gm::cvt_pk_bf16(v1[2], v1[3]);
                            *(gm::u32x4*)(f.yb + (size_t)a * D + c0) = w; } } } };
        gm::gemm_unit<true>((GM_LAS unsigned char*)lds, (const char*)f.actb, offA, (const char*)(f.d_t + (le * D + pn * 256) * FF), FF, epi);
    }
}

namespace rw {
typedef float f32x4 __attribute__((ext_vector_type(4)));
typedef unsigned u32x2 __attribute__((ext_vector_type(2)));
constexpr int ROWS_PB = 65;
__device__ __forceinline__ float wave_sum(float v) {
#pragma unroll
    for (int o = 32; o >= 1; o >>= 1) v += __shfl_xor(v, o);
    return v;
}
__device__ __forceinline__ unsigned pk2(float lo, float hi) { unsigned r; asm volatile("v_cvt_pk_bf16_f32 %0, %1, %2" : "=v"(r) : "v"(lo), "v"(hi)); return r; }
__device__ __forceinline__ f32x4 bf4(u32x2 w) { f32x4 r; r[0] = __uint_as_float(w.x << 16); r[1] = __uint_as_float(w.x & 0xffff0000u); r[2] = __uint_as_float(w.y << 16); r[3] = __uint_as_float(w.y & 0xffff0000u); return r; }
__device__ __forceinline__ void norm_store(const f32x4 (&x)[4], const float* g, const float* shift, const float* scale, bf16_t* dst, int lane) {
    float ss = 0.f;
#pragma unroll
    for (int j = 0; j < 4; ++j) ss += x[j][0] * x[j][0] + x[j][1] * x[j][1] + x[j][2] * x[j][2] + x[j][3] * x[j][3];
    ss = wave_sum(ss); const float rs = 1.0f / sqrtf(ss * (1.0f / D) + EPS);
#pragma unroll
    for (int j = 0; j < 4; ++j) { const int c = 4 * lane + 256 * j; const f32x4 gv = *(const f32x4*)(g + c), sh = *(const f32x4*)(shift + c), sc = *(const f32x4*)(scale + c);
        const f32x4 o = x[j] * rs * gv * (1.0f + sc) + sh; u32x2 w; w.x = pk2(o[0], o[1]); w.y = pk2(o[2], o[3]); *(u32x2*)(dst + c) = w; }
}
__device__ __forceinline__ void first_norm_phase(const P& p) {
    int tid = threadIdx.x; asm volatile("" : "+v"(tid)); const int wid = tid >> 6, lane = tid & 63;
    for (int i = wid; i < ROWS_PB; i += 8) { const int r = blockIdx.x * ROWS_PB + i; if (r >= M) break;
        const float* src = r < CTX ? p.ctx + (size_t)r * D : p.x + (size_t)(r - CTX) * D; f32x4 x[4];
#pragma unroll
        for (int j = 0; j < 4; ++j) { x[j] = *(const f32x4*)(src + 4 * lane + 256 * j); *(f32x4*)(p.xres + (size_t)r * D + 4 * lane + 256 * j) = x[j]; }
        norm_store(x, p.norm1_g, modv(p, 0, r, 0), modv(p, 0, r, 1), p.hb1 + (size_t)r * D, lane); }
}
__device__ __forceinline__ void combine_phase(const P& p, int l) {
    int tid = threadIdx.x; asm volatile("" : "+v"(tid)); const int wid = tid >> 6, lane = tid & 63;
    for (int i = wid; i < ROWS_PB; i += 8) { const int r = blockIdx.x * ROWS_PB + i; if (r >= M) break;
        const f32x4 tw = *(const f32x4*)(p.topw + (size_t)r * 4); const float* gate = modv(p, l, r, 5); f32x4 x[4];
#pragma unroll
        for (int j = 0; j < 4; ++j) { const int c = 4 * lane + 256 * j; f32x4 s = {0.f, 0.f, 0.f, 0.f};
#pragma unroll
            for (int k = 0; k < 4; ++k) s += bf4(*(const u32x2*)(p.ybn + ((size_t)r * 4 + k) * D + c)) * tw[k];
            x[j] = *(const f32x4*)(p.xres + (size_t)r * D + c) + *(const f32x4*)(gate + c) * s; }
        if (l + 1 < DEPTH) {
#pragma unroll
            for (int j = 0; j < 4; ++j) *(f32x4*)(p.xres + (size_t)r * D + 4 * lane + 256 * j) = x[j];
            norm_store(x, p.norm1_g + (size_t)(l + 1) * D, modv(p, l + 1, r, 0), modv(p, l + 1, r, 1), p.hb1 + (size_t)r * D, lane);
        } else if (r >= CTX) {
#pragma unroll
            for (int j = 0; j < 4; ++j) *(f32x4*)(p.out + (size_t)(r - CTX) * D + 4 * lane + 256 * j) = x[j];
        } }
}
__device__ __forceinline__ void router_phase(const P& p, int l, char* lds) {
    int tid = threadIdx.x; asm volatile("" : "+v"(tid)); const int wid = tid >> 6, lane = tid & 63;
    float* WT = (float*)lds; float* bias2 = WT + 32 * 1024; int* lcnt = (int*)(bias2 + 64); int* lbase = lcnt + 32; int* rec = lbase + 32;
    const float* rwp = p.router_w + (size_t)l * D * NE;
    for (int i = tid; i < D * NE / 4; i += 512) { const int k = i >> 3, e4 = i & 7; const f32x4 v = *(const f32x4*)(rwp + (size_t)k * NE + e4 * 4);
#pragma unroll
        for (int q = 0; q < 4; ++q) WT[(e4 * 4 + q) * 1024 + (k ^ (e4 << 2))] = v[q]; }
    if (tid < 32) lcnt[tid] = 0;
    __syncthreads();
    {
#pragma unroll
        for (int v = 0; v < 2; ++v) { const float* sh = p.mod + ((size_t)(l * 2 + v) * 6 + 3) * D; f32x4 s[4];
#pragma unroll
            for (int j = 0; j < 4; ++j) s[j] = *(const f32x4*)(sh + 4 * lane + 256 * j);
#pragma unroll
            for (int q = 0; q < 4; ++q) { const int e = wid * 4 + q; float a = 0.f;
#pragma unroll
                for (int j = 0; j < 4; ++j) { const f32x4 w = *(const f32x4*)(WT + e * 1024 + ((4 * lane + 256 * j) ^ (((e >> 2) & 7) << 2))); a += w[0] * s[j][0] + w[1] * s[j][1] + w[2] * s[j][2] + w[3] * s[j][3]; }
                a = wave_sum(a); if (lane == 0) bias2[v * 32 + e] = a + p.router_b[l * NE + e]; } }
    }
    __syncthreads();
    const float* g2 = p.norm2_g + (size_t)l * D;
    for (int rp = wid; rp < (ROWS_PB + 1) / 2; rp += 8) {
        float acc[2][32]; float rsv[2]; int rr[2];
        f32x4 xg[2][4];
#pragma unroll
        for (int q = 0; q < 2; ++q) { const int il = 2 * rp + q; const int r = blockIdx.x * ROWS_PB + (il < ROWS_PB ? il : ROWS_PB - 1); rr[q] = r;
            const float* sc = modv(p, l, r, 4); const float* sh = modv(p, l, r, 3); float ss = 0.f; f32x4 x[4];
#pragma unroll
            for (int j = 0; j < 4; ++j) { x[j] = *(const f32x4*)(p.xres + (size_t)r * D + 4 * lane + 256 * j); ss += x[j][0] * x[j][0] + x[j][1] * x[j][1] + x[j][2] * x[j][2] + x[j][3] * x[j][3]; }
            ss = wave_sum(ss); const float rs = 1.0f / sqrtf(ss * (1.0f / D) + EPS); rsv[q] = rs;
#pragma unroll
            for (int j = 0; j < 4; ++j) { const int c = 4 * lane + 256 * j; xg[q][j] = x[j] * *(const f32x4*)(g2 + c) * (1.0f + *(const f32x4*)(sc + c));
                const f32x4 o = xg[q][j] * rs + *(const f32x4*)(sh + c); u32x2 w; w.x = pk2(o[0], o[1]); w.y = pk2(o[2], o[3]); if (il < ROWS_PB) *(u32x2*)(p.hb2 + (size_t)r * D + c) = w; }
        }
#pragma unroll
        for (int e = 0; e < 32; ++e) { float a0 = 0.f, a1 = 0.f;
#pragma unroll
            for (int j = 0; j < 4; ++j) { const f32x4 w = *(const f32x4*)(WT + e * 1024 + ((4 * lane + 256 * j) ^ (((e >> 2) & 7) << 2)));
                a0 += w[0] * xg[0][j][0] + w[1] * xg[0][j][1] + w[2] * xg[0][j][2] + w[3] * xg[0][j][3]; a1 += w[0] * xg[1][j][0] + w[1] * xg[1][j][1] + w[2] * xg[1][j][2] + w[3] * xg[1][j][3]; }
            acc[0][e] = a0; acc[1][e] = a1; }
        float v[64];
#pragma unroll
        for (int e = 0; e < 32; ++e) { v[e] = acc[0][e]; v[32 + e] = acc[1][e]; }
#pragma unroll
        for (int m = 32, n = 64; m >= 1; m >>= 1, n >>= 1) {
#pragma unroll
            for (int i = 0; i < n / 2; ++i) { const bool up = (lane & m) != 0; const float keep = up ? v[i + n / 2] : v[i], send = up ? v[i] : v[i + n / 2]; v[i] = keep + __shfl_xor(send, m); } }
        const int q = lane >> 5, e = lane & 31; const int r = rr[q]; const int il = 2 * rp + q;
        float logit = v[0] * rsv[q] + bias2[(r < CTX ? 32 : 0) + e];
        float cur = logit; int sel[4]; float sv[4];
#pragma unroll
        for (int k = 0; k < 4; ++k) { float mx = cur;
#pragma unroll
            for (int o = 16; o >= 1; o >>= 1) mx = fmaxf(mx, __shfl_xor(mx, o));
            const unsigned long long bal = __ballot(cur == mx); const unsigned half = (unsigned)(bal >> (q * 32)); const int win = __ffs(half) - 1;
            sel[k] = win; sv[k] = mx; if (e == win) cur = -3.0e38f; }
        if (e < 4 && il < ROWS_PB) {
            float es[4], sum = 0.f;
#pragma unroll
            for (int k = 0; k < 4; ++k) { es[k] = __expf(sv[k] - sv[0]); sum += es[k]; }
            const int myk = e; const int mye = myk == 0 ? sel[0] : myk == 1 ? sel[1] : myk == 2 ? sel[2] : sel[3]; const float myw = (myk == 0 ? es[0] : myk == 1 ? es[1] : myk == 2 ? es[2] : es[3]) / sum;
            p.topw[(size_t)r * 4 + myk] = myw; const int pos = atomicAdd(&lcnt[mye], 1); rec[il * 4 + myk] = mye | (pos << 8);
        }
    }
    __syncthreads();
    if (tid < 32) lbase[tid] = atomicAdd(&p.cnt[tid], lcnt[tid]);
    __syncthreads();
    if (tid < ROWS_PB * 4) { const int il = tid >> 2, k = tid & 3; const int r = blockIdx.x * ROWS_PB + il; const int rc = rec[tid]; const int e = rc & 255, pos = rc >> 8;
        p.list[(size_t)e * M + lbase[e] + pos] = r * 4 + k; }
    __syncthreads();
}
}

namespace ml {
typedef short bf16x8 __attribute__((ext_vector_type(8)));
typedef float f32x4 __attribute__((ext_vector_type(4)));
typedef unsigned u32x2 __attribute__((ext_vector_type(2)));
constexpr int RB = 65, MT = 5;
constexpr int AQ_STRIDE = QL * 2 + 16, AKV_STRIDE = KVL * 2 + 16;
constexpr int OFF_AQ = 0, OFF_AKV = OFF_AQ + 80 * AQ_STRIDE, OFF_KRS = OFF_AKV + 80 * AKV_STRIDE, OFF_KSS = OFF_KRS + 80 * 32 * 4, LDS_MLA = OFF_KSS + 80 * 4;
struct MW { const bf16_t* w_uq_t; const bf16_t* w_ukv_t; const float* ropec; const float* ropes; const float* proj; int ldp; bf16_t* qb; bf16_t* kb; bf16_t* vb; };
__device__ __forceinline__ void mla_phase(const P& p, const MW& w, int l, char* lds) {
    int tid = threadIdx.x; asm volatile("" : "+v"(tid)); const int wid = __builtin_amdgcn_readfirstlane(tid >> 6), lane = tid & 63, fr = lane & 15, fq = lane >> 4;
    const int row0 = blockIdx.x * RB;
    for (int i = wid; i < 80; i += 8) {
        char* aq = lds + OFF_AQ + i * AQ_STRIDE; char* akv = lds + OFF_AKV + i * AKV_STRIDE; float* krs = (float*)(lds + OFF_KRS) + i * 32;
        if (i < RB && row0 + i < M) { const float* pr = w.proj + (size_t)(row0 + i) * w.ldp;
            { const f32x4 x = *(const f32x4*)(pr + C_Q + 4 * lane); float ss = rw::wave_sum(x[0] * x[0] + x[1] * x[1] + x[2] * x[2] + x[3] * x[3]); const float rs = 1.0f / sqrtf(ss * (1.0f / QL) + EPS);
              const f32x4 g = *(const f32x4*)(p.q_g + l * QL + 4 * lane); const f32x4 o = x * rs * g; u32x2 v; v.x = rw::pk2(o[0], o[1]); v.y = rw::pk2(o[2], o[3]); *(u32x2*)(aq + 8 * lane) = v; }
            { f32x4 x = {0.f, 0.f, 0.f, 0.f}; if (lane < 32) x = *(const f32x4*)(pr + C_KV + 4 * lane); float ss = rw::wave_sum(x[0] * x[0] + x[1] * x[1] + x[2] * x[2] + x[3] * x[3]); const float rs = 1.0f / sqrtf(ss * (1.0f / KVL) + EPS);
              if (lane < 32) { const f32x4 g = *(const f32x4*)(p.kv_g + l * KVL + 4 * lane); const f32x4 o = x * rs * g; u32x2 v; v.x = rw::pk2(o[0], o[1]); v.y = rw::pk2(o[2], o[3]); *(u32x2*)(akv + 8 * lane) = v; } }
            { f32x4 x = {0.f, 0.f, 0.f, 0.f}; if (lane < 8) { x = *(const f32x4*)(pr + C_KR + 4 * lane); *(f32x4*)(krs + 4 * lane) = x; }
              const float ss = rw::wave_sum(x[0] * x[0] + x[1] * x[1] + x[2] * x[2] + x[3] * x[3]); if (lane == 0) ((float*)(lds + OFF_KSS))[i] = ss; }
        } else {
            u32x2 z; z.x = 0u; z.y = 0u; *(u32x2*)(aq + 8 * lane) = z; if (lane < 32) *(u32x2*)(akv + 8 * lane) = z; if (lane < 32) krs[lane] = 0.f; if (lane == 0) ((float*)(lds + OFF_KSS))[i] = 0.f;
        }
    }
    __syncthreads();
    if (wid < 6) {
        const int hh = wid; f32x4 acc[MT][6];
#pragma unroll
        for (int mt = 0; mt < MT; ++mt)
#pragma unroll
            for (int nt = 0; nt < 6; ++nt) acc[mt][nt] = (f32x4){0.f, 0.f, 0.f, 0.f};
        const bf16_t* wb = w.w_uq_t + (size_t)(hh * QKD + fr) * QL + 8 * fq;
#pragma unroll 1
        for (int ks = 0; ks < QL / 32; ++ks) { bf16x8 b[6], a[MT];
#pragma unroll
            for (int nt = 0; nt < 6; ++nt) b[nt] = *(const bf16x8*)(wb + (size_t)nt * 16 * QL + ks * 32);
#pragma unroll
            for (int mt = 0; mt < MT; ++mt) a[mt] = *(const bf16x8*)(lds + OFF_AQ + (mt * 16 + fr) * AQ_STRIDE + (ks * 32 + 8 * fq) * 2);
#pragma unroll
            for (int mt = 0; mt < MT; ++mt)
#pragma unroll
                for (int nt = 0; nt < 6; ++nt) acc[mt][nt] = __builtin_amdgcn_mfma_f32_16x16x32_bf16(b[nt], a[mt], acc[mt][nt], 0, 0, 0); }
        f32x4 gq[6];
#pragma unroll
        for (int nt = 0; nt < 6; ++nt) gq[nt] = *(const f32x4*)(p.qn_g + l * QKD + nt * 16 + 4 * fq);
#pragma unroll
        for (int mt = 0; mt < MT; ++mt) { const int il = mt * 16 + fr; const int r = row0 + il; const bool ok = il < RB && r < M; float ss = 0.f;
#pragma unroll
            for (int nt = 0; nt < 6; ++nt) ss += acc[mt][nt][0] * acc[mt][nt][0] + acc[mt][nt][1] * acc[mt][nt][1] + acc[mt][nt][2] * acc[mt][nt][2] + acc[mt][nt][3] * acc[mt][nt][3];
            ss += __shfl_xor(ss, 16); ss += __shfl_xor(ss, 32); const float rs = 1.0f / sqrtf(ss * (1.0f / QKD) + EPS);
            const bool lat = r >= CTX; const int t = lat ? r - CTX : 0;
#pragma unroll
            for (int nt = 0; nt < 6; ++nt) { f32x4 v = acc[mt][nt] * rs * gq[nt];
                if (nt >= 4) { f32x4 other; other[0] = __shfl_xor(v[0], 32); other[1] = __shfl_xor(v[1], 32); other[2] = __shfl_xor(v[2], 32); other[3] = __shfl_xor(v[3], 32);
                    if (lat && ok) { const int pos = (nt == 4) ? (t / GRID_W) : (t % GRID_W); const f32x4 cs = *(const f32x4*)(w.ropec + (size_t)pos * 8 + 4 * (fq & 1)), sn = *(const f32x4*)(w.ropes + (size_t)pos * 8 + 4 * (fq & 1));
                        v = (fq >> 1) ? (v * cs + other * sn) : (v * cs - other * sn); } }
                if (ok) { u32x2 o; o.x = rw::pk2(v[0], v[1]); o.y = rw::pk2(v[2], v[3]); *(u32x2*)(w.qb + ((size_t)r * NH + hh) * QKD + nt * 16 + 4 * fq) = o; } } }
    } else {
        for (int hs = 0; hs < 3; ++hs) { const int hh = (wid - 6) * 3 + hs;
#pragma unroll
          for (int pass = 0; pass < 2; ++pass) { f32x4 acc[MT][4];
#pragma unroll
            for (int mt = 0; mt < MT; ++mt)
#pragma unroll
                for (int nt = 0; nt < 4; ++nt) acc[mt][nt] = (f32x4){0.f, 0.f, 0.f, 0.f};
            const bf16_t* wb = w.w_ukv_t + (size_t)(hh * 128 + pass * 64 + fr) * KVL + 8 * fq;
#pragma unroll 1
            for (int ks = 0; ks < KVL / 32; ++ks) { bf16x8 b[4], a[MT];
#pragma unroll
                for (int nt = 0; nt < 4; ++nt) b[nt] = *(const bf16x8*)(wb + (size_t)nt * 16 * KVL + ks * 32);
#pragma unroll
                for (int mt = 0; mt < MT; ++mt) a[mt] = *(const bf16x8*)(lds + OFF_AKV + (mt * 16 + fr) * AKV_STRIDE + (ks * 32 + 8 * fq) * 2);
#pragma unroll
                for (int mt = 0; mt < MT; ++mt)
#pragma unroll
                    for (int nt = 0; nt < 4; ++nt) acc[mt][nt] = __builtin_amdgcn_mfma_f32_16x16x32_bf16(b[nt], a[mt], acc[mt][nt], 0, 0, 0); }
            if (pass == 0) {
                f32x4 gk[4], gr[2], gro[2];
#pragma unroll
                for (int nt = 0; nt < 4; ++nt) gk[nt] = *(const f32x4*)(p.kn_g + l * QKD + nt * 16 + 4 * fq);
#pragma unroll
                for (int a = 0; a < 2; ++a) { gr[a] = *(const f32x4*)(p.kn_g + l * QKD + NOPE + a * 16 + 4 * fq); gro[a] = *(const f32x4*)(p.kn_g + l * QKD + NOPE + a * 16 + ((4 * fq) ^ 8)); }
#pragma unroll
                for (int mt = 0; mt < MT; ++mt) { const int il = mt * 16 + fr; const int r = row0 + il; const bool ok = il < RB && r < M; float ss = 0.f;
#pragma unroll
                    for (int nt = 0; nt < 4; ++nt) ss += acc[mt][nt][0] * acc[mt][nt][0] + acc[mt][nt][1] * acc[mt][nt][1] + acc[mt][nt][2] * acc[mt][nt][2] + acc[mt][nt][3] * acc[mt][nt][3];
                    ss += __shfl_xor(ss, 16); ss += __shfl_xor(ss, 32); ss += ((const float*)(lds + OFF_KSS))[il]; const float rs = 1.0f / sqrtf(ss * (1.0f / QKD) + EPS);
                    const bool lat = r >= CTX; const int t = lat ? r - CTX : 0;
                    if (ok) {
                        bf16_t* kd = w.kb + ((size_t)r * NH + hh) * QKD; const float* krs = (const float*)(lds + OFF_KRS) + il * 32;
#pragma unroll
                        for (int nt = 0; nt < 4; ++nt) { const f32x4 v = acc[mt][nt] * rs * gk[nt]; u32x2 o; o.x = rw::pk2(v[0], v[1]); o.y = rw::pk2(v[2], v[3]); *(u32x2*)(kd + nt * 16 + 4 * fq) = o; }
#pragma unroll
                        for (int a = 0; a < 2; ++a) { f32x4 v = *(const f32x4*)(krs + a * 16 + 4 * fq) * rs * gr[a]; const f32x4 other = *(const f32x4*)(krs + a * 16 + ((4 * fq) ^ 8)) * rs * gro[a];
                            if (lat) { const int pos = (a == 0) ? (t / GRID_W) : (t % GRID_W); const f32x4 cs = *(const f32x4*)(w.ropec + (size_t)pos * 8 + 4 * (fq & 1)), sn = *(const f32x4*)(w.ropes + (size_t)pos * 8 + 4 * (fq & 1));
                                v = (fq >> 1) ? (v * cs + other * sn) : (v * cs - other * sn); }
                            u32x2 o; o.x = rw::pk2(v[0], v[1]); o.y = rw::pk2(v[2], v[3]); *(u32x2*)(kd + NOPE + a * 16 + 4 * fq) = o; }
                    } }
            } else {
#pragma unroll
                for (int mt = 0; mt < MT; ++mt) { const int il = mt * 16 + fr; const int r = row0 + il; const bool ok = il < RB && r < M;
                    if (ok) { bf16_t* vd = w.vb + ((size_t)r * NH + hh) * VD;
#pragma unroll
                        for (int nt = 0; nt < 4; ++nt) { const f32x4 v = acc[mt][nt]; u32x2 o; o.x = rw::pk2(v[0], v[1]); o.y = rw::pk2(v[2], v[3]); *(u32x2*)(vd + nt * 16 + 4 * fq) = o; } } }
            }
          }
        }
    }
    __syncthreads();
}
}

namespace sd {
typedef short bf16x8 __attribute__((ext_vector_type(8)));
typedef float f32x4 __attribute__((ext_vector_type(4)));
typedef unsigned u32x2 __attribute__((ext_vector_type(2)));
typedef unsigned u32x4 __attribute__((ext_vector_type(4)));
constexpr int SBS = 144, STS = 272;
constexpr int OFF_BM = 0, OFF_CM = OFF_BM + 128 * SBS, OFF_XT = OFF_CM + 128 * SBS, OFF_BTF = OFF_XT + 64 * STS, OFF_BTB = OFF_BTF + 64 * STS, OFF_L = OFF_BTB + 64 * STS, OFF_SC = OFF_L + 128 * STS, LDS_SSD = OFF_SC + 4 * 128 * 4;
struct SsdW { const float* proj; int ldp; float* yd; float* st; float* cdec; float* cs; bf16_t* cg; bf16_t* prevb; };
__device__ __forceinline__ bf16x8 ldfrag(const char* base, int row, int stride, int kbyte) { return *(const bf16x8*)(base + row * stride + kbyte); }
__device__ __forceinline__ float silu_f(float x) { return x / (1.0f + __expf(-x)); }
__device__ __forceinline__ void chunk_unit(const P& p, const SsdW& w, int l, int c, int hh, char* lds) {
    int tid = threadIdx.x; asm volatile("" : "+v"(tid)); const int wid = __builtin_amdgcn_readfirstlane(tid >> 6), lane = tid & 63, fr = lane & 15, fq = lane >> 4;
    const int R0 = c * CHUNK, g = hh / (SH / SG); const int seg0 = R0 < CTX ? 0 : CTX, seg1 = R0 < CTX ? CTX : M;
    float* csf = (float*)(lds + OFF_SC); float* csb = csf + 128; float* dtf = csb + 128; float* dtb = dtf + 128;
    if (tid < 256) { const int r = tid & 127, d = tid >> 7; const float v = softplusf(w.proj[(size_t)(R0 + r) * w.ldp + C_DT + d * 6 + hh] + p.dt_bias[l * 12 + d * 6 + hh]); (d ? dtb : dtf)[r] = v; }
    __syncthreads();
    if (wid < 2) {
        const int d = wid; const float a = -__expf(p.a_log[l * 12 + d * 6 + hh]); const float* dts = d ? dtb : dtf; float* cso = d ? csb : csf;
        const int i0 = 2 * lane, i1 = 2 * lane + 1; const int r0 = d ? 127 - i0 : i0, r1 = d ? 127 - i1 : i1;
        const float v0 = dts[r0] * a, v1 = dts[r1] * a; float s = v0 + v1;
#pragma unroll
        for (int o = 1; o < 64; o <<= 1) { const float t = __shfl_up(s, o); if (lane >= o) s += t; }
        const float excl = s - (v0 + v1); const float c0 = excl + v0, c1 = c0 + v1; cso[r0] = c0; cso[r1] = c1;
        w.cs[((size_t)d * M + R0 + r0) * SH + hh] = c0; w.cs[((size_t)d * M + R0 + r1) * SH + hh] = c1;
        if (lane == 63) w.cdec[((size_t)d * NCH + c) * SH + hh] = __expf(c1);
    }
    __syncthreads();
    {   const int col = tid & 63, l0 = (tid >> 6) * 16; const float cfe = csf[127], cbe = csb[0];
#pragma unroll
        for (int which = 0; which < 3; ++which) { const int cidx = which == 0 ? hh * SP + col : (which == 1 ? SW + g * SN + col : SW + SG * SN + g * SN + col);
            const float w0 = p.conv_w[((size_t)l * 4 + 0) * CONVD + cidx], w1 = p.conv_w[((size_t)l * 4 + 1) * CONVD + cidx], w2 = p.conv_w[((size_t)l * 4 + 2) * CONVD + cidx], w3 = p.conv_w[((size_t)l * 4 + 3) * CONVD + cidx], bb = p.conv_b[l * CONVD + cidx];
            float v[19];
#pragma unroll
            for (int i = 0; i < 19; ++i) { const int r = R0 + l0 - 2 + i; v[i] = (r >= seg0 && r < seg1) ? w.proj[(size_t)r * w.ldp + C_XBC + cidx] : 0.f; }
            float y[16];
#pragma unroll
            for (int i = 0; i < 16; ++i) y[i] = silu_f(bb + w0 * v[i] + w1 * v[i + 1] + w2 * v[i + 2] + w3 * v[i + 3]);
            if (which == 0) {
                u32x4 a, b; a.x = rw::pk2(y[0], y[1]); a.y = rw::pk2(y[2], y[3]); a.z = rw::pk2(y[4], y[5]); a.w = rw::pk2(y[6], y[7]); b.x = rw::pk2(y[8], y[9]); b.y = rw::pk2(y[10], y[11]); b.z = rw::pk2(y[12], y[13]); b.w = rw::pk2(y[14], y[15]);
                *(u32x4*)(lds + OFF_XT + col * STS + l0 * 2) = a; *(u32x4*)(lds + OFF_XT + col * STS + l0 * 2 + 16) = b;
            } else if (which == 1) {
                float yf[16], yb[16];
#pragma unroll
                for (int i = 0; i < 16; ++i) { *(bf16_t*)(lds + OFF_BM + (l0 + i) * SBS + col * 2) = f2bf(y[i]); yf[i] = y[i] * __expf(cfe - csf[l0 + i]) * dtf[l0 + i]; yb[i] = y[i] * __expf(cbe - csb[l0 + i]) * dtb[l0 + i]; }
                u32x4 a, b; a.x = rw::pk2(yf[0], yf[1]); a.y = rw::pk2(yf[2], yf[3]); a.z = rw::pk2(yf[4], yf[5]); a.w = rw::pk2(yf[6], yf[7]); b.x = rw::pk2(yf[8], yf[9]); b.y = rw::pk2(yf[10], yf[11]); b.z = rw::pk2(yf[12], yf[13]); b.w = rw::pk2(yf[14], yf[15]);
                *(u32x4*)(lds + OFF_BTF + col * STS + l0 * 2) = a; *(u32x4*)(lds + OFF_BTF + col * STS + l0 * 2 + 16) = b;
                a.x = rw::pk2(yb[0], yb[1]); a.y = rw::pk2(yb[2], yb[3]); a.z = rw::pk2(yb[4], yb[5]); a.w = rw::pk2(yb[6], yb[7]); b.x = rw::pk2(yb[8], yb[9]); b.y = rw::pk2(yb[10], yb[11]); b.z = rw::pk2(yb[12], yb[13]); b.w = rw::pk2(yb[14], yb[15]);
                *(u32x4*)(lds + OFF_BTB + col * STS + l0 * 2) = a; *(u32x4*)(lds + OFF_BTB + col * STS + l0 * 2 + 16) = b;
            } else {
#pragma unroll
                for (int i = 0; i < 16; ++i) { const bf16_t cv = f2bf(y[i]); *(bf16_t*)(lds + OFF_CM + (l0 + i) * SBS + col * 2) = cv; if (hh % (SH / SG) == 0) w.cg[((size_t)(R0 + l0 + i) * SG + g) * SN + col] = cv; }
            } }
    }
    __syncthreads();
    {   const int lt = wid, lrow = 16 * lt + fr; const bf16x8 c0 = ldfrag(lds + OFF_CM, lrow, SBS, 16 * fq), c1 = ldfrag(lds + OFF_CM, lrow, SBS, 64 + 16 * fq);
        const float cfl = csf[lrow], cbl = csb[lrow], Dh = p.ssd_d[l * SH + hh];
#pragma unroll
        for (int st = 0; st < 8; ++st) { const bf16x8 b0 = ldfrag(lds + OFF_BM, 16 * st + fr, SBS, 16 * fq), b1 = ldfrag(lds + OFF_BM, 16 * st + fr, SBS, 64 + 16 * fq);
            f32x4 acc = {0.f, 0.f, 0.f, 0.f}; acc = __builtin_amdgcn_mfma_f32_16x16x32_bf16(b0, c0, acc, 0, 0, 0); acc = __builtin_amdgcn_mfma_f32_16x16x32_bf16(b1, c1, acc, 0, 0, 0);
            const int s0 = 16 * st + 4 * fq; const f32x4 cfs = *(const f32x4*)(csf + s0), cbs = *(const f32x4*)(csb + s0), dfs = *(const f32x4*)(dtf + s0), dbs = *(const f32x4*)(dtb + s0); float o[4];
#pragma unroll
            for (int j = 0; j < 4; ++j) { const int s = s0 + j; const float ef = s <= lrow ? __expf(fminf(cfl - cfs[j], 0.f)) * dfs[j] : 0.f; const float eb = s >= lrow ? __expf(fminf(cbl - cbs[j], 0.f)) * dbs[j] : 0.f;
                o[j] = acc[j] * (ef + eb) + (s == lrow ? Dh : 0.f); }
            u32x2 pk; pk.x = rw::pk2(o[0], o[1]); pk.y = rw::pk2(o[2], o[3]); *(u32x2*)(lds + OFF_L + lrow * STS + s0 * 2) = pk; }
    }
    __syncthreads();
    {   const int lt = wid, lrow = 16 * lt + fr; bf16x8 lf[4];
#pragma unroll
        for (int ks = 0; ks < 4; ++ks) lf[ks] = ldfrag(lds + OFF_L, lrow, STS, 64 * ks + 16 * fq);
#pragma unroll
        for (int pt = 0; pt < 4; ++pt) { f32x4 acc = {0.f, 0.f, 0.f, 0.f};
#pragma unroll
            for (int ks = 0; ks < 4; ++ks) acc = __builtin_amdgcn_mfma_f32_16x16x32_bf16(ldfrag(lds + OFF_XT, 16 * pt + fr, STS, 64 * ks + 16 * fq), lf[ks], acc, 0, 0, 0);
            *(f32x4*)(w.yd + (size_t)(R0 + lrow) * SW + hh * SP + 16 * pt + 4 * fq) = acc; }
    }
    {   const int d = wid >> 2, ptile = wid & 3, prow = 16 * ptile + fr; bf16x8 xf[4]; const char* bt = lds + (d ? OFF_BTB : OFF_BTF);
#pragma unroll
        for (int ks = 0; ks < 4; ++ks) xf[ks] = ldfrag(lds + OFF_XT, prow, STS, 64 * ks + 16 * fq);
#pragma unroll
        for (int nt = 0; nt < 4; ++nt) { f32x4 acc = {0.f, 0.f, 0.f, 0.f};
#pragma unroll
            for (int ks = 0; ks < 4; ++ks) acc = __builtin_amdgcn_mfma_f32_16x16x32_bf16(ldfrag(bt, 16 * nt + fr, STS, 64 * ks + 16 * fq), xf[ks], acc, 0, 0, 0);
            *(f32x4*)(w.st + ((((size_t)d * NCH + c) * SH + hh) * SP + prow) * SN + 16 * nt + 4 * fq) = acc; }
    }
    __syncthreads();
}
__device__ __forceinline__ void carry_phase(const SsdW& w) {
    int tid = threadIdx.x; asm volatile("" : "+v"(tid));
    constexpr int PER = 2 * SH * SP * SN / 256;
    if (tid < PER) { const int eidx = blockIdx.x * PER + tid; if (eidx < 2 * SH * SP * SN) { const int dir = eidx / (SH * SP * SN), rem = eidx % (SH * SP * SN), hh = rem / (SP * SN), e = rem % (SP * SN); float state = 0.f;
        for (int b = 0; b < NCH / 13; ++b) { float sv[13], dv[13]; size_t ov[13];
#pragma unroll
            for (int j = 0; j < 13; ++j) { const int i = b * 13 + j; const int c = dir == 0 ? i : (i < CTX / CHUNK ? CTX / CHUNK - 1 - i : NCH - 1 - (i - CTX / CHUNK));
                ov[j] = (((size_t)dir * NCH + c) * SH + hh) * (SP * SN) + e; sv[j] = w.st[ov[j]]; dv[j] = w.cdec[((size_t)dir * NCH + c) * SH + hh]; }
#pragma unroll
            for (int j = 0; j < 13; ++j) { w.prevb[ov[j]] = f2bf(state); state = state * dv[j] + sv[j]; } } } }
}
__device__ __forceinline__ void final_phase(const P& p, const SsdW& w, int l, bf16_t* dst, int ldd) {
    int tid = threadIdx.x; asm volatile("" : "+v"(tid)); const int wid = __builtin_amdgcn_readfirstlane(tid >> 6), lane = tid & 63, fr = lane & 15, fq = lane >> 4;
    const int ltg = wid * gridDim.x + blockIdx.x; if (ltg >= M / 16) return;
    const int r = ltg * 16 + fr, c = (ltg * 16) / CHUNK;
    bf16x8 cf[2][2];
#pragma unroll
    for (int g = 0; g < 2; ++g)
#pragma unroll
        for (int ks = 0; ks < 2; ++ks) cf[g][ks] = *(const bf16x8*)(w.cg + ((size_t)r * SG + g) * SN + 32 * ks + 8 * fq);
    f32x4 gv[SH][4]; float ss = 0.f;
#pragma unroll
    for (int hh = 0; hh < SH; ++hh) { const int g = hh / (SH / SG); const float ef = __expf(w.cs[(size_t)r * SH + hh]), eb = __expf(w.cs[((size_t)M + r) * SH + hh]);
#pragma unroll
        for (int pt = 0; pt < 4; ++pt) { f32x4 af = {0.f, 0.f, 0.f, 0.f}, ab = {0.f, 0.f, 0.f, 0.f};
            const bf16_t* pf = w.prevb + ((((size_t)0 * NCH + c) * SH + hh) * SP + 16 * pt + fr) * SN + 8 * fq; const bf16_t* pb = w.prevb + ((((size_t)1 * NCH + c) * SH + hh) * SP + 16 * pt + fr) * SN + 8 * fq;
#pragma unroll
            for (int ks = 0; ks < 2; ++ks) { af = __builtin_amdgcn_mfma_f32_16x16x32_bf16(*(const bf16x8*)(pf + 32 * ks), cf[g][ks], af, 0, 0, 0); ab = __builtin_amdgcn_mfma_f32_16x16x32_bf16(*(const bf16x8*)(pb + 32 * ks), cf[g][ks], ab, 0, 0, 0); }
            const int col = hh * SP + 16 * pt + 4 * fq; const f32x4 yd = *(const f32x4*)(w.yd + (size_t)r * SW + col), z = *(const f32x4*)(w.proj + (size_t)r * w.ldp + C_Z + col);
            f32x4 y = yd + af * ef + ab * eb;
#pragma unroll
            for (int j = 0; j < 4; ++j) { y[j] *= silu_f(z[j]); ss += y[j] * y[j]; }
            gv[hh][pt] = y; } }
    ss += __shfl_xor(ss, 16); ss += __shfl_xor(ss, 32); const float rs = 1.0f / sqrtf(ss * (1.0f / SW) + EPS);
#pragma unroll
    for (int hh = 0; hh < SH; ++hh)
#pragma unroll
        for (int pt = 0; pt < 4; ++pt) { const int col = hh * SP + 16 * pt + 4 * fq; const f32x4 o = gv[hh][pt] * rs * *(const f32x4*)(p.ssd_norm_g + l * SW + col);
            u32x2 pk; pk.x = rw::pk2(o[0], o[1]); pk.y = rw::pk2(o[2], o[3]); *(u32x2*)(dst + (size_t)r * ldd + col) = pk; }
}
}

namespace mc {
typedef float f32x4 __attribute__((ext_vector_type(4)));
__device__ __forceinline__ void modvec_phase(const P& p, char* lds) {
    int tid = threadIdx.x; asm volatile("" : "+v"(tid));
    float* sc = (float*)lds; float* part = sc + 2 * D;
    for (int i = tid; i < 2 * D; i += 512) { const float v = i < D ? p.c[i] : p.c_ctx[i - D]; sc[i] = v / (1.0f + __expf(-v)); }
    __syncthreads();
    constexpr int NCK = 6 * D / 128, NU = DEPTH * NCK;
    for (int u = blockIdx.x; u < NU; u += gridDim.x) { const int l = u / NCK, j = (u % NCK) * 128 + (tid & 127), kg = tid >> 7; const float* wp = p.mod_w + (size_t)l * D * 6 * D + j; float a0 = 0.f, a1 = 0.f;
#pragma unroll 8
        for (int k = kg; k < D; k += 4) { const float wv = wp[(size_t)k * 6 * D]; a0 += sc[k] * wv; a1 += sc[D + k] * wv; }
        part[(kg * 2 + 0) * 128 + (tid & 127)] = a0; part[(kg * 2 + 1) * 128 + (tid & 127)] = a1;
        __syncthreads();
        if (tid < 256) { const int which = tid >> 7, cc = tid & 127; const float s = part[(0 * 2 + which) * 128 + cc] + part[(1 * 2 + which) * 128 + cc] + part[(2 * 2 + which) * 128 + cc] + part[(3 * 2 + which) * 128 + cc];
            const int jj = (u % NCK) * 128 + cc; p.mod[((size_t)(l * 2 + which) * 6) * D + jj] = s + p.mod_b[(size_t)l * 6 * D + jj]; }
        __syncthreads(); }
}
__device__ __forceinline__ void pool_phase(const P& p, const float* proj, int ldp, int l, bf16_t* dst, int ldd, char* lds) {
    int tid = threadIdx.x; asm volatile("" : "+v"(tid));
    constexpr int RB = 65; float* pm = (float*)lds;
    const int row0 = blockIdx.x * RB;
    {   const int c = tid & 255, gi = c >> 6, win = 2 << gi;
        for (int i = tid >> 8; i < RB; i += 2) { const int r = row0 + i; if (r >= M) break; const int seg0 = r < CTX ? 0 : CTX, n = r < CTX ? CTX : SEQ, t = r - seg0;
            int lo = t - win / 2, hi = t - win / 2 + win; lo = lo < 0 ? 0 : lo; hi = hi > n ? n : hi; float s = 0.f;
            for (int tt = lo; tt < hi; ++tt) s += proj[(size_t)(seg0 + tt) * ldp + C_POOL + c];
            pm[i * 256 + c] = s / (float)(hi - lo) - proj[(size_t)r * ldp + C_POOL + c]; } }
    __syncthreads();
    {   const int d = tid & 63, gi = (tid >> 6) & 3, rh = tid >> 8; float wcol[64]; const float* wp = p.pool_w + (((size_t)l * 4 + gi) * 64) * 64 + d;
#pragma unroll
        for (int c = 0; c < 64; ++c) wcol[c] = wp[(size_t)c * 64];
        const float scl = p.pool_scale[l * PW + gi * 64 + d];
        for (int i = rh; i < RB; i += 2) { const int r = row0 + i; if (r >= M) break; const f32x4* pr = (const f32x4*)(pm + i * 256 + gi * 64); float acc = 0.f;
#pragma unroll
            for (int c4 = 0; c4 < 16; ++c4) { const f32x4 v = pr[c4]; acc += v[0] * wcol[4 * c4] + v[1] * wcol[4 * c4 + 1] + v[2] * wcol[4 * c4 + 2] + v[3] * wcol[4 * c4 + 3]; }
            dst[(size_t)r * ldd + gi * 64 + d] = f2bf(acc * scl); } }
    __syncthreads();
}
}

#ifndef CHECK_MLA
#define CHECK_MLA 0
#endif
#ifndef CHECK_SSD
#define CHECK_SSD 0
#endif
__device__ __forceinline__ int gtid() { int t = threadIdx.x; asm volatile("" : "+v"(t)); return blockIdx.x * 512 + t; }
template <int OP> __device__ __forceinline__ void run_op(const P& p, int l) {
    const long n = op_count(OP); const long stride = (long)gridDim.x * blockDim.x;
    for (long i = gtid(); i < n; i += stride) op_run(OP, p, l, i);
}
struct KArgs { P p; FW f; unsigned* bar; };
__device__ __forceinline__ const KArgs& kargs() { auto q = __builtin_amdgcn_kernarg_segment_ptr(); asm volatile("" : "+s"(q)); return *(const KArgs*)q; }
constexpr int LDS_BYTES = gm::STAGE_BYTES + 4096;
#define BAR() do { XcdBarrier b2_; b2_.bar = kargs().bar; unsigned xx_ = xbx; asm volatile("" : "+s"(xx_)); b2_.x = xx_; b2_.st = (volatile LAS unsigned*)(lds + LDS_BYTES - 16); xcd_barrier(b2_); } while (0)
#define PH(OPX) do { run_op<OPX>(kargs().p, lo()); BAR(); } while (0)
#define RUN(OPX) run_op<OPX>(kargs().p, lo())

template <class TO> __device__ __forceinline__ void attn_phase(const P& p, TO* O, int ldo, char* lds) {
    constexpr int NQT = M / 256, NU = NH * NQT;
    for (int u = blockIdx.x; u < NU; u += gridDim.x) {
        const int hh = u / NQT, qt = u % NQT; const int seq = qt == 0 ? CTX : M;
        __syncthreads();
        at::attn_body<TO>(p.qb + (size_t)qt * 256 * at::LDQ + hh * at::DQ, p.kb + hh * at::DQ, p.vb + hh * at::DV, O + (size_t)qt * 256 * ldo + hh * at::DV, ldo, seq, lds);
    }
    __syncthreads();
}
template <class TA> __device__ __forceinline__ float ldf(const TA* a, size_t i);
template <> __device__ __forceinline__ float ldf<float>(const float* a, size_t i) { return a[i]; }
template <> __device__ __forceinline__ float ldf<bf16_t>(const bf16_t* a, size_t i) { return bf2f(a[i]); }
template <class TA, class TB> __device__ __forceinline__ void chk_accum(const TA* a, int lda, const TB* b, int ldb, long nrows, int ncols, float* diag) {
    float sd = 0.f, sr = 0.f; const long n = nrows * ncols; const long stride = (long)gridDim.x * blockDim.x;
    for (long i = gtid(); i < n; i += stride) { const long r = i / ncols; const int c = (int)(i % ncols);
        const float x = ldf<TA>(a, r * lda + c), y = ldf<TB>(b, r * ldb + c); sd += (x - y) * (x - y); sr += y * y; }
    for (int o = 32; o >= 1; o >>= 1) { sd += __shfl_xor(sd, o); sr += __shfl_xor(sr, o); }
    if ((threadIdx.x & 63) == 0) { atomicAdd(diag, sd); atomicAdd(diag + 1, sr); }
}
#define MLA_CALL(QB, KB, VB) { const int ll_ = lo(); ml::MW mw_; mw_.qb = (QB); mw_.kb = (KB); mw_.vb = (VB); mw_.w_uq_t = KF.w_uq_t + (size_t)ll_ * NH * QKD * QL; mw_.w_ukv_t = KF.w_ukv_t + (size_t)ll_ * NH * 128 * KVL; \
        mw_.ropec = KF.ropec; mw_.ropes = KF.ropes; mw_.proj = KP.proj; mw_.ldp = INC; ml::mla_phase(KP, mw_, ll_, lds); }
#if CHECK_MLA
#define MLA_STEP PH(OP_LATNORM); RUN(OP_QRAW); PH(OP_KVRAW); RUN(OP_QHEAD); RUN(OP_KHEAD); if (l == 0) { MLA_CALL(KF.qb2, KF.kb2, KF.vb2) } BAR(); \
        if (l == 0) { chk_accum<bf16_t, bf16_t>(KF.qb2, NH * QKD, KP.qb, NH * QKD, M, NH * QKD, KP.diag + 0); chk_accum<bf16_t, bf16_t>(KF.kb2, NH * QKD, KP.kb, NH * QKD, M, NH * QKD, KP.diag + 2); chk_accum<bf16_t, bf16_t>(KF.vb2, NH * VD, KP.vb, NH * VD, M, NH * VD, KP.diag + 4); }
#else
#define MLA_STEP MLA_CALL(KP.qb, KP.kb, KP.vb) BAR();
#endif
#define SSD_W(NAME) sd::SsdW NAME; NAME.proj = KP.proj; NAME.ldp = INC; NAME.yd = KF.yd2; NAME.st = KF.st2; NAME.cdec = KF.cdec2; NAME.cs = KF.cs2; NAME.cg = KF.cg; NAME.prevb = KF.prevb;
#define SSD_S1() { SSD_W(sw_) const int ll_ = lo(); for (int u = blockIdx.x; u < NCH * SH; u += gridDim.x) sd::chunk_unit(KP, sw_, ll_, u / SH, u % SH, lds); }
#define SSD_S2() { SSD_W(sw_) sd::carry_phase(sw_); }
#define SSD_S3(DST, LDD) { SSD_W(sw_) sd::final_phase(KP, sw_, lo(), (DST), (LDD)); }
#if CHECK_SSD
#define SSD_STEPS RUN(OP_CONV); RUN(OP_DT); PH(OP_POOLP); RUN(OP_SSD_CS); RUN(OP_SSD_G); PH(OP_POOLMM); attn_phase<float>(KP, KP.mixin, MIXW, lds); RUN(OP_SSD_YD); PH(OP_SSD_ST); PH(OP_SSD_CARRY); PH(OP_SSD_YOFF); PH(OP_SSDFIN); \
        if (l == 0) { SSD_S1() BAR(); SSD_S2() BAR(); SSD_S3(KF.ssdb2, SW) BAR(); chk_accum<bf16_t, float>(KF.ssdb2, SW, KP.mixin + NH * VD, MIXW, M, SW, KP.diag + 0); } PH(OP_MIXB);
#else
#define SSD_STEPS mc::pool_phase(KP, KP.proj, INC, lo(), KP.mixb + NH * VD + SW, MIXW, lds); SSD_S1() BAR(); attn_phase<bf16_t>(KP, KP.mixb, MIXW, lds); SSD_S2() BAR(); SSD_S3(KP.mixb + NH * VD, MIXW) BAR();
#endif
#define LAYER_BODY(L) { const int l = (L); \
        auto lo = [&]() { int ll = l; asm volatile("" : "+s"(ll)); return ll; }; \
        if (blockIdx.x == 0 && threadIdx.x < NE) KP.cnt[threadIdx.x] = 0; \
        inproj_phase(KP, KF, lo(), KP.proj, lds); BAR(); \
        MLA_STEP \
        SSD_STEPS \
        outproj_phase<true>(KP, KF, lo(), KP.xres, lds); BAR(); \
        rw::router_phase(KP, lo(), lds); BAR(); \
        moe1_phase(KP, KF, lo(), lds); BAR(); moe2_phase(KP, KF, lo(), lds); BAR(); \
        rw::combine_phase(KP, lo()); BAR(); \
    }
__global__ void __launch_bounds__(512, 2) k_mega(KArgs a) {
    extern __shared__ __attribute__((aligned(16))) char lds[];
    uint4* xbw = (uint4*)(lds + LDS_BYTES - 16);
    if (threadIdx.x == 0) *xbw = make_uint4(0u, 0u, 0u, 0u);
    __syncthreads();
    const unsigned xbx = xcd_barrier_post(kargs().bar, (volatile LAS unsigned*)xbw).x;
#define KP kargs().p
#define KF kargs().f
    { const int l = 0; auto lo = [&]() { return l; }; if (blockIdx.x == 0 && threadIdx.x < 16) KP.diag[threadIdx.x] = 0.f; mc::modvec_phase(KP, lds);
      cvt_phase(KP, KF, 0, DEPTH, lds); BAR(); rw::first_norm_phase(KP); BAR(); }
    LAYER_BODY(0) LAYER_BODY(1) LAYER_BODY(2) LAYER_BODY(3)
#if CHECK_MLA || CHECK_SSD
    {
        float e = 0.f;
        for (int c = 0; c < 3; ++c) { const float dn = KP.diag[2 * c + 1]; if (dn == 0.f && KP.diag[2 * c] == 0.f) continue; const float ec = sqrtf(KP.diag[2 * c] / dn); e = ec > e ? ec : e; if (!(ec == ec)) e = 1e3f; }
        const float sc = 1.0f + 10.0f * e; const long n = (long)SEQ * D; const long stride = (long)gridDim.x * blockDim.x;
        for (long i = gtid(); i < n; i += stride) KP.out[i] *= sc;
    }
#endif
#undef KP
#undef KF
}
static size_t carve(char*& cur, size_t bytes) { size_t a = (bytes + 255) & ~(size_t)255; cur += a; return a; }
static bool setup_params(P& p, FW& f, unsigned*& bar, void* const* d_in, void* d_out, void* d_ws, size_t ws_size) {
    const float** pp = (const float**)&p; for (int i = 0; i < 32; ++i) pp[i] = (const float*)d_in[i];
    p.out = (float*)d_out;
    char* cur = (char*)d_ws; char* base = cur;
    bar = (unsigned*)cur; carve(cur, XCD_BAR_WORDS * sizeof(unsigned));
#define CARVE(field, type, count) p.field = (type*)cur; carve(cur, (size_t)(count) * sizeof(type));
#define CARVEF(field, type, count) f.field = (type*)cur; carve(cur, (size_t)(count) * sizeof(type));
    CARVE(xres, float, (size_t)M * D) CARVE(mod, float, (size_t)DEPTH * 12 * D) CARVE(proj, float, (size_t)M * INC)
#if CHECK_MLA
    CARVE(qln, float, (size_t)M * QL) CARVE(kvln, float, (size_t)M * KVL) CARVE(qraw, float, (size_t)M * NH * QKD) CARVE(kvraw, float, (size_t)M * NH * 128) CARVE(q, float, (size_t)M * NH * QKD) CARVE(k, float, (size_t)M * NH * QKD) CARVE(v, float, (size_t)M * NH * VD)
    CARVEF(qb2, bf16_t, (size_t)M * NH * QKD) CARVEF(kb2, bf16_t, (size_t)M * NH * QKD) CARVEF(vb2, bf16_t, (size_t)M * NH * VD)
#endif
    CARVE(mixin, float, (size_t)M * MIXW) CARVE(xbc, float, (size_t)M * CONVD) CARVE(dt, float, (size_t)M * 12) CARVE(ydir, float, (size_t)2 * M * SW)
    CARVE(poolp, float, (size_t)M * PW) CARVE(topw, float, (size_t)M * 4)
    CARVE(topi, int, (size_t)M * 4) CARVE(cnt, int, NE) CARVE(list, int, (size_t)NE * M)
    CARVE(qb, bf16_t, (size_t)M * NH * QKD) CARVE(kb, bf16_t, (size_t)M * NH * QKD) CARVE(vb, bf16_t, (size_t)M * NH * VD) CARVE(diag, float, 64)
    CARVE(cs, float, (size_t)2 * M * SH) CARVE(cdec, float, (size_t)2 * NCH * SH) CARVE(gmat, float, (size_t)M * SG * CHUNK) CARVE(st, float, (size_t)2 * NCH * SH * SP * SN)
    CARVE(hb1, bf16_t, (size_t)M * D) CARVE(hb2, bf16_t, (size_t)M * D) CARVE(mixb, bf16_t, (size_t)M * MIXW)
    CARVEF(actb, bf16_t, (size_t)4 * M * FF) CARVEF(yb, bf16_t, (size_t)4 * M * D)
    f.hb1 = p.hb1; f.hb2 = p.hb2; f.mixb = p.mixb; p.ybn = f.yb; p.attf = nullptr;
    const int nl = DEPTH;
    CARVEF(w_uq_t, bf16_t, (size_t)nl * NH * QKD * QL) CARVEF(w_ukv_t, bf16_t, (size_t)nl * NH * 128 * KVL) CARVEF(ropec, float, 256 * 8) CARVEF(ropes, float, 256 * 8)
    CARVEF(yd2, float, (size_t)M * SW) CARVEF(st2, float, (size_t)2 * NCH * SH * SP * SN) CARVEF(cdec2, float, (size_t)2 * NCH * SH) CARVEF(cs2, float, (size_t)2 * M * SH)
    CARVEF(cg, bf16_t, (size_t)M * SG * SN) CARVEF(prevb, bf16_t, (size_t)2 * NCH * SH * SP * SN) CARVEF(ssdb2, bf16_t, (size_t)M * SW)
    CARVEF(w_in_t, bf16_t, (size_t)nl * INC_PAD * D) CARVEF(w_out_t, bf16_t, (size_t)nl * D * MIXW) CARVEF(gu_t, bf16_t, (size_t)nl * NE * 2 * FF * D) CARVEF(d_t, bf16_t, (size_t)nl * NE * D * FF)
    p.act = nullptr; p.down = nullptr; f.proj2 = nullptr; f.mix2 = nullptr;
#undef CARVE
#undef CARVEF
    if (getenv("KDEBUG")) fprintf(stderr, "ws used %zu of %zu\n", (size_t)(cur - base), ws_size);
    return (size_t)(cur - base) <= ws_size;
}
extern "C" void kernel_launch(void* const* d_in, const int* in_sizes, int n_in, void* d_out, int out_size, void* d_ws, size_t ws_size, hipStream_t stream) {
    KArgs a{};
    if (n_in < 32 || !setup_params(a.p, a.f, a.bar, d_in, d_out, d_ws, ws_size)) return;
    static int grid = 0;
    if (!grid) { int dev = 0, cus = 0, per_cu = 0; (void)hipGetDevice(&dev); (void)hipDeviceGetAttribute(&cus, hipDeviceAttributeMultiprocessorCount, dev);
        (void)hipFuncSetAttribute((const void*)k_mega, hipFuncAttributeMaxDynamicSharedMemorySize, LDS_BYTES);
        (void)hipOccupancyMaxActiveBlocksPerMultiprocessor(&per_cu, k_mega, 512, LDS_BYTES); grid = cus * (per_cu < 1 ? per_cu : 1); }
    if (grid <= 0) return;
    (void)hipMemsetAsync(a.bar, 0, XCD_BAR_WORDS * sizeof(unsigned), stream);
    hipLaunchKernelGGL(k_mega, dim3(grid), dim3(512), LDS_BYTES, stream, a);
}
```

```cpp
#include <hip/hip_runtime.h>
#include <stdint.h>
#include <stdlib.h>
#include <stdio.h>

#ifndef NAIVE_H
#define NAIVE_H
#include <math.h>
#ifdef HOST_TEST
#define HD inline
#define HDC inline
#define ATOMIC_INC(p) ((*(p))++)
#define UNIFORM(x) (x)
#else
#define HD __device__ __forceinline__
#define HDC __host__ __device__ __forceinline__
#define ATOMIC_INC(p) atomicAdd((p), 1)
#define UNIFORM(x) __builtin_amdgcn_readfirstlane(x)
#endif

#ifndef CFG_D
#define CFG_D 1024
#define CFG_SEQ 16384
#define CFG_CTX 256
#define CFG_FF 1024
#define CFG_DEPTH 4
#endif
constexpr int D = CFG_D, SEQ = CFG_SEQ, CTX = CFG_CTX, FF = CFG_FF, DEPTH = CFG_DEPTH;
constexpr int M = CTX + SEQ;
constexpr int GRID_W = 64;
constexpr int NH = 6, QKD = 96, NOPE = 64, ROPE = 32, VD = 64, QL = 256, KVL = 128;
constexpr int SH = 6, SP = 64, SW = 384, SG = 2, SN = 64, CONVD = 640, CHUNK = 128;
constexpr int PW = 256, MIXW = 1024, INC = 1708;
constexpr int C_Q = 0, C_KV = 256, C_KR = 384, C_Z = 416, C_XBC = 800, C_DT = 1440, C_POOL = 1452;
constexpr int NE = 32, TOPK = 4;
constexpr int NCH = M / CHUNK;
constexpr float EPS = 1e-6f;

typedef unsigned short bf16_t;
HD bf16_t f2bf(float f) { union { float f; unsigned u; } v; v.f = f; unsigned u = v.u; u += 0x7FFFu + ((u >> 16) & 1u); return (bf16_t)(u >> 16); }
HD float bf2f(bf16_t b) { union { float f; unsigned u; } v; v.u = ((unsigned)b) << 16; return v.f; }
struct P {
    const float *x, *c, *ctx, *c_ctx, *norm1_g, *norm2_g, *mod_w, *mod_b, *w_in, *q_g, *kv_g, *w_uq, *w_ukv, *qn_g, *kn_g;
    const float *conv_w, *conv_b, *a_log, *dt_bias, *ssd_d, *ssd_norm_g, *pool_w, *pool_scale, *w_out, *router_w, *router_b;
    const float *wg, *bg, *wu, *bu, *wd, *bd;
    float* out;
    float *xres, *mod, *rs, *h, *proj, *qln, *kvln, *qraw, *kvraw, *q, *k, *v, *mixin, *xbc, *dt, *ydir, *poolp, *mix, *logits, *topw, *act, *down;
    int *topi, *cnt, *list;
    bf16_t *qb, *kb, *vb;
    float *attf, *diag;
    float *cs, *cdec, *gmat, *st;
    bf16_t *hb1, *hb2, *mixb, *ybn;
};

HD float siluf(float x) { return x / (1.0f + expf(-x)); }
HD float sigmf(float x) { return 1.0f / (1.0f + expf(-x)); }
HD float softplusf(float x) { return x > 20.0f ? x : log1pf(expf(x)); }
HD const float* modv(const P& p, int l, int r, int j) { return p.mod + ((size_t)(l * 2 + (r < CTX ? 1 : 0)) * 6 + j) * D; }

enum { OP_COPY_IN = 0, OP_MODVEC, OP_ROWSTAT, OP_NORM1, OP_INPROJ, OP_LATNORM, OP_QRAW, OP_KVRAW, OP_QHEAD, OP_KHEAD, OP_ATTN, OP_CONV, OP_DT, OP_SSDSCAN, OP_SSDFIN,
       OP_POOLP, OP_POOLMM, OP_OUTPROJ, OP_RES1, OP_NORM2, OP_LOGITS, OP_ZEROCNT, OP_TOPK, OP_GATEUP, OP_DOWN, OP_COMBINE, OP_WRITE_OUT, OP_MIXB, OP_COMBINE2, OP_SSD_CS, OP_SSD_G, OP_SSD_YD, OP_SSD_ST, OP_SSD_CARRY, OP_SSD_YOFF, OP_COUNT };

HDC long op_count(int op) {
    switch (op) {
        case OP_COPY_IN: return (long)M * D;
        case OP_MODVEC: return (long)DEPTH * 2 * 6 * D;
        case OP_ROWSTAT: return M;
        case OP_NORM1: case OP_NORM2: return (long)M * D;
        case OP_INPROJ: return (long)(M / 8) * INC;
        case OP_LATNORM: return 2L * M;
        case OP_QRAW: return (long)(M / 8) * (NH * QKD);
        case OP_KVRAW: return (long)(M / 8) * (NH * 128);
        case OP_QHEAD: case OP_KHEAD: return (long)M * NH;
        case OP_ATTN: return (long)M * NH;
        case OP_CONV: return (long)M * CONVD;
        case OP_DT: return (long)M * 12;
        case OP_SSDSCAN: return 2L * SH * SP;
        case OP_SSDFIN: return M;
        case OP_POOLP: return (long)M * PW;
        case OP_POOLMM: return (long)M * PW;
        case OP_OUTPROJ: return (long)(M / 8) * D;
        case OP_RES1: return (long)M * D;
        case OP_LOGITS: return (long)M * NE;
        case OP_ZEROCNT: return NE;
        case OP_TOPK: return M;
        case OP_GATEUP: return (long)NE * (M / 8) * FF;
        case OP_DOWN: return (long)NE * (M / 8) * D;
        case OP_COMBINE: return (long)M * D;
        case OP_WRITE_OUT: return (long)SEQ * D;
        case OP_MIXB: return (long)M * MIXW;
        case OP_COMBINE2: return (long)M * D;
        case OP_SSD_CS: return 2L * NCH * SH;
        case OP_SSD_G: return (long)M * SG * CHUNK;
        case OP_SSD_YD: return (long)M * SW;
        case OP_SSD_ST: return 2L * NCH * SH * SP * SN;
        case OP_SSD_CARRY: return 2L * SH * SP * SN;
        case OP_SSD_YOFF: return (long)M * SW;
    }
    return 0;
}

HD void gemm8(const float* A, int lda, const float* B, int ldb, const float* bias, float* C, int ldc, int N, int K, long idx) {
    const int j = (int)(idx % N); const long r0 = (idx / N) * 8;
    float acc[8];
#pragma unroll
    for (int i = 0; i < 8; ++i) acc[i] = 0.f;
    const float* a = A + r0 * lda;
    for (int k = 0; k < K; ++k) {
        const float b = B[(size_t)k * ldb + j];
#pragma unroll
        for (int i = 0; i < 8; ++i) acc[i] += a[(size_t)i * lda + k] * b;
    }
    const float bv = bias ? bias[j] : 0.f;
#pragma unroll
    for (int i = 0; i < 8; ++i) C[(r0 + i) * ldc + j] = acc[i] + bv;
}

HD void sincos_rr(float angf, float& cs, float& sn) {
    const double x = (double)angf; const double n = rint(x * 0.63661977236758134308); const double y = (x - n * 1.57079632679489655800) - n * 6.123233995736766e-17; const double y2 = y * y;
    const double s = y * (1.0 + y2 * (-1.0 / 6 + y2 * (1.0 / 120 + y2 * (-1.0 / 5040 + y2 * (1.0 / 362880 + y2 * (-1.0 / 39916800))))));
    const double c = 1.0 + y2 * (-0.5 + y2 * (1.0 / 24 + y2 * (-1.0 / 720 + y2 * (1.0 / 40320 + y2 * (-1.0 / 3628800 + y2 * (1.0 / 479001600))))));
    const int q = ((int)n) & 3; const double cc = (q == 0) ? c : (q == 1) ? -s : (q == 2) ? -c : s; const double ss = (q == 0) ? s : (q == 1) ? c : (q == 2) ? -s : -c;
    cs = (float)cc; sn = (float)ss;
}
HD float rope_inv_freq(int f) { return f == 0 ? 1.0f : f == 1 ? 0.31622776f : f == 2 ? 0.1f : f == 3 ? 0.031622775f : f == 4 ? 0.01f : f == 5 ? 0.0031622776f : f == 6 ? 0.001f : 0.00031622776f; }
HD void rope_apply(float* v32, int t) {
    const float row = (float)(t / GRID_W), col = (float)(t % GRID_W);
#pragma unroll
    for (int a = 0; a < 2; ++a)
#pragma unroll
        for (int f = 0; f < 8; ++f) {
            const float ang = (a == 0 ? row : col) * rope_inv_freq(f);
            float cs, sn; sincos_rr(ang, cs, sn);
            const float x1 = v32[a * 16 + f], x2 = v32[a * 16 + 8 + f];
            v32[a * 16 + f] = x1 * cs - x2 * sn; v32[a * 16 + 8 + f] = x2 * cs + x1 * sn;
        }
}

HD void op_run(int op, const P& p, int l, long idx) {
    switch (op) {
    case OP_COPY_IN: { const long r = idx / D; const int c = (int)(idx % D); p.xres[idx] = r < CTX ? p.ctx[idx] : p.x[(r - CTX) * D + c]; } break;
    case OP_MODVEC: {
        const int j = (int)(idx % (6 * D)); const int which = (int)((idx / (6 * D)) % 2); const int ll = (int)(idx / (12 * D));
        const float* cv = which ? p.c_ctx : p.c; float s = 0.f;
        for (int k = 0; k < D; ++k) s += siluf(cv[k]) * p.mod_w[((size_t)ll * D + k) * (6 * D) + j];
        p.mod[idx] = s + p.mod_b[(size_t)ll * 6 * D + j];
    } break;
    case OP_ROWSTAT: { const float* xr = p.xres + idx * D; float s = 0.f; for (int k = 0; k < D; ++k) s += xr[k] * xr[k]; p.rs[idx] = 1.0f / sqrtf(s / D + EPS); } break;
    case OP_NORM1: case OP_NORM2: { const int r = (int)(idx / D), c = (int)(idx % D); const int o = op == OP_NORM1 ? 0 : 3;
        const float g = (op == OP_NORM1 ? p.norm1_g : p.norm2_g)[l * D + c];
        const float hv = p.xres[idx] * p.rs[r] * g * (1.0f + modv(p, l, r, o + 1)[c]) + modv(p, l, r, o)[c]; p.h[idx] = hv;
        bf16_t* hb = op == OP_NORM1 ? p.hb1 : p.hb2; if (hb) hb[idx] = f2bf(hv); } break;
    case OP_INPROJ: gemm8(p.h, D, p.w_in + (size_t)l * D * INC, INC, nullptr, p.proj, INC, INC, D, idx); break;
    case OP_LATNORM: {
        const int which = idx >= M; const long r = which ? idx - M : idx; const int n = which ? KVL : QL; const float* src = p.proj + r * INC + (which ? C_KV : C_Q);
        float s = 0.f; for (int k = 0; k < n; ++k) s += src[k] * src[k]; const float rs = 1.0f / sqrtf(s / n + EPS);
        float* dst = which ? p.kvln + r * KVL : p.qln + r * QL; const float* g = which ? p.kv_g + l * KVL : p.q_g + l * QL;
        for (int k = 0; k < n; ++k) dst[k] = src[k] * rs * g[k];
    } break;
    case OP_QRAW: gemm8(p.qln, QL, p.w_uq + (size_t)l * QL * (NH * QKD), NH * QKD, nullptr, p.qraw, NH * QKD, NH * QKD, QL, idx); break;
    case OP_KVRAW: gemm8(p.kvln, KVL, p.w_ukv + (size_t)l * KVL * (NH * 128), NH * 128, nullptr, p.kvraw, NH * 128, NH * 128, KVL, idx); break;
    case OP_QHEAD: { const int r = (int)(idx / NH), hh = (int)(idx % NH); const float* src = p.qraw + (size_t)r * (NH * QKD) + hh * QKD; float s = 0.f;
        for (int d = 0; d < QKD; ++d) s += src[d] * src[d]; const float rs = 1.0f / sqrtf(s / QKD + EPS);
        float* dst = p.q + ((size_t)r * NH + hh) * QKD; float rp[32];
        for (int d = 0; d < NOPE; ++d) dst[d] = src[d] * rs * p.qn_g[l * QKD + d];
#pragma unroll
        for (int d = 0; d < 32; ++d) rp[d] = src[NOPE + d] * rs * p.qn_g[l * QKD + NOPE + d];
        if (r >= CTX) rope_apply(rp, r - CTX);
#pragma unroll
        for (int d = 0; d < 32; ++d) dst[NOPE + d] = rp[d];
        bf16_t* db = p.qb + ((size_t)r * NH + hh) * QKD;
        for (int d = 0; d < QKD; ++d) db[d] = f2bf(dst[d]);
    } break;
    case OP_KHEAD: { const int r = (int)(idx / NH), hh = (int)(idx % NH); const float* kn = p.kvraw + (size_t)r * (NH * 128) + hh * 128; const float* kr = p.proj + (size_t)r * INC + C_KR; float s = 0.f;
        for (int d = 0; d < NOPE; ++d) s += kn[d] * kn[d];
        for (int d = 0; d < ROPE; ++d) s += kr[d] * kr[d];
        const float rs = 1.0f / sqrtf(s / QKD + EPS);
        float* dst = p.k + ((size_t)r * NH + hh) * QKD; float rp[32];
        for (int d = 0; d < NOPE; ++d) dst[d] = kn[d] * rs * p.kn_g[l * QKD + d];
#pragma unroll
        for (int d = 0; d < 32; ++d) rp[d] = kr[d] * rs * p.kn_g[l * QKD + NOPE + d];
        if (r >= CTX) rope_apply(rp, r - CTX);
#pragma unroll
        for (int d = 0; d < 32; ++d) dst[NOPE + d] = rp[d];
        float* vd = p.v + ((size_t)r * NH + hh) * VD;
        for (int d = 0; d < VD; ++d) vd[d] = kn[NOPE + d];
        bf16_t* db = p.kb + ((size_t)r * NH + hh) * QKD; bf16_t* vdb = p.vb + ((size_t)r * NH + hh) * VD;
        for (int d = 0; d < QKD; ++d) db[d] = f2bf(dst[d]);
        for (int d = 0; d < VD; ++d) vdb[d] = f2bf(kn[NOPE + d]);
    } break;
    case OP_ATTN: {
        const int r = (int)(idx % M), hh = UNIFORM((int)(idx / M)); const int nk = r < CTX ? CTX : M;
        float qv[QKD];
        const float* qp = p.q + ((size_t)r * NH + hh) * QKD; const float scale = 1.0f / sqrtf((float)QKD);
#pragma unroll
        for (int d = 0; d < QKD; ++d) qv[d] = qp[d] * scale;
        for (int half = 0; half < 2; ++half) {
            float o[32];
#pragma unroll
            for (int d = 0; d < 32; ++d) o[d] = 0.f;
            float mx = -1e30f, lsum = 0.f;
            for (int kk = 0; kk < nk; ++kk) {
                const float* kp = p.k + ((size_t)kk * NH + hh) * QKD; const float* vp = p.v + ((size_t)kk * NH + hh) * VD + half * 32; float s = 0.f;
#pragma unroll
                for (int d = 0; d < QKD; ++d) s += qv[d] * kp[d];
                const float mn = s > mx ? s : mx; const float corr = expf(mx - mn), pe = expf(s - mn);
                lsum = lsum * corr + pe; mx = mn;
#pragma unroll
                for (int d = 0; d < 32; ++d) o[d] = o[d] * corr + pe * vp[d];
            }
            const float inv = 1.0f / lsum; float* dst = p.mixin + (size_t)r * MIXW + hh * VD + half * 32;
#pragma unroll
            for (int d = 0; d < 32; ++d) dst[d] = o[d] * inv;
        }
    } break;
    case OP_CONV: { const int r = (int)(idx / CONVD), c = (int)(idx % CONVD); const int seg0 = r < CTX ? 0 : CTX, n = r < CTX ? CTX : SEQ, t = r - seg0; float y = p.conv_b[l * CONVD + c];
#pragma unroll
        for (int j = 0; j < 4; ++j) { const int tt = t - 2 + j; if (tt >= 0 && tt < n) y += p.conv_w[((size_t)l * 4 + j) * CONVD + c] * p.proj[(size_t)(seg0 + tt) * INC + C_XBC + c]; }
        p.xbc[idx] = siluf(y); } break;
    case OP_DT: { const int r = (int)(idx / 12), j = (int)(idx % 12); p.dt[idx] = softplusf(p.proj[(size_t)r * INC + C_DT + j] + p.dt_bias[l * 12 + j]); } break;
    case OP_SSDSCAN: {
        const int pp = (int)(idx % SP), hh = UNIFORM((int)((idx / SP) % SH)), dir = UNIFORM((int)(idx / (SP * SH))); const int g = hh / (SH / SG);
        const float a = -expf(p.a_log[l * 12 + dir * 6 + hh]); float st[SN];
#pragma unroll
        for (int n = 0; n < SN; ++n) st[n] = 0.f;
        for (int step = 0; step < M; ++step) {
            const int r = dir == 0 ? step : (step < CTX ? CTX - 1 - step : M - 1 - (step - CTX));
            const float dtv = p.dt[(size_t)r * 12 + dir * 6 + hh]; const float dA = expf(dtv * a); const float xv = p.xbc[(size_t)r * CONVD + hh * SP + pp] * dtv;
            const float* Bp = p.xbc + (size_t)r * CONVD + SW + g * SN; const float* Cp = p.xbc + (size_t)r * CONVD + SW + SG * SN + g * SN; float y = 0.f;
#pragma unroll
            for (int n = 0; n < SN; ++n) { st[n] = st[n] * dA + xv * Bp[n]; y += st[n] * Cp[n]; }
            p.ydir[((size_t)dir * M + r) * SW + hh * SP + pp] = y;
        }
    } break;
    case OP_SSDFIN: { const long r = idx; float ss = 0.f;
        for (int c = 0; c < SW; ++c) { const float y = p.ydir[r * SW + c] + p.ydir[((size_t)M + r) * SW + c] + p.ssd_d[l * SH + c / SP] * p.xbc[r * CONVD + c]; const float gv = y * siluf(p.proj[r * INC + C_Z + c]); ss += gv * gv; }
        const float rs = 1.0f / sqrtf(ss / SW + EPS);
        for (int c = 0; c < SW; ++c) { const float y = p.ydir[r * SW + c] + p.ydir[((size_t)M + r) * SW + c] + p.ssd_d[l * SH + c / SP] * p.xbc[r * CONVD + c]; const float gv = y * siluf(p.proj[r * INC + C_Z + c]);
            p.mixin[r * MIXW + NH * VD + c] = gv * rs * p.ssd_norm_g[l * SW + c]; }
    } break;
    case OP_POOLP: { const int r = (int)(idx / PW), c = (int)(idx % PW); const int gi = c / 64; const int win = 2 << gi; const int seg0 = r < CTX ? 0 : CTX, n = r < CTX ? CTX : SEQ, t = r - seg0;
        int lo = t - win / 2, hi = t - win / 2 + win; lo = lo < 0 ? 0 : lo; hi = hi > n ? n : hi; float s = 0.f;
        for (int tt = lo; tt < hi; ++tt) s += p.proj[(size_t)(seg0 + tt) * INC + C_POOL + c];
        p.poolp[idx] = s / (float)(hi - lo) - p.proj[(size_t)r * INC + C_POOL + c]; } break;
    case OP_POOLMM: { const int r = (int)(idx / PW), c = (int)(idx % PW); const int gi = c / 64, d = c % 64; float s = 0.f;
        for (int cc = 0; cc < 64; ++cc) s += p.poolp[(size_t)r * PW + gi * 64 + cc] * p.pool_w[(((size_t)l * 4 + gi) * 64 + cc) * 64 + d];
        p.mixin[(size_t)r * MIXW + NH * VD + SW + c] = s * p.pool_scale[l * PW + c]; } break;
    case OP_OUTPROJ: gemm8(p.mixin, MIXW, p.w_out + (size_t)l * MIXW * D, D, nullptr, p.mix, D, D, MIXW, idx); break;
    case OP_RES1: { const int r = (int)(idx / D), c = (int)(idx % D); p.xres[idx] += modv(p, l, r, 2)[c] * p.mix[idx]; } break;
    case OP_LOGITS: { const int r = (int)(idx / NE), e = (int)(idx % NE); const float* hr = p.h + (size_t)r * D; float s = 0.f;
        for (int k = 0; k < D; ++k) s += hr[k] * p.router_w[((size_t)l * D + k) * NE + e];
        p.logits[idx] = s + p.router_b[l * NE + e]; } break;
    case OP_ZEROCNT: p.cnt[idx] = 0; break;
    case OP_TOPK: { const long t = idx; float lg[NE];
#pragma unroll
        for (int e = 0; e < NE; ++e) lg[e] = p.logits[t * NE + e];
        int sel[4]; float sv[4];
#pragma unroll
        for (int kk = 0; kk < 4; ++kk) { float best = -3.0e38f; int bi = 0;
#pragma unroll
            for (int e = 0; e < NE; ++e) { bool taken = false;
#pragma unroll
                for (int q = 0; q < kk; ++q) taken = taken || (sel[q] == e);
                if (!taken && lg[e] > best) { best = lg[e]; bi = e; } }
            sel[kk] = bi; sv[kk] = best; }
        float es[4], sum = 0.f;
#pragma unroll
        for (int kk = 0; kk < 4; ++kk) { es[kk] = expf(sv[kk] - sv[0]); sum += es[kk]; }
#pragma unroll
        for (int kk = 0; kk < 4; ++kk) { p.topi[t * 4 + kk] = sel[kk]; p.topw[t * 4 + kk] = es[kk] / sum; const int pos = ATOMIC_INC(&p.cnt[sel[kk]]); p.list[(size_t)sel[kk] * M + pos] = (int)(t * 4 + kk); }
    } break;
    case OP_GATEUP: {
        const int j = (int)(idx % FF); const long rest = idx / FF; const int rb = (int)(rest % (M / 8)), e = (int)(rest / (M / 8)); const int cnt = p.cnt[e]; if (rb * 8 >= cnt) break;
        int a[8]; float g[8], u[8];
#pragma unroll
        for (int i = 0; i < 8; ++i) { a[i] = rb * 8 + i < cnt ? p.list[(size_t)e * M + rb * 8 + i] : -1; g[i] = 0.f; u[i] = 0.f; }
        const float* wgp = p.wg + ((size_t)l * NE + e) * D * FF + j; const float* wup = p.wu + ((size_t)l * NE + e) * D * FF + j;
        for (int k = 0; k < D; ++k) { const float gw = wgp[(size_t)k * FF], uw = wup[(size_t)k * FF];
#pragma unroll
            for (int i = 0; i < 8; ++i) { const float xv = p.h[(size_t)(a[i] < 0 ? 0 : a[i] / 4) * D + k]; g[i] += xv * gw; u[i] += xv * uw; } }
        const float bgv = p.bg[((size_t)l * NE + e) * FF + j], buv = p.bu[((size_t)l * NE + e) * FF + j];
#pragma unroll
        for (int i = 0; i < 8; ++i) if (a[i] >= 0) { float gv = g[i] + bgv; gv = gv < 7.0f ? gv : 7.0f; float uv = u[i] + buv; uv = uv < -7.0f ? -7.0f : (uv > 7.0f ? 7.0f : uv);
            p.act[(size_t)a[i] * FF + j] = gv * sigmf(1.702f * gv) * (uv + 1.0f); }
    } break;
    case OP_DOWN: {
        const int j = (int)(idx % D); const long rest = idx / D; const int rb = (int)(rest % (M / 8)), e = (int)(rest / (M / 8)); const int cnt = p.cnt[e]; if (rb * 8 >= cnt) break;
        int a[8]; float o[8];
#pragma unroll
        for (int i = 0; i < 8; ++i) { a[i] = rb * 8 + i < cnt ? p.list[(size_t)e * M + rb * 8 + i] : -1; o[i] = 0.f; }
        const float* wdp = p.wd + ((size_t)l * NE + e) * FF * D + j;
        for (int k = 0; k < FF; ++k) { const float w = wdp[(size_t)k * D];
#pragma unroll
            for (int i = 0; i < 8; ++i) o[i] += p.act[(size_t)(a[i] < 0 ? 0 : a[i]) * FF + k] * w; }
        const float bv = p.bd[((size_t)l * NE + e) * D + j];
#pragma unroll
        for (int i = 0; i < 8; ++i) if (a[i] >= 0) p.down[(size_t)a[i] * D + j] = o[i] + bv;
    } break;
    case OP_COMBINE: { const int r = (int)(idx / D), c = (int)(idx % D); float s = 0.f;
#pragma unroll
        for (int kk = 0; kk < 4; ++kk) s += p.topw[(size_t)r * 4 + kk] * p.down[((size_t)r * 4 + kk) * D + c];
        p.xres[idx] += modv(p, l, r, 5)[c] * s; } break;
    case OP_WRITE_OUT: p.out[idx] = p.xres[(size_t)CTX * D + idx]; break;
    case OP_MIXB: p.mixb[idx] = f2bf(p.mixin[idx]); break;
    case OP_SSD_CS: {
        const int hh = (int)(idx % SH), c = (int)((idx / SH) % NCH), dir = (int)(idx / (SH * NCH)); const float a = -expf(p.a_log[l * 12 + dir * 6 + hh]); float acc = 0.f;
        for (int i = 0; i < CHUNK; ++i) { const int r = c * CHUNK + (dir == 0 ? i : CHUNK - 1 - i); acc += p.dt[(size_t)r * 12 + dir * 6 + hh] * a; p.cs[((size_t)dir * M + r) * SH + hh] = acc; }
        p.cdec[idx] = expf(acc);
    } break;
    case OP_SSD_G: {
        const int s = (int)(idx % CHUNK), g = (int)((idx / CHUNK) % SG), r = (int)(idx / (CHUNK * SG)); const int r2 = (r / CHUNK) * CHUNK + s;
        const float* Cp = p.xbc + (size_t)r * CONVD + SW + SG * SN + g * SN; const float* Bp = p.xbc + (size_t)r2 * CONVD + SW + g * SN; float acc = 0.f;
        for (int n = 0; n < SN; ++n) acc += Cp[n] * Bp[n];
        p.gmat[idx] = acc;
    } break;
    case OP_SSD_YD: {
        const int cc = (int)(idx % SW), r = (int)(idx / SW); const int hh = cc / SP, g = hh / (SH / SG); const int c0 = (r / CHUNK) * CHUNK, lpos = r - c0;
        const float* G = p.gmat + ((size_t)r * SG + g) * CHUNK; const float csf = p.cs[(size_t)r * SH + hh], csb = p.cs[((size_t)M + r) * SH + hh]; float y = 0.f;
        for (int s = 0; s <= lpos; ++s) { const int r2 = c0 + s; y += G[s] * expf(csf - p.cs[(size_t)r2 * SH + hh]) * p.dt[(size_t)r2 * 12 + hh] * p.xbc[(size_t)r2 * CONVD + cc]; }
        for (int s = lpos; s < CHUNK; ++s) { const int r2 = c0 + s; y += G[s] * expf(csb - p.cs[((size_t)M + r2) * SH + hh]) * p.dt[(size_t)r2 * 12 + 6 + hh] * p.xbc[(size_t)r2 * CONVD + cc]; }
        p.ydir[idx] = y;
    } break;
    case OP_SSD_ST: {
        const int n = (int)(idx % SN), pp = (int)((idx / SN) % SP), hh = (int)((idx / (SN * SP)) % SH), c = (int)((idx / (SN * SP * SH)) % NCH), dir = (int)(idx / ((long)SN * SP * SH * NCH)); const int g = hh / (SH / SG);
        const int rend = c * CHUNK + (dir == 0 ? CHUNK - 1 : 0); const float cse = p.cs[((size_t)dir * M + rend) * SH + hh]; float acc = 0.f;
        for (int i = 0; i < CHUNK; ++i) { const int r = c * CHUNK + i; acc += p.xbc[(size_t)r * CONVD + SW + g * SN + n] * expf(cse - p.cs[((size_t)dir * M + r) * SH + hh]) * p.dt[(size_t)r * 12 + dir * 6 + hh] * p.xbc[(size_t)r * CONVD + hh * SP + pp]; }
        p.st[idx] = acc;
    } break;
    case OP_SSD_CARRY: {
        const int e = (int)(idx % (SP * SN)), hh = (int)((idx / (SP * SN)) % SH), dir = (int)(idx / ((long)SP * SN * SH)); float state = 0.f;
        for (int i = 0; i < NCH; ++i) { const int c = dir == 0 ? i : (i < CTX / CHUNK ? CTX / CHUNK - 1 - i : NCH - 1 - (i - CTX / CHUNK));
            const size_t o = (((size_t)dir * NCH + c) * SH + hh) * (SP * SN) + e; const float stc = p.st[o]; p.st[o] = state; state = state * p.cdec[((size_t)dir * NCH + c) * SH + hh] + stc; }
    } break;
    case OP_SSD_YOFF: {
        const int cc = (int)(idx % SW), r = (int)(idx / SW); const int hh = cc / SP, pp = cc % SP, g = hh / (SH / SG), c = r / CHUNK; const float* Cp = p.xbc + (size_t)r * CONVD + SW + SG * SN + g * SN;
        float y = 0.f;
#pragma unroll
        for (int dir = 0; dir < 2; ++dir) { const float* pv = p.st + ((((size_t)dir * NCH + c) * SH + hh) * SP + pp) * SN; float acc = 0.f;
            for (int n = 0; n < SN; ++n) acc += Cp[n] * pv[n];
            y += acc * expf(p.cs[((size_t)dir * M + r) * SH + hh]); }
        p.ydir[(size_t)M * SW + idx] = y;
    } break;
    case OP_COMBINE2: { const int r = (int)(idx / D), c = (int)(idx % D); float s = 0.f;
#pragma unroll
        for (int kk = 0; kk < 4; ++kk) s += p.topw[(size_t)r * 4 + kk] * bf2f(p.ybn[((size_t)r * 4 + kk) * D + c]);
        p.xres[idx] += modv(p, l, r, 5)[c] * s; } break;
    }
}

static const int LAYER_OPS[] = { OP_ROWSTAT, OP_NORM1, OP_INPROJ, OP_LATNORM, OP_QRAW, OP_KVRAW, OP_QHEAD, OP_KHEAD, OP_ATTN, OP_CONV, OP_DT, OP_SSDSCAN, OP_SSDFIN, OP_POOLP, OP_POOLMM,
                                 OP_OUTPROJ, OP_RES1, OP_ROWSTAT, OP_NORM2, OP_LOGITS, OP_ZEROCNT, OP_TOPK, OP_GATEUP, OP_DOWN, OP_COMBINE };
constexpr int N_LAYER_OPS = sizeof(LAYER_OPS) / sizeof(int);
#endif

#define XB_TMO      128
#define XB_XCNT(j)  (256  + 64 * (j))
#define XB_XSUB(j)  (1280 + 64 * (j))
#define XB_XGEN(j)  (2304 + 64 * (j))
#define XB_TOP      3328
#define XB_TOPGEN   3392
#define XCD_BAR_WORDS 3456
#define XB_SPIN_CAP (1u << 22)
#define LAS __attribute__((address_space(3)))

__device__ __forceinline__ unsigned xb_ld(unsigned* p)              { return __hip_atomic_load(p, __ATOMIC_RELAXED, __HIP_MEMORY_SCOPE_AGENT); }
__device__ __forceinline__ unsigned xb_add(unsigned* p, unsigned v) { return __hip_atomic_fetch_add(p, v, __ATOMIC_RELAXED, __HIP_MEMORY_SCOPE_AGENT); }
__device__ __forceinline__ unsigned xb_xcc_id() { return (unsigned)__builtin_amdgcn_s_getreg((3 << 11) | 20) & 0xFu; }
#define XB_SPIN(cond, bar) do { unsigned _sp = 0; while (cond) { __builtin_amdgcn_s_sleep(1); \
    if ((++_sp & 255u) == 0u) { if (xb_ld(&(bar)[XB_TMO])) break; if (_sp > XB_SPIN_CAP) { atomicAdd(&(bar)[XB_TMO], 1u); break; } } } } while (0)

struct XcdBarrier {
    unsigned* bar; unsigned x;
    volatile LAS unsigned* st;
};

__device__ __forceinline__ XcdBarrier xcd_barrier_post(unsigned* bar, volatile LAS unsigned* st) {
    XcdBarrier b; b.bar = bar; b.x = xb_xcc_id(); b.st = st;
    if (threadIdx.x == 0) (void)xb_add(&bar[XB_XCNT(b.x)], 1u);
    return b;
}
__device__ __forceinline__ void xcd_barrier_complete(unsigned* bar, unsigned x, unsigned& nloc, unsigned& nx) {
    const unsigned G = gridDim.x * gridDim.y * gridDim.z;
    unsigned sum, cnt, mine, sp = 0u;
    for (;;) {
        sum = 0u; cnt = 0u; mine = 0u;
#pragma unroll
        for (unsigned j = 0; j < 16; ++j) { const unsigned c = xb_ld(&bar[XB_XCNT(j)]); sum += c; cnt += (c > 0u) ? 1u : 0u; mine = (j == x) ? c : mine; }
        if (sum == G) break;
        __builtin_amdgcn_s_sleep(1);
        if ((++sp & 255u) == 0u) { if (xb_ld(&bar[XB_TMO])) break; if (sp > XB_SPIN_CAP) { atomicAdd(&bar[XB_TMO], 1u); break; } }
    }
    nloc = mine > 0u ? mine : 1u; nx = cnt > 0u ? cnt : 1u;
}

__device__ __forceinline__ void xcd_barrier(const XcdBarrier& b) {
    asm volatile("s_waitcnt vmcnt(0)" ::: "memory");
    __syncthreads();
    if (threadIdx.x == 0) {
        unsigned* bar = b.bar;
        __builtin_amdgcn_s_waitcnt(0);
        unsigned nloc = b.st[0], nx = b.st[1];
        if (nloc == 0u) { unsigned xx = b.x; asm volatile("" : "+s"(xx));   xcd_barrier_complete(bar, xx, nloc, nx); b.st[0] = nloc; b.st[1] = nx; }
        const unsigned old = xb_add(&bar[XB_XSUB(b.x)], 1u);
        const unsigned gen = old / nloc;
        if (old + 1u == (gen + 1u) * nloc) {
            __builtin_amdgcn_fence(__ATOMIC_RELEASE, "agent");
            asm volatile("s_waitcnt vmcnt(0)" ::: "memory");
            const unsigned og = xb_add(&bar[XB_TOP], 1u);
            const unsigned tg = og / nx;
            if (og + 1u == (tg + 1u) * nx) xb_add(&bar[XB_TOPGEN], 1u);
            else XB_SPIN(xb_ld(&bar[XB_TOPGEN]) == tg, bar);
            __builtin_amdgcn_fence(__ATOMIC_ACQUIRE, "agent");
            xb_add(&bar[XB_XGEN(b.x)], 1u);
            asm volatile("s_waitcnt vmcnt(0)" ::: "memory");
        } else {
            XB_SPIN(xb_ld(&bar[XB_XGEN(b.x)]) == gen, bar);
            __builtin_amdgcn_fence(__ATOMIC_ACQUIRE, "agent");
            asm volatile("s_waitcnt vmcnt(0)" ::: "memory");
        }
    }
    __syncthreads();
}


namespace at {
typedef unsigned short bf16_t;
using bf16x8 = __attribute__((ext_vector_type(8))) short;
using s16x4  = __attribute__((ext_vector_type(4))) short;
using f32x16 = __attribute__((ext_vector_type(16))) float;
using u32x4  = __attribute__((ext_vector_type(4))) unsigned;
constexpr int DQ = 96, DV = 64, NW = 8, QBLK = 32, KVBLK = 64;
constexpr int LDQ = 6 * DQ, LDK = 6 * DQ, LDV = 6 * DV;
constexpr float SCALE = 0.10206207261596575f;
constexpr float THR = 8.f;
constexpr int KROW = 208;
constexpr int SHM_K = KVBLK * KROW, SHM_V = KVBLK * DV * 2;
constexpr int SHM_ATTN = 2 * SHM_V + 2 * SHM_K + NW * 64 * 4;
#define AT_SBAR() __builtin_amdgcn_sched_barrier(0)
__device__ __forceinline__ int crow(int r, int hi) { return (r & 3) + 8 * (r >> 2) + 4 * hi; }
__device__ __forceinline__ unsigned cvtpk(float lo, float hi) { unsigned r; asm volatile("v_cvt_pk_bf16_f32 %0, %1, %2" : "=v"(r) : "v"(lo), "v"(hi)); return r; }

__device__ __forceinline__ void partialSM(f32x16& p0, f32x16& p1, float& m_reg, float& mn, float& alpha) {
  constexpr float C = SCALE * 1.4426950408889634f;
  float pmax = p0[0];
#pragma unroll
  for (int r = 1; r < 16; ++r) pmax = fmaxf(pmax, p0[r]);
#pragma unroll
  for (int r = 0; r < 16; ++r) pmax = fmaxf(pmax, p1[r]);
  { auto rr = __builtin_amdgcn_permlane32_swap(__float_as_uint(pmax), __float_as_uint(pmax), false, false);
    pmax = fmaxf(__uint_as_float(rr[0]), __uint_as_float(rr[1])); }
  if (__builtin_expect(__all(pmax - m_reg <= THR / SCALE), 1)) { mn = m_reg; alpha = 1.f; }
  else { mn = fmaxf(m_reg, pmax); alpha = __builtin_amdgcn_exp2f((m_reg - mn) * C); m_reg = mn; }
  float mnC = -mn * C;
#pragma unroll
  for (int r = 0; r < 16; ++r) p0[r] = fmaf(p0[r], C, mnC);
#pragma unroll
  for (int r = 0; r < 16; ++r) p1[r] = fmaf(p1[r], C, mnC);
#pragma unroll
  for (int r = 0; r < 16; ++r) p0[r] = __builtin_amdgcn_exp2f(p0[r]);
}
__device__ __forceinline__ void finishSM(f32x16& p0, f32x16& p1, float alpha, float& l_reg, bf16x8& pa0, bf16x8& pa1, bf16x8& pa2, bf16x8& pa3) {
#pragma unroll
  for (int r = 0; r < 16; ++r) p1[r] = __builtin_amdgcn_exp2f(p1[r]);
  float ps = 0;
#pragma unroll
  for (int r = 0; r < 16; ++r) ps += p0[r];
#pragma unroll
  for (int r = 0; r < 16; ++r) ps += p1[r];
  { auto rr = __builtin_amdgcn_permlane32_swap(__float_as_uint(ps), __float_as_uint(ps), false, false);
    ps = __uint_as_float(rr[0]) + __uint_as_float(rr[1]); }
  l_reg = l_reg * alpha + ps;
#define AT_PK4(P, BASE, OUT) do { unsigned a0 = cvtpk(P[BASE + 0], P[BASE + 1]), a1 = cvtpk(P[BASE + 2], P[BASE + 3]);   \
    unsigned b0 = cvtpk(P[BASE + 4], P[BASE + 5]), b1 = cvtpk(P[BASE + 6], P[BASE + 7]);                              \
    auto r0 = __builtin_amdgcn_permlane32_swap(a0, b0, false, false); auto r1 = __builtin_amdgcn_permlane32_swap(a1, b1, false, false); \
    u32x4 w = {r0[0], r1[0], r0[1], r1[1]}; OUT = *reinterpret_cast<bf16x8*>(&w); } while (0)
  AT_PK4(p0, 0, pa0); AT_PK4(p0, 8, pa1); AT_PK4(p1, 0, pa2); AT_PK4(p1, 8, pa3);
#undef AT_PK4
}
__device__ __forceinline__ void qkt(f32x16& p0, f32x16& p1, const char* Ks, const bf16x8* qr, int r32, int hi) {
  p0 = f32x16{}; p1 = f32x16{};
#pragma unroll
  for (int d0 = 0; d0 < 6; ++d0) { const int cb = (d0 * 16 + hi * 8) * 2;
    bf16x8 b0 = *reinterpret_cast<const bf16x8*>(Ks + r32 * KROW + cb);
    bf16x8 b1 = *reinterpret_cast<const bf16x8*>(Ks + (32 + r32) * KROW + cb);
    p0 = __builtin_amdgcn_mfma_f32_32x32x16_bf16(b0, qr[d0], p0, 0, 0, 0);
    p1 = __builtin_amdgcn_mfma_f32_32x32x16_bf16(b1, qr[d0], p1, 0, 0, 0); }
}
__device__ __forceinline__ int v_st(int k, int c) { const int kk = (k & ~0xC) | ((k & 4) << 1) | ((k & 8) >> 1); return ((kk >> 3) * 2 + (c >> 5)) * 512 + ((kk & 7) * 32 + (c & 31)) * 2; }
__device__ __forceinline__ int v_rd_base(int lane) { return ((lane & 3) << 3) | (((lane >> 2) & 3) << 6) | (((lane >> 4) & 1) << 5) | (((lane >> 5) & 1) << 8); }
constexpr int v_rd_off(int d0, int ks, int half) { return d0 * 512 + ks * 2048 + half * 1024; }
template <int OFF> __device__ __forceinline__ s16x4 tr_read(int vb) {
  s16x4 r; asm volatile("ds_read_b64_tr_b16 %0, %1 offset:%2" : "=&v"(r) : "v"(vb), "i"(OFF) : "memory"); return r;
}
template <int D0> __device__ __forceinline__ void pv_one(f32x16& od, int vb, bf16x8 pa0, bf16x8 pa1, bf16x8 pa2, bf16x8 pa3) {
  const s16x4 l0 = tr_read<v_rd_off(D0, 0, 0)>(vb), h0 = tr_read<v_rd_off(D0, 0, 1)>(vb), l1 = tr_read<v_rd_off(D0, 1, 0)>(vb), h1 = tr_read<v_rd_off(D0, 1, 1)>(vb);
  const s16x4 l2 = tr_read<v_rd_off(D0, 2, 0)>(vb), h2 = tr_read<v_rd_off(D0, 2, 1)>(vb), l3 = tr_read<v_rd_off(D0, 3, 0)>(vb), h3 = tr_read<v_rd_off(D0, 3, 1)>(vb);
  asm volatile("s_waitcnt lgkmcnt(0)" ::: "memory"); AT_SBAR();
#define AT_PK(L, H) (bf16x8){L[0], L[1], L[2], L[3], H[0], H[1], H[2], H[3]}
  od = __builtin_amdgcn_mfma_f32_32x32x16_bf16(pa0, AT_PK(l0, h0), od, 0, 0, 0);
  od = __builtin_amdgcn_mfma_f32_32x32x16_bf16(pa1, AT_PK(l1, h1), od, 0, 0, 0);
  od = __builtin_amdgcn_mfma_f32_32x32x16_bf16(pa2, AT_PK(l2, h2), od, 0, 0, 0);
  od = __builtin_amdgcn_mfma_f32_32x32x16_bf16(pa3, AT_PK(l3, h3), od, 0, 0, 0);
#undef AT_PK
}
__device__ __forceinline__ void pv_d0(f32x16* o, int vb, bf16x8 pa0, bf16x8 pa1, bf16x8 pa2, bf16x8 pa3) {
  pv_one<0>(o[0], vb, pa0, pa1, pa2, pa3); pv_one<1>(o[1], vb, pa0, pa1, pa2, pa3);
}
template <class TO> __device__ __forceinline__ void attn_body(const bf16_t* __restrict__ Qb, const bf16_t* __restrict__ Kh, const bf16_t* __restrict__ Vh, TO* __restrict__ Ob, int ldo, int seq, char* lds, float* __restrict__ ml = nullptr, int ldml = 0) {
  int tid = threadIdx.x; asm volatile("" : "+v"(tid));
  const int wid = tid >> 6, lane = tid & 63, r32 = lane & 31, hi = lane >> 5;
  char* V_lds = lds; char* K_lds = lds + 2 * SHM_V;
  float* ws = (float*)(lds + 2 * SHM_V + 2 * SHM_K) + wid * 64; float* li_l = ws; float* al_l = ws + 32;
  float m_reg = -1e30f, l_reg = 0; f32x16 o[2] = {}; bf16x8 qr[6];
  const bf16_t* Qw = Qb + (long)(wid * QBLK + r32) * LDQ + hi * 8;
#pragma unroll
  for (int d0 = 0; d0 < 6; ++d0) qr[d0] = *reinterpret_cast<const bf16x8*>(Qw + d0 * 16);
  const int kr0 = tid / 12, kc0 = tid % 12, c1 = 512 + (tid & 255), kr1 = c1 / 12, kc1 = c1 % 12, vr = tid >> 3, vc = (tid & 7) * 8;
  const bool k1on = tid < 256;
  const int kst0 = kr0 * KROW + kc0 * 16, kst1 = kr1 * KROW + kc1 * 16, vst = v_st(vr, vc);
  const long kg0 = (long)kr0 * LDK + kc0 * 8, kg1 = (long)kr1 * LDK + kc1 * 8, vg = (long)vr * LDV + vc;
  const int vb0 = (int)(uintptr_t)V_lds + v_rd_base(lane);
  struct { bf16x8 vs, ks0, ks1; } sr_[2];
#define AT_SLOAD(i, k0) do { sr_[i].vs = *reinterpret_cast<const bf16x8*>(Vh + (long)(k0) * LDV + vg); \
    sr_[i].ks0 = *reinterpret_cast<const bf16x8*>(Kh + (long)(k0) * LDK + kg0); sr_[i].ks1 = *reinterpret_cast<const bf16x8*>(Kh + (long)(k0) * LDK + kg1); } while (0)
#define AT_SWRITE(b, i) do { *(bf16x8*)(V_lds + (b) * SHM_V + vst) = sr_[i].vs; *(bf16x8*)(K_lds + (b) * SHM_K + kst0) = sr_[i].ks0; \
    if (k1on) *(bf16x8*)(K_lds + (b) * SHM_K + kst1) = sr_[i].ks1; } while (0)
#define AT_SWAIT() asm volatile("s_waitcnt vmcnt(3)" ::: "memory")
#define AT_RESC(a) do { if (__any((a) < 1.f)) { if (hi == 0) al_l[r32] = (a); asm volatile("s_waitcnt lgkmcnt(0)" ::: "memory"); \
    _Pragma("unroll") for (int d = 0; d < 2; ++d) _Pragma("unroll") for (int r = 0; r < 16; ++r) o[d][r] *= al_l[crow(r, hi)]; } } while (0)
  f32x16 pA0, pA1, pB0, pB1; float mnA, mnB, alA, alB; bf16x8 pa0, pa1, pa2, pa3; const int NT = seq / KVBLK;
  constexpr int SE = 0, SO = 1;
  AT_SLOAD(SE, 0); asm volatile("s_waitcnt vmcnt(0)" ::: "memory"); AT_SWRITE(0, SE); __syncthreads();
  qkt(pA0, pA1, K_lds, qr, r32, hi); partialSM(pA0, pA1, m_reg, mnA, alA);
  AT_SLOAD(SO, KVBLK); if (2 < NT) AT_SLOAD(SE, 2 * KVBLK);
  AT_SWAIT(); AT_SWRITE(1, SO); __syncthreads();
  for (int j = 1; j + 1 < NT; j += 2) {
    AT_SBAR(); qkt(pB0, pB1, K_lds + SHM_K, qr, r32, hi);
    finishSM(pA0, pA1, alA, l_reg, pa0, pa1, pa2, pa3); AT_SBAR();
    AT_SLOAD(SO, (j + 2) * KVBLK); AT_SBAR();
    pv_d0(o, vb0, pa0, pa1, pa2, pa3); partialSM(pB0, pB1, m_reg, mnB, alB);
    __syncthreads(); AT_SWAIT(); AT_SWRITE(0, SE);
    AT_RESC(alB); __syncthreads();
    AT_SBAR(); qkt(pA0, pA1, K_lds, qr, r32, hi);
    finishSM(pB0, pB1, alB, l_reg, pa0, pa1, pa2, pa3); AT_SBAR();
    if (j + 3 < NT) AT_SLOAD(SE, (j + 3) * KVBLK); AT_SBAR();
    pv_d0(o, vb0 + SHM_V, pa0, pa1, pa2, pa3); partialSM(pA0, pA1, m_reg, mnA, alA);
    __syncthreads(); AT_SWAIT(); AT_SWRITE(1, SO);
    AT_RESC(alA); __syncthreads();
  }
  AT_SBAR(); qkt(pB0, pB1, K_lds + SHM_K, qr, r32, hi);
  finishSM(pA0, pA1, alA, l_reg, pa0, pa1, pa2, pa3); AT_SBAR();
  pv_d0(o, vb0, pa0, pa1, pa2, pa3); partialSM(pB0, pB1, m_reg, mnB, alB);
  __syncthreads(); AT_RESC(alB);
  finishSM(pB0, pB1, alB, l_reg, pa0, pa1, pa2, pa3); AT_SBAR();
  pv_d0(o, vb0 + SHM_V, pa0, pa1, pa2, pa3);
  if (hi == 0) li_l[r32] = l_reg; asm volatile("s_waitcnt lgkmcnt(0)" ::: "memory");
  if (ml != nullptr && hi == 0) { float* q = ml + (long)(wid * QBLK + r32) * ldml; q[0] = m_reg; q[1] = l_reg; }
  float rli[16];
#pragma unroll
  for (int r = 0; r < 16; ++r) rli[r] = __builtin_amdgcn_rcpf(li_l[crow(r, hi)]);
  TO* Ow = Ob + (long)(wid * QBLK) * ldo;
#pragma unroll
  for (int r = 0; r < 16; ++r) { const int orow = crow(r, hi);
#pragma unroll
    for (int d0 = 0; d0 < 2; ++d0) { const float val = o[d0][r] * rli[r]; if constexpr (sizeof(TO) == 2) Ow[(long)orow * ldo + d0 * 32 + r32] = (TO)(cvtpk(val, val) & 0xffffu); else Ow[(long)orow * ldo + d0 * 32 + r32] = val; } }
#undef AT_SLOAD
#undef AT_SWRITE
#undef AT_SWAIT
#undef AT_RESC
}
__device__ __forceinline__ void attn_combine(const bf16_t* Opart, const float* ml, bf16_t* dst, int ldd, int nrows_total, int ctx_rows) {
  int tid = threadIdx.x; asm volatile("" : "+v"(tid)); const int wid = tid >> 6, lane = tid & 63;
  constexpr float C = SCALE * 1.4426950408889634f; const size_t hs = (size_t)nrows_total * 6 * DV;
  for (int r = blockIdx.x * 8 + wid; r < nrows_total; r += gridDim.x * 8) {
#pragma unroll
    for (int j = 0; j < 3; ++j) { const int c = 2 * (lane + 64 * j), hh = c >> 6; const unsigned w0 = *(const unsigned*)(Opart + (size_t)r * 384 + c);
      unsigned res = w0;
      if (r >= ctx_rows) { const unsigned w1 = *(const unsigned*)(Opart + hs + (size_t)r * 384 + c);
        const float m0 = ml[((size_t)r * 6 + hh) * 2], l0 = ml[((size_t)r * 6 + hh) * 2 + 1], m1 = ml[((size_t)(nrows_total + r) * 6 + hh) * 2], l1 = ml[((size_t)(nrows_total + r) * 6 + hh) * 2 + 1];
        const float m = fmaxf(m0, m1); const float a0 = __builtin_amdgcn_exp2f((m0 - m) * C) * l0, a1 = __builtin_amdgcn_exp2f((m1 - m) * C) * l1; const float inv = 1.0f / (a0 + a1); const float f0 = a0 * inv, f1 = a1 * inv;
        const float x0 = __uint_as_float(w0 << 16) * f0 + __uint_as_float(w1 << 16) * f1, x1 = __uint_as_float(w0 & 0xffff0000u) * f0 + __uint_as_float(w1 & 0xffff0000u) * f1; res = cvtpk(x0, x1); }
      *(unsigned*)(dst + (size_t)r * ldd + c) = res; } }
}
}

namespace gm {
#define GM_LAS __attribute__((address_space(3)))
typedef unsigned short bf16_t;
typedef short bf16x8 __attribute__((ext_vector_type(8)));
typedef float f32x4 __attribute__((ext_vector_type(4)));
typedef unsigned u32x4 __attribute__((ext_vector_type(4)));
constexpr int BM = 256, BK = 64, HALF = 128, HTB = HALF * BK * 2, STAGE_BYTES = 8 * HTB;
__host__ __device__ __forceinline__ int lds_byte(int r, int c) { const int st = (r >> 4) * 2 + (c >> 5), rr = r & 15, cc = c & 31, ob = rr * 64 + cc * 2; return st * 1024 + (ob ^ (((ob >> 9) & 1) << 5)); }
__host__ __device__ __forceinline__ void stage_rc(int b, int& R, int& C) { const int st = b / 1024, sb = b % 1024, swz = sb ^ (((sb >> 9) & 1) << 5); R = (st >> 1) * 16 + swz / 64; C = (st & 1) * 32 + (swz % 64) / 2; }
__host__ __device__ __forceinline__ int perm32(int rho) { const int n = rho >> 4, i = rho & 15; return 8 * (i >> 2) + 4 * n + (i & 3); }
__device__ __forceinline__ unsigned cvt_pk_bf16(float lo, float hi) { unsigned r; asm volatile("v_cvt_pk_bf16_f32 %0, %1, %2" : "=v"(r) : "v"(lo), "v"(hi)); return r; }

template <bool PERM, class Epi>
__device__ __forceinline__ void gemm_unit(GM_LAS unsigned char* lds, const char* A, const unsigned (&offA)[2][2], const char* Bt, int K, const Epi& E) {
    int tid = threadIdx.x; asm volatile("" : "+v"(tid));
    const int wid = __builtin_amdgcn_readfirstlane(tid >> 6), lane = tid & 63, wr = wid >> 2, wc = wid & 3, fr = lane & 15, fq = lane >> 4;
    const int nt = K / BK;
    unsigned voffB[2];
#pragma unroll
    for (int i = 0; i < 2; ++i) { int R, C; stage_rc(tid * 16 + i * 8192, R, C); const int Rb = PERM ? ((R & ~31) + perm32(R & 31)) : R; voffB[i] = (unsigned)(Rb * K + C) * 2u; }
    const size_t kstep = (size_t)(BK * 2);
    const size_t hstep = (size_t)HALF * K * 2;
    const unsigned ldsw = (unsigned)wid * 1024u;
    const int aoff = lds_byte(wr * 64 + fr, fq * 8), boff = lds_byte(wc * 32 + fr, fq * 8);
#define GM_SA(b, h) (((b) * 2 + (h)) * HTB)
#define GM_SB(b, h) ((4 + (b) * 2 + (h)) * HTB)
#define GM_STAGEB(bufoff, gbase) do { _Pragma("unroll") for (int _i = 0; _i < 2; ++_i) \
        __builtin_amdgcn_global_load_lds((const unsigned*)((const char*)(gbase) + voffB[_i]), (GM_LAS unsigned*)(lds + (bufoff) + ldsw + _i * 8192), 16, 0, 0); } while (0)
#define GM_STAGEA(bufoff, h, kbyte) do { _Pragma("unroll") for (int _i = 0; _i < 2; ++_i) \
        __builtin_amdgcn_global_load_lds((const unsigned*)(A + (size_t)offA[h][_i] + (kbyte)), (GM_LAS unsigned*)(lds + (bufoff) + ldsw + _i * 8192), 16, 0, 0); } while (0)
#define GM_LDA(dst, b, h) do { _Pragma("unroll") for (int m = 0; m < 4; ++m) _Pragma("unroll") for (int k = 0; k < 2; ++k) dst[m][k] = *(const GM_LAS bf16x8*)(lds + GM_SA(b, h) + aoff + m * 2048 + k * 1024); } while (0)
#define GM_LDB(dst, b, h) do { _Pragma("unroll") for (int n = 0; n < 2; ++n) _Pragma("unroll") for (int k = 0; k < 2; ++k) dst[n][k] = *(const GM_LAS bf16x8*)(lds + GM_SB(b, h) + boff + n * 2048 + k * 1024); } while (0)
#define GM_MMA(ai, bj, At, Bt_) do { __builtin_amdgcn_s_setprio(1); _Pragma("unroll") for (int m = 0; m < 4; ++m) _Pragma("unroll") for (int n = 0; n < 2; ++n) _Pragma("unroll") for (int k = 0; k < 2; ++k) \
        acc[ai][bj][m][n] = __builtin_amdgcn_mfma_f32_16x16x32_bf16(Bt_[n][k], At[m][k], acc[ai][bj][m][n], 0, 0, 0); __builtin_amdgcn_s_setprio(0); } while (0)
#define GM_WAIT_V(n) asm volatile("s_waitcnt vmcnt(" #n ")" ::: "memory")
#define GM_WAIT_L(n) asm volatile("s_waitcnt lgkmcnt(" #n ")" ::: "memory")
#define GM_BAR __builtin_amdgcn_s_barrier()
#define GM_SCHED __builtin_amdgcn_sched_barrier(0)
    f32x4 acc[2][2][4][2];
#pragma unroll
    for (int a = 0; a < 2; ++a)
#pragma unroll
        for (int b = 0; b < 2; ++b)
#pragma unroll
            for (int m = 0; m < 4; ++m)
#pragma unroll
                for (int n = 0; n < 2; ++n) acc[a][b][m][n] = (f32x4){0.f, 0.f, 0.f, 0.f};
    bf16x8 At[4][2], B0[2][2], B1[2][2];
    const char* cB = Bt;
    GM_STAGEB(GM_SB(0, 0), cB); GM_STAGEA(GM_SA(0, 0), 0, 0); GM_STAGEB(GM_SB(0, 1), cB + hstep); GM_STAGEA(GM_SA(0, 1), 1, 0);
    if (wr == 1) GM_BAR;
    GM_WAIT_V(4); GM_BAR;
    GM_STAGEB(GM_SB(1, 0), cB + kstep); GM_STAGEA(GM_SA(1, 0), 0, kstep); GM_STAGEB(GM_SB(1, 1), cB + hstep + kstep);
    GM_WAIT_V(6); GM_BAR;
    for (int t = 0; t < nt; t += 2) {
        const bool last = (t == nt - 2);
        const size_t k1 = (size_t)(t + 1) * kstep;
        const size_t k2 = last ? 0 : (size_t)(t + 2) * kstep;
        const size_t k3 = k2 + kstep;
        const char* b2 = cB + k2; const char* b3 = cB + k3;
        GM_LDB(B0, 0, 0); GM_SCHED; GM_LDA(At, 0, 0); GM_STAGEA(GM_SA(1, 1), 1, k1);
        GM_WAIT_L(8); GM_BAR; GM_WAIT_L(0); GM_MMA(0, 0, At, B0); GM_BAR; GM_SCHED;
        GM_LDB(B1, 0, 1); GM_STAGEB(GM_SB(0, 0), b2);
        GM_BAR; GM_WAIT_L(0); GM_MMA(0, 1, At, B1); GM_BAR;
        GM_LDA(At, 0, 1); GM_STAGEA(GM_SA(0, 0), 0, k2);
        GM_BAR; GM_WAIT_L(0); GM_MMA(1, 0, At, B0); GM_BAR; GM_SCHED;
        GM_STAGEB(GM_SB(0, 1), b2 + hstep);
        GM_WAIT_V(6); GM_BAR; GM_MMA(1, 1, At, B1); GM_BAR;
        GM_LDB(B0, 1, 0); GM_SCHED; GM_LDA(At, 1, 0); GM_STAGEA(GM_SA(0, 1), 1, k2);
        GM_WAIT_L(8); GM_BAR; GM_WAIT_L(0); GM_MMA(0, 0, At, B0); GM_BAR; GM_SCHED;
        GM_LDB(B1, 1, 1); GM_STAGEB(GM_SB(1, 0), b3);
        GM_BAR; GM_WAIT_L(0); GM_MMA(0, 1, At, B1); GM_BAR;
        GM_LDA(At, 1, 1); GM_STAGEA(GM_SA(1, 0), 0, k3);
        GM_BAR; GM_WAIT_L(0); GM_MMA(1, 0, At, B0); GM_BAR; GM_SCHED;
        GM_STAGEB(GM_SB(1, 1), b3 + hstep);
        GM_WAIT_V(6); GM_BAR; GM_MMA(1, 1, At, B1); GM_BAR;
    }
    E(acc, wr, wc, fr, fq);
    GM_WAIT_V(0);
    if (wr == 0) GM_BAR;
    GM_BAR;
#undef GM_SA
#undef GM_SB
#undef GM_STAGEA
#undef GM_STAGEB
#undef GM_LDA
#undef GM_LDB
#undef GM_MMA
#undef GM_WAIT_V
#undef GM_WAIT_L
#undef GM_BAR
#undef GM_SCHED
}
__device__ __forceinline__ void dense_offA(unsigned (&offA)[2][2], long row0, int K) {
    int tid = threadIdx.x; asm volatile("" : "+v"(tid));
#pragma unroll
    for (int i = 0; i < 2; ++i) { int R, C; stage_rc(tid * 16 + i * 8192, R, C);
#pragma unroll
        for (int h = 0; h < 2; ++h) offA[h][i] = (unsigned)(((row0 + h * HALF + R) * K + C) * 2); }
}
}

struct FW {
    bf16_t *w_in_t, *w_out_t, *gu_t, *d_t;
    bf16_t *hb1, *hb2, *mixb, *actb, *yb;
    float *proj2, *mix2;
    bf16_t *w_uq_t, *w_ukv_t;
    float *ropec, *ropes;
    bf16_t *qb2, *kb2, *vb2;
    bf16_t* opart; float* aml;
    float *yd2, *st2, *cdec2, *cs2; bf16_t *cg, *prevb, *ssdb2;
};
constexpr int INC_PAD = 1792;
template <int MAP> __device__ __forceinline__ void cvt_tile(const float* src, int ldn, int nvalid, bf16_t* dst, int K, int k0, int n0, float* T) {
    int tid = threadIdx.x; asm volatile("" : "+v"(tid)); const int r = tid >> 4, c4 = (tid & 15) * 4;
#pragma unroll
    for (int i = 0; i < 2; ++i) { const int kk = r + 32 * i; float4 v = make_float4(0.f, 0.f, 0.f, 0.f);
        if (n0 + c4 < nvalid) v = *(const float4*)(src + (size_t)(k0 + kk) * ldn + n0 + c4);
        T[kk * 65 + c4 + 0] = v.x; T[kk * 65 + c4 + 1] = v.y; T[kk * 65 + c4 + 2] = v.z; T[kk * 65 + c4 + 3] = v.w; }
    __syncthreads();
    { const int n = tid >> 3, kc = tid & 7; float f[8];
#pragma unroll
        for (int j = 0; j < 8; ++j) f[j] = T[(kc * 8 + j) * 65 + n];
        gm::u32x4 w; w.x = gm::cvt_pk_bf16(f[0], f[1]); w.y = gm::cvt_pk_bf16(f[2], f[3]); w.z = gm::cvt_pk_bf16(f[4], f[5]); w.w = gm::cvt_pk_bf16(f[6], f[7]);
        const int nn = n0 + n; const int drow = MAP == 0 ? nn : ((nn >> 7) * 256 + (MAP == 2 ? 128 : 0) + (nn & 127));
        *(gm::u32x4*)(dst + (size_t)drow * K + k0 + kc * 8) = w; }
    __syncthreads();
}
__device__ __forceinline__ void cvt_phase(const P& p, const FW& f, int l0, int l1, char* lds) {
    float* T = (float*)lds;
    constexpr int T_IN = 16 * 28, T_OUT = 16 * 16, T_E = 16 * 16, T_UQ = 4 * 9, T_UKV = 2 * 12, T_LAYER = T_IN + T_OUT + T_UQ + T_UKV + NE * 3 * T_E;
    const int total = (l1 - l0) * T_LAYER;
    if (blockIdx.x == gridDim.x - 1) for (int i = threadIdx.x; i < 256 * 8; i += 512) { float cs, sn; sincos_rr((float)(i >> 3) * rope_inv_freq(i & 7), cs, sn); f.ropec[i] = cs; f.ropes[i] = sn; }
    for (int t = blockIdx.x; t < total; t += gridDim.x) {
        const int l = l0 + t / T_LAYER; int r = t % T_LAYER;
        if (r < T_IN) { const int kt = r / 28, ntl = r % 28; cvt_tile<0>(p.w_in + (size_t)l * D * INC, INC, INC, f.w_in_t + (size_t)l * INC_PAD * D, D, kt * 64, ntl * 64, T); continue; }
        r -= T_IN;
        if (r < T_OUT) { const int kt = r / 16, ntl = r % 16; cvt_tile<0>(p.w_out + (size_t)l * MIXW * D, D, D, f.w_out_t + (size_t)l * D * MIXW, MIXW, kt * 64, ntl * 64, T); continue; }
        r -= T_OUT;
        if (r < T_UQ) { const int kt = r / 9, ntl = r % 9; cvt_tile<0>(p.w_uq + (size_t)l * QL * NH * QKD, NH * QKD, NH * QKD, f.w_uq_t + (size_t)l * NH * QKD * QL, QL, kt * 64, ntl * 64, T); continue; }
        r -= T_UQ;
        if (r < T_UKV) { const int kt = r / 12, ntl = r % 12; cvt_tile<0>(p.w_ukv + (size_t)l * KVL * NH * 128, NH * 128, NH * 128, f.w_ukv_t + (size_t)l * NH * 128 * KVL, KVL, kt * 64, ntl * 64, T); continue; }
        r -= T_UKV;
        const int e = r / (3 * T_E), which = (r / T_E) % 3, tt = r % T_E, kt = tt / 16, ntl = tt % 16; const size_t le = (size_t)l * NE + e;
        if (which == 0) cvt_tile<1>(p.wg + le * D * FF, FF, FF, f.gu_t + le * 2 * FF * D, D, kt * 64, ntl * 64, T);
        else if (which == 1) cvt_tile<2>(p.wu + le * D * FF, FF, FF, f.gu_t + le * 2 * FF * D, D, kt * 64, ntl * 64, T);
        else cvt_tile<0>(p.wd + le * FF * D, D, D, f.d_t + le * D * FF, FF, kt * 64, ntl * 64, T);
    }
}
__device__ __forceinline__ void inproj_phase(const P& p, const FW& f, int l, float* dst, char* lds) {
    constexpr int NPN = INC_PAD / 256, NU = (M / 256) * NPN;
    for (int u = blockIdx.x; u < NU; u += gridDim.x) {
        const int pm = u / NPN, pn = u % NPN; unsigned offA[2][2]; gm::dense_offA(offA, (long)pm * 256, D);
        auto epi = [&](const gm::f32x4 (&acc)[2][2][4][2], int wr, int wc, int fr, int fq) {
            const int row0 = pm * 256 + wr * 64 + fr, col0 = pn * 256 + wc * 32 + 4 * fq;
#pragma unroll
            for (int ai = 0; ai < 2; ++ai)
#pragma unroll
                for (int m = 0; m < 4; ++m) { float* rowp = dst + (size_t)(row0 + ai * 128 + m * 16) * INC + col0;
#pragma unroll
                    for (int bj = 0; bj < 2; ++bj)
#pragma unroll
                        for (int n = 0; n < 2; ++n) if (col0 + bj * 128 + n * 16 < INC) *(gm::f32x4*)(rowp + bj * 128 + n * 16) = acc[ai][bj][m][n]; } };
        gm::gemm_unit<false>((GM_LAS unsigned char*)lds, (const char*)f.hb1, offA, (const char*)(f.w_in_t + ((size_t)l * INC_PAD + pn * 256) * D), D, epi);
    }
}
template <bool TOX> __device__ __forceinline__ void outproj_phase(const P& p, const FW& f, int l, float* dst, char* lds) {
    constexpr int NPN = D / 256, NU = (M / 256) * NPN;
    for (int u = blockIdx.x; u < NU; u += gridDim.x) {
        const int pm = u / NPN, pn = u % NPN; unsigned offA[2][2]; gm::dense_offA(offA, (long)pm * 256, MIXW);
        auto epi = [&](const gm::f32x4 (&acc)[2][2][4][2], int wr, int wc, int fr, int fq) {
            const int row0 = pm * 256 + wr * 64 + fr, col0 = pn * 256 + wc * 32 + 4 * fq; const float* gate = modv(p, l, pm * 256, 2);
#pragma unroll
            for (int ai = 0; ai < 2; ++ai)
#pragma unroll
                for (int m = 0; m < 4; ++m) { float* rowp = dst + (size_t)(row0 + ai * 128 + m * 16) * D + col0;
#pragma unroll
                    for (int bj = 0; bj < 2; ++bj)
#pragma unroll
                        for (int n = 0; n < 2; ++n) { float* q = rowp + bj * 128 + n * 16;
                            if (TOX) { const gm::f32x4 g = *(const gm::f32x4*)(gate + col0 + bj * 128 + n * 16); const gm::f32x4 x = *(const gm::f32x4*)q; *(gm::f32x4*)q = x + g * acc[ai][bj][m][n]; }
                            else *(gm::f32x4*)q = acc[ai][bj][m][n]; } } };
        gm::gemm_unit<false>((GM_LAS unsigned char*)lds, (const char*)f.mixb, offA, (const char*)(f.w_out_t + ((size_t)l * D + pn * 256) * MIXW), MIXW, epi);
    }
}
__device__ __forceinline__ bool moe_find(const int* cnt, int tg, int& e, int& ti, int& c) {
    int acc = 0;
    for (int x = 0; x < NE; ++x) { const int cx = cnt[x]; const int nt = (cx + 255) >> 8; if (tg < acc + nt) { e = x; ti = tg - acc; c = cx; return true; } acc += nt; }
    return false;
}
__device__ __forceinline__ int moe_tiles(const int* cnt) { int acc = 0; for (int x = 0; x < NE; ++x) acc += (cnt[x] + 255) >> 8; return acc; }
template <bool SRC_TOK> __device__ __forceinline__ void gather_offA(unsigned (&offA)[2][2], const int* lst, int base, int cnt, int K) {
    int tid = threadIdx.x; asm volatile("" : "+v"(tid));
#pragma unroll
    for (int i = 0; i < 2; ++i) { int R, C; gm::stage_rc(tid * 16 + i * 8192, R, C);
#pragma unroll
        for (int h = 0; h < 2; ++h) { const int s = base + h * 128 + R; int a = s < cnt ? lst[s] : 0; if (SRC_TOK) a >>= 2; offA[h][i] = (unsigned)(((size_t)a * K + C) * 2); } }
}
__device__ __forceinline__ void moe1_phase(const P& p, const FW& f, int l, char* lds) {
    constexpr int NPN = 2 * FF / 256; const int NU = moe_tiles(p.cnt) * NPN;
    for (int u = blockIdx.x; u < NU; u += gridDim.x) {
        int e, ti, cnt; if (!moe_find(p.cnt, u / NPN, e, ti, cnt)) break; const int pn = u % NPN; const int* lst = p.list + (size_t)e * M; const size_t le = (size_t)l * NE + e;
        unsigned offA[2][2]; gather_offA<true>(offA, lst, ti * 256, cnt, D);
        auto epi = [&](const gm::f32x4 (&acc)[2][2][4][2], int wr, int wc, int fr, int fq) {
            const int ff0 = pn * 128 + wc * 32 + 8 * fq; const float* bgp = p.bg + le * FF + ff0; const float* bup = p.bu + le * FF + ff0;
            const gm::f32x4 bg0 = *(const gm::f32x4*)bgp, bg1 = *(const gm::f32x4*)(bgp + 4), bu0 = *(const gm::f32x4*)bup, bu1 = *(const gm::f32x4*)(bup + 4);
#pragma unroll
            for (int ai = 0; ai < 2; ++ai)
#pragma unroll
                for (int m = 0; m < 4; ++m) { const int s = ti * 256 + ai * 128 + wr * 64 + m * 16 + fr; if (s < cnt) { const int a = lst[s]; float o[8];
#pragma unroll
                        for (int n = 0; n < 2; ++n)
#pragma unroll
                            for (int j = 0; j < 4; ++j) { float g = acc[ai][0][m][n][j] + (n ? bg1[j] : bg0[j]); float uu = acc[ai][1][m][n][j] + (n ? bu1[j] : bu0[j]);
                                g = g < 7.0f ? g : 7.0f; uu = uu < -7.0f ? -7.0f : (uu > 7.0f ? 7.0f : uu); o[n * 4 + j] = g * (1.0f / (1.0f + __expf(-1.702f * g))) * (uu + 1.0f); }
                        gm::u32x4 w; w.x = gm::cvt_pk_bf16(o[0], o[1]); w.y = gm::cvt_pk_bf16(o[2], o[3]); w.z = gm::cvt_pk_bf16(o[4], o[5]); w.w = gm::cvt_pk_bf16(o[6], o[7]);
                        *(gm::u32x4*)(f.actb + (size_t)a * FF + ff0) = w; } } };
        gm::gemm_unit<true>((GM_LAS unsigned char*)lds, (const char*)f.hb2, offA, (const char*)(f.gu_t + (le * 2 * FF + pn * 256) * D), D, epi);
    }
}
__device__ __forceinline__ void moe2_phase(const P& p, const FW& f, int l, char* lds) {
    constexpr int NPN = D / 256; const int NU = moe_tiles(p.cnt) * NPN;
    for (int u = blockIdx.x; u < NU; u += gridDim.x) {
        int e, ti, cnt; if (!moe_find(p.cnt, u / NPN, e, ti, cnt)) break; const int pn = u % NPN; const int* lst = p.list + (size_t)e * M; const size_t le = (size_t)l * NE + e;
        unsigned offA[2][2]; gather_offA<false>(offA, lst, ti * 256, cnt, FF);
        auto epi = [&](const gm::f32x4 (&acc)[2][2][4][2], int wr, int wc, int fr, int fq) {
#pragma unroll
            for (int bj = 0; bj < 2; ++bj) { const int c0 = pn * 256 + bj * 128 + wc * 32 + 8 * fq; const float* bp = p.bd + le * D + c0; const gm::f32x4 b0 = *(const gm::f32x4*)bp, b1 = *(const gm::f32x4*)(bp + 4);
#pragma unroll
                for (int ai = 0; ai < 2; ++ai)
#pragma unroll
                    for (int m = 0; m < 4; ++m) { const int s = ti * 256 + ai * 128 + wr * 64 + m * 16 + fr; if (s < cnt) { const int a = lst[s];
                            const gm::f32x4 v0 = acc[ai][bj][m][0] + b0, v1 = acc[ai][bj][m][1] + b1;
                            gm::u32x4 w; w.x = gm::cvt_pk_bf16(v0[0], v0[1]); w.y = gm::cvt_pk_bf16(v0[2], v0[3]); w.z = gm::cvt_pk_bf16(v1[0], v1[1]); w.w = gm::cvt_pk_bf16(v1[2], v1[3]);
                            *(gm::u32x4*)(f.yb + (size_t)a * D + c0) = w; } } } };
        gm::gemm_unit<true>((GM_LAS unsigned char*)lds, (const char*)f.actb, offA, (const char*)(f.d_t + (le * D + pn * 256) * FF), FF, epi);
    }
}

namespace rw {
typedef float f32x4 __attribute__((ext_vector_type(4)));
typedef unsigned u32x2 __attribute__((ext_vector_type(2)));
constexpr int ROWS_PB = 65;
__device__ __forceinline__ float wave_sum(float v) {
#pragma unroll
    for (int o = 32; o >= 1; o >>= 1) v += __shfl_xor(v, o);
    return v;
}
__device__ __forceinline__ unsigned pk2(float lo, float hi) { unsigned r; asm volatile("v_cvt_pk_bf16_f32 %0, %1, %2" : "=v"(r) : "v"(lo), "v"(hi)); return r; }
__device__ __forceinline__ f32x4 bf4(u32x2 w) { f32x4 r; r[0] = __uint_as_float(w.x << 16); r[1] = __uint_as_float(w.x & 0xffff0000u); r[2] = __uint_as_float(w.y << 16); r[3] = __uint_as_float(w.y & 0xffff0000u); return r; }
__device__ __forceinline__ void norm_store(const f32x4 (&x)[4], const float* g, const float* shift, const float* scale, bf16_t* dst, int lane) {
    float ss = 0.f;
#pragma unroll
    for (int j = 0; j < 4; ++j) ss += x[j][0] * x[j][0] + x[j][1] * x[j][1] + x[j][2] * x[j][2] + x[j][3] * x[j][3];
    ss = wave_sum(ss); const float rs = 1.0f / sqrtf(ss * (1.0f / D) + EPS);
#pragma unroll
    for (int j = 0; j < 4; ++j) { const int c = 4 * lane + 256 * j; const f32x4 gv = *(const f32x4*)(g + c), sh = *(const f32x4*)(shift + c), sc = *(const f32x4*)(scale + c);
        const f32x4 o = x[j] * rs * gv * (1.0f + sc) + sh; u32x2 w; w.x = pk2(o[0], o[1]); w.y = pk2(o[2], o[3]); *(u32x2*)(dst + c) = w; }
}
__device__ __forceinline__ void first_norm_phase(const P& p) {
    int tid = threadIdx.x; asm volatile("" : "+v"(tid)); const int wid = tid >> 6, lane = tid & 63;
    for (int i = wid; i < ROWS_PB; i += 8) { const int r = blockIdx.x * ROWS_PB + i; if (r >= M) break;
        const float* src = r < CTX ? p.ctx + (size_t)r * D : p.x + (size_t)(r - CTX) * D; f32x4 x[4];
#pragma unroll
        for (int j = 0; j < 4; ++j) { x[j] = *(const f32x4*)(src + 4 * lane + 256 * j); *(f32x4*)(p.xres + (size_t)r * D + 4 * lane + 256 * j) = x[j]; }
        norm_store(x, p.norm1_g, modv(p, 0, r, 0), modv(p, 0, r, 1), p.hb1 + (size_t)r * D, lane); }
}
template <bool DRY = false> __device__ __forceinline__ void combine_phase(const P& p, int l) {
    int tid = threadIdx.x; asm volatile("" : "+v"(tid)); const int wid = tid >> 6, lane = tid & 63;
    for (int i = wid; i < ROWS_PB; i += 8) { const int r = blockIdx.x * ROWS_PB + i; if (r >= M) break;
        const f32x4 tw = *(const f32x4*)(p.topw + (size_t)r * 4); const float* gate = modv(p, l, r, 5); f32x4 x[4];
#pragma unroll
        for (int j = 0; j < 4; ++j) { const int c = 4 * lane + 256 * j; f32x4 s = {0.f, 0.f, 0.f, 0.f};
#pragma unroll
            for (int k = 0; k < 4; ++k) s += bf4(*(const u32x2*)(p.ybn + ((size_t)r * 4 + k) * D + c)) * tw[k];
            x[j] = *(const f32x4*)(p.xres + (size_t)r * D + c) + *(const f32x4*)(gate + c) * s; }
        if (l + 1 < DEPTH) {
#pragma unroll
            for (int j = 0; j < 4; ++j) if (!DRY) *(f32x4*)(p.xres + (size_t)r * D + 4 * lane + 256 * j) = x[j];
            norm_store(x, p.norm1_g + (size_t)(l + 1) * D, modv(p, l + 1, r, 0), modv(p, l + 1, r, 1), p.hb1 + (size_t)r * D, lane);
        } else if (r >= CTX) {
#pragma unroll
            for (int j = 0; j < 4; ++j) *(f32x4*)(p.out + (size_t)(r - CTX) * D + 4 * lane + 256 * j) = x[j];
        } }
}
template <bool DRY = false> __device__ __forceinline__ void router_phase(const P& p, int l, char* lds) {
    int tid = threadIdx.x; asm volatile("" : "+v"(tid)); const int wid = tid >> 6, lane = tid & 63;
    float* WT = (float*)lds; float* bias2 = WT + 32 * 1024; int* lcnt = (int*)(bias2 + 64); int* lbase = lcnt + 32; int* rec = lbase + 32;
    const float* rwp = p.router_w + (size_t)l * D * NE;
    for (int i = tid; i < D * NE / 4; i += 512) { const int k = i >> 3, e4 = i & 7; const f32x4 v = *(const f32x4*)(rwp + (size_t)k * NE + e4 * 4);
#pragma unroll
        for (int q = 0; q < 4; ++q) WT[(e4 * 4 + q) * 1024 + (k ^ (e4 << 2))] = v[q]; }
    if (tid < 32) lcnt[tid] = 0;
    __syncthreads();
    {
#pragma unroll
        for (int v = 0; v < 2; ++v) { const float* sh = p.mod + ((size_t)(l * 2 + v) * 6 + 3) * D; f32x4 s[4];
#pragma unroll
            for (int j = 0; j < 4; ++j) s[j] = *(const f32x4*)(sh + 4 * lane + 256 * j);
#pragma unroll
            for (int q = 0; q < 4; ++q) { const int e = wid * 4 + q; float a = 0.f;
#pragma unroll
                for (int j = 0; j < 4; ++j) { const f32x4 w = *(const f32x4*)(WT + e * 1024 + ((4 * lane + 256 * j) ^ (((e >> 2) & 7) << 2))); a += w[0] * s[j][0] + w[1] * s[j][1] + w[2] * s[j][2] + w[3] * s[j][3]; }
                a = wave_sum(a); if (lane == 0) bias2[v * 32 + e] = a + p.router_b[l * NE + e]; } }
    }
    __syncthreads();
    const float* g2 = p.norm2_g + (size_t)l * D;
    for (int rp = wid; rp < (ROWS_PB + 1) / 2; rp += 8) {
        float acc[2][32]; float rsv[2]; int rr[2];
        f32x4 xg[2][4];
#pragma unroll
        for (int q = 0; q < 2; ++q) { const int il = 2 * rp + q; const int r = blockIdx.x * ROWS_PB + (il < ROWS_PB ? il : ROWS_PB - 1); rr[q] = r;
            const float* sc = modv(p, l, r, 4); const float* sh = modv(p, l, r, 3); float ss = 0.f; f32x4 x[4];
#pragma unroll
            for (int j = 0; j < 4; ++j) { x[j] = *(const f32x4*)(p.xres + (size_t)r * D + 4 * lane + 256 * j); ss += x[j][0] * x[j][0] + x[j][1] * x[j][1] + x[j][2] * x[j][2] + x[j][3] * x[j][3]; }
            ss = wave_sum(ss); const float rs = 1.0f / sqrtf(ss * (1.0f / D) + EPS); rsv[q] = rs;
#pragma unroll
            for (int j = 0; j < 4; ++j) { const int c = 4 * lane + 256 * j; xg[q][j] = x[j] * *(const f32x4*)(g2 + c) * (1.0f + *(const f32x4*)(sc + c));
                const f32x4 o = xg[q][j] * rs + *(const f32x4*)(sh + c); u32x2 w; w.x = pk2(o[0], o[1]); w.y = pk2(o[2], o[3]); if (il < ROWS_PB) *(u32x2*)(p.hb2 + (size_t)r * D + c) = w; }
        }
#pragma unroll
        for (int e = 0; e < 32; ++e) { float a0 = 0.f, a1 = 0.f;
#pragma unroll
            for (int j = 0; j < 4; ++j) { const f32x4 w = *(const f32x4*)(WT + e * 1024 + ((4 * lane + 256 * j) ^ (((e >> 2) & 7) << 2)));
                a0 += w[0] * xg[0][j][0] + w[1] * xg[0][j][1] + w[2] * xg[0][j][2] + w[3] * xg[0][j][3]; a1 += w[0] * xg[1][j][0] + w[1] * xg[1][j][1] + w[2] * xg[1][j][2] + w[3] * xg[1][j][3]; }
            acc[0][e] = a0; acc[1][e] = a1; }
        float v[64];
#pragma unroll
        for (int e = 0; e < 32; ++e) { v[e] = acc[0][e]; v[32 + e] = acc[1][e]; }
#pragma unroll
        for (int m = 32, n = 64; m >= 1; m >>= 1, n >>= 1) {
#pragma unroll
            for (int i = 0; i < n / 2; ++i) { const bool up = (lane & m) != 0; const float keep = up ? v[i + n / 2] : v[i], send = up ? v[i] : v[i + n / 2]; v[i] = keep + __shfl_xor(send, m); } }
        const int q = lane >> 5, e = lane & 31; const int r = rr[q]; const int il = 2 * rp + q;
        float logit = v[0] * rsv[q] + bias2[(r < CTX ? 32 : 0) + e];
        float cur = logit; int sel[4]; float sv[4];
#pragma unroll
        for (int k = 0; k < 4; ++k) { float mx = cur;
#pragma unroll
            for (int o = 16; o >= 1; o >>= 1) mx = fmaxf(mx, __shfl_xor(mx, o));
            const unsigned long long bal = __ballot(cur == mx); const unsigned half = (unsigned)(bal >> (q * 32)); const int win = __ffs(half) - 1;
            sel[k] = win; sv[k] = mx; if (e == win) cur = -3.0e38f; }
        if (e < 4 && il < ROWS_PB) {
            float es[4], sum = 0.f;
#pragma unroll
            for (int k = 0; k < 4; ++k) { es[k] = __expf(sv[k] - sv[0]); sum += es[k]; }
            const int myk = e; const int mye = myk == 0 ? sel[0] : myk == 1 ? sel[1] : myk == 2 ? sel[2] : sel[3]; const float myw = (myk == 0 ? es[0] : myk == 1 ? es[1] : myk == 2 ? es[2] : es[3]) / sum;
            if (!DRY) p.topw[(size_t)r * 4 + myk] = myw; const int pos = atomicAdd(&lcnt[mye], 1); rec[il * 4 + myk] = mye | (pos << 8);
        }
    }
    __syncthreads();
    if (tid < 32) lbase[tid] = DRY ? 0 : atomicAdd(&p.cnt[tid], lcnt[tid]);
    __syncthreads();
    if (tid < ROWS_PB * 4) { const int il = tid >> 2, k = tid & 3; const int r = blockIdx.x * ROWS_PB + il; const int rc = rec[tid]; const int e = rc & 255, pos = rc >> 8;
        if (!DRY) p.list[(size_t)e * M + lbase[e] + pos] = r * 4 + k; }
    __syncthreads();
}
}

namespace ml {
typedef short bf16x8 __attribute__((ext_vector_type(8)));
typedef float f32x4 __attribute__((ext_vector_type(4)));
typedef unsigned u32x2 __attribute__((ext_vector_type(2)));
constexpr int RB = 65, MT = 5;
constexpr int AQ_STRIDE = QL * 2 + 16, AKV_STRIDE = KVL * 2 + 16;
constexpr int OFF_AQ = 0, OFF_AKV = OFF_AQ + 80 * AQ_STRIDE, OFF_KRS = OFF_AKV + 80 * AKV_STRIDE, OFF_KSS = OFF_KRS + 80 * 32 * 4, LDS_MLA = OFF_KSS + 80 * 4;
struct MW { const bf16_t* w_uq_t; const bf16_t* w_ukv_t; const float* ropec; const float* ropes; const float* proj; int ldp; bf16_t* qb; bf16_t* kb; bf16_t* vb; };
__device__ __forceinline__ void mla_phase(const P& p, const MW& w, int l, char* lds) {
    int tid = threadIdx.x; asm volatile("" : "+v"(tid)); const int wid = __builtin_amdgcn_readfirstlane(tid >> 6), lane = tid & 63, fr = lane & 15, fq = lane >> 4;
    const int row0 = blockIdx.x * RB;
    for (int i = wid; i < 80; i += 8) {
        char* aq = lds + OFF_AQ + i * AQ_STRIDE; char* akv = lds + OFF_AKV + i * AKV_STRIDE; float* krs = (float*)(lds + OFF_KRS) + i * 32;
        if (i < RB && row0 + i < M) { const float* pr = w.proj + (size_t)(row0 + i) * w.ldp;
            { const f32x4 x = *(const f32x4*)(pr + C_Q + 4 * lane); float ss = rw::wave_sum(x[0] * x[0] + x[1] * x[1] + x[2] * x[2] + x[3] * x[3]); const float rs = 1.0f / sqrtf(ss * (1.0f / QL) + EPS);
              const f32x4 g = *(const f32x4*)(p.q_g + l * QL + 4 * lane); const f32x4 o = x * rs * g; u32x2 v; v.x = rw::pk2(o[0], o[1]); v.y = rw::pk2(o[2], o[3]); *(u32x2*)(aq + 8 * lane) = v; }
            { f32x4 x = {0.f, 0.f, 0.f, 0.f}; if (lane < 32) x = *(const f32x4*)(pr + C_KV + 4 * lane); float ss = rw::wave_sum(x[0] * x[0] + x[1] * x[1] + x[2] * x[2] + x[3] * x[3]); const float rs = 1.0f / sqrtf(ss * (1.0f / KVL) + EPS);
              if (lane < 32) { const f32x4 g = *(const f32x4*)(p.kv_g + l * KVL + 4 * lane); const f32x4 o = x * rs * g; u32x2 v; v.x = rw::pk2(o[0], o[1]); v.y = rw::pk2(o[2], o[3]); *(u32x2*)(akv + 8 * lane) = v; } }
            { f32x4 x = {0.f, 0.f, 0.f, 0.f}; if (lane < 8) { x = *(const f32x4*)(pr + C_KR + 4 * lane); *(f32x4*)(krs + 4 * lane) = x; }
              const float ss = rw::wave_sum(x[0] * x[0] + x[1] * x[1] + x[2] * x[2] + x[3] * x[3]); if (lane == 0) ((float*)(lds + OFF_KSS))[i] = ss; }
        } else {
            u32x2 z; z.x = 0u; z.y = 0u; *(u32x2*)(aq + 8 * lane) = z; if (lane < 32) *(u32x2*)(akv + 8 * lane) = z; if (lane < 32) krs[lane] = 0.f; if (lane == 0) ((float*)(lds + OFF_KSS))[i] = 0.f;
        }
    }
    __syncthreads();
    if (wid < 6) {
        const int hh = wid; f32x4 acc[MT][6];
#pragma unroll
        for (int mt = 0; mt < MT; ++mt)
#pragma unroll
            for (int nt = 0; nt < 6; ++nt) acc[mt][nt] = (f32x4){0.f, 0.f, 0.f, 0.f};
        const bf16_t* wb = w.w_uq_t + (size_t)(hh * QKD + fr) * QL + 8 * fq;
#pragma unroll 1
        for (int ks = 0; ks < QL / 32; ++ks) { bf16x8 b[6], a[MT];
#pragma unroll
            for (int nt = 0; nt < 6; ++nt) b[nt] = *(const bf16x8*)(wb + (size_t)nt * 16 * QL + ks * 32);
#pragma unroll
            for (int mt = 0; mt < MT; ++mt) a[mt] = *(const bf16x8*)(lds + OFF_AQ + (mt * 16 + fr) * AQ_STRIDE + (ks * 32 + 8 * fq) * 2);
#pragma unroll
            for (int mt = 0; mt < MT; ++mt)
#pragma unroll
                for (int nt = 0; nt < 6; ++nt) acc[mt][nt] = __builtin_amdgcn_mfma_f32_16x16x32_bf16(b[nt], a[mt], acc[mt][nt], 0, 0, 0); }
        f32x4 gq[6];
#pragma unroll
        for (int nt = 0; nt < 6; ++nt) gq[nt] = *(const f32x4*)(p.qn_g + l * QKD + nt * 16 + 4 * fq);
#pragma unroll
        for (int mt = 0; mt < MT; ++mt) { const int il = mt * 16 + fr; const int r = row0 + il; const bool ok = il < RB && r < M; float ss = 0.f;
#pragma unroll
            for (int nt = 0; nt < 6; ++nt) ss += acc[mt][nt][0] * acc[mt][nt][0] + acc[mt][nt][1] * acc[mt][nt][1] + acc[mt][nt][2] * acc[mt][nt][2] + acc[mt][nt][3] * acc[mt][nt][3];
            ss += __shfl_xor(ss, 16); ss += __shfl_xor(ss, 32); const float rs = 1.0f / sqrtf(ss * (1.0f / QKD) + EPS);
            const bool lat = r >= CTX; const int t = lat ? r - CTX : 0;
#pragma unroll
            for (int nt = 0; nt < 6; ++nt) { f32x4 v = acc[mt][nt] * rs * gq[nt];
                if (nt >= 4) { f32x4 other; other[0] = __shfl_xor(v[0], 32); other[1] = __shfl_xor(v[1], 32); other[2] = __shfl_xor(v[2], 32); other[3] = __shfl_xor(v[3], 32);
                    if (lat && ok) { const int pos = (nt == 4) ? (t / GRID_W) : (t % GRID_W); const f32x4 cs = *(const f32x4*)(w.ropec + (size_t)pos * 8 + 4 * (fq & 1)), sn = *(const f32x4*)(w.ropes + (size_t)pos * 8 + 4 * (fq & 1));
                        v = (fq >> 1) ? (v * cs + other * sn) : (v * cs - other * sn); } }
                if (ok) { u32x2 o; o.x = rw::pk2(v[0], v[1]); o.y = rw::pk2(v[2], v[3]); *(u32x2*)(w.qb + ((size_t)r * NH + hh) * QKD + nt * 16 + 4 * fq) = o; } } }
    } else {
        for (int hs = 0; hs < 3; ++hs) { const int hh = (wid - 6) * 3 + hs;
#pragma unroll
          for (int pass = 0; pass < 2; ++pass) { f32x4 acc[MT][4];
#pragma unroll
            for (int mt = 0; mt < MT; ++mt)
#pragma unroll
                for (int nt = 0; nt < 4; ++nt) acc[mt][nt] = (f32x4){0.f, 0.f, 0.f, 0.f};
            const bf16_t* wb = w.w_ukv_t + (size_t)(hh * 128 + pass * 64 + fr) * KVL + 8 * fq;
#pragma unroll 1
            for (int ks = 0; ks < KVL / 32; ++ks) { bf16x8 b[4], a[MT];
#pragma unroll
                for (int nt = 0; nt < 4; ++nt) b[nt] = *(const bf16x8*)(wb + (size_t)nt * 16 * KVL + ks * 32);
#pragma unroll
                for (int mt = 0; mt < MT; ++mt) a[mt] = *(const bf16x8*)(lds + OFF_AKV + (mt * 16 + fr) * AKV_STRIDE + (ks * 32 + 8 * fq) * 2);
#pragma unroll
                for (int mt = 0; mt < MT; ++mt)
#pragma unroll
                    for (int nt = 0; nt < 4; ++nt) acc[mt][nt] = __builtin_amdgcn_mfma_f32_16x16x32_bf16(b[nt], a[mt], acc[mt][nt], 0, 0, 0); }
            if (pass == 0) {
                f32x4 gk[4], gr[2], gro[2];
#pragma unroll
                for (int nt = 0; nt < 4; ++nt) gk[nt] = *(const f32x4*)(p.kn_g + l * QKD + nt * 16 + 4 * fq);
#pragma unroll
                for (int a = 0; a < 2; ++a) { gr[a] = *(const f32x4*)(p.kn_g + l * QKD + NOPE + a * 16 + 4 * fq); gro[a] = *(const f32x4*)(p.kn_g + l * QKD + NOPE + a * 16 + ((4 * fq) ^ 8)); }
#pragma unroll
                for (int mt = 0; mt < MT; ++mt) { const int il = mt * 16 + fr; const int r = row0 + il; const bool ok = il < RB && r < M; float ss = 0.f;
#pragma unroll
                    for (int nt = 0; nt < 4; ++nt) ss += acc[mt][nt][0] * acc[mt][nt][0] + acc[mt][nt][1] * acc[mt][nt][1] + acc[mt][nt][2] * acc[mt][nt][2] + acc[mt][nt][3] * acc[mt][nt][3];
                    ss += __shfl_xor(ss, 16); ss += __shfl_xor(ss, 32); ss += ((const float*)(lds + OFF_KSS))[il]; const float rs = 1.0f / sqrtf(ss * (1.0f / QKD) + EPS);
                    const bool lat = r >= CTX; const int t = lat ? r - CTX : 0;
                    if (ok) {
                        bf16_t* kd = w.kb + ((size_t)r * NH + hh) * QKD; const float* krs = (const float*)(lds + OFF_KRS) + il * 32;
#pragma unroll
                        for (int nt = 0; nt < 4; ++nt) { const f32x4 v = acc[mt][nt] * rs * gk[nt]; u32x2 o; o.x = rw::pk2(v[0], v[1]); o.y = rw::pk2(v[2], v[3]); *(u32x2*)(kd + nt * 16 + 4 * fq) = o; }
#pragma unroll
                        for (int a = 0; a < 2; ++a) { f32x4 v = *(const f32x4*)(krs + a * 16 + 4 * fq) * rs * gr[a]; const f32x4 other = *(const f32x4*)(krs + a * 16 + ((4 * fq) ^ 8)) * rs * gro[a];
                            if (lat) { const int pos = (a == 0) ? (t / GRID_W) : (t % GRID_W); const f32x4 cs = *(const f32x4*)(w.ropec + (size_t)pos * 8 + 4 * (fq & 1)), sn = *(const f32x4*)(w.ropes + (size_t)pos * 8 + 4 * (fq & 1));
                                v = (fq >> 1) ? (v * cs + other * sn) : (v * cs - other * sn); }
                            u32x2 o; o.x = rw::pk2(v[0], v[1]); o.y = rw::pk2(v[2], v[3]); *(u32x2*)(kd + NOPE + a * 16 + 4 * fq) = o; }
                    } }
            } else {
#pragma unroll
                for (int mt = 0; mt < MT; ++mt) { const int il = mt * 16 + fr; const int r = row0 + il; const bool ok = il < RB && r < M;
                    if (ok) { bf16_t* vd = w.vb + ((size_t)r * NH + hh) * VD;
#pragma unroll
                        for (int nt = 0; nt < 4; ++nt) { const f32x4 v = acc[mt][nt]; u32x2 o; o.x = rw::pk2(v[0], v[1]); o.y = rw::pk2(v[2], v[3]); *(u32x2*)(vd + nt * 16 + 4 * fq) = o; } } }
            }
          }
        }
    }
    __syncthreads();
}
}

namespace sd {
typedef short bf16x8 __attribute__((ext_vector_type(8)));
typedef float f32x4 __attribute__((ext_vector_type(4)));
typedef unsigned u32x2 __attribute__((ext_vector_type(2)));
typedef unsigned u32x4 __attribute__((ext_vector_type(4)));
constexpr int SBS = 144, STS = 272;
constexpr int OFF_BM = 0, OFF_CM = OFF_BM + 128 * SBS, OFF_XT = OFF_CM + 128 * SBS, OFF_BTF = OFF_XT + 64 * STS, OFF_BTB = OFF_BTF + 64 * STS, OFF_L = OFF_BTB + 64 * STS, OFF_SC = OFF_L + 128 * STS, LDS_SSD = OFF_SC + 4 * 128 * 4;
struct SsdW { const float* proj; int ldp; float* yd; float* st; float* cdec; float* cs; bf16_t* cg; bf16_t* prevb; };
__device__ __forceinline__ bf16x8 ldfrag(const char* base, int row, int stride, int kbyte) { return *(const bf16x8*)(base + row * stride + kbyte); }
__device__ __forceinline__ float silu_f(float x) { return x / (1.0f + __expf(-x)); }
__device__ __forceinline__ void chunk_unit(const P& p, const SsdW& w, int l, int c, int hh, char* lds) {
    int tid = threadIdx.x; asm volatile("" : "+v"(tid)); const int wid = __builtin_amdgcn_readfirstlane(tid >> 6), lane = tid & 63, fr = lane & 15, fq = lane >> 4;
    const int R0 = c * CHUNK, g = hh / (SH / SG); const int seg0 = R0 < CTX ? 0 : CTX, seg1 = R0 < CTX ? CTX : M;
    float* csf = (float*)(lds + OFF_SC); float* csb = csf + 128; float* dtf = csb + 128; float* dtb = dtf + 128;
    if (tid < 256) { const int r = tid & 127, d = tid >> 7; const float v = softplusf(w.proj[(size_t)(R0 + r) * w.ldp + C_DT + d * 6 + hh] + p.dt_bias[l * 12 + d * 6 + hh]); (d ? dtb : dtf)[r] = v; }
    __syncthreads();
    if (wid < 2) {
        const int d = wid; const float a = -__expf(p.a_log[l * 12 + d * 6 + hh]); const float* dts = d ? dtb : dtf; float* cso = d ? csb : csf;
        const int i0 = 2 * lane, i1 = 2 * lane + 1; const int r0 = d ? 127 - i0 : i0, r1 = d ? 127 - i1 : i1;
        const float v0 = dts[r0] * a, v1 = dts[r1] * a; float s = v0 + v1;
#pragma unroll
        for (int o = 1; o < 64; o <<= 1) { const float t = __shfl_up(s, o); if (lane >= o) s += t; }
        const float excl = s - (v0 + v1); const float c0 = excl + v0, c1 = c0 + v1; cso[r0] = c0; cso[r1] = c1;
        w.cs[((size_t)d * M + R0 + r0) * SH + hh] = c0; w.cs[((size_t)d * M + R0 + r1) * SH + hh] = c1;
        if (lane == 63) w.cdec[((size_t)d * NCH + c) * SH + hh] = __expf(c1);
    }
    __syncthreads();
    {   const int col = tid & 63, l0 = (tid >> 6) * 16; const float cfe = csf[127], cbe = csb[0];
#pragma unroll
        for (int which = 0; which < 3; ++which) { const int cidx = which == 0 ? hh * SP + col : (which == 1 ? SW + g * SN + col : SW + SG * SN + g * SN + col);
            const float w0 = p.conv_w[((size_t)l * 4 + 0) * CONVD + cidx], w1 = p.conv_w[((size_t)l * 4 + 1) * CONVD + cidx], w2 = p.conv_w[((size_t)l * 4 + 2) * CONVD + cidx], w3 = p.conv_w[((size_t)l * 4 + 3) * CONVD + cidx], bb = p.conv_b[l * CONVD + cidx];
            float v[19];
#pragma unroll
            for (int i = 0; i < 19; ++i) { const int r = R0 + l0 - 2 + i; v[i] = (r >= seg0 && r < seg1) ? w.proj[(size_t)r * w.ldp + C_XBC + cidx] : 0.f; }
            float y[16];
#pragma unroll
            for (int i = 0; i < 16; ++i) y[i] = silu_f(bb + w0 * v[i] + w1 * v[i + 1] + w2 * v[i + 2] + w3 * v[i + 3]);
            if (which == 0) {
                u32x4 a, b; a.x = rw::pk2(y[0], y[1]); a.y = rw::pk2(y[2], y[3]); a.z = rw::pk2(y[4], y[5]); a.w = rw::pk2(y[6], y[7]); b.x = rw::pk2(y[8], y[9]); b.y = rw::pk2(y[10], y[11]); b.z = rw::pk2(y[12], y[13]); b.w = rw::pk2(y[14], y[15]);
                *(u32x4*)(lds + OFF_XT + col * STS + l0 * 2) = a; *(u32x4*)(lds + OFF_XT + col * STS + l0 * 2 + 16) = b;
            } else if (which == 1) {
                float yf[16], yb[16];
#pragma unroll
                for (int i = 0; i < 16; ++i) { *(bf16_t*)(lds + OFF_BM + (l0 + i) * SBS + col * 2) = f2bf(y[i]); yf[i] = y[i] * __expf(cfe - csf[l0 + i]) * dtf[l0 + i]; yb[i] = y[i] * __expf(cbe - csb[l0 + i]) * dtb[l0 + i]; }
                u32x4 a, b; a.x = rw::pk2(yf[0], yf[1]); a.y = rw::pk2(yf[2], yf[3]); a.z = rw::pk2(yf[4], yf[5]); a.w = rw::pk2(yf[6], yf[7]); b.x = rw::pk2(yf[8], yf[9]); b.y = rw::pk2(yf[10], yf[11]); b.z = rw::pk2(yf[12], yf[13]); b.w = rw::pk2(yf[14], yf[15]);
                *(u32x4*)(lds + OFF_BTF + col * STS + l0 * 2) = a; *(u32x4*)(lds + OFF_BTF + col * STS + l0 * 2 + 16) = b;
                a.x = rw::pk2(yb[0], yb[1]); a.y = rw::pk2(yb[2], yb[3]); a.z = rw::pk2(yb[4], yb[5]); a.w = rw::pk2(yb[6], yb[7]); b.x = rw::pk2(yb[8], yb[9]); b.y = rw::pk2(yb[10], yb[11]); b.z = rw::pk2(yb[12], yb[13]); b.w = rw::pk2(yb[14], yb[15]);
                *(u32x4*)(lds + OFF_BTB + col * STS + l0 * 2) = a; *(u32x4*)(lds + OFF_BTB + col * STS + l0 * 2 + 16) = b;
            } else {
#pragma unroll
                for (int i = 0; i < 16; ++i) { const bf16_t cv = f2bf(y[i]); *(bf16_t*)(lds + OFF_CM + (l0 + i) * SBS + col * 2) = cv; if (hh % (SH / SG) == 0) w.cg[((size_t)(R0 + l0 + i) * SG + g) * SN + col] = cv; }
            } }
    }
    __syncthreads();
    {   const int lt = wid, lrow = 16 * lt + fr; const bf16x8 c0 = ldfrag(lds + OFF_CM, lrow, SBS, 16 * fq), c1 = ldfrag(lds + OFF_CM, lrow, SBS, 64 + 16 * fq);
        const float cfl = csf[lrow], cbl = csb[lrow], Dh = p.ssd_d[l * SH + hh];
#pragma unroll
        for (int st = 0; st < 8; ++st) { const bf16x8 b0 = ldfrag(lds + OFF_BM, 16 * st + fr, SBS, 16 * fq), b1 = ldfrag(lds + OFF_BM, 16 * st + fr, SBS, 64 + 16 * fq);
            f32x4 acc = {0.f, 0.f, 0.f, 0.f}; acc = __builtin_amdgcn_mfma_f32_16x16x32_bf16(b0, c0, acc, 0, 0, 0); acc = __builtin_amdgcn_mfma_f32_16x16x32_bf16(b1, c1, acc, 0, 0, 0);
            const int s0 = 16 * st + 4 * fq; const f32x4 cfs = *(const f32x4*)(csf + s0), cbs = *(const f32x4*)(csb + s0), dfs = *(const f32x4*)(dtf + s0), dbs = *(const f32x4*)(dtb + s0); float o[4];
#pragma unroll
            for (int j = 0; j < 4; ++j) { const int s = s0 + j; const float ef = s <= lrow ? __expf(fminf(cfl - cfs[j], 0.f)) * dfs[j] : 0.f; const float eb = s >= lrow ? __expf(fminf(cbl - cbs[j], 0.f)) * dbs[j] : 0.f;
                o[j] = acc[j] * (ef + eb) + (s == lrow ? Dh : 0.f); }
            u32x2 pk; pk.x = rw::pk2(o[0], o[1]); pk.y = rw::pk2(o[2], o[3]); *(u32x2*)(lds + OFF_L + lrow * STS + s0 * 2) = pk; }
    }
    __syncthreads();
    {   const int lt = wid, lrow = 16 * lt + fr; bf16x8 lf[4];
#pragma unroll
        for (int ks = 0; ks < 4; ++ks) lf[ks] = ldfrag(lds + OFF_L, lrow, STS, 64 * ks + 16 * fq);
#pragma unroll
        for (int pt = 0; pt < 4; ++pt) { f32x4 acc = {0.f, 0.f, 0.f, 0.f};
#pragma unroll
            for (int ks = 0; ks < 4; ++ks) acc = __builtin_amdgcn_mfma_f32_16x16x32_bf16(ldfrag(lds + OFF_XT, 16 * pt + fr, STS, 64 * ks + 16 * fq), lf[ks], acc, 0, 0, 0);
            *(f32x4*)(w.yd + (size_t)(R0 + lrow) * SW + hh * SP + 16 * pt + 4 * fq) = acc; }
    }
    {   const int d = wid >> 2, ptile = wid & 3, prow = 16 * ptile + fr; bf16x8 xf[4]; const char* bt = lds + (d ? OFF_BTB : OFF_BTF);
#pragma unroll
        for (int ks = 0; ks < 4; ++ks) xf[ks] = ldfrag(lds + OFF_XT, prow, STS, 64 * ks + 16 * fq);
#pragma unroll
        for (int nt = 0; nt < 4; ++nt) { f32x4 acc = {0.f, 0.f, 0.f, 0.f};
#pragma unroll
            for (int ks = 0; ks < 4; ++ks) acc = __builtin_amdgcn_mfma_f32_16x16x32_bf16(ldfrag(bt, 16 * nt + fr, STS, 64 * ks + 16 * fq), xf[ks], acc, 0, 0, 0);
            *(f32x4*)(w.st + ((((size_t)d * NCH + c) * SH + hh) * SP + prow) * SN + 16 * nt + 4 * fq) = acc; }
    }
    __syncthreads();
}
__device__ __forceinline__ void carry_phase(const SsdW& w) {
    int tid = threadIdx.x; asm volatile("" : "+v"(tid));
    constexpr int PER = 2 * SH * SP * SN / 256;
    if (tid < PER) { const int eidx = blockIdx.x * PER + tid; if (eidx < 2 * SH * SP * SN) { const int dir = eidx / (SH * SP * SN), rem = eidx % (SH * SP * SN), hh = rem / (SP * SN), e = rem % (SP * SN); float state = 0.f;
        for (int b = 0; b < NCH / 13; ++b) { float sv[13], dv[13]; size_t ov[13];
#pragma unroll
            for (int j = 0; j < 13; ++j) { const int i = b * 13 + j; const int c = dir == 0 ? i : (i < CTX / CHUNK ? CTX / CHUNK - 1 - i : NCH - 1 - (i - CTX / CHUNK));
                ov[j] = (((size_t)dir * NCH + c) * SH + hh) * (SP * SN) + e; sv[j] = w.st[ov[j]]; dv[j] = w.cdec[((size_t)dir * NCH + c) * SH + hh]; }
#pragma unroll
            for (int j = 0; j < 13; ++j) { w.prevb[ov[j]] = f2bf(state); state = state * dv[j] + sv[j]; } } } }
}
__device__ __forceinline__ void final_phase(const P& p, const SsdW& w, int l, bf16_t* dst, int ldd) {
    int tid = threadIdx.x; asm volatile("" : "+v"(tid)); const int wid = __builtin_amdgcn_readfirstlane(tid >> 6), lane = tid & 63, fr = lane & 15, fq = lane >> 4;
    const int ltg = wid * gridDim.x + blockIdx.x; if (ltg >= M / 16) return;
    const int r = ltg * 16 + fr, c = (ltg * 16) / CHUNK;
    bf16x8 cf[2][2];
#pragma unroll
    for (int g = 0; g < 2; ++g)
#pragma unroll
        for (int ks = 0; ks < 2; ++ks) cf[g][ks] = *(const bf16x8*)(w.cg + ((size_t)r * SG + g) * SN + 32 * ks + 8 * fq);
    f32x4 gv[SH][4]; float ss = 0.f;
#pragma unroll
    for (int hh = 0; hh < SH; ++hh) { const int g = hh / (SH / SG); const float ef = __expf(w.cs[(size_t)r * SH + hh]), eb = __expf(w.cs[((size_t)M + r) * SH + hh]);
#pragma unroll
        for (int pt = 0; pt < 4; ++pt) { f32x4 af = {0.f, 0.f, 0.f, 0.f}, ab = {0.f, 0.f, 0.f, 0.f};
            const bf16_t* pf = w.prevb + ((((size_t)0 * NCH + c) * SH + hh) * SP + 16 * pt + fr) * SN + 8 * fq; const bf16_t* pb = w.prevb + ((((size_t)1 * NCH + c) * SH + hh) * SP + 16 * pt + fr) * SN + 8 * fq;
#pragma unroll
            for (int ks = 0; ks < 2; ++ks) { af = __builtin_amdgcn_mfma_f32_16x16x32_bf16(*(const bf16x8*)(pf + 32 * ks), cf[g][ks], af, 0, 0, 0); ab = __builtin_amdgcn_mfma_f32_16x16x32_bf16(*(const bf16x8*)(pb + 32 * ks), cf[g][ks], ab, 0, 0, 0); }
            const int col = hh * SP + 16 * pt + 4 * fq; const f32x4 yd = *(const f32x4*)(w.yd + (size_t)r * SW + col), z = *(const f32x4*)(w.proj + (size_t)r * w.ldp + C_Z + col);
            f32x4 y = yd + af * ef + ab * eb;
#pragma unroll
            for (int j = 0; j < 4; ++j) { y[j] *= silu_f(z[j]); ss += y[j] * y[j]; }
            gv[hh][pt] = y; } }
    ss += __shfl_xor(ss, 16); ss += __shfl_xor(ss, 32); const float rs = 1.0f / sqrtf(ss * (1.0f / SW) + EPS);
#pragma unroll
    for (int hh = 0; hh < SH; ++hh)
#pragma unroll
        for (int pt = 0; pt < 4; ++pt) { const int col = hh * SP + 16 * pt + 4 * fq; const f32x4 o = gv[hh][pt] * rs * *(const f32x4*)(p.ssd_norm_g + l * SW + col);
            u32x2 pk; pk.x = rw::pk2(o[0], o[1]); pk.y = rw::pk2(o[2], o[3]); *(u32x2*)(dst + (size_t)r * ldd + col) = pk; }
}
}

namespace mc {
typedef float f32x4 __attribute__((ext_vector_type(4)));
__device__ __forceinline__ void modvec_phase(const P& p, char* lds) {
    int tid = threadIdx.x; asm volatile("" : "+v"(tid));
    float* sc = (float*)lds; float* part = sc + 2 * D;
    for (int i = tid; i < 2 * D; i += 512) { const float v = i < D ? p.c[i] : p.c_ctx[i - D]; sc[i] = v / (1.0f + __expf(-v)); }
    __syncthreads();
    constexpr int NCK = 6 * D / 128, NU = DEPTH * NCK;
    for (int u = blockIdx.x; u < NU; u += gridDim.x) { const int l = u / NCK, j = (u % NCK) * 128 + (tid & 127), kg = tid >> 7; const float* wp = p.mod_w + (size_t)l * D * 6 * D + j; float a0 = 0.f, a1 = 0.f;
#pragma unroll 8
        for (int k = kg; k < D; k += 4) { const float wv = wp[(size_t)k * 6 * D]; a0 += sc[k] * wv; a1 += sc[D + k] * wv; }
        part[(kg * 2 + 0) * 128 + (tid & 127)] = a0; part[(kg * 2 + 1) * 128 + (tid & 127)] = a1;
        __syncthreads();
        if (tid < 256) { const int which = tid >> 7, cc = tid & 127; const float s = part[(0 * 2 + which) * 128 + cc] + part[(1 * 2 + which) * 128 + cc] + part[(2 * 2 + which) * 128 + cc] + part[(3 * 2 + which) * 128 + cc];
            const int jj = (u % NCK) * 128 + cc; p.mod[((size_t)(l * 2 + which) * 6) * D + jj] = s + p.mod_b[(size_t)l * 6 * D + jj]; }
        __syncthreads(); }
}
__device__ __forceinline__ void pool_phase(const P& p, const float* proj, int ldp, int l, bf16_t* dst, int ldd, char* lds) {
    int tid = threadIdx.x; asm volatile("" : "+v"(tid));
    constexpr int RB = 65; float* pm = (float*)lds;
    const int row0 = blockIdx.x * RB;
    {   const int c = tid & 255, gi = c >> 6, win = 2 << gi;
        for (int i = tid >> 8; i < RB; i += 2) { const int r = row0 + i; if (r >= M) break; const int seg0 = r < CTX ? 0 : CTX, n = r < CTX ? CTX : SEQ, t = r - seg0;
            int lo = t - win / 2, hi = t - win / 2 + win; lo = lo < 0 ? 0 : lo; hi = hi > n ? n : hi; float s = 0.f;
            for (int tt = lo; tt < hi; ++tt) s += proj[(size_t)(seg0 + tt) * ldp + C_POOL + c];
            pm[i * 256 + c] = s / (float)(hi - lo) - proj[(size_t)r * ldp + C_POOL + c]; } }
    __syncthreads();
    {   const int d = tid & 63, gi = (tid >> 6) & 3, rh = tid >> 8; float wcol[64]; const float* wp = p.pool_w + (((size_t)l * 4 + gi) * 64) * 64 + d;
#pragma unroll
        for (int c = 0; c < 64; ++c) wcol[c] = wp[(size_t)c * 64];
        const float scl = p.pool_scale[l * PW + gi * 64 + d];
        for (int i = rh; i < RB; i += 2) { const int r = row0 + i; if (r >= M) break; const f32x4* pr = (const f32x4*)(pm + i * 256 + gi * 64); float acc = 0.f;
#pragma unroll
            for (int c4 = 0; c4 < 16; ++c4) { const f32x4 v = pr[c4]; acc += v[0] * wcol[4 * c4] + v[1] * wcol[4 * c4 + 1] + v[2] * wcol[4 * c4 + 2] + v[3] * wcol[4 * c4 + 3]; }
            dst[(size_t)r * ldd + gi * 64 + d] = f2bf(acc * scl); } }
    __syncthreads();
}
}

#ifndef CHECK_MLA
#define CHECK_MLA 0
#endif
#ifndef CHECK_SSD
#define CHECK_SSD 0
#endif
#ifndef REP_ATT
#define REP_ATT 1
#endif
#ifndef REP_MOE
#define REP_MOE 1
#endif
#ifndef REP_PROJ
#define REP_PROJ 1
#endif
#ifndef REP_PRE
#define REP_PRE 1
#endif
#ifndef REP_PREP
#define REP_PREP 1
#endif
#ifndef REP_ROW
#define REP_ROW 1
#endif
#ifndef REP_FIN
#define REP_FIN 1
#endif
#define REPEAT(N, ...) for (int rep_ = 0; rep_ < (N); ++rep_) { __VA_ARGS__ }
__device__ __forceinline__ int gtid() { int t = threadIdx.x; asm volatile("" : "+v"(t)); return blockIdx.x * 512 + t; }
template <int OP> __device__ __forceinline__ void run_op(const P& p, int l) {
    const long n = op_count(OP); const long stride = (long)gridDim.x * blockDim.x;
    for (long i = gtid(); i < n; i += stride) op_run(OP, p, l, i);
}
struct KArgs { P p; FW f; unsigned* bar; };
__device__ __forceinline__ const KArgs& kargs() { auto q = __builtin_amdgcn_kernarg_segment_ptr(); asm volatile("" : "+s"(q)); return *(const KArgs*)q; }
constexpr int LDS_BYTES = gm::STAGE_BYTES + 4096;
#define BAR() do { XcdBarrier b2_; b2_.bar = kargs().bar; unsigned xx_ = xbx; asm volatile("" : "+s"(xx_)); b2_.x = xx_; b2_.st = (volatile LAS unsigned*)(lds + LDS_BYTES - 16); xcd_barrier(b2_); } while (0)
#define PH(OPX) do { run_op<OPX>(kargs().p, lo()); BAR(); } while (0)
#define RUN(OPX) run_op<OPX>(kargs().p, lo())

__device__ __forceinline__ void attn_split_phase(const P& p, const FW& f, char* lds) {
    constexpr int NQL = SEQ / 256, NUL = NH * NQL * 2, NU = NUL + NH, HALF_KEYS = M / 2;
    for (int u = blockIdx.x; u < NU; u += gridDim.x) {
        int hh, qt, half, seq;
        if (u < NUL) { hh = u / (NQL * 2); const int rem = u % (NQL * 2); qt = 1 + (rem >> 1); half = rem & 1; seq = HALF_KEYS; } else { hh = u - NUL; qt = 0; half = 0; seq = CTX; }
        const size_t koff = (size_t)half * HALF_KEYS;
        __syncthreads();
        at::attn_body<bf16_t>(p.qb + (size_t)qt * 256 * at::LDQ + hh * at::DQ, p.kb + koff * at::LDK + hh * at::DQ, p.vb + koff * at::LDV + hh * at::DV,
                              f.opart + (size_t)half * M * (NH * VD) + (size_t)qt * 256 * (NH * VD) + hh * at::DV, NH * VD, seq, lds,
                              f.aml + (((size_t)half * M + (size_t)qt * 256) * NH + hh) * 2, NH * 2);
    }
    __syncthreads();
}
template <class TO> __device__ __forceinline__ void attn_phase(const P& p, TO* O, int ldo, char* lds) {
    constexpr int NQT = M / 256, NU = NH * NQT;
    for (int u = blockIdx.x; u < NU; u += gridDim.x) {
        const int hh = u / NQT, qt = u % NQT; const int seq = qt == 0 ? CTX : M;
        __syncthreads();
        at::attn_body<TO>(p.qb + (size_t)qt * 256 * at::LDQ + hh * at::DQ, p.kb + hh * at::DQ, p.vb + hh * at::DV, O + (size_t)qt * 256 * ldo + hh * at::DV, ldo, seq, lds);
    }
    __syncthreads();
}
template <class TA> __device__ __forceinline__ float ldf(const TA* a, size_t i);
template <> __device__ __forceinline__ float ldf<float>(const float* a, size_t i) { return a[i]; }
template <> __device__ __forceinline__ float ldf<bf16_t>(const bf16_t* a, size_t i) { return bf2f(a[i]); }
template <class TA, class TB> __device__ __forceinline__ void chk_accum(const TA* a, int lda, const TB* b, int ldb, long nrows, int ncols, float* diag) {
    float sd = 0.f, sr = 0.f; const long n = nrows * ncols; const long stride = (long)gridDim.x * blockDim.x;
    for (long i = gtid(); i < n; i += stride) { const long r = i / ncols; const int c = (int)(i % ncols);
        const float x = ldf<TA>(a, r * lda + c), y = ldf<TB>(b, r * ldb + c); sd += (x - y) * (x - y); sr += y * y; }
    for (int o = 32; o >= 1; o >>= 1) { sd += __shfl_xor(sd, o); sr += __shfl_xor(sr, o); }
    if ((threadIdx.x & 63) == 0) { atomicAdd(diag, sd); atomicAdd(diag + 1, sr); }
}
#define MLA_CALL(QB, KB, VB) { const int ll_ = lo(); ml::MW mw_; mw_.qb = (QB); mw_.kb = (KB); mw_.vb = (VB); mw_.w_uq_t = KF.w_uq_t + (size_t)ll_ * NH * QKD * QL; mw_.w_ukv_t = KF.w_ukv_t + (size_t)ll_ * NH * 128 * KVL; \
        mw_.ropec = KF.ropec; mw_.ropes = KF.ropes; mw_.proj = KP.proj; mw_.ldp = INC; ml::mla_phase(KP, mw_, ll_, lds); }
#if CHECK_MLA
#define MLA_STEP PH(OP_LATNORM); RUN(OP_QRAW); PH(OP_KVRAW); RUN(OP_QHEAD); RUN(OP_KHEAD); if (l == 0) { MLA_CALL(KF.qb2, KF.kb2, KF.vb2) } BAR(); \
        if (l == 0) { chk_accum<bf16_t, bf16_t>(KF.qb2, NH * QKD, KP.qb, NH * QKD, M, NH * QKD, KP.diag + 0); chk_accum<bf16_t, bf16_t>(KF.kb2, NH * QKD, KP.kb, NH * QKD, M, NH * QKD, KP.diag + 2); chk_accum<bf16_t, bf16_t>(KF.vb2, NH * VD, KP.vb, NH * VD, M, NH * VD, KP.diag + 4); }
#else
#define MLA_STEP REPEAT(REP_PREP, MLA_CALL(KP.qb, KP.kb, KP.vb))
#endif
#define SSD_W(NAME) sd::SsdW NAME; NAME.proj = KP.proj; NAME.ldp = INC; NAME.yd = KF.yd2; NAME.st = KF.st2; NAME.cdec = KF.cdec2; NAME.cs = KF.cs2; NAME.cg = KF.cg; NAME.prevb = KF.prevb;
#define SSD_S1() { SSD_W(sw_) const int ll_ = lo(); for (int u = blockIdx.x; u < NCH * SH; u += gridDim.x) sd::chunk_unit(KP, sw_, ll_, u / SH, u % SH, lds); }
#define SSD_S2() { SSD_W(sw_) sd::carry_phase(sw_); }
#define SSD_S3(DST, LDD) { SSD_W(sw_) sd::final_phase(KP, sw_, lo(), (DST), (LDD)); }
#if CHECK_SSD
#define SSD_STEPS RUN(OP_CONV); RUN(OP_DT); PH(OP_POOLP); RUN(OP_SSD_CS); RUN(OP_SSD_G); PH(OP_POOLMM); attn_phase<float>(KP, KP.mixin, MIXW, lds); RUN(OP_SSD_YD); PH(OP_SSD_ST); PH(OP_SSD_CARRY); PH(OP_SSD_YOFF); PH(OP_SSDFIN); \
        if (l == 0) { SSD_S1() BAR(); SSD_S2() BAR(); SSD_S3(KF.ssdb2, SW) BAR(); chk_accum<bf16_t, float>(KF.ssdb2, SW, KP.mixin + NH * VD, MIXW, M, SW, KP.diag + 0); } PH(OP_MIXB);
#else
#define SSD_STEPS REPEAT(REP_PREP, mc::pool_phase(KP, KP.proj, INC, lo(), KP.mixb + NH * VD + SW, MIXW, lds); SSD_S1()) BAR(); REPEAT(REP_ATT, attn_split_phase(KP, KF, lds);) REPEAT(REP_FIN, SSD_S2()) BAR(); REPEAT(REP_FIN, SSD_S3(KP.mixb + NH * VD, MIXW) at::attn_combine(KF.opart, KF.aml, KP.mixb, MIXW, M, CTX);) BAR();
#endif
#define LAYER_BODY(L) { const int l = (L); \
        auto lo = [&]() { int ll = l; asm volatile("" : "+s"(ll)); return ll; }; \
        if (blockIdx.x == 0 && threadIdx.x < NE) KP.cnt[threadIdx.x] = 0; \
        REPEAT(REP_PROJ, inproj_phase(KP, KF, lo(), KP.proj, lds);) BAR(); \
        MLA_STEP \
        SSD_STEPS \
        REPEAT(REP_PROJ - 1, outproj_phase<false>(KP, KF, lo(), KP.mixin, lds);) outproj_phase<true>(KP, KF, lo(), KP.xres, lds); BAR(); \
        REPEAT(REP_ROW - 1, rw::router_phase<true>(KP, lo(), lds);) rw::router_phase<false>(KP, lo(), lds); BAR(); \
        REPEAT(REP_MOE, moe1_phase(KP, KF, lo(), lds);) BAR(); REPEAT(REP_MOE, moe2_phase(KP, KF, lo(), lds);) BAR(); \
        REPEAT(REP_ROW - 1, rw::combine_phase<true>(KP, lo());) rw::combine_phase<false>(KP, lo()); BAR(); \
    }
__global__ void __launch_bounds__(512, 2) k_mega(KArgs a) {
    extern __shared__ __attribute__((aligned(16))) char lds[];
    uint4* xbw = (uint4*)(lds + LDS_BYTES - 16);
    if (threadIdx.x == 0) *xbw = make_uint4(0u, 0u, 0u, 0u);
    __syncthreads();
    const unsigned xbx = xcd_barrier_post(kargs().bar, (volatile LAS unsigned*)xbw).x;
#define KP kargs().p
#define KF kargs().f
    { const int l = 0; auto lo = [&]() { return l; }; if (blockIdx.x == 0 && threadIdx.x < 16) KP.diag[threadIdx.x] = 0.f; REPEAT(REP_PRE, mc::modvec_phase(KP, lds); cvt_phase(KP, KF, 0, DEPTH, lds);) BAR(); rw::first_norm_phase(KP); BAR(); }
    LAYER_BODY(0) LAYER_BODY(1) LAYER_BODY(2) LAYER_BODY(3)
#if CHECK_MLA || CHECK_SSD
    {
        float e = 0.f;
        for (int c = 0; c < 3; ++c) { const float dn = KP.diag[2 * c + 1]; if (dn == 0.f && KP.diag[2 * c] == 0.f) continue; const float ec = sqrtf(KP.diag[2 * c] / dn); e = ec > e ? ec : e; if (!(ec == ec)) e = 1e3f; }
        const float sc = 1.0f + 10.0f * e; const long n = (long)SEQ * D; const long stride = (long)gridDim.x * blockDim.x;
        for (long i = gtid(); i < n; i += stride) KP.out[i] *= sc;
    }
#endif
#undef KP
#undef KF
}
static size_t carve(char*& cur, size_t bytes) { size_t a = (bytes + 255) & ~(size_t)255; cur += a; return a; }
static bool setup_params(P& p, FW& f, unsigned*& bar, void* const* d_in, void* d_out, void* d_ws, size_t ws_size) {
    const float** pp = (const float**)&p; for (int i = 0; i < 32; ++i) pp[i] = (const float*)d_in[i];
    p.out = (float*)d_out;
    char* cur = (char*)d_ws; char* base = cur;
    bar = (unsigned*)cur; carve(cur, XCD_BAR_WORDS * sizeof(unsigned));
#define CARVE(field, type, count) p.field = (type*)cur; carve(cur, (size_t)(count) * sizeof(type));
#define CARVEF(field, type, count) f.field = (type*)cur; carve(cur, (size_t)(count) * sizeof(type));
    CARVE(xres, float, (size_t)M * D) CARVE(mod, float, (size_t)DEPTH * 12 * D) CARVE(proj, float, (size_t)M * INC)
#if CHECK_MLA
    CARVE(qln, float, (size_t)M * QL) CARVE(kvln, float, (size_t)M * KVL) CARVE(qraw, float, (size_t)M * NH * QKD) CARVE(kvraw, float, (size_t)M * NH * 128) CARVE(q, float, (size_t)M * NH * QKD) CARVE(k, float, (size_t)M * NH * QKD) CARVE(v, float, (size_t)M * NH * VD)
    CARVEF(qb2, bf16_t, (size_t)M * NH * QKD) CARVEF(kb2, bf16_t, (size_t)M * NH * QKD) CARVEF(vb2, bf16_t, (size_t)M * NH * VD)
#endif
    CARVE(mixin, float, (size_t)M * MIXW) CARVE(xbc, float, (size_t)M * CONVD) CARVE(dt, float, (size_t)M * 12) CARVE(ydir, float, (size_t)2 * M * SW)
    CARVE(poolp, float, (size_t)M * PW) CARVE(topw, float, (size_t)M * 4)
    CARVE(topi, int, (size_t)M * 4) CARVE(cnt, int, NE) CARVE(list, int, (size_t)NE * M)
    CARVE(qb, bf16_t, (size_t)M * NH * QKD) CARVE(kb, bf16_t, (size_t)M * NH * QKD) CARVE(vb, bf16_t, (size_t)M * NH * VD) CARVE(diag, float, 64)
    CARVE(cs, float, (size_t)2 * M * SH) CARVE(cdec, float, (size_t)2 * NCH * SH) CARVE(gmat, float, (size_t)M * SG * CHUNK) CARVE(st, float, (size_t)2 * NCH * SH * SP * SN)
    CARVE(hb1, bf16_t, (size_t)M * D) CARVE(hb2, bf16_t, (size_t)M * D) CARVE(mixb, bf16_t, (size_t)M * MIXW)
    CARVEF(actb, bf16_t, (size_t)4 * M * FF) CARVEF(yb, bf16_t, (size_t)4 * M * D)
    f.hb1 = p.hb1; f.hb2 = p.hb2; f.mixb = p.mixb; p.ybn = f.yb; p.attf = nullptr;
    const int nl = DEPTH;
    CARVEF(w_uq_t, bf16_t, (size_t)nl * NH * QKD * QL) CARVEF(w_ukv_t, bf16_t, (size_t)nl * NH * 128 * KVL) CARVEF(ropec, float, 256 * 8) CARVEF(ropes, float, 256 * 8)
    CARVEF(opart, bf16_t, (size_t)2 * M * NH * VD) CARVEF(aml, float, (size_t)2 * M * NH * 2)
    CARVEF(yd2, float, (size_t)M * SW) CARVEF(st2, float, (size_t)2 * NCH * SH * SP * SN) CARVEF(cdec2, float, (size_t)2 * NCH * SH) CARVEF(cs2, float, (size_t)2 * M * SH)
    CARVEF(cg, bf16_t, (size_t)M * SG * SN) CARVEF(prevb, bf16_t, (size_t)2 * NCH * SH * SP * SN) CARVEF(ssdb2, bf16_t, (size_t)M * SW)
    CARVEF(w_in_t, bf16_t, (size_t)nl * INC_PAD * D) CARVEF(w_out_t, bf16_t, (size_t)nl * D * MIXW) CARVEF(gu_t, bf16_t, (size_t)nl * NE * 2 * FF * D) CARVEF(d_t, bf16_t, (size_t)nl * NE * D * FF)
    p.act = nullptr; p.down = nullptr; f.proj2 = nullptr; f.mix2 = nullptr;
#undef CARVE
#undef CARVEF
    if (getenv("KDEBUG")) fprintf(stderr, "ws used %zu of %zu\n", (size_t)(cur - base), ws_size);
    return (size_t)(cur - base) <= ws_size;
}
extern "C" void kernel_launch(void* const* d_in, const int* in_sizes, int n_in, void* d_out, int out_size, void* d_ws, size_t ws_size, hipStream_t stream) {
    KArgs a{};
    if (n_in < 32 || !setup_params(a.p, a.f, a.bar, d_in, d_out, d_ws, ws_size)) return;
    static int grid = 0;
    if (!grid) { int dev = 0, cus = 0, per_cu = 0; (void)hipGetDevice(&dev); (void)hipDeviceGetAttribute(&cus, hipDeviceAttributeMultiprocessorCount, dev);
        (void)hipFuncSetAttribute((const void*)k_mega, hipFuncAttributeMaxDynamicSharedMemorySize, LDS_BYTES);
        (void)hipOccupancyMaxActiveBlocksPerMultiprocessor(&per_cu, k_mega, 512, LDS_BYTES); grid = cus * (per_cu < 1 ? per_cu : 1); }
    if (grid <= 0) return;
    (void)hipMemsetAsync(a.bar, 0, XCD_BAR_WORDS * sizeof(unsigned), stream);
    hipLaunchKernelGGL(k_mega, dim3(grid), dim3(512), LDS_BYTES, stream, a);
}
```

```cpp
#include <hip/hip_runtime.h>
#include <stdint.h>
#include <stdlib.h>
#include <stdio.h>

#ifndef NAIVE_H
#define NAIVE_H
#include <math.h>
#ifdef HOST_TEST
#define HD inline
#define HDC inline
#define ATOMIC_INC(p) ((*(p))++)
#define UNIFORM(x) (x)
#else
#define HD __device__ __forceinline__
#define HDC __host__ __device__ __forceinline__
#define ATOMIC_INC(p) atomicAdd((p), 1)
#define UNIFORM(x) __builtin_amdgcn_readfirstlane(x)
#endif

#ifndef CFG_D
#define CFG_D 1024
#define CFG_SEQ 16384
#define CFG_CTX 256
#define CFG_FF 1024
#define CFG_DEPTH 4
#endif
constexpr int D = CFG_D, SEQ = CFG_SEQ, CTX = CFG_CTX, FF = CFG_FF, DEPTH = CFG_DEPTH;
constexpr int M = CTX + SEQ;
constexpr int GRID_W = 64;
constexpr int NH = 6, QKD = 96, NOPE = 64, ROPE = 32, VD = 64, QL = 256, KVL = 128;
constexpr int SH = 6, SP = 64, SW = 384, SG = 2, SN = 64, CONVD = 640, CHUNK = 128;
constexpr int PW = 256, MIXW = 1024, INC = 1708;
constexpr int C_Q = 0, C_KV = 256, C_KR = 384, C_Z = 416, C_XBC = 800, C_DT = 1440, C_POOL = 1452;
constexpr int NE = 32, TOPK = 4;
constexpr int NCH = M / CHUNK;
constexpr float EPS = 1e-6f;

typedef unsigned short bf16_t;
HD bf16_t f2bf(float f) { union { float f; unsigned u; } v; v.f = f; unsigned u = v.u; u += 0x7FFFu + ((u >> 16) & 1u); return (bf16_t)(u >> 16); }
HD float bf2f(bf16_t b) { union { float f; unsigned u; } v; v.u = ((unsigned)b) << 16; return v.f; }
struct P {
    const float *x, *c, *ctx, *c_ctx, *norm1_g, *norm2_g, *mod_w, *mod_b, *w_in, *q_g, *kv_g, *w_uq, *w_ukv, *qn_g, *kn_g;
    const float *conv_w, *conv_b, *a_log, *dt_bias, *ssd_d, *ssd_norm_g, *pool_w, *pool_scale, *w_out, *router_w, *router_b;
    const float *wg, *bg, *wu, *bu, *wd, *bd;
    float* out;
    float *xres, *mod, *rs, *h, *proj, *qln, *kvln, *qraw, *kvraw, *q, *k, *v, *mixin, *xbc, *dt, *ydir, *poolp, *mix, *logits, *topw, *act, *down;
    int *topi, *cnt, *list;
    bf16_t *qb, *kb, *vb;
    float *attf, *diag;
    float *cs, *cdec, *gmat, *st;
    bf16_t *hb1, *hb2, *mixb, *ybn;
};

HD float siluf(float x) { return x / (1.0f + expf(-x)); }
HD float sigmf(float x) { return 1.0f / (1.0f + expf(-x)); }
HD float softplusf(float x) { return x > 20.0f ? x : log1pf(expf(x)); }
HD const float* modv(const P& p, int l, int r, int j) { return p.mod + ((size_t)(l * 2 + (r < CTX ? 1 : 0)) * 6 + j) * D; }

enum { OP_COPY_IN = 0, OP_MODVEC, OP_ROWSTAT, OP_NORM1, OP_INPROJ, OP_LATNORM, OP_QRAW, OP_KVRAW, OP_QHEAD, OP_KHEAD, OP_ATTN, OP_CONV, OP_DT, OP_SSDSCAN, OP_SSDFIN,
       OP_POOLP, OP_POOLMM, OP_OUTPROJ, OP_RES1, OP_NORM2, OP_LOGITS, OP_ZEROCNT, OP_TOPK, OP_GATEUP, OP_DOWN, OP_COMBINE, OP_WRITE_OUT, OP_MIXB, OP_COMBINE2, OP_SSD_CS, OP_SSD_G, OP_SSD_YD, OP_SSD_ST, OP_SSD_CARRY, OP_SSD_YOFF, OP_COUNT };

HDC long op_count(int op) {
    switch (op) {
        case OP_COPY_IN: return (long)M * D;
        case OP_MODVEC: return (long)DEPTH * 2 * 6 * D;
        case OP_ROWSTAT: return M;
        case OP_NORM1: case OP_NORM2: return (long)M * D;
        case OP_INPROJ: return (long)(M / 8) * INC;
        case OP_LATNORM: return 2L * M;
        case OP_QRAW: return (long)(M / 8) * (NH * QKD);
        case OP_KVRAW: return (long)(M / 8) * (NH * 128);
        case OP_QHEAD: case OP_KHEAD: return (long)M * NH;
        case OP_ATTN: return (long)M * NH;
        case OP_CONV: return (long)M * CONVD;
        case OP_DT: return (long)M * 12;
        case OP_SSDSCAN: return 2L * SH * SP;
        case OP_SSDFIN: return M;
        case OP_POOLP: return (long)M * PW;
        case OP_POOLMM: return (long)M * PW;
        case OP_OUTPROJ: return (long)(M / 8) * D;
        case OP_RES1: return (long)M * D;
        case OP_LOGITS: return (long)M * NE;
        case OP_ZEROCNT: return NE;
        case OP_TOPK: return M;
        case OP_GATEUP: return (long)NE * (M / 8) * FF;
        case OP_DOWN: return (long)NE * (M / 8) * D;
        case OP_COMBINE: return (long)M * D;
        case OP_WRITE_OUT: return (long)SEQ * D;
        case OP_MIXB: return (long)M * MIXW;
        case OP_COMBINE2: return (long)M * D;
        case OP_SSD_CS: return 2L * NCH * SH;
        case OP_SSD_G: return (long)M * SG * CHUNK;
        case OP_SSD_YD: return (long)M * SW;
        case OP_SSD_ST: return 2L * NCH * SH * SP * SN;
        case OP_SSD_CARRY: return 2L * SH * SP * SN;
        case OP_SSD_YOFF: return (long)M * SW;
    }
    return 0;
}

HD void gemm8(const float* A, int lda, const float* B, int ldb, const float* bias, float* C, int ldc, int N, int K, long idx) {
    const int j = (int)(idx % N); const long r0 = (idx / N) * 8;
    float acc[8];
#pragma unroll
    for (int i = 0; i < 8; ++i) acc[i] = 0.f;
    const float* a = A + r0 * lda;
    for (int k = 0; k < K; ++k) {
        const float b = B[(size_t)k * ldb + j];
#pragma unroll
        for (int i = 0; i < 8; ++i) acc[i] += a[(size_t)i * lda + k] * b;
    }
    const float bv = bias ? bias[j] : 0.f;
#pragma unroll
    for (int i = 0; i < 8; ++i) C[(r0 + i) * ldc + j] = acc[i] + bv;
}

HD void sincos_rr(float angf, float& cs, float& sn) {
    const double x = (double)angf; const double n = rint(x * 0.63661977236758134308); const double y = (x - n * 1.57079632679489655800) - n * 6.123233995736766e-17; const double y2 = y * y;
    const double s = y * (1.0 + y2 * (-1.0 / 6 + y2 * (1.0 / 120 + y2 * (-1.0 / 5040 + y2 * (1.0 / 362880 + y2 * (-1.0 / 39916800))))));
    const double c = 1.0 + y2 * (-0.5 + y2 * (1.0 / 24 + y2 * (-1.0 / 720 + y2 * (1.0 / 40320 + y2 * (-1.0 / 3628800 + y2 * (1.0 / 479001600))))));
    const int q = ((int)n) & 3; const double cc = (q == 0) ? c : (q == 1) ? -s : (q == 2) ? -c : s; const double ss = (q == 0) ? s : (q == 1) ? c : (q == 2) ? -s : -c;
    cs = (float)cc; sn = (float)ss;
}
HD float rope_inv_freq(int f) { return f == 0 ? 1.0f : f == 1 ? 0.31622776f : f == 2 ? 0.1f : f == 3 ? 0.031622775f : f == 4 ? 0.01f : f == 5 ? 0.0031622776f : f == 6 ? 0.001f : 0.00031622776f; }
HD void rope_apply(float* v32, int t) {
    const float row = (float)(t / GRID_W), col = (float)(t % GRID_W);
#pragma unroll
    for (int a = 0; a < 2; ++a)
#pragma unroll
        for (int f = 0; f < 8; ++f) {
            const float ang = (a == 0 ? row : col) * rope_inv_freq(f);
            float cs, sn; sincos_rr(ang, cs, sn);
            const float x1 = v32[a * 16 + f], x2 = v32[a * 16 + 8 + f];
            v32[a * 16 + f] = x1 * cs - x2 * sn; v32[a * 16 + 8 + f] = x2 * cs + x1 * sn;
        }
}

HD void op_run(int op, const P& p, int l, long idx) {
    switch (op) {
    case OP_COPY_IN: { const long r = idx / D; const int c = (int)(idx % D); p.xres[idx] = r < CTX ? p.ctx[idx] : p.x[(r - CTX) * D + c]; } break;
    case OP_MODVEC: {
        const int j = (int)(idx % (6 * D)); const int which = (int)((idx / (6 * D)) % 2); const int ll = (int)(idx / (12 * D));
        const float* cv = which ? p.c_ctx : p.c; float s = 0.f;
        for (int k = 0; k < D; ++k) s += siluf(cv[k]) * p.mod_w[((size_t)ll * D + k) * (6 * D) + j];
        p.mod[idx] = s + p.mod_b[(size_t)ll * 6 * D + j];
    } break;
    case OP_ROWSTAT: { const float* xr = p.xres + idx * D; float s = 0.f; for (int k = 0; k < D; ++k) s += xr[k] * xr[k]; p.rs[idx] = 1.0f / sqrtf(s / D + EPS); } break;
    case OP_NORM1: case OP_NORM2: { const int r = (int)(idx / D), c = (int)(idx % D); const int o = op == OP_NORM1 ? 0 : 3;
        const float g = (op == OP_NORM1 ? p.norm1_g : p.norm2_g)[l * D + c];
        const float hv = p.xres[idx] * p.rs[r] * g * (1.0f + modv(p, l, r, o + 1)[c]) + modv(p, l, r, o)[c]; p.h[idx] = hv;
        bf16_t* hb = op == OP_NORM1 ? p.hb1 : p.hb2; if (hb) hb[idx] = f2bf(hv); } break;
    case OP_INPROJ: gemm8(p.h, D, p.w_in + (size_t)l * D * INC, INC, nullptr, p.proj, INC, INC, D, idx); break;
    case OP_LATNORM: {
        const int which = idx >= M; const long r = which ? idx - M : idx; const int n = which ? KVL : QL; const float* src = p.proj + r * INC + (which ? C_KV : C_Q);
        float s = 0.f; for (int k = 0; k < n; ++k) s += src[k] * src[k]; const float rs = 1.0f / sqrtf(s / n + EPS);
        float* dst = which ? p.kvln + r * KVL : p.qln + r * QL; const float* g = which ? p.kv_g + l * KVL : p.q_g + l * QL;
        for (int k = 0; k < n; ++k) dst[k] = src[k] * rs * g[k];
    } break;
    case OP_QRAW: gemm8(p.qln, QL, p.w_uq + (size_t)l * QL * (NH * QKD), NH * QKD, nullptr, p.qraw, NH * QKD, NH * QKD, QL, idx); break;
    case OP_KVRAW: gemm8(p.kvln, KVL, p.w_ukv + (size_t)l * KVL * (NH * 128), NH * 128, nullptr, p.kvraw, NH * 128, NH * 128, KVL, idx); break;
    case OP_QHEAD: { const int r = (int)(idx / NH), hh = (int)(idx % NH); const float* src = p.qraw + (size_t)r * (NH * QKD) + hh * QKD; float s = 0.f;
        for (int d = 0; d < QKD; ++d) s += src[d] * src[d]; const float rs = 1.0f / sqrtf(s / QKD + EPS);
        float* dst = p.q + ((size_t)r * NH + hh) * QKD; float rp[32];
        for (int d = 0; d < NOPE; ++d) dst[d] = src[d] * rs * p.qn_g[l * QKD + d];
#pragma unroll
        for (int d = 0; d < 32; ++d) rp[d] = src[NOPE + d] * rs * p.qn_g[l * QKD + NOPE + d];
        if (r >= CTX) rope_apply(rp, r - CTX);
#pragma unroll
        for (int d = 0; d < 32; ++d) dst[NOPE + d] = rp[d];
        bf16_t* db = p.qb + ((size_t)r * NH + hh) * QKD;
        for (int d = 0; d < QKD; ++d) db[d] = f2bf(dst[d]);
    } break;
    case OP_KHEAD: { const int r = (int)(idx / NH), hh = (int)(idx % NH); const float* kn = p.kvraw + (size_t)r * (NH * 128) + hh * 128; const float* kr = p.proj + (size_t)r * INC + C_KR; float s = 0.f;
        for (int d = 0; d < NOPE; ++d) s += kn[d] * kn[d];
        for (int d = 0; d < ROPE; ++d) s += kr[d] * kr[d];
        const float rs = 1.0f / sqrtf(s / QKD + EPS);
        float* dst = p.k + ((size_t)r * NH + hh) * QKD; float rp[32];
        for (int d = 0; d < NOPE; ++d) dst[d] = kn[d] * rs * p.kn_g[l * QKD + d];
#pragma unroll
        for (int d = 0; d < 32; ++d) rp[d] = kr[d] * rs * p.kn_g[l * QKD + NOPE + d];
        if (r >= CTX) rope_apply(rp, r - CTX);
#pragma unroll
        for (int d = 0; d < 32; ++d) dst[NOPE + d] = rp[d];
        float* vd = p.v + ((size_t)r * NH + hh) * VD;
        for (int d = 0; d < VD; ++d) vd[d] = kn[NOPE + d];
        bf16_t* db = p.kb + ((size_t)r * NH + hh) * QKD; bf16_t* vdb = p.vb + ((size_t)r * NH + hh) * VD;
        for (int d = 0; d < QKD; ++d) db[d] = f2bf(dst[d]);
        for (int d = 0; d < VD; ++d) vdb[d] = f2bf(kn[NOPE + d]);
    } break;
    case OP_ATTN: {
        const int r = (int)(idx % M), hh = UNIFORM((int)(idx / M)); const int nk = r < CTX ? CTX : M;
        float qv[QKD];
        const float* qp = p.q + ((size_t)r * NH + hh) * QKD; const float scale = 1.0f / sqrtf((float)QKD);
#pragma unroll
        for (int d = 0; d < QKD; ++d) qv[d] = qp[d] * scale;
        for (int half = 0; half < 2; ++half) {
            float o[32];
#pragma unroll
            for (int d = 0; d < 32; ++d) o[d] = 0.f;
            float mx = -1e30f, lsum = 0.f;
            for (int kk = 0; kk < nk; ++kk) {
                const float* kp = p.k + ((size_t)kk * NH + hh) * QKD; const float* vp = p.v + ((size_t)kk * NH + hh) * VD + half * 32; float s = 0.f;
#pragma unroll
                for (int d = 0; d < QKD; ++d) s += qv[d] * kp[d];
                const float mn = s > mx ? s : mx; const float corr = expf(mx - mn), pe = expf(s - mn);
                lsum = lsum * corr + pe; mx = mn;
#pragma unroll
                for (int d = 0; d < 32; ++d) o[d] = o[d] * corr + pe * vp[d];
            }
            const float inv = 1.0f / lsum; float* dst = p.mixin + (size_t)r * MIXW + hh * VD + half * 32;
#pragma unroll
            for (int d = 0; d < 32; ++d) dst[d] = o[d] * inv;
        }
    } break;
    case OP_CONV: { const int r = (int)(idx / CONVD), c = (int)(idx % CONVD); const int seg0 = r < CTX ? 0 : CTX, n = r < CTX ? CTX : SEQ, t = r - seg0; float y = p.conv_b[l * CONVD + c];
#pragma unroll
        for (int j = 0; j < 4; ++j) { const int tt = t - 2 + j; if (tt >= 0 && tt < n) y += p.conv_w[((size_t)l * 4 + j) * CONVD + c] * p.proj[(size_t)(seg0 + tt) * INC + C_XBC + c]; }
        p.xbc[idx] = siluf(y); } break;
    case OP_DT: { const int r = (int)(idx / 12), j = (int)(idx % 12); p.dt[idx] = softplusf(p.proj[(size_t)r * INC + C_DT + j] + p.dt_bias[l * 12 + j]); } break;
    case OP_SSDSCAN: {
        const int pp = (int)(idx % SP), hh = UNIFORM((int)((idx / SP) % SH)), dir = UNIFORM((int)(idx / (SP * SH))); const int g = hh / (SH / SG);
        const float a = -expf(p.a_log[l * 12 + dir * 6 + hh]); float st[SN];
#pragma unroll
        for (int n = 0; n < SN; ++n) st[n] = 0.f;
        for (int step = 0; step < M; ++step) {
            const int r = dir == 0 ? step : (step < CTX ? CTX - 1 - step : M - 1 - (step - CTX));
            const float dtv = p.dt[(size_t)r * 12 + dir * 6 + hh]; const float dA = expf(dtv * a); const float xv = p.xbc[(size_t)r * CONVD + hh * SP + pp] * dtv;
            const float* Bp = p.xbc + (size_t)r * CONVD + SW + g * SN; const float* Cp = p.xbc + (size_t)r * CONVD + SW + SG * SN + g * SN; float y = 0.f;
#pragma unroll
            for (int n = 0; n < SN; ++n) { st[n] = st[n] * dA + xv * Bp[n]; y += st[n] * Cp[n]; }
            p.ydir[((size_t)dir * M + r) * SW + hh * SP + pp] = y;
        }
    } break;
    case OP_SSDFIN: { const long r = idx; float ss = 0.f;
        for (int c = 0; c < SW; ++c) { const float y = p.ydir[r * SW + c] + p.ydir[((size_t)M + r) * SW + c] + p.ssd_d[l * SH + c / SP] * p.xbc[r * CONVD + c]; const float gv = y * siluf(p.proj[r * INC + C_Z + c]); ss += gv * gv; }
        const float rs = 1.0f / sqrtf(ss / SW + EPS);
        for (int c = 0; c < SW; ++c) { const float y = p.ydir[r * SW + c] + p.ydir[((size_t)M + r) * SW + c] + p.ssd_d[l * SH + c / SP] * p.xbc[r * CONVD + c]; const float gv = y * siluf(p.proj[r * INC + C_Z + c]);
            p.mixin[r * MIXW + NH * VD + c] = gv * rs * p.ssd_norm_g[l * SW + c]; }
    } break;
    case OP_POOLP: { const int r = (int)(idx / PW), c = (int)(idx % PW); const int gi = c / 64; const int win = 2 << gi; const int seg0 = r < CTX ? 0 : CTX, n = r < CTX ? CTX : SEQ, t = r - seg0;
        int lo = t - win / 2, hi = t - win / 2 + win; lo = lo < 0 ? 0 : lo; hi = hi > n ? n : hi; float s = 0.f;
        for (int tt = lo; tt < hi; ++tt) s += p.proj[(size_t)(seg0 + tt) * INC + C_POOL + c];
        p.poolp[idx] = s / (float)(hi - lo) - p.proj[(size_t)r * INC + C_POOL + c]; } break;
    case OP_POOLMM: { const int r = (int)(idx / PW), c = (int)(idx % PW); const int gi = c / 64, d = c % 64; float s = 0.f;
        for (int cc = 0; cc < 64; ++cc) s += p.poolp[(size_t)r * PW + gi * 64 + cc] * p.pool_w[(((size_t)l * 4 + gi) * 64 + cc) * 64 + d];
        p.mixin[(size_t)r * MIXW + NH * VD + SW + c] = s * p.pool_scale[l * PW + c]; } break;
    case OP_OUTPROJ: gemm8(p.mixin, MIXW, p.w_out + (size_t)l * MIXW * D, D, nullptr, p.mix, D, D, MIXW, idx); break;
    case OP_RES1: { const int r = (int)(idx / D), c = (int)(idx % D); p.xres[idx] += modv(p, l, r, 2)[c] * p.mix[idx]; } break;
    case OP_LOGITS: { const int r = (int)(idx / NE), e = (int)(idx % NE); const float* hr = p.h + (size_t)r * D; float s = 0.f;
        for (int k = 0; k < D; ++k) s += hr[k] * p.router_w[((size_t)l * D + k) * NE + e];
        p.logits[idx] = s + p.router_b[l * NE + e]; } break;
    case OP_ZEROCNT: p.cnt[idx] = 0; break;
    case OP_TOPK: { const long t = idx; float lg[NE];
#pragma unroll
        for (int e = 0; e < NE; ++e) lg[e] = p.logits[t * NE + e];
        int sel[4]; float sv[4];
#pragma unroll
        for (int kk = 0; kk < 4; ++kk) { float best = -3.0e38f; int bi = 0;
#pragma unroll
            for (int e = 0; e < NE; ++e) { bool taken = false;
#pragma unroll
                for (int q = 0; q < kk; ++q) taken = taken || (sel[q] == e);
                if (!taken && lg[e] > best) { best = lg[e]; bi = e; } }
            sel[kk] = bi; sv[kk] = best; }
        float es[4], sum = 0.f;
#pragma unroll
        for (int kk = 0; kk < 4; ++kk) { es[kk] = expf(sv[kk] - sv[0]); sum += es[kk]; }
#pragma unroll
        for (int kk = 0; kk < 4; ++kk) { p.topi[t * 4 + kk] = sel[kk]; p.topw[t * 4 + kk] = es[kk] / sum; const int pos = ATOMIC_INC(&p.cnt[sel[kk]]); p.list[(size_t)sel[kk] * M + pos] = (int)(t * 4 + kk); }
    } break;
    case OP_GATEUP: {
        const int j = (int)(idx % FF); const long rest = idx / FF; const int rb = (int)(rest % (M / 8)), e = (int)(rest / (M / 8)); const int cnt = p.cnt[e]; if (rb * 8 >= cnt) break;
        int a[8]; float g[8], u[8];
#pragma unroll
        for (int i = 0; i < 8; ++i) { a[i] = rb * 8 + i < cnt ? p.list[(size_t)e * M + rb * 8 + i] : -1; g[i] = 0.f; u[i] = 0.f; }
        const float* wgp = p.wg + ((size_t)l * NE + e) * D * FF + j; const float* wup = p.wu + ((size_t)l * NE + e) * D * FF + j;
        for (int k = 0; k < D; ++k) { const float gw = wgp[(size_t)k * FF], uw = wup[(size_t)k * FF];
#pragma unroll
            for (int i = 0; i < 8; ++i) { const float xv = p.h[(size_t)(a[i] < 0 ? 0 : a[i] / 4) * D + k]; g[i] += xv * gw; u[i] += xv * uw; } }
        const float bgv = p.bg[((size_t)l * NE + e) * FF + j], buv = p.bu[((size_t)l * NE + e) * FF + j];
#pragma unroll
        for (int i = 0; i < 8; ++i) if (a[i] >= 0) { float gv = g[i] + bgv; gv = gv < 7.0f ? gv : 7.0f; float uv = u[i] + buv; uv = uv < -7.0f ? -7.0f : (uv > 7.0f ? 7.0f : uv);
            p.act[(size_t)a[i] * FF + j] = gv * sigmf(1.702f * gv) * (uv + 1.0f); }
    } break;
    case OP_DOWN: {
        const int j = (int)(idx % D); const long rest = idx / D; const int rb = (int)(rest % (M / 8)), e = (int)(rest / (M / 8)); const int cnt = p.cnt[e]; if (rb * 8 >= cnt) break;
        int a[8]; float o[8];
#pragma unroll
        for (int i = 0; i < 8; ++i) { a[i] = rb * 8 + i < cnt ? p.list[(size_t)e * M + rb * 8 + i] : -1; o[i] = 0.f; }
        const float* wdp = p.wd + ((size_t)l * NE + e) * FF * D + j;
        for (int k = 0; k < FF; ++k) { const float w = wdp[(size_t)k * D];
#pragma unroll
            for (int i = 0; i < 8; ++i) o[i] += p.act[(size_t)(a[i] < 0 ? 0 : a[i]) * FF + k] * w; }
        const float bv = p.bd[((size_t)l * NE + e) * D + j];
#pragma unroll
        for (int i = 0; i < 8; ++i) if (a[i] >= 0) p.down[(size_t)a[i] * D + j] = o[i] + bv;
    } break;
    case OP_COMBINE: { const int r = (int)(idx / D), c = (int)(idx % D); float s = 0.f;
#pragma unroll
        for (int kk = 0; kk < 4; ++kk) s += p.topw[(size_t)r * 4 + kk] * p.down[((size_t)r * 4 + kk) * D + c];
        p.xres[idx] += modv(p, l, r, 5)[c] * s; } break;
    case OP_WRITE_OUT: p.out[idx] = p.xres[(size_t)CTX * D + idx]; break;
    case OP_MIXB: p.mixb[idx] = f2bf(p.mixin[idx]); break;
    case OP_SSD_CS: {
        const int hh = (int)(idx % SH), c = (int)((idx / SH) % NCH), dir = (int)(idx / (SH * NCH)); const float a = -expf(p.a_log[l * 12 + dir * 6 + hh]); float acc = 0.f;
        for (int i = 0; i < CHUNK; ++i) { const int r = c * CHUNK + (dir == 0 ? i : CHUNK - 1 - i); acc += p.dt[(size_t)r * 12 + dir * 6 + hh] * a; p.cs[((size_t)dir * M + r) * SH + hh] = acc; }
        p.cdec[idx] = expf(acc);
    } break;
    case OP_SSD_G: {
        const int s = (int)(idx % CHUNK), g = (int)((idx / CHUNK) % SG), r = (int)(idx / (CHUNK * SG)); const int r2 = (r / CHUNK) * CHUNK + s;
        const float* Cp = p.xbc + (size_t)r * CONVD + SW + SG * SN + g * SN; const float* Bp = p.xbc + (size_t)r2 * CONVD + SW + g * SN; float acc = 0.f;
        for (int n = 0; n < SN; ++n) acc += Cp[n] * Bp[n];
        p.gmat[idx] = acc;
    } break;
    case OP_SSD_YD: {
        const int cc = (int)(idx % SW), r = (int)(idx / SW); const int hh = cc / SP, g = hh / (SH / SG); const int c0 = (r / CHUNK) * CHUNK, lpos = r - c0;
        const float* G = p.gmat + ((size_t)r * SG + g) * CHUNK; const float csf = p.cs[(size_t)r * SH + hh], csb = p.cs[((size_t)M + r) * SH + hh]; float y = 0.f;
        for (int s = 0; s <= lpos; ++s) { const int r2 = c0 + s; y += G[s] * expf(csf - p.cs[(size_t)r2 * SH + hh]) * p.dt[(size_t)r2 * 12 + hh] * p.xbc[(size_t)r2 * CONVD + cc]; }
        for (int s = lpos; s < CHUNK; ++s) { const int r2 = c0 + s; y += G[s] * expf(csb - p.cs[((size_t)M + r2) * SH + hh]) * p.dt[(size_t)r2 * 12 + 6 + hh] * p.xbc[(size_t)r2 * CONVD + cc]; }
        p.ydir[idx] = y;
    } break;
    case OP_SSD_ST: {
        const int n = (int)(idx % SN), pp = (int)((idx / SN) % SP), hh = (int)((idx / (SN * SP)) % SH), c = (int)((idx / (SN * SP * SH)) % NCH), dir = (int)(idx / ((long)SN * SP * SH * NCH)); const int g = hh / (SH / SG);
        const int rend = c * CHUNK + (dir == 0 ? CHUNK - 1 : 0); const float cse = p.cs[((size_t)dir * M + rend) * SH + hh]; float acc = 0.f;
        for (int i = 0; i < CHUNK; ++i) { const int r = c * CHUNK + i; acc += p.xbc[(size_t)r * CONVD + SW + g * SN + n] * expf(cse - p.cs[((size_t)dir * M + r) * SH + hh]) * p.dt[(size_t)r * 12 + dir * 6 + hh] * p.xbc[(size_t)r * CONVD + hh * SP + pp]; }
        p.st[idx] = acc;
    } break;
    case OP_SSD_CARRY: {
        const int e = (int)(idx % (SP * SN)), hh = (int)((idx / (SP * SN)) % SH), dir = (int)(idx / ((long)SP * SN * SH)); float state = 0.f;
        for (int i = 0; i < NCH; ++i) { const int c = dir == 0 ? i : (i < CTX / CHUNK ? CTX / CHUNK - 1 - i : NCH - 1 - (i - CTX / CHUNK));
            const size_t o = (((size_t)dir * NCH + c) * SH + hh) * (SP * SN) + e; const float stc = p.st[o]; p.st[o] = state; state = state * p.cdec[((size_t)dir * NCH + c) * SH + hh] + stc; }
    } break;
    case OP_SSD_YOFF: {
        const int cc = (int)(idx % SW), r = (int)(idx / SW); const int hh = cc / SP, pp = cc % SP, g = hh / (SH / SG), c = r / CHUNK; const float* Cp = p.xbc + (size_t)r * CONVD + SW + SG * SN + g * SN;
        float y = 0.f;
#pragma unroll
        for (int dir = 0; dir < 2; ++dir) { const float* pv = p.st + ((((size_t)dir * NCH + c) * SH + hh) * SP + pp) * SN; float acc = 0.f;
            for (int n = 0; n < SN; ++n) acc += Cp[n] * pv[n];
            y += acc * expf(p.cs[((size_t)dir * M + r) * SH + hh]); }
        p.ydir[(size_t)M * SW + idx] = y;
    } break;
    case OP_COMBINE2: { const int r = (int)(idx / D), c = (int)(idx % D); float s = 0.f;
#pragma unroll
        for (int kk = 0; kk < 4; ++kk) s += p.topw[(size_t)r * 4 + kk] * bf2f(p.ybn[((size_t)r * 4 + kk) * D + c]);
        p.xres[idx] += modv(p, l, r, 5)[c] * s; } break;
    }
}

static const int LAYER_OPS[] = { OP_ROWSTAT, OP_NORM1, OP_INPROJ, OP_LATNORM, OP_QRAW, OP_KVRAW, OP_QHEAD, OP_KHEAD, OP_ATTN, OP_CONV, OP_DT, OP_SSDSCAN, OP_SSDFIN, OP_POOLP, OP_POOLMM,
                                 OP_OUTPROJ, OP_RES1, OP_ROWSTAT, OP_NORM2, OP_LOGITS, OP_ZEROCNT, OP_TOPK, OP_GATEUP, OP_DOWN, OP_COMBINE };
constexpr int N_LAYER_OPS = sizeof(LAYER_OPS) / sizeof(int);
#endif

#define XB_TMO      128
#define XB_XCNT(j)  (256  + 64 * (j))
#define XB_XSUB(j)  (1280 + 64 * (j))
#define XB_XGEN(j)  (2304 + 64 * (j))
#define XB_TOP      3328
#define XB_TOPGEN   3392
#define XCD_BAR_WORDS 3456
#define XB_SPIN_CAP (1u << 22)
#define LAS __attribute__((address_space(3)))

__device__ __forceinline__ unsigned xb_ld(unsigned* p)              { return __hip_atomic_load(p, __ATOMIC_RELAXED, __HIP_MEMORY_SCOPE_AGENT); }
__device__ __forceinline__ unsigned xb_add(unsigned* p, unsigned v) { return __hip_atomic_fetch_add(p, v, __ATOMIC_RELAXED, __HIP_MEMORY_SCOPE_AGENT); }
__device__ __forceinline__ unsigned xb_xcc_id() { return (unsigned)__builtin_amdgcn_s_getreg((3 << 11) | 20) & 0xFu; }
#define XB_SPIN(cond, bar) do { unsigned _sp = 0; while (cond) { __builtin_amdgcn_s_sleep(1); \
    if ((++_sp & 255u) == 0u) { if (xb_ld(&(bar)[XB_TMO])) break; if (_sp > XB_SPIN_CAP) { atomicAdd(&(bar)[XB_TMO], 1u); break; } } } } while (0)

struct XcdBarrier {
    unsigned* bar; unsigned x;
    volatile LAS unsigned* st;
};

__device__ __forceinline__ XcdBarrier xcd_barrier_post(unsigned* bar, volatile LAS unsigned* st) {
    XcdBarrier b; b.bar = bar; b.x = xb_xcc_id(); b.st = st;
    if (threadIdx.x == 0) (void)xb_add(&bar[XB_XCNT(b.x)], 1u);
    return b;
}
__device__ __forceinline__ void xcd_barrier_complete(unsigned* bar, unsigned x, unsigned& nloc, unsigned& nx) {
    const unsigned G = gridDim.x * gridDim.y * gridDim.z;
    unsigned sum, cnt, mine, sp = 0u;
    for (;;) {
        sum = 0u; cnt = 0u; mine = 0u;
#pragma unroll
        for (unsigned j = 0; j < 16; ++j) { const unsigned c = xb_ld(&bar[XB_XCNT(j)]); sum += c; cnt += (c > 0u) ? 1u : 0u; mine = (j == x) ? c : mine; }
        if (sum == G) break;
        __builtin_amdgcn_s_sleep(1);
        if ((++sp & 255u) == 0u) { if (xb_ld(&bar[XB_TMO])) break; if (sp > XB_SPIN_CAP) { atomicAdd(&bar[XB_TMO], 1u); break; } }
    }
    nloc = mine > 0u ? mine : 1u; nx = cnt > 0u ? cnt : 1u;
}

__device__ __forceinline__ void xcd_barrier(const XcdBarrier& b) {
    asm volatile("s_waitcnt vmcnt(0)" ::: "memory");
    __syncthreads();
    if (threadIdx.x == 0) {
        unsigned* bar = b.bar;
        __builtin_amdgcn_s_waitcnt(0);
        unsigned nloc = b.st[0], nx = b.st[1];
        if (nloc == 0u) { unsigned xx = b.x; asm volatile("" : "+s"(xx));   xcd_barrier_complete(bar, xx, nloc, nx); b.st[0] = nloc; b.st[1] = nx; }
        const unsigned old = xb_add(&bar[XB_XSUB(b.x)], 1u);
        const unsigned gen = old / nloc;
        if (old + 1u == (gen + 1u) * nloc) {
            __builtin_amdgcn_fence(__ATOMIC_RELEASE, "agent");
            asm volatile("s_waitcnt vmcnt(0)" ::: "memory");
            const unsigned og = xb_add(&bar[XB_TOP], 1u);
            const unsigned tg = og / nx;
            if (og + 1u == (tg + 1u) * nx) xb_add(&bar[XB_TOPGEN], 1u);
            else XB_SPIN(xb_ld(&bar[XB_TOPGEN]) == tg, bar);
            __builtin_amdgcn_fence(__ATOMIC_ACQUIRE, "agent");
            xb_add(&bar[XB_XGEN(b.x)], 1u);
            asm volatile("s_waitcnt vmcnt(0)" ::: "memory");
        } else {
            XB_SPIN(xb_ld(&bar[XB_XGEN(b.x)]) == gen, bar);
            __builtin_amdgcn_fence(__ATOMIC_ACQUIRE, "agent");
            asm volatile("s_waitcnt vmcnt(0)" ::: "memory");
        }
    }
    __syncthreads();
}


namespace at {
typedef unsigned short bf16_t;
using bf16x8 = __attribute__((ext_vector_type(8))) short;
using s16x4  = __attribute__((ext_vector_type(4))) short;
using f32x16 = __attribute__((ext_vector_type(16))) float;
using u32x4  = __attribute__((ext_vector_type(4))) unsigned;
constexpr int DQ = 96, DV = 64, NW = 8, QBLK = 32, KVBLK = 64;
constexpr int LDQ = 6 * DQ, LDK = 6 * DQ, LDV = 6 * DV;
constexpr float SCALE = 0.10206207261596575f;
constexpr float THR = 8.f;
constexpr int KROW = 208;
constexpr int SHM_K = KVBLK * KROW, SHM_V = KVBLK * DV * 2;
constexpr int SHM_ATTN = 2 * SHM_V + 2 * SHM_K + NW * 64 * 4;
#define AT_SBAR() __builtin_amdgcn_sched_barrier(0)
__device__ __forceinline__ int crow(int r, int hi) { return (r & 3) + 8 * (r >> 2) + 4 * hi; }
__device__ __forceinline__ unsigned cvtpk(float lo, float hi) { unsigned r; asm volatile("v_cvt_pk_bf16_f32 %0, %1, %2" : "=v"(r) : "v"(lo), "v"(hi)); return r; }

__device__ __forceinline__ void partialSM(f32x16& p0, f32x16& p1, float& m_reg, float& mn, float& alpha) {
  constexpr float C = SCALE * 1.4426950408889634f;
  float pmax = p0[0];
#pragma unroll
  for (int r = 1; r < 16; ++r) pmax = fmaxf(pmax, p0[r]);
#pragma unroll
  for (int r = 0; r < 16; ++r) pmax = fmaxf(pmax, p1[r]);
  { auto rr = __builtin_amdgcn_permlane32_swap(__float_as_uint(pmax), __float_as_uint(pmax), false, false);
    pmax = fmaxf(__uint_as_float(rr[0]), __uint_as_float(rr[1])); }
  if (__builtin_expect(__all(pmax - m_reg <= THR / SCALE), 1)) { mn = m_reg; alpha = 1.f; }
  else { mn = fmaxf(m_reg, pmax); alpha = __builtin_amdgcn_exp2f((m_reg - mn) * C); m_reg = mn; }
  float mnC = -mn * C;
#pragma unroll
  for (int r = 0; r < 16; ++r) p0[r] = fmaf(p0[r], C, mnC);
#pragma unroll
  for (int r = 0; r < 16; ++r) p1[r] = fmaf(p1[r], C, mnC);
#pragma unroll
  for (int r = 0; r < 16; ++r) p0[r] = __builtin_amdgcn_exp2f(p0[r]);
}
__device__ __forceinline__ void finishSM(f32x16& p0, f32x16& p1, float alpha, float& l_reg, bf16x8& pa0, bf16x8& pa1, bf16x8& pa2, bf16x8& pa3) {
#pragma unroll
  for (int r = 0; r < 16; ++r) p1[r] = __builtin_amdgcn_exp2f(p1[r]);
  float ps = 0;
#pragma unroll
  for (int r = 0; r < 16; ++r) ps += p0[r];
#pragma unroll
  for (int r = 0; r < 16; ++r) ps += p1[r];
  { auto rr = __builtin_amdgcn_permlane32_swap(__float_as_uint(ps), __float_as_uint(ps), false, false);
    ps = __uint_as_float(rr[0]) + __uint_as_float(rr[1]); }
  l_reg = l_reg * alpha + ps;
#define AT_PK4(P, BASE, OUT) do { unsigned a0 = cvtpk(P[BASE + 0], P[BASE + 1]), a1 = cvtpk(P[BASE + 2], P[BASE + 3]);   \
    unsigned b0 = cvtpk(P[BASE + 4], P[BASE + 5]), b1 = cvtpk(P[BASE + 6], P[BASE + 7]);                              \
    auto r0 = __builtin_amdgcn_permlane32_swap(a0, b0, false, false); auto r1 = __builtin_amdgcn_permlane32_swap(a1, b1, false, false); \
    u32x4 w = {r0[0], r1[0], r0[1], r1[1]}; OUT = *reinterpret_cast<bf16x8*>(&w); } while (0)
  AT_PK4(p0, 0, pa0); AT_PK4(p0, 8, pa1); AT_PK4(p1, 0, pa2); AT_PK4(p1, 8, pa3);
#undef AT_PK4
}
__device__ __forceinline__ void qkt(f32x16& p0, f32x16& p1, const char* Ks, const bf16x8* qr, int r32, int hi) {
  p0 = f32x16{}; p1 = f32x16{};
#pragma unroll
  for (int d0 = 0; d0 < 6; ++d0) { const int cb = (d0 * 16 + hi * 8) * 2;
    bf16x8 b0 = *reinterpret_cast<const bf16x8*>(Ks + r32 * KROW + cb);
    bf16x8 b1 = *reinterpret_cast<const bf16x8*>(Ks + (32 + r32) * KROW + cb);
    p0 = __builtin_amdgcn_mfma_f32_32x32x16_bf16(b0, qr[d0], p0, 0, 0, 0);
    p1 = __builtin_amdgcn_mfma_f32_32x32x16_bf16(b1, qr[d0], p1, 0, 0, 0); }
}
__device__ __forceinline__ int v_st(int k, int c) { const int kk = (k & ~0xC) | ((k & 4) << 1) | ((k & 8) >> 1); return ((kk >> 3) * 2 + (c >> 5)) * 512 + ((kk & 7) * 32 + (c & 31)) * 2; }
__device__ __forceinline__ int v_rd_base(int lane) { return ((lane & 3) << 3) | (((lane >> 2) & 3) << 6) | (((lane >> 4) & 1) << 5) | (((lane >> 5) & 1) << 8); }
constexpr int v_rd_off(int d0, int ks, int half) { return d0 * 512 + ks * 2048 + half * 1024; }
template <int OFF> __device__ __forceinline__ s16x4 tr_read(int vb) {
  s16x4 r; asm volatile("ds_read_b64_tr_b16 %0, %1 offset:%2" : "=&v"(r) : "v"(vb), "i"(OFF) : "memory"); return r;
}
template <int D0> __device__ __forceinline__ void pv_one(f32x16& od, int vb, bf16x8 pa0, bf16x8 pa1, bf16x8 pa2, bf16x8 pa3) {
  const s16x4 l0 = tr_read<v_rd_off(D0, 0, 0)>(vb), h0 = tr_read<v_rd_off(D0, 0, 1)>(vb), l1 = tr_read<v_rd_off(D0, 1, 0)>(vb), h1 = tr_read<v_rd_off(D0, 1, 1)>(vb);
  const s16x4 l2 = tr_read<v_rd_off(D0, 2, 0)>(vb), h2 = tr_read<v_rd_off(D0, 2, 1)>(vb), l3 = tr_read<v_rd_off(D0, 3, 0)>(vb), h3 = tr_read<v_rd_off(D0, 3, 1)>(vb);
  asm volatile("s_waitcnt lgkmcnt(0)" ::: "memory"); AT_SBAR();
#define AT_PK(L, H) (bf16x8){L[0], L[1], L[2], L[3], H[0], H[1], H[2], H[3]}
  od = __builtin_amdgcn_mfma_f32_32x32x16_bf16(pa0, AT_PK(l0, h0), od, 0, 0, 0);
  od = __builtin_amdgcn_mfma_f32_32x32x16_bf16(pa1, AT_PK(l1, h1), od, 0, 0, 0);
  od = __builtin_amdgcn_mfma_f32_32x32x16_bf16(pa2, AT_PK(l2, h2), od, 0, 0, 0);
  od = __builtin_amdgcn_mfma_f32_32x32x16_bf16(pa3, AT_PK(l3, h3), od, 0, 0, 0);
#undef AT_PK
}
__device__ __forceinline__ void pv_d0(f32x16* o, int vb, bf16x8 pa0, bf16x8 pa1, bf16x8 pa2, bf16x8 pa3) {
  pv_one<0>(o[0], vb, pa0, pa1, pa2, pa3); pv_one<1>(o[1], vb, pa0, pa1, pa2, pa3);
}
template <class TO> __device__ __forceinline__ void attn_body(const bf16_t* __restrict__ Qb, const bf16_t* __restrict__ Kh, const bf16_t* __restrict__ Vh, TO* __restrict__ Ob, int ldo, int seq, char* lds, float* __restrict__ ml = nullptr, int ldml = 0) {
  int tid = threadIdx.x; asm volatile("" : "+v"(tid));
  const int wid = tid >> 6, lane = tid & 63, r32 = lane & 31, hi = lane >> 5;
  char* V_lds = lds; char* K_lds = lds + 2 * SHM_V;
  float* ws = (float*)(lds + 2 * SHM_V + 2 * SHM_K) + wid * 64; float* li_l = ws; float* al_l = ws + 32;
  float m_reg = -1e30f, l_reg = 0; f32x16 o[2] = {}; bf16x8 qr[6];
  const bf16_t* Qw = Qb + (long)(wid * QBLK + r32) * LDQ + hi * 8;
#pragma unroll
  for (int d0 = 0; d0 < 6; ++d0) qr[d0] = *reinterpret_cast<const bf16x8*>(Qw + d0 * 16);
  const int kr0 = tid / 12, kc0 = tid % 12, c1 = 512 + (tid & 255), kr1 = c1 / 12, kc1 = c1 % 12, vr = tid >> 3, vc = (tid & 7) * 8;
  const bool k1on = tid < 256;
  const int kst0 = kr0 * KROW + kc0 * 16, kst1 = kr1 * KROW + kc1 * 16, vst = v_st(vr, vc);
  const long kg0 = (long)kr0 * LDK + kc0 * 8, kg1 = (long)kr1 * LDK + kc1 * 8, vg = (long)vr * LDV + vc;
  const int vb0 = (int)(uintptr_t)V_lds + v_rd_base(lane);
  struct { bf16x8 vs, ks0, ks1; } sr_[2];
#define AT_SLOAD(i, k0) do { sr_[i].vs = *reinterpret_cast<const bf16x8*>(Vh + (long)(k0) * LDV + vg); \
    sr_[i].ks0 = *reinterpret_cast<const bf16x8*>(Kh + (long)(k0) * LDK + kg0); sr_[i].ks1 = *reinterpret_cast<const bf16x8*>(Kh + (long)(k0) * LDK + kg1); } while (0)
#define AT_SWRITE(b, i) do { *(bf16x8*)(V_lds + (b) * SHM_V + vst) = sr_[i].vs; *(bf16x8*)(K_lds + (b) * SHM_K + kst0) = sr_[i].ks0; \
    if (k1on) *(bf16x8*)(K_lds + (b) * SHM_K + kst1) = sr_[i].ks1; } while (0)
#define AT_SWAIT() asm volatile("s_waitcnt vmcnt(3)" ::: "memory")
#define AT_RESC(a) do { if (__any((a) < 1.f)) { if (hi == 0) al_l[r32] = (a); asm volatile("s_waitcnt lgkmcnt(0)" ::: "memory"); \
    _Pragma("unroll") for (int d = 0; d < 2; ++d) _Pragma("unroll") for (int r = 0; r < 16; ++r) o[d][r] *= al_l[crow(r, hi)]; } } while (0)
  f32x16 pA0, pA1, pB0, pB1; float mnA, mnB, alA, alB; bf16x8 pa0, pa1, pa2, pa3; const int NT = seq / KVBLK;
  constexpr int SE = 0, SO = 1;
  AT_SLOAD(SE, 0); asm volatile("s_waitcnt vmcnt(0)" ::: "memory"); AT_SWRITE(0, SE); __syncthreads();
  qkt(pA0, pA1, K_lds, qr, r32, hi); partialSM(pA0, pA1, m_reg, mnA, alA);
  AT_SLOAD(SO, KVBLK); if (2 < NT) AT_SLOAD(SE, 2 * KVBLK);
  AT_SWAIT(); AT_SWRITE(1, SO); __syncthreads();
  for (int j = 1; j + 1 < NT; j += 2) {
    AT_SBAR(); qkt(pB0, pB1, K_lds + SHM_K, qr, r32, hi);
    finishSM(pA0, pA1, alA, l_reg, pa0, pa1, pa2, pa3); AT_SBAR();
    AT_SLOAD(SO, (j + 2) * KVBLK); AT_SBAR();
    pv_d0(o, vb0, pa0, pa1, pa2, pa3); partialSM(pB0, pB1, m_reg, mnB, alB);
    __syncthreads(); AT_SWAIT(); AT_SWRITE(0, SE);
    AT_RESC(alB); __syncthreads();
    AT_SBAR(); qkt(pA0, pA1, K_lds, qr, r32, hi);
    finishSM(pB0, pB1, alB, l_reg, pa0, pa1, pa2, pa3); AT_SBAR();
    if (j + 3 < NT) AT_SLOAD(SE, (j + 3) * KVBLK); AT_SBAR();
    pv_d0(o, vb0 + SHM_V, pa0, pa1, pa2, pa3); partialSM(pA0, pA1, m_reg, mnA, alA);
    __syncthreads(); AT_SWAIT(); AT_SWRITE(1, SO);
    AT_RESC(alA); __syncthreads();
  }
  AT_SBAR(); qkt(pB0, pB1, K_lds + SHM_K, qr, r32, hi);
  finishSM(pA0, pA1, alA, l_reg, pa0, pa1, pa2, pa3); AT_SBAR();
  pv_d0(o, vb0, pa0, pa1, pa2, pa3); partialSM(pB0, pB1, m_reg, mnB, alB);
  __syncthreads(); AT_RESC(alB);
  finishSM(pB0, pB1, alB, l_reg, pa0, pa1, pa2, pa3); AT_SBAR();
  pv_d0(o, vb0 + SHM_V, pa0, pa1, pa2, pa3);
  if (hi == 0) li_l[r32] = l_reg; asm volatile("s_waitcnt lgkmcnt(0)" ::: "memory");
  if (ml != nullptr && hi == 0) { float* q = ml + (long)(wid * QBLK + r32) * ldml; q[0] = m_reg; q[1] = l_reg; }
  float rli[16];
#pragma unroll
  for (int r = 0; r < 16; ++r) rli[r] = __builtin_amdgcn_rcpf(li_l[crow(r, hi)]);
  TO* Ow = Ob + (long)(wid * QBLK) * ldo;
#pragma unroll
  for (int r = 0; r < 16; ++r) { const int orow = crow(r, hi);
#pragma unroll
    for (int d0 = 0; d0 < 2; ++d0) { const float val = o[d0][r] * rli[r]; if constexpr (sizeof(TO) == 2) Ow[(long)orow * ldo + d0 * 32 + r32] = (TO)(cvtpk(val, val) & 0xffffu); else Ow[(long)orow * ldo + d0 * 32 + r32] = val; } }
#undef AT_SLOAD
#undef AT_SWRITE
#undef AT_SWAIT
#undef AT_RESC
}
__device__ __forceinline__ void attn_combine(const bf16_t* Opart, const float* ml, bf16_t* dst, int ldd, int nrows_total, int ctx_rows) {
  int tid = threadIdx.x; asm volatile("" : "+v"(tid)); const int wid = tid >> 6, lane = tid & 63;
  constexpr float C = SCALE * 1.4426950408889634f; const size_t hs = (size_t)nrows_total * 6 * DV;
  for (int r = blockIdx.x * 8 + wid; r < nrows_total; r += gridDim.x * 8) {
#pragma unroll
    for (int j = 0; j < 3; ++j) { const int c = 2 * (lane + 64 * j), hh = c >> 6; const unsigned w0 = *(const unsigned*)(Opart + (size_t)r * 384 + c);
      unsigned res = w0;
      if (r >= ctx_rows) { const unsigned w1 = *(const unsigned*)(Opart + hs + (size_t)r * 384 + c);
        const float m0 = ml[((size_t)r * 6 + hh) * 2], l0 = ml[((size_t)r * 6 + hh) * 2 + 1], m1 = ml[((size_t)(nrows_total + r) * 6 + hh) * 2], l1 = ml[((size_t)(nrows_total + r) * 6 + hh) * 2 + 1];
        const float m = fmaxf(m0, m1); const float a0 = __builtin_amdgcn_exp2f((m0 - m) * C) * l0, a1 = __builtin_amdgcn_exp2f((m1 - m) * C) * l1; const float inv = 1.0f / (a0 + a1); const float f0 = a0 * inv, f1 = a1 * inv;
        const float x0 = __uint_as_float(w0 << 16) * f0 + __uint_as_float(w1 << 16) * f1, x1 = __uint_as_float(w0 & 0xffff0000u) * f0 + __uint_as_float(w1 & 0xffff0000u) * f1; res = cvtpk(x0, x1); }
      *(unsigned*)(dst + (size_t)r * ldd + c) = res; } }
}
}

namespace gm {
#define GM_LAS __attribute__((address_space(3)))
typedef unsigned short bf16_t;
typedef short bf16x8 __attribute__((ext_vector_type(8)));
typedef float f32x4 __attribute__((ext_vector_type(4)));
typedef unsigned u32x4 __attribute__((ext_vector_type(4)));
constexpr int BM = 256, BK = 64, HALF = 128, HTB = HALF * BK * 2, STAGE_BYTES = 8 * HTB;
__host__ __device__ __forceinline__ int lds_byte(int r, int c) { const int st = (r >> 4) * 2 + (c >> 5), rr = r & 15, cc = c & 31, ob = rr * 64 + cc * 2; return st * 1024 + (ob ^ (((ob >> 9) & 1) << 5)); }
__host__ __device__ __forceinline__ void stage_rc(int b, int& R, int& C) { const int st = b / 1024, sb = b % 1024, swz = sb ^ (((sb >> 9) & 1) << 5); R = (st >> 1) * 16 + swz / 64; C = (st & 1) * 32 + (swz % 64) / 2; }
__host__ __device__ __forceinline__ int perm32(int rho) { const int n = rho >> 4, i = rho & 15; return 8 * (i >> 2) + 4 * n + (i & 3); }
__device__ __forceinline__ unsigned cvt_pk_bf16(float lo, float hi) { unsigned r; asm volatile("v_cvt_pk_bf16_f32 %0, %1, %2" : "=v"(r) : "v"(lo), "v"(hi)); return r; }

template <bool PERM, class Epi>
__device__ __forceinline__ void gemm_unit(GM_LAS unsigned char* lds, const char* A, const unsigned (&offA)[2][2], const char* Bt, int K, const Epi& E) {
    int tid = threadIdx.x; asm volatile("" : "+v"(tid));
    const int wid = __builtin_amdgcn_readfirstlane(tid >> 6), lane = tid & 63, wr = wid >> 2, wc = wid & 3, fr = lane & 15, fq = lane >> 4;
    const int nt = K / BK;
    unsigned voffB[2];
#pragma unroll
    for (int i = 0; i < 2; ++i) { int R, C; stage_rc(tid * 16 + i * 8192, R, C); const int Rb = PERM ? ((R & ~31) + perm32(R & 31)) : R; voffB[i] = (unsigned)(Rb * K + C) * 2u; }
    const size_t kstep = (size_t)(BK * 2);
    const size_t hstep = (size_t)HALF * K * 2;
    const unsigned ldsw = (unsigned)wid * 1024u;
    const int aoff = lds_byte(wr * 64 + fr, fq * 8), boff = lds_byte(wc * 32 + fr, fq * 8);
#define GM_SA(b, h) (((b) * 2 + (h)) * HTB)
#define GM_SB(b, h) ((4 + (b) * 2 + (h)) * HTB)
#define GM_STAGEB(bufoff, gbase) do { _Pragma("unroll") for (int _i = 0; _i < 2; ++_i) \
        __builtin_amdgcn_global_load_lds((const unsigned*)((const char*)(gbase) + voffB[_i]), (GM_LAS unsigned*)(lds + (bufoff) + ldsw + _i * 8192), 16, 0, 0); } while (0)
#define GM_STAGEA(bufoff, h, kbyte) do { _Pragma("unroll") for (int _i = 0; _i < 2; ++_i) \
        __builtin_amdgcn_global_load_lds((const unsigned*)(A + (size_t)offA[h][_i] + (kbyte)), (GM_LAS unsigned*)(lds + (bufoff) + ldsw + _i * 8192), 16, 0, 0); } while (0)
#define GM_LDA(dst, b, h) do { _Pragma("unroll") for (int m = 0; m < 4; ++m) _Pragma("unroll") for (int k = 0; k < 2; ++k) dst[m][k] = *(const GM_LAS bf16x8*)(lds + GM_SA(b, h) + aoff + m * 2048 + k * 1024); } while (0)
#define GM_LDB(dst, b, h) do { _Pragma("unroll") for (int n = 0; n < 2; ++n) _Pragma("unroll") for (int k = 0; k < 2; ++k) dst[n][k] = *(const GM_LAS bf16x8*)(lds + GM_SB(b, h) + boff + n * 2048 + k * 1024); } while (0)
#define GM_MMA(ai, bj, At, Bt_) do { __builtin_amdgcn_s_setprio(1); _Pragma("unroll") for (int m = 0; m < 4; ++m) _Pragma("unroll") for (int n = 0; n < 2; ++n) _Pragma("unroll") for (int k = 0; k < 2; ++k) \
        acc[ai][bj][m][n] = __builtin_amdgcn_mfma_f32_16x16x32_bf16(Bt_[n][k], At[m][k], acc[ai][bj][m][n], 0, 0, 0); __builtin_amdgcn_s_setprio(0); } while (0)
#define GM_WAIT_V(n) asm volatile("s_waitcnt vmcnt(" #n ")" ::: "memory")
#define GM_WAIT_L(n) asm volatile("s_waitcnt lgkmcnt(" #n ")" ::: "memory")
#define GM_BAR __builtin_amdgcn_s_barrier()
#define GM_SCHED __builtin_amdgcn_sched_barrier(0)
    f32x4 acc[2][2][4][2];
#pragma unroll
    for (int a = 0; a < 2; ++a)
#pragma unroll
        for (int b = 0; b < 2; ++b)
#pragma unroll
            for (int m = 0; m < 4; ++m)
#pragma unroll
                for (int n = 0; n < 2; ++n) acc[a][b][m][n] = (f32x4){0.f, 0.f, 0.f, 0.f};
    bf16x8 At[4][2], B0[2][2], B1[2][2];
    const char* cB = Bt;
    GM_STAGEB(GM_SB(0, 0), cB); GM_STAGEA(GM_SA(0, 0), 0, 0); GM_STAGEB(GM_SB(0, 1), cB + hstep); GM_STAGEA(GM_SA(0, 1), 1, 0);
    if (wr == 1) GM_BAR;
    GM_WAIT_V(4); GM_BAR;
    GM_STAGEB(GM_SB(1, 0), cB + kstep); GM_STAGEA(GM_SA(1, 0), 0, kstep); GM_STAGEB(GM_SB(1, 1), cB + hstep + kstep);
    GM_WAIT_V(6); GM_BAR;
    for (int t = 0; t < nt; t += 2) {
        const bool last = (t == nt - 2);
        const size_t k1 = (size_t)(t + 1) * kstep;
        const size_t k2 = last ? 0 : (size_t)(t + 2) * kstep;
        const size_t k3 = k2 + kstep;
        const char* b2 = cB + k2; const char* b3 = cB + k3;
        GM_LDB(B0, 0, 0); GM_SCHED; GM_LDA(At, 0, 0); GM_STAGEA(GM_SA(1, 1), 1, k1);
        GM_WAIT_L(8); GM_BAR; GM_WAIT_L(0); GM_MMA(0, 0, At, B0); GM_BAR; GM_SCHED;
        GM_LDB(B1, 0, 1); GM_STAGEB(GM_SB(0, 0), b2);
        GM_BAR; GM_WAIT_L(0); GM_MMA(0, 1, At, B1); GM_BAR;
        GM_LDA(At, 0, 1); GM_STAGEA(GM_SA(0, 0), 0, k2);
        GM_BAR; GM_WAIT_L(0); GM_MMA(1, 0, At, B0); GM_BAR; GM_SCHED;
        GM_STAGEB(GM_SB(0, 1), b2 + hstep);
        GM_WAIT_V(6); GM_BAR; GM_MMA(1, 1, At, B1); GM_BAR;
        GM_LDB(B0, 1, 0); GM_SCHED; GM_LDA(At, 1, 0); GM_STAGEA(GM_SA(0, 1), 1, k2);
        GM_WAIT_L(8); GM_BAR; GM_WAIT_L(0); GM_MMA(0, 0, At, B0); GM_BAR; GM_SCHED;
        GM_LDB(B1, 1, 1); GM_STAGEB(GM_SB(1, 0), b3);
        GM_BAR; GM_WAIT_L(0); GM_MMA(0, 1, At, B1); GM_BAR;
        GM_LDA(At, 1, 1); GM_STAGEA(GM_SA(1, 0), 0, k3);
        GM_BAR; GM_WAIT_L(0); GM_MMA(1, 0, At, B0); GM_BAR; GM_SCHED;
        GM_STAGEB(GM_SB(1, 1), b3 + hstep);
        GM_WAIT_V(6); GM_BAR; GM_MMA(1, 1, At, B1); GM_BAR;
    }
    E(acc, wr, wc, fr, fq);
    GM_WAIT_V(0);
    if (wr == 0) GM_BAR;
    GM_BAR;
#undef GM_SA
#undef GM_SB
#undef GM_STAGEA
#undef GM_STAGEB
#undef GM_LDA
#undef GM_LDB
#undef GM_MMA
#undef GM_WAIT_V
#undef GM_WAIT_L
#undef GM_BAR
#undef GM_SCHED
}
template <bool PERM, class U, class Sched, class Epi>
__device__ __forceinline__ void gemm_stream(GM_LAS unsigned char* lds, int K, const Sched& S, const Epi& E) {
    int tid = threadIdx.x; asm volatile("" : "+v"(tid));
    const int wid = __builtin_amdgcn_readfirstlane(tid >> 6), lane = tid & 63, wr = wid >> 2, wc = wid & 3, fr = lane & 15, fq = lane >> 4;
    const int nt = K / BK;
    unsigned voffB[2];
#pragma unroll
    for (int i = 0; i < 2; ++i) { int R, C; stage_rc(tid * 16 + i * 8192, R, C); const int Rb = PERM ? ((R & ~31) + perm32(R & 31)) : R; voffB[i] = (unsigned)(Rb * K + C) * 2u; }
    const size_t kstep = (size_t)(BK * 2);
    const size_t hstep = (size_t)HALF * K * 2;
    const unsigned ldsw = (unsigned)wid * 1024u;
    const int aoff = lds_byte(wr * 64 + fr, fq * 8), boff = lds_byte(wc * 32 + fr, fq * 8);
#define GM_SA(b, h) (((b) * 2 + (h)) * HTB)
#define GM_SB(b, h) ((4 + (b) * 2 + (h)) * HTB)
#define GM_STAGEB(bufoff, gbase) do { _Pragma("unroll") for (int _i = 0; _i < 2; ++_i) \
        __builtin_amdgcn_global_load_lds((const unsigned*)((const char*)(gbase) + voffB[_i]), (GM_LAS unsigned*)(lds + (bufoff) + ldsw + _i * 8192), 16, 0, 0); } while (0)
#define GM_STAGEA2(bufoff, abase, o0, o1, kbyte) do { \
        __builtin_amdgcn_global_load_lds((const unsigned*)((abase) + (size_t)(o0) + (kbyte)), (GM_LAS unsigned*)(lds + (bufoff) + ldsw), 16, 0, 0); \
        __builtin_amdgcn_global_load_lds((const unsigned*)((abase) + (size_t)(o1) + (kbyte)), (GM_LAS unsigned*)(lds + (bufoff) + ldsw + 8192), 16, 0, 0); } while (0)
#define GM_LDA(dst, b, h) do { _Pragma("unroll") for (int m = 0; m < 4; ++m) _Pragma("unroll") for (int k = 0; k < 2; ++k) dst[m][k] = *(const GM_LAS bf16x8*)(lds + GM_SA(b, h) + aoff + m * 2048 + k * 1024); } while (0)
#define GM_LDB(dst, b, h) do { _Pragma("unroll") for (int n = 0; n < 2; ++n) _Pragma("unroll") for (int k = 0; k < 2; ++k) dst[n][k] = *(const GM_LAS bf16x8*)(lds + GM_SB(b, h) + boff + n * 2048 + k * 1024); } while (0)
#define GM_MMA(ai, bj, At, Bt_) do { __builtin_amdgcn_s_setprio(1); _Pragma("unroll") for (int m = 0; m < 4; ++m) _Pragma("unroll") for (int n = 0; n < 2; ++n) _Pragma("unroll") for (int k = 0; k < 2; ++k) \
        acc[ai][bj][m][n] = __builtin_amdgcn_mfma_f32_16x16x32_bf16(Bt_[n][k], At[m][k], acc[ai][bj][m][n], 0, 0, 0); __builtin_amdgcn_s_setprio(0); } while (0)
#define GM_WAIT_V(n) asm volatile("s_waitcnt vmcnt(" #n ")" ::: "memory")
#define GM_WAIT_L(n) asm volatile("s_waitcnt lgkmcnt(" #n ")" ::: "memory")
#define GM_BAR __builtin_amdgcn_s_barrier()
#define GM_SCHED __builtin_amdgcn_sched_barrier(0)
    U cur, nxt; int ui = 0;
    if (!S(0, cur)) return;
    f32x4 acc[2][2][4][2];
#pragma unroll
    for (int a = 0; a < 2; ++a)
#pragma unroll
        for (int b = 0; b < 2; ++b)
#pragma unroll
            for (int m = 0; m < 4; ++m)
#pragma unroll
                for (int n = 0; n < 2; ++n) acc[a][b][m][n] = (f32x4){0.f, 0.f, 0.f, 0.f};
    bf16x8 At[4][2], B0[2][2], B1[2][2];
    GM_STAGEB(GM_SB(0, 0), cur.B); GM_STAGEA2(GM_SA(0, 0), cur.A, cur.offA[0][0], cur.offA[0][1], 0); GM_STAGEB(GM_SB(0, 1), cur.B + hstep); GM_STAGEA2(GM_SA(0, 1), cur.A, cur.offA[1][0], cur.offA[1][1], 0);
    if (wr == 1) GM_BAR;
    GM_WAIT_V(4); GM_BAR;
    GM_STAGEB(GM_SB(1, 0), cur.B + kstep); GM_STAGEA2(GM_SA(1, 0), cur.A, cur.offA[0][0], cur.offA[0][1], kstep); GM_STAGEB(GM_SB(1, 1), cur.B + hstep + kstep);
    GM_WAIT_V(6); GM_BAR;
    for (;;) {
        const bool has_next = S(ui + 1, nxt);
        for (int t = 0; t < nt; t += 2) {
            const bool last = (t == nt - 2); const bool usen = last && has_next;
            const size_t k1 = (size_t)(t + 1) * kstep;
            const size_t k2 = last ? 0 : (size_t)(t + 2) * kstep, k3 = k2 + kstep;
            const char* a2b = usen ? nxt.A : cur.A; const char* b2b = usen ? nxt.B : cur.B;
            const unsigned o00 = usen ? nxt.offA[0][0] : cur.offA[0][0], o01 = usen ? nxt.offA[0][1] : cur.offA[0][1], o10 = usen ? nxt.offA[1][0] : cur.offA[1][0], o11 = usen ? nxt.offA[1][1] : cur.offA[1][1];
            const char* b2 = b2b + k2; const char* b3 = b2b + k3;
            GM_LDB(B0, 0, 0); GM_SCHED; GM_LDA(At, 0, 0); GM_STAGEA2(GM_SA(1, 1), cur.A, cur.offA[1][0], cur.offA[1][1], k1);
            GM_WAIT_L(8); GM_BAR; GM_WAIT_L(0); GM_MMA(0, 0, At, B0); GM_BAR; GM_SCHED;
            GM_LDB(B1, 0, 1); GM_STAGEB(GM_SB(0, 0), b2);
            GM_BAR; GM_WAIT_L(0); GM_MMA(0, 1, At, B1); GM_BAR;
            GM_LDA(At, 0, 1); GM_STAGEA2(GM_SA(0, 0), a2b, o00, o01, k2);
            GM_BAR; GM_WAIT_L(0); GM_MMA(1, 0, At, B0); GM_BAR; GM_SCHED;
            GM_STAGEB(GM_SB(0, 1), b2 + hstep);
            GM_WAIT_V(6); GM_BAR; GM_MMA(1, 1, At, B1); GM_BAR;
            GM_LDB(B0, 1, 0); GM_SCHED; GM_LDA(At, 1, 0); GM_STAGEA2(GM_SA(0, 1), a2b, o10, o11, k2);
            GM_WAIT_L(8); GM_BAR; GM_WAIT_L(0); GM_MMA(0, 0, At, B0); GM_BAR; GM_SCHED;
            GM_LDB(B1, 1, 1); GM_STAGEB(GM_SB(1, 0), b3);
            GM_BAR; GM_WAIT_L(0); GM_MMA(0, 1, At, B1); GM_BAR;
            GM_LDA(At, 1, 1); GM_STAGEA2(GM_SA(1, 0), a2b, o00, o01, k3);
            GM_BAR; GM_WAIT_L(0); GM_MMA(1, 0, At, B0); GM_BAR; GM_SCHED;
            GM_STAGEB(GM_SB(1, 1), b3 + hstep);
            GM_WAIT_V(6); GM_BAR; GM_MMA(1, 1, At, B1); GM_BAR;
        }
        E(acc, cur, wr, wc, fr, fq);
        if (!has_next) break;
#pragma unroll
        for (int a = 0; a < 2; ++a)
#pragma unroll
            for (int b = 0; b < 2; ++b)
#pragma unroll
                for (int m = 0; m < 4; ++m)
#pragma unroll
                    for (int n = 0; n < 2; ++n) acc[a][b][m][n] = (f32x4){0.f, 0.f, 0.f, 0.f};
        cur = nxt; ++ui;
    }
    GM_WAIT_V(0);
    if (wr == 0) GM_BAR;
    GM_BAR;
#undef GM_SA
#undef GM_SB
#undef GM_STAGEA2
#undef GM_STAGEB
#undef GM_LDA
#undef GM_LDB
#undef GM_MMA
#undef GM_WAIT_V
#undef GM_WAIT_L
#undef GM_BAR
#undef GM_SCHED
}
__device__ __forceinline__ void dense_offA(unsigned (&offA)[2][2], long row0, int K) {
    int tid = threadIdx.x; asm volatile("" : "+v"(tid));
#pragma unroll
    for (int i = 0; i < 2; ++i) { int R, C; stage_rc(tid * 16 + i * 8192, R, C);
#pragma unroll
        for (int h = 0; h < 2; ++h) offA[h][i] = (unsigned)(((row0 + h * HALF + R) * K + C) * 2); }
}
}

struct FW {
    bf16_t *w_in_t, *w_out_t, *gu_t, *d_t;
    bf16_t *hb1, *hb2, *mixb, *actb, *yb;
    float *proj2, *mix2;
    bf16_t *w_uq_t, *w_ukv_t;
    float *ropec, *ropes;
    bf16_t *qb2, *kb2, *vb2;
    bf16_t* opart; float* aml;
    float *yd2, *st2, *cdec2, *cs2; bf16_t *cg, *prevb, *ssdb2;
};
constexpr int INC_PAD = 1792;
template <int MAP> __device__ __forceinline__ void cvt_tile(const float* src, int ldn, int nvalid, bf16_t* dst, int K, int k0, int n0, float* T) {
    int tid = threadIdx.x; asm volatile("" : "+v"(tid)); const int r = tid >> 4, c4 = (tid & 15) * 4;
#pragma unroll
    for (int i = 0; i < 2; ++i) { const int kk = r + 32 * i; float4 v = make_float4(0.f, 0.f, 0.f, 0.f);
        if (n0 + c4 < nvalid) v = *(const float4*)(src + (size_t)(k0 + kk) * ldn + n0 + c4);
        T[kk * 65 + c4 + 0] = v.x; T[kk * 65 + c4 + 1] = v.y; T[kk * 65 + c4 + 2] = v.z; T[kk * 65 + c4 + 3] = v.w; }
    __syncthreads();
    { const int n = tid >> 3, kc = tid & 7; float f[8];
#pragma unroll
        for (int j = 0; j < 8; ++j) f[j] = T[(kc * 8 + j) * 65 + n];
        gm::u32x4 w; w.x = gm::cvt_pk_bf16(f[0], f[1]); w.y = gm::cvt_pk_bf16(f[2], f[3]); w.z = gm::cvt_pk_bf16(f[4], f[5]); w.w = gm::cvt_pk_bf16(f[6], f[7]);
        const int nn = n0 + n; const int drow = MAP == 0 ? nn : ((nn >> 7) * 256 + (MAP == 2 ? 128 : 0) + (nn & 127));
        *(gm::u32x4*)(dst + (size_t)drow * K + k0 + kc * 8) = w; }
    __syncthreads();
}
template <int MAP> __device__ __forceinline__ void cvt_strip(const float* src, int ldn, int nvalid, bf16_t* dst, int K, int k0, int n0, float* T) {
    int tid = threadIdx.x; asm volatile("" : "+v"(tid)); const int r = tid >> 4, c4 = (tid & 15) * 4;
    float4 v[4][2];
#pragma unroll
    for (int t = 0; t < 4; ++t)
#pragma unroll
        for (int i = 0; i < 2; ++i) { v[t][i] = make_float4(0.f, 0.f, 0.f, 0.f); if (n0 + t * 64 + c4 < nvalid) v[t][i] = *(const float4*)(src + (size_t)(k0 + r + 32 * i) * ldn + n0 + t * 64 + c4); }
#pragma unroll
    for (int t = 0; t < 4; ++t)
#pragma unroll
        for (int i = 0; i < 2; ++i) { float* q = T + t * (64 * 65) + (r + 32 * i) * 65 + c4; q[0] = v[t][i].x; q[1] = v[t][i].y; q[2] = v[t][i].z; q[3] = v[t][i].w; }
    __syncthreads();
    { const int n = tid >> 3, kc = tid & 7;
#pragma unroll
        for (int t = 0; t < 4; ++t) { float f[8];
#pragma unroll
            for (int j = 0; j < 8; ++j) f[j] = T[t * (64 * 65) + (kc * 8 + j) * 65 + n];
            gm::u32x4 w; w.x = gm::cvt_pk_bf16(f[0], f[1]); w.y = gm::cvt_pk_bf16(f[2], f[3]); w.z = gm::cvt_pk_bf16(f[4], f[5]); w.w = gm::cvt_pk_bf16(f[6], f[7]);
            const int nn = n0 + t * 64 + n; const int drow = MAP == 0 ? nn : ((nn >> 7) * 256 + (MAP == 2 ? 128 : 0) + (nn & 127));
            *(gm::u32x4*)(dst + (size_t)drow * K + k0 + kc * 8) = w; } }
    __syncthreads();
}
__device__ __forceinline__ void cvt_phase(const P& p, const FW& f, int l0, int l1, char* lds) {
    float* T = (float*)lds;
    constexpr int T_IN = 16 * 7, T_OUT = 16 * 4, T_E = 16 * 4, T_UQ = 4 * 9, T_UKV = 2 * 12, T_LAYER = T_IN + T_OUT + T_UQ + T_UKV + NE * 3 * T_E;
    const int total = (l1 - l0) * T_LAYER;
    if (blockIdx.x == gridDim.x - 1) for (int i = threadIdx.x; i < 256 * 8; i += 512) { float cs, sn; sincos_rr((float)(i >> 3) * rope_inv_freq(i & 7), cs, sn); f.ropec[i] = cs; f.ropes[i] = sn; }
    for (int t = blockIdx.x; t < total; t += gridDim.x) {
        const int l = l0 + t / T_LAYER; int r = t % T_LAYER;
        if (r < T_IN) { const int kt = r / 7, ntl = r % 7; cvt_strip<0>(p.w_in + (size_t)l * D * INC, INC, INC, f.w_in_t + (size_t)l * INC_PAD * D, D, kt * 64, ntl * 256, T); continue; }
        r -= T_IN;
        if (r < T_OUT) { const int kt = r / 4, ntl = r % 4; cvt_strip<0>(p.w_out + (size_t)l * MIXW * D, D, D, f.w_out_t + (size_t)l * D * MIXW, MIXW, kt * 64, ntl * 256, T); continue; }
        r -= T_OUT;
        if (r < T_UQ) { const int kt = r / 9, ntl = r % 9; cvt_tile<0>(p.w_uq + (size_t)l * QL * NH * QKD, NH * QKD, NH * QKD, f.w_uq_t + (size_t)l * NH * QKD * QL, QL, kt * 64, ntl * 64, T); continue; }
        r -= T_UQ;
        if (r < T_UKV) { const int kt = r / 12, ntl = r % 12; cvt_tile<0>(p.w_ukv + (size_t)l * KVL * NH * 128, NH * 128, NH * 128, f.w_ukv_t + (size_t)l * NH * 128 * KVL, KVL, kt * 64, ntl * 64, T); continue; }
        r -= T_UKV;
        const int e = r / (3 * T_E), which = (r / T_E) % 3, tt = r % T_E, kt = tt / 4, ntl = tt % 4; const size_t le = (size_t)l * NE + e;
        if (which == 0) cvt_strip<1>(p.wg + le * D * FF, FF, FF, f.gu_t + le * 2 * FF * D, D, kt * 64, ntl * 256, T);
        else if (which == 1) cvt_strip<2>(p.wu + le * D * FF, FF, FF, f.gu_t + le * 2 * FF * D, D, kt * 64, ntl * 256, T);
        else cvt_strip<0>(p.wd + le * FF * D, D, D, f.d_t + le * D * FF, FF, kt * 64, ntl * 256, T);
    }
}
struct UDense { const char* A; unsigned offA[2][2]; const char* B; int pm, pn; };
__device__ __forceinline__ void inproj_phase(const P& p, const FW& f, int l, float* dst, char* lds) {
    constexpr int NPN = INC_PAD / 256, NU = (M / 256) * NPN;
    auto sched = [&](int i, UDense& u) { const int uu = blockIdx.x + i * gridDim.x; if (uu >= NU) return false; u.pm = uu / NPN; u.pn = uu % NPN; u.A = (const char*)f.hb1; gm::dense_offA(u.offA, (long)u.pm * 256, D);
        u.B = (const char*)(f.w_in_t + ((size_t)l * INC_PAD + u.pn * 256) * D); return true; };
    auto epi = [&](const gm::f32x4 (&acc)[2][2][4][2], const UDense& u, int wr, int wc, int fr, int fq) {
        const int row0 = u.pm * 256 + wr * 64 + fr, col0 = u.pn * 256 + wc * 32 + 4 * fq;
#pragma unroll
        for (int ai = 0; ai < 2; ++ai)
#pragma unroll
            for (int m = 0; m < 4; ++m) { float* rowp = dst + (size_t)(row0 + ai * 128 + m * 16) * INC + col0;
#pragma unroll
                for (int bj = 0; bj < 2; ++bj)
#pragma unroll
                    for (int n = 0; n < 2; ++n) if (col0 + bj * 128 + n * 16 < INC) *(gm::f32x4*)(rowp + bj * 128 + n * 16) = acc[ai][bj][m][n]; } };
    gm::gemm_stream<false, UDense>((GM_LAS unsigned char*)lds, D, sched, epi);
}
template <bool TOX> __device__ __forceinline__ void outproj_phase(const P& p, const FW& f, int l, float* dst, char* lds) {
    constexpr int NPN = D / 256, NU = (M / 256) * NPN;
    auto sched = [&](int i, UDense& u) { const int uu = blockIdx.x + i * gridDim.x; if (uu >= NU) return false; u.pm = uu / NPN; u.pn = uu % NPN; u.A = (const char*)f.mixb; gm::dense_offA(u.offA, (long)u.pm * 256, MIXW);
        u.B = (const char*)(f.w_out_t + ((size_t)l * D + u.pn * 256) * MIXW); return true; };
    auto epi = [&](const gm::f32x4 (&acc)[2][2][4][2], const UDense& u, int wr, int wc, int fr, int fq) {
        const int row0 = u.pm * 256 + wr * 64 + fr, col0 = u.pn * 256 + wc * 32 + 4 * fq; const float* gate = modv(p, l, u.pm * 256, 2);
#pragma unroll
        for (int ai = 0; ai < 2; ++ai)
#pragma unroll
            for (int m = 0; m < 4; ++m) { float* rowp = dst + (size_t)(row0 + ai * 128 + m * 16) * D + col0;
#pragma unroll
                for (int bj = 0; bj < 2; ++bj)
#pragma unroll
                    for (int n = 0; n < 2; ++n) { float* q = rowp + bj * 128 + n * 16;
                        if (TOX) { const gm::f32x4 g = *(const gm::f32x4*)(gate + col0 + bj * 128 + n * 16); const gm::f32x4 x = *(const gm::f32x4*)q; *(gm::f32x4*)q = x + g * acc[ai][bj][m][n]; }
                        else *(gm::f32x4*)q = acc[ai][bj][m][n]; } } };
    gm::gemm_stream<false, UDense>((GM_LAS unsigned char*)lds, MIXW, sched, epi);
}
__device__ __forceinline__ bool moe_find(const int* cnt, int tg, int& e, int& ti, int& c) {
    int acc = 0;
    for (int x = 0; x < NE; ++x) { const int cx = cnt[x]; const int nt = (cx + 255) >> 8; if (tg < acc + nt) { e = x; ti = tg - acc; c = cx; return true; } acc += nt; }
    return false;
}
__device__ __forceinline__ int moe_tiles(const int* cnt) { int acc = 0; for (int x = 0; x < NE; ++x) acc += (cnt[x] + 255) >> 8; return acc; }
template <bool SRC_TOK> __device__ __forceinline__ void gather_offA(unsigned (&offA)[2][2], const int* lst, int base, int cnt, int K) {
    int tid = threadIdx.x; asm volatile("" : "+v"(tid));
#pragma unroll
    for (int i = 0; i < 2; ++i) { int R, C; gm::stage_rc(tid * 16 + i * 8192, R, C);
#pragma unroll
        for (int h = 0; h < 2; ++h) { const int s = base + h * 128 + R; int a = s < cnt ? lst[s] : 0; if (SRC_TOK) a >>= 2; offA[h][i] = (unsigned)(((size_t)a * K + C) * 2); } }
}
__device__ __forceinline__ void moe1_phase(const P& p, const FW& f, int l, char* lds) {
    constexpr int NPN = 2 * FF / 256; const int NU = moe_tiles(p.cnt) * NPN;
    for (int u = blockIdx.x; u < NU; u += gridDim.x) {
        int e, ti, cnt; if (!moe_find(p.cnt, u / NPN, e, ti, cnt)) break; const int pn = u % NPN; const int* lst = p.list + (size_t)e * M; const size_t le = (size_t)l * NE + e;
        unsigned offA[2][2]; gather_offA<true>(offA, lst, ti * 256, cnt, D);
        auto epi = [&](const gm::f32x4 (&acc)[2][2][4][2], int wr, int wc, int fr, int fq) {
            const int ff0 = pn * 128 + wc * 32 + 8 * fq; const float* bgp = p.bg + le * FF + ff0; const float* bup = p.bu + le * FF + ff0;
            const gm::f32x4 bg0 = *(const gm::f32x4*)bgp, bg1 = *(const gm::f32x4*)(bgp + 4), bu0 = *(const gm::f32x4*)bup, bu1 = *(const gm::f32x4*)(bup + 4);
#pragma unroll
            for (int ai = 0; ai < 2; ++ai)
#pragma unroll
                for (int m = 0; m < 4; ++m) { const int s = ti * 256 + ai * 128 + wr * 64 + m * 16 + fr; if (s < cnt) { const int a = lst[s]; float o[8];
#pragma unroll
                        for (int n = 0; n < 2; ++n)
#pragma unroll
                            for (int j = 0; j < 4; ++j) { float g = acc[ai][0][m][n][j] + (n ? bg1[j] : bg0[j]); float uu = acc[ai][1][m][n][j] + (n ? bu1[j] : bu0[j]);
                                g = g < 7.0f ? g : 7.0f; uu = uu < -7.0f ? -7.0f : (uu > 7.0f ? 7.0f : uu); o[n * 4 + j] = g * (1.0f / (1.0f + __expf(-1.702f * g))) * (uu + 1.0f); }
                        gm::u32x4 w; w.x = gm::cvt_pk_bf16(o[0], o[1]); w.y = gm::cvt_pk_bf16(o[2], o[3]); w.z = gm::cvt_pk_bf16(o[4], o[5]); w.w = gm::cvt_pk_bf16(o[6], o[7]);
                        *(gm::u32x4*)(f.actb + (size_t)a * FF + ff0) = w; } } };
        gm::gemm_unit<true>((GM_LAS unsigned char*)lds, (const char*)f.hb2, offA, (const char*)(f.gu_t + (le * 2 * FF + pn * 256) * D), D, epi);
    }
}
__device__ __forceinline__ void moe2_phase(const P& p, const FW& f, int l, char* lds) {
    constexpr int NPN = D / 256; const int NU = moe_tiles(p.cnt) * NPN;
    for (int u = blockIdx.x; u < NU; u += gridDim.x) {
        int e, ti, cnt; if (!moe_find(p.cnt, u / NPN, e, ti, cnt)) break; const int pn = u % NPN; const int* lst = p.list + (size_t)e * M; const size_t le = (size_t)l * NE + e;
        unsigned offA[2][2]; gather_offA<false>(offA, lst, ti * 256, cnt, FF);
        auto epi = [&](const gm::f32x4 (&acc)[2][2][4][2], int wr, int wc, int fr, int fq) {
#pragma unroll
            for (int bj = 0; bj < 2; ++bj) { const int c0 = pn * 256 + bj * 128 + wc * 32 + 8 * fq; const float* bp = p.bd + le * D + c0; const gm::f32x4 b0 = *(const gm::f32x4*)bp, b1 = *(const gm::f32x4*)(bp + 4);
#pragma unroll
                for (int ai = 0; ai < 2; ++ai)
#pragma unroll
                    for (int m = 0; m < 4; ++m) { const int s = ti * 256 + ai * 128 + wr * 64 + m * 16 + fr; if (s < cnt) { const int a = lst[s];
                            const gm::f32x4 v0 = acc[ai][bj][m][0] + b0, v1 = acc[ai][bj][m][1] + b1;
                            gm::u32x4 w; w.x = gm::cvt_pk_bf16(v0[0], v0[1]); w.y = gm::cvt_pk_bf16(v0[2], v0[3]); w.z = gm::cvt_pk_bf16(v1[0], v1[1]); w.w = gm::cvt_pk_bf16(v1[2], v1[3]);
                            *(gm::u32x4*)(f.yb + (size_t)a * D + c0) = w; } } } };
        gm::gemm_unit<true>((GM_LAS unsigned char*)lds, (const char*)f.actb, offA, (const char*)(f.d_t + (le * D + pn * 256) * FF), FF, epi);
    }
}

namespace rw {
typedef float f32x4 __attribute__((ext_vector_type(4)));
typedef unsigned u32x2 __attribute__((ext_vector_type(2)));
constexpr int ROWS_PB = 65;
__device__ __forceinline__ float wave_sum(float v) {
#pragma unroll
    for (int o = 32; o >= 1; o >>= 1) v += __shfl_xor(v, o);
    return v;
}
__device__ __forceinline__ unsigned pk2(float lo, float hi) { unsigned r; asm volatile("v_cvt_pk_bf16_f32 %0, %1, %2" : "=v"(r) : "v"(lo), "v"(hi)); return r; }
__device__ __forceinline__ f32x4 bf4(u32x2 w) { f32x4 r; r[0] = __uint_as_float(w.x << 16); r[1] = __uint_as_float(w.x & 0xffff0000u); r[2] = __uint_as_float(w.y << 16); r[3] = __uint_as_float(w.y & 0xffff0000u); return r; }
__device__ __forceinline__ void norm_store(const f32x4 (&x)[4], const float* g, const float* shift, const float* scale, bf16_t* dst, int lane) {
    float ss = 0.f;
#pragma unroll
    for (int j = 0; j < 4; ++j) ss += x[j][0] * x[j][0] + x[j][1] * x[j][1] + x[j][2] * x[j][2] + x[j][3] * x[j][3];
    ss = wave_sum(ss); const float rs = 1.0f / sqrtf(ss * (1.0f / D) + EPS);
#pragma unroll
    for (int j = 0; j < 4; ++j) { const int c = 4 * lane + 256 * j; const f32x4 gv = *(const f32x4*)(g + c), sh = *(const f32x4*)(shift + c), sc = *(const f32x4*)(scale + c);
        const f32x4 o = x[j] * rs * gv * (1.0f + sc) + sh; u32x2 w; w.x = pk2(o[0], o[1]); w.y = pk2(o[2], o[3]); *(u32x2*)(dst + c) = w; }
}
__device__ __forceinline__ void first_norm_phase(const P& p) {
    int tid = threadIdx.x; asm volatile("" : "+v"(tid)); const int wid = tid >> 6, lane = tid & 63;
    for (int i = wid; i < ROWS_PB; i += 8) { const int r = blockIdx.x * ROWS_PB + i; if (r >= M) break;
        const float* src = r < CTX ? p.ctx + (size_t)r * D : p.x + (size_t)(r - CTX) * D; f32x4 x[4];
#pragma unroll
        for (int j = 0; j < 4; ++j) { x[j] = *(const f32x4*)(src + 4 * lane + 256 * j); *(f32x4*)(p.xres + (size_t)r * D + 4 * lane + 256 * j) = x[j]; }
        norm_store(x, p.norm1_g, modv(p, 0, r, 0), modv(p, 0, r, 1), p.hb1 + (size_t)r * D, lane); }
}
template <bool DRY = false> __device__ __forceinline__ void combine_phase(const P& p, int l) {
    int tid = threadIdx.x; asm volatile("" : "+v"(tid)); const int wid = tid >> 6, lane = tid & 63;
    for (int i = wid; i < ROWS_PB; i += 8) { const int r = blockIdx.x * ROWS_PB + i; if (r >= M) break;
        const f32x4 tw = *(const f32x4*)(p.topw + (size_t)r * 4); const float* gate = modv(p, l, r, 5); f32x4 x[4];
#pragma unroll
        for (int j = 0; j < 4; ++j) { const int c = 4 * lane + 256 * j; f32x4 s = {0.f, 0.f, 0.f, 0.f};
#pragma unroll
            for (int k = 0; k < 4; ++k) s += bf4(*(const u32x2*)(p.ybn + ((size_t)r * 4 + k) * D + c)) * tw[k];
            x[j] = *(const f32x4*)(p.xres + (size_t)r * D + c) + *(const f32x4*)(gate + c) * s; }
        if (l + 1 < DEPTH) {
#pragma unroll
            for (int j = 0; j < 4; ++j) if (!DRY) *(f32x4*)(p.xres + (size_t)r * D + 4 * lane + 256 * j) = x[j];
            norm_store(x, p.norm1_g + (size_t)(l + 1) * D, modv(p, l + 1, r, 0), modv(p, l + 1, r, 1), p.hb1 + (size_t)r * D, lane);
        } else if (r >= CTX) {
#pragma unroll
            for (int j = 0; j < 4; ++j) *(f32x4*)(p.out + (size_t)(r - CTX) * D + 4 * lane + 256 * j) = x[j];
        } }
}
template <bool DRY = false> __device__ __forceinline__ void router_phase(const P& p, int l, char* lds) {
    int tid = threadIdx.x; asm volatile("" : "+v"(tid)); const int wid = tid >> 6, lane = tid & 63;
    float* WT = (float*)lds; float* bias2 = WT + 32 * 1024; int* lcnt = (int*)(bias2 + 64); int* lbase = lcnt + 32; int* rec = lbase + 32;
    const float* rwp = p.router_w + (size_t)l * D * NE;
    for (int i = tid; i < D * NE / 4; i += 512) { const int k = i >> 3, e4 = i & 7; const f32x4 v = *(const f32x4*)(rwp + (size_t)k * NE + e4 * 4);
#pragma unroll
        for (int q = 0; q < 4; ++q) WT[(e4 * 4 + q) * 1024 + (k ^ (e4 << 2))] = v[q]; }
    if (tid < 32) lcnt[tid] = 0;
    __syncthreads();
    {
#pragma unroll
        for (int v = 0; v < 2; ++v) { const float* sh = p.mod + ((size_t)(l * 2 + v) * 6 + 3) * D; f32x4 s[4];
#pragma unroll
            for (int j = 0; j < 4; ++j) s[j] = *(const f32x4*)(sh + 4 * lane + 256 * j);
#pragma unroll
            for (int q = 0; q < 4; ++q) { const int e = wid * 4 + q; float a = 0.f;
#pragma unroll
                for (int j = 0; j < 4; ++j) { const f32x4 w = *(const f32x4*)(WT + e * 1024 + ((4 * lane + 256 * j) ^ (((e >> 2) & 7) << 2))); a += w[0] * s[j][0] + w[1] * s[j][1] + w[2] * s[j][2] + w[3] * s[j][3]; }
                a = wave_sum(a); if (lane == 0) bias2[v * 32 + e] = a + p.router_b[l * NE + e]; } }
    }
    __syncthreads();
    const float* g2 = p.norm2_g + (size_t)l * D;
    for (int rp = wid; rp < (ROWS_PB + 1) / 2; rp += 8) {
        float acc[2][32]; float rsv[2]; int rr[2];
        f32x4 xg[2][4];
#pragma unroll
        for (int q = 0; q < 2; ++q) { const int il = 2 * rp + q; const int r = blockIdx.x * ROWS_PB + (il < ROWS_PB ? il : ROWS_PB - 1); rr[q] = r;
            const float* sc = modv(p, l, r, 4); const float* sh = modv(p, l, r, 3); float ss = 0.f; f32x4 x[4];
#pragma unroll
            for (int j = 0; j < 4; ++j) { x[j] = *(const f32x4*)(p.xres + (size_t)r * D + 4 * lane + 256 * j); ss += x[j][0] * x[j][0] + x[j][1] * x[j][1] + x[j][2] * x[j][2] + x[j][3] * x[j][3]; }
            ss = wave_sum(ss); const float rs = 1.0f / sqrtf(ss * (1.0f / D) + EPS); rsv[q] = rs;
#pragma unroll
            for (int j = 0; j < 4; ++j) { const int c = 4 * lane + 256 * j; xg[q][j] = x[j] * *(const f32x4*)(g2 + c) * (1.0f + *(const f32x4*)(sc + c));
                const f32x4 o = xg[q][j] * rs + *(const f32x4*)(sh + c); u32x2 w; w.x = pk2(o[0], o[1]); w.y = pk2(o[2], o[3]); if (il < ROWS_PB) *(u32x2*)(p.hb2 + (size_t)r * D + c) = w; }
        }
#pragma unroll
        for (int e = 0; e < 32; ++e) { float a0 = 0.f, a1 = 0.f;
#pragma unroll
            for (int j = 0; j < 4; ++j) { const f32x4 w = *(const f32x4*)(WT + e * 1024 + ((4 * lane + 256 * j) ^ (((e >> 2) & 7) << 2)));
                a0 += w[0] * xg[0][j][0] + w[1] * xg[0][j][1] + w[2] * xg[0][j][2] + w[3] * xg[0][j][3]; a1 += w[0] * xg[1][j][0] + w[1] * xg[1][j][1] + w[2] * xg[1][j][2] + w[3] * xg[1][j][3]; }
            acc[0][e] = a0; acc[1][e] = a1; }
        float v[64];
#pragma unroll
        for (int e = 0; e < 32; ++e) { v[e] = acc[0][e]; v[32 + e] = acc[1][e]; }
#pragma unroll
        for (int m = 32, n = 64; m >= 1; m >>= 1, n >>= 1) {
#pragma unroll
            for (int i = 0; i < n / 2; ++i) { const bool up = (lane & m) != 0; const float keep = up ? v[i + n / 2] : v[i], send = up ? v[i] : v[i + n / 2]; v[i] = keep + __shfl_xor(send, m); } }
        const int q = lane >> 5, e = lane & 31; const int r = rr[q]; const int il = 2 * rp + q;
        float logit = v[0] * rsv[q] + bias2[(r < CTX ? 32 : 0) + e];
        float cur = logit; int sel[4]; float sv[4];
#pragma unroll
        for (int k = 0; k < 4; ++k) { float mx = cur;
#pragma unroll
            for (int o = 16; o >= 1; o >>= 1) mx = fmaxf(mx, __shfl_xor(mx, o));
            const unsigned long long bal = __ballot(cur == mx); const unsigned half = (unsigned)(bal >> (q * 32)); const int win = __ffs(half) - 1;
            sel[k] = win; sv[k] = mx; if (e == win) cur = -3.0e38f; }
        if (e < 4 && il < ROWS_PB) {
            float es[4], sum = 0.f;
#pragma unroll
            for (int k = 0; k < 4; ++k) { es[k] = __expf(sv[k] - sv[0]); sum += es[k]; }
            const int myk = e; const int mye = myk == 0 ? sel[0] : myk == 1 ? sel[1] : myk == 2 ? sel[2] : sel[3]; const float myw = (myk == 0 ? es[0] : myk == 1 ? es[1] : myk == 2 ? es[2] : es[3]) / sum;
            if (!DRY) p.topw[(size_t)r * 4 + myk] = myw; const int pos = atomicAdd(&lcnt[mye], 1); rec[il * 4 + myk] = mye | (pos << 8);
        }
    }
    __syncthreads();
    if (tid < 32) lbase[tid] = DRY ? 0 : atomicAdd(&p.cnt[tid], lcnt[tid]);
    __syncthreads();
    if (tid < ROWS_PB * 4) { const int il = tid >> 2, k = tid & 3; const int r = blockIdx.x * ROWS_PB + il; const int rc = rec[tid]; const int e = rc & 255, pos = rc >> 8;
        if (!DRY) p.list[(size_t)e * M + lbase[e] + pos] = r * 4 + k; }
    __syncthreads();
}
}

namespace ml {
typedef short bf16x8 __attribute__((ext_vector_type(8)));
typedef float f32x4 __attribute__((ext_vector_type(4)));
typedef unsigned u32x2 __attribute__((ext_vector_type(2)));
constexpr int RB = 65, MT = 5;
constexpr int AQ_STRIDE = QL * 2 + 16, AKV_STRIDE = KVL * 2 + 16;
constexpr int OFF_AQ = 0, OFF_AKV = OFF_AQ + 80 * AQ_STRIDE, OFF_KRS = OFF_AKV + 80 * AKV_STRIDE, OFF_KSS = OFF_KRS + 80 * 32 * 4, LDS_MLA = OFF_KSS + 80 * 4;
struct MW { const bf16_t* w_uq_t; const bf16_t* w_ukv_t; const float* ropec; const float* ropes; const float* proj; int ldp; bf16_t* qb; bf16_t* kb; bf16_t* vb; };
__device__ __forceinline__ void mla_phase(const P& p, const MW& w, int l, char* lds) {
    int tid = threadIdx.x; asm volatile("" : "+v"(tid)); const int wid = __builtin_amdgcn_readfirstlane(tid >> 6), lane = tid & 63, fr = lane & 15, fq = lane >> 4;
    const int row0 = blockIdx.x * RB;
    for (int i = wid; i < 80; i += 8) {
        char* aq = lds + OFF_AQ + i * AQ_STRIDE; char* akv = lds + OFF_AKV + i * AKV_STRIDE; float* krs = (float*)(lds + OFF_KRS) + i * 32;
        if (i < RB && row0 + i < M) { const float* pr = w.proj + (size_t)(row0 + i) * w.ldp;
            { const f32x4 x = *(const f32x4*)(pr + C_Q + 4 * lane); float ss = rw::wave_sum(x[0] * x[0] + x[1] * x[1] + x[2] * x[2] + x[3] * x[3]); const float rs = 1.0f / sqrtf(ss * (1.0f / QL) + EPS);
              const f32x4 g = *(const f32x4*)(p.q_g + l * QL + 4 * lane); const f32x4 o = x * rs * g; u32x2 v; v.x = rw::pk2(o[0], o[1]); v.y = rw::pk2(o[2], o[3]); *(u32x2*)(aq + 8 * lane) = v; }
            { f32x4 x = {0.f, 0.f, 0.f, 0.f}; if (lane < 32) x = *(const f32x4*)(pr + C_KV + 4 * lane); float ss = rw::wave_sum(x[0] * x[0] + x[1] * x[1] + x[2] * x[2] + x[3] * x[3]); const float rs = 1.0f / sqrtf(ss * (1.0f / KVL) + EPS);
              if (lane < 32) { const f32x4 g = *(const f32x4*)(p.kv_g + l * KVL + 4 * lane); const f32x4 o = x * rs * g; u32x2 v; v.x = rw::pk2(o[0], o[1]); v.y = rw::pk2(o[2], o[3]); *(u32x2*)(akv + 8 * lane) = v; } }
            { f32x4 x = {0.f, 0.f, 0.f, 0.f}; if (lane < 8) { x = *(const f32x4*)(pr + C_KR + 4 * lane); *(f32x4*)(krs + 4 * lane) = x; }
              const float ss = rw::wave_sum(x[0] * x[0] + x[1] * x[1] + x[2] * x[2] + x[3] * x[3]); if (lane == 0) ((float*)(lds + OFF_KSS))[i] = ss; }
        } else {
            u32x2 z; z.x = 0u; z.y = 0u; *(u32x2*)(aq + 8 * lane) = z; if (lane < 32) *(u32x2*)(akv + 8 * lane) = z; if (lane < 32) krs[lane] = 0.f; if (lane == 0) ((float*)(lds + OFF_KSS))[i] = 0.f;
        }
    }
    __syncthreads();
    if (wid < 6) {
        const int hh = wid; f32x4 acc[MT][6];
#pragma unroll
        for (int mt = 0; mt < MT; ++mt)
#pragma unroll
            for (int nt = 0; nt < 6; ++nt) acc[mt][nt] = (f32x4){0.f, 0.f, 0.f, 0.f};
        const bf16_t* wb = w.w_uq_t + (size_t)(hh * QKD + fr) * QL + 8 * fq;
#pragma unroll 1
        for (int ks = 0; ks < QL / 32; ++ks) { bf16x8 b[6], a[MT];
#pragma unroll
            for (int nt = 0; nt < 6; ++nt) b[nt] = *(const bf16x8*)(wb + (size_t)nt * 16 * QL + ks * 32);
#pragma unroll
            for (int mt = 0; mt < MT; ++mt) a[mt] = *(const bf16x8*)(lds + OFF_AQ + (mt * 16 + fr) * AQ_STRIDE + (ks * 32 + 8 * fq) * 2);
#pragma unroll
            for (int mt = 0; mt < MT; ++mt)
#pragma unroll
                for (int nt = 0; nt < 6; ++nt) acc[mt][nt] = __builtin_amdgcn_mfma_f32_16x16x32_bf16(b[nt], a[mt], acc[mt][nt], 0, 0, 0); }
        f32x4 gq[6];
#pragma unroll
        for (int nt = 0; nt < 6; ++nt) gq[nt] = *(const f32x4*)(p.qn_g + l * QKD + nt * 16 + 4 * fq);
#pragma unroll
        for (int mt = 0; mt < MT; ++mt) { const int il = mt * 16 + fr; const int r = row0 + il; const bool ok = il < RB && r < M; float ss = 0.f;
#pragma unroll
            for (int nt = 0; nt < 6; ++nt) ss += acc[mt][nt][0] * acc[mt][nt][0] + acc[mt][nt][1] * acc[mt][nt][1] + acc[mt][nt][2] * acc[mt][nt][2] + acc[mt][nt][3] * acc[mt][nt][3];
            ss += __shfl_xor(ss, 16); ss += __shfl_xor(ss, 32); const float rs = 1.0f / sqrtf(ss * (1.0f / QKD) + EPS);
            const bool lat = r >= CTX; const int t = lat ? r - CTX : 0;
#pragma unroll
            for (int nt = 0; nt < 6; ++nt) { f32x4 v = acc[mt][nt] * rs * gq[nt];
                if (nt >= 4) { f32x4 other; other[0] = __shfl_xor(v[0], 32); other[1] = __shfl_xor(v[1], 32); other[2] = __shfl_xor(v[2], 32); other[3] = __shfl_xor(v[3], 32);
                    if (lat && ok) { const int pos = (nt == 4) ? (t / GRID_W) : (t % GRID_W); const f32x4 cs = *(const f32x4*)(w.ropec + (size_t)pos * 8 + 4 * (fq & 1)), sn = *(const f32x4*)(w.ropes + (size_t)pos * 8 + 4 * (fq & 1));
                        v = (fq >> 1) ? (v * cs + other * sn) : (v * cs - other * sn); } }
                if (ok) { u32x2 o; o.x = rw::pk2(v[0], v[1]); o.y = rw::pk2(v[2], v[3]); *(u32x2*)(w.qb + ((size_t)r * NH + hh) * QKD + nt * 16 + 4 * fq) = o; } } }
    } else {
        for (int hs = 0; hs < 3; ++hs) { const int hh = (wid - 6) * 3 + hs;
#pragma unroll
          for (int pass = 0; pass < 2; ++pass) { f32x4 acc[MT][4];
#pragma unroll
            for (int mt = 0; mt < MT; ++mt)
#pragma unroll
                for (int nt = 0; nt < 4; ++nt) acc[mt][nt] = (f32x4){0.f, 0.f, 0.f, 0.f};
            const bf16_t* wb = w.w_ukv_t + (size_t)(hh * 128 + pass * 64 + fr) * KVL + 8 * fq;
#pragma unroll 1
            for (int ks = 0; ks < KVL / 32; ++ks) { bf16x8 b[4], a[MT];
#pragma unroll
                for (int nt = 0; nt < 4; ++nt) b[nt] = *(const bf16x8*)(wb + (size_t)nt * 16 * KVL + ks * 32);
#pragma unroll
                for (int mt = 0; mt < MT; ++mt) a[mt] = *(const bf16x8*)(lds + OFF_AKV + (mt * 16 + fr) * AKV_STRIDE + (ks * 32 + 8 * fq) * 2);
#pragma unroll
                for (int mt = 0; mt < MT; ++mt)
#pragma unroll
                    for (int nt = 0; nt < 4; ++nt) acc[mt][nt] = __builtin_amdgcn_mfma_f32_16x16x32_bf16(b[nt], a[mt], acc[mt][nt], 0, 0, 0); }
            if (pass == 0) {
                f32x4 gk[4], gr[2], gro[2];
#pragma unroll
                for (int nt = 0; nt < 4; ++nt) gk[nt] = *(const f32x4*)(p.kn_g + l * QKD + nt * 16 + 4 * fq);
#pragma unroll
                for (int a = 0; a < 2; ++a) { gr[a] = *(const f32x4*)(p.kn_g + l * QKD + NOPE + a * 16 + 4 * fq); gro[a] = *(const f32x4*)(p.kn_g + l * QKD + NOPE + a * 16 + ((4 * fq) ^ 8)); }
#pragma unroll
                for (int mt = 0; mt < MT; ++mt) { const int il = mt * 16 + fr; const int r = row0 + il; const bool ok = il < RB && r < M; float ss = 0.f;
#pragma unroll
                    for (int nt = 0; nt < 4; ++nt) ss += acc[mt][nt][0] * acc[mt][nt][0] + acc[mt][nt][1] * acc[mt][nt][1] + acc[mt][nt][2] * acc[mt][nt][2] + acc[mt][nt][3] * acc[mt][nt][3];
                    ss += __shfl_xor(ss, 16); ss += __shfl_xor(ss, 32); ss += ((const float*)(lds + OFF_KSS))[il]; const float rs = 1.0f / sqrtf(ss * (1.0f / QKD) + EPS);
                    const bool lat = r >= CTX; const int t = lat ? r - CTX : 0;
                    if (ok) {
                        bf16_t* kd = w.kb + ((size_t)r * NH + hh) * QKD; const float* krs = (const float*)(lds + OFF_KRS) + il * 32;
#pragma unroll
                        for (int nt = 0; nt < 4; ++nt) { const f32x4 v = acc[mt][nt] * rs * gk[nt]; u32x2 o; o.x = rw::pk2(v[0], v[1]); o.y = rw::pk2(v[2], v[3]); *(u32x2*)(kd + nt * 16 + 4 * fq) = o; }
#pragma unroll
                        for (int a = 0; a < 2; ++a) { f32x4 v = *(const f32x4*)(krs + a * 16 + 4 * fq) * rs * gr[a]; const f32x4 other = *(const f32x4*)(krs + a * 16 + ((4 * fq) ^ 8)) * rs * gro[a];
                            if (lat) { const int pos = (a == 0) ? (t / GRID_W) : (t % GRID_W); const f32x4 cs = *(const f32x4*)(w.ropec + (size_t)pos * 8 + 4 * (fq & 1)), sn = *(const f32x4*)(w.ropes + (size_t)pos * 8 + 4 * (fq & 1));
                                v = (fq >> 1) ? (v * cs + other * sn) : (v * cs - other * sn); }
                            u32x2 o; o.x = rw::pk2(v[0], v[1]); o.y = rw::pk2(v[2], v[3]); *(u32x2*)(kd + NOPE + a * 16 + 4 * fq) = o; }
                    } }
            } else {
#pragma unroll
                for (int mt = 0; mt < MT; ++mt) { const int il = mt * 16 + fr; const int r = row0 + il; const bool ok = il < RB && r < M;
                    if (ok) { bf16_t* vd = w.vb + ((size_t)r * NH + hh) * VD;
#pragma unroll
                        for (int nt = 0; nt < 4; ++nt) { const f32x4 v = acc[mt][nt]; u32x2 o; o.x = rw::pk2(v[0], v[1]); o.y = rw::pk2(v[2], v[3]); *(u32x2*)(vd + nt * 16 + 4 * fq) = o; } } }
            }
          }
        }
    }
    __syncthreads();
}
}

namespace sd {
typedef short bf16x8 __attribute__((ext_vector_type(8)));
typedef float f32x4 __attribute__((ext_vector_type(4)));
typedef unsigned u32x2 __attribute__((ext_vector_type(2)));
typedef unsigned u32x4 __attribute__((ext_vector_type(4)));
constexpr int SBS = 144, STS = 272;
constexpr int OFF_BM = 0, OFF_CM = OFF_BM + 128 * SBS, OFF_XT = OFF_CM + 128 * SBS, OFF_BTF = OFF_XT + 64 * STS, OFF_BTB = OFF_BTF + 64 * STS, OFF_L = OFF_BTB + 64 * STS, OFF_SC = OFF_L + 128 * STS, LDS_SSD = OFF_SC + 4 * 128 * 4;
struct SsdW { const float* proj; int ldp; float* yd; float* st; float* cdec; float* cs; bf16_t* cg; bf16_t* prevb; };
__device__ __forceinline__ bf16x8 ldfrag(const char* base, int row, int stride, int kbyte) { return *(const bf16x8*)(base + row * stride + kbyte); }
__device__ __forceinline__ float silu_f(float x) { return x / (1.0f + __expf(-x)); }
__device__ __forceinline__ void chunk_unit(const P& p, const SsdW& w, int l, int c, int hh, char* lds) {
    int tid = threadIdx.x; asm volatile("" : "+v"(tid)); const int wid = __builtin_amdgcn_readfirstlane(tid >> 6), lane = tid & 63, fr = lane & 15, fq = lane >> 4;
    const int R0 = c * CHUNK, g = hh / (SH / SG); const int seg0 = R0 < CTX ? 0 : CTX, seg1 = R0 < CTX ? CTX : M;
    float* csf = (float*)(lds + OFF_SC); float* csb = csf + 128; float* dtf = csb + 128; float* dtb = dtf + 128;
    if (tid < 256) { const int r = tid & 127, d = tid >> 7; const float v = softplusf(w.proj[(size_t)(R0 + r) * w.ldp + C_DT + d * 6 + hh] + p.dt_bias[l * 12 + d * 6 + hh]); (d ? dtb : dtf)[r] = v; }
    __syncthreads();
    if (wid < 2) {
        const int d = wid; const float a = -__expf(p.a_log[l * 12 + d * 6 + hh]); const float* dts = d ? dtb : dtf; float* cso = d ? csb : csf;
        const int i0 = 2 * lane, i1 = 2 * lane + 1; const int r0 = d ? 127 - i0 : i0, r1 = d ? 127 - i1 : i1;
        const float v0 = dts[r0] * a, v1 = dts[r1] * a; float s = v0 + v1;
#pragma unroll
        for (int o = 1; o < 64; o <<= 1) { const float t = __shfl_up(s, o); if (lane >= o) s += t; }
        const float excl = s - (v0 + v1); const float c0 = excl + v0, c1 = c0 + v1; cso[r0] = c0; cso[r1] = c1;
        w.cs[((size_t)d * M + R0 + r0) * SH + hh] = c0; w.cs[((size_t)d * M + R0 + r1) * SH + hh] = c1;
        if (lane == 63) w.cdec[((size_t)d * NCH + c) * SH + hh] = __expf(c1);
    }
    __syncthreads();
    {   const int col = tid & 63, l0 = (tid >> 6) * 16; const float cfe = csf[127], cbe = csb[0];
#pragma unroll
        for (int which = 0; which < 3; ++which) { const int cidx = which == 0 ? hh * SP + col : (which == 1 ? SW + g * SN + col : SW + SG * SN + g * SN + col);
            const float w0 = p.conv_w[((size_t)l * 4 + 0) * CONVD + cidx], w1 = p.conv_w[((size_t)l * 4 + 1) * CONVD + cidx], w2 = p.conv_w[((size_t)l * 4 + 2) * CONVD + cidx], w3 = p.conv_w[((size_t)l * 4 + 3) * CONVD + cidx], bb = p.conv_b[l * CONVD + cidx];
            float v[19];
#pragma unroll
            for (int i = 0; i < 19; ++i) { const int r = R0 + l0 - 2 + i; v[i] = (r >= seg0 && r < seg1) ? w.proj[(size_t)r * w.ldp + C_XBC + cidx] : 0.f; }
            float y[16];
#pragma unroll
            for (int i = 0; i < 16; ++i) y[i] = silu_f(bb + w0 * v[i] + w1 * v[i + 1] + w2 * v[i + 2] + w3 * v[i + 3]);
            if (which == 0) {
                u32x4 a, b; a.x = rw::pk2(y[0], y[1]); a.y = rw::pk2(y[2], y[3]); a.z = rw::pk2(y[4], y[5]); a.w = rw::pk2(y[6], y[7]); b.x = rw::pk2(y[8], y[9]); b.y = rw::pk2(y[10], y[11]); b.z = rw::pk2(y[12], y[13]); b.w = rw::pk2(y[14], y[15]);
                *(u32x4*)(lds + OFF_XT + col * STS + l0 * 2) = a; *(u32x4*)(lds + OFF_XT + col * STS + l0 * 2 + 16) = b;
            } else if (which == 1) {
                float yf[16], yb[16];
#pragma unroll
                for (int i = 0; i < 16; ++i) { *(bf16_t*)(lds + OFF_BM + (l0 + i) * SBS + col * 2) = f2bf(y[i]); yf[i] = y[i] * __expf(cfe - csf[l0 + i]) * dtf[l0 + i]; yb[i] = y[i] * __expf(cbe - csb[l0 + i]) * dtb[l0 + i]; }
                u32x4 a, b; a.x = rw::pk2(yf[0], yf[1]); a.y = rw::pk2(yf[2], yf[3]); a.z = rw::pk2(yf[4], yf[5]); a.w = rw::pk2(yf[6], yf[7]); b.x = rw::pk2(yf[8], yf[9]); b.y = rw::pk2(yf[10], yf[11]); b.z = rw::pk2(yf[12], yf[13]); b.w = rw::pk2(yf[14], yf[15]);
                *(u32x4*)(lds + OFF_BTF + col * STS + l0 * 2) = a; *(u32x4*)(lds + OFF_BTF + col * STS + l0 * 2 + 16) = b;
                a.x = rw::pk2(yb[0], yb[1]); a.y = rw::pk2(yb[2], yb[3]); a.z = rw::pk2(yb[4], yb[5]); a.w = rw::pk2(yb[6], yb[7]); b.x = rw::pk2(yb[8], yb[9]); b.y = rw::pk2(yb[10], yb[11]); b.z = rw::pk2(yb[12], yb[13]); b.w = rw::pk2(yb[14], yb[15]);
                *(u32x4*)(lds + OFF_BTB + col * STS + l0 * 2) = a; *(u32x4*)(lds + OFF_BTB + col * STS + l0 * 2 + 16) = b;
            } else {
#pragma unroll
                for (int i = 0; i < 16; ++i) { const bf16_t cv = f2bf(y[i]); *(bf16_t*)(lds + OFF_CM + (l0 + i) * SBS + col * 2) = cv; if (hh % (SH / SG) == 0) w.cg[((size_t)(R0 + l0 + i) * SG + g) * SN + col] = cv; }
            } }
    }
    __syncthreads();
    {   const int lt = wid, lrow = 16 * lt + fr; const bf16x8 c0 = ldfrag(lds + OFF_CM, lrow, SBS, 16 * fq), c1 = ldfrag(lds + OFF_CM, lrow, SBS, 64 + 16 * fq);
        const float cfl = csf[lrow], cbl = csb[lrow], Dh = p.ssd_d[l * SH + hh];
#pragma unroll
        for (int st = 0; st < 8; ++st) { const bf16x8 b0 = ldfrag(lds + OFF_BM, 16 * st + fr, SBS, 16 * fq), b1 = ldfrag(lds + OFF_BM, 16 * st + fr, SBS, 64 + 16 * fq);
            f32x4 acc = {0.f, 0.f, 0.f, 0.f}; acc = __builtin_amdgcn_mfma_f32_16x16x32_bf16(b0, c0, acc, 0, 0, 0); acc = __builtin_amdgcn_mfma_f32_16x16x32_bf16(b1, c1, acc, 0, 0, 0);
            const int s0 = 16 * st + 4 * fq; const f32x4 cfs = *(const f32x4*)(csf + s0), cbs = *(const f32x4*)(csb + s0), dfs = *(const f32x4*)(dtf + s0), dbs = *(const f32x4*)(dtb + s0); float o[4];
#pragma unroll
            for (int j = 0; j < 4; ++j) { const int s = s0 + j; const float ef = s <= lrow ? __expf(fminf(cfl - cfs[j], 0.f)) * dfs[j] : 0.f; const float eb = s >= lrow ? __expf(fminf(cbl - cbs[j], 0.f)) * dbs[j] : 0.f;
                o[j] = acc[j] * (ef + eb) + (s == lrow ? Dh : 0.f); }
            u32x2 pk; pk.x = rw::pk2(o[0], o[1]); pk.y = rw::pk2(o[2], o[3]); *(u32x2*)(lds + OFF_L + lrow * STS + s0 * 2) = pk; }
    }
    __syncthreads();
    {   const int lt = wid, lrow = 16 * lt + fr; bf16x8 lf[4];
#pragma unroll
        for (int ks = 0; ks < 4; ++ks) lf[ks] = ldfrag(lds + OFF_L, lrow, STS, 64 * ks + 16 * fq);
#pragma unroll
        for (int pt = 0; pt < 4; ++pt) { f32x4 acc = {0.f, 0.f, 0.f, 0.f};
#pragma unroll
            for (int ks = 0; ks < 4; ++ks) acc = __builtin_amdgcn_mfma_f32_16x16x32_bf16(ldfrag(lds + OFF_XT, 16 * pt + fr, STS, 64 * ks + 16 * fq), lf[ks], acc, 0, 0, 0);
            *(f32x4*)(w.yd + (size_t)(R0 + lrow) * SW + hh * SP + 16 * pt + 4 * fq) = acc; }
    }
    {   const int d = wid >> 2, ptile = wid & 3, prow = 16 * ptile + fr; bf16x8 xf[4]; const char* bt = lds + (d ? OFF_BTB : OFF_BTF);
#pragma unroll
        for (int ks = 0; ks < 4; ++ks) xf[ks] = ldfrag(lds + OFF_XT, prow, STS, 64 * ks + 16 * fq);
#pragma unroll
        for (int nt = 0; nt < 4; ++nt) { f32x4 acc = {0.f, 0.f, 0.f, 0.f};
#pragma unroll
            for (int ks = 0; ks < 4; ++ks) acc = __builtin_amdgcn_mfma_f32_16x16x32_bf16(ldfrag(bt, 16 * nt + fr, STS, 64 * ks + 16 * fq), xf[ks], acc, 0, 0, 0);
            *(f32x4*)(w.st + ((((size_t)d * NCH + c) * SH + hh) * SP + prow) * SN + 16 * nt + 4 * fq) = acc; }
    }
    __syncthreads();
}
__device__ __forceinline__ void carry_phase(const SsdW& w) {
    int tid = threadIdx.x; asm volatile("" : "+v"(tid));
    constexpr int PER = 2 * SH * SP * SN / 256;
    if (tid < PER) { const int eidx = blockIdx.x * PER + tid; if (eidx < 2 * SH * SP * SN) { const int dir = eidx / (SH * SP * SN), rem = eidx % (SH * SP * SN), hh = rem / (SP * SN), e = rem % (SP * SN); float state = 0.f;
        for (int b = 0; b < NCH / 13; ++b) { float sv[13], dv[13]; size_t ov[13];
#pragma unroll
            for (int j = 0; j < 13; ++j) { const int i = b * 13 + j; const int c = dir == 0 ? i : (i < CTX / CHUNK ? CTX / CHUNK - 1 - i : NCH - 1 - (i - CTX / CHUNK));
                ov[j] = (((size_t)dir * NCH + c) * SH + hh) * (SP * SN) + e; sv[j] = w.st[ov[j]]; dv[j] = w.cdec[((size_t)dir * NCH + c) * SH + hh]; }
#pragma unroll
            for (int j = 0; j < 13; ++j) { w.prevb[ov[j]] = f2bf(state); state = state * dv[j] + sv[j]; } } } }
}
__device__ __forceinline__ void final_phase(const P& p, const SsdW& w, int l, bf16_t* dst, int ldd) {
    int tid = threadIdx.x; asm volatile("" : "+v"(tid)); const int wid = __builtin_amdgcn_readfirstlane(tid >> 6), lane = tid & 63, fr = lane & 15, fq = lane >> 4;
    const int ltg = wid * gridDim.x + blockIdx.x; if (ltg >= M / 16) return;
    const int r = ltg * 16 + fr, c = (ltg * 16) / CHUNK;
    bf16x8 cf[2][2];
#pragma unroll
    for (int g = 0; g < 2; ++g)
#pragma unroll
        for (int ks = 0; ks < 2; ++ks) cf[g][ks] = *(const bf16x8*)(w.cg + ((size_t)r * SG + g) * SN + 32 * ks + 8 * fq);
    u32x2 gv[SH][4]; float ss = 0.f;
#pragma unroll
    for (int hh = 0; hh < SH; ++hh) { const int g = hh / (SH / SG); const float ef = __expf(w.cs[(size_t)r * SH + hh]), eb = __expf(w.cs[((size_t)M + r) * SH + hh]);
#pragma unroll
        for (int pt = 0; pt < 4; ++pt) { f32x4 af = {0.f, 0.f, 0.f, 0.f}, ab = {0.f, 0.f, 0.f, 0.f};
            const bf16_t* pf = w.prevb + ((((size_t)0 * NCH + c) * SH + hh) * SP + 16 * pt + fr) * SN + 8 * fq; const bf16_t* pb = w.prevb + ((((size_t)1 * NCH + c) * SH + hh) * SP + 16 * pt + fr) * SN + 8 * fq;
#pragma unroll
            for (int ks = 0; ks < 2; ++ks) { af = __builtin_amdgcn_mfma_f32_16x16x32_bf16(*(const bf16x8*)(pf + 32 * ks), cf[g][ks], af, 0, 0, 0); ab = __builtin_amdgcn_mfma_f32_16x16x32_bf16(*(const bf16x8*)(pb + 32 * ks), cf[g][ks], ab, 0, 0, 0); }
            const int col = hh * SP + 16 * pt + 4 * fq; const f32x4 yd = *(const f32x4*)(w.yd + (size_t)r * SW + col), z = *(const f32x4*)(w.proj + (size_t)r * w.ldp + C_Z + col);
            f32x4 y = yd + af * ef + ab * eb;
#pragma unroll
            for (int j = 0; j < 4; ++j) { y[j] *= silu_f(z[j]); ss += y[j] * y[j]; }
            u32x2 pk; pk.x = rw::pk2(y[0], y[1]); pk.y = rw::pk2(y[2], y[3]); gv[hh][pt] = pk; } }
    ss += __shfl_xor(ss, 16); ss += __shfl_xor(ss, 32); const float rs = 1.0f / sqrtf(ss * (1.0f / SW) + EPS);
#pragma unroll
    for (int hh = 0; hh < SH; ++hh)
#pragma unroll
        for (int pt = 0; pt < 4; ++pt) { const int col = hh * SP + 16 * pt + 4 * fq; const f32x4 o = rw::bf4(gv[hh][pt]) * rs * *(const f32x4*)(p.ssd_norm_g + l * SW + col);
            u32x2 pk; pk.x = rw::pk2(o[0], o[1]); pk.y = rw::pk2(o[2], o[3]); *(u32x2*)(dst + (size_t)r * ldd + col) = pk; }
}
}

namespace mc {
typedef float f32x4 __attribute__((ext_vector_type(4)));
__device__ __forceinline__ void modvec_phase(const P& p, char* lds) {
    int tid = threadIdx.x; asm volatile("" : "+v"(tid));
    float* sc = (float*)lds; float* part = sc + 2 * D;
    for (int i = tid; i < 2 * D; i += 512) { const float v = i < D ? p.c[i] : p.c_ctx[i - D]; sc[i] = v / (1.0f + __expf(-v)); }
    __syncthreads();
    constexpr int NCK = 6 * D / 128, NU = DEPTH * NCK;
    for (int u = blockIdx.x; u < NU; u += gridDim.x) { const int l = u / NCK, j = (u % NCK) * 128 + (tid & 127), kg = tid >> 7; const float* wp = p.mod_w + (size_t)l * D * 6 * D + j; float a0 = 0.f, a1 = 0.f;
#pragma unroll 8
        for (int k = kg; k < D; k += 4) { const float wv = wp[(size_t)k * 6 * D]; a0 += sc[k] * wv; a1 += sc[D + k] * wv; }
        part[(kg * 2 + 0) * 128 + (tid & 127)] = a0; part[(kg * 2 + 1) * 128 + (tid & 127)] = a1;
        __syncthreads();
        if (tid < 256) { const int which = tid >> 7, cc = tid & 127; const float s = part[(0 * 2 + which) * 128 + cc] + part[(1 * 2 + which) * 128 + cc] + part[(2 * 2 + which) * 128 + cc] + part[(3 * 2 + which) * 128 + cc];
            const int jj = (u % NCK) * 128 + cc; p.mod[((size_t)(l * 2 + which) * 6) * D + jj] = s + p.mod_b[(size_t)l * 6 * D + jj]; }
        __syncthreads(); }
}
__device__ __forceinline__ void pool_phase(const P& p, const float* proj, int ldp, int l, bf16_t* dst, int ldd, char* lds) {
    int tid = threadIdx.x; asm volatile("" : "+v"(tid));
    constexpr int RB = 65; float* pm = (float*)lds;
    const int row0 = blockIdx.x * RB;
    {   const int c = tid & 255, gi = c >> 6, win = 2 << gi;
        for (int i = tid >> 8; i < RB; i += 2) { const int r = row0 + i; if (r >= M) break; const int seg0 = r < CTX ? 0 : CTX, n = r < CTX ? CTX : SEQ, t = r - seg0;
            int lo = t - win / 2, hi = t - win / 2 + win; lo = lo < 0 ? 0 : lo; hi = hi > n ? n : hi; float s = 0.f;
            for (int tt = lo; tt < hi; ++tt) s += proj[(size_t)(seg0 + tt) * ldp + C_POOL + c];
            pm[i * 256 + c] = s / (float)(hi - lo) - proj[(size_t)r * ldp + C_POOL + c]; } }
    __syncthreads();
    {   const int d = tid & 63, gi = (tid >> 6) & 3, rh = tid >> 8; float wcol[64]; const float* wp = p.pool_w + (((size_t)l * 4 + gi) * 64) * 64 + d;
#pragma unroll
        for (int c = 0; c < 64; ++c) wcol[c] = wp[(size_t)c * 64];
        const float scl = p.pool_scale[l * PW + gi * 64 + d];
        for (int i = rh; i < RB; i += 2) { const int r = row0 + i; if (r >= M) break; const f32x4* pr = (const f32x4*)(pm + i * 256 + gi * 64); float acc = 0.f;
#pragma unroll
            for (int c4 = 0; c4 < 16; ++c4) { const f32x4 v = pr[c4]; acc += v[0] * wcol[4 * c4] + v[1] * wcol[4 * c4 + 1] + v[2] * wcol[4 * c4 + 2] + v[3] * wcol[4 * c4 + 3]; }
            dst[(size_t)r * ldd + gi * 64 + d] = f2bf(acc * scl); } }
    __syncthreads();
}
}

#ifndef CHECK_MLA
#define CHECK_MLA 0
#endif
#ifndef CHECK_SSD
#define CHECK_SSD 0
#endif
#ifndef REP_ATT
#define REP_ATT 1
#endif
#ifndef REP_MOE
#define REP_MOE 1
#endif
#ifndef REP_PROJ
#define REP_PROJ 1
#endif
#ifndef REP_PRE
#define REP_PRE 1
#endif
#ifndef REP_PREP
#define REP_PREP 1
#endif
#ifndef REP_ROW
#define REP_ROW 1
#endif
#ifndef REP_FIN
#define REP_FIN 1
#endif
#define REPEAT(N, ...) for (int rep_ = 0; rep_ < (N); ++rep_) { __VA_ARGS__ }
__device__ __forceinline__ int gtid() { int t = threadIdx.x; asm volatile("" : "+v"(t)); return blockIdx.x * 512 + t; }
template <int OP> __device__ __forceinline__ void run_op(const P& p, int l) {
    const long n = op_count(OP); const long stride = (long)gridDim.x * blockDim.x;
    for (long i = gtid(); i < n; i += stride) op_run(OP, p, l, i);
}
struct KArgs { P p; FW f; unsigned* bar; };
__device__ __forceinline__ const KArgs& kargs() { auto q = __builtin_amdgcn_kernarg_segment_ptr(); asm volatile("" : "+s"(q)); return *(const KArgs*)q; }
constexpr int LDS_BYTES = gm::STAGE_BYTES + 4096;
#ifndef REP_BAR
#define REP_BAR 1
#endif
#if REP_BAR == 2
#define BAR() do { BAR1(); BAR1(); } while (0)
#else
#define BAR() BAR1()
#endif
#define BAR1() do { XcdBarrier b2_; b2_.bar = kargs().bar; unsigned xx_ = xbx; asm volatile("" : "+s"(xx_)); b2_.x = xx_; b2_.st = (volatile LAS unsigned*)(lds + LDS_BYTES - 16); xcd_barrier(b2_); } while (0)
#define PH(OPX) do { run_op<OPX>(kargs().p, lo()); BAR(); } while (0)
#define RUN(OPX) run_op<OPX>(kargs().p, lo())

__device__ __forceinline__ void attn_split_phase(const P& p, const FW& f, char* lds) {
    constexpr int NQL = SEQ / 256, NUL = NH * NQL * 2, NU = NUL + NH, HALF_KEYS = M / 2;
    for (int u = blockIdx.x; u < NU; u += gridDim.x) {
        int hh, qt, half, seq;
        if (u < NUL) { hh = u / (NQL * 2); const int rem = u % (NQL * 2); qt = 1 + (rem >> 1); half = rem & 1; seq = HALF_KEYS; } else { hh = u - NUL; qt = 0; half = 0; seq = CTX; }
        const size_t koff = (size_t)half * HALF_KEYS;
        __syncthreads();
        at::attn_body<bf16_t>(p.qb + (size_t)qt * 256 * at::LDQ + hh * at::DQ, p.kb + koff * at::LDK + hh * at::DQ, p.vb + koff * at::LDV + hh * at::DV,
                              f.opart + (size_t)half * M * (NH * VD) + (size_t)qt * 256 * (NH * VD) + hh * at::DV, NH * VD, seq, lds,
                              f.aml + (((size_t)half * M + (size_t)qt * 256) * NH + hh) * 2, NH * 2);
    }
    __syncthreads();
}
template <class TO> __device__ __forceinline__ void attn_phase(const P& p, TO* O, int ldo, char* lds) {
    constexpr int NQT = M / 256, NU = NH * NQT;
    for (int u = blockIdx.x; u < NU; u += gridDim.x) {
        const int hh = u / NQT, qt = u % NQT; const int seq = qt == 0 ? CTX : M;
        __syncthreads();
        at::attn_body<TO>(p.qb + (size_t)qt * 256 * at::LDQ + hh * at::DQ, p.kb + hh * at::DQ, p.vb + hh * at::DV, O + (size_t)qt * 256 * ldo + hh * at::DV, ldo, seq, lds);
    }
    __syncthreads();
}
template <class TA> __device__ __forceinline__ float ldf(const TA* a, size_t i);
template <> __device__ __forceinline__ float ldf<float>(const float* a, size_t i) { return a[i]; }
template <> __device__ __forceinline__ float ldf<bf16_t>(const bf16_t* a, size_t i) { return bf2f(a[i]); }
template <class TA, class TB> __device__ __forceinline__ void chk_accum(const TA* a, int lda, const TB* b, int ldb, long nrows, int ncols, float* diag) {
    float sd = 0.f, sr = 0.f; const long n = nrows * ncols; const long stride = (long)gridDim.x * blockDim.x;
    for (long i = gtid(); i < n; i += stride) { const long r = i / ncols; const int c = (int)(i % ncols);
        const float x = ldf<TA>(a, r * lda + c), y = ldf<TB>(b, r * ldb + c); sd += (x - y) * (x - y); sr += y * y; }
    for (int o = 32; o >= 1; o >>= 1) { sd += __shfl_xor(sd, o); sr += __shfl_xor(sr, o); }
    if ((threadIdx.x & 63) == 0) { atomicAdd(diag, sd); atomicAdd(diag + 1, sr); }
}
#define MLA_CALL(QB, KB, VB) { const int ll_ = lo(); ml::MW mw_; mw_.qb = (QB); mw_.kb = (KB); mw_.vb = (VB); mw_.w_uq_t = KF.w_uq_t + (size_t)ll_ * NH * QKD * QL; mw_.w_ukv_t = KF.w_ukv_t + (size_t)ll_ * NH * 128 * KVL; \
        mw_.ropec = KF.ropec; mw_.ropes = KF.ropes; mw_.proj = KP.proj; mw_.ldp = INC; ml::mla_phase(KP, mw_, ll_, lds); }
#if CHECK_MLA
#define MLA_STEP PH(OP_LATNORM); RUN(OP_QRAW); PH(OP_KVRAW); RUN(OP_QHEAD); RUN(OP_KHEAD); if (l == 0) { MLA_CALL(KF.qb2, KF.kb2, KF.vb2) } BAR(); \
        if (l == 0) { chk_accum<bf16_t, bf16_t>(KF.qb2, NH * QKD, KP.qb, NH * QKD, M, NH * QKD, KP.diag + 0); chk_accum<bf16_t, bf16_t>(KF.kb2, NH * QKD, KP.kb, NH * QKD, M, NH * QKD, KP.diag + 2); chk_accum<bf16_t, bf16_t>(KF.vb2, NH * VD, KP.vb, NH * VD, M, NH * VD, KP.diag + 4); }
#else
#define MLA_STEP REPEAT(REP_PREP, MLA_CALL(KP.qb, KP.kb, KP.vb))
#endif
#define SSD_W(NAME) sd::SsdW NAME; NAME.proj = KP.proj; NAME.ldp = INC; NAME.yd = KF.yd2; NAME.st = KF.st2; NAME.cdec = KF.cdec2; NAME.cs = KF.cs2; NAME.cg = KF.cg; NAME.prevb = KF.prevb;
#define SSD_S1() { SSD_W(sw_) const int ll_ = lo(); for (int u = blockIdx.x; u < NCH * SH; u += gridDim.x) sd::chunk_unit(KP, sw_, ll_, u / SH, u % SH, lds); }
#define SSD_S2() { SSD_W(sw_) sd::carry_phase(sw_); }
#define SSD_S3(DST, LDD) { SSD_W(sw_) sd::final_phase(KP, sw_, lo(), (DST), (LDD)); }
#if CHECK_SSD
#define SSD_STEPS RUN(OP_CONV); RUN(OP_DT); PH(OP_POOLP); RUN(OP_SSD_CS); RUN(OP_SSD_G); PH(OP_POOLMM); attn_phase<float>(KP, KP.mixin, MIXW, lds); RUN(OP_SSD_YD); PH(OP_SSD_ST); PH(OP_SSD_CARRY); PH(OP_SSD_YOFF); PH(OP_SSDFIN); \
        if (l == 0) { SSD_S1() BAR(); SSD_S2() BAR(); SSD_S3(KF.ssdb2, SW) BAR(); chk_accum<bf16_t, float>(KF.ssdb2, SW, KP.mixin + NH * VD, MIXW, M, SW, KP.diag + 0); } PH(OP_MIXB);
#else
#define SSD_STEPS REPEAT(REP_PREP, mc::pool_phase(KP, KP.proj, INC, lo(), KP.mixb + NH * VD + SW, MIXW, lds); SSD_S1()) BAR(); REPEAT(REP_ATT, attn_split_phase(KP, KF, lds);) REPEAT(REP_FIN, SSD_S2()) BAR(); REPEAT(REP_FIN, SSD_S3(KP.mixb + NH * VD, MIXW) at::attn_combine(KF.opart, KF.aml, KP.mixb, MIXW, M, CTX);) BAR();
#endif
#define LAYER_BODY(L) { const int l = (L); \
        auto lo = [&]() { int ll = l; asm volatile("" : "+s"(ll)); return ll; }; \
        if (blockIdx.x == 0 && threadIdx.x < NE) KP.cnt[threadIdx.x] = 0; \
        REPEAT(REP_PROJ, inproj_phase(KP, KF, lo(), KP.proj, lds);) BAR(); \
        MLA_STEP \
        SSD_STEPS \
        REPEAT(REP_PROJ - 1, outproj_phase<false>(KP, KF, lo(), KP.mixin, lds);) outproj_phase<true>(KP, KF, lo(), KP.xres, lds); BAR(); \
        REPEAT(REP_ROW - 1, rw::router_phase<true>(KP, lo(), lds);) rw::router_phase<false>(KP, lo(), lds); BAR(); \
        REPEAT(REP_MOE, moe1_phase(KP, KF, lo(), lds);) BAR(); REPEAT(REP_MOE, moe2_phase(KP, KF, lo(), lds);) BAR(); \
        REPEAT(REP_ROW - 1, rw::combine_phase<true>(KP, lo());) rw::combine_phase<false>(KP, lo()); BAR(); \
    }
__global__ void __launch_bounds__(512, 2) k_mega(KArgs a) {
    extern __shared__ __attribute__((aligned(16))) char lds[];
    uint4* xbw = (uint4*)(lds + LDS_BYTES - 16);
    if (threadIdx.x == 0) *xbw = make_uint4(0u, 0u, 0u, 0u);
    __syncthreads();
    const unsigned xbx = xcd_barrier_post(kargs().bar, (volatile LAS unsigned*)xbw).x;
#define KP kargs().p
#define KF kargs().f
    { const int l = 0; auto lo = [&]() { return l; }; if (blockIdx.x == 0 && threadIdx.x < 16) KP.diag[threadIdx.x] = 0.f; REPEAT(REP_PRE, mc::modvec_phase(KP, lds); cvt_phase(KP, KF, 0, DEPTH, lds);) BAR(); rw::first_norm_phase(KP); BAR(); }
    LAYER_BODY(0) LAYER_BODY(1) LAYER_BODY(2) LAYER_BODY(3)
#if CHECK_MLA || CHECK_SSD
    {
        float e = 0.f;
        for (int c = 0; c < 3; ++c) { const float dn = KP.diag[2 * c + 1]; if (dn == 0.f && KP.diag[2 * c] == 0.f) continue; const float ec = sqrtf(KP.diag[2 * c] / dn); e = ec > e ? ec : e; if (!(ec == ec)) e = 1e3f; }
        const float sc = 1.0f + 10.0f * e; const long n = (long)SEQ * D; const long stride = (long)gridDim.x * blockDim.x;
        for (long i = gtid(); i < n; i += stride) KP.out[i] *= sc;
    }
#endif
#undef KP
#undef KF
}
static size_t carve(char*& cur, size_t bytes) { size_t a = (bytes + 255) & ~(size_t)255; cur += a; return a; }
static bool setup_params(P& p, FW& f, unsigned*& bar, void* const* d_in, void* d_out, void* d_ws, size_t ws_size) {
    const float** pp = (const float**)&p; for (int i = 0; i < 32; ++i) pp[i] = (const float*)d_in[i];
    p.out = (float*)d_out;
    char* cur = (char*)d_ws; char* base = cur;
    bar = (unsigned*)cur; carve(cur, XCD_BAR_WORDS * sizeof(unsigned));
#define CARVE(field, type, count) p.field = (type*)cur; carve(cur, (size_t)(count) * sizeof(type));
#define CARVEF(field, type, count) f.field = (type*)cur; carve(cur, (size_t)(count) * sizeof(type));
    CARVE(xres, float, (size_t)M * D) CARVE(mod, float, (size_t)DEPTH * 12 * D) CARVE(proj, float, (size_t)M * INC)
#if CHECK_MLA
    CARVE(qln, float, (size_t)M * QL) CARVE(kvln, float, (size_t)M * KVL) CARVE(qraw, float, (size_t)M * NH * QKD) CARVE(kvraw, float, (size_t)M * NH * 128) CARVE(q, float, (size_t)M * NH * QKD) CARVE(k, float, (size_t)M * NH * QKD) CARVE(v, float, (size_t)M * NH * VD)
    CARVEF(qb2, bf16_t, (size_t)M * NH * QKD) CARVEF(kb2, bf16_t, (size_t)M * NH * QKD) CARVEF(vb2, bf16_t, (size_t)M * NH * VD)
#endif
    CARVE(mixin, float, (size_t)M * MIXW) CARVE(xbc, float, (size_t)M * CONVD) CARVE(dt, float, (size_t)M * 12) CARVE(ydir, float, (size_t)2 * M * SW)
    CARVE(poolp, float, (size_t)M * PW) CARVE(topw, float, (size_t)M * 4)
    CARVE(topi, int, (size_t)M * 4) CARVE(cnt, int, NE) CARVE(list, int, (size_t)NE * M)
    CARVE(qb, bf16_t, (size_t)M * NH * QKD) CARVE(kb, bf16_t, (size_t)M * NH * QKD) CARVE(vb, bf16_t, (size_t)M * NH * VD) CARVE(diag, float, 64)
    CARVE(cs, float, (size_t)2 * M * SH) CARVE(cdec, float, (size_t)2 * NCH * SH) CARVE(gmat, float, (size_t)M * SG * CHUNK) CARVE(st, float, (size_t)2 * NCH * SH * SP * SN)
    CARVE(hb1, bf16_t, (size_t)M * D) CARVE(hb2, bf16_t, (size_t)M * D) CARVE(mixb, bf16_t, (size_t)M * MIXW)
    CARVEF(actb, bf16_t, (size_t)4 * M * FF) CARVEF(yb, bf16_t, (size_t)4 * M * D)
    f.hb1 = p.hb1; f.hb2 = p.hb2; f.mixb = p.mixb; p.ybn = f.yb; p.attf = nullptr;
    const int nl = DEPTH;
    CARVEF(w_uq_t, bf16_t, (size_t)nl * NH * QKD * QL) CARVEF(w_ukv_t, bf16_t, (size_t)nl * NH * 128 * KVL) CARVEF(ropec, float, 256 * 8) CARVEF(ropes, float, 256 * 8)
    CARVEF(opart, bf16_t, (size_t)2 * M * NH * VD) CARVEF(aml, float, (size_t)2 * M * NH * 2)
    CARVEF(yd2, float, (size_t)M * SW) CARVEF(st2, float, (size_t)2 * NCH * SH * SP * SN) CARVEF(cdec2, float, (size_t)2 * NCH * SH) CARVEF(cs2, float, (size_t)2 * M * SH)
    CARVEF(cg, bf16_t, (size_t)M * SG * SN) CARVEF(prevb, bf16_t, (size_t)2 * NCH * SH * SP * SN) CARVEF(ssdb2, bf16_t, (size_t)M * SW)
    CARVEF(w_in_t, bf16_t, (size_t)nl * INC_PAD * D) CARVEF(w_out_t, bf16_t, (size_t)nl * D * MIXW) CARVEF(gu_t, bf16_t, (size_t)nl * NE * 2 * FF * D) CARVEF(d_t, bf16_t, (size_t)nl * NE * D * FF)
    p.act = nullptr; p.down = nullptr; f.proj2 = nullptr; f.mix2 = nullptr;
#undef CARVE
#undef CARVEF
    if (getenv("KDEBUG")) fprintf(stderr, "ws used %zu of %zu\n", (size_t)(cur - base), ws_size);
    return (size_t)(cur - base) <= ws_size;
}
extern "C" void kernel_launch(void* const* d_in, const int* in_sizes, int n_in, void* d_out, int out_size, void* d_ws, size_t ws_size, hipStream_t stream) {
    KArgs a{};
    if (n_in < 32 || !setup_params(a.p, a.f, a.bar, d_in, d_out, d_ws, ws_size)) return;
    static int grid = 0;
    if (!grid) { int dev = 0, cus = 0, per_cu = 0; (void)hipGetDevice(&dev); (void)hipDeviceGetAttribute(&cus, hipDeviceAttributeMultiprocessorCount, dev);
        (void)hipFuncSetAttribute((const void*)k_mega, hipFuncAttributeMaxDynamicSharedMemorySize, LDS_BYTES);
        (void)hipOccupancyMaxActiveBlocksPerMultiprocessor(&per_cu, k_mega, 512, LDS_BYTES); grid = cus * (per_cu < 1 ? per_cu : 1); }
    if (grid <= 0) return;
    (void)hipMemsetAsync(a.bar, 0, XCD_BAR_WORDS * sizeof(unsigned), stream);
    hipLaunchKernelGGL(k_mega, dim3(grid), dim3(512), LDS_BYTES, stream, a);
}
```

```cpp
#include <hip/hip_runtime.h>
#include <stdint.h>
#include <stdlib.h>
#include <stdio.h>

#ifndef NAIVE_H
#define NAIVE_H
#include <math.h>
#ifdef HOST_TEST
#define HD inline
#define HDC inline
#define ATOMIC_INC(p) ((*(p))++)
#define UNIFORM(x) (x)
#else
#define HD __device__ __forceinline__
#define HDC __host__ __device__ __forceinline__
#define ATOMIC_INC(p) atomicAdd((p), 1)
#define UNIFORM(x) __builtin_amdgcn_readfirstlane(x)
#endif

#ifndef CFG_D
#define CFG_D 1024
#define CFG_SEQ 16384
#define CFG_CTX 256
#define CFG_FF 1024
#define CFG_DEPTH 4
#endif
constexpr int D = CFG_D, SEQ = CFG_SEQ, CTX = CFG_CTX, FF = CFG_FF, DEPTH = CFG_DEPTH;
constexpr int M = CTX + SEQ;
constexpr int GRID_W = 64;
constexpr int NH = 6, QKD = 96, NOPE = 64, ROPE = 32, VD = 64, QL = 256, KVL = 128;
constexpr int SH = 6, SP = 64, SW = 384, SG = 2, SN = 64, CONVD = 640, CHUNK = 128;
constexpr int PW = 256, MIXW = 1024, INC = 1708;
constexpr int C_Q = 0, C_KV = 256, C_KR = 384, C_Z = 416, C_XBC = 800, C_DT = 1440, C_POOL = 1452;
constexpr int NE = 32, TOPK = 4;
constexpr int NCH = M / CHUNK;
constexpr float EPS = 1e-6f;

typedef unsigned short bf16_t;
HD bf16_t f2bf(float f) { union { float f; unsigned u; } v; v.f = f; unsigned u = v.u; u += 0x7FFFu + ((u >> 16) & 1u); return (bf16_t)(u >> 16); }
HD float bf2f(bf16_t b) { union { float f; unsigned u; } v; v.u = ((unsigned)b) << 16; return v.f; }
struct P {
    const float *x, *c, *ctx, *c_ctx, *norm1_g, *norm2_g, *mod_w, *mod_b, *w_in, *q_g, *kv_g, *w_uq, *w_ukv, *qn_g, *kn_g;
    const float *conv_w, *conv_b, *a_log, *dt_bias, *ssd_d, *ssd_norm_g, *pool_w, *pool_scale, *w_out, *router_w, *router_b;
    const float *wg, *bg, *wu, *bu, *wd, *bd;
    float* out;
    float *xres, *mod, *rs, *h, *proj, *qln, *kvln, *qraw, *kvraw, *q, *k, *v, *mixin, *xbc, *dt, *ydir, *poolp, *mix, *logits, *topw, *act, *down;
    int *topi, *cnt, *list;
    bf16_t *qb, *kb, *vb;
    float *attf, *diag;
    float *cs, *cdec, *gmat, *st;
    bf16_t *hb1, *hb2, *mixb, *ybn;
};

HD float siluf(float x) { return x / (1.0f + expf(-x)); }
HD float sigmf(float x) { return 1.0f / (1.0f + expf(-x)); }
HD float softplusf(float x) { return x > 20.0f ? x : log1pf(expf(x)); }
HD const float* modv(const P& p, int l, int r, int j) { return p.mod + ((size_t)(l * 2 + (r < CTX ? 1 : 0)) * 6 + j) * D; }

enum { OP_COPY_IN = 0, OP_MODVEC, OP_ROWSTAT, OP_NORM1, OP_INPROJ, OP_LATNORM, OP_QRAW, OP_KVRAW, OP_QHEAD, OP_KHEAD, OP_ATTN, OP_CONV, OP_DT, OP_SSDSCAN, OP_SSDFIN,
       OP_POOLP, OP_POOLMM, OP_OUTPROJ, OP_RES1, OP_NORM2, OP_LOGITS, OP_ZEROCNT, OP_TOPK, OP_GATEUP, OP_DOWN, OP_COMBINE, OP_WRITE_OUT, OP_MIXB, OP_COMBINE2, OP_SSD_CS, OP_SSD_G, OP_SSD_YD, OP_SSD_ST, OP_SSD_CARRY, OP_SSD_YOFF, OP_COUNT };

HDC long op_count(int op) {
    switch (op) {
        case OP_COPY_IN: return (long)M * D;
        case OP_MODVEC: return (long)DEPTH * 2 * 6 * D;
        case OP_ROWSTAT: return M;
        case OP_NORM1: case OP_NORM2: return (long)M * D;
        case OP_INPROJ: return (long)(M / 8) * INC;
        case OP_LATNORM: return 2L * M;
        case OP_QRAW: return (long)(M / 8) * (NH * QKD);
        case OP_KVRAW: return (long)(M / 8) * (NH * 128);
        case OP_QHEAD: case OP_KHEAD: return (long)M * NH;
        case OP_ATTN: return (long)M * NH;
        case OP_CONV: return (long)M * CONVD;
        case OP_DT: return (long)M * 12;
        case OP_SSDSCAN: return 2L * SH * SP;
        case OP_SSDFIN: return M;
        case OP_POOLP: return (long)M * PW;
        case OP_POOLMM: return (long)M * PW;
        case OP_OUTPROJ: return (long)(M / 8) * D;
        case OP_RES1: return (long)M * D;
        case OP_LOGITS: return (long)M * NE;
        case OP_ZEROCNT: return NE;
        case OP_TOPK: return M;
        case OP_GATEUP: return (long)NE * (M / 8) * FF;
        case OP_DOWN: return (long)NE * (M / 8) * D;
        case OP_COMBINE: return (long)M * D;
        case OP_WRITE_OUT: return (long)SEQ * D;
        case OP_MIXB: return (long)M * MIXW;
        case OP_COMBINE2: return (long)M * D;
        case OP_SSD_CS: return 2L * NCH * SH;
        case OP_SSD_G: return (long)M * SG * CHUNK;
        case OP_SSD_YD: return (long)M * SW;
        case OP_SSD_ST: return 2L * NCH * SH * SP * SN;
        case OP_SSD_CARRY: return 2L * SH * SP * SN;
        case OP_SSD_YOFF: return (long)M * SW;
    }
    return 0;
}

HD void gemm8(const float* A, int lda, const float* B, int ldb, const float* bias, float* C, int ldc, int N, int K, long idx) {
    const int j = (int)(idx % N); const long r0 = (idx / N) * 8;
    float acc[8];
#pragma unroll
    for (int i = 0; i < 8; ++i) acc[i] = 0.f;
    const float* a = A + r0 * lda;
    for (int k = 0; k < K; ++k) {
        const float b = B[(size_t)k * ldb + j];
#pragma unroll
        for (int i = 0; i < 8; ++i) acc[i] += a[(size_t)i * lda + k] * b;
    }
    const float bv = bias ? bias[j] : 0.f;
#pragma unroll
    for (int i = 0; i < 8; ++i) C[(r0 + i) * ldc + j] = acc[i] + bv;
}

HD void sincos_rr(float angf, float& cs, float& sn) {
    const double x = (double)angf; const double n = rint(x * 0.63661977236758134308); const double y = (x - n * 1.57079632679489655800) - n * 6.123233995736766e-17; const double y2 = y * y;
    const double s = y * (1.0 + y2 * (-1.0 / 6 + y2 * (1.0 / 120 + y2 * (-1.0 / 5040 + y2 * (1.0 / 362880 + y2 * (-1.0 / 39916800))))));
    const double c = 1.0 + y2 * (-0.5 + y2 * (1.0 / 24 + y2 * (-1.0 / 720 + y2 * (1.0 / 40320 + y2 * (-1.0 / 3628800 + y2 * (1.0 / 479001600))))));
    const int q = ((int)n) & 3; const double cc = (q == 0) ? c : (q == 1) ? -s : (q == 2) ? -c : s; const double ss = (q == 0) ? s : (q == 1) ? c : (q == 2) ? -s : -c;
    cs = (float)cc; sn = (float)ss;
}
HD float rope_inv_freq(int f) { return f == 0 ? 1.0f : f == 1 ? 0.31622776f : f == 2 ? 0.1f : f == 3 ? 0.031622775f : f == 4 ? 0.01f : f == 5 ? 0.0031622776f : f == 6 ? 0.001f : 0.00031622776f; }
HD void rope_apply(float* v32, int t) {
    const float row = (float)(t / GRID_W), col = (float)(t % GRID_W);
#pragma unroll
    for (int a = 0; a < 2; ++a)
#pragma unroll
        for (int f = 0; f < 8; ++f) {
            const float ang = (a == 0 ? row : col) * rope_inv_freq(f);
            float cs, sn; sincos_rr(ang, cs, sn);
            const float x1 = v32[a * 16 + f], x2 = v32[a * 16 + 8 + f];
            v32[a * 16 + f] = x1 * cs - x2 * sn; v32[a * 16 + 8 + f] = x2 * cs + x1 * sn;
        }
}

HD void op_run(int op, const P& p, int l, long idx) {
    switch (op) {
    case OP_COPY_IN: { const long r = idx / D; const int c = (int)(idx % D); p.xres[idx] = r < CTX ? p.ctx[idx] : p.x[(r - CTX) * D + c]; } break;
    case OP_MODVEC: {
        const int j = (int)(idx % (6 * D)); const int which = (int)((idx / (6 * D)) % 2); const int ll = (int)(idx / (12 * D));
        const float* cv = which ? p.c_ctx : p.c; float s = 0.f;
        for (int k = 0; k < D; ++k) s += siluf(cv[k]) * p.mod_w[((size_t)ll * D + k) * (6 * D) + j];
        p.mod[idx] = s + p.mod_b[(size_t)ll * 6 * D + j];
    } break;
    case OP_ROWSTAT: { const float* xr = p.xres + idx * D; float s = 0.f; for (int k = 0; k < D; ++k) s += xr[k] * xr[k]; p.rs[idx] = 1.0f / sqrtf(s / D + EPS); } break;
    case OP_NORM1: case OP_NORM2: { const int r = (int)(idx / D), c = (int)(idx % D); const int o = op == OP_NORM1 ? 0 : 3;
        const float g = (op == OP_NORM1 ? p.norm1_g : p.norm2_g)[l * D + c];
        const float hv = p.xres[idx] * p.rs[r] * g * (1.0f + modv(p, l, r, o + 1)[c]) + modv(p, l, r, o)[c]; p.h[idx] = hv;
        bf16_t* hb = op == OP_NORM1 ? p.hb1 : p.hb2; if (hb) hb[idx] = f2bf(hv); } break;
    case OP_INPROJ: gemm8(p.h, D, p.w_in + (size_t)l * D * INC, INC, nullptr, p.proj, INC, INC, D, idx); break;
    case OP_LATNORM: {
        const int which = idx >= M; const long r = which ? idx - M : idx; const int n = which ? KVL : QL; const float* src = p.proj + r * INC + (which ? C_KV : C_Q);
        float s = 0.f; for (int k = 0; k < n; ++k) s += src[k] * src[k]; const float rs = 1.0f / sqrtf(s / n + EPS);
        float* dst = which ? p.kvln + r * KVL : p.qln + r * QL; const float* g = which ? p.kv_g + l * KVL : p.q_g + l * QL;
        for (int k = 0; k < n; ++k) dst[k] = src[k] * rs * g[k];
    } break;
    case OP_QRAW: gemm8(p.qln, QL, p.w_uq + (size_t)l * QL * (NH * QKD), NH * QKD, nullptr, p.qraw, NH * QKD, NH * QKD, QL, idx); break;
    case OP_KVRAW: gemm8(p.kvln, KVL, p.w_ukv + (size_t)l * KVL * (NH * 128), NH * 128, nullptr, p.kvraw, NH * 128, NH * 128, KVL, idx); break;
    case OP_QHEAD: { const int r = (int)(idx / NH), hh = (int)(idx % NH); const float* src = p.qraw + (size_t)r * (NH * QKD) + hh * QKD; float s = 0.f;
        for (int d = 0; d < QKD; ++d) s += src[d] * src[d]; const float rs = 1.0f / sqrtf(s / QKD + EPS);
        float* dst = p.q + ((size_t)r * NH + hh) * QKD; float rp[32];
        for (int d = 0; d < NOPE; ++d) dst[d] = src[d] * rs * p.qn_g[l * QKD + d];
#pragma unroll
        for (int d = 0; d < 32; ++d) rp[d] = src[NOPE + d] * rs * p.qn_g[l * QKD + NOPE + d];
        if (r >= CTX) rope_apply(rp, r - CTX);
#pragma unroll
        for (int d = 0; d < 32; ++d) dst[NOPE + d] = rp[d];
        bf16_t* db = p.qb + ((size_t)r * NH + hh) * QKD;
        for (int d = 0; d < QKD; ++d) db[d] = f2bf(dst[d]);
    } break;
    case OP_KHEAD: { const int r = (int)(idx / NH), hh = (int)(idx % NH); const float* kn = p.kvraw + (size_t)r * (NH * 128) + hh * 128; const float* kr = p.proj + (size_t)r * INC + C_KR; float s = 0.f;
        for (int d = 0; d < NOPE; ++d) s += kn[d] * kn[d];
        for (int d = 0; d < ROPE; ++d) s += kr[d] * kr[d];
        const float rs = 1.0f / sqrtf(s / QKD + EPS);
        float* dst = p.k + ((size_t)r * NH + hh) * QKD; float rp[32];
        for (int d = 0; d < NOPE; ++d) dst[d] = kn[d] * rs * p.kn_g[l * QKD + d];
#pragma unroll
        for (int d = 0; d < 32; ++d) rp[d] = kr[d] * rs * p.kn_g[l * QKD + NOPE + d];
        if (r >= CTX) rope_apply(rp, r - CTX);
#pragma unroll
        for (int d = 0; d < 32; ++d) dst[NOPE + d] = rp[d];
        float* vd = p.v + ((size_t)r * NH + hh) * VD;
        for (int d = 0; d < VD; ++d) vd[d] = kn[NOPE + d];
        bf16_t* db = p.kb + ((size_t)r * NH + hh) * QKD; bf16_t* vdb = p.vb + ((size_t)r * NH + hh) * VD;
        for (int d = 0; d < QKD; ++d) db[d] = f2bf(dst[d]);
        for (int d = 0; d < VD; ++d) vdb[d] = f2bf(kn[NOPE + d]);
    } break;
    case OP_ATTN: {
        const int r = (int)(idx % M), hh = UNIFORM((int)(idx / M)); const int nk = r < CTX ? CTX : M;
        float qv[QKD];
        const float* qp = p.q + ((size_t)r * NH + hh) * QKD; const float scale = 1.0f / sqrtf((float)QKD);
#pragma unroll
        for (int d = 0; d < QKD; ++d) qv[d] = qp[d] * scale;
        for (int half = 0; half < 2; ++half) {
            float o[32];
#pragma unroll
            for (int d = 0; d < 32; ++d) o[d] = 0.f;
            float mx = -1e30f, lsum = 0.f;
            for (int kk = 0; kk < nk; ++kk) {
                const float* kp = p.k + ((size_t)kk * NH + hh) * QKD; const float* vp = p.v + ((size_t)kk * NH + hh) * VD + half * 32; float s = 0.f;
#pragma unroll
                for (int d = 0; d < QKD; ++d) s += qv[d] * kp[d];
                const float mn = s > mx ? s : mx; const float corr = expf(mx - mn), pe = expf(s - mn);
                lsum = lsum * corr + pe; mx = mn;
#pragma unroll
                for (int d = 0; d < 32; ++d) o[d] = o[d] * corr + pe * vp[d];
            }
            const float inv = 1.0f / lsum; float* dst = p.mixin + (size_t)r * MIXW + hh * VD + half * 32;
#pragma unroll
            for (int d = 0; d < 32; ++d) dst[d] = o[d] * inv;
        }
    } break;
    case OP_CONV: { const int r = (int)(idx / CONVD), c = (int)(idx % CONVD); const int seg0 = r < CTX ? 0 : CTX, n = r < CTX ? CTX : SEQ, t = r - seg0; float y = p.conv_b[l * CONVD + c];
#pragma unroll
        for (int j = 0; j < 4; ++j) { const int tt = t - 2 + j; if (tt >= 0 && tt < n) y += p.conv_w[((size_t)l * 4 + j) * CONVD + c] * p.proj[(size_t)(seg0 + tt) * INC + C_XBC + c]; }
        p.xbc[idx] = siluf(y); } break;
    case OP_DT: { const int r = (int)(idx / 12), j = (int)(idx % 12); p.dt[idx] = softplusf(p.proj[(size_t)r * INC + C_DT + j] + p.dt_bias[l * 12 + j]); } break;
    case OP_SSDSCAN: {
        const int pp = (int)(idx % SP), hh = UNIFORM((int)((idx / SP) % SH)), dir = UNIFORM((int)(idx / (SP * SH))); const int g = hh / (SH / SG);
        const float a = -expf(p.a_log[l * 12 + dir * 6 + hh]); float st[SN];
#pragma unroll
        for (int n = 0; n < SN; ++n) st[n] = 0.f;
        for (int step = 0; step < M; ++step) {
            const int r = dir == 0 ? step : (step < CTX ? CTX - 1 - step : M - 1 - (step - CTX));
            const float dtv = p.dt[(size_t)r * 12 + dir * 6 + hh]; const float dA = expf(dtv * a); const float xv = p.xbc[(size_t)r * CONVD + hh * SP + pp] * dtv;
            const float* Bp = p.xbc + (size_t)r * CONVD + SW + g * SN; const float* Cp = p.xbc + (size_t)r * CONVD + SW + SG * SN + g * SN; float y = 0.f;
#pragma unroll
            for (int n = 0; n < SN; ++n) { st[n] = st[n] * dA + xv * Bp[n]; y += st[n] * Cp[n]; }
            p.ydir[((size_t)dir * M + r) * SW + hh * SP + pp] = y;
        }
    } break;
    case OP_SSDFIN: { const long r = idx; float ss = 0.f;
        for (int c = 0; c < SW; ++c) { const float y = p.ydir[r * SW + c] + p.ydir[((size_t)M + r) * SW + c] + p.ssd_d[l * SH + c / SP] * p.xbc[r * CONVD + c]; const float gv = y * siluf(p.proj[r * INC + C_Z + c]); ss += gv * gv; }
        const float rs = 1.0f / sqrtf(ss / SW + EPS);
        for (int c = 0; c < SW; ++c) { const float y = p.ydir[r * SW + c] + p.ydir[((size_t)M + r) * SW + c] + p.ssd_d[l * SH + c / SP] * p.xbc[r * CONVD + c]; const float gv = y * siluf(p.proj[r * INC + C_Z + c]);
            p.mixin[r * MIXW + NH * VD + c] = gv * rs * p.ssd_norm_g[l * SW + c]; }
    } break;
    case OP_POOLP: { const int r = (int)(idx / PW), c = (int)(idx % PW); const int gi = c / 64; const int win = 2 << gi; const int seg0 = r < CTX ? 0 : CTX, n = r < CTX ? CTX : SEQ, t = r - seg0;
        int lo = t - win / 2, hi = t - win / 2 + win; lo = lo < 0 ? 0 : lo; hi = hi > n ? n : hi; float s = 0.f;
        for (int tt = lo; tt < hi; ++tt) s += p.proj[(size_t)(seg0 + tt) * INC + C_POOL + c];
        p.poolp[idx] = s / (float)(hi - lo) - p.proj[(size_t)r * INC + C_POOL + c]; } break;
    case OP_POOLMM: { const int r = (int)(idx / PW), c = (int)(idx % PW); const int gi = c / 64, d = c % 64; float s = 0.f;
        for (int cc = 0; cc < 64; ++cc) s += p.poolp[(size_t)r * PW + gi * 64 + cc] * p.pool_w[(((size_t)l * 4 + gi) * 64 + cc) * 64 + d];
        p.mixin[(size_t)r * MIXW + NH * VD + SW + c] = s * p.pool_scale[l * PW + c]; } break;
    case OP_OUTPROJ: gemm8(p.mixin, MIXW, p.w_out + (size_t)l * MIXW * D, D, nullptr, p.mix, D, D, MIXW, idx); break;
    case OP_RES1: { const int r = (int)(idx / D), c = (int)(idx % D); p.xres[idx] += modv(p, l, r, 2)[c] * p.mix[idx]; } break;
    case OP_LOGITS: { const int r = (int)(idx / NE), e = (int)(idx % NE); const float* hr = p.h + (size_t)r * D; float s = 0.f;
        for (int k = 0; k < D; ++k) s += hr[k] * p.router_w[((size_t)l * D + k) * NE + e];
        p.logits[idx] = s + p.router_b[l * NE + e]; } break;
    case OP_ZEROCNT: p.cnt[idx] = 0; break;
    case OP_TOPK: { const long t = idx; float lg[NE];
#pragma unroll
        for (int e = 0; e < NE; ++e) lg[e] = p.logits[t * NE + e];
        int sel[4]; float sv[4];
#pragma unroll
        for (int kk = 0; kk < 4; ++kk) { float best = -3.0e38f; int bi = 0;
#pragma unroll
            for (int e = 0; e < NE; ++e) { bool taken = false;
#pragma unroll
                for (int q = 0; q < kk; ++q) taken = taken || (sel[q] == e);
                if (!taken && lg[e] > best) { best = lg[e]; bi = e; } }
            sel[kk] = bi; sv[kk] = best; }
        float es[4], sum = 0.f;
#pragma unroll
        for (int kk = 0; kk < 4; ++kk) { es[kk] = expf(sv[kk] - sv[0]); sum += es[kk]; }
#pragma unroll
        for (int kk = 0; kk < 4; ++kk) { p.topi[t * 4 + kk] = sel[kk]; p.topw[t * 4 + kk] = es[kk] / sum; const int pos = ATOMIC_INC(&p.cnt[sel[kk]]); p.list[(size_t)sel[kk] * M + pos] = (int)(t * 4 + kk); }
    } break;
    case OP_GATEUP: {
        const int j = (int)(idx % FF); const long rest = idx / FF; const int rb = (int)(rest % (M / 8)), e = (int)(rest / (M / 8)); const int cnt = p.cnt[e]; if (rb * 8 >= cnt) break;
        int a[8]; float g[8], u[8];
#pragma unroll
        for (int i = 0; i < 8; ++i) { a[i] = rb * 8 + i < cnt ? p.list[(size_t)e * M + rb * 8 + i] : -1; g[i] = 0.f; u[i] = 0.f; }
        const float* wgp = p.wg + ((size_t)l * NE + e) * D * FF + j; const float* wup = p.wu + ((size_t)l * NE + e) * D * FF + j;
        for (int k = 0; k < D; ++k) { const float gw = wgp[(size_t)k * FF], uw = wup[(size_t)k * FF];
#pragma unroll
            for (int i = 0; i < 8; ++i) { const float xv = p.h[(size_t)(a[i] < 0 ? 0 : a[i] / 4) * D + k]; g[i] += xv * gw; u[i] += xv * uw; } }
        const float bgv = p.bg[((size_t)l * NE + e) * FF + j], buv = p.bu[((size_t)l * NE + e) * FF + j];
#pragma unroll
        for (int i = 0; i < 8; ++i) if (a[i] >= 0) { float gv = g[i] + bgv; gv = gv < 7.0f ? gv : 7.0f; float uv = u[i] + buv; uv = uv < -7.0f ? -7.0f : (uv > 7.0f ? 7.0f : uv);
            p.act[(size_t)a[i] * FF + j] = gv * sigmf(1.702f * gv) * (uv + 1.0f); }
    } break;
    case OP_DOWN: {
        const int j = (int)(idx % D); const long rest = idx / D; const int rb = (int)(rest % (M / 8)), e = (int)(rest / (M / 8)); const int cnt = p.cnt[e]; if (rb * 8 >= cnt) break;
        int a[8]; float o[8];
#pragma unroll
        for (int i = 0; i < 8; ++i) { a[i] = rb * 8 + i < cnt ? p.list[(size_t)e * M + rb * 8 + i] : -1; o[i] = 0.f; }
        const float* wdp = p.wd + ((size_t)l * NE + e) * FF * D + j;
        for (int k = 0; k < FF; ++k) { const float w = wdp[(size_t)k * D];
#pragma unroll
            for (int i = 0; i < 8; ++i) o[i] += p.act[(size_t)(a[i] < 0 ? 0 : a[i]) * FF + k] * w; }
        const float bv = p.bd[((size_t)l * NE + e) * D + j];
#pragma unroll
        for (int i = 0; i < 8; ++i) if (a[i] >= 0) p.down[(size_t)a[i] * D + j] = o[i] + bv;
    } break;
    case OP_COMBINE: { const int r = (int)(idx / D), c = (int)(idx % D); float s = 0.f;
#pragma unroll
        for (int kk = 0; kk < 4; ++kk) s += p.topw[(size_t)r * 4 + kk] * p.down[((size_t)r * 4 + kk) * D + c];
        p.xres[idx] += modv(p, l, r, 5)[c] * s; } break;
    case OP_WRITE_OUT: p.out[idx] = p.xres[(size_t)CTX * D + idx]; break;
    case OP_MIXB: p.mixb[idx] = f2bf(p.mixin[idx]); break;
    case OP_SSD_CS: {
        const int hh = (int)(idx % SH), c = (int)((idx / SH) % NCH), dir = (int)(idx / (SH * NCH)); const float a = -expf(p.a_log[l * 12 + dir * 6 + hh]); float acc = 0.f;
        for (int i = 0; i < CHUNK; ++i) { const int r = c * CHUNK + (dir == 0 ? i : CHUNK - 1 - i); acc += p.dt[(size_t)r * 12 + dir * 6 + hh] * a; p.cs[((size_t)dir * M + r) * SH + hh] = acc; }
        p.cdec[idx] = expf(acc);
    } break;
    case OP_SSD_G: {
        const int s = (int)(idx % CHUNK), g = (int)((idx / CHUNK) % SG), r = (int)(idx / (CHUNK * SG)); const int r2 = (r / CHUNK) * CHUNK + s;
        const float* Cp = p.xbc + (size_t)r * CONVD + SW + SG * SN + g * SN; const float* Bp = p.xbc + (size_t)r2 * CONVD + SW + g * SN; float acc = 0.f;
        for (int n = 0; n < SN; ++n) acc += Cp[n] * Bp[n];
        p.gmat[idx] = acc;
    } break;
    case OP_SSD_YD: {
        const int cc = (int)(idx % SW), r = (int)(idx / SW); const int hh = cc / SP, g = hh / (SH / SG); const int c0 = (r / CHUNK) * CHUNK, lpos = r - c0;
        const float* G = p.gmat + ((size_t)r * SG + g) * CHUNK; const float csf = p.cs[(size_t)r * SH + hh], csb = p.cs[((size_t)M + r) * SH + hh]; float y = 0.f;
        for (int s = 0; s <= lpos; ++s) { const int r2 = c0 + s; y += G[s] * expf(csf - p.cs[(size_t)r2 * SH + hh]) * p.dt[(size_t)r2 * 12 + hh] * p.xbc[(size_t)r2 * CONVD + cc]; }
        for (int s = lpos; s < CHUNK; ++s) { const int r2 = c0 + s; y += G[s] * expf(csb - p.cs[((size_t)M + r2) * SH + hh]) * p.dt[(size_t)r2 * 12 + 6 + hh] * p.xbc[(size_t)r2 * CONVD + cc]; }
        p.ydir[idx] = y;
    } break;
    case OP_SSD_ST: {
        const int n = (int)(idx % SN), pp = (int)((idx / SN) % SP), hh = (int)((idx / (SN * SP)) % SH), c = (int)((idx / (SN * SP * SH)) % NCH), dir = (int)(idx / ((long)SN * SP * SH * NCH)); const int g = hh / (SH / SG);
        const int rend = c * CHUNK + (dir == 0 ? CHUNK - 1 : 0); const float cse = p.cs[((size_t)dir * M + rend) * SH + hh]; float acc = 0.f;
        for (int i = 0; i < CHUNK; ++i) { const int r = c * CHUNK + i; acc += p.xbc[(size_t)r * CONVD + SW + g * SN + n] * expf(cse - p.cs[((size_t)dir * M + r) * SH + hh]) * p.dt[(size_t)r * 12 + dir * 6 + hh] * p.xbc[(size_t)r * CONVD + hh * SP + pp]; }
        p.st[idx] = acc;
    } break;
    case OP_SSD_CARRY: {
        const int e = (int)(idx % (SP * SN)), hh = (int)((idx / (SP * SN)) % SH), dir = (int)(idx / ((long)SP * SN * SH)); float state = 0.f;
        for (int i = 0; i < NCH; ++i) { const int c = dir == 0 ? i : (i < CTX / CHUNK ? CTX / CHUNK - 1 - i : NCH - 1 - (i - CTX / CHUNK));
            const size_t o = (((size_t)dir * NCH + c) * SH + hh) * (SP * SN) + e; const float stc = p.st[o]; p.st[o] = state; state = state * p.cdec[((size_t)dir * NCH + c) * SH + hh] + stc; }
    } break;
    case OP_SSD_YOFF: {
        const int cc = (int)(idx % SW), r = (int)(idx / SW); const int hh = cc / SP, pp = cc % SP, g = hh / (SH / SG), c = r / CHUNK; const float* Cp = p.xbc + (size_t)r * CONVD + SW + SG * SN + g * SN;
        float y = 0.f;
#pragma unroll
        for (int dir = 0; dir < 2; ++dir) { const float* pv = p.st + ((((size_t)dir * NCH + c) * SH + hh) * SP + pp) * SN; float acc = 0.f;
            for (int n = 0; n < SN; ++n) acc += Cp[n] * pv[n];
            y += acc * expf(p.cs[((size_t)dir * M + r) * SH + hh]); }
        p.ydir[(size_t)M * SW + idx] = y;
    } break;
    case OP_COMBINE2: { const int r = (int)(idx / D), c = (int)(idx % D); float s = 0.f;
#pragma unroll
        for (int kk = 0; kk < 4; ++kk) s += p.topw[(size_t)r * 4 + kk] * bf2f(p.ybn[((size_t)r * 4 + kk) * D + c]);
        p.xres[idx] += modv(p, l, r, 5)[c] * s; } break;
    }
}

static const int LAYER_OPS[] = { OP_ROWSTAT, OP_NORM1, OP_INPROJ, OP_LATNORM, OP_QRAW, OP_KVRAW, OP_QHEAD, OP_KHEAD, OP_ATTN, OP_CONV, OP_DT, OP_SSDSCAN, OP_SSDFIN, OP_POOLP, OP_POOLMM,
                                 OP_OUTPROJ, OP_RES1, OP_ROWSTAT, OP_NORM2, OP_LOGITS, OP_ZEROCNT, OP_TOPK, OP_GATEUP, OP_DOWN, OP_COMBINE };
constexpr int N_LAYER_OPS = sizeof(LAYER_OPS) / sizeof(int);
#endif

#define XB_TMO      128
#define XB_XCNT(j)  (256  + 64 * (j))
#define XB_XSUB(j)  (1280 + 64 * (j))
#define XB_XGEN(j)  (2304 + 64 * (j))
#define XB_TOP      3328
#define XB_TOPGEN   3392
#define XCD_BAR_WORDS 3456
#define XB_SPIN_CAP (1u << 22)
#define LAS __attribute__((address_space(3)))

__device__ __forceinline__ unsigned xb_ld(unsigned* p)              { return __hip_atomic_load(p, __ATOMIC_RELAXED, __HIP_MEMORY_SCOPE_AGENT); }
__device__ __forceinline__ unsigned xb_add(unsigned* p, unsigned v) { return __hip_atomic_fetch_add(p, v, __ATOMIC_RELAXED, __HIP_MEMORY_SCOPE_AGENT); }
__device__ __forceinline__ unsigned xb_xcc_id() { return (unsigned)__builtin_amdgcn_s_getreg((3 << 11) | 20) & 0xFu; }
#define XB_SPIN(cond, bar) do { unsigned _sp = 0; while (cond) { __builtin_amdgcn_s_sleep(1); \
    if ((++_sp & 255u) == 0u) { if (xb_ld(&(bar)[XB_TMO])) break; if (_sp > XB_SPIN_CAP) { atomicAdd(&(bar)[XB_TMO], 1u); break; } } } } while (0)

struct XcdBarrier {
    unsigned* bar; unsigned x;
    volatile LAS unsigned* st;
};

__device__ __forceinline__ XcdBarrier xcd_barrier_post(unsigned* bar, volatile LAS unsigned* st) {
    XcdBarrier b; b.bar = bar; b.x = xb_xcc_id(); b.st = st;
    if (threadIdx.x == 0) (void)xb_add(&bar[XB_XCNT(b.x)], 1u);
    return b;
}
__device__ __forceinline__ void xcd_barrier_complete(unsigned* bar, unsigned x, unsigned& nloc, unsigned& nx) {
    const unsigned G = gridDim.x * gridDim.y * gridDim.z;
    unsigned sum, cnt, mine, sp = 0u;
    for (;;) {
        sum = 0u; cnt = 0u; mine = 0u;
#pragma unroll
        for (unsigned j = 0; j < 16; ++j) { const unsigned c = xb_ld(&bar[XB_XCNT(j)]); sum += c; cnt += (c > 0u) ? 1u : 0u; mine = (j == x) ? c : mine; }
        if (sum == G) break;
        __builtin_amdgcn_s_sleep(1);
        if ((++sp & 255u) == 0u) { if (xb_ld(&bar[XB_TMO])) break; if (sp > XB_SPIN_CAP) { atomicAdd(&bar[XB_TMO], 1u); break; } }
    }
    nloc = mine > 0u ? mine : 1u; nx = cnt > 0u ? cnt : 1u;
}

__device__ __forceinline__ void xcd_barrier(const XcdBarrier& b) {
    asm volatile("s_waitcnt vmcnt(0)" ::: "memory");
    __syncthreads();
    if (threadIdx.x == 0) {
        unsigned* bar = b.bar;
        __builtin_amdgcn_s_waitcnt(0);
        unsigned nloc = b.st[0], nx = b.st[1];
        if (nloc == 0u) { unsigned xx = b.x; asm volatile("" : "+s"(xx));   xcd_barrier_complete(bar, xx, nloc, nx); b.st[0] = nloc; b.st[1] = nx; }
        const unsigned old = xb_add(&bar[XB_XSUB(b.x)], 1u);
        const unsigned gen = old / nloc;
        if (old + 1u == (gen + 1u) * nloc) {
            __builtin_amdgcn_fence(__ATOMIC_RELEASE, "agent");
            asm volatile("s_waitcnt vmcnt(0)" ::: "memory");
            const unsigned og = xb_add(&bar[XB_TOP], 1u);
            const unsigned tg = og / nx;
            if (og + 1u == (tg + 1u) * nx) xb_add(&bar[XB_TOPGEN], 1u);
            else XB_SPIN(xb_ld(&bar[XB_TOPGEN]) == tg, bar);
            __builtin_amdgcn_fence(__ATOMIC_ACQUIRE, "agent");
            xb_add(&bar[XB_XGEN(b.x)], 1u);
            asm volatile("s_waitcnt vmcnt(0)" ::: "memory");
        } else {
            XB_SPIN(xb_ld(&bar[XB_XGEN(b.x)]) == gen, bar);
            __builtin_amdgcn_fence(__ATOMIC_ACQUIRE, "agent");
            asm volatile("s_waitcnt vmcnt(0)" ::: "memory");
        }
    }
    __syncthreads();
}


namespace at {
typedef unsigned short bf16_t;
using bf16x8 = __attribute__((ext_vector_type(8))) short;
using s16x4  = __attribute__((ext_vector_type(4))) short;
using f32x16 = __attribute__((ext_vector_type(16))) float;
using u32x4  = __attribute__((ext_vector_type(4))) unsigned;
constexpr int DQ = 96, DV = 64, NW = 8, QBLK = 32, KVBLK = 64;
constexpr int LDQ = 6 * DQ, LDK = 6 * DQ, LDV = 6 * DV;
constexpr float SCALE = 0.10206207261596575f;
constexpr float THR = 8.f;
constexpr int KROW = 208;
constexpr int SHM_K = KVBLK * KROW, SHM_V = KVBLK * DV * 2;
constexpr int SHM_ATTN = 2 * SHM_V + 2 * SHM_K + NW * 64 * 4;
#define AT_SBAR() __builtin_amdgcn_sched_barrier(0)
__device__ __forceinline__ int crow(int r, int hi) { return (r & 3) + 8 * (r >> 2) + 4 * hi; }
__device__ __forceinline__ unsigned cvtpk(float lo, float hi) { unsigned r; asm volatile("v_cvt_pk_bf16_f32 %0, %1, %2" : "=v"(r) : "v"(lo), "v"(hi)); return r; }

__device__ __forceinline__ void partialSM(f32x16& p0, f32x16& p1, float& m_reg, float& mn, float& alpha) {
  constexpr float C = SCALE * 1.4426950408889634f;
  float pmax = p0[0];
#pragma unroll
  for (int r = 1; r < 16; ++r) pmax = fmaxf(pmax, p0[r]);
#pragma unroll
  for (int r = 0; r < 16; ++r) pmax = fmaxf(pmax, p1[r]);
  { auto rr = __builtin_amdgcn_permlane32_swap(__float_as_uint(pmax), __float_as_uint(pmax), false, false);
    pmax = fmaxf(__uint_as_float(rr[0]), __uint_as_float(rr[1])); }
  if (__builtin_expect(__all(pmax - m_reg <= THR / SCALE), 1)) { mn = m_reg; alpha = 1.f; }
  else { mn = fmaxf(m_reg, pmax); alpha = __builtin_amdgcn_exp2f((m_reg - mn) * C); m_reg = mn; }
  float mnC = -mn * C;
#pragma unroll
  for (int r = 0; r < 16; ++r) p0[r] = fmaf(p0[r], C, mnC);
#pragma unroll
  for (int r = 0; r < 16; ++r) p1[r] = fmaf(p1[r], C, mnC);
#pragma unroll
  for (int r = 0; r < 16; ++r) p0[r] = __builtin_amdgcn_exp2f(p0[r]);
}
__device__ __forceinline__ void finishSM(f32x16& p0, f32x16& p1, float alpha, float& l_reg, bf16x8& pa0, bf16x8& pa1, bf16x8& pa2, bf16x8& pa3) {
#pragma unroll
  for (int r = 0; r < 16; ++r) p1[r] = __builtin_amdgcn_exp2f(p1[r]);
  float ps = 0;
#pragma unroll
  for (int r = 0; r < 16; ++r) ps += p0[r];
#pragma unroll
  for (int r = 0; r < 16; ++r) ps += p1[r];
  { auto rr = __builtin_amdgcn_permlane32_swap(__float_as_uint(ps), __float_as_uint(ps), false, false);
    ps = __uint_as_float(rr[0]) + __uint_as_float(rr[1]); }
  l_reg = l_reg * alpha + ps;
#define AT_PK4(P, BASE, OUT) do { unsigned a0 = cvtpk(P[BASE + 0], P[BASE + 1]), a1 = cvtpk(P[BASE + 2], P[BASE + 3]);   \
    unsigned b0 = cvtpk(P[BASE + 4], P[BASE + 5]), b1 = cvtpk(P[BASE + 6], P[BASE + 7]);                              \
    auto r0 = __builtin_amdgcn_permlane32_swap(a0, b0, false, false); auto r1 = __builtin_amdgcn_permlane32_swap(a1, b1, false, false); \
    u32x4 w = {r0[0], r1[0], r0[1], r1[1]}; OUT = *reinterpret_cast<bf16x8*>(&w); } while (0)
  AT_PK4(p0, 0, pa0); AT_PK4(p0, 8, pa1); AT_PK4(p1, 0, pa2); AT_PK4(p1, 8, pa3);
#undef AT_PK4
}
__device__ __forceinline__ void qkt(f32x16& p0, f32x16& p1, const char* Ks, const bf16x8* qr, int r32, int hi) {
  p0 = f32x16{}; p1 = f32x16{};
#pragma unroll
  for (int d0 = 0; d0 < 6; ++d0) { const int cb = (d0 * 16 + hi * 8) * 2;
    bf16x8 b0 = *reinterpret_cast<const bf16x8*>(Ks + r32 * KROW + cb);
    bf16x8 b1 = *reinterpret_cast<const bf16x8*>(Ks + (32 + r32) * KROW + cb);
    p0 = __builtin_amdgcn_mfma_f32_32x32x16_bf16(b0, qr[d0], p0, 0, 0, 0);
    p1 = __builtin_amdgcn_mfma_f32_32x32x16_bf16(b1, qr[d0], p1, 0, 0, 0); }
}
__device__ __forceinline__ int v_st(int k, int c) { const int kk = (k & ~0xC) | ((k & 4) << 1) | ((k & 8) >> 1); return ((kk >> 3) * 2 + (c >> 5)) * 512 + ((kk & 7) * 32 + (c & 31)) * 2; }
__device__ __forceinline__ int v_rd_base(int lane) { return ((lane & 3) << 3) | (((lane >> 2) & 3) << 6) | (((lane >> 4) & 1) << 5) | (((lane >> 5) & 1) << 8); }
constexpr int v_rd_off(int d0, int ks, int half) { return d0 * 512 + ks * 2048 + half * 1024; }
template <int OFF> __device__ __forceinline__ s16x4 tr_read(int vb) {
  s16x4 r; asm volatile("ds_read_b64_tr_b16 %0, %1 offset:%2" : "=&v"(r) : "v"(vb), "i"(OFF) : "memory"); return r;
}
template <int D0> __device__ __forceinline__ void pv_one(f32x16& od, int vb, bf16x8 pa0, bf16x8 pa1, bf16x8 pa2, bf16x8 pa3) {
  const s16x4 l0 = tr_read<v_rd_off(D0, 0, 0)>(vb), h0 = tr_read<v_rd_off(D0, 0, 1)>(vb), l1 = tr_read<v_rd_off(D0, 1, 0)>(vb), h1 = tr_read<v_rd_off(D0, 1, 1)>(vb);
  const s16x4 l2 = tr_read<v_rd_off(D0, 2, 0)>(vb), h2 = tr_read<v_rd_off(D0, 2, 1)>(vb), l3 = tr_read<v_rd_off(D0, 3, 0)>(vb), h3 = tr_read<v_rd_off(D0, 3, 1)>(vb);
  asm volatile("s_waitcnt lgkmcnt(0)" ::: "memory"); AT_SBAR();
#define AT_PK(L, H) (bf16x8){L[0], L[1], L[2], L[3], H[0], H[1], H[2], H[3]}
  od = __builtin_amdgcn_mfma_f32_32x32x16_bf16(pa0, AT_PK(l0, h0), od, 0, 0, 0);
  od = __builtin_amdgcn_mfma_f32_32x32x16_bf16(pa1, AT_PK(l1, h1), od, 0, 0, 0);
  od = __builtin_amdgcn_mfma_f32_32x32x16_bf16(pa2, AT_PK(l2, h2), od, 0, 0, 0);
  od = __builtin_amdgcn_mfma_f32_32x32x16_bf16(pa3, AT_PK(l3, h3), od, 0, 0, 0);
#undef AT_PK
}
__device__ __forceinline__ void pv_d0(f32x16* o, int vb, bf16x8 pa0, bf16x8 pa1, bf16x8 pa2, bf16x8 pa3) {
  pv_one<0>(o[0], vb, pa0, pa1, pa2, pa3); pv_one<1>(o[1], vb, pa0, pa1, pa2, pa3);
}
template <class TO> __device__ __forceinline__ void attn_body(const bf16_t* __restrict__ Qb, const bf16_t* __restrict__ Kh, const bf16_t* __restrict__ Vh, TO* __restrict__ Ob, int ldo, int seq, char* lds, float* __restrict__ ml = nullptr, int ldml = 0) {
  int tid = threadIdx.x; asm volatile("" : "+v"(tid));
  const int wid = tid >> 6, lane = tid & 63, r32 = lane & 31, hi = lane >> 5;
  char* V_lds = lds; char* K_lds = lds + 2 * SHM_V;
  float* ws = (float*)(lds + 2 * SHM_V + 2 * SHM_K) + wid * 64; float* li_l = ws; float* al_l = ws + 32;
  float m_reg = -1e30f, l_reg = 0; f32x16 o[2] = {}; bf16x8 qr[6];
  const bf16_t* Qw = Qb + (long)(wid * QBLK + r32) * LDQ + hi * 8;
#pragma unroll
  for (int d0 = 0; d0 < 6; ++d0) qr[d0] = *reinterpret_cast<const bf16x8*>(Qw + d0 * 16);
  const int kr0 = tid / 12, kc0 = tid % 12, c1 = 512 + (tid & 255), kr1 = c1 / 12, kc1 = c1 % 12, vr = tid >> 3, vc = (tid & 7) * 8;
  const bool k1on = tid < 256;
  const int kst0 = kr0 * KROW + kc0 * 16, kst1 = kr1 * KROW + kc1 * 16, vst = v_st(vr, vc);
  const long kg0 = (long)kr0 * LDK + kc0 * 8, kg1 = (long)kr1 * LDK + kc1 * 8, vg = (long)vr * LDV + vc;
  const int vb0 = (int)(uintptr_t)V_lds + v_rd_base(lane);
  struct { bf16x8 vs, ks0, ks1; } sr_[2];
#define AT_SLOAD(i, k0) do { sr_[i].vs = *reinterpret_cast<const bf16x8*>(Vh + (long)(k0) * LDV + vg); \
    sr_[i].ks0 = *reinterpret_cast<const bf16x8*>(Kh + (long)(k0) * LDK + kg0); sr_[i].ks1 = *reinterpret_cast<const bf16x8*>(Kh + (long)(k0) * LDK + kg1); } while (0)
#define AT_SWRITE(b, i) do { *(bf16x8*)(V_lds + (b) * SHM_V + vst) = sr_[i].vs; *(bf16x8*)(K_lds + (b) * SHM_K + kst0) = sr_[i].ks0; \
    if (k1on) *(bf16x8*)(K_lds + (b) * SHM_K + kst1) = sr_[i].ks1; } while (0)
#define AT_SWAIT() asm volatile("s_waitcnt vmcnt(3)" ::: "memory")
#define AT_RESC(a) do { if (__any((a) < 1.f)) { if (hi == 0) al_l[r32] = (a); asm volatile("s_waitcnt lgkmcnt(0)" ::: "memory"); \
    _Pragma("unroll") for (int d = 0; d < 2; ++d) _Pragma("unroll") for (int r = 0; r < 16; ++r) o[d][r] *= al_l[crow(r, hi)]; } } while (0)
  f32x16 pA0, pA1, pB0, pB1; float mnA, mnB, alA, alB; bf16x8 pa0, pa1, pa2, pa3; const int NT = seq / KVBLK;
  constexpr int SE = 0, SO = 1;
  AT_SLOAD(SE, 0); asm volatile("s_waitcnt vmcnt(0)" ::: "memory"); AT_SWRITE(0, SE); __syncthreads();
  qkt(pA0, pA1, K_lds, qr, r32, hi); partialSM(pA0, pA1, m_reg, mnA, alA);
  AT_SLOAD(SO, KVBLK); if (2 < NT) AT_SLOAD(SE, 2 * KVBLK);
  AT_SWAIT(); AT_SWRITE(1, SO); __syncthreads();
  for (int j = 1; j + 1 < NT; j += 2) {
    AT_SBAR(); qkt(pB0, pB1, K_lds + SHM_K, qr, r32, hi);
    finishSM(pA0, pA1, alA, l_reg, pa0, pa1, pa2, pa3); AT_SBAR();
    AT_SLOAD(SO, (j + 2) * KVBLK); AT_SBAR();
    pv_d0(o, vb0, pa0, pa1, pa2, pa3); partialSM(pB0, pB1, m_reg, mnB, alB);
    __syncthreads(); AT_SWAIT(); AT_SWRITE(0, SE);
    AT_RESC(alB); __syncthreads();
    AT_SBAR(); qkt(pA0, pA1, K_lds, qr, r32, hi);
    finishSM(pB0, pB1, alB, l_reg, pa0, pa1, pa2, pa3); AT_SBAR();
    if (j + 3 < NT) AT_SLOAD(SE, (j + 3) * KVBLK); AT_SBAR();
    pv_d0(o, vb0 + SHM_V, pa0, pa1, pa2, pa3); partialSM(pA0, pA1, m_reg, mnA, alA);
    __syncthreads(); AT_SWAIT(); AT_SWRITE(1, SO);
    AT_RESC(alA); __syncthreads();
  }
  AT_SBAR(); qkt(pB0, pB1, K_lds + SHM_K, qr, r32, hi);
  finishSM(pA0, pA1, alA, l_reg, pa0, pa1, pa2, pa3); AT_SBAR();
  pv_d0(o, vb0, pa0, pa1, pa2, pa3); partialSM(pB0, pB1, m_reg, mnB, alB);
  __syncthreads(); AT_RESC(alB);
  finishSM(pB0, pB1, alB, l_reg, pa0, pa1, pa2, pa3); AT_SBAR();
  pv_d0(o, vb0 + SHM_V, pa0, pa1, pa2, pa3);
  if (hi == 0) li_l[r32] = l_reg; asm volatile("s_waitcnt lgkmcnt(0)" ::: "memory");
  if (ml != nullptr && hi == 0) { float* q = ml + (long)(wid * QBLK + r32) * ldml; q[0] = m_reg; q[1] = l_reg; }
  float rli[16];
#pragma unroll
  for (int r = 0; r < 16; ++r) rli[r] = __builtin_amdgcn_rcpf(li_l[crow(r, hi)]);
  TO* Ow = Ob + (long)(wid * QBLK) * ldo;
#pragma unroll
  for (int r = 0; r < 16; ++r) { const int orow = crow(r, hi);
#pragma unroll
    for (int d0 = 0; d0 < 2; ++d0) { const float val = o[d0][r] * rli[r]; if constexpr (sizeof(TO) == 2) Ow[(long)orow * ldo + d0 * 32 + r32] = (TO)(cvtpk(val, val) & 0xffffu); else Ow[(long)orow * ldo + d0 * 32 + r32] = val; } }
#undef AT_SLOAD
#undef AT_SWRITE
#undef AT_SWAIT
#undef AT_RESC
}
__device__ __forceinline__ void attn_combine(const bf16_t* Opart, const float* ml, bf16_t* dst, int ldd, int nrows_total, int ctx_rows) {
  int tid = threadIdx.x; asm volatile("" : "+v"(tid)); const int wid = tid >> 6, lane = tid & 63;
  constexpr float C = SCALE * 1.4426950408889634f; const size_t hs = (size_t)nrows_total * 6 * DV;
  for (int r = blockIdx.x * 8 + wid; r < nrows_total; r += gridDim.x * 8) {
#pragma unroll
    for (int j = 0; j < 3; ++j) { const int c = 2 * (lane + 64 * j), hh = c >> 6; const unsigned w0 = *(const unsigned*)(Opart + (size_t)r * 384 + c);
      unsigned res = w0;
      if (r >= ctx_rows) { const unsigned w1 = *(const unsigned*)(Opart + hs + (size_t)r * 384 + c);
        const float m0 = ml[((size_t)r * 6 + hh) * 2], l0 = ml[((size_t)r * 6 + hh) * 2 + 1], m1 = ml[((size_t)(nrows_total + r) * 6 + hh) * 2], l1 = ml[((size_t)(nrows_total + r) * 6 + hh) * 2 + 1];
        const float m = fmaxf(m0, m1); const float a0 = __builtin_amdgcn_exp2f((m0 - m) * C) * l0, a1 = __builtin_amdgcn_exp2f((m1 - m) * C) * l1; const float inv = 1.0f / (a0 + a1); const float f0 = a0 * inv, f1 = a1 * inv;
        const float x0 = __uint_as_float(w0 << 16) * f0 + __uint_as_float(w1 << 16) * f1, x1 = __uint_as_float(w0 & 0xffff0000u) * f0 + __uint_as_float(w1 & 0xffff0000u) * f1; res = cvtpk(x0, x1); }
      *(unsigned*)(dst + (size_t)r * ldd + c) = res; } }
}
}

namespace gm {
#define GM_LAS __attribute__((address_space(3)))
typedef unsigned short bf16_t;
typedef short bf16x8 __attribute__((ext_vector_type(8)));
typedef float f32x4 __attribute__((ext_vector_type(4)));
typedef unsigned u32x4 __attribute__((ext_vector_type(4)));
constexpr int BM = 256, BK = 64, HALF = 128, HTB = HALF * BK * 2, STAGE_BYTES = 8 * HTB;
__host__ __device__ __forceinline__ int lds_byte(int r, int c) { const int st = (r >> 4) * 2 + (c >> 5), rr = r & 15, cc = c & 31, ob = rr * 64 + cc * 2; return st * 1024 + (ob ^ (((ob >> 9) & 1) << 5)); }
__host__ __device__ __forceinline__ void stage_rc(int b, int& R, int& C) { const int st = b / 1024, sb = b % 1024, swz = sb ^ (((sb >> 9) & 1) << 5); R = (st >> 1) * 16 + swz / 64; C = (st & 1) * 32 + (swz % 64) / 2; }
__host__ __device__ __forceinline__ int perm32(int rho) { const int n = rho >> 4, i = rho & 15; return 8 * (i >> 2) + 4 * n + (i & 3); }
__device__ __forceinline__ unsigned cvt_pk_bf16(float lo, float hi) { unsigned r; asm volatile("v_cvt_pk_bf16_f32 %0, %1, %2" : "=v"(r) : "v"(lo), "v"(hi)); return r; }

template <bool PERM, class Epi>
__device__ __forceinline__ void gemm_unit(GM_LAS unsigned char* lds, const char* A, const unsigned (&offA)[2][2], const char* Bt, int K, const Epi& E) {
    int tid = threadIdx.x; asm volatile("" : "+v"(tid));
    const int wid = __builtin_amdgcn_readfirstlane(tid >> 6), lane = tid & 63, wr = wid >> 2, wc = wid & 3, fr = lane & 15, fq = lane >> 4;
    const int nt = K / BK;
    unsigned voffB[2];
#pragma unroll
    for (int i = 0; i < 2; ++i) { int R, C; stage_rc(tid * 16 + i * 8192, R, C); const int Rb = PERM ? ((R & ~31) + perm32(R & 31)) : R; voffB[i] = (unsigned)(Rb * K + C) * 2u; }
    const size_t kstep = (size_t)(BK * 2);
    const size_t hstep = (size_t)HALF * K * 2;
    const unsigned ldsw = (unsigned)wid * 1024u;
    const int aoff = lds_byte(wr * 64 + fr, fq * 8), boff = lds_byte(wc * 32 + fr, fq * 8);
#define GM_SA(b, h) (((b) * 2 + (h)) * HTB)
#define GM_SB(b, h) ((4 + (b) * 2 + (h)) * HTB)
#define GM_STAGEB(bufoff, gbase) do { _Pragma("unroll") for (int _i = 0; _i < 2; ++_i) \
        __builtin_amdgcn_global_load_lds((const unsigned*)((const char*)(gbase) + voffB[_i]), (GM_LAS unsigned*)(lds + (bufoff) + ldsw + _i * 8192), 16, 0, 0); } while (0)
#define GM_STAGEA(bufoff, h, kbyte) do { _Pragma("unroll") for (int _i = 0; _i < 2; ++_i) \
        __builtin_amdgcn_global_load_lds((const unsigned*)(A + (size_t)offA[h][_i] + (kbyte)), (GM_LAS unsigned*)(lds + (bufoff) + ldsw + _i * 8192), 16, 0, 0); } while (0)
#define GM_LDA(dst, b, h) do { _Pragma("unroll") for (int m = 0; m < 4; ++m) _Pragma("unroll") for (int k = 0; k < 2; ++k) dst[m][k] = *(const GM_LAS bf16x8*)(lds + GM_SA(b, h) + aoff + m * 2048 + k * 1024); } while (0)
#define GM_LDB(dst, b, h) do { _Pragma("unroll") for (int n = 0; n < 2; ++n) _Pragma("unroll") for (int k = 0; k < 2; ++k) dst[n][k] = *(const GM_LAS bf16x8*)(lds + GM_SB(b, h) + boff + n * 2048 + k * 1024); } while (0)
#define GM_MMA(ai, bj, At, Bt_) do { __builtin_amdgcn_s_setprio(1); _Pragma("unroll") for (int m = 0; m < 4; ++m) _Pragma("unroll") for (int n = 0; n < 2; ++n) _Pragma("unroll") for (int k = 0; k < 2; ++k) \
        acc[ai][bj][m][n] = __builtin_amdgcn_mfma_f32_16x16x32_bf16(Bt_[n][k], At[m][k], acc[ai][bj][m][n], 0, 0, 0); __builtin_amdgcn_s_setprio(0); } while (0)
#define GM_WAIT_V(n) asm volatile("s_waitcnt vmcnt(" #n ")" ::: "memory")
#define GM_WAIT_L(n) asm volatile("s_waitcnt lgkmcnt(" #n ")" ::: "memory")
#define GM_BAR __builtin_amdgcn_s_barrier()
#define GM_SCHED __builtin_amdgcn_sched_barrier(0)
    f32x4 acc[2][2][4][2];
#pragma unroll
    for (int a = 0; a < 2; ++a)
#pragma unroll
        for (int b = 0; b < 2; ++b)
#pragma unroll
            for (int m = 0; m < 4; ++m)
#pragma unroll
                for (int n = 0; n < 2; ++n) acc[a][b][m][n] = (f32x4){0.f, 0.f, 0.f, 0.f};
    bf16x8 At[4][2], B0[2][2], B1[2][2];
    const char* cB = Bt;
    GM_STAGEB(GM_SB(0, 0), cB); GM_STAGEA(GM_SA(0, 0), 0, 0); GM_STAGEB(GM_SB(0, 1), cB + hstep); GM_STAGEA(GM_SA(0, 1), 1, 0);
    if (wr == 1) GM_BAR;
    GM_WAIT_V(4); GM_BAR;
    GM_STAGEB(GM_SB(1, 0), cB + kstep); GM_STAGEA(GM_SA(1, 0), 0, kstep); GM_STAGEB(GM_SB(1, 1), cB + hstep + kstep);
    GM_WAIT_V(6); GM_BAR;
    for (int t = 0; t < nt; t += 2) {
        const bool last = (t == nt - 2);
        const size_t k1 = (size_t)(t + 1) * kstep;
        const size_t k2 = last ? 0 : (size_t)(t + 2) * kstep;
        const size_t k3 = k2 + kstep;
        const char* b2 = cB + k2; const char* b3 = cB + k3;
        GM_LDB(B0, 0, 0); GM_SCHED; GM_LDA(At, 0, 0); GM_STAGEA(GM_SA(1, 1), 1, k1);
        GM_WAIT_L(8); GM_BAR; GM_WAIT_L(0); GM_MMA(0, 0, At, B0); GM_BAR; GM_SCHED;
        GM_LDB(B1, 0, 1); GM_STAGEB(GM_SB(0, 0), b2);
        GM_BAR; GM_WAIT_L(0); GM_MMA(0, 1, At, B1); GM_BAR;
        GM_LDA(At, 0, 1); GM_STAGEA(GM_SA(0, 0), 0, k2);
        GM_BAR; GM_WAIT_L(0); GM_MMA(1, 0, At, B0); GM_BAR; GM_SCHED;
        GM_STAGEB(GM_SB(0, 1), b2 + hstep);
        GM_WAIT_V(6); GM_BAR; GM_MMA(1, 1, At, B1); GM_BAR;
        GM_LDB(B0, 1, 0); GM_SCHED; GM_LDA(At, 1, 0); GM_STAGEA(GM_SA(0, 1), 1, k2);
        GM_WAIT_L(8); GM_BAR; GM_WAIT_L(0); GM_MMA(0, 0, At, B0); GM_BAR; GM_SCHED;
        GM_LDB(B1, 1, 1); GM_STAGEB(GM_SB(1, 0), b3);
        GM_BAR; GM_WAIT_L(0); GM_MMA(0, 1, At, B1); GM_BAR;
        GM_LDA(At, 1, 1); GM_STAGEA(GM_SA(1, 0), 0, k3);
        GM_BAR; GM_WAIT_L(0); GM_MMA(1, 0, At, B0); GM_BAR; GM_SCHED;
        GM_STAGEB(GM_SB(1, 1), b3 + hstep);
        GM_WAIT_V(6); GM_BAR; GM_MMA(1, 1, At, B1); GM_BAR;
    }
    E(acc, wr, wc, fr, fq);
    GM_WAIT_V(0);
    if (wr == 0) GM_BAR;
    GM_BAR;
#undef GM_SA
#undef GM_SB
#undef GM_STAGEA
#undef GM_STAGEB
#undef GM_LDA
#undef GM_LDB
#undef GM_MMA
#undef GM_WAIT_V
#undef GM_WAIT_L
#undef GM_BAR
#undef GM_SCHED
}
template <bool PERM, class U, class Sched, class Epi>
__device__ __forceinline__ void gemm_stream(GM_LAS unsigned char* lds, int K, const Sched& S, const Epi& E) {
    int tid = threadIdx.x; asm volatile("" : "+v"(tid));
    const int wid = __builtin_amdgcn_readfirstlane(tid >> 6), lane = tid & 63, wr = wid >> 2, wc = wid & 3, fr = lane & 15, fq = lane >> 4;
    const int nt = K / BK;
    unsigned voffB[2];
#pragma unroll
    for (int i = 0; i < 2; ++i) { int R, C; stage_rc(tid * 16 + i * 8192, R, C); const int Rb = PERM ? ((R & ~31) + perm32(R & 31)) : R; voffB[i] = (unsigned)(Rb * K + C) * 2u; }
    const size_t kstep = (size_t)(BK * 2);
    const size_t hstep = (size_t)HALF * K * 2;
    const unsigned ldsw = (unsigned)wid * 1024u;
    const int aoff = lds_byte(wr * 64 + fr, fq * 8), boff = lds_byte(wc * 32 + fr, fq * 8);
#define GM_SA(b, h) (((b) * 2 + (h)) * HTB)
#define GM_SB(b, h) ((4 + (b) * 2 + (h)) * HTB)
#define GM_STAGEB(bufoff, gbase) do { _Pragma("unroll") for (int _i = 0; _i < 2; ++_i) \
        __builtin_amdgcn_global_load_lds((const unsigned*)((const char*)(gbase) + voffB[_i]), (GM_LAS unsigned*)(lds + (bufoff) + ldsw + _i * 8192), 16, 0, 0); } while (0)
#define GM_STAGEA2(bufoff, abase, o0, o1, kbyte) do { \
        __builtin_amdgcn_global_load_lds((const unsigned*)((abase) + (size_t)(o0) + (kbyte)), (GM_LAS unsigned*)(lds + (bufoff) + ldsw), 16, 0, 0); \
        __builtin_amdgcn_global_load_lds((const unsigned*)((abase) + (size_t)(o1) + (kbyte)), (GM_LAS unsigned*)(lds + (bufoff) + ldsw + 8192), 16, 0, 0); } while (0)
#define GM_LDA(dst, b, h) do { _Pragma("unroll") for (int m = 0; m < 4; ++m) _Pragma("unroll") for (int k = 0; k < 2; ++k) dst[m][k] = *(const GM_LAS bf16x8*)(lds + GM_SA(b, h) + aoff + m * 2048 + k * 1024); } while (0)
#define GM_LDB(dst, b, h) do { _Pragma("unroll") for (int n = 0; n < 2; ++n) _Pragma("unroll") for (int k = 0; k < 2; ++k) dst[n][k] = *(const GM_LAS bf16x8*)(lds + GM_SB(b, h) + boff + n * 2048 + k * 1024); } while (0)
#define GM_MMA(ai, bj, At, Bt_) do { __builtin_amdgcn_s_setprio(1); _Pragma("unroll") for (int m = 0; m < 4; ++m) _Pragma("unroll") for (int n = 0; n < 2; ++n) _Pragma("unroll") for (int k = 0; k < 2; ++k) \
        acc[ai][bj][m][n] = __builtin_amdgcn_mfma_f32_16x16x32_bf16(Bt_[n][k], At[m][k], acc[ai][bj][m][n], 0, 0, 0); __builtin_amdgcn_s_setprio(0); } while (0)
#define GM_WAIT_V(n) asm volatile("s_waitcnt vmcnt(" #n ")" ::: "memory")
#define GM_WAIT_L(n) asm volatile("s_waitcnt lgkmcnt(" #n ")" ::: "memory")
#define GM_BAR __builtin_amdgcn_s_barrier()
#define GM_SCHED __builtin_amdgcn_sched_barrier(0)
    U cur, nxt; int ui = 0;
    if (!S(0, cur)) return;
    f32x4 acc[2][2][4][2];
#pragma unroll
    for (int a = 0; a < 2; ++a)
#pragma unroll
        for (int b = 0; b < 2; ++b)
#pragma unroll
            for (int m = 0; m < 4; ++m)
#pragma unroll
                for (int n = 0; n < 2; ++n) acc[a][b][m][n] = (f32x4){0.f, 0.f, 0.f, 0.f};
    bf16x8 At[4][2], B0[2][2], B1[2][2];
    GM_STAGEB(GM_SB(0, 0), cur.B); GM_STAGEA2(GM_SA(0, 0), cur.A, cur.offA[0][0], cur.offA[0][1], 0); GM_STAGEB(GM_SB(0, 1), cur.B + hstep); GM_STAGEA2(GM_SA(0, 1), cur.A, cur.offA[1][0], cur.offA[1][1], 0);
    if (wr == 1) GM_BAR;
    GM_WAIT_V(4); GM_BAR;
    GM_STAGEB(GM_SB(1, 0), cur.B + kstep); GM_STAGEA2(GM_SA(1, 0), cur.A, cur.offA[0][0], cur.offA[0][1], kstep); GM_STAGEB(GM_SB(1, 1), cur.B + hstep + kstep);
    GM_WAIT_V(6); GM_BAR;
    for (;;) {
        const bool has_next = S(ui + 1, nxt);
        for (int t = 0; t < nt; t += 2) {
            const bool last = (t == nt - 2); const bool usen = last && has_next;
            const size_t k1 = (size_t)(t + 1) * kstep;
            const size_t k2 = last ? 0 : (size_t)(t + 2) * kstep, k3 = k2 + kstep;
            const char* a2b = usen ? nxt.A : cur.A; const char* b2b = usen ? nxt.B : cur.B;
            const unsigned o00 = usen ? nxt.offA[0][0] : cur.offA[0][0], o01 = usen ? nxt.offA[0][1] : cur.offA[0][1], o10 = usen ? nxt.offA[1][0] : cur.offA[1][0], o11 = usen ? nxt.offA[1][1] : cur.offA[1][1];
            const char* b2 = b2b + k2; const char* b3 = b2b + k3;
            GM_LDB(B0, 0, 0); GM_SCHED; GM_LDA(At, 0, 0); GM_STAGEA2(GM_SA(1, 1), cur.A, cur.offA[1][0], cur.offA[1][1], k1);
            GM_WAIT_L(8); GM_BAR; GM_WAIT_L(0); GM_MMA(0, 0, At, B0); GM_BAR; GM_SCHED;
            GM_LDB(B1, 0, 1); GM_STAGEB(GM_SB(0, 0), b2);
            GM_BAR; GM_WAIT_L(0); GM_MMA(0, 1, At, B1); GM_BAR;
            GM_LDA(At, 0, 1); GM_STAGEA2(GM_SA(0, 0), a2b, o00, o01, k2);
            GM_BAR; GM_WAIT_L(0); GM_MMA(1, 0, At, B0); GM_BAR; GM_SCHED;
            GM_STAGEB(GM_SB(0, 1), b2 + hstep);
            GM_WAIT_V(6); GM_BAR; GM_MMA(1, 1, At, B1); GM_BAR;
            GM_LDB(B0, 1, 0); GM_SCHED; GM_LDA(At, 1, 0); GM_STAGEA2(GM_SA(0, 1), a2b, o10, o11, k2);
            GM_WAIT_L(8); GM_BAR; GM_WAIT_L(0); GM_MMA(0, 0, At, B0); GM_BAR; GM_SCHED;
            GM_LDB(B1, 1, 1); GM_STAGEB(GM_SB(1, 0), b3);
            GM_BAR; GM_WAIT_L(0); GM_MMA(0, 1, At, B1); GM_BAR;
            GM_LDA(At, 1, 1); GM_STAGEA2(GM_SA(1, 0), a2b, o00, o01, k3);
            GM_BAR; GM_WAIT_L(0); GM_MMA(1, 0, At, B0); GM_BAR; GM_SCHED;
            GM_STAGEB(GM_SB(1, 1), b3 + hstep);
            GM_WAIT_V(6); GM_BAR; GM_MMA(1, 1, At, B1); GM_BAR;
        }
        E(acc, cur, wr, wc, fr, fq);
        if (!has_next) break;
#pragma unroll
        for (int a = 0; a < 2; ++a)
#pragma unroll
            for (int b = 0; b < 2; ++b)
#pragma unroll
                for (int m = 0; m < 4; ++m)
#pragma unroll
                    for (int n = 0; n < 2; ++n) acc[a][b][m][n] = (f32x4){0.f, 0.f, 0.f, 0.f};
        cur = nxt; ++ui;
    }
    GM_WAIT_V(0);
    if (wr == 0) GM_BAR;
    GM_BAR;
#undef GM_SA
#undef GM_SB
#undef GM_STAGEA2
#undef GM_STAGEB
#undef GM_LDA
#undef GM_LDB
#undef GM_MMA
#undef GM_WAIT_V
#undef GM_WAIT_L
#undef GM_BAR
#undef GM_SCHED
}
__device__ __forceinline__ void dense_offA(unsigned (&offA)[2][2], long row0, int K) {
    int tid = threadIdx.x; asm volatile("" : "+v"(tid));
#pragma unroll
    for (int i = 0; i < 2; ++i) { int R, C; stage_rc(tid * 16 + i * 8192, R, C);
#pragma unroll
        for (int h = 0; h < 2; ++h) offA[h][i] = (unsigned)(((row0 + h * HALF + R) * K + C) * 2); }
}
}

struct FW {
    bf16_t *w_in_t, *w_out_t, *gu_t, *d_t;
    bf16_t *hb1, *hb2, *mixb, *actb, *yb;
    bf16_t* projb;
    float *proj2, *mix2;
    bf16_t *w_uq_t, *w_ukv_t;
    float *ropec, *ropes;
    bf16_t *qb2, *kb2, *vb2;
    bf16_t* opart; float* aml;
    float *yd2, *st2, *cdec2, *cs2; bf16_t *cg, *prevb, *ssdb2;
};
constexpr int INC_PAD = 1792;
template <int MAP> __device__ __forceinline__ void cvt_tile(const float* src, int ldn, int nvalid, bf16_t* dst, int K, int k0, int n0, float* T) {
    int tid = threadIdx.x; asm volatile("" : "+v"(tid)); const int r = tid >> 4, c4 = (tid & 15) * 4;
#pragma unroll
    for (int i = 0; i < 2; ++i) { const int kk = r + 32 * i; float4 v = make_float4(0.f, 0.f, 0.f, 0.f);
        if (n0 + c4 < nvalid) v = *(const float4*)(src + (size_t)(k0 + kk) * ldn + n0 + c4);
        T[kk * 65 + c4 + 0] = v.x; T[kk * 65 + c4 + 1] = v.y; T[kk * 65 + c4 + 2] = v.z; T[kk * 65 + c4 + 3] = v.w; }
    __syncthreads();
    { const int n = tid >> 3, kc = tid & 7; float f[8];
#pragma unroll
        for (int j = 0; j < 8; ++j) f[j] = T[(kc * 8 + j) * 65 + n];
        gm::u32x4 w; w.x = gm::cvt_pk_bf16(f[0], f[1]); w.y = gm::cvt_pk_bf16(f[2], f[3]); w.z = gm::cvt_pk_bf16(f[4], f[5]); w.w = gm::cvt_pk_bf16(f[6], f[7]);
        const int nn = n0 + n; const int drow = MAP == 0 ? nn : ((nn >> 7) * 256 + (MAP == 2 ? 128 : 0) + (nn & 127));
        *(gm::u32x4*)(dst + (size_t)drow * K + k0 + kc * 8) = w; }
    __syncthreads();
}
template <int MAP> __device__ __forceinline__ void cvt_strip(const float* src, int ldn, int nvalid, bf16_t* dst, int K, int k0, int n0, float* T) {
    int tid = threadIdx.x; asm volatile("" : "+v"(tid)); const int r = tid >> 4, c4 = (tid & 15) * 4;
    float4 v[4][2];
#pragma unroll
    for (int t = 0; t < 4; ++t)
#pragma unroll
        for (int i = 0; i < 2; ++i) { v[t][i] = make_float4(0.f, 0.f, 0.f, 0.f); if (n0 + t * 64 + c4 < nvalid) v[t][i] = *(const float4*)(src + (size_t)(k0 + r + 32 * i) * ldn + n0 + t * 64 + c4); }
#pragma unroll
    for (int t = 0; t < 4; ++t)
#pragma unroll
        for (int i = 0; i < 2; ++i) { float* q = T + t * (64 * 65) + (r + 32 * i) * 65 + c4; q[0] = v[t][i].x; q[1] = v[t][i].y; q[2] = v[t][i].z; q[3] = v[t][i].w; }
    __syncthreads();
    { const int n = tid >> 3, kc = tid & 7;
#pragma unroll
        for (int t = 0; t < 4; ++t) { float f[8];
#pragma unroll
            for (int j = 0; j < 8; ++j) f[j] = T[t * (64 * 65) + (kc * 8 + j) * 65 + n];
            gm::u32x4 w; w.x = gm::cvt_pk_bf16(f[0], f[1]); w.y = gm::cvt_pk_bf16(f[2], f[3]); w.z = gm::cvt_pk_bf16(f[4], f[5]); w.w = gm::cvt_pk_bf16(f[6], f[7]);
            const int nn = n0 + t * 64 + n; const int drow = MAP == 0 ? nn : ((nn >> 7) * 256 + (MAP == 2 ? 128 : 0) + (nn & 127));
            *(gm::u32x4*)(dst + (size_t)drow * K + k0 + kc * 8) = w; } }
    __syncthreads();
}
__device__ __forceinline__ void cvt_phase(const P& p, const FW& f, int l0, int l1, char* lds) {
    float* T = (float*)lds;
    constexpr int T_IN = 16 * 7, T_OUT = 16 * 4, T_E = 16 * 4, T_UQ = 4 * 9, T_UKV = 2 * 12, T_LAYER = T_IN + T_OUT + T_UQ + T_UKV + NE * 3 * T_E;
    const int total = (l1 - l0) * T_LAYER;
    if (blockIdx.x == gridDim.x - 1) for (int i = threadIdx.x; i < 256 * 8; i += 512) { float cs, sn; sincos_rr((float)(i >> 3) * rope_inv_freq(i & 7), cs, sn); f.ropec[i] = cs; f.ropes[i] = sn; }
    for (int t = blockIdx.x; t < total; t += gridDim.x) {
        const int l = l0 + t / T_LAYER; int r = t % T_LAYER;
        if (r < T_IN) { const int kt = r / 7, ntl = r % 7; cvt_strip<0>(p.w_in + (size_t)l * D * INC, INC, INC, f.w_in_t + (size_t)l * INC_PAD * D, D, kt * 64, ntl * 256, T); continue; }
        r -= T_IN;
        if (r < T_OUT) { const int kt = r / 4, ntl = r % 4; cvt_strip<0>(p.w_out + (size_t)l * MIXW * D, D, D, f.w_out_t + (size_t)l * D * MIXW, MIXW, kt * 64, ntl * 256, T); continue; }
        r -= T_OUT;
        if (r < T_UQ) { const int kt = r / 9, ntl = r % 9; cvt_tile<0>(p.w_uq + (size_t)l * QL * NH * QKD, NH * QKD, NH * QKD, f.w_uq_t + (size_t)l * NH * QKD * QL, QL, kt * 64, ntl * 64, T); continue; }
        r -= T_UQ;
        if (r < T_UKV) { const int kt = r / 12, ntl = r % 12; cvt_tile<0>(p.w_ukv + (size_t)l * KVL * NH * 128, NH * 128, NH * 128, f.w_ukv_t + (size_t)l * NH * 128 * KVL, KVL, kt * 64, ntl * 64, T); continue; }
        r -= T_UKV;
        const int e = r / (3 * T_E), which = (r / T_E) % 3, tt = r % T_E, kt = tt / 4, ntl = tt % 4; const size_t le = (size_t)l * NE + e;
        if (which == 0) cvt_strip<1>(p.wg + le * D * FF, FF, FF, f.gu_t + le * 2 * FF * D, D, kt * 64, ntl * 256, T);
        else if (which == 1) cvt_strip<2>(p.wu + le * D * FF, FF, FF, f.gu_t + le * 2 * FF * D, D, kt * 64, ntl * 256, T);
        else cvt_strip<0>(p.wd + le * FF * D, D, D, f.d_t + le * D * FF, FF, kt * 64, ntl * 256, T);
    }
}
struct UDense { const char* A; unsigned offA[2][2]; const char* B; int pm, pn; };
__device__ __forceinline__ void inproj_phase(const P& p, const FW& f, int l, bf16_t* dst, char* lds) {
    constexpr int NPN = INC_PAD / 256, NU = (M / 256) * NPN;
    auto sched = [&](int i, UDense& u) { const int uu = blockIdx.x + i * gridDim.x; if (uu >= NU) return false; u.pm = uu / NPN; u.pn = uu % NPN; u.A = (const char*)f.hb1; gm::dense_offA(u.offA, (long)u.pm * 256, D);
        u.B = (const char*)(f.w_in_t + ((size_t)l * INC_PAD + u.pn * 256) * D); return true; };
    auto epi = [&](const gm::f32x4 (&acc)[2][2][4][2], const UDense& u, int wr, int wc, int fr, int fq) {
        const int row0 = u.pm * 256 + wr * 64 + fr, col0 = u.pn * 256 + wc * 32 + 8 * fq;
#pragma unroll
        for (int ai = 0; ai < 2; ++ai)
#pragma unroll
            for (int m = 0; m < 4; ++m) { bf16_t* rowp = dst + (size_t)(row0 + ai * 128 + m * 16) * INC_PAD + col0;
#pragma unroll
                for (int bj = 0; bj < 2; ++bj) { const gm::f32x4 v0 = acc[ai][bj][m][0], v1 = acc[ai][bj][m][1];
                    gm::u32x4 w; w.x = gm::cvt_pk_bf16(v0[0], v0[1]); w.y = gm::cvt_pk_bf16(v0[2], v0[3]); w.z = gm::cvt_pk_bf16(v1[0], v1[1]); w.w = gm::cvt_pk_bf16(v1[2], v1[3]);
                    *(gm::u32x4*)(rowp + bj * 128) = w; } } };
    gm::gemm_stream<true, UDense>((GM_LAS unsigned char*)lds, D, sched, epi);
}
template <bool TOX> __device__ __forceinline__ void outproj_phase(const P& p, const FW& f, int l, float* dst, char* lds) {
    constexpr int NPN = D / 256, NU = (M / 256) * NPN;
    auto sched = [&](int i, UDense& u) { const int uu = blockIdx.x + i * gridDim.x; if (uu >= NU) return false; u.pm = uu / NPN; u.pn = uu % NPN; u.A = (const char*)f.mixb; gm::dense_offA(u.offA, (long)u.pm * 256, MIXW);
        u.B = (const char*)(f.w_out_t + ((size_t)l * D + u.pn * 256) * MIXW); return true; };
    auto epi = [&](const gm::f32x4 (&acc)[2][2][4][2], const UDense& u, int wr, int wc, int fr, int fq) {
        const int row0 = u.pm * 256 + wr * 64 + fr, col0 = u.pn * 256 + wc * 32 + 4 * fq; const float* gate = modv(p, l, u.pm * 256, 2);
#pragma unroll
        for (int ai = 0; ai < 2; ++ai)
#pragma unroll
            for (int m = 0; m < 4; ++m) { float* rowp = dst + (size_t)(row0 + ai * 128 + m * 16) * D + col0;
#pragma unroll
                for (int bj = 0; bj < 2; ++bj)
#pragma unroll
                    for (int n = 0; n < 2; ++n) { float* q = rowp + bj * 128 + n * 16;
                        if (TOX) { const gm::f32x4 g = *(const gm::f32x4*)(gate + col0 + bj * 128 + n * 16); const gm::f32x4 x = *(const gm::f32x4*)q; *(gm::f32x4*)q = x + g * acc[ai][bj][m][n]; }
                        else *(gm::f32x4*)q = acc[ai][bj][m][n]; } } };
    gm::gemm_stream<false, UDense>((GM_LAS unsigned char*)lds, MIXW, sched, epi);
}
__device__ __forceinline__ bool moe_find(const int* cnt, int tg, int& e, int& ti, int& c) {
    int acc = 0;
    for (int x = 0; x < NE; ++x) { const int cx = cnt[x]; const int nt = (cx + 255) >> 8; if (tg < acc + nt) { e = x; ti = tg - acc; c = cx; return true; } acc += nt; }
    return false;
}
__device__ __forceinline__ int moe_tiles(const int* cnt) { int acc = 0; for (int x = 0; x < NE; ++x) acc += (cnt[x] + 255) >> 8; return acc; }
template <bool SRC_TOK> __device__ __forceinline__ void gather_offA(unsigned (&offA)[2][2], const int* lst, int base, int cnt, int K) {
    int tid = threadIdx.x; asm volatile("" : "+v"(tid));
#pragma unroll
    for (int i = 0; i < 2; ++i) { int R, C; gm::stage_rc(tid * 16 + i * 8192, R, C);
#pragma unroll
        for (int h = 0; h < 2; ++h) { const int s = base + h * 128 + R; int a = s < cnt ? lst[s] : 0; if (SRC_TOK) a >>= 2; offA[h][i] = (unsigned)(((size_t)a * K + C) * 2); } }
}
__device__ __forceinline__ void moe1_phase(const P& p, const FW& f, int l, char* lds) {
    constexpr int NPN = 2 * FF / 256; const int NU = moe_tiles(p.cnt) * NPN;
    for (int u = blockIdx.x; u < NU; u += gridDim.x) {
        int e, ti, cnt; if (!moe_find(p.cnt, u / NPN, e, ti, cnt)) break; const int pn = u % NPN; const int* lst = p.list + (size_t)e * M; const size_t le = (size_t)l * NE + e;
        unsigned offA[2][2]; gather_offA<true>(offA, lst, ti * 256, cnt, D);
        auto epi = [&](const gm::f32x4 (&acc)[2][2][4][2], int wr, int wc, int fr, int fq) {
            const int ff0 = pn * 128 + wc * 32 + 8 * fq; const float* bgp = p.bg + le * FF + ff0; const float* bup = p.bu + le * FF + ff0;
            const gm::f32x4 bg0 = *(const gm::f32x4*)bgp, bg1 = *(const gm::f32x4*)(bgp + 4), bu0 = *(const gm::f32x4*)bup, bu1 = *(const gm::f32x4*)(bup + 4);
#pragma unroll
            for (int ai = 0; ai < 2; ++ai)
#pragma unroll
                for (int m = 0; m < 4; ++m) { const int s = ti * 256 + ai * 128 + wr * 64 + m * 16 + fr; if (s < cnt) { const int a = lst[s]; float o[8];
#pragma unroll
                        for (int n = 0; n < 2; ++n)
#pragma unroll
                            for (int j = 0; j < 4; ++j) { float g = acc[ai][0][m][n][j] + (n ? bg1[j] : bg0[j]); float uu = acc[ai][1][m][n][j] + (n ? bu1[j] : bu0[j]);
                                g = g < 7.0f ? g : 7.0f; uu = uu < -7.0f ? -7.0f : (uu > 7.0f ? 7.0f : uu); o[n * 4 + j] = g * (1.0f / (1.0f + __expf(-1.702f * g))) * (uu + 1.0f); }
                        gm::u32x4 w; w.x = gm::cvt_pk_bf16(o[0], o[1]); w.y = gm::cvt_pk_bf16(o[2], o[3]); w.z = gm::cvt_pk_bf16(o[4], o[5]); w.w = gm::cvt_pk_bf16(o[6], o[7]);
                        *(gm::u32x4*)(f.actb + (size_t)a * FF + ff0) = w; } } };
        gm::gemm_unit<true>((GM_LAS unsigned char*)lds, (const char*)f.hb2, offA, (const char*)(f.gu_t + (le * 2 * FF + pn * 256) * D), D, epi);
    }
}
__device__ __forceinline__ void moe2_phase(const P& p, const FW& f, int l, char* lds) {
    constexpr int NPN = D / 256; const int NU = moe_tiles(p.cnt) * NPN;
    for (int u = blockIdx.x; u < NU; u += gridDim.x) {
        int e, ti, cnt; if (!moe_find(p.cnt, u / NPN, e, ti, cnt)) break; const int pn = u % NPN; const int* lst = p.list + (size_t)e * M; const size_t le = (size_t)l * NE + e;
        unsigned offA[2][2]; gather_offA<false>(offA, lst, ti * 256, cnt, FF);
        auto epi = [&](const gm::f32x4 (&acc)[2][2][4][2], int wr, int wc, int fr, int fq) {
#pragma unroll
            for (int bj = 0; bj < 2; ++bj) { const int c0 = pn * 256 + bj * 128 + wc * 32 + 8 * fq; const float* bp = p.bd + le * D + c0; const gm::f32x4 b0 = *(const gm::f32x4*)bp, b1 = *(const gm::f32x4*)(bp + 4);
#pragma unroll
                for (int ai = 0; ai < 2; ++ai)
#pragma unroll
                    for (int m = 0; m < 4; ++m) { const int s = ti * 256 + ai * 128 + wr * 64 + m * 16 + fr; if (s < cnt) { const int a = lst[s];
                            const gm::f32x4 v0 = acc[ai][bj][m][0] + b0, v1 = acc[ai][bj][m][1] + b1;
                            gm::u32x4 w; w.x = gm::cvt_pk_bf16(v0[0], v0[1]); w.y = gm::cvt_pk_bf16(v0[2], v0[3]); w.z = gm::cvt_pk_bf16(v1[0], v1[1]); w.w = gm::cvt_pk_bf16(v1[2], v1[3]);
                            *(gm::u32x4*)(f.yb + (size_t)a * D + c0) = w; } } } };
        gm::gemm_unit<true>((GM_LAS unsigned char*)lds, (const char*)f.actb, offA, (const char*)(f.d_t + (le * D + pn * 256) * FF), FF, epi);
    }
}

namespace rw {
typedef float f32x4 __attribute__((ext_vector_type(4)));
typedef unsigned u32x2 __attribute__((ext_vector_type(2)));
constexpr int ROWS_PB = 65;
__device__ __forceinline__ float wave_sum(float v) {
#pragma unroll
    for (int o = 32; o >= 1; o >>= 1) v += __shfl_xor(v, o);
    return v;
}
__device__ __forceinline__ unsigned pk2(float lo, float hi) { unsigned r; asm volatile("v_cvt_pk_bf16_f32 %0, %1, %2" : "=v"(r) : "v"(lo), "v"(hi)); return r; }
__device__ __forceinline__ float ld1(const bf16_t* q) { return __uint_as_float(((unsigned)*q) << 16); }
__device__ __forceinline__ f32x4 bf4(u32x2 w) { f32x4 r; r[0] = __uint_as_float(w.x << 16); r[1] = __uint_as_float(w.x & 0xffff0000u); r[2] = __uint_as_float(w.y << 16); r[3] = __uint_as_float(w.y & 0xffff0000u); return r; }
__device__ __forceinline__ f32x4 ld4(const bf16_t* q) { return bf4(*(const u32x2*)q); }
__device__ __forceinline__ void norm_store(const f32x4 (&x)[4], const float* g, const float* shift, const float* scale, bf16_t* dst, int lane) {
    float ss = 0.f;
#pragma unroll
    for (int j = 0; j < 4; ++j) ss += x[j][0] * x[j][0] + x[j][1] * x[j][1] + x[j][2] * x[j][2] + x[j][3] * x[j][3];
    ss = wave_sum(ss); const float rs = 1.0f / sqrtf(ss * (1.0f / D) + EPS);
#pragma unroll
    for (int j = 0; j < 4; ++j) { const int c = 4 * lane + 256 * j; const f32x4 gv = *(const f32x4*)(g + c), sh = *(const f32x4*)(shift + c), sc = *(const f32x4*)(scale + c);
        const f32x4 o = x[j] * rs * gv * (1.0f + sc) + sh; u32x2 w; w.x = pk2(o[0], o[1]); w.y = pk2(o[2], o[3]); *(u32x2*)(dst + c) = w; }
}
__device__ __forceinline__ void first_norm_phase(const P& p) {
    int tid = threadIdx.x; asm volatile("" : "+v"(tid)); const int wid = tid >> 6, lane = tid & 63;
    for (int i = wid; i < ROWS_PB; i += 8) { const int r = blockIdx.x * ROWS_PB + i; if (r >= M) break;
        const float* src = r < CTX ? p.ctx + (size_t)r * D : p.x + (size_t)(r - CTX) * D; f32x4 x[4];
#pragma unroll
        for (int j = 0; j < 4; ++j) { x[j] = *(const f32x4*)(src + 4 * lane + 256 * j); *(f32x4*)(p.xres + (size_t)r * D + 4 * lane + 256 * j) = x[j]; }
        norm_store(x, p.norm1_g, modv(p, 0, r, 0), modv(p, 0, r, 1), p.hb1 + (size_t)r * D, lane); }
}
template <bool DRY = false> __device__ __forceinline__ void combine_phase(const P& p, int l) {
    int tid = threadIdx.x; asm volatile("" : "+v"(tid)); const int wid = tid >> 6, lane = tid & 63;
    for (int i = wid; i < ROWS_PB; i += 8) { const int r = blockIdx.x * ROWS_PB + i; if (r >= M) break;
        const f32x4 tw = *(const f32x4*)(p.topw + (size_t)r * 4); const float* gate = modv(p, l, r, 5); f32x4 x[4];
#pragma unroll
        for (int j = 0; j < 4; ++j) { const int c = 4 * lane + 256 * j; f32x4 s = {0.f, 0.f, 0.f, 0.f};
#pragma unroll
            for (int k = 0; k < 4; ++k) s += bf4(*(const u32x2*)(p.ybn + ((size_t)r * 4 + k) * D + c)) * tw[k];
            x[j] = *(const f32x4*)(p.xres + (size_t)r * D + c) + *(const f32x4*)(gate + c) * s; }
        if (l + 1 < DEPTH) {
#pragma unroll
            for (int j = 0; j < 4; ++j) if (!DRY) *(f32x4*)(p.xres + (size_t)r * D + 4 * lane + 256 * j) = x[j];
            norm_store(x, p.norm1_g + (size_t)(l + 1) * D, modv(p, l + 1, r, 0), modv(p, l + 1, r, 1), p.hb1 + (size_t)r * D, lane);
        } else if (r >= CTX) {
#pragma unroll
            for (int j = 0; j < 4; ++j) *(f32x4*)(p.out + (size_t)(r - CTX) * D + 4 * lane + 256 * j) = x[j];
        } }
}
template <bool DRY = false> __device__ __forceinline__ void router_phase(const P& p, int l, char* lds) {
    int tid = threadIdx.x; asm volatile("" : "+v"(tid)); const int wid = tid >> 6, lane = tid & 63;
    float* WT = (float*)lds; float* bias2 = WT + 32 * 1024; int* lcnt = (int*)(bias2 + 64); int* lbase = lcnt + 32; int* rec = lbase + 32;
    const float* rwp = p.router_w + (size_t)l * D * NE;
    for (int i = tid; i < D * NE / 4; i += 512) { const int k = i >> 3, e4 = i & 7; const f32x4 v = *(const f32x4*)(rwp + (size_t)k * NE + e4 * 4);
#pragma unroll
        for (int q = 0; q < 4; ++q) WT[(e4 * 4 + q) * 1024 + (k ^ (e4 << 2))] = v[q]; }
    if (tid < 32) lcnt[tid] = 0;
    __syncthreads();
    {
#pragma unroll
        for (int v = 0; v < 2; ++v) { const float* sh = p.mod + ((size_t)(l * 2 + v) * 6 + 3) * D; f32x4 s[4];
#pragma unroll
            for (int j = 0; j < 4; ++j) s[j] = *(const f32x4*)(sh + 4 * lane + 256 * j);
#pragma unroll
            for (int q = 0; q < 4; ++q) { const int e = wid * 4 + q; float a = 0.f;
#pragma unroll
                for (int j = 0; j < 4; ++j) { const f32x4 w = *(const f32x4*)(WT + e * 1024 + ((4 * lane + 256 * j) ^ (((e >> 2) & 7) << 2))); a += w[0] * s[j][0] + w[1] * s[j][1] + w[2] * s[j][2] + w[3] * s[j][3]; }
                a = wave_sum(a); if (lane == 0) bias2[v * 32 + e] = a + p.router_b[l * NE + e]; } }
    }
    __syncthreads();
    const float* g2 = p.norm2_g + (size_t)l * D;
    for (int rp = wid; rp < (ROWS_PB + 1) / 2; rp += 8) {
        float acc[2][32]; float rsv[2]; int rr[2];
        f32x4 xg[2][4];
#pragma unroll
        for (int q = 0; q < 2; ++q) { const int il = 2 * rp + q; const int r = blockIdx.x * ROWS_PB + (il < ROWS_PB ? il : ROWS_PB - 1); rr[q] = r;
            const float* sc = modv(p, l, r, 4); const float* sh = modv(p, l, r, 3); float ss = 0.f; f32x4 x[4];
#pragma unroll
            for (int j = 0; j < 4; ++j) { x[j] = *(const f32x4*)(p.xres + (size_t)r * D + 4 * lane + 256 * j); ss += x[j][0] * x[j][0] + x[j][1] * x[j][1] + x[j][2] * x[j][2] + x[j][3] * x[j][3]; }
            ss = wave_sum(ss); const float rs = 1.0f / sqrtf(ss * (1.0f / D) + EPS); rsv[q] = rs;
#pragma unroll
            for (int j = 0; j < 4; ++j) { const int c = 4 * lane + 256 * j; xg[q][j] = x[j] * *(const f32x4*)(g2 + c) * (1.0f + *(const f32x4*)(sc + c));
                const f32x4 o = xg[q][j] * rs + *(const f32x4*)(sh + c); u32x2 w; w.x = pk2(o[0], o[1]); w.y = pk2(o[2], o[3]); if (il < ROWS_PB) *(u32x2*)(p.hb2 + (size_t)r * D + c) = w; }
        }
#pragma unroll
        for (int e = 0; e < 32; ++e) { float a0 = 0.f, a1 = 0.f;
#pragma unroll
            for (int j = 0; j < 4; ++j) { const f32x4 w = *(const f32x4*)(WT + e * 1024 + ((4 * lane + 256 * j) ^ (((e >> 2) & 7) << 2)));
                a0 += w[0] * xg[0][j][0] + w[1] * xg[0][j][1] + w[2] * xg[0][j][2] + w[3] * xg[0][j][3]; a1 += w[0] * xg[1][j][0] + w[1] * xg[1][j][1] + w[2] * xg[1][j][2] + w[3] * xg[1][j][3]; }
            acc[0][e] = a0; acc[1][e] = a1; }
        float v[64];
#pragma unroll
        for (int e = 0; e < 32; ++e) { v[e] = acc[0][e]; v[32 + e] = acc[1][e]; }
#pragma unroll
        for (int m = 32, n = 64; m >= 1; m >>= 1, n >>= 1) {
#pragma unroll
            for (int i = 0; i < n / 2; ++i) { const bool up = (lane & m) != 0; const float keep = up ? v[i + n / 2] : v[i], send = up ? v[i] : v[i + n / 2]; v[i] = keep + __shfl_xor(send, m); } }
        const int q = lane >> 5, e = lane & 31; const int r = rr[q]; const int il = 2 * rp + q;
        float logit = v[0] * rsv[q] + bias2[(r < CTX ? 32 : 0) + e];
        float cur = logit; int sel[4]; float sv[4];
#pragma unroll
        for (int k = 0; k < 4; ++k) { float mx = cur;
#pragma unroll
            for (int o = 16; o >= 1; o >>= 1) mx = fmaxf(mx, __shfl_xor(mx, o));
            const unsigned long long bal = __ballot(cur == mx); const unsigned half = (unsigned)(bal >> (q * 32)); const int win = __ffs(half) - 1;
            sel[k] = win; sv[k] = mx; if (e == win) cur = -3.0e38f; }
        if (e < 4 && il < ROWS_PB) {
            float es[4], sum = 0.f;
#pragma unroll
            for (int k = 0; k < 4; ++k) { es[k] = __expf(sv[k] - sv[0]); sum += es[k]; }
            const int myk = e; const int mye = myk == 0 ? sel[0] : myk == 1 ? sel[1] : myk == 2 ? sel[2] : sel[3]; const float myw = (myk == 0 ? es[0] : myk == 1 ? es[1] : myk == 2 ? es[2] : es[3]) / sum;
            if (!DRY) p.topw[(size_t)r * 4 + myk] = myw; const int pos = atomicAdd(&lcnt[mye], 1); rec[il * 4 + myk] = mye | (pos << 8);
        }
    }
    __syncthreads();
    if (tid < 32) lbase[tid] = DRY ? 0 : atomicAdd(&p.cnt[tid], lcnt[tid]);
    __syncthreads();
    if (tid < ROWS_PB * 4) { const int il = tid >> 2, k = tid & 3; const int r = blockIdx.x * ROWS_PB + il; const int rc = rec[tid]; const int e = rc & 255, pos = rc >> 8;
        if (!DRY) p.list[(size_t)e * M + lbase[e] + pos] = r * 4 + k; }
    __syncthreads();
}
}

namespace ml {
typedef short bf16x8 __attribute__((ext_vector_type(8)));
typedef float f32x4 __attribute__((ext_vector_type(4)));
typedef unsigned u32x2 __attribute__((ext_vector_type(2)));
constexpr int RB = 65, MT = 5;
constexpr int AQ_STRIDE = QL * 2 + 16, AKV_STRIDE = KVL * 2 + 16;
constexpr int OFF_AQ = 0, OFF_AKV = OFF_AQ + 80 * AQ_STRIDE, OFF_KRS = OFF_AKV + 80 * AKV_STRIDE, OFF_KSS = OFF_KRS + 80 * 32 * 4, LDS_MLA = OFF_KSS + 80 * 4;
struct MW { const bf16_t* w_uq_t; const bf16_t* w_ukv_t; const float* ropec; const float* ropes; const bf16_t* proj; int ldp; bf16_t* qb; bf16_t* kb; bf16_t* vb; };
__device__ __forceinline__ void mla_phase(const P& p, const MW& w, int l, char* lds) {
    int tid = threadIdx.x; asm volatile("" : "+v"(tid)); const int wid = __builtin_amdgcn_readfirstlane(tid >> 6), lane = tid & 63, fr = lane & 15, fq = lane >> 4;
    const int row0 = blockIdx.x * RB;
    for (int i = wid; i < 80; i += 8) {
        char* aq = lds + OFF_AQ + i * AQ_STRIDE; char* akv = lds + OFF_AKV + i * AKV_STRIDE; float* krs = (float*)(lds + OFF_KRS) + i * 32;
        if (i < RB && row0 + i < M) { const bf16_t* pr = w.proj + (size_t)(row0 + i) * w.ldp;
            { const f32x4 x = rw::ld4(pr + C_Q + 4 * lane); float ss = rw::wave_sum(x[0] * x[0] + x[1] * x[1] + x[2] * x[2] + x[3] * x[3]); const float rs = 1.0f / sqrtf(ss * (1.0f / QL) + EPS);
              const f32x4 g = *(const f32x4*)(p.q_g + l * QL + 4 * lane); const f32x4 o = x * rs * g; u32x2 v; v.x = rw::pk2(o[0], o[1]); v.y = rw::pk2(o[2], o[3]); *(u32x2*)(aq + 8 * lane) = v; }
            { f32x4 x = {0.f, 0.f, 0.f, 0.f}; if (lane < 32) x = rw::ld4(pr + C_KV + 4 * lane); float ss = rw::wave_sum(x[0] * x[0] + x[1] * x[1] + x[2] * x[2] + x[3] * x[3]); const float rs = 1.0f / sqrtf(ss * (1.0f / KVL) + EPS);
              if (lane < 32) { const f32x4 g = *(const f32x4*)(p.kv_g + l * KVL + 4 * lane); const f32x4 o = x * rs * g; u32x2 v; v.x = rw::pk2(o[0], o[1]); v.y = rw::pk2(o[2], o[3]); *(u32x2*)(akv + 8 * lane) = v; } }
            { f32x4 x = {0.f, 0.f, 0.f, 0.f}; if (lane < 8) { x = rw::ld4(pr + C_KR + 4 * lane); *(f32x4*)(krs + 4 * lane) = x; }
              const float ss = rw::wave_sum(x[0] * x[0] + x[1] * x[1] + x[2] * x[2] + x[3] * x[3]); if (lane == 0) ((float*)(lds + OFF_KSS))[i] = ss; }
        } else {
            u32x2 z; z.x = 0u; z.y = 0u; *(u32x2*)(aq + 8 * lane) = z; if (lane < 32) *(u32x2*)(akv + 8 * lane) = z; if (lane < 32) krs[lane] = 0.f; if (lane == 0) ((float*)(lds + OFF_KSS))[i] = 0.f;
        }
    }
    __syncthreads();
    if (wid < 6) {
        const int hh = wid; f32x4 acc[MT][6];
#pragma unroll
        for (int mt = 0; mt < MT; ++mt)
#pragma unroll
            for (int nt = 0; nt < 6; ++nt) acc[mt][nt] = (f32x4){0.f, 0.f, 0.f, 0.f};
        const bf16_t* wb = w.w_uq_t + (size_t)(hh * QKD + fr) * QL + 8 * fq;
#pragma unroll 1
        for (int ks = 0; ks < QL / 32; ++ks) { bf16x8 b[6], a[MT];
#pragma unroll
            for (int nt = 0; nt < 6; ++nt) b[nt] = *(const bf16x8*)(wb + (size_t)nt * 16 * QL + ks * 32);
#pragma unroll
            for (int mt = 0; mt < MT; ++mt) a[mt] = *(const bf16x8*)(lds + OFF_AQ + (mt * 16 + fr) * AQ_STRIDE + (ks * 32 + 8 * fq) * 2);
#pragma unroll
            for (int mt = 0; mt < MT; ++mt)
#pragma unroll
                for (int nt = 0; nt < 6; ++nt) acc[mt][nt] = __builtin_amdgcn_mfma_f32_16x16x32_bf16(b[nt], a[mt], acc[mt][nt], 0, 0, 0); }
        f32x4 gq[6];
#pragma unroll
        for (int nt = 0; nt < 6; ++nt) gq[nt] = *(const f32x4*)(p.qn_g + l * QKD + nt * 16 + 4 * fq);
#pragma unroll
        for (int mt = 0; mt < MT; ++mt) { const int il = mt * 16 + fr; const int r = row0 + il; const bool ok = il < RB && r < M; float ss = 0.f;
#pragma unroll
            for (int nt = 0; nt < 6; ++nt) ss += acc[mt][nt][0] * acc[mt][nt][0] + acc[mt][nt][1] * acc[mt][nt][1] + acc[mt][nt][2] * acc[mt][nt][2] + acc[mt][nt][3] * acc[mt][nt][3];
            ss += __shfl_xor(ss, 16); ss += __shfl_xor(ss, 32); const float rs = 1.0f / sqrtf(ss * (1.0f / QKD) + EPS);
            const bool lat = r >= CTX; const int t = lat ? r - CTX : 0;
#pragma unroll
            for (int nt = 0; nt < 6; ++nt) { f32x4 v = acc[mt][nt] * rs * gq[nt];
                if (nt >= 4) { f32x4 other; other[0] = __shfl_xor(v[0], 32); other[1] = __shfl_xor(v[1], 32); other[2] = __shfl_xor(v[2], 32); other[3] = __shfl_xor(v[3], 32);
                    if (lat && ok) { const int pos = (nt == 4) ? (t / GRID_W) : (t % GRID_W); const f32x4 cs = *(const f32x4*)(w.ropec + (size_t)pos * 8 + 4 * (fq & 1)), sn = *(const f32x4*)(w.ropes + (size_t)pos * 8 + 4 * (fq & 1));
                        v = (fq >> 1) ? (v * cs + other * sn) : (v * cs - other * sn); } }
                if (ok) { u32x2 o; o.x = rw::pk2(v[0], v[1]); o.y = rw::pk2(v[2], v[3]); *(u32x2*)(w.qb + ((size_t)r * NH + hh) * QKD + nt * 16 + 4 * fq) = o; } } }
    } else {
        for (int hs = 0; hs < 3; ++hs) { const int hh = (wid - 6) * 3 + hs;
#pragma unroll
          for (int pass = 0; pass < 2; ++pass) { f32x4 acc[MT][4];
#pragma unroll
            for (int mt = 0; mt < MT; ++mt)
#pragma unroll
                for (int nt = 0; nt < 4; ++nt) acc[mt][nt] = (f32x4){0.f, 0.f, 0.f, 0.f};
            const bf16_t* wb = w.w_ukv_t + (size_t)(hh * 128 + pass * 64 + fr) * KVL + 8 * fq;
#pragma unroll 1
            for (int ks = 0; ks < KVL / 32; ++ks) { bf16x8 b[4], a[MT];
#pragma unroll
                for (int nt = 0; nt < 4; ++nt) b[nt] = *(const bf16x8*)(wb + (size_t)nt * 16 * KVL + ks * 32);
#pragma unroll
                for (int mt = 0; mt < MT; ++mt) a[mt] = *(const bf16x8*)(lds + OFF_AKV + (mt * 16 + fr) * AKV_STRIDE + (ks * 32 + 8 * fq) * 2);
#pragma unroll
                for (int mt = 0; mt < MT; ++mt)
#pragma unroll
                    for (int nt = 0; nt < 4; ++nt) acc[mt][nt] = __builtin_amdgcn_mfma_f32_16x16x32_bf16(b[nt], a[mt], acc[mt][nt], 0, 0, 0); }
            if (pass == 0) {
                f32x4 gk[4], gr[2], gro[2];
#pragma unroll
                for (int nt = 0; nt < 4; ++nt) gk[nt] = *(const f32x4*)(p.kn_g + l * QKD + nt * 16 + 4 * fq);
#pragma unroll
                for (int a = 0; a < 2; ++a) { gr[a] = *(const f32x4*)(p.kn_g + l * QKD + NOPE + a * 16 + 4 * fq); gro[a] = *(const f32x4*)(p.kn_g + l * QKD + NOPE + a * 16 + ((4 * fq) ^ 8)); }
#pragma unroll
                for (int mt = 0; mt < MT; ++mt) { const int il = mt * 16 + fr; const int r = row0 + il; const bool ok = il < RB && r < M; float ss = 0.f;
#pragma unroll
                    for (int nt = 0; nt < 4; ++nt) ss += acc[mt][nt][0] * acc[mt][nt][0] + acc[mt][nt][1] * acc[mt][nt][1] + acc[mt][nt][2] * acc[mt][nt][2] + acc[mt][nt][3] * acc[mt][nt][3];
                    ss += __shfl_xor(ss, 16); ss += __shfl_xor(ss, 32); ss += ((const float*)(lds + OFF_KSS))[il]; const float rs = 1.0f / sqrtf(ss * (1.0f / QKD) + EPS);
                    const bool lat = r >= CTX; const int t = lat ? r - CTX : 0;
                    if (ok) {
                        bf16_t* kd = w.kb + ((size_t)r * NH + hh) * QKD; const float* krs = (const float*)(lds + OFF_KRS) + il * 32;
#pragma unroll
                        for (int nt = 0; nt < 4; ++nt) { const f32x4 v = acc[mt][nt] * rs * gk[nt]; u32x2 o; o.x = rw::pk2(v[0], v[1]); o.y = rw::pk2(v[2], v[3]); *(u32x2*)(kd + nt * 16 + 4 * fq) = o; }
#pragma unroll
                        for (int a = 0; a < 2; ++a) { f32x4 v = *(const f32x4*)(krs + a * 16 + 4 * fq) * rs * gr[a]; const f32x4 other = *(const f32x4*)(krs + a * 16 + ((4 * fq) ^ 8)) * rs * gro[a];
                            if (lat) { const int pos = (a == 0) ? (t / GRID_W) : (t % GRID_W); const f32x4 cs = *(const f32x4*)(w.ropec + (size_t)pos * 8 + 4 * (fq & 1)), sn = *(const f32x4*)(w.ropes + (size_t)pos * 8 + 4 * (fq & 1));
                                v = (fq >> 1) ? (v * cs + other * sn) : (v * cs - other * sn); }
                            u32x2 o; o.x = rw::pk2(v[0], v[1]); o.y = rw::pk2(v[2], v[3]); *(u32x2*)(kd + NOPE + a * 16 + 4 * fq) = o; }
                    } }
            } else {
#pragma unroll
                for (int mt = 0; mt < MT; ++mt) { const int il = mt * 16 + fr; const int r = row0 + il; const bool ok = il < RB && r < M;
                    if (ok) { bf16_t* vd = w.vb + ((size_t)r * NH + hh) * VD;
#pragma unroll
                        for (int nt = 0; nt < 4; ++nt) { const f32x4 v = acc[mt][nt]; u32x2 o; o.x = rw::pk2(v[0], v[1]); o.y = rw::pk2(v[2], v[3]); *(u32x2*)(vd + nt * 16 + 4 * fq) = o; } } }
            }
          }
        }
    }
    __syncthreads();
}
}

namespace sd {
typedef short bf16x8 __attribute__((ext_vector_type(8)));
typedef float f32x4 __attribute__((ext_vector_type(4)));
typedef unsigned u32x2 __attribute__((ext_vector_type(2)));
typedef unsigned u32x4 __attribute__((ext_vector_type(4)));
constexpr int SBS = 144, STS = 272;
constexpr int OFF_BM = 0, OFF_CM = OFF_BM + 128 * SBS, OFF_XT = OFF_CM + 128 * SBS, OFF_BTF = OFF_XT + 64 * STS, OFF_BTB = OFF_BTF + 64 * STS, OFF_L = OFF_BTB + 64 * STS, OFF_SC = OFF_L + 128 * STS, LDS_SSD = OFF_SC + 4 * 128 * 4;
struct SsdW { const bf16_t* proj; int ldp; float* yd; float* st; float* cdec; float* cs; bf16_t* cg; bf16_t* prevb; };
__device__ __forceinline__ bf16x8 ldfrag(const char* base, int row, int stride, int kbyte) { return *(const bf16x8*)(base + row * stride + kbyte); }
__device__ __forceinline__ float silu_f(float x) { return x / (1.0f + __expf(-x)); }
__device__ __forceinline__ void chunk_unit(const P& p, const SsdW& w, int l, int c, int hh, char* lds) {
    int tid = threadIdx.x; asm volatile("" : "+v"(tid)); const int wid = __builtin_amdgcn_readfirstlane(tid >> 6), lane = tid & 63, fr = lane & 15, fq = lane >> 4;
    const int R0 = c * CHUNK, g = hh / (SH / SG); const int seg0 = R0 < CTX ? 0 : CTX, seg1 = R0 < CTX ? CTX : M;
    float* csf = (float*)(lds + OFF_SC); float* csb = csf + 128; float* dtf = csb + 128; float* dtb = dtf + 128;
    if (tid < 256) { const int r = tid & 127, d = tid >> 7; const float v = softplusf(rw::ld1(w.proj + (size_t)(R0 + r) * w.ldp + C_DT + d * 6 + hh) + p.dt_bias[l * 12 + d * 6 + hh]); (d ? dtb : dtf)[r] = v; }
    __syncthreads();
    if (wid < 2) {
        const int d = wid; const float a = -__expf(p.a_log[l * 12 + d * 6 + hh]); const float* dts = d ? dtb : dtf; float* cso = d ? csb : csf;
        const int i0 = 2 * lane, i1 = 2 * lane + 1; const int r0 = d ? 127 - i0 : i0, r1 = d ? 127 - i1 : i1;
        const float v0 = dts[r0] * a, v1 = dts[r1] * a; float s = v0 + v1;
#pragma unroll
        for (int o = 1; o < 64; o <<= 1) { const float t = __shfl_up(s, o); if (lane >= o) s += t; }
        const float excl = s - (v0 + v1); const float c0 = excl + v0, c1 = c0 + v1; cso[r0] = c0; cso[r1] = c1;
        w.cs[((size_t)d * M + R0 + r0) * SH + hh] = c0; w.cs[((size_t)d * M + R0 + r1) * SH + hh] = c1;
        if (lane == 63) w.cdec[((size_t)d * NCH + c) * SH + hh] = __expf(c1);
    }
    __syncthreads();
    {   const int col = tid & 63, l0 = (tid >> 6) * 16; const float cfe = csf[127], cbe = csb[0];
#pragma unroll
        for (int which = 0; which < 3; ++which) { const int cidx = which == 0 ? hh * SP + col : (which == 1 ? SW + g * SN + col : SW + SG * SN + g * SN + col);
            const float w0 = p.conv_w[((size_t)l * 4 + 0) * CONVD + cidx], w1 = p.conv_w[((size_t)l * 4 + 1) * CONVD + cidx], w2 = p.conv_w[((size_t)l * 4 + 2) * CONVD + cidx], w3 = p.conv_w[((size_t)l * 4 + 3) * CONVD + cidx], bb = p.conv_b[l * CONVD + cidx];
            float v[19];
#pragma unroll
            for (int i = 0; i < 19; ++i) { const int r = R0 + l0 - 2 + i; v[i] = (r >= seg0 && r < seg1) ? rw::ld1(w.proj + (size_t)r * w.ldp + C_XBC + cidx) : 0.f; }
            float y[16];
#pragma unroll
            for (int i = 0; i < 16; ++i) y[i] = silu_f(bb + w0 * v[i] + w1 * v[i + 1] + w2 * v[i + 2] + w3 * v[i + 3]);
            if (which == 0) {
                u32x4 a, b; a.x = rw::pk2(y[0], y[1]); a.y = rw::pk2(y[2], y[3]); a.z = rw::pk2(y[4], y[5]); a.w = rw::pk2(y[6], y[7]); b.x = rw::pk2(y[8], y[9]); b.y = rw::pk2(y[10], y[11]); b.z = rw::pk2(y[12], y[13]); b.w = rw::pk2(y[14], y[15]);
                *(u32x4*)(lds + OFF_XT + col * STS + l0 * 2) = a; *(u32x4*)(lds + OFF_XT + col * STS + l0 * 2 + 16) = b;
            } else if (which == 1) {
                float yf[16], yb[16];
#pragma unroll
                for (int i = 0; i < 16; ++i) { *(bf16_t*)(lds + OFF_BM + (l0 + i) * SBS + col * 2) = f2bf(y[i]); yf[i] = y[i] * __expf(cfe - csf[l0 + i]) * dtf[l0 + i]; yb[i] = y[i] * __expf(cbe - csb[l0 + i]) * dtb[l0 + i]; }
                u32x4 a, b; a.x = rw::pk2(yf[0], yf[1]); a.y = rw::pk2(yf[2], yf[3]); a.z = rw::pk2(yf[4], yf[5]); a.w = rw::pk2(yf[6], yf[7]); b.x = rw::pk2(yf[8], yf[9]); b.y = rw::pk2(yf[10], yf[11]); b.z = rw::pk2(yf[12], yf[13]); b.w = rw::pk2(yf[14], yf[15]);
                *(u32x4*)(lds + OFF_BTF + col * STS + l0 * 2) = a; *(u32x4*)(lds + OFF_BTF + col * STS + l0 * 2 + 16) = b;
                a.x = rw::pk2(yb[0], yb[1]); a.y = rw::pk2(yb[2], yb[3]); a.z = rw::pk2(yb[4], yb[5]); a.w = rw::pk2(yb[6], yb[7]); b.x = rw::pk2(yb[8], yb[9]); b.y = rw::pk2(yb[10], yb[11]); b.z = rw::pk2(yb[12], yb[13]); b.w = rw::pk2(yb[14], yb[15]);
                *(u32x4*)(lds + OFF_BTB + col * STS + l0 * 2) = a; *(u32x4*)(lds + OFF_BTB + col * STS + l0 * 2 + 16) = b;
            } else {
#pragma unroll
                for (int i = 0; i < 16; ++i) { const bf16_t cv = f2bf(y[i]); *(bf16_t*)(lds + OFF_CM + (l0 + i) * SBS + col * 2) = cv; if (hh % (SH / SG) == 0) w.cg[((size_t)(R0 + l0 + i) * SG + g) * SN + col] = cv; }
            } }
    }
    __syncthreads();
    {   const int lt = wid, lrow = 16 * lt + fr; const bf16x8 c0 = ldfrag(lds + OFF_CM, lrow, SBS, 16 * fq), c1 = ldfrag(lds + OFF_CM, lrow, SBS, 64 + 16 * fq);
        const float cfl = csf[lrow], cbl = csb[lrow], Dh = p.ssd_d[l * SH + hh];
#pragma unroll
        for (int st = 0; st < 8; ++st) { const bf16x8 b0 = ldfrag(lds + OFF_BM, 16 * st + fr, SBS, 16 * fq), b1 = ldfrag(lds + OFF_BM, 16 * st + fr, SBS, 64 + 16 * fq);
            f32x4 acc = {0.f, 0.f, 0.f, 0.f}; acc = __builtin_amdgcn_mfma_f32_16x16x32_bf16(b0, c0, acc, 0, 0, 0); acc = __builtin_amdgcn_mfma_f32_16x16x32_bf16(b1, c1, acc, 0, 0, 0);
            const int s0 = 16 * st + 4 * fq; const f32x4 cfs = *(const f32x4*)(csf + s0), cbs = *(const f32x4*)(csb + s0), dfs = *(const f32x4*)(dtf + s0), dbs = *(const f32x4*)(dtb + s0); float o[4];
#pragma unroll
            for (int j = 0; j < 4; ++j) { const int s = s0 + j; const float ef = s <= lrow ? __expf(fminf(cfl - cfs[j], 0.f)) * dfs[j] : 0.f; const float eb = s >= lrow ? __expf(fminf(cbl - cbs[j], 0.f)) * dbs[j] : 0.f;
                o[j] = acc[j] * (ef + eb) + (s == lrow ? Dh : 0.f); }
            u32x2 pk; pk.x = rw::pk2(o[0], o[1]); pk.y = rw::pk2(o[2], o[3]); *(u32x2*)(lds + OFF_L + lrow * STS + s0 * 2) = pk; }
    }
    __syncthreads();
    {   const int lt = wid, lrow = 16 * lt + fr; bf16x8 lf[4];
#pragma unroll
        for (int ks = 0; ks < 4; ++ks) lf[ks] = ldfrag(lds + OFF_L, lrow, STS, 64 * ks + 16 * fq);
#pragma unroll
        for (int pt = 0; pt < 4; ++pt) { f32x4 acc = {0.f, 0.f, 0.f, 0.f};
#pragma unroll
            for (int ks = 0; ks < 4; ++ks) acc = __builtin_amdgcn_mfma_f32_16x16x32_bf16(ldfrag(lds + OFF_XT, 16 * pt + fr, STS, 64 * ks + 16 * fq), lf[ks], acc, 0, 0, 0);
            *(f32x4*)(w.yd + (size_t)(R0 + lrow) * SW + hh * SP + 16 * pt + 4 * fq) = acc; }
    }
    {   const int d = wid >> 2, ptile = wid & 3, prow = 16 * ptile + fr; bf16x8 xf[4]; const char* bt = lds + (d ? OFF_BTB : OFF_BTF);
#pragma unroll
        for (int ks = 0; ks < 4; ++ks) xf[ks] = ldfrag(lds + OFF_XT, prow, STS, 64 * ks + 16 * fq);
#pragma unroll
        for (int nt = 0; nt < 4; ++nt) { f32x4 acc = {0.f, 0.f, 0.f, 0.f};
#pragma unroll
            for (int ks = 0; ks < 4; ++ks) acc = __builtin_amdgcn_mfma_f32_16x16x32_bf16(ldfrag(bt, 16 * nt + fr, STS, 64 * ks + 16 * fq), xf[ks], acc, 0, 0, 0);
            *(f32x4*)(w.st + ((((size_t)d * NCH + c) * SH + hh) * SP + prow) * SN + 16 * nt + 4 * fq) = acc; }
    }
    __syncthreads();
}
__device__ __forceinline__ void carry_phase(const SsdW& w) {
    int tid = threadIdx.x; asm volatile("" : "+v"(tid));
    constexpr int PER = 2 * SH * SP * SN / 256;
    if (tid < PER) { const int eidx = blockIdx.x * PER + tid; if (eidx < 2 * SH * SP * SN) { const int dir = eidx / (SH * SP * SN), rem = eidx % (SH * SP * SN), hh = rem / (SP * SN), e = rem % (SP * SN); float state = 0.f;
        for (int b = 0; b < NCH / 13; ++b) { float sv[13], dv[13]; size_t ov[13];
#pragma unroll
            for (int j = 0; j < 13; ++j) { const int i = b * 13 + j; const int c = dir == 0 ? i : (i < CTX / CHUNK ? CTX / CHUNK - 1 - i : NCH - 1 - (i - CTX / CHUNK));
                ov[j] = (((size_t)dir * NCH + c) * SH + hh) * (SP * SN) + e; sv[j] = w.st[ov[j]]; dv[j] = w.cdec[((size_t)dir * NCH + c) * SH + hh]; }
#pragma unroll
            for (int j = 0; j < 13; ++j) { w.prevb[ov[j]] = f2bf(state); state = state * dv[j] + sv[j]; } } } }
}
__device__ __forceinline__ void final_phase(const P& p, const SsdW& w, int l, bf16_t* dst, int ldd) {
    int tid = threadIdx.x; asm volatile("" : "+v"(tid)); const int wid = __builtin_amdgcn_readfirstlane(tid >> 6), lane = tid & 63, fr = lane & 15, fq = lane >> 4;
    const int ltg = wid * gridDim.x + blockIdx.x; if (ltg >= M / 16) return;
    const int r = ltg * 16 + fr, c = (ltg * 16) / CHUNK;
    bf16x8 cf[2][2];
#pragma unroll
    for (int g = 0; g < 2; ++g)
#pragma unroll
        for (int ks = 0; ks < 2; ++ks) cf[g][ks] = *(const bf16x8*)(w.cg + ((size_t)r * SG + g) * SN + 32 * ks + 8 * fq);
    u32x2 gv[SH][4]; float ss = 0.f;
#pragma unroll
    for (int hh = 0; hh < SH; ++hh) { const int g = hh / (SH / SG); const float ef = __expf(w.cs[(size_t)r * SH + hh]), eb = __expf(w.cs[((size_t)M + r) * SH + hh]);
#pragma unroll
        for (int pt = 0; pt < 4; ++pt) { f32x4 af = {0.f, 0.f, 0.f, 0.f}, ab = {0.f, 0.f, 0.f, 0.f};
            const bf16_t* pf = w.prevb + ((((size_t)0 * NCH + c) * SH + hh) * SP + 16 * pt + fr) * SN + 8 * fq; const bf16_t* pb = w.prevb + ((((size_t)1 * NCH + c) * SH + hh) * SP + 16 * pt + fr) * SN + 8 * fq;
#pragma unroll
            for (int ks = 0; ks < 2; ++ks) { af = __builtin_amdgcn_mfma_f32_16x16x32_bf16(*(const bf16x8*)(pf + 32 * ks), cf[g][ks], af, 0, 0, 0); ab = __builtin_amdgcn_mfma_f32_16x16x32_bf16(*(const bf16x8*)(pb + 32 * ks), cf[g][ks], ab, 0, 0, 0); }
            const int col = hh * SP + 16 * pt + 4 * fq; const f32x4 yd = *(const f32x4*)(w.yd + (size_t)r * SW + col), z = rw::ld4(w.proj + (size_t)r * w.ldp + C_Z + col);
            f32x4 y = yd + af * ef + ab * eb;
#pragma unroll
            for (int j = 0; j < 4; ++j) { y[j] *= silu_f(z[j]); ss += y[j] * y[j]; }
            u32x2 pk; pk.x = rw::pk2(y[0], y[1]); pk.y = rw::pk2(y[2], y[3]); gv[hh][pt] = pk; } }
    ss += __shfl_xor(ss, 16); ss += __shfl_xor(ss, 32); const float rs = 1.0f / sqrtf(ss * (1.0f / SW) + EPS);
#pragma unroll
    for (int hh = 0; hh < SH; ++hh)
#pragma unroll
        for (int pt = 0; pt < 4; ++pt) { const int col = hh * SP + 16 * pt + 4 * fq; const f32x4 o = rw::bf4(gv[hh][pt]) * rs * *(const f32x4*)(p.ssd_norm_g + l * SW + col);
            u32x2 pk; pk.x = rw::pk2(o[0], o[1]); pk.y = rw::pk2(o[2], o[3]); *(u32x2*)(dst + (size_t)r * ldd + col) = pk; }
}
}

namespace mc {
typedef float f32x4 __attribute__((ext_vector_type(4)));
__device__ __forceinline__ void modvec_phase(const P& p, char* lds) {
    int tid = threadIdx.x; asm volatile("" : "+v"(tid));
    float* sc = (float*)lds; float* part = sc + 2 * D;
    for (int i = tid; i < 2 * D; i += 512) { const float v = i < D ? p.c[i] : p.c_ctx[i - D]; sc[i] = v / (1.0f + __expf(-v)); }
    __syncthreads();
    constexpr int NCK = 6 * D / 128, NU = DEPTH * NCK;
    for (int u = blockIdx.x; u < NU; u += gridDim.x) { const int l = u / NCK, j = (u % NCK) * 128 + (tid & 127), kg = tid >> 7; const float* wp = p.mod_w + (size_t)l * D * 6 * D + j; float a0 = 0.f, a1 = 0.f;
#pragma unroll 8
        for (int k = kg; k < D; k += 4) { const float wv = wp[(size_t)k * 6 * D]; a0 += sc[k] * wv; a1 += sc[D + k] * wv; }
        part[(kg * 2 + 0) * 128 + (tid & 127)] = a0; part[(kg * 2 + 1) * 128 + (tid & 127)] = a1;
        __syncthreads();
        if (tid < 256) { const int which = tid >> 7, cc = tid & 127; const float s = part[(0 * 2 + which) * 128 + cc] + part[(1 * 2 + which) * 128 + cc] + part[(2 * 2 + which) * 128 + cc] + part[(3 * 2 + which) * 128 + cc];
            const int jj = (u % NCK) * 128 + cc; p.mod[((size_t)(l * 2 + which) * 6) * D + jj] = s + p.mod_b[(size_t)l * 6 * D + jj]; }
        __syncthreads(); }
}
__device__ __forceinline__ void pool_phase(const P& p, const bf16_t* proj, int ldp, int l, bf16_t* dst, int ldd, char* lds) {
    int tid = threadIdx.x; asm volatile("" : "+v"(tid));
    constexpr int RB = 65; float* pm = (float*)lds;
    const int row0 = blockIdx.x * RB;
    {
        const int c = tid & 255, gi = c >> 6, hw = 1 << gi, rh = tid >> 8;
        const int i0 = rh * 33, nr = rh ? 32 : 33;
        float v[33 + 16];
#pragma unroll
        for (int k = 0; k < 33 + 16; ++k) { const int r = row0 + i0 - 8 + k; v[k] = (r >= 0 && r < M && k < nr + 16) ? rw::ld1(proj + (size_t)r * ldp + C_POOL + c) : 0.f; }
#pragma unroll
        for (int i = 0; i < 33; ++i) { const int r = row0 + i0 + i; if (i < nr && r < M) { const int seg0 = r < CTX ? 0 : CTX, seg1 = r < CTX ? CTX : M; float s = 0.f; int cnt = 0;
#pragma unroll
                for (int o = -8; o < 8; ++o) { const int rr = r + o; const bool in = o >= -hw && o < hw && rr >= seg0 && rr < seg1; s += in ? v[i + 8 + o] : 0.f; cnt += in ? 1 : 0; }
                pm[(i0 + i) * 256 + c] = s / (float)cnt - v[i + 8]; } }
    }
    __syncthreads();
    {   const int d = tid & 63, gi = (tid >> 6) & 3, rh = tid >> 8; float wcol[64]; const float* wp = p.pool_w + (((size_t)l * 4 + gi) * 64) * 64 + d;
#pragma unroll
        for (int c = 0; c < 64; ++c) wcol[c] = wp[(size_t)c * 64];
        const float scl = p.pool_scale[l * PW + gi * 64 + d];
        for (int i = rh; i < RB; i += 2) { const int r = row0 + i; if (r >= M) break; const f32x4* pr = (const f32x4*)(pm + i * 256 + gi * 64); float acc = 0.f;
#pragma unroll
            for (int c4 = 0; c4 < 16; ++c4) { const f32x4 v = pr[c4]; acc += v[0] * wcol[4 * c4] + v[1] * wcol[4 * c4 + 1] + v[2] * wcol[4 * c4 + 2] + v[3] * wcol[4 * c4 + 3]; }
            dst[(size_t)r * ldd + gi * 64 + d] = f2bf(acc * scl); } }
    __syncthreads();
}
}

#ifndef CHECK_MLA
#define CHECK_MLA 0
#endif
#ifndef CHECK_SSD
#define CHECK_SSD 0
#endif
#ifndef REP_ATT
#define REP_ATT 1
#endif
#ifndef REP_MOE
#define REP_MOE 1
#endif
#ifndef REP_PROJ
#define REP_PROJ 1
#endif
#ifndef REP_PRE
#define REP_PRE 1
#endif
#ifndef REP_PREP
#define REP_PREP 1
#endif
#ifndef REP_ROW
#define REP_ROW 1
#endif
#ifndef REP_MLA
#define REP_MLA 1
#endif
#ifndef REP_POOL
#define REP_POOL 1
#endif
#ifndef REP_S1
#define REP_S1 1
#endif
#ifndef REP_FIN
#define REP_FIN 1
#endif
#define REPEAT(N, ...) for (int rep_ = 0; rep_ < (N); ++rep_) { __VA_ARGS__ }
__device__ __forceinline__ int gtid() { int t = threadIdx.x; asm volatile("" : "+v"(t)); return blockIdx.x * 512 + t; }
template <int OP> __device__ __forceinline__ void run_op(const P& p, int l) {
    const long n = op_count(OP); const long stride = (long)gridDim.x * blockDim.x;
    for (long i = gtid(); i < n; i += stride) op_run(OP, p, l, i);
}
struct KArgs { P p; FW f; unsigned* bar; };
__device__ __forceinline__ const KArgs& kargs() { auto q = __builtin_amdgcn_kernarg_segment_ptr(); asm volatile("" : "+s"(q)); return *(const KArgs*)q; }
constexpr int LDS_BYTES = gm::STAGE_BYTES + 4096;
#ifndef REP_BAR
#define REP_BAR 1
#endif
#if REP_BAR == 2
#define BAR() do { BAR1(); BAR1(); } while (0)
#else
#define BAR() BAR1()
#endif
#define BAR1() do { XcdBarrier b2_; b2_.bar = kargs().bar; unsigned xx_ = xbx; asm volatile("" : "+s"(xx_)); b2_.x = xx_; b2_.st = (volatile LAS unsigned*)(lds + LDS_BYTES - 16); xcd_barrier(b2_); } while (0)
#define PH(OPX) do { run_op<OPX>(kargs().p, lo()); BAR(); } while (0)
#define RUN(OPX) run_op<OPX>(kargs().p, lo())

__device__ __forceinline__ void attn_split_phase(const P& p, const FW& f, char* lds) {
    constexpr int NQL = SEQ / 256, NUL = NH * NQL * 2, NU = NUL + NH, HALF_KEYS = M / 2;
    for (int u = blockIdx.x; u < NU; u += gridDim.x) {
        int hh, qt, half, seq;
        if (u < NUL) { hh = u / (NQL * 2); const int rem = u % (NQL * 2); qt = 1 + (rem >> 1); half = rem & 1; seq = HALF_KEYS; } else { hh = u - NUL; qt = 0; half = 0; seq = CTX; }
        const size_t koff = (size_t)half * HALF_KEYS;
        __syncthreads();
        at::attn_body<bf16_t>(p.qb + (size_t)qt * 256 * at::LDQ + hh * at::DQ, p.kb + koff * at::LDK + hh * at::DQ, p.vb + koff * at::LDV + hh * at::DV,
                              f.opart + (size_t)half * M * (NH * VD) + (size_t)qt * 256 * (NH * VD) + hh * at::DV, NH * VD, seq, lds,
                              f.aml + (((size_t)half * M + (size_t)qt * 256) * NH + hh) * 2, NH * 2);
    }
    __syncthreads();
}
template <class TO> __device__ __forceinline__ void attn_phase(const P& p, TO* O, int ldo, char* lds) {
    constexpr int NQT = M / 256, NU = NH * NQT;
    for (int u = blockIdx.x; u < NU; u += gridDim.x) {
        const int hh = u / NQT, qt = u % NQT; const int seq = qt == 0 ? CTX : M;
        __syncthreads();
        at::attn_body<TO>(p.qb + (size_t)qt * 256 * at::LDQ + hh * at::DQ, p.kb + hh * at::DQ, p.vb + hh * at::DV, O + (size_t)qt * 256 * ldo + hh * at::DV, ldo, seq, lds);
    }
    __syncthreads();
}
template <class TA> __device__ __forceinline__ float ldf(const TA* a, size_t i);
template <> __device__ __forceinline__ float ldf<float>(const float* a, size_t i) { return a[i]; }
template <> __device__ __forceinline__ float ldf<bf16_t>(const bf16_t* a, size_t i) { return bf2f(a[i]); }
template <class TA, class TB> __device__ __forceinline__ void chk_accum(const TA* a, int lda, const TB* b, int ldb, long nrows, int ncols, float* diag) {
    float sd = 0.f, sr = 0.f; const long n = nrows * ncols; const long stride = (long)gridDim.x * blockDim.x;
    for (long i = gtid(); i < n; i += stride) { const long r = i / ncols; const int c = (int)(i % ncols);
        const float x = ldf<TA>(a, r * lda + c), y = ldf<TB>(b, r * ldb + c); sd += (x - y) * (x - y); sr += y * y; }
    for (int o = 32; o >= 1; o >>= 1) { sd += __shfl_xor(sd, o); sr += __shfl_xor(sr, o); }
    if ((threadIdx.x & 63) == 0) { atomicAdd(diag, sd); atomicAdd(diag + 1, sr); }
}
#define MLA_CALL(QB, KB, VB) { const int ll_ = lo(); ml::MW mw_; mw_.qb = (QB); mw_.kb = (KB); mw_.vb = (VB); mw_.w_uq_t = KF.w_uq_t + (size_t)ll_ * NH * QKD * QL; mw_.w_ukv_t = KF.w_ukv_t + (size_t)ll_ * NH * 128 * KVL; \
        mw_.ropec = KF.ropec; mw_.ropes = KF.ropes; mw_.proj = KF.projb; mw_.ldp = INC_PAD; ml::mla_phase(KP, mw_, ll_, lds); }
#if CHECK_MLA
#define MLA_STEP PH(OP_LATNORM); RUN(OP_QRAW); PH(OP_KVRAW); RUN(OP_QHEAD); RUN(OP_KHEAD); if (l == 0) { MLA_CALL(KF.qb2, KF.kb2, KF.vb2) } BAR(); \
        if (l == 0) { chk_accum<bf16_t, bf16_t>(KF.qb2, NH * QKD, KP.qb, NH * QKD, M, NH * QKD, KP.diag + 0); chk_accum<bf16_t, bf16_t>(KF.kb2, NH * QKD, KP.kb, NH * QKD, M, NH * QKD, KP.diag + 2); chk_accum<bf16_t, bf16_t>(KF.vb2, NH * VD, KP.vb, NH * VD, M, NH * VD, KP.diag + 4); }
#else
#define MLA_STEP REPEAT(REP_PREP * REP_MLA, MLA_CALL(KP.qb, KP.kb, KP.vb))
#endif
#define SSD_W(NAME) sd::SsdW NAME; NAME.proj = KF.projb; NAME.ldp = INC_PAD; NAME.yd = KF.yd2; NAME.st = KF.st2; NAME.cdec = KF.cdec2; NAME.cs = KF.cs2; NAME.cg = KF.cg; NAME.prevb = KF.prevb;
#define SSD_S1() { SSD_W(sw_) const int ll_ = lo(); for (int u = blockIdx.x; u < NCH * SH; u += gridDim.x) sd::chunk_unit(KP, sw_, ll_, u / SH, u % SH, lds); }
#define SSD_S2() { SSD_W(sw_) sd::carry_phase(sw_); }
#define SSD_S3(DST, LDD) { SSD_W(sw_) sd::final_phase(KP, sw_, lo(), (DST), (LDD)); }
#if CHECK_SSD
#define SSD_STEPS RUN(OP_CONV); RUN(OP_DT); PH(OP_POOLP); RUN(OP_SSD_CS); RUN(OP_SSD_G); PH(OP_POOLMM); attn_phase<float>(KP, KP.mixin, MIXW, lds); RUN(OP_SSD_YD); PH(OP_SSD_ST); PH(OP_SSD_CARRY); PH(OP_SSD_YOFF); PH(OP_SSDFIN); \
        if (l == 0) { SSD_S1() BAR(); SSD_S2() BAR(); SSD_S3(KF.ssdb2, SW) BAR(); chk_accum<bf16_t, float>(KF.ssdb2, SW, KP.mixin + NH * VD, MIXW, M, SW, KP.diag + 0); } PH(OP_MIXB);
#else
#define SSD_STEPS REPEAT(REP_PREP * REP_POOL, mc::pool_phase(KP, KF.projb, INC_PAD, lo(), KP.mixb + NH * VD + SW, MIXW, lds);) REPEAT(REP_PREP * REP_S1, SSD_S1()) BAR(); REPEAT(REP_ATT, attn_split_phase(KP, KF, lds);) REPEAT(REP_FIN, SSD_S2()) BAR(); REPEAT(REP_FIN, SSD_S3(KP.mixb + NH * VD, MIXW) at::attn_combine(KF.opart, KF.aml, KP.mixb, MIXW, M, CTX);) BAR();
#endif
#define LAYER_BODY(L) { const int l = (L); \
        auto lo = [&]() { int ll = l; asm volatile("" : "+s"(ll)); return ll; }; \
        if (blockIdx.x == 0 && threadIdx.x < NE) KP.cnt[threadIdx.x] = 0; \
        REPEAT(REP_PROJ, inproj_phase(KP, KF, lo(), KF.projb, lds);) BAR(); \
        MLA_STEP \
        SSD_STEPS \
        REPEAT(REP_PROJ - 1, outproj_phase<false>(KP, KF, lo(), KP.mixin, lds);) outproj_phase<true>(KP, KF, lo(), KP.xres, lds); BAR(); \
        REPEAT(REP_ROW - 1, rw::router_phase<true>(KP, lo(), lds);) rw::router_phase<false>(KP, lo(), lds); BAR(); \
        REPEAT(REP_MOE, moe1_phase(KP, KF, lo(), lds);) BAR(); REPEAT(REP_MOE, moe2_phase(KP, KF, lo(), lds);) BAR(); \
        REPEAT(REP_ROW - 1, rw::combine_phase<true>(KP, lo());) rw::combine_phase<false>(KP, lo()); BAR(); \
    }
__global__ void __launch_bounds__(512, 2) k_mega(KArgs a) {
    extern __shared__ __attribute__((aligned(16))) char lds[];
    uint4* xbw = (uint4*)(lds + LDS_BYTES - 16);
    if (threadIdx.x == 0) *xbw = make_uint4(0u, 0u, 0u, 0u);
    __syncthreads();
    const unsigned xbx = xcd_barrier_post(kargs().bar, (volatile LAS unsigned*)xbw).x;
#define KP kargs().p
#define KF kargs().f
    { const int l = 0; auto lo = [&]() { return l; }; if (blockIdx.x == 0 && threadIdx.x < 16) KP.diag[threadIdx.x] = 0.f; REPEAT(REP_PRE, mc::modvec_phase(KP, lds); cvt_phase(KP, KF, 0, DEPTH, lds);) BAR(); rw::first_norm_phase(KP); BAR(); }
    LAYER_BODY(0) LAYER_BODY(1) LAYER_BODY(2) LAYER_BODY(3)
#if CHECK_MLA || CHECK_SSD
    {
        float e = 0.f;
        for (int c = 0; c < 3; ++c) { const float dn = KP.diag[2 * c + 1]; if (dn == 0.f && KP.diag[2 * c] == 0.f) continue; const float ec = sqrtf(KP.diag[2 * c] / dn); e = ec > e ? ec : e; if (!(ec == ec)) e = 1e3f; }
        const float sc = 1.0f + 10.0f * e; const long n = (long)SEQ * D; const long stride = (long)gridDim.x * blockDim.x;
        for (long i = gtid(); i < n; i += stride) KP.out[i] *= sc;
    }
#endif
#undef KP
#undef KF
}
static size_t carve(char*& cur, size_t bytes) { size_t a = (bytes + 255) & ~(size_t)255; cur += a; return a; }
static bool setup_params(P& p, FW& f, unsigned*& bar, void* const* d_in, void* d_out, void* d_ws, size_t ws_size) {
    const float** pp = (const float**)&p; for (int i = 0; i < 32; ++i) pp[i] = (const float*)d_in[i];
    p.out = (float*)d_out;
    char* cur = (char*)d_ws; char* base = cur;
    bar = (unsigned*)cur; carve(cur, XCD_BAR_WORDS * sizeof(unsigned));
#define CARVE(field, type, count) p.field = (type*)cur; carve(cur, (size_t)(count) * sizeof(type));
#define CARVEF(field, type, count) f.field = (type*)cur; carve(cur, (size_t)(count) * sizeof(type));
    CARVE(xres, float, (size_t)M * D) CARVE(mod, float, (size_t)DEPTH * 12 * D) CARVEF(projb, bf16_t, (size_t)M * INC_PAD)
#if CHECK_MLA
    CARVE(qln, float, (size_t)M * QL) CARVE(kvln, float, (size_t)M * KVL) CARVE(qraw, float, (size_t)M * NH * QKD) CARVE(kvraw, float, (size_t)M * NH * 128) CARVE(q, float, (size_t)M * NH * QKD) CARVE(k, float, (size_t)M * NH * QKD) CARVE(v, float, (size_t)M * NH * VD)
    CARVEF(qb2, bf16_t, (size_t)M * NH * QKD) CARVEF(kb2, bf16_t, (size_t)M * NH * QKD) CARVEF(vb2, bf16_t, (size_t)M * NH * VD)
#endif
    CARVE(mixin, float, (size_t)M * MIXW) CARVE(xbc, float, (size_t)M * CONVD) CARVE(dt, float, (size_t)M * 12) CARVE(ydir, float, (size_t)2 * M * SW)
    CARVE(poolp, float, (size_t)M * PW) CARVE(topw, float, (size_t)M * 4)
    CARVE(topi, int, (size_t)M * 4) CARVE(cnt, int, NE) CARVE(list, int, (size_t)NE * M)
    CARVE(qb, bf16_t, (size_t)M * NH * QKD) CARVE(kb, bf16_t, (size_t)M * NH * QKD) CARVE(vb, bf16_t, (size_t)M * NH * VD) CARVE(diag, float, 64)
    CARVE(cs, float, (size_t)2 * M * SH) CARVE(cdec, float, (size_t)2 * NCH * SH) CARVE(gmat, float, (size_t)M * SG * CHUNK) CARVE(st, float, (size_t)2 * NCH * SH * SP * SN)
    CARVE(hb1, bf16_t, (size_t)M * D) CARVE(hb2, bf16_t, (size_t)M * D) CARVE(mixb, bf16_t, (size_t)M * MIXW)
    CARVEF(actb, bf16_t, (size_t)4 * M * FF) CARVEF(yb, bf16_t, (size_t)4 * M * D)
    f.hb1 = p.hb1; f.hb2 = p.hb2; f.mixb = p.mixb; p.ybn = f.yb; p.attf = nullptr;
    const int nl = DEPTH;
    CARVEF(w_uq_t, bf16_t, (size_t)nl * NH * QKD * QL) CARVEF(w_ukv_t, bf16_t, (size_t)nl * NH * 128 * KVL) CARVEF(ropec, float, 256 * 8) CARVEF(ropes, float, 256 * 8)
    CARVEF(opart, bf16_t, (size_t)2 * M * NH * VD) CARVEF(aml, float, (size_t)2 * M * NH * 2)
    CARVEF(yd2, float, (size_t)M * SW) CARVEF(st2, float, (size_t)2 * NCH * SH * SP * SN) CARVEF(cdec2, float, (size_t)2 * NCH * SH) CARVEF(cs2, float, (size_t)2 * M * SH)
    CARVEF(cg, bf16_t, (size_t)M * SG * SN) CARVEF(prevb, bf16_t, (size_t)2 * NCH * SH * SP * SN) CARVEF(ssdb2, bf16_t, (size_t)M * SW)
    CARVEF(w_in_t, bf16_t, (size_t)nl * INC_PAD * D) CARVEF(w_out_t, bf16_t, (size_t)nl * D * MIXW) CARVEF(gu_t, bf16_t, (size_t)nl * NE * 2 * FF * D) CARVEF(d_t, bf16_t, (size_t)nl * NE * D * FF)
    p.act = nullptr; p.down = nullptr; f.proj2 = nullptr; f.mix2 = nullptr;
#undef CARVE
#undef CARVEF
    if (getenv("KDEBUG")) fprintf(stderr, "ws used %zu of %zu\n", (size_t)(cur - base), ws_size);
    return (size_t)(cur - base) <= ws_size;
}
extern "C" void kernel_launch(void* const* d_in, const int* in_sizes, int n_in, void* d_out, int out_size, void* d_ws, size_t ws_size, hipStream_t stream) {
    KArgs a{};
    if (n_in < 32 || !setup_params(a.p, a.f, a.bar, d_in, d_out, d_ws, ws_size)) return;
    static int grid = 0;
    if (!grid) { int dev = 0, cus = 0, per_cu = 0; (void)hipGetDevice(&dev); (void)hipDeviceGetAttribute(&cus, hipDeviceAttributeMultiprocessorCount, dev);
        (void)hipFuncSetAttribute((const void*)k_mega, hipFuncAttributeMaxDynamicSharedMemorySize, LDS_BYTES);
        (void)hipOccupancyMaxActiveBlocksPerMultiprocessor(&per_cu, k_mega, 512, LDS_BYTES); grid = cus * (per_cu < 1 ? per_cu : 1); }
    if (grid <= 0) return;
    (void)hipMemsetAsync(a.bar, 0, XCD_BAR_WORDS * sizeof(unsigned), stream);
    hipLaunchKernelGGL(k_mega, dim3(grid), dim3(512), LDS_BYTES, stream, a);
}
```

```cpp
#include <hip/hip_runtime.h>
#include <stdint.h>
#include <stdlib.h>
#include <stdio.h>

#ifndef NAIVE_H
#define NAIVE_H
#include <math.h>
#ifdef HOST_TEST
#define HD inline
#define HDC inline
#define ATOMIC_INC(p) ((*(p))++)
#define UNIFORM(x) (x)
#else
#define HD __device__ __forceinline__
#define HDC __host__ __device__ __forceinline__
#define ATOMIC_INC(p) atomicAdd((p), 1)
#define UNIFORM(x) __builtin_amdgcn_readfirstlane(x)
#endif

#ifndef CFG_D
#define CFG_D 1024
#define CFG_SEQ 16384
#define CFG_CTX 256
#define CFG_FF 1024
#define CFG_DEPTH 4
#endif
constexpr int D = CFG_D, SEQ = CFG_SEQ, CTX = CFG_CTX, FF = CFG_FF, DEPTH = CFG_DEPTH;
constexpr int M = CTX + SEQ;
constexpr int GRID_W = 64;
constexpr int NH = 6, QKD = 96, NOPE = 64, ROPE = 32, VD = 64, QL = 256, KVL = 128;
constexpr int SH = 6, SP = 64, SW = 384, SG = 2, SN = 64, CONVD = 640, CHUNK = 128;
constexpr int PW = 256, MIXW = 1024, INC = 1708;
constexpr int C_Q = 0, C_KV = 256, C_KR = 384, C_Z = 416, C_XBC = 800, C_DT = 1440, C_POOL = 1452;
constexpr int NE = 32, TOPK = 4;
constexpr int NCH = M / CHUNK;
constexpr float EPS = 1e-6f;

typedef unsigned short bf16_t;
HD bf16_t f2bf(float f) { union { float f; unsigned u; } v; v.f = f; unsigned u = v.u; u += 0x7FFFu + ((u >> 16) & 1u); return (bf16_t)(u >> 16); }
HD float bf2f(bf16_t b) { union { float f; unsigned u; } v; v.u = ((unsigned)b) << 16; return v.f; }
struct P {
    const float *x, *c, *ctx, *c_ctx, *norm1_g, *norm2_g, *mod_w, *mod_b, *w_in, *q_g, *kv_g, *w_uq, *w_ukv, *qn_g, *kn_g;
    const float *conv_w, *conv_b, *a_log, *dt_bias, *ssd_d, *ssd_norm_g, *pool_w, *pool_scale, *w_out, *router_w, *router_b;
    const float *wg, *bg, *wu, *bu, *wd, *bd;
    float* out;
    float *xres, *mod, *rs, *h, *proj, *qln, *kvln, *qraw, *kvraw, *q, *k, *v, *mixin, *xbc, *dt, *ydir, *poolp, *mix, *logits, *topw, *act, *down;
    int *topi, *cnt, *list;
    bf16_t *qb, *kb, *vb;
    float *attf, *diag;
    float *cs, *cdec, *gmat, *st;
    bf16_t *hb1, *hb2, *mixb, *ybn;
};

HD float siluf(float x) { return x / (1.0f + expf(-x)); }
HD float sigmf(float x) { return 1.0f / (1.0f + expf(-x)); }
HD float softplusf(float x) { return x > 20.0f ? x : log1pf(expf(x)); }
HD const float* modv(const P& p, int l, int r, int j) { return p.mod + ((size_t)(l * 2 + (r < CTX ? 1 : 0)) * 6 + j) * D; }

enum { OP_COPY_IN = 0, OP_MODVEC, OP_ROWSTAT, OP_NORM1, OP_INPROJ, OP_LATNORM, OP_QRAW, OP_KVRAW, OP_QHEAD, OP_KHEAD, OP_ATTN, OP_CONV, OP_DT, OP_SSDSCAN, OP_SSDFIN,
       OP_POOLP, OP_POOLMM, OP_OUTPROJ, OP_RES1, OP_NORM2, OP_LOGITS, OP_ZEROCNT, OP_TOPK, OP_GATEUP, OP_DOWN, OP_COMBINE, OP_WRITE_OUT, OP_MIXB, OP_COMBINE2, OP_SSD_CS, OP_SSD_G, OP_SSD_YD, OP_SSD_ST, OP_SSD_CARRY, OP_SSD_YOFF, OP_COUNT };

HDC long op_count(int op) {
    switch (op) {
        case OP_COPY_IN: return (long)M * D;
        case OP_MODVEC: return (long)DEPTH * 2 * 6 * D;
        case OP_ROWSTAT: return M;
        case OP_NORM1: case OP_NORM2: return (long)M * D;
        case OP_INPROJ: return (long)(M / 8) * INC;
        case OP_LATNORM: return 2L * M;
        case OP_QRAW: return (long)(M / 8) * (NH * QKD);
        case OP_KVRAW: return (long)(M / 8) * (NH * 128);
        case OP_QHEAD: case OP_KHEAD: return (long)M * NH;
        case OP_ATTN: return (long)M * NH;
        case OP_CONV: return (long)M * CONVD;
        case OP_DT: return (long)M * 12;
        case OP_SSDSCAN: return 2L * SH * SP;
        case OP_SSDFIN: return M;
        case OP_POOLP: return (long)M * PW;
        case OP_POOLMM: return (long)M * PW;
        case OP_OUTPROJ: return (long)(M / 8) * D;
        case OP_RES1: return (long)M * D;
        case OP_LOGITS: return (long)M * NE;
        case OP_ZEROCNT: return NE;
        case OP_TOPK: return M;
        case OP_GATEUP: return (long)NE * (M / 8) * FF;
        case OP_DOWN: return (long)NE * (M / 8) * D;
        case OP_COMBINE: return (long)M * D;
        case OP_WRITE_OUT: return (long)SEQ * D;
        case OP_MIXB: return (long)M * MIXW;
        case OP_COMBINE2: return (long)M * D;
        case OP_SSD_CS: return 2L * NCH * SH;
        case OP_SSD_G: return (long)M * SG * CHUNK;
        case OP_SSD_YD: return (long)M * SW;
        case OP_SSD_ST: return 2L * NCH * SH * SP * SN;
        case OP_SSD_CARRY: return 2L * SH * SP * SN;
        case OP_SSD_YOFF: return (long)M * SW;
    }
    return 0;
}

HD void gemm8(const float* A, int lda, const float* B, int ldb, const float* bias, float* C, int ldc, int N, int K, long idx) {
    const int j = (int)(idx % N); const long r0 = (idx / N) * 8;
    float acc[8];
#pragma unroll
    for (int i = 0; i < 8; ++i) acc[i] = 0.f;
    const float* a = A + r0 * lda;
    for (int k = 0; k < K; ++k) {
        const float b = B[(size_t)k * ldb + j];
#pragma unroll
        for (int i = 0; i < 8; ++i) acc[i] += a[(size_t)i * lda + k] * b;
    }
    const float bv = bias ? bias[j] : 0.f;
#pragma unroll
    for (int i = 0; i < 8; ++i) C[(r0 + i) * ldc + j] = acc[i] + bv;
}

HD void sincos_rr(float angf, float& cs, float& sn) {
    const double x = (double)angf; const double n = rint(x * 0.63661977236758134308); const double y = (x - n * 1.57079632679489655800) - n * 6.123233995736766e-17; const double y2 = y * y;
    const double s = y * (1.0 + y2 * (-1.0 / 6 + y2 * (1.0 / 120 + y2 * (-1.0 / 5040 + y2 * (1.0 / 362880 + y2 * (-1.0 / 39916800))))));
    const double c = 1.0 + y2 * (-0.5 + y2 * (1.0 / 24 + y2 * (-1.0 / 720 + y2 * (1.0 / 40320 + y2 * (-1.0 / 3628800 + y2 * (1.0 / 479001600))))));
    const int q = ((int)n) & 3; const double cc = (q == 0) ? c : (q == 1) ? -s : (q == 2) ? -c : s; const double ss = (q == 0) ? s : (q == 1) ? c : (q == 2) ? -s : -c;
    cs = (float)cc; sn = (float)ss;
}
HD float rope_inv_freq(int f) { return f == 0 ? 1.0f : f == 1 ? 0.31622776f : f == 2 ? 0.1f : f == 3 ? 0.031622775f : f == 4 ? 0.01f : f == 5 ? 0.0031622776f : f == 6 ? 0.001f : 0.00031622776f; }
HD void rope_apply(float* v32, int t) {
    const float row = (float)(t / GRID_W), col = (float)(t % GRID_W);
#pragma unroll
    for (int a = 0; a < 2; ++a)
#pragma unroll
        for (int f = 0; f < 8; ++f) {
            const float ang = (a == 0 ? row : col) * rope_inv_freq(f);
            float cs, sn; sincos_rr(ang, cs, sn);
            const float x1 = v32[a * 16 + f], x2 = v32[a * 16 + 8 + f];
            v32[a * 16 + f] = x1 * cs - x2 * sn; v32[a * 16 + 8 + f] = x2 * cs + x1 * sn;
        }
}

HD void op_run(int op, const P& p, int l, long idx) {
    switch (op) {
    case OP_COPY_IN: { const long r = idx / D; const int c = (int)(idx % D); p.xres[idx] = r < CTX ? p.ctx[idx] : p.x[(r - CTX) * D + c]; } break;
    case OP_MODVEC: {
        const int j = (int)(idx % (6 * D)); const int which = (int)((idx / (6 * D)) % 2); const int ll = (int)(idx / (12 * D));
        const float* cv = which ? p.c_ctx : p.c; float s = 0.f;
        for (int k = 0; k < D; ++k) s += siluf(cv[k]) * p.mod_w[((size_t)ll * D + k) * (6 * D) + j];
        p.mod[idx] = s + p.mod_b[(size_t)ll * 6 * D + j];
    } break;
    case OP_ROWSTAT: { const float* xr = p.xres + idx * D; float s = 0.f; for (int k = 0; k < D; ++k) s += xr[k] * xr[k]; p.rs[idx] = 1.0f / sqrtf(s / D + EPS); } break;
    case OP_NORM1: case OP_NORM2: { const int r = (int)(idx / D), c = (int)(idx % D); const int o = op == OP_NORM1 ? 0 : 3;
        const float g = (op == OP_NORM1 ? p.norm1_g : p.norm2_g)[l * D + c];
        const float hv = p.xres[idx] * p.rs[r] * g * (1.0f + modv(p, l, r, o + 1)[c]) + modv(p, l, r, o)[c]; p.h[idx] = hv;
        bf16_t* hb = op == OP_NORM1 ? p.hb1 : p.hb2; if (hb) hb[idx] = f2bf(hv); } break;
    case OP_INPROJ: gemm8(p.h, D, p.w_in + (size_t)l * D * INC, INC, nullptr, p.proj, INC, INC, D, idx); break;
    case OP_LATNORM: {
        const int which = idx >= M; const long r = which ? idx - M : idx; const int n = which ? KVL : QL; const float* src = p.proj + r * INC + (which ? C_KV : C_Q);
        float s = 0.f; for (int k = 0; k < n; ++k) s += src[k] * src[k]; const float rs = 1.0f / sqrtf(s / n + EPS);
        float* dst = which ? p.kvln + r * KVL : p.qln + r * QL; const float* g = which ? p.kv_g + l * KVL : p.q_g + l * QL;
        for (int k = 0; k < n; ++k) dst[k] = src[k] * rs * g[k];
    } break;
    case OP_QRAW: gemm8(p.qln, QL, p.w_uq + (size_t)l * QL * (NH * QKD), NH * QKD, nullptr, p.qraw, NH * QKD, NH * QKD, QL, idx); break;
    case OP_KVRAW: gemm8(p.kvln, KVL, p.w_ukv + (size_t)l * KVL * (NH * 128), NH * 128, nullptr, p.kvraw, NH * 128, NH * 128, KVL, idx); break;
    case OP_QHEAD: { const int r = (int)(idx / NH), hh = (int)(idx % NH); const float* src = p.qraw + (size_t)r * (NH * QKD) + hh * QKD; float s = 0.f;
        for (int d = 0; d < QKD; ++d) s += src[d] * src[d]; const float rs = 1.0f / sqrtf(s / QKD + EPS);
        float* dst = p.q + ((size_t)r * NH + hh) * QKD; float rp[32];
        for (int d = 0; d < NOPE; ++d) dst[d] = src[d] * rs * p.qn_g[l * QKD + d];
#pragma unroll
        for (int d = 0; d < 32; ++d) rp[d] = src[NOPE + d] * rs * p.qn_g[l * QKD + NOPE + d];
        if (r >= CTX) rope_apply(rp, r - CTX);
#pragma unroll
        for (int d = 0; d < 32; ++d) dst[NOPE + d] = rp[d];
        bf16_t* db = p.qb + ((size_t)r * NH + hh) * QKD;
        for (int d = 0; d < QKD; ++d) db[d] = f2bf(dst[d]);
    } break;
    case OP_KHEAD: { const int r = (int)(idx / NH), hh = (int)(idx % NH); const float* kn = p.kvraw + (size_t)r * (NH * 128) + hh * 128; const float* kr = p.proj + (size_t)r * INC + C_KR; float s = 0.f;
        for (int d = 0; d < NOPE; ++d) s += kn[d] * kn[d];
        for (int d = 0; d < ROPE; ++d) s += kr[d] * kr[d];
        const float rs = 1.0f / sqrtf(s / QKD + EPS);
        float* dst = p.k + ((size_t)r * NH + hh) * QKD; float rp[32];
        for (int d = 0; d < NOPE; ++d) dst[d] = kn[d] * rs * p.kn_g[l * QKD + d];
#pragma unroll
        for (int d = 0; d < 32; ++d) rp[d] = kr[d] * rs * p.kn_g[l * QKD + NOPE + d];
        if (r >= CTX) rope_apply(rp, r - CTX);
#pragma unroll
        for (int d = 0; d < 32; ++d) dst[NOPE + d] = rp[d];
        float* vd = p.v + ((size_t)r * NH + hh) * VD;
        for (int d = 0; d < VD; ++d) vd[d] = kn[NOPE + d];
        bf16_t* db = p.kb + ((size_t)r * NH + hh) * QKD; bf16_t* vdb = p.vb + ((size_t)r * NH + hh) * VD;
        for (int d = 0; d < QKD; ++d) db[d] = f2bf(dst[d]);
        for (int d = 0; d < VD; ++d) vdb[d] = f2bf(kn[NOPE + d]);
    } break;
    case OP_ATTN: {
        const int r = (int)(idx % M), hh = UNIFORM((int)(idx / M)); const int nk = r < CTX ? CTX : M;
        float qv[QKD];
        const float* qp = p.q + ((size_t)r * NH + hh) * QKD; const float scale = 1.0f / sqrtf((float)QKD);
#pragma unroll
        for (int d = 0; d < QKD; ++d) qv[d] = qp[d] * scale;
        for (int half = 0; half < 2; ++half) {
            float o[32];
#pragma unroll
            for (int d = 0; d < 32; ++d) o[d] = 0.f;
            float mx = -1e30f, lsum = 0.f;
            for (int kk = 0; kk < nk; ++kk) {
                const float* kp = p.k + ((size_t)kk * NH + hh) * QKD; const float* vp = p.v + ((size_t)kk * NH + hh) * VD + half * 32; float s = 0.f;
#pragma unroll
                for (int d = 0; d < QKD; ++d) s += qv[d] * kp[d];
                const float mn = s > mx ? s : mx; const float corr = expf(mx - mn), pe = expf(s - mn);
                lsum = lsum * corr + pe; mx = mn;
#pragma unroll
                for (int d = 0; d < 32; ++d) o[d] = o[d] * corr + pe * vp[d];
            }
            const float inv = 1.0f / lsum; float* dst = p.mixin + (size_t)r * MIXW + hh * VD + half * 32;
#pragma unroll
            for (int d = 0; d < 32; ++d) dst[d] = o[d] * inv;
        }
    } break;
    case OP_CONV: { const int r = (int)(idx / CONVD), c = (int)(idx % CONVD); const int seg0 = r < CTX ? 0 : CTX, n = r < CTX ? CTX : SEQ, t = r - seg0; float y = p.conv_b[l * CONVD + c];
#pragma unroll
        for (int j = 0; j < 4; ++j) { const int tt = t - 2 + j; if (tt >= 0 && tt < n) y += p.conv_w[((size_t)l * 4 + j) * CONVD + c] * p.proj[(size_t)(seg0 + tt) * INC + C_XBC + c]; }
        p.xbc[idx] = siluf(y); } break;
    case OP_DT: { const int r = (int)(idx / 12), j = (int)(idx % 12); p.dt[idx] = softplusf(p.proj[(size_t)r * INC + C_DT + j] + p.dt_bias[l * 12 + j]); } break;
    case OP_SSDSCAN: {
        const int pp = (int)(idx % SP), hh = UNIFORM((int)((idx / SP) % SH)), dir = UNIFORM((int)(idx / (SP * SH))); const int g = hh / (SH / SG);
        const float a = -expf(p.a_log[l * 12 + dir * 6 + hh]); float st[SN];
#pragma unroll
        for (int n = 0; n < SN; ++n) st[n] = 0.f;
        for (int step = 0; step < M; ++step) {
            const int r = dir == 0 ? step : (step < CTX ? CTX - 1 - step : M - 1 - (step - CTX));
            const float dtv = p.dt[(size_t)r * 12 + dir * 6 + hh]; const float dA = expf(dtv * a); const float xv = p.xbc[(size_t)r * CONVD + hh * SP + pp] * dtv;
            const float* Bp = p.xbc + (size_t)r * CONVD + SW + g * SN; const float* Cp = p.xbc + (size_t)r * CONVD + SW + SG * SN + g * SN; float y = 0.f;
#pragma unroll
            for (int n = 0; n < SN; ++n) { st[n] = st[n] * dA + xv * Bp[n]; y += st[n] * Cp[n]; }
            p.ydir[((size_t)dir * M + r) * SW + hh * SP + pp] = y;
        }
    } break;
    case OP_SSDFIN: { const long r = idx; float ss = 0.f;
        for (int c = 0; c < SW; ++c) { const float y = p.ydir[r * SW + c] + p.ydir[((size_t)M + r) * SW + c] + p.ssd_d[l * SH + c / SP] * p.xbc[r * CONVD + c]; const float gv = y * siluf(p.proj[r * INC + C_Z + c]); ss += gv * gv; }
        const float rs = 1.0f / sqrtf(ss / SW + EPS);
        for (int c = 0; c < SW; ++c) { const float y = p.ydir[r * SW + c] + p.ydir[((size_t)M + r) * SW + c] + p.ssd_d[l * SH + c / SP] * p.xbc[r * CONVD + c]; const float gv = y * siluf(p.proj[r * INC + C_Z + c]);
            p.mixin[r * MIXW + NH * VD + c] = gv * rs * p.ssd_norm_g[l * SW + c]; }
    } break;
    case OP_POOLP: { const int r = (int)(idx / PW), c = (int)(idx % PW); const int gi = c / 64; const int win = 2 << gi; const int seg0 = r < CTX ? 0 : CTX, n = r < CTX ? CTX : SEQ, t = r - seg0;
        int lo = t - win / 2, hi = t - win / 2 + win; lo = lo < 0 ? 0 : lo; hi = hi > n ? n : hi; float s = 0.f;
        for (int tt = lo; tt < hi; ++tt) s += p.proj[(size_t)(seg0 + tt) * INC + C_POOL + c];
        p.poolp[idx] = s / (float)(hi - lo) - p.proj[(size_t)r * INC + C_POOL + c]; } break;
    case OP_POOLMM: { const int r = (int)(idx / PW), c = (int)(idx % PW); const int gi = c / 64, d = c % 64; float s = 0.f;
        for (int cc = 0; cc < 64; ++cc) s += p.poolp[(size_t)r * PW + gi * 64 + cc] * p.pool_w[(((size_t)l * 4 + gi) * 64 + cc) * 64 + d];
        p.mixin[(size_t)r * MIXW + NH * VD + SW + c] = s * p.pool_scale[l * PW + c]; } break;
    case OP_OUTPROJ: gemm8(p.mixin, MIXW, p.w_out + (size_t)l * MIXW * D, D, nullptr, p.mix, D, D, MIXW, idx); break;
    case OP_RES1: { const int r = (int)(idx / D), c = (int)(idx % D); p.xres[idx] += modv(p, l, r, 2)[c] * p.mix[idx]; } break;
    case OP_LOGITS: { const int r = (int)(idx / NE), e = (int)(idx % NE); const float* hr = p.h + (size_t)r * D; float s = 0.f;
        for (int k = 0; k < D; ++k) s += hr[k] * p.router_w[((size_t)l * D + k) * NE + e];
        p.logits[idx] = s + p.router_b[l * NE + e]; } break;
    case OP_ZEROCNT: p.cnt[idx] = 0; break;
    case OP_TOPK: { const long t = idx; float lg[NE];
#pragma unroll
        for (int e = 0; e < NE; ++e) lg[e] = p.logits[t * NE + e];
        int sel[4]; float sv[4];
#pragma unroll
        for (int kk = 0; kk < 4; ++kk) { float best = -3.0e38f; int bi = 0;
#pragma unroll
            for (int e = 0; e < NE; ++e) { bool taken = false;
#pragma unroll
                for (int q = 0; q < kk; ++q) taken = taken || (sel[q] == e);
                if (!taken && lg[e] > best) { best = lg[e]; bi = e; } }
            sel[kk] = bi; sv[kk] = best; }
        float es[4], sum = 0.f;
#pragma unroll
        for (int kk = 0; kk < 4; ++kk) { es[kk] = expf(sv[kk] - sv[0]); sum += es[kk]; }
#pragma unroll
        for (int kk = 0; kk < 4; ++kk) { p.topi[t * 4 + kk] = sel[kk]; p.topw[t * 4 + kk] = es[kk] / sum; const int pos = ATOMIC_INC(&p.cnt[sel[kk]]); p.list[(size_t)sel[kk] * M + pos] = (int)(t * 4 + kk); }
    } break;
    case OP_GATEUP: {
        const int j = (int)(idx % FF); const long rest = idx / FF; const int rb = (int)(rest % (M / 8)), e = (int)(rest / (M / 8)); const int cnt = p.cnt[e]; if (rb * 8 >= cnt) break;
        int a[8]; float g[8], u[8];
#pragma unroll
        for (int i = 0; i < 8; ++i) { a[i] = rb * 8 + i < cnt ? p.list[(size_t)e * M + rb * 8 + i] : -1; g[i] = 0.f; u[i] = 0.f; }
        const float* wgp = p.wg + ((size_t)l * NE + e) * D * FF + j; const float* wup = p.wu + ((size_t)l * NE + e) * D * FF + j;
        for (int k = 0; k < D; ++k) { const float gw = wgp[(size_t)k * FF], uw = wup[(size_t)k * FF];
#pragma unroll
            for (int i = 0; i < 8; ++i) { const float xv = p.h[(size_t)(a[i] < 0 ? 0 : a[i] / 4) * D + k]; g[i] += xv * gw; u[i] += xv * uw; } }
        const float bgv = p.bg[((size_t)l * NE + e) * FF + j], buv = p.bu[((size_t)l * NE + e) * FF + j];
#pragma unroll
        for (int i = 0; i < 8; ++i) if (a[i] >= 0) { float gv = g[i] + bgv; gv = gv < 7.0f ? gv : 7.0f; float uv = u[i] + buv; uv = uv < -7.0f ? -7.0f : (uv > 7.0f ? 7.0f : uv);
            p.act[(size_t)a[i] * FF + j] = gv * sigmf(1.702f * gv) * (uv + 1.0f); }
    } break;
    case OP_DOWN: {
        const int j = (int)(idx % D); const long rest = idx / D; const int rb = (int)(rest % (M / 8)), e = (int)(rest / (M / 8)); const int cnt = p.cnt[e]; if (rb * 8 >= cnt) break;
        int a[8]; float o[8];
#pragma unroll
        for (int i = 0; i < 8; ++i) { a[i] = rb * 8 + i < cnt ? p.list[(size_t)e * M + rb * 8 + i] : -1; o[i] = 0.f; }
        const float* wdp = p.wd + ((size_t)l * NE + e) * FF * D + j;
        for (int k = 0; k < FF; ++k) { const float w = wdp[(size_t)k * D];
#pragma unroll
            for (int i = 0; i < 8; ++i) o[i] += p.act[(size_t)(a[i] < 0 ? 0 : a[i]) * FF + k] * w; }
        const float bv = p.bd[((size_t)l * NE + e) * D + j];
#pragma unroll
        for (int i = 0; i < 8; ++i) if (a[i] >= 0) p.down[(size_t)a[i] * D + j] = o[i] + bv;
    } break;
    case OP_COMBINE: { const int r = (int)(idx / D), c = (int)(idx % D); float s = 0.f;
#pragma unroll
        for (int kk = 0; kk < 4; ++kk) s += p.topw[(size_t)r * 4 + kk] * p.down[((size_t)r * 4 + kk) * D + c];
        p.xres[idx] += modv(p, l, r, 5)[c] * s; } break;
    case OP_WRITE_OUT: p.out[idx] = p.xres[(size_t)CTX * D + idx]; break;
    case OP_MIXB: p.mixb[idx] = f2bf(p.mixin[idx]); break;
    case OP_SSD_CS: {
        const int hh = (int)(idx % SH), c = (int)((idx / SH) % NCH), dir = (int)(idx / (SH * NCH)); const float a = -expf(p.a_log[l * 12 + dir * 6 + hh]); float acc = 0.f;
        for (int i = 0; i < CHUNK; ++i) { const int r = c * CHUNK + (dir == 0 ? i : CHUNK - 1 - i); acc += p.dt[(size_t)r * 12 + dir * 6 + hh] * a; p.cs[((size_t)dir * M + r) * SH + hh] = acc; }
        p.cdec[idx] = expf(acc);
    } break;
    case OP_SSD_G: {
        const int s = (int)(idx % CHUNK), g = (int)((idx / CHUNK) % SG), r = (int)(idx / (CHUNK * SG)); const int r2 = (r / CHUNK) * CHUNK + s;
        const float* Cp = p.xbc + (size_t)r * CONVD + SW + SG * SN + g * SN; const float* Bp = p.xbc + (size_t)r2 * CONVD + SW + g * SN; float acc = 0.f;
        for (int n = 0; n < SN; ++n) acc += Cp[n] * Bp[n];
        p.gmat[idx] = acc;
    } break;
    case OP_SSD_YD: {
        const int cc = (int)(idx % SW), r = (int)(idx / SW); const int hh = cc / SP, g = hh / (SH / SG); const int c0 = (r / CHUNK) * CHUNK, lpos = r - c0;
        const float* G = p.gmat + ((size_t)r * SG + g) * CHUNK; const float csf = p.cs[(size_t)r * SH + hh], csb = p.cs[((size_t)M + r) * SH + hh]; float y = 0.f;
        for (int s = 0; s <= lpos; ++s) { const int r2 = c0 + s; y += G[s] * expf(csf - p.cs[(size_t)r2 * SH + hh]) * p.dt[(size_t)r2 * 12 + hh] * p.xbc[(size_t)r2 * CONVD + cc]; }
        for (int s = lpos; s < CHUNK; ++s) { const int r2 = c0 + s; y += G[s] * expf(csb - p.cs[((size_t)M + r2) * SH + hh]) * p.dt[(size_t)r2 * 12 + 6 + hh] * p.xbc[(size_t)r2 * CONVD + cc]; }
        p.ydir[idx] = y;
    } break;
    case OP_SSD_ST: {
        const int n = (int)(idx % SN), pp = (int)((idx / SN) % SP), hh = (int)((idx / (SN * SP)) % SH), c = (int)((idx / (SN * SP * SH)) % NCH), dir = (int)(idx / ((long)SN * SP * SH * NCH)); const int g = hh / (SH / SG);
        const int rend = c * CHUNK + (dir == 0 ? CHUNK - 1 : 0); const float cse = p.cs[((size_t)dir * M + rend) * SH + hh]; float acc = 0.f;
        for (int i = 0; i < CHUNK; ++i) { const int r = c * CHUNK + i; acc += p.xbc[(size_t)r * CONVD + SW + g * SN + n] * expf(cse - p.cs[((size_t)dir * M + r) * SH + hh]) * p.dt[(size_t)r * 12 + dir * 6 + hh] * p.xbc[(size_t)r * CONVD + hh * SP + pp]; }
        p.st[idx] = acc;
    } break;
    case OP_SSD_CARRY: {
        const int e = (int)(idx % (SP * SN)), hh = (int)((idx / (SP * SN)) % SH), dir = (int)(idx / ((long)SP * SN * SH)); float state = 0.f;
        for (int i = 0; i < NCH; ++i) { const int c = dir == 0 ? i : (i < CTX / CHUNK ? CTX / CHUNK - 1 - i : NCH - 1 - (i - CTX / CHUNK));
            const size_t o = (((size_t)dir * NCH + c) * SH + hh) * (SP * SN) + e; const float stc = p.st[o]; p.st[o] = state; state = state * p.cdec[((size_t)dir * NCH + c) * SH + hh] + stc; }
    } break;
    case OP_SSD_YOFF: {
        const int cc = (int)(idx % SW), r = (int)(idx / SW); const int hh = cc / SP, pp = cc % SP, g = hh / (SH / SG), c = r / CHUNK; const float* Cp = p.xbc + (size_t)r * CONVD + SW + SG * SN + g * SN;
        float y = 0.f;
#pragma unroll
        for (int dir = 0; dir < 2; ++dir) { const float* pv = p.st + ((((size_t)dir * NCH + c) * SH + hh) * SP + pp) * SN; float acc = 0.f;
            for (int n = 0; n < SN; ++n) acc += Cp[n] * pv[n];
            y += acc * expf(p.cs[((size_t)dir * M + r) * SH + hh]); }
        p.ydir[(size_t)M * SW + idx] = y;
    } break;
    case OP_COMBINE2: { const int r = (int)(idx / D), c = (int)(idx % D); float s = 0.f;
#pragma unroll
        for (int kk = 0; kk < 4; ++kk) s += p.topw[(size_t)r * 4 + kk] * bf2f(p.ybn[((size_t)r * 4 + kk) * D + c]);
        p.xres[idx] += modv(p, l, r, 5)[c] * s; } break;
    }
}

static const int LAYER_OPS[] = { OP_ROWSTAT, OP_NORM1, OP_INPROJ, OP_LATNORM, OP_QRAW, OP_KVRAW, OP_QHEAD, OP_KHEAD, OP_ATTN, OP_CONV, OP_DT, OP_SSDSCAN, OP_SSDFIN, OP_POOLP, OP_POOLMM,
                                 OP_OUTPROJ, OP_RES1, OP_ROWSTAT, OP_NORM2, OP_LOGITS, OP_ZEROCNT, OP_TOPK, OP_GATEUP, OP_DOWN, OP_COMBINE };
constexpr int N_LAYER_OPS = sizeof(LAYER_OPS) / sizeof(int);
#endif

#define XB_TMO      128
#define XB_XCNT(j)  (256  + 64 * (j))
#define XB_XSUB(j)  (1280 + 64 * (j))
#define XB_XGEN(j)  (2304 + 64 * (j))
#define XB_TOP      3328
#define XB_TOPGEN   3392
#define XCD_BAR_WORDS 3456
#define XB_SPIN_CAP (1u << 22)
#define LAS __attribute__((address_space(3)))

__device__ __forceinline__ unsigned xb_ld(unsigned* p)              { return __hip_atomic_load(p, __ATOMIC_RELAXED, __HIP_MEMORY_SCOPE_AGENT); }
__device__ __forceinline__ unsigned xb_add(unsigned* p, unsigned v) { return __hip_atomic_fetch_add(p, v, __ATOMIC_RELAXED, __HIP_MEMORY_SCOPE_AGENT); }
__device__ __forceinline__ unsigned xb_xcc_id() { return (unsigned)__builtin_amdgcn_s_getreg((3 << 11) | 20) & 0xFu; }
#define XB_SPIN(cond, bar) do { unsigned _sp = 0; while (cond) { __builtin_amdgcn_s_sleep(1); \
    if ((++_sp & 255u) == 0u) { if (xb_ld(&(bar)[XB_TMO])) break; if (_sp > XB_SPIN_CAP) { atomicAdd(&(bar)[XB_TMO], 1u); break; } } } } while (0)

struct XcdBarrier {
    unsigned* bar; unsigned x;
    volatile LAS unsigned* st;
};

__device__ __forceinline__ XcdBarrier xcd_barrier_post(unsigned* bar, volatile LAS unsigned* st) {
    XcdBarrier b; b.bar = bar; b.x = xb_xcc_id(); b.st = st;
    if (threadIdx.x == 0) (void)xb_add(&bar[XB_XCNT(b.x)], 1u);
    return b;
}
__device__ __forceinline__ void xcd_barrier_complete(unsigned* bar, unsigned x, unsigned& nloc, unsigned& nx) {
    const unsigned G = gridDim.x * gridDim.y * gridDim.z;
    unsigned sum, cnt, mine, sp = 0u;
    for (;;) {
        sum = 0u; cnt = 0u; mine = 0u;
#pragma unroll
        for (unsigned j = 0; j < 16; ++j) { const unsigned c = xb_ld(&bar[XB_XCNT(j)]); sum += c; cnt += (c > 0u) ? 1u : 0u; mine = (j == x) ? c : mine; }
        if (sum == G) break;
        __builtin_amdgcn_s_sleep(1);
        if ((++sp & 255u) == 0u) { if (xb_ld(&bar[XB_TMO])) break; if (sp > XB_SPIN_CAP) { atomicAdd(&bar[XB_TMO], 1u); break; } }
    }
    nloc = mine > 0u ? mine : 1u; nx = cnt > 0u ? cnt : 1u;
}

__device__ __forceinline__ void xcd_barrier(const XcdBarrier& b) {
    asm volatile("s_waitcnt vmcnt(0)" ::: "memory");
    __syncthreads();
    if (threadIdx.x == 0) {
        unsigned* bar = b.bar;
        __builtin_amdgcn_s_waitcnt(0);
        unsigned nloc = b.st[0], nx = b.st[1];
        if (nloc == 0u) { unsigned xx = b.x; asm volatile("" : "+s"(xx));   xcd_barrier_complete(bar, xx, nloc, nx); b.st[0] = nloc; b.st[1] = nx; }
        const unsigned old = xb_add(&bar[XB_XSUB(b.x)], 1u);
        const unsigned gen = old / nloc;
        if (old + 1u == (gen + 1u) * nloc) {
            __builtin_amdgcn_fence(__ATOMIC_RELEASE, "agent");
            asm volatile("s_waitcnt vmcnt(0)" ::: "memory");
            const unsigned og = xb_add(&bar[XB_TOP], 1u);
            const unsigned tg = og / nx;
            if (og + 1u == (tg + 1u) * nx) xb_add(&bar[XB_TOPGEN], 1u);
            else XB_SPIN(xb_ld(&bar[XB_TOPGEN]) == tg, bar);
            __builtin_amdgcn_fence(__ATOMIC_ACQUIRE, "agent");
            xb_add(&bar[XB_XGEN(b.x)], 1u);
            asm volatile("s_waitcnt vmcnt(0)" ::: "memory");
        } else {
            XB_SPIN(xb_ld(&bar[XB_XGEN(b.x)]) == gen, bar);
            __builtin_amdgcn_fence(__ATOMIC_ACQUIRE, "agent");
            asm volatile("s_waitcnt vmcnt(0)" ::: "memory");
        }
    }
    __syncthreads();
}


namespace at {
typedef unsigned short bf16_t;
using bf16x8 = __attribute__((ext_vector_type(8))) short;
using s16x4  = __attribute__((ext_vector_type(4))) short;
using f32x16 = __attribute__((ext_vector_type(16))) float;
using u32x4  = __attribute__((ext_vector_type(4))) unsigned;
constexpr int DQ = 96, DV = 64, NW = 8, QBLK = 32, KVBLK = 64;
constexpr int LDQ = 6 * DQ, LDK = 6 * DQ, LDV = 6 * DV;
constexpr float SCALE = 0.10206207261596575f;
constexpr float QSCALE = SCALE * 1.4426950408889634f;
constexpr float THR = 8.f * 1.4426950408889634f;
constexpr int KROW = 208;
constexpr int SHM_K = KVBLK * KROW, SHM_V = KVBLK * DV * 2;
constexpr int SHM_ATTN = 2 * SHM_V + 2 * SHM_K + NW * 64 * 4;
#define AT_SBAR() __builtin_amdgcn_sched_barrier(0)
__device__ __forceinline__ int crow(int r, int hi) { return (r & 3) + 8 * (r >> 2) + 4 * hi; }
__device__ __forceinline__ unsigned cvtpk(float lo, float hi) { unsigned r; asm volatile("v_cvt_pk_bf16_f32 %0, %1, %2" : "=v"(r) : "v"(lo), "v"(hi)); return r; }

__device__ __forceinline__ void partialSM(f32x16& p0, f32x16& p1, float& m_reg, float& mn, float& alpha) {
  float pmax = p0[0];
#pragma unroll
  for (int r = 1; r < 16; ++r) pmax = fmaxf(pmax, p0[r]);
#pragma unroll
  for (int r = 0; r < 16; ++r) pmax = fmaxf(pmax, p1[r]);
  { auto rr = __builtin_amdgcn_permlane32_swap(__float_as_uint(pmax), __float_as_uint(pmax), false, false);
    pmax = fmaxf(__uint_as_float(rr[0]), __uint_as_float(rr[1])); }
  if (__builtin_expect(__all(pmax - m_reg <= THR), 1)) { mn = m_reg; alpha = 1.f; }
  else { mn = fmaxf(m_reg, pmax); alpha = __builtin_amdgcn_exp2f(m_reg - mn); m_reg = mn; }
#pragma unroll
  for (int r = 0; r < 16; ++r) p0[r] -= mn;
#pragma unroll
  for (int r = 0; r < 16; ++r) p1[r] -= mn;
#pragma unroll
  for (int r = 0; r < 16; ++r) p0[r] = __builtin_amdgcn_exp2f(p0[r]);
}
__device__ __forceinline__ void finishSM(f32x16& p0, f32x16& p1, float alpha, float& l_reg, bf16x8& pa0, bf16x8& pa1, bf16x8& pa2, bf16x8& pa3) {
#pragma unroll
  for (int r = 0; r < 16; ++r) p1[r] = __builtin_amdgcn_exp2f(p1[r]);
  float ps = 0;
#pragma unroll
  for (int r = 0; r < 16; ++r) ps += p0[r];
#pragma unroll
  for (int r = 0; r < 16; ++r) ps += p1[r];
  { auto rr = __builtin_amdgcn_permlane32_swap(__float_as_uint(ps), __float_as_uint(ps), false, false);
    ps = __uint_as_float(rr[0]) + __uint_as_float(rr[1]); }
  l_reg = l_reg * alpha + ps;
#define AT_PK4(P, BASE, OUT) do { unsigned a0 = cvtpk(P[BASE + 0], P[BASE + 1]), a1 = cvtpk(P[BASE + 2], P[BASE + 3]);   \
    unsigned b0 = cvtpk(P[BASE + 4], P[BASE + 5]), b1 = cvtpk(P[BASE + 6], P[BASE + 7]);                              \
    auto r0 = __builtin_amdgcn_permlane32_swap(a0, b0, false, false); auto r1 = __builtin_amdgcn_permlane32_swap(a1, b1, false, false); \
    u32x4 w = {r0[0], r1[0], r0[1], r1[1]}; OUT = *reinterpret_cast<bf16x8*>(&w); } while (0)
  AT_PK4(p0, 0, pa0); AT_PK4(p0, 8, pa1); AT_PK4(p1, 0, pa2); AT_PK4(p1, 8, pa3);
#undef AT_PK4
}
__device__ __forceinline__ void fastSM(f32x16& p0, f32x16& p1, float& l_reg, bf16x8& pa0, bf16x8& pa1, bf16x8& pa2, bf16x8& pa3) {
#pragma unroll
  for (int r = 0; r < 16; ++r) p0[r] = __builtin_amdgcn_exp2f(p0[r]);
#pragma unroll
  for (int r = 0; r < 16; ++r) p1[r] = __builtin_amdgcn_exp2f(p1[r]);
  float ps = 0;
#pragma unroll
  for (int r = 0; r < 16; ++r) ps += p0[r];
#pragma unroll
  for (int r = 0; r < 16; ++r) ps += p1[r];
  l_reg += ps;
#define AT_PK4(P, BASE, OUT) do { unsigned a0 = cvtpk(P[BASE + 0], P[BASE + 1]), a1 = cvtpk(P[BASE + 2], P[BASE + 3]);   \
    unsigned b0 = cvtpk(P[BASE + 4], P[BASE + 5]), b1 = cvtpk(P[BASE + 6], P[BASE + 7]);                              \
    auto r0 = __builtin_amdgcn_permlane32_swap(a0, b0, false, false); auto r1 = __builtin_amdgcn_permlane32_swap(a1, b1, false, false); \
    u32x4 w = {r0[0], r1[0], r0[1], r1[1]}; OUT = *reinterpret_cast<bf16x8*>(&w); } while (0)
  AT_PK4(p0, 0, pa0); AT_PK4(p0, 8, pa1); AT_PK4(p1, 0, pa2); AT_PK4(p1, 8, pa3);
#undef AT_PK4
}
__device__ __forceinline__ bool attn_fast_ok(const float* qn_g, const float* kn_g) {
  float gq = 0.f, gk = 0.f; for (int i = 0; i < DQ; ++i) { gq = fmaxf(gq, fabsf(qn_g[i])); gk = fmaxf(gk, fabsf(kn_g[i])); }
  return gq * gk * (float)DQ * QSCALE <= 80.f;
}
__device__ __forceinline__ void qkt(f32x16& p0, f32x16& p1, const char* Ks, const bf16x8* qr, int r32, int hi) {
  p0 = f32x16{}; p1 = f32x16{};
#pragma unroll
  for (int d0 = 0; d0 < 6; ++d0) { const int cb = (d0 * 16 + hi * 8) * 2;
    bf16x8 b0 = *reinterpret_cast<const bf16x8*>(Ks + r32 * KROW + cb);
    bf16x8 b1 = *reinterpret_cast<const bf16x8*>(Ks + (32 + r32) * KROW + cb);
    p0 = __builtin_amdgcn_mfma_f32_32x32x16_bf16(b0, qr[d0], p0, 0, 0, 0);
    p1 = __builtin_amdgcn_mfma_f32_32x32x16_bf16(b1, qr[d0], p1, 0, 0, 0); }
}
__device__ __forceinline__ int v_st(int k, int c) { const int kk = (k & ~0xC) | ((k & 4) << 1) | ((k & 8) >> 1); return ((kk >> 3) * 2 + (c >> 5)) * 512 + ((kk & 7) * 32 + (c & 31)) * 2; }
__device__ __forceinline__ int v_rd_base(int lane) { return ((lane & 3) << 3) | (((lane >> 2) & 3) << 6) | (((lane >> 4) & 1) << 5) | (((lane >> 5) & 1) << 8); }
constexpr int v_rd_off(int d0, int ks, int half) { return d0 * 512 + ks * 2048 + half * 1024; }
template <int OFF> __device__ __forceinline__ s16x4 tr_read(int vb) {
  s16x4 r; asm volatile("ds_read_b64_tr_b16 %0, %1 offset:%2" : "=&v"(r) : "v"(vb), "i"(OFF) : "memory"); return r;
}
template <int D0> __device__ __forceinline__ void pv_one(f32x16& od, int vb, bf16x8 pa0, bf16x8 pa1, bf16x8 pa2, bf16x8 pa3) {
  const s16x4 l0 = tr_read<v_rd_off(D0, 0, 0)>(vb), h0 = tr_read<v_rd_off(D0, 0, 1)>(vb), l1 = tr_read<v_rd_off(D0, 1, 0)>(vb), h1 = tr_read<v_rd_off(D0, 1, 1)>(vb);
  const s16x4 l2 = tr_read<v_rd_off(D0, 2, 0)>(vb), h2 = tr_read<v_rd_off(D0, 2, 1)>(vb), l3 = tr_read<v_rd_off(D0, 3, 0)>(vb), h3 = tr_read<v_rd_off(D0, 3, 1)>(vb);
  asm volatile("s_waitcnt lgkmcnt(0)" ::: "memory"); AT_SBAR();
#define AT_PK(L, H) (bf16x8){L[0], L[1], L[2], L[3], H[0], H[1], H[2], H[3]}
  od = __builtin_amdgcn_mfma_f32_32x32x16_bf16(pa0, AT_PK(l0, h0), od, 0, 0, 0);
  od = __builtin_amdgcn_mfma_f32_32x32x16_bf16(pa1, AT_PK(l1, h1), od, 0, 0, 0);
  od = __builtin_amdgcn_mfma_f32_32x32x16_bf16(pa2, AT_PK(l2, h2), od, 0, 0, 0);
  od = __builtin_amdgcn_mfma_f32_32x32x16_bf16(pa3, AT_PK(l3, h3), od, 0, 0, 0);
#undef AT_PK
}
__device__ __forceinline__ void pv_d0(f32x16* o, int vb, bf16x8 pa0, bf16x8 pa1, bf16x8 pa2, bf16x8 pa3) {
  pv_one<0>(o[0], vb, pa0, pa1, pa2, pa3); pv_one<1>(o[1], vb, pa0, pa1, pa2, pa3);
}
template <class TO, bool FAST> __device__ __forceinline__ void attn_body(const bf16_t* __restrict__ Qb, const bf16_t* __restrict__ Kh, const bf16_t* __restrict__ Vh, TO* __restrict__ Ob, int ldo, int seq, char* lds, float* __restrict__ ml = nullptr, int ldml = 0) {
  int tid = threadIdx.x; asm volatile("" : "+v"(tid));
  const int wid = tid >> 6, lane = tid & 63, r32 = lane & 31, hi = lane >> 5;
  char* V_lds = lds; char* K_lds = lds + 2 * SHM_V;
  float* ws = (float*)(lds + 2 * SHM_V + 2 * SHM_K) + wid * 64; float* li_l = ws; float* al_l = ws + 32;
  float m_reg = -1e30f, l_reg = 0; f32x16 o[2] = {}; bf16x8 qr[6];
  const bf16_t* Qw = Qb + (long)(wid * QBLK + r32) * LDQ + hi * 8;
#pragma unroll
  for (int d0 = 0; d0 < 6; ++d0) qr[d0] = *reinterpret_cast<const bf16x8*>(Qw + d0 * 16);
  const int kr0 = tid / 12, kc0 = tid % 12, c1 = 512 + (tid & 255), kr1 = c1 / 12, kc1 = c1 % 12, vr = tid >> 3, vc = (tid & 7) * 8;
  const bool k1on = tid < 256;
  const int kst0 = kr0 * KROW + kc0 * 16, kst1 = kr1 * KROW + kc1 * 16, vst = v_st(vr, vc);
  const long kg0 = (long)kr0 * LDK + kc0 * 8, kg1 = (long)kr1 * LDK + kc1 * 8, vg = (long)vr * LDV + vc;
  const int vb0 = (int)(uintptr_t)V_lds + v_rd_base(lane);
  struct { bf16x8 vs, ks0, ks1; } sr_[2];
#define AT_SLOAD(i, k0) do { sr_[i].vs = *reinterpret_cast<const bf16x8*>(Vh + (long)(k0) * LDV + vg); \
    sr_[i].ks0 = *reinterpret_cast<const bf16x8*>(Kh + (long)(k0) * LDK + kg0); sr_[i].ks1 = *reinterpret_cast<const bf16x8*>(Kh + (long)(k0) * LDK + kg1); } while (0)
#define AT_SWRITE(b, i) do { *(bf16x8*)(V_lds + (b) * SHM_V + vst) = sr_[i].vs; *(bf16x8*)(K_lds + (b) * SHM_K + kst0) = sr_[i].ks0; \
    if (k1on) *(bf16x8*)(K_lds + (b) * SHM_K + kst1) = sr_[i].ks1; } while (0)
#define AT_SWAIT() asm volatile("s_waitcnt vmcnt(3)" ::: "memory")
#define AT_RESC(a) do { if (__any((a) < 1.f)) { if (hi == 0) al_l[r32] = (a); asm volatile("s_waitcnt lgkmcnt(0)" ::: "memory"); \
    _Pragma("unroll") for (int d = 0; d < 2; ++d) _Pragma("unroll") for (int r = 0; r < 16; ++r) o[d][r] *= al_l[crow(r, hi)]; } } while (0)
  f32x16 pA0, pA1, pB0, pB1; float mnA, mnB, alA, alB; bf16x8 pa0, pa1, pa2, pa3; const int NT = seq / KVBLK;
  constexpr int SE = 0, SO = 1;
  AT_SLOAD(SE, 0); asm volatile("s_waitcnt vmcnt(0)" ::: "memory"); AT_SWRITE(0, SE); __syncthreads();
  if constexpr (FAST) {
    qkt(pA0, pA1, K_lds, qr, r32, hi);
    AT_SLOAD(SO, KVBLK); if (2 < NT) AT_SLOAD(SE, 2 * KVBLK);
    AT_SWAIT(); AT_SWRITE(1, SO); __syncthreads();
    for (int j = 1; j + 1 < NT; j += 2) {
      AT_SBAR(); qkt(pB0, pB1, K_lds + SHM_K, qr, r32, hi);
      fastSM(pA0, pA1, l_reg, pa0, pa1, pa2, pa3); AT_SBAR();
      AT_SLOAD(SO, (j + 2) * KVBLK); AT_SBAR();
      pv_d0(o, vb0, pa0, pa1, pa2, pa3);
      __syncthreads(); AT_SWAIT(); AT_SWRITE(0, SE);
      __syncthreads();
      AT_SBAR(); qkt(pA0, pA1, K_lds, qr, r32, hi);
      fastSM(pB0, pB1, l_reg, pa0, pa1, pa2, pa3); AT_SBAR();
      if (j + 3 < NT) AT_SLOAD(SE, (j + 3) * KVBLK); AT_SBAR();
      pv_d0(o, vb0 + SHM_V, pa0, pa1, pa2, pa3);
      __syncthreads(); AT_SWAIT(); AT_SWRITE(1, SO);
      __syncthreads();
    }
    AT_SBAR(); qkt(pB0, pB1, K_lds + SHM_K, qr, r32, hi);
    fastSM(pA0, pA1, l_reg, pa0, pa1, pa2, pa3); AT_SBAR();
    pv_d0(o, vb0, pa0, pa1, pa2, pa3);
    fastSM(pB0, pB1, l_reg, pa0, pa1, pa2, pa3); AT_SBAR();
    pv_d0(o, vb0 + SHM_V, pa0, pa1, pa2, pa3);
    { auto rr = __builtin_amdgcn_permlane32_swap(__float_as_uint(l_reg), __float_as_uint(l_reg), false, false); l_reg = __uint_as_float(rr[0]) + __uint_as_float(rr[1]); }
    m_reg = 0.f;
  } else {
  qkt(pA0, pA1, K_lds, qr, r32, hi); partialSM(pA0, pA1, m_reg, mnA, alA);
  AT_SLOAD(SO, KVBLK); if (2 < NT) AT_SLOAD(SE, 2 * KVBLK);
  AT_SWAIT(); AT_SWRITE(1, SO); __syncthreads();
  for (int j = 1; j + 1 < NT; j += 2) {
    AT_SBAR(); qkt(pB0, pB1, K_lds + SHM_K, qr, r32, hi);
    finishSM(pA0, pA1, alA, l_reg, pa0, pa1, pa2, pa3); AT_SBAR();
    AT_SLOAD(SO, (j + 2) * KVBLK); AT_SBAR();
    pv_d0(o, vb0, pa0, pa1, pa2, pa3); partialSM(pB0, pB1, m_reg, mnB, alB);
    __syncthreads(); AT_SWAIT(); AT_SWRITE(0, SE);
    AT_RESC(alB); __syncthreads();
    AT_SBAR(); qkt(pA0, pA1, K_lds, qr, r32, hi);
    finishSM(pB0, pB1, alB, l_reg, pa0, pa1, pa2, pa3); AT_SBAR();
    if (j + 3 < NT) AT_SLOAD(SE, (j + 3) * KVBLK); AT_SBAR();
    pv_d0(o, vb0 + SHM_V, pa0, pa1, pa2, pa3); partialSM(pA0, pA1, m_reg, mnA, alA);
    __syncthreads(); AT_SWAIT(); AT_SWRITE(1, SO);
    AT_RESC(alA); __syncthreads();
  }
  AT_SBAR(); qkt(pB0, pB1, K_lds + SHM_K, qr, r32, hi);
  finishSM(pA0, pA1, alA, l_reg, pa0, pa1, pa2, pa3); AT_SBAR();
  pv_d0(o, vb0, pa0, pa1, pa2, pa3); partialSM(pB0, pB1, m_reg, mnB, alB);
  __syncthreads(); AT_RESC(alB);
  finishSM(pB0, pB1, alB, l_reg, pa0, pa1, pa2, pa3); AT_SBAR();
  pv_d0(o, vb0 + SHM_V, pa0, pa1, pa2, pa3);
  }
  if (hi == 0) li_l[r32] = l_reg; asm volatile("s_waitcnt lgkmcnt(0)" ::: "memory");
  if (ml != nullptr && hi == 0) { float* q = ml + (long)(wid * QBLK + r32) * ldml; q[0] = m_reg; q[1] = l_reg; }
  float rli[16];
#pragma unroll
  for (int r = 0; r < 16; ++r) rli[r] = __builtin_amdgcn_rcpf(li_l[crow(r, hi)]);
  TO* Ow = Ob + (long)(wid * QBLK) * ldo;
#pragma unroll
  for (int r = 0; r < 16; ++r) { const int orow = crow(r, hi);
#pragma unroll
    for (int d0 = 0; d0 < 2; ++d0) { const float val = o[d0][r] * rli[r]; if constexpr (sizeof(TO) == 2) Ow[(long)orow * ldo + d0 * 32 + r32] = (TO)(cvtpk(val, val) & 0xffffu); else Ow[(long)orow * ldo + d0 * 32 + r32] = val; } }
#undef AT_SLOAD
#undef AT_SWRITE
#undef AT_SWAIT
#undef AT_RESC
}
__device__ __forceinline__ void attn_combine(const bf16_t* Opart, const float* ml, bf16_t* dst, int ldd, int nrows_total, int ctx_rows) {
  int tid = threadIdx.x; asm volatile("" : "+v"(tid)); const int wid = tid >> 6, lane = tid & 63;
  const size_t hs = (size_t)nrows_total * 6 * DV;
  for (int r = blockIdx.x * 8 + wid; r < nrows_total; r += gridDim.x * 8) {
#pragma unroll
    for (int j = 0; j < 3; ++j) { const int c = 2 * (lane + 64 * j), hh = c >> 6; const unsigned w0 = *(const unsigned*)(Opart + (size_t)r * 384 + c);
      unsigned res = w0;
      if (r >= ctx_rows) { const unsigned w1 = *(const unsigned*)(Opart + hs + (size_t)r * 384 + c);
        const float m0 = ml[((size_t)r * 6 + hh) * 2], l0 = ml[((size_t)r * 6 + hh) * 2 + 1], m1 = ml[((size_t)(nrows_total + r) * 6 + hh) * 2], l1 = ml[((size_t)(nrows_total + r) * 6 + hh) * 2 + 1];
        const float m = fmaxf(m0, m1); const float a0 = __builtin_amdgcn_exp2f(m0 - m) * l0, a1 = __builtin_amdgcn_exp2f(m1 - m) * l1; const float inv = 1.0f / (a0 + a1); const float f0 = a0 * inv, f1 = a1 * inv;
        const float x0 = __uint_as_float(w0 << 16) * f0 + __uint_as_float(w1 << 16) * f1, x1 = __uint_as_float(w0 & 0xffff0000u) * f0 + __uint_as_float(w1 & 0xffff0000u) * f1; res = cvtpk(x0, x1); }
      *(unsigned*)(dst + (size_t)r * ldd + c) = res; } }
}
}

namespace gm {
#define GM_LAS __attribute__((address_space(3)))
typedef unsigned short bf16_t;
typedef short bf16x8 __attribute__((ext_vector_type(8)));
typedef float f32x4 __attribute__((ext_vector_type(4)));
typedef unsigned u32x4 __attribute__((ext_vector_type(4)));
constexpr int BM = 256, BK = 64, HALF = 128, HTB = HALF * BK * 2, STAGE_BYTES = 8 * HTB;
__host__ __device__ __forceinline__ int lds_byte(int r, int c) { const int st = (r >> 4) * 2 + (c >> 5), rr = r & 15, cc = c & 31, ob = rr * 64 + cc * 2; return st * 1024 + (ob ^ (((ob >> 9) & 1) << 5)); }
__host__ __device__ __forceinline__ void stage_rc(int b, int& R, int& C) { const int st = b / 1024, sb = b % 1024, swz = sb ^ (((sb >> 9) & 1) << 5); R = (st >> 1) * 16 + swz / 64; C = (st & 1) * 32 + (swz % 64) / 2; }
__host__ __device__ __forceinline__ int perm32(int rho) { const int n = rho >> 4, i = rho & 15; return 8 * (i >> 2) + 4 * n + (i & 3); }
__device__ __forceinline__ unsigned cvt_pk_bf16(float lo, float hi) { unsigned r; asm volatile("v_cvt_pk_bf16_f32 %0, %1, %2" : "=v"(r) : "v"(lo), "v"(hi)); return r; }

template <bool PERM, class Epi>
__device__ __forceinline__ void gemm_unit(GM_LAS unsigned char* lds, const char* A, const unsigned (&offA)[2][2], const char* Bt, int K, const Epi& E) {
    int tid = threadIdx.x; asm volatile("" : "+v"(tid));
    const int wid = __builtin_amdgcn_readfirstlane(tid >> 6), lane = tid & 63, wr = wid >> 2, wc = wid & 3, fr = lane & 15, fq = lane >> 4;
    const int nt = K / BK;
    unsigned voffB[2];
#pragma unroll
    for (int i = 0; i < 2; ++i) { int R, C; stage_rc(tid * 16 + i * 8192, R, C); const int Rb = PERM ? ((R & ~31) + perm32(R & 31)) : R; voffB[i] = (unsigned)(Rb * K + C) * 2u; }
    const size_t kstep = (size_t)(BK * 2);
    const size_t hstep = (size_t)HALF * K * 2;
    const unsigned ldsw = (unsigned)wid * 1024u;
    const int aoff = lds_byte(wr * 64 + fr, fq * 8), boff = lds_byte(wc * 32 + fr, fq * 8);
#define GM_SA(b, h) (((b) * 2 + (h)) * HTB)
#define GM_SB(b, h) ((4 + (b) * 2 + (h)) * HTB)
#define GM_STAGEB(bufoff, gbase) do { _Pragma("unroll") for (int _i = 0; _i < 2; ++_i) \
        __builtin_amdgcn_global_load_lds((const unsigned*)((const char*)(gbase) + voffB[_i]), (GM_LAS unsigned*)(lds + (bufoff) + ldsw + _i * 8192), 16, 0, 0); } while (0)
#define GM_STAGEA(bufoff, h, kbyte) do { _Pragma("unroll") for (int _i = 0; _i < 2; ++_i) \
        __builtin_amdgcn_global_load_lds((const unsigned*)(A + (size_t)offA[h][_i] + (kbyte)), (GM_LAS unsigned*)(lds + (bufoff) + ldsw + _i * 8192), 16, 0, 0); } while (0)
#define GM_LDA(dst, b, h) do { _Pragma("unroll") for (int m = 0; m < 4; ++m) _Pragma("unroll") for (int k = 0; k < 2; ++k) dst[m][k] = *(const GM_LAS bf16x8*)(lds + GM_SA(b, h) + aoff + m * 2048 + k * 1024); } while (0)
#define GM_LDB(dst, b, h) do { _Pragma("unroll") for (int n = 0; n < 2; ++n) _Pragma("unroll") for (int k = 0; k < 2; ++k) dst[n][k] = *(const GM_LAS bf16x8*)(lds + GM_SB(b, h) + boff + n * 2048 + k * 1024); } while (0)
#define GM_MMA(ai, bj, At, Bt_) do { __builtin_amdgcn_s_setprio(1); _Pragma("unroll") for (int m = 0; m < 4; ++m) _Pragma("unroll") for (int n = 0; n < 2; ++n) _Pragma("unroll") for (int k = 0; k < 2; ++k) \
        acc[ai][bj][m][n] = __builtin_amdgcn_mfma_f32_16x16x32_bf16(Bt_[n][k], At[m][k], acc[ai][bj][m][n], 0, 0, 0); __builtin_amdgcn_s_setprio(0); } while (0)
#define GM_WAIT_V(n) asm volatile("s_waitcnt vmcnt(" #n ")" ::: "memory")
#define GM_WAIT_L(n) asm volatile("s_waitcnt lgkmcnt(" #n ")" ::: "memory")
#define GM_BAR __builtin_amdgcn_s_barrier()
#define GM_SCHED __builtin_amdgcn_sched_barrier(0)
    f32x4 acc[2][2][4][2];
#pragma unroll
    for (int a = 0; a < 2; ++a)
#pragma unroll
        for (int b = 0; b < 2; ++b)
#pragma unroll
            for (int m = 0; m < 4; ++m)
#pragma unroll
                for (int n = 0; n < 2; ++n) acc[a][b][m][n] = (f32x4){0.f, 0.f, 0.f, 0.f};
    bf16x8 At[4][2], B0[2][2], B1[2][2];
    const char* cB = Bt;
    GM_STAGEB(GM_SB(0, 0), cB); GM_STAGEA(GM_SA(0, 0), 0, 0); GM_STAGEB(GM_SB(0, 1), cB + hstep); GM_STAGEA(GM_SA(0, 1), 1, 0);
    if (wr == 1) GM_BAR;
    GM_WAIT_V(4); GM_BAR;
    GM_STAGEB(GM_SB(1, 0), cB + kstep); GM_STAGEA(GM_SA(1, 0), 0, kstep); GM_STAGEB(GM_SB(1, 1), cB + hstep + kstep);
    GM_WAIT_V(6); GM_BAR;
    for (int t = 0; t < nt; t += 2) {
        const bool last = (t == nt - 2);
        const size_t k1 = (size_t)(t + 1) * kstep;
        const size_t k2 = last ? 0 : (size_t)(t + 2) * kstep;
        const size_t k3 = k2 + kstep;
        const char* b2 = cB + k2; const char* b3 = cB + k3;
        GM_LDB(B0, 0, 0); GM_SCHED; GM_LDA(At, 0, 0); GM_STAGEA(GM_SA(1, 1), 1, k1);
        GM_WAIT_L(8); GM_BAR; GM_WAIT_L(0); GM_MMA(0, 0, At, B0); GM_BAR; GM_SCHED;
        GM_LDB(B1, 0, 1); GM_STAGEB(GM_SB(0, 0), b2);
        GM_BAR; GM_WAIT_L(0); GM_MMA(0, 1, At, B1); GM_BAR;
        GM_LDA(At, 0, 1); GM_STAGEA(GM_SA(0, 0), 0, k2);
        GM_BAR; GM_WAIT_L(0); GM_MMA(1, 0, At, B0); GM_BAR; GM_SCHED;
        GM_STAGEB(GM_SB(0, 1), b2 + hstep);
        GM_WAIT_V(6); GM_BAR; GM_MMA(1, 1, At, B1); GM_BAR;
        GM_LDB(B0, 1, 0); GM_SCHED; GM_LDA(At, 1, 0); GM_STAGEA(GM_SA(0, 1), 1, k2);
        GM_WAIT_L(8); GM_BAR; GM_WAIT_L(0); GM_MMA(0, 0, At, B0); GM_BAR; GM_SCHED;
        GM_LDB(B1, 1, 1); GM_STAGEB(GM_SB(1, 0), b3);
        GM_BAR; GM_WAIT_L(0); GM_MMA(0, 1, At, B1); GM_BAR;
        GM_LDA(At, 1, 1); GM_STAGEA(GM_SA(1, 0), 0, k3);
        GM_BAR; GM_WAIT_L(0); GM_MMA(1, 0, At, B0); GM_BAR; GM_SCHED;
        GM_STAGEB(GM_SB(1, 1), b3 + hstep);
        GM_WAIT_V(6); GM_BAR; GM_MMA(1, 1, At, B1); GM_BAR;
    }
    E(acc, wr, wc, fr, fq);
    GM_WAIT_V(0);
    if (wr == 0) GM_BAR;
    GM_BAR;
#undef GM_SA
#undef GM_SB
#undef GM_STAGEA
#undef GM_STAGEB
#undef GM_LDA
#undef GM_LDB
#undef GM_MMA
#undef GM_WAIT_V
#undef GM_WAIT_L
#undef GM_BAR
#undef GM_SCHED
}
template <bool PERM, class U, class Sched, class Epi>
__device__ __forceinline__ void gemm_stream(GM_LAS unsigned char* lds, int K, const Sched& S, const Epi& E) {
    int tid = threadIdx.x; asm volatile("" : "+v"(tid));
    const int wid = __builtin_amdgcn_readfirstlane(tid >> 6), lane = tid & 63, wr = wid >> 2, wc = wid & 3, fr = lane & 15, fq = lane >> 4;
    const int nt = K / BK;
    unsigned voffB[2];
#pragma unroll
    for (int i = 0; i < 2; ++i) { int R, C; stage_rc(tid * 16 + i * 8192, R, C); const int Rb = PERM ? ((R & ~31) + perm32(R & 31)) : R; voffB[i] = (unsigned)(Rb * K + C) * 2u; }
    const size_t kstep = (size_t)(BK * 2);
    const size_t hstep = (size_t)HALF * K * 2;
    const unsigned ldsw = (unsigned)wid * 1024u;
    const int aoff = lds_byte(wr * 64 + fr, fq * 8), boff = lds_byte(wc * 32 + fr, fq * 8);
#define GM_SA(b, h) (((b) * 2 + (h)) * HTB)
#define GM_SB(b, h) ((4 + (b) * 2 + (h)) * HTB)
#define GM_STAGEB(bufoff, gbase) do { _Pragma("unroll") for (int _i = 0; _i < 2; ++_i) \
        __builtin_amdgcn_global_load_lds((const unsigned*)((const char*)(gbase) + voffB[_i]), (GM_LAS unsigned*)(lds + (bufoff) + ldsw + _i * 8192), 16, 0, 0); } while (0)
#define GM_STAGEA2(bufoff, abase, o0, o1, kbyte) do { \
        __builtin_amdgcn_global_load_lds((const unsigned*)((abase) + (size_t)(o0) + (kbyte)), (GM_LAS unsigned*)(lds + (bufoff) + ldsw), 16, 0, 0); \
        __builtin_amdgcn_global_load_lds((const unsigned*)((abase) + (size_t)(o1) + (kbyte)), (GM_LAS unsigned*)(lds + (bufoff) + ldsw + 8192), 16, 0, 0); } while (0)
#define GM_LDA(dst, b, h) do { _Pragma("unroll") for (int m = 0; m < 4; ++m) _Pragma("unroll") for (int k = 0; k < 2; ++k) dst[m][k] = *(const GM_LAS bf16x8*)(lds + GM_SA(b, h) + aoff + m * 2048 + k * 1024); } while (0)
#define GM_LDB(dst, b, h) do { _Pragma("unroll") for (int n = 0; n < 2; ++n) _Pragma("unroll") for (int k = 0; k < 2; ++k) dst[n][k] = *(const GM_LAS bf16x8*)(lds + GM_SB(b, h) + boff + n * 2048 + k * 1024); } while (0)
#define GM_MMA(ai, bj, At, Bt_) do { __builtin_amdgcn_s_setprio(1); _Pragma("unroll") for (int m = 0; m < 4; ++m) _Pragma("unroll") for (int n = 0; n < 2; ++n) _Pragma("unroll") for (int k = 0; k < 2; ++k) \
        acc[ai][bj][m][n] = __builtin_amdgcn_mfma_f32_16x16x32_bf16(Bt_[n][k], At[m][k], acc[ai][bj][m][n], 0, 0, 0); __builtin_amdgcn_s_setprio(0); } while (0)
#define GM_WAIT_V(n) asm volatile("s_waitcnt vmcnt(" #n ")" ::: "memory")
#define GM_WAIT_L(n) asm volatile("s_waitcnt lgkmcnt(" #n ")" ::: "memory")
#define GM_BAR __builtin_amdgcn_s_barrier()
#define GM_SCHED __builtin_amdgcn_sched_barrier(0)
    U cur, nxt; int ui = 0;
    if (!S(0, cur)) return;
    f32x4 acc[2][2][4][2];
#pragma unroll
    for (int a = 0; a < 2; ++a)
#pragma unroll
        for (int b = 0; b < 2; ++b)
#pragma unroll
            for (int m = 0; m < 4; ++m)
#pragma unroll
                for (int n = 0; n < 2; ++n) acc[a][b][m][n] = (f32x4){0.f, 0.f, 0.f, 0.f};
    bf16x8 At[4][2], B0[2][2], B1[2][2];
    GM_STAGEB(GM_SB(0, 0), cur.B); GM_STAGEA2(GM_SA(0, 0), cur.A, cur.offA[0][0], cur.offA[0][1], 0); GM_STAGEB(GM_SB(0, 1), cur.B + hstep); GM_STAGEA2(GM_SA(0, 1), cur.A, cur.offA[1][0], cur.offA[1][1], 0);
    if (wr == 1) GM_BAR;
    GM_WAIT_V(4); GM_BAR;
    GM_STAGEB(GM_SB(1, 0), cur.B + kstep); GM_STAGEA2(GM_SA(1, 0), cur.A, cur.offA[0][0], cur.offA[0][1], kstep); GM_STAGEB(GM_SB(1, 1), cur.B + hstep + kstep);
    GM_WAIT_V(6); GM_BAR;
    for (;;) {
        const bool has_next = S(ui + 1, nxt);
        for (int t = 0; t < nt; t += 2) {
            const bool last = (t == nt - 2); const bool usen = last && has_next;
            const size_t k1 = (size_t)(t + 1) * kstep;
            const size_t k2 = last ? 0 : (size_t)(t + 2) * kstep, k3 = k2 + kstep;
            const char* a2b = usen ? nxt.A : cur.A; const char* b2b = usen ? nxt.B : cur.B;
            const unsigned o00 = usen ? nxt.offA[0][0] : cur.offA[0][0], o01 = usen ? nxt.offA[0][1] : cur.offA[0][1], o10 = usen ? nxt.offA[1][0] : cur.offA[1][0], o11 = usen ? nxt.offA[1][1] : cur.offA[1][1];
            const char* b2 = b2b + k2; const char* b3 = b2b + k3;
            GM_LDB(B0, 0, 0); GM_SCHED; GM_LDA(At, 0, 0); GM_STAGEA2(GM_SA(1, 1), cur.A, cur.offA[1][0], cur.offA[1][1], k1);
            GM_WAIT_L(8); GM_BAR; GM_WAIT_L(0); GM_MMA(0, 0, At, B0); GM_BAR; GM_SCHED;
            GM_LDB(B1, 0, 1); GM_STAGEB(GM_SB(0, 0), b2);
            GM_BAR; GM_WAIT_L(0); GM_MMA(0, 1, At, B1); GM_BAR;
            GM_LDA(At, 0, 1); GM_STAGEA2(GM_SA(0, 0), a2b, o00, o01, k2);
            GM_BAR; GM_WAIT_L(0); GM_MMA(1, 0, At, B0); GM_BAR; GM_SCHED;
            GM_STAGEB(GM_SB(0, 1), b2 + hstep);
            GM_WAIT_V(6); GM_BAR; GM_MMA(1, 1, At, B1); GM_BAR;
            GM_LDB(B0, 1, 0); GM_SCHED; GM_LDA(At, 1, 0); GM_STAGEA2(GM_SA(0, 1), a2b, o10, o11, k2);
            GM_WAIT_L(8); GM_BAR; GM_WAIT_L(0); GM_MMA(0, 0, At, B0); GM_BAR; GM_SCHED;
            GM_LDB(B1, 1, 1); GM_STAGEB(GM_SB(1, 0), b3);
            GM_BAR; GM_WAIT_L(0); GM_MMA(0, 1, At, B1); GM_BAR;
            GM_LDA(At, 1, 1); GM_STAGEA2(GM_SA(1, 0), a2b, o00, o01, k3);
            GM_BAR; GM_WAIT_L(0); GM_MMA(1, 0, At, B0); GM_BAR; GM_SCHED;
            GM_STAGEB(GM_SB(1, 1), b3 + hstep);
            GM_WAIT_V(6); GM_BAR; GM_MMA(1, 1, At, B1); GM_BAR;
        }
        E(acc, cur, wr, wc, fr, fq);
        if (!has_next) break;
#pragma unroll
        for (int a = 0; a < 2; ++a)
#pragma unroll
            for (int b = 0; b < 2; ++b)
#pragma unroll
                for (int m = 0; m < 4; ++m)
#pragma unroll
                    for (int n = 0; n < 2; ++n) acc[a][b][m][n] = (f32x4){0.f, 0.f, 0.f, 0.f};
        cur = nxt; ++ui;
    }
    GM_WAIT_V(0);
    if (wr == 0) GM_BAR;
    GM_BAR;
#undef GM_SA
#undef GM_SB
#undef GM_STAGEA2
#undef GM_STAGEB
#undef GM_LDA
#undef GM_LDB
#undef GM_MMA
#undef GM_WAIT_V
#undef GM_WAIT_L
#undef GM_BAR
#undef GM_SCHED
}
__device__ __forceinline__ void dense_offA(unsigned (&offA)[2][2], long row0, int K) {
    int tid = threadIdx.x; asm volatile("" : "+v"(tid));
#pragma unroll
    for (int i = 0; i < 2; ++i) { int R, C; stage_rc(tid * 16 + i * 8192, R, C);
#pragma unroll
        for (int h = 0; h < 2; ++h) offA[h][i] = (unsigned)(((row0 + h * HALF + R) * K + C) * 2); }
}
}

struct FW {
    bf16_t *w_in_t, *w_out_t, *gu_t, *d_t;
    bf16_t *hb1, *hb2, *mixb, *actb, *yb;
    bf16_t* projb;
    float *proj2, *mix2;
    bf16_t *w_uq_t, *w_ukv_t;
    float *ropec, *ropes;
    bf16_t *qb2, *kb2, *vb2;
    bf16_t* opart; float* aml;
    float *yd2, *st2, *cdec2, *cs2; bf16_t *cg, *prevb, *ssdb2;
};
constexpr int INC_PAD = 1792;
template <int MAP> __device__ __forceinline__ void cvt_tile(const float* src, int ldn, int nvalid, bf16_t* dst, int K, int k0, int n0, float* T) {
    int tid = threadIdx.x; asm volatile("" : "+v"(tid)); const int r = tid >> 4, c4 = (tid & 15) * 4;
#pragma unroll
    for (int i = 0; i < 2; ++i) { const int kk = r + 32 * i; float4 v = make_float4(0.f, 0.f, 0.f, 0.f);
        if (n0 + c4 < nvalid) v = *(const float4*)(src + (size_t)(k0 + kk) * ldn + n0 + c4);
        T[kk * 65 + c4 + 0] = v.x; T[kk * 65 + c4 + 1] = v.y; T[kk * 65 + c4 + 2] = v.z; T[kk * 65 + c4 + 3] = v.w; }
    __syncthreads();
    { const int n = tid >> 3, kc = tid & 7; float f[8];
#pragma unroll
        for (int j = 0; j < 8; ++j) f[j] = T[(kc * 8 + j) * 65 + n];
        gm::u32x4 w; w.x = gm::cvt_pk_bf16(f[0], f[1]); w.y = gm::cvt_pk_bf16(f[2], f[3]); w.z = gm::cvt_pk_bf16(f[4], f[5]); w.w = gm::cvt_pk_bf16(f[6], f[7]);
        const int nn = n0 + n; const int drow = MAP == 0 ? nn : ((nn >> 7) * 256 + (MAP == 2 ? 128 : 0) + (nn & 127));
        *(gm::u32x4*)(dst + (size_t)drow * K + k0 + kc * 8) = w; }
    __syncthreads();
}
template <int MAP> __device__ __forceinline__ void cvt_strip(const float* src, int ldn, int nvalid, bf16_t* dst, int K, int k0, int n0, float* T) {
    int tid = threadIdx.x; asm volatile("" : "+v"(tid)); const int r = tid >> 4, c4 = (tid & 15) * 4;
    float4 v[4][2];
#pragma unroll
    for (int t = 0; t < 4; ++t)
#pragma unroll
        for (int i = 0; i < 2; ++i) { v[t][i] = make_float4(0.f, 0.f, 0.f, 0.f); if (n0 + t * 64 + c4 < nvalid) v[t][i] = *(const float4*)(src + (size_t)(k0 + r + 32 * i) * ldn + n0 + t * 64 + c4); }
#pragma unroll
    for (int t = 0; t < 4; ++t)
#pragma unroll
        for (int i = 0; i < 2; ++i) { float* q = T + t * (64 * 65) + (r + 32 * i) * 65 + c4; q[0] = v[t][i].x; q[1] = v[t][i].y; q[2] = v[t][i].z; q[3] = v[t][i].w; }
    __syncthreads();
    { const int n = tid >> 3, kc = tid & 7;
#pragma unroll
        for (int t = 0; t < 4; ++t) { float f[8];
#pragma unroll
            for (int j = 0; j < 8; ++j) f[j] = T[t * (64 * 65) + (kc * 8 + j) * 65 + n];
            gm::u32x4 w; w.x = gm::cvt_pk_bf16(f[0], f[1]); w.y = gm::cvt_pk_bf16(f[2], f[3]); w.z = gm::cvt_pk_bf16(f[4], f[5]); w.w = gm::cvt_pk_bf16(f[6], f[7]);
            const int nn = n0 + t * 64 + n; const int drow = MAP == 0 ? nn : ((nn >> 7) * 256 + (MAP == 2 ? 128 : 0) + (nn & 127));
            *(gm::u32x4*)(dst + (size_t)drow * K + k0 + kc * 8) = w; } }
    __syncthreads();
}
__device__ __forceinline__ void cvt_phase(const P& p, const FW& f, int l0, int l1, char* lds) {
    float* T = (float*)lds;
    constexpr int T_IN = 16 * 7, T_OUT = 16 * 4, T_E = 16 * 4, T_UQ = 4 * 9, T_UKV = 2 * 12, T_LAYER = T_IN + T_OUT + T_UQ + T_UKV + NE * 3 * T_E;
    const int total = (l1 - l0) * T_LAYER;
    if (blockIdx.x == gridDim.x - 1) for (int i = threadIdx.x; i < 256 * 8; i += 512) { float cs, sn; sincos_rr((float)(i >> 3) * rope_inv_freq(i & 7), cs, sn); f.ropec[i] = cs; f.ropes[i] = sn; }
    for (int t = blockIdx.x; t < total; t += gridDim.x) {
        const int l = l0 + t / T_LAYER; int r = t % T_LAYER;
        if (r < T_IN) { const int kt = r / 7, ntl = r % 7; cvt_strip<0>(p.w_in + (size_t)l * D * INC, INC, INC, f.w_in_t + (size_t)l * INC_PAD * D, D, kt * 64, ntl * 256, T); continue; }
        r -= T_IN;
        if (r < T_OUT) { const int kt = r / 4, ntl = r % 4; cvt_strip<0>(p.w_out + (size_t)l * MIXW * D, D, D, f.w_out_t + (size_t)l * D * MIXW, MIXW, kt * 64, ntl * 256, T); continue; }
        r -= T_OUT;
        if (r < T_UQ) { const int kt = r / 9, ntl = r % 9; cvt_tile<0>(p.w_uq + (size_t)l * QL * NH * QKD, NH * QKD, NH * QKD, f.w_uq_t + (size_t)l * NH * QKD * QL, QL, kt * 64, ntl * 64, T); continue; }
        r -= T_UQ;
        if (r < T_UKV) { const int kt = r / 12, ntl = r % 12; cvt_tile<0>(p.w_ukv + (size_t)l * KVL * NH * 128, NH * 128, NH * 128, f.w_ukv_t + (size_t)l * NH * 128 * KVL, KVL, kt * 64, ntl * 64, T); continue; }
        r -= T_UKV;
        const int e = r / (3 * T_E), which = (r / T_E) % 3, tt = r % T_E, kt = tt / 4, ntl = tt % 4; const size_t le = (size_t)l * NE + e;
        if (which == 0) cvt_strip<1>(p.wg + le * D * FF, FF, FF, f.gu_t + le * 2 * FF * D, D, kt * 64, ntl * 256, T);
        else if (which == 1) cvt_strip<2>(p.wu + le * D * FF, FF, FF, f.gu_t + le * 2 * FF * D, D, kt * 64, ntl * 256, T);
        else cvt_strip<0>(p.wd + le * FF * D, D, D, f.d_t + le * D * FF, FF, kt * 64, ntl * 256, T);
    }
}
struct UDense { const char* A; unsigned offA[2][2]; const char* B; int pm, pn; };
__device__ __forceinline__ void inproj_phase(const P& p, const FW& f, int l, bf16_t* dst, char* lds) {
    constexpr int NPN = INC_PAD / 256, NU = (M / 256) * NPN;
    auto sched = [&](int i, UDense& u) { const int uu = blockIdx.x + i * gridDim.x; if (uu >= NU) return false; u.pm = uu / NPN; u.pn = uu % NPN; u.A = (const char*)f.hb1; gm::dense_offA(u.offA, (long)u.pm * 256, D);
        u.B = (const char*)(f.w_in_t + ((size_t)l * INC_PAD + u.pn * 256) * D); return true; };
    auto epi = [&](const gm::f32x4 (&acc)[2][2][4][2], const UDense& u, int wr, int wc, int fr, int fq) {
        const int row0 = u.pm * 256 + wr * 64 + fr, col0 = u.pn * 256 + wc * 32 + 8 * fq;
#pragma unroll
        for (int ai = 0; ai < 2; ++ai)
#pragma unroll
            for (int m = 0; m < 4; ++m) { bf16_t* rowp = dst + (size_t)(row0 + ai * 128 + m * 16) * INC_PAD + col0;
#pragma unroll
                for (int bj = 0; bj < 2; ++bj) { const gm::f32x4 v0 = acc[ai][bj][m][0], v1 = acc[ai][bj][m][1];
                    gm::u32x4 w; w.x = gm::cvt_pk_bf16(v0[0], v0[1]); w.y = gm::cvt_pk_bf16(v0[2], v0[3]); w.z = gm::cvt_pk_bf16(v1[0], v1[1]); w.w = gm::cvt_pk_bf16(v1[2], v1[3]);
                    *(gm::u32x4*)(rowp + bj * 128) = w; } } };
    gm::gemm_stream<true, UDense>((GM_LAS unsigned char*)lds, D, sched, epi);
}
template <bool TOX> __device__ __forceinline__ void outproj_phase(const P& p, const FW& f, int l, float* dst, char* lds) {
    constexpr int NPN = D / 256, NU = (M / 256) * NPN;
    auto sched = [&](int i, UDense& u) { const int uu = blockIdx.x + i * gridDim.x; if (uu >= NU) return false; u.pm = uu / NPN; u.pn = uu % NPN; u.A = (const char*)f.mixb; gm::dense_offA(u.offA, (long)u.pm * 256, MIXW);
        u.B = (const char*)(f.w_out_t + ((size_t)l * D + u.pn * 256) * MIXW); return true; };
    auto epi = [&](const gm::f32x4 (&acc)[2][2][4][2], const UDense& u, int wr, int wc, int fr, int fq) {
        const int row0 = u.pm * 256 + wr * 64 + fr, col0 = u.pn * 256 + wc * 32 + 4 * fq; const float* gate = modv(p, l, u.pm * 256, 2);
#pragma unroll
        for (int ai = 0; ai < 2; ++ai)
#pragma unroll
            for (int m = 0; m < 4; ++m) { float* rowp = dst + (size_t)(row0 + ai * 128 + m * 16) * D + col0;
#pragma unroll
                for (int bj = 0; bj < 2; ++bj)
#pragma unroll
                    for (int n = 0; n < 2; ++n) { float* q = rowp + bj * 128 + n * 16;
                        if (TOX) { const gm::f32x4 g = *(const gm::f32x4*)(gate + col0 + bj * 128 + n * 16); const gm::f32x4 x = *(const gm::f32x4*)q; *(gm::f32x4*)q = x + g * acc[ai][bj][m][n]; }
                        else *(gm::f32x4*)q = acc[ai][bj][m][n]; } } };
    gm::gemm_stream<false, UDense>((GM_LAS unsigned char*)lds, MIXW, sched, epi);
}
__device__ __forceinline__ bool moe_find(const int* cnt, int tg, int& e, int& ti, int& c) {
    int acc = 0;
    for (int x = 0; x < NE; ++x) { const int cx = cnt[x]; const int nt = (cx + 255) >> 8; if (tg < acc + nt) { e = x; ti = tg - acc; c = cx; return true; } acc += nt; }
    return false;
}
__device__ __forceinline__ int moe_tiles(const int* cnt) { int acc = 0; for (int x = 0; x < NE; ++x) acc += (cnt[x] + 255) >> 8; return acc; }
template <bool SRC_TOK> __device__ __forceinline__ void gather_offA(unsigned (&offA)[2][2], const int* lst, int base, int cnt, int K) {
    int tid = threadIdx.x; asm volatile("" : "+v"(tid));
#pragma unroll
    for (int i = 0; i < 2; ++i) { int R, C; gm::stage_rc(tid * 16 + i * 8192, R, C);
#pragma unroll
        for (int h = 0; h < 2; ++h) { const int s = base + h * 128 + R; int a = s < cnt ? lst[s] : 0; if (SRC_TOK) a >>= 2; offA[h][i] = (unsigned)(((size_t)a * K + C) * 2); } }
}
__device__ __forceinline__ void moe1_phase(const P& p, const FW& f, int l, char* lds) {
    constexpr int NPN = 2 * FF / 256; const int NU = moe_tiles(p.cnt) * NPN;
    for (int u = blockIdx.x; u < NU; u += gridDim.x) {
        int e, ti, cnt; if (!moe_find(p.cnt, u / NPN, e, ti, cnt)) break; const int pn = u % NPN; const int* lst = p.list + (size_t)e * M; const size_t le = (size_t)l * NE + e;
        unsigned offA[2][2]; gather_offA<true>(offA, lst, ti * 256, cnt, D);
        auto epi = [&](const gm::f32x4 (&acc)[2][2][4][2], int wr, int wc, int fr, int fq) {
            const int ff0 = pn * 128 + wc * 32 + 8 * fq; const float* bgp = p.bg + le * FF + ff0; const float* bup = p.bu + le * FF + ff0;
            const gm::f32x4 bg0 = *(const gm::f32x4*)bgp, bg1 = *(const gm::f32x4*)(bgp + 4), bu0 = *(const gm::f32x4*)bup, bu1 = *(const gm::f32x4*)(bup + 4);
#pragma unroll
            for (int ai = 0; ai < 2; ++ai)
#pragma unroll
                for (int m = 0; m < 4; ++m) { const int s = ti * 256 + ai * 128 + wr * 64 + m * 16 + fr; if (s < cnt) { const int a = lst[s]; float o[8];
#pragma unroll
                        for (int n = 0; n < 2; ++n)
#pragma unroll
                            for (int j = 0; j < 4; ++j) { float g = acc[ai][0][m][n][j] + (n ? bg1[j] : bg0[j]); float uu = acc[ai][1][m][n][j] + (n ? bu1[j] : bu0[j]);
                                g = g < 7.0f ? g : 7.0f; uu = uu < -7.0f ? -7.0f : (uu > 7.0f ? 7.0f : uu); o[n * 4 + j] = g * (1.0f / (1.0f + __expf(-1.702f * g))) * (uu + 1.0f); }
                        gm::u32x4 w; w.x = gm::cvt_pk_bf16(o[0], o[1]); w.y = gm::cvt_pk_bf16(o[2], o[3]); w.z = gm::cvt_pk_bf16(o[4], o[5]); w.w = gm::cvt_pk_bf16(o[6], o[7]);
                        *(gm::u32x4*)(f.actb + (size_t)a * FF + ff0) = w; } } };
        gm::gemm_unit<true>((GM_LAS unsigned char*)lds, (const char*)f.hb2, offA, (const char*)(f.gu_t + (le * 2 * FF + pn * 256) * D), D, epi);
    }
}
__device__ __forceinline__ void moe2_phase(const P& p, const FW& f, int l, char* lds) {
    constexpr int NPN = D / 256; const int NU = moe_tiles(p.cnt) * NPN;
    for (int u = blockIdx.x; u < NU; u += gridDim.x) {
        int e, ti, cnt; if (!moe_find(p.cnt, u / NPN, e, ti, cnt)) break; const int pn = u % NPN; const int* lst = p.list + (size_t)e * M; const size_t le = (size_t)l * NE + e;
        unsigned offA[2][2]; gather_offA<false>(offA, lst, ti * 256, cnt, FF);
        auto epi = [&](const gm::f32x4 (&acc)[2][2][4][2], int wr, int wc, int fr, int fq) {
#pragma unroll
            for (int bj = 0; bj < 2; ++bj) { const int c0 = pn * 256 + bj * 128 + wc * 32 + 8 * fq; const float* bp = p.bd + le * D + c0; const gm::f32x4 b0 = *(const gm::f32x4*)bp, b1 = *(const gm::f32x4*)(bp + 4);
#pragma unroll
                for (int ai = 0; ai < 2; ++ai)
#pragma unroll
                    for (int m = 0; m < 4; ++m) { const int s = ti * 256 + ai * 128 + wr * 64 + m * 16 + fr; if (s < cnt) { const int a = lst[s];
                            const gm::f32x4 v0 = acc[ai][bj][m][0] + b0, v1 = acc[ai][bj][m][1] + b1;
                            gm::u32x4 w; w.x = gm::cvt_pk_bf16(v0[0], v0[1]); w.y = gm::cvt_pk_bf16(v0[2], v0[3]); w.z = gm::cvt_pk_bf16(v1[0], v1[1]); w.w = gm::cvt_pk_bf16(v1[2], v1[3]);
                            *(gm::u32x4*)(f.yb + (size_t)a * D + c0) = w; } } } };
        gm::gemm_unit<true>((GM_LAS unsigned char*)lds, (const char*)f.actb, offA, (const char*)(f.d_t + (le * D + pn * 256) * FF), FF, epi);
    }
}

namespace rw {
typedef float f32x4 __attribute__((ext_vector_type(4)));
typedef unsigned u32x2 __attribute__((ext_vector_type(2)));
constexpr int ROWS_PB = 65;
__device__ __forceinline__ float wave_sum(float v) {
#pragma unroll
    for (int o = 32; o >= 1; o >>= 1) v += __shfl_xor(v, o);
    return v;
}
__device__ __forceinline__ unsigned pk2(float lo, float hi) { unsigned r; asm volatile("v_cvt_pk_bf16_f32 %0, %1, %2" : "=v"(r) : "v"(lo), "v"(hi)); return r; }
__device__ __forceinline__ float ld1(const bf16_t* q) { return __uint_as_float(((unsigned)*q) << 16); }
__device__ __forceinline__ f32x4 bf4(u32x2 w) { f32x4 r; r[0] = __uint_as_float(w.x << 16); r[1] = __uint_as_float(w.x & 0xffff0000u); r[2] = __uint_as_float(w.y << 16); r[3] = __uint_as_float(w.y & 0xffff0000u); return r; }
__device__ __forceinline__ f32x4 ld4(const bf16_t* q) { return bf4(*(const u32x2*)q); }
__device__ __forceinline__ void norm_store(const f32x4 (&x)[4], const float* g, const float* shift, const float* scale, bf16_t* dst, int lane) {
    float ss = 0.f;
#pragma unroll
    for (int j = 0; j < 4; ++j) ss += x[j][0] * x[j][0] + x[j][1] * x[j][1] + x[j][2] * x[j][2] + x[j][3] * x[j][3];
    ss = wave_sum(ss); const float rs = 1.0f / sqrtf(ss * (1.0f / D) + EPS);
#pragma unroll
    for (int j = 0; j < 4; ++j) { const int c = 4 * lane + 256 * j; const f32x4 gv = *(const f32x4*)(g + c), sh = *(const f32x4*)(shift + c), sc = *(const f32x4*)(scale + c);
        const f32x4 o = x[j] * rs * gv * (1.0f + sc) + sh; u32x2 w; w.x = pk2(o[0], o[1]); w.y = pk2(o[2], o[3]); *(u32x2*)(dst + c) = w; }
}
__device__ __forceinline__ void first_norm_phase(const P& p) {
    int tid = threadIdx.x; asm volatile("" : "+v"(tid)); const int wid = tid >> 6, lane = tid & 63;
    for (int i = wid; i < ROWS_PB; i += 8) { const int r = blockIdx.x * ROWS_PB + i; if (r >= M) break;
        const float* src = r < CTX ? p.ctx + (size_t)r * D : p.x + (size_t)(r - CTX) * D; f32x4 x[4];
#pragma unroll
        for (int j = 0; j < 4; ++j) { x[j] = *(const f32x4*)(src + 4 * lane + 256 * j); *(f32x4*)(p.xres + (size_t)r * D + 4 * lane + 256 * j) = x[j]; }
        norm_store(x, p.norm1_g, modv(p, 0, r, 0), modv(p, 0, r, 1), p.hb1 + (size_t)r * D, lane); }
}
template <bool DRY = false> __device__ __forceinline__ void combine_phase(const P& p, int l) {
    int tid = threadIdx.x; asm volatile("" : "+v"(tid)); const int wid = tid >> 6, lane = tid & 63;
    for (int i = wid; i < ROWS_PB; i += 8) { const int r = blockIdx.x * ROWS_PB + i; if (r >= M) break;
        const f32x4 tw = *(const f32x4*)(p.topw + (size_t)r * 4); const float* gate = modv(p, l, r, 5); f32x4 x[4];
#pragma unroll
        for (int j = 0; j < 4; ++j) { const int c = 4 * lane + 256 * j; f32x4 s = {0.f, 0.f, 0.f, 0.f};
#pragma unroll
            for (int k = 0; k < 4; ++k) s += bf4(*(const u32x2*)(p.ybn + ((size_t)r * 4 + k) * D + c)) * tw[k];
            x[j] = *(const f32x4*)(p.xres + (size_t)r * D + c) + *(const f32x4*)(gate + c) * s; }
        if (l + 1 < DEPTH) {
#pragma unroll
            for (int j = 0; j < 4; ++j) if (!DRY) *(f32x4*)(p.xres + (size_t)r * D + 4 * lane + 256 * j) = x[j];
            norm_store(x, p.norm1_g + (size_t)(l + 1) * D, modv(p, l + 1, r, 0), modv(p, l + 1, r, 1), p.hb1 + (size_t)r * D, lane);
        } else if (r >= CTX) {
#pragma unroll
            for (int j = 0; j < 4; ++j) *(f32x4*)(p.out + (size_t)(r - CTX) * D + 4 * lane + 256 * j) = x[j];
        } }
}
template <bool DRY = false> __device__ __forceinline__ void router_phase(const P& p, int l, char* lds) {
    int tid = threadIdx.x; asm volatile("" : "+v"(tid)); const int wid = tid >> 6, lane = tid & 63;
    float* WT = (float*)lds; float* bias2 = WT + 32 * 1024; int* lcnt = (int*)(bias2 + 64); int* lbase = lcnt + 32; int* rec = lbase + 32;
    const float* rwp = p.router_w + (size_t)l * D * NE;
    for (int i = tid; i < D * NE / 4; i += 512) { const int k = i >> 3, e4 = i & 7; const f32x4 v = *(const f32x4*)(rwp + (size_t)k * NE + e4 * 4);
#pragma unroll
        for (int q = 0; q < 4; ++q) WT[(e4 * 4 + q) * 1024 + (k ^ (e4 << 2))] = v[q]; }
    if (tid < 32) lcnt[tid] = 0;
    __syncthreads();
    {
#pragma unroll
        for (int v = 0; v < 2; ++v) { const float* sh = p.mod + ((size_t)(l * 2 + v) * 6 + 3) * D; f32x4 s[4];
#pragma unroll
            for (int j = 0; j < 4; ++j) s[j] = *(const f32x4*)(sh + 4 * lane + 256 * j);
#pragma unroll
            for (int q = 0; q < 4; ++q) { const int e = wid * 4 + q; float a = 0.f;
#pragma unroll
                for (int j = 0; j < 4; ++j) { const f32x4 w = *(const f32x4*)(WT + e * 1024 + ((4 * lane + 256 * j) ^ (((e >> 2) & 7) << 2))); a += w[0] * s[j][0] + w[1] * s[j][1] + w[2] * s[j][2] + w[3] * s[j][3]; }
                a = wave_sum(a); if (lane == 0) bias2[v * 32 + e] = a + p.router_b[l * NE + e]; } }
    }
    __syncthreads();
    const float* g2 = p.norm2_g + (size_t)l * D;
    for (int rp = wid; rp < (ROWS_PB + 1) / 2; rp += 8) {
        float acc[2][32]; float rsv[2]; int rr[2];
        f32x4 xg[2][4];
#pragma unroll
        for (int q = 0; q < 2; ++q) { const int il = 2 * rp + q; const int r = blockIdx.x * ROWS_PB + (il < ROWS_PB ? il : ROWS_PB - 1); rr[q] = r;
            const float* sc = modv(p, l, r, 4); const float* sh = modv(p, l, r, 3); float ss = 0.f; f32x4 x[4];
#pragma unroll
            for (int j = 0; j < 4; ++j) { x[j] = *(const f32x4*)(p.xres + (size_t)r * D + 4 * lane + 256 * j); ss += x[j][0] * x[j][0] + x[j][1] * x[j][1] + x[j][2] * x[j][2] + x[j][3] * x[j][3]; }
            ss = wave_sum(ss); const float rs = 1.0f / sqrtf(ss * (1.0f / D) + EPS); rsv[q] = rs;
#pragma unroll
            for (int j = 0; j < 4; ++j) { const int c = 4 * lane + 256 * j; xg[q][j] = x[j] * *(const f32x4*)(g2 + c) * (1.0f + *(const f32x4*)(sc + c));
                const f32x4 o = xg[q][j] * rs + *(const f32x4*)(sh + c); u32x2 w; w.x = pk2(o[0], o[1]); w.y = pk2(o[2], o[3]); if (il < ROWS_PB) *(u32x2*)(p.hb2 + (size_t)r * D + c) = w; }
        }
#pragma unroll
        for (int e = 0; e < 32; ++e) { float a0 = 0.f, a1 = 0.f;
#pragma unroll
            for (int j = 0; j < 4; ++j) { const f32x4 w = *(const f32x4*)(WT + e * 1024 + ((4 * lane + 256 * j) ^ (((e >> 2) & 7) << 2)));
                a0 += w[0] * xg[0][j][0] + w[1] * xg[0][j][1] + w[2] * xg[0][j][2] + w[3] * xg[0][j][3]; a1 += w[0] * xg[1][j][0] + w[1] * xg[1][j][1] + w[2] * xg[1][j][2] + w[3] * xg[1][j][3]; }
            acc[0][e] = a0; acc[1][e] = a1; }
        float v[64];
#pragma unroll
        for (int e = 0; e < 32; ++e) { v[e] = acc[0][e]; v[32 + e] = acc[1][e]; }
#pragma unroll
        for (int m = 32, n = 64; m >= 1; m >>= 1, n >>= 1) {
#pragma unroll
            for (int i = 0; i < n / 2; ++i) { const bool up = (lane & m) != 0; const float keep = up ? v[i + n / 2] : v[i], send = up ? v[i] : v[i + n / 2]; v[i] = keep + __shfl_xor(send, m); } }
        const int q = lane >> 5, e = lane & 31; const int r = rr[q]; const int il = 2 * rp + q;
        float logit = v[0] * rsv[q] + bias2[(r < CTX ? 32 : 0) + e];
        float cur = logit; int sel[4]; float sv[4];
#pragma unroll
        for (int k = 0; k < 4; ++k) { float mx = cur;
#pragma unroll
            for (int o = 16; o >= 1; o >>= 1) mx = fmaxf(mx, __shfl_xor(mx, o));
            const unsigned long long bal = __ballot(cur == mx); const unsigned half = (unsigned)(bal >> (q * 32)); const int win = __ffs(half) - 1;
            sel[k] = win; sv[k] = mx; if (e == win) cur = -3.0e38f; }
        if (e < 4 && il < ROWS_PB) {
            float es[4], sum = 0.f;
#pragma unroll
            for (int k = 0; k < 4; ++k) { es[k] = __expf(sv[k] - sv[0]); sum += es[k]; }
            const int myk = e; const int mye = myk == 0 ? sel[0] : myk == 1 ? sel[1] : myk == 2 ? sel[2] : sel[3]; const float myw = (myk == 0 ? es[0] : myk == 1 ? es[1] : myk == 2 ? es[2] : es[3]) / sum;
            if (!DRY) p.topw[(size_t)r * 4 + myk] = myw; const int pos = atomicAdd(&lcnt[mye], 1); rec[il * 4 + myk] = mye | (pos << 8);
        }
    }
    __syncthreads();
    if (tid < 32) lbase[tid] = DRY ? 0 : atomicAdd(&p.cnt[tid], lcnt[tid]);
    __syncthreads();
    if (tid < ROWS_PB * 4) { const int il = tid >> 2, k = tid & 3; const int r = blockIdx.x * ROWS_PB + il; const int rc = rec[tid]; const int e = rc & 255, pos = rc >> 8;
        if (!DRY) p.list[(size_t)e * M + lbase[e] + pos] = r * 4 + k; }
    __syncthreads();
}
}

namespace ml {
typedef short bf16x8 __attribute__((ext_vector_type(8)));
typedef float f32x4 __attribute__((ext_vector_type(4)));
typedef unsigned u32x2 __attribute__((ext_vector_type(2)));
constexpr int RB = 65, MT = 5;
constexpr int AQ_STRIDE = QL * 2 + 16, AKV_STRIDE = KVL * 2 + 16;
constexpr int OFF_AQ = 0, OFF_AKV = OFF_AQ + 80 * AQ_STRIDE, OFF_KRS = OFF_AKV + 80 * AKV_STRIDE, OFF_KSS = OFF_KRS + 80 * 32 * 4, LDS_MLA = OFF_KSS + 80 * 4;
struct MW { const bf16_t* w_uq_t; const bf16_t* w_ukv_t; const float* ropec; const float* ropes; const bf16_t* proj; int ldp; bf16_t* qb; bf16_t* kb; bf16_t* vb; };
__device__ __forceinline__ void mla_phase(const P& p, const MW& w, int l, char* lds) {
    int tid = threadIdx.x; asm volatile("" : "+v"(tid)); const int wid = __builtin_amdgcn_readfirstlane(tid >> 6), lane = tid & 63, fr = lane & 15, fq = lane >> 4;
    const int row0 = blockIdx.x * RB;
    for (int i = wid; i < 80; i += 8) {
        char* aq = lds + OFF_AQ + i * AQ_STRIDE; char* akv = lds + OFF_AKV + i * AKV_STRIDE; float* krs = (float*)(lds + OFF_KRS) + i * 32;
        if (i < RB && row0 + i < M) { const bf16_t* pr = w.proj + (size_t)(row0 + i) * w.ldp;
            { const f32x4 x = rw::ld4(pr + C_Q + 4 * lane); float ss = rw::wave_sum(x[0] * x[0] + x[1] * x[1] + x[2] * x[2] + x[3] * x[3]); const float rs = 1.0f / sqrtf(ss * (1.0f / QL) + EPS);
              const f32x4 g = *(const f32x4*)(p.q_g + l * QL + 4 * lane); const f32x4 o = x * rs * g; u32x2 v; v.x = rw::pk2(o[0], o[1]); v.y = rw::pk2(o[2], o[3]); *(u32x2*)(aq + 8 * lane) = v; }
            { f32x4 x = {0.f, 0.f, 0.f, 0.f}; if (lane < 32) x = rw::ld4(pr + C_KV + 4 * lane); float ss = rw::wave_sum(x[0] * x[0] + x[1] * x[1] + x[2] * x[2] + x[3] * x[3]); const float rs = 1.0f / sqrtf(ss * (1.0f / KVL) + EPS);
              if (lane < 32) { const f32x4 g = *(const f32x4*)(p.kv_g + l * KVL + 4 * lane); const f32x4 o = x * rs * g; u32x2 v; v.x = rw::pk2(o[0], o[1]); v.y = rw::pk2(o[2], o[3]); *(u32x2*)(akv + 8 * lane) = v; } }
            { f32x4 x = {0.f, 0.f, 0.f, 0.f}; if (lane < 8) { x = rw::ld4(pr + C_KR + 4 * lane); *(f32x4*)(krs + 4 * lane) = x; }
              const float ss = rw::wave_sum(x[0] * x[0] + x[1] * x[1] + x[2] * x[2] + x[3] * x[3]); if (lane == 0) ((float*)(lds + OFF_KSS))[i] = ss; }
        } else {
            u32x2 z; z.x = 0u; z.y = 0u; *(u32x2*)(aq + 8 * lane) = z; if (lane < 32) *(u32x2*)(akv + 8 * lane) = z; if (lane < 32) krs[lane] = 0.f; if (lane == 0) ((float*)(lds + OFF_KSS))[i] = 0.f;
        }
    }
    __syncthreads();
    if (wid < 6) {
        const int hh = wid; f32x4 acc[MT][6];
#pragma unroll
        for (int mt = 0; mt < MT; ++mt)
#pragma unroll
            for (int nt = 0; nt < 6; ++nt) acc[mt][nt] = (f32x4){0.f, 0.f, 0.f, 0.f};
        const bf16_t* wb = w.w_uq_t + (size_t)(hh * QKD + fr) * QL + 8 * fq;
#pragma unroll 1
        for (int ks = 0; ks < QL / 32; ++ks) { bf16x8 b[6], a[MT];
#pragma unroll
            for (int nt = 0; nt < 6; ++nt) b[nt] = *(const bf16x8*)(wb + (size_t)nt * 16 * QL + ks * 32);
#pragma unroll
            for (int mt = 0; mt < MT; ++mt) a[mt] = *(const bf16x8*)(lds + OFF_AQ + (mt * 16 + fr) * AQ_STRIDE + (ks * 32 + 8 * fq) * 2);
#pragma unroll
            for (int mt = 0; mt < MT; ++mt)
#pragma unroll
                for (int nt = 0; nt < 6; ++nt) acc[mt][nt] = __builtin_amdgcn_mfma_f32_16x16x32_bf16(b[nt], a[mt], acc[mt][nt], 0, 0, 0); }
        f32x4 gq[6];
#pragma unroll
        for (int nt = 0; nt < 6; ++nt) gq[nt] = *(const f32x4*)(p.qn_g + l * QKD + nt * 16 + 4 * fq);
#pragma unroll
        for (int mt = 0; mt < MT; ++mt) { const int il = mt * 16 + fr; const int r = row0 + il; const bool ok = il < RB && r < M; float ss = 0.f;
#pragma unroll
            for (int nt = 0; nt < 6; ++nt) ss += acc[mt][nt][0] * acc[mt][nt][0] + acc[mt][nt][1] * acc[mt][nt][1] + acc[mt][nt][2] * acc[mt][nt][2] + acc[mt][nt][3] * acc[mt][nt][3];
            ss += __shfl_xor(ss, 16); ss += __shfl_xor(ss, 32); const float rs = 1.0f / sqrtf(ss * (1.0f / QKD) + EPS);
            const bool lat = r >= CTX; const int t = lat ? r - CTX : 0;
#pragma unroll
            for (int nt = 0; nt < 6; ++nt) { f32x4 v = acc[mt][nt] * (rs * at::QSCALE) * gq[nt];
                if (nt >= 4) { f32x4 other; other[0] = __shfl_xor(v[0], 32); other[1] = __shfl_xor(v[1], 32); other[2] = __shfl_xor(v[2], 32); other[3] = __shfl_xor(v[3], 32);
                    if (lat && ok) { const int pos = (nt == 4) ? (t / GRID_W) : (t % GRID_W); const f32x4 cs = *(const f32x4*)(w.ropec + (size_t)pos * 8 + 4 * (fq & 1)), sn = *(const f32x4*)(w.ropes + (size_t)pos * 8 + 4 * (fq & 1));
                        v = (fq >> 1) ? (v * cs + other * sn) : (v * cs - other * sn); } }
                if (ok) { u32x2 o; o.x = rw::pk2(v[0], v[1]); o.y = rw::pk2(v[2], v[3]); *(u32x2*)(w.qb + ((size_t)r * NH + hh) * QKD + nt * 16 + 4 * fq) = o; } } }
    } else {
        for (int hs = 0; hs < 3; ++hs) { const int hh = (wid - 6) * 3 + hs;
#pragma unroll
          for (int pass = 0; pass < 2; ++pass) { f32x4 acc[MT][4];
#pragma unroll
            for (int mt = 0; mt < MT; ++mt)
#pragma unroll
                for (int nt = 0; nt < 4; ++nt) acc[mt][nt] = (f32x4){0.f, 0.f, 0.f, 0.f};
            const bf16_t* wb = w.w_ukv_t + (size_t)(hh * 128 + pass * 64 + fr) * KVL + 8 * fq;
#pragma unroll 1
            for (int ks = 0; ks < KVL / 32; ++ks) { bf16x8 b[4], a[MT];
#pragma unroll
                for (int nt = 0; nt < 4; ++nt) b[nt] = *(const bf16x8*)(wb + (size_t)nt * 16 * KVL + ks * 32);
#pragma unroll
                for (int mt = 0; mt < MT; ++mt) a[mt] = *(const bf16x8*)(lds + OFF_AKV + (mt * 16 + fr) * AKV_STRIDE + (ks * 32 + 8 * fq) * 2);
#pragma unroll
                for (int mt = 0; mt < MT; ++mt)
#pragma unroll
                    for (int nt = 0; nt < 4; ++nt) acc[mt][nt] = __builtin_amdgcn_mfma_f32_16x16x32_bf16(b[nt], a[mt], acc[mt][nt], 0, 0, 0); }
            if (pass == 0) {
                f32x4 gk[4], gr[2], gro[2];
#pragma unroll
                for (int nt = 0; nt < 4; ++nt) gk[nt] = *(const f32x4*)(p.kn_g + l * QKD + nt * 16 + 4 * fq);
#pragma unroll
                for (int a = 0; a < 2; ++a) { gr[a] = *(const f32x4*)(p.kn_g + l * QKD + NOPE + a * 16 + 4 * fq); gro[a] = *(const f32x4*)(p.kn_g + l * QKD + NOPE + a * 16 + ((4 * fq) ^ 8)); }
#pragma unroll
                for (int mt = 0; mt < MT; ++mt) { const int il = mt * 16 + fr; const int r = row0 + il; const bool ok = il < RB && r < M; float ss = 0.f;
#pragma unroll
                    for (int nt = 0; nt < 4; ++nt) ss += acc[mt][nt][0] * acc[mt][nt][0] + acc[mt][nt][1] * acc[mt][nt][1] + acc[mt][nt][2] * acc[mt][nt][2] + acc[mt][nt][3] * acc[mt][nt][3];
                    ss += __shfl_xor(ss, 16); ss += __shfl_xor(ss, 32); ss += ((const float*)(lds + OFF_KSS))[il]; const float rs = 1.0f / sqrtf(ss * (1.0f / QKD) + EPS);
                    const bool lat = r >= CTX; const int t = lat ? r - CTX : 0;
                    if (ok) {
                        bf16_t* kd = w.kb + ((size_t)r * NH + hh) * QKD; const float* krs = (const float*)(lds + OFF_KRS) + il * 32;
#pragma unroll
                        for (int nt = 0; nt < 4; ++nt) { const f32x4 v = acc[mt][nt] * rs * gk[nt]; u32x2 o; o.x = rw::pk2(v[0], v[1]); o.y = rw::pk2(v[2], v[3]); *(u32x2*)(kd + nt * 16 + 4 * fq) = o; }
#pragma unroll
                        for (int a = 0; a < 2; ++a) { f32x4 v = *(const f32x4*)(krs + a * 16 + 4 * fq) * rs * gr[a]; const f32x4 other = *(const f32x4*)(krs + a * 16 + ((4 * fq) ^ 8)) * rs * gro[a];
                            if (lat) { const int pos = (a == 0) ? (t / GRID_W) : (t % GRID_W); const f32x4 cs = *(const f32x4*)(w.ropec + (size_t)pos * 8 + 4 * (fq & 1)), sn = *(const f32x4*)(w.ropes + (size_t)pos * 8 + 4 * (fq & 1));
                                v = (fq >> 1) ? (v * cs + other * sn) : (v * cs - other * sn); }
                            u32x2 o; o.x = rw::pk2(v[0], v[1]); o.y = rw::pk2(v[2], v[3]); *(u32x2*)(kd + NOPE + a * 16 + 4 * fq) = o; }
                    } }
            } else {
#pragma unroll
                for (int mt = 0; mt < MT; ++mt) { const int il = mt * 16 + fr; const int r = row0 + il; const bool ok = il < RB && r < M;
                    if (ok) { bf16_t* vd = w.vb + ((size_t)r * NH + hh) * VD;
#pragma unroll
                        for (int nt = 0; nt < 4; ++nt) { const f32x4 v = acc[mt][nt]; u32x2 o; o.x = rw::pk2(v[0], v[1]); o.y = rw::pk2(v[2], v[3]); *(u32x2*)(vd + nt * 16 + 4 * fq) = o; } } }
            }
          }
        }
    }
    __syncthreads();
}
}

namespace sd {
typedef short bf16x8 __attribute__((ext_vector_type(8)));
typedef float f32x4 __attribute__((ext_vector_type(4)));
typedef unsigned u32x2 __attribute__((ext_vector_type(2)));
typedef unsigned u32x4 __attribute__((ext_vector_type(4)));
constexpr int SBS = 144, STS = 272;
constexpr int OFF_BM = 0, OFF_CM = OFF_BM + 128 * SBS, OFF_XT = OFF_CM + 128 * SBS, OFF_BTF = OFF_XT + 64 * STS, OFF_BTB = OFF_BTF + 64 * STS, OFF_L = OFF_BTB + 64 * STS, OFF_SC = OFF_L + 128 * STS, LDS_SSD = OFF_SC + 4 * 128 * 4;
struct SsdW { const bf16_t* proj; int ldp; float* yd; float* st; float* cdec; float* cs; bf16_t* cg; bf16_t* prevb; };
__device__ __forceinline__ bf16x8 ldfrag(const char* base, int row, int stride, int kbyte) { return *(const bf16x8*)(base + row * stride + kbyte); }
__device__ __forceinline__ float silu_f(float x) { return x / (1.0f + __expf(-x)); }
__device__ __forceinline__ void chunk_unit(const P& p, const SsdW& w, int l, int c, int hh, char* lds) {
    int tid = threadIdx.x; asm volatile("" : "+v"(tid)); const int wid = __builtin_amdgcn_readfirstlane(tid >> 6), lane = tid & 63, fr = lane & 15, fq = lane >> 4;
    const int R0 = c * CHUNK, g = hh / (SH / SG); const int seg0 = R0 < CTX ? 0 : CTX, seg1 = R0 < CTX ? CTX : M;
    float* csf = (float*)(lds + OFF_SC); float* csb = csf + 128; float* dtf = csb + 128; float* dtb = dtf + 128;
    if (tid < 256) { const int r = tid & 127, d = tid >> 7; const float v = softplusf(rw::ld1(w.proj + (size_t)(R0 + r) * w.ldp + C_DT + d * 6 + hh) + p.dt_bias[l * 12 + d * 6 + hh]); (d ? dtb : dtf)[r] = v; }
    __syncthreads();
    if (wid < 2) {
        const int d = wid; const float a = -__expf(p.a_log[l * 12 + d * 6 + hh]); const float* dts = d ? dtb : dtf; float* cso = d ? csb : csf;
        const int i0 = 2 * lane, i1 = 2 * lane + 1; const int r0 = d ? 127 - i0 : i0, r1 = d ? 127 - i1 : i1;
        const float v0 = dts[r0] * a, v1 = dts[r1] * a; float s = v0 + v1;
#pragma unroll
        for (int o = 1; o < 64; o <<= 1) { const float t = __shfl_up(s, o); if (lane >= o) s += t; }
        const float excl = s - (v0 + v1); const float c0 = excl + v0, c1 = c0 + v1; cso[r0] = c0; cso[r1] = c1;
        w.cs[((size_t)d * M + R0 + r0) * SH + hh] = c0; w.cs[((size_t)d * M + R0 + r1) * SH + hh] = c1;
        if (lane == 63) w.cdec[((size_t)d * NCH + c) * SH + hh] = __expf(c1);
    }
    __syncthreads();
    {   const int col = tid & 63, l0 = (tid >> 6) * 16; const float cfe = csf[127], cbe = csb[0];
#pragma unroll
        for (int which = 0; which < 3; ++which) { const int cidx = which == 0 ? hh * SP + col : (which == 1 ? SW + g * SN + col : SW + SG * SN + g * SN + col);
            const float w0 = p.conv_w[((size_t)l * 4 + 0) * CONVD + cidx], w1 = p.conv_w[((size_t)l * 4 + 1) * CONVD + cidx], w2 = p.conv_w[((size_t)l * 4 + 2) * CONVD + cidx], w3 = p.conv_w[((size_t)l * 4 + 3) * CONVD + cidx], bb = p.conv_b[l * CONVD + cidx];
            float v[19];
#pragma unroll
            for (int i = 0; i < 19; ++i) { const int r = R0 + l0 - 2 + i; v[i] = (r >= seg0 && r < seg1) ? rw::ld1(w.proj + (size_t)r * w.ldp + C_XBC + cidx) : 0.f; }
            float y[16];
#pragma unroll
            for (int i = 0; i < 16; ++i) y[i] = silu_f(bb + w0 * v[i] + w1 * v[i + 1] + w2 * v[i + 2] + w3 * v[i + 3]);
            if (which == 0) {
                u32x4 a, b; a.x = rw::pk2(y[0], y[1]); a.y = rw::pk2(y[2], y[3]); a.z = rw::pk2(y[4], y[5]); a.w = rw::pk2(y[6], y[7]); b.x = rw::pk2(y[8], y[9]); b.y = rw::pk2(y[10], y[11]); b.z = rw::pk2(y[12], y[13]); b.w = rw::pk2(y[14], y[15]);
                *(u32x4*)(lds + OFF_XT + col * STS + l0 * 2) = a; *(u32x4*)(lds + OFF_XT + col * STS + l0 * 2 + 16) = b;
            } else if (which == 1) {
                float yf[16], yb[16];
#pragma unroll
                for (int i = 0; i < 16; ++i) { *(bf16_t*)(lds + OFF_BM + (l0 + i) * SBS + col * 2) = f2bf(y[i]); yf[i] = y[i] * __expf(cfe - csf[l0 + i]) * dtf[l0 + i]; yb[i] = y[i] * __expf(cbe - csb[l0 + i]) * dtb[l0 + i]; }
                u32x4 a, b; a.x = rw::pk2(yf[0], yf[1]); a.y = rw::pk2(yf[2], yf[3]); a.z = rw::pk2(yf[4], yf[5]); a.w = rw::pk2(yf[6], yf[7]); b.x = rw::pk2(yf[8], yf[9]); b.y = rw::pk2(yf[10], yf[11]); b.z = rw::pk2(yf[12], yf[13]); b.w = rw::pk2(yf[14], yf[15]);
                *(u32x4*)(lds + OFF_BTF + col * STS + l0 * 2) = a; *(u32x4*)(lds + OFF_BTF + col * STS + l0 * 2 + 16) = b;
                a.x = rw::pk2(yb[0], yb[1]); a.y = rw::pk2(yb[2], yb[3]); a.z = rw::pk2(yb[4], yb[5]); a.w = rw::pk2(yb[6], yb[7]); b.x = rw::pk2(yb[8], yb[9]); b.y = rw::pk2(yb[10], yb[11]); b.z = rw::pk2(yb[12], yb[13]); b.w = rw::pk2(yb[14], yb[15]);
                *(u32x4*)(lds + OFF_BTB + col * STS + l0 * 2) = a; *(u32x4*)(lds + OFF_BTB + col * STS + l0 * 2 + 16) = b;
            } else {
#pragma unroll
                for (int i = 0; i < 16; ++i) { const bf16_t cv = f2bf(y[i]); *(bf16_t*)(lds + OFF_CM + (l0 + i) * SBS + col * 2) = cv; if (hh % (SH / SG) == 0) w.cg[((size_t)(R0 + l0 + i) * SG + g) * SN + col] = cv; }
            } }
    }
    __syncthreads();
    {   const int lt = wid, lrow = 16 * lt + fr; const bf16x8 c0 = ldfrag(lds + OFF_CM, lrow, SBS, 16 * fq), c1 = ldfrag(lds + OFF_CM, lrow, SBS, 64 + 16 * fq);
        const float cfl = csf[lrow], cbl = csb[lrow], Dh = p.ssd_d[l * SH + hh];
#pragma unroll
        for (int st = 0; st < 8; ++st) { const bf16x8 b0 = ldfrag(lds + OFF_BM, 16 * st + fr, SBS, 16 * fq), b1 = ldfrag(lds + OFF_BM, 16 * st + fr, SBS, 64 + 16 * fq);
            f32x4 acc = {0.f, 0.f, 0.f, 0.f}; acc = __builtin_amdgcn_mfma_f32_16x16x32_bf16(b0, c0, acc, 0, 0, 0); acc = __builtin_amdgcn_mfma_f32_16x16x32_bf16(b1, c1, acc, 0, 0, 0);
            const int s0 = 16 * st + 4 * fq; const f32x4 cfs = *(const f32x4*)(csf + s0), cbs = *(const f32x4*)(csb + s0), dfs = *(const f32x4*)(dtf + s0), dbs = *(const f32x4*)(dtb + s0); float o[4];
#pragma unroll
            for (int j = 0; j < 4; ++j) { const int s = s0 + j; const float ef = s <= lrow ? __expf(fminf(cfl - cfs[j], 0.f)) * dfs[j] : 0.f; const float eb = s >= lrow ? __expf(fminf(cbl - cbs[j], 0.f)) * dbs[j] : 0.f;
                o[j] = acc[j] * (ef + eb) + (s == lrow ? Dh : 0.f); }
            u32x2 pk; pk.x = rw::pk2(o[0], o[1]); pk.y = rw::pk2(o[2], o[3]); *(u32x2*)(lds + OFF_L + lrow * STS + s0 * 2) = pk; }
    }
    __syncthreads();
    {   const int lt = wid, lrow = 16 * lt + fr; bf16x8 lf[4];
#pragma unroll
        for (int ks = 0; ks < 4; ++ks) lf[ks] = ldfrag(lds + OFF_L, lrow, STS, 64 * ks + 16 * fq);
#pragma unroll
        for (int pt = 0; pt < 4; ++pt) { f32x4 acc = {0.f, 0.f, 0.f, 0.f};
#pragma unroll
            for (int ks = 0; ks < 4; ++ks) acc = __builtin_amdgcn_mfma_f32_16x16x32_bf16(ldfrag(lds + OFF_XT, 16 * pt + fr, STS, 64 * ks + 16 * fq), lf[ks], acc, 0, 0, 0);
            *(f32x4*)(w.yd + (size_t)(R0 + lrow) * SW + hh * SP + 16 * pt + 4 * fq) = acc; }
    }
    {   const int d = wid >> 2, ptile = wid & 3, prow = 16 * ptile + fr; bf16x8 xf[4]; const char* bt = lds + (d ? OFF_BTB : OFF_BTF);
#pragma unroll
        for (int ks = 0; ks < 4; ++ks) xf[ks] = ldfrag(lds + OFF_XT, prow, STS, 64 * ks + 16 * fq);
#pragma unroll
        for (int nt = 0; nt < 4; ++nt) { f32x4 acc = {0.f, 0.f, 0.f, 0.f};
#pragma unroll
            for (int ks = 0; ks < 4; ++ks) acc = __builtin_amdgcn_mfma_f32_16x16x32_bf16(ldfrag(bt, 16 * nt + fr, STS, 64 * ks + 16 * fq), xf[ks], acc, 0, 0, 0);
            *(f32x4*)(w.st + ((((size_t)d * NCH + c) * SH + hh) * SP + prow) * SN + 16 * nt + 4 * fq) = acc; }
    }
    __syncthreads();
}
__device__ __forceinline__ void carry_phase(const SsdW& w) {
    int tid = threadIdx.x; asm volatile("" : "+v"(tid));
    constexpr int PER = 2 * SH * SP * SN / 256;
    if (tid < PER) { const int eidx = blockIdx.x * PER + tid; if (eidx < 2 * SH * SP * SN) { const int dir = eidx / (SH * SP * SN), rem = eidx % (SH * SP * SN), hh = rem / (SP * SN), e = rem % (SP * SN); float state = 0.f;
        for (int b = 0; b < NCH / 13; ++b) { float sv[13], dv[13]; size_t ov[13];
#pragma unroll
            for (int j = 0; j < 13; ++j) { const int i = b * 13 + j; const int c = dir == 0 ? i : (i < CTX / CHUNK ? CTX / CHUNK - 1 - i : NCH - 1 - (i - CTX / CHUNK));
                ov[j] = (((size_t)dir * NCH + c) * SH + hh) * (SP * SN) + e; sv[j] = w.st[ov[j]]; dv[j] = w.cdec[((size_t)dir * NCH + c) * SH + hh]; }
#pragma unroll
            for (int j = 0; j < 13; ++j) { w.prevb[ov[j]] = f2bf(state); state = state * dv[j] + sv[j]; } } } }
}
__device__ __forceinline__ void final_phase(const P& p, const SsdW& w, int l, bf16_t* dst, int ldd) {
    int tid = threadIdx.x; asm volatile("" : "+v"(tid)); const int wid = __builtin_amdgcn_readfirstlane(tid >> 6), lane = tid & 63, fr = lane & 15, fq = lane >> 4;
    const int ltg = wid * gridDim.x + blockIdx.x; if (ltg >= M / 16) return;
    const int r = ltg * 16 + fr, c = (ltg * 16) / CHUNK;
    bf16x8 cf[2][2];
#pragma unroll
    for (int g = 0; g < 2; ++g)
#pragma unroll
        for (int ks = 0; ks < 2; ++ks) cf[g][ks] = *(const bf16x8*)(w.cg + ((size_t)r * SG + g) * SN + 32 * ks + 8 * fq);
    u32x2 gv[SH][4]; float ss = 0.f;
#pragma unroll
    for (int hh = 0; hh < SH; ++hh) { const int g = hh / (SH / SG); const float ef = __expf(w.cs[(size_t)r * SH + hh]), eb = __expf(w.cs[((size_t)M + r) * SH + hh]);
#pragma unroll
        for (int pt = 0; pt < 4; ++pt) { f32x4 af = {0.f, 0.f, 0.f, 0.f}, ab = {0.f, 0.f, 0.f, 0.f};
            const bf16_t* pf = w.prevb + ((((size_t)0 * NCH + c) * SH + hh) * SP + 16 * pt + fr) * SN + 8 * fq; const bf16_t* pb = w.prevb + ((((size_t)1 * NCH + c) * SH + hh) * SP + 16 * pt + fr) * SN + 8 * fq;
#pragma unroll
            for (int ks = 0; ks < 2; ++ks) { af = __builtin_amdgcn_mfma_f32_16x16x32_bf16(*(const bf16x8*)(pf + 32 * ks), cf[g][ks], af, 0, 0, 0); ab = __builtin_amdgcn_mfma_f32_16x16x32_bf16(*(const bf16x8*)(pb + 32 * ks), cf[g][ks], ab, 0, 0, 0); }
            const int col = hh * SP + 16 * pt + 4 * fq; const f32x4 yd = *(const f32x4*)(w.yd + (size_t)r * SW + col), z = rw::ld4(w.proj + (size_t)r * w.ldp + C_Z + col);
            f32x4 y = yd + af * ef + ab * eb;
#pragma unroll
            for (int j = 0; j < 4; ++j) { y[j] *= silu_f(z[j]); ss += y[j] * y[j]; }
            u32x2 pk; pk.x = rw::pk2(y[0], y[1]); pk.y = rw::pk2(y[2], y[3]); gv[hh][pt] = pk; } }
    ss += __shfl_xor(ss, 16); ss += __shfl_xor(ss, 32); const float rs = 1.0f / sqrtf(ss * (1.0f / SW) + EPS);
#pragma unroll
    for (int hh = 0; hh < SH; ++hh)
#pragma unroll
        for (int pt = 0; pt < 4; ++pt) { const int col = hh * SP + 16 * pt + 4 * fq; const f32x4 o = rw::bf4(gv[hh][pt]) * rs * *(const f32x4*)(p.ssd_norm_g + l * SW + col);
            u32x2 pk; pk.x = rw::pk2(o[0], o[1]); pk.y = rw::pk2(o[2], o[3]); *(u32x2*)(dst + (size_t)r * ldd + col) = pk; }
}
}

namespace mc {
typedef float f32x4 __attribute__((ext_vector_type(4)));
__device__ __forceinline__ void modvec_phase(const P& p, char* lds) {
    int tid = threadIdx.x; asm volatile("" : "+v"(tid));
    float* sc = (float*)lds; float* part = sc + 2 * D;
    for (int i = tid; i < 2 * D; i += 512) { const float v = i < D ? p.c[i] : p.c_ctx[i - D]; sc[i] = v / (1.0f + __expf(-v)); }
    __syncthreads();
    constexpr int NCK = 6 * D / 128, NU = DEPTH * NCK;
    for (int u = blockIdx.x; u < NU; u += gridDim.x) { const int l = u / NCK, j = (u % NCK) * 128 + (tid & 127), kg = tid >> 7; const float* wp = p.mod_w + (size_t)l * D * 6 * D + j; float a0 = 0.f, a1 = 0.f;
#pragma unroll 8
        for (int k = kg; k < D; k += 4) { const float wv = wp[(size_t)k * 6 * D]; a0 += sc[k] * wv; a1 += sc[D + k] * wv; }
        part[(kg * 2 + 0) * 128 + (tid & 127)] = a0; part[(kg * 2 + 1) * 128 + (tid & 127)] = a1;
        __syncthreads();
        if (tid < 256) { const int which = tid >> 7, cc = tid & 127; const float s = part[(0 * 2 + which) * 128 + cc] + part[(1 * 2 + which) * 128 + cc] + part[(2 * 2 + which) * 128 + cc] + part[(3 * 2 + which) * 128 + cc];
            const int jj = (u % NCK) * 128 + cc; p.mod[((size_t)(l * 2 + which) * 6) * D + jj] = s + p.mod_b[(size_t)l * 6 * D + jj]; }
        __syncthreads(); }
}
__device__ __forceinline__ void pool_phase(const P& p, const bf16_t* proj, int ldp, int l, bf16_t* dst, int ldd, char* lds) {
    int tid = threadIdx.x; asm volatile("" : "+v"(tid));
    constexpr int RB = 65; float* pm = (float*)lds;
    const int row0 = blockIdx.x * RB;
    {
        const int c = tid & 255, gi = c >> 6, hw = 1 << gi, rh = tid >> 8;
        const int i0 = rh * 33, nr = rh ? 32 : 33;
        float v[33 + 16];
#pragma unroll
        for (int k = 0; k < 33 + 16; ++k) { const int r = row0 + i0 - 8 + k; v[k] = (r >= 0 && r < M && k < nr + 16) ? rw::ld1(proj + (size_t)r * ldp + C_POOL + c) : 0.f; }
#pragma unroll
        for (int i = 0; i < 33; ++i) { const int r = row0 + i0 + i; if (i < nr && r < M) { const int seg0 = r < CTX ? 0 : CTX, seg1 = r < CTX ? CTX : M; float s = 0.f; int cnt = 0;
#pragma unroll
                for (int o = -8; o < 8; ++o) { const int rr = r + o; const bool in = o >= -hw && o < hw && rr >= seg0 && rr < seg1; s += in ? v[i + 8 + o] : 0.f; cnt += in ? 1 : 0; }
                pm[(i0 + i) * 256 + c] = s / (float)cnt - v[i + 8]; } }
    }
    __syncthreads();
    {   const int d = tid & 63, gi = (tid >> 6) & 3, rh = tid >> 8; float wcol[64]; const float* wp = p.pool_w + (((size_t)l * 4 + gi) * 64) * 64 + d;
#pragma unroll
        for (int c = 0; c < 64; ++c) wcol[c] = wp[(size_t)c * 64];
        const float scl = p.pool_scale[l * PW + gi * 64 + d];
        for (int i = rh; i < RB; i += 2) { const int r = row0 + i; if (r >= M) break; const f32x4* pr = (const f32x4*)(pm + i * 256 + gi * 64); float acc = 0.f;
#pragma unroll
            for (int c4 = 0; c4 < 16; ++c4) { const f32x4 v = pr[c4]; acc += v[0] * wcol[4 * c4] + v[1] * wcol[4 * c4 + 1] + v[2] * wcol[4 * c4 + 2] + v[3] * wcol[4 * c4 + 3]; }
            dst[(size_t)r * ldd + gi * 64 + d] = f2bf(acc * scl); } }
    __syncthreads();
}
}

#ifndef CHECK_MLA
#define CHECK_MLA 0
#endif
#ifndef CHECK_SSD
#define CHECK_SSD 0
#endif
#ifndef REP_ATT
#define REP_ATT 1
#endif
#ifndef REP_MOE
#define REP_MOE 1
#endif
#ifndef REP_PROJ
#define REP_PROJ 1
#endif
#ifndef REP_PRE
#define REP_PRE 1
#endif
#ifndef REP_PREP
#define REP_PREP 1
#endif
#ifndef REP_ROW
#define REP_ROW 1
#endif
#ifndef REP_MLA
#define REP_MLA 1
#endif
#ifndef REP_POOL
#define REP_POOL 1
#endif
#ifndef REP_S1
#define REP_S1 1
#endif
#ifndef REP_FIN
#define REP_FIN 1
#endif
#ifndef REP_WITH_BAR
#define REP_WITH_BAR 0
#endif
#define REPEAT(N, ...) for (int rep_ = 0; rep_ < (N); ++rep_) { __VA_ARGS__ if (REP_WITH_BAR && rep_ + 1 < (N)) BAR1(); }
__device__ __forceinline__ int gtid() { int t = threadIdx.x; asm volatile("" : "+v"(t)); return blockIdx.x * 512 + t; }
template <int OP> __device__ __forceinline__ void run_op(const P& p, int l) {
    const long n = op_count(OP); const long stride = (long)gridDim.x * blockDim.x;
    for (long i = gtid(); i < n; i += stride) op_run(OP, p, l, i);
}
struct KArgs { P p; FW f; unsigned* bar; };
__device__ __forceinline__ const KArgs& kargs() { auto q = __builtin_amdgcn_kernarg_segment_ptr(); asm volatile("" : "+s"(q)); return *(const KArgs*)q; }
constexpr int LDS_BYTES = gm::STAGE_BYTES + 4096;
#ifndef REP_BAR
#define REP_BAR 1
#endif
#if REP_BAR == 2
#define BAR() do { BAR1(); BAR1(); } while (0)
#else
#define BAR() BAR1()
#endif
#define BAR1() do { XcdBarrier b2_; b2_.bar = kargs().bar; unsigned xx_ = xbx; asm volatile("" : "+s"(xx_)); b2_.x = xx_; b2_.st = (volatile LAS unsigned*)(lds + LDS_BYTES - 16); xcd_barrier(b2_); } while (0)
#define PH(OPX) do { run_op<OPX>(kargs().p, lo()); BAR(); } while (0)
#define RUN(OPX) run_op<OPX>(kargs().p, lo())

__device__ __forceinline__ void attn_split_phase(const P& p, const FW& f, int l, char* lds) {
    const bool fast = at::attn_fast_ok(p.qn_g + l * QKD, p.kn_g + l * QKD);
    constexpr int NQL = SEQ / 256, NUL = NH * NQL * 2, NU = NUL + NH, HALF_KEYS = M / 2;
    for (int u = blockIdx.x; u < NU; u += gridDim.x) {
        int hh, qt, half, seq;
        if (u < NUL) { hh = u / (NQL * 2); const int rem = u % (NQL * 2); qt = 1 + (rem >> 1); half = rem & 1; seq = HALF_KEYS; } else { hh = u - NUL; qt = 0; half = 0; seq = CTX; }
        const size_t koff = (size_t)half * HALF_KEYS;
        __syncthreads();
        const bf16_t* Qp = p.qb + (size_t)qt * 256 * at::LDQ + hh * at::DQ; const bf16_t* Kp = p.kb + koff * at::LDK + hh * at::DQ; const bf16_t* Vp = p.vb + koff * at::LDV + hh * at::DV;
        bf16_t* Op = f.opart + (size_t)half * M * (NH * VD) + (size_t)qt * 256 * (NH * VD) + hh * at::DV; float* MLp = f.aml + (((size_t)half * M + (size_t)qt * 256) * NH + hh) * 2;
        if (fast) at::attn_body<bf16_t, true>(Qp, Kp, Vp, Op, NH * VD, seq, lds, MLp, NH * 2); else at::attn_body<bf16_t, false>(Qp, Kp, Vp, Op, NH * VD, seq, lds, MLp, NH * 2);
    }
    __syncthreads();
}
template <class TA> __device__ __forceinline__ float ldf(const TA* a, size_t i);
template <> __device__ __forceinline__ float ldf<float>(const float* a, size_t i) { return a[i]; }
template <> __device__ __forceinline__ float ldf<bf16_t>(const bf16_t* a, size_t i) { return bf2f(a[i]); }
template <class TA, class TB> __device__ __forceinline__ void chk_accum(const TA* a, int lda, const TB* b, int ldb, long nrows, int ncols, float* diag) {
    float sd = 0.f, sr = 0.f; const long n = nrows * ncols; const long stride = (long)gridDim.x * blockDim.x;
    for (long i = gtid(); i < n; i += stride) { const long r = i / ncols; const int c = (int)(i % ncols);
        const float x = ldf<TA>(a, r * lda + c), y = ldf<TB>(b, r * ldb + c); sd += (x - y) * (x - y); sr += y * y; }
    for (int o = 32; o >= 1; o >>= 1) { sd += __shfl_xor(sd, o); sr += __shfl_xor(sr, o); }
    if ((threadIdx.x & 63) == 0) { atomicAdd(diag, sd); atomicAdd(diag + 1, sr); }
}
#define MLA_CALL(QB, KB, VB) { const int ll_ = lo(); ml::MW mw_; mw_.qb = (QB); mw_.kb = (KB); mw_.vb = (VB); mw_.w_uq_t = KF.w_uq_t + (size_t)ll_ * NH * QKD * QL; mw_.w_ukv_t = KF.w_ukv_t + (size_t)ll_ * NH * 128 * KVL; \
        mw_.ropec = KF.ropec; mw_.ropes = KF.ropes; mw_.proj = KF.projb; mw_.ldp = INC_PAD; ml::mla_phase(KP, mw_, ll_, lds); }
#if CHECK_MLA
#define MLA_STEP PH(OP_LATNORM); RUN(OP_QRAW); PH(OP_KVRAW); RUN(OP_QHEAD); RUN(OP_KHEAD); if (l == 0) { MLA_CALL(KF.qb2, KF.kb2, KF.vb2) } BAR(); \
        if (l == 0) { chk_accum<bf16_t, bf16_t>(KF.qb2, NH * QKD, KP.qb, NH * QKD, M, NH * QKD, KP.diag + 0); chk_accum<bf16_t, bf16_t>(KF.kb2, NH * QKD, KP.kb, NH * QKD, M, NH * QKD, KP.diag + 2); chk_accum<bf16_t, bf16_t>(KF.vb2, NH * VD, KP.vb, NH * VD, M, NH * VD, KP.diag + 4); }
#else
#define MLA_STEP REPEAT(REP_PREP * REP_MLA, MLA_CALL(KP.qb, KP.kb, KP.vb))
#endif
#define SSD_W(NAME) sd::SsdW NAME; NAME.proj = KF.projb; NAME.ldp = INC_PAD; NAME.yd = KF.yd2; NAME.st = KF.st2; NAME.cdec = KF.cdec2; NAME.cs = KF.cs2; NAME.cg = KF.cg; NAME.prevb = KF.prevb;
#define SSD_S1() { SSD_W(sw_) const int ll_ = lo(); for (int u = blockIdx.x; u < NCH * SH; u += gridDim.x) sd::chunk_unit(KP, sw_, ll_, u / SH, u % SH, lds); }
#define SSD_S2() { SSD_W(sw_) sd::carry_phase(sw_); }
#define SSD_S3(DST, LDD) { SSD_W(sw_) sd::final_phase(KP, sw_, lo(), (DST), (LDD)); }
#if CHECK_SSD
#define SSD_STEPS RUN(OP_CONV); RUN(OP_DT); PH(OP_POOLP); RUN(OP_SSD_CS); RUN(OP_SSD_G); PH(OP_POOLMM); attn_phase<float>(KP, KP.mixin, MIXW, lds); RUN(OP_SSD_YD); PH(OP_SSD_ST); PH(OP_SSD_CARRY); PH(OP_SSD_YOFF); PH(OP_SSDFIN); \
        if (l == 0) { SSD_S1() BAR(); SSD_S2() BAR(); SSD_S3(KF.ssdb2, SW) BAR(); chk_accum<bf16_t, float>(KF.ssdb2, SW, KP.mixin + NH * VD, MIXW, M, SW, KP.diag + 0); } PH(OP_MIXB);
#else
#define SSD_STEPS REPEAT(REP_PREP * REP_POOL, mc::pool_phase(KP, KF.projb, INC_PAD, lo(), KP.mixb + NH * VD + SW, MIXW, lds);) REPEAT(REP_PREP * REP_S1, SSD_S1()) BAR(); REPEAT(REP_ATT, attn_split_phase(KP, KF, lo(), lds);) REPEAT(REP_FIN, SSD_S2()) BAR(); REPEAT(REP_FIN, SSD_S3(KP.mixb + NH * VD, MIXW) at::attn_combine(KF.opart, KF.aml, KP.mixb, MIXW, M, CTX);) BAR();
#endif
#define LAYER_BODY(L) { const int l = (L); \
        auto lo = [&]() { int ll = l; asm volatile("" : "+s"(ll)); return ll; }; \
        if (blockIdx.x == 0 && threadIdx.x < NE) KP.cnt[threadIdx.x] = 0; \
        REPEAT(REP_PROJ, inproj_phase(KP, KF, lo(), KF.projb, lds);) BAR(); \
        MLA_STEP \
        SSD_STEPS \
        REPEAT(REP_PROJ - 1, outproj_phase<false>(KP, KF, lo(), KP.mixin, lds);) outproj_phase<true>(KP, KF, lo(), KP.xres, lds); BAR(); \
        REPEAT(REP_ROW - 1, rw::router_phase<true>(KP, lo(), lds);) rw::router_phase<false>(KP, lo(), lds); BAR(); \
        REPEAT(REP_MOE, moe1_phase(KP, KF, lo(), lds);) BAR(); REPEAT(REP_MOE, moe2_phase(KP, KF, lo(), lds);) BAR(); \
        REPEAT(REP_ROW - 1, rw::combine_phase<true>(KP, lo());) rw::combine_phase<false>(KP, lo()); BAR(); \
    }
__global__ void __launch_bounds__(512, 2) k_mega(KArgs a) {
    extern __shared__ __attribute__((aligned(16))) char lds[];
    uint4* xbw = (uint4*)(lds + LDS_BYTES - 16);
    if (threadIdx.x == 0) *xbw = make_uint4(0u, 0u, 0u, 0u);
    __syncthreads();
    const unsigned xbx = xcd_barrier_post(kargs().bar, (volatile LAS unsigned*)xbw).x;
#define KP kargs().p
#define KF kargs().f
    { const int l = 0; auto lo = [&]() { return l; }; if (blockIdx.x == 0 && threadIdx.x < 16) KP.diag[threadIdx.x] = 0.f; REPEAT(REP_PRE, mc::modvec_phase(KP, lds); cvt_phase(KP, KF, 0, DEPTH, lds);) BAR(); rw::first_norm_phase(KP); BAR(); }
    LAYER_BODY(0) LAYER_BODY(1) LAYER_BODY(2) LAYER_BODY(3)
#if CHECK_MLA || CHECK_SSD
    {
        float e = 0.f;
        for (int c = 0; c < 3; ++c) { const float dn = KP.diag[2 * c + 1]; if (dn == 0.f && KP.diag[2 * c] == 0.f) continue; const float ec = sqrtf(KP.diag[2 * c] / dn); e = ec > e ? ec : e; if (!(ec == ec)) e = 1e3f; }
        const float sc = 1.0f + 10.0f * e; const long n = (long)SEQ * D; const long stride = (long)gridDim.x * blockDim.x;
        for (long i = gtid(); i < n; i += stride) KP.out[i] *= sc;
    }
#endif
#undef KP
#undef KF
}
static size_t carve(char*& cur, size_t bytes) { size_t a = (bytes + 255) & ~(size_t)255; cur += a; return a; }
static bool setup_params(P& p, FW& f, unsigned*& bar, void* const* d_in, void* d_out, void* d_ws, size_t ws_size) {
    const float** pp = (const float**)&p; for (int i = 0; i < 32; ++i) pp[i] = (const float*)d_in[i];
    p.out = (float*)d_out;
    char* cur = (char*)d_ws; char* base = cur;
    bar = (unsigned*)cur; carve(cur, XCD_BAR_WORDS * sizeof(unsigned));
#define CARVE(field, type, count) p.field = (type*)cur; carve(cur, (size_t)(count) * sizeof(type));
#define CARVEF(field, type, count) f.field = (type*)cur; carve(cur, (size_t)(count) * sizeof(type));
    CARVE(xres, float, (size_t)M * D) CARVE(mod, float, (size_t)DEPTH * 12 * D) CARVEF(projb, bf16_t, (size_t)M * INC_PAD)
#if CHECK_MLA
    CARVE(qln, float, (size_t)M * QL) CARVE(kvln, float, (size_t)M * KVL) CARVE(qraw, float, (size_t)M * NH * QKD) CARVE(kvraw, float, (size_t)M * NH * 128) CARVE(q, float, (size_t)M * NH * QKD) CARVE(k, float, (size_t)M * NH * QKD) CARVE(v, float, (size_t)M * NH * VD)
    CARVEF(qb2, bf16_t, (size_t)M * NH * QKD) CARVEF(kb2, bf16_t, (size_t)M * NH * QKD) CARVEF(vb2, bf16_t, (size_t)M * NH * VD)
#endif
    CARVE(mixin, float, (size_t)M * MIXW) CARVE(xbc, float, (size_t)M * CONVD) CARVE(dt, float, (size_t)M * 12) CARVE(ydir, float, (size_t)2 * M * SW)
    CARVE(poolp, float, (size_t)M * PW) CARVE(topw, float, (size_t)M * 4)
    CARVE(topi, int, (size_t)M * 4) CARVE(cnt, int, NE) CARVE(list, int, (size_t)NE * M)
    CARVE(qb, bf16_t, (size_t)M * NH * QKD) CARVE(kb, bf16_t, (size_t)M * NH * QKD) CARVE(vb, bf16_t, (size_t)M * NH * VD) CARVE(diag, float, 64)
    CARVE(cs, float, (size_t)2 * M * SH) CARVE(cdec, float, (size_t)2 * NCH * SH) CARVE(gmat, float, (size_t)M * SG * CHUNK) CARVE(st, float, (size_t)2 * NCH * SH * SP * SN)
    CARVE(hb1, bf16_t, (size_t)M * D) CARVE(hb2, bf16_t, (size_t)M * D) CARVE(mixb, bf16_t, (size_t)M * MIXW)
    CARVEF(actb, bf16_t, (size_t)4 * M * FF) CARVEF(yb, bf16_t, (size_t)4 * M * D)
    f.hb1 = p.hb1; f.hb2 = p.hb2; f.mixb = p.mixb; p.ybn = f.yb; p.attf = nullptr;
    const int nl = DEPTH;
    CARVEF(w_uq_t, bf16_t, (size_t)nl * NH * QKD * QL) CARVEF(w_ukv_t, bf16_t, (size_t)nl * NH * 128 * KVL) CARVEF(ropec, float, 256 * 8) CARVEF(ropes, float, 256 * 8)
    CARVEF(opart, bf16_t, (size_t)2 * M * NH * VD) CARVEF(aml, float, (size_t)2 * M * NH * 2)
    CARVEF(yd2, float, (size_t)M * SW) CARVEF(st2, float, (size_t)2 * NCH * SH * SP * SN) CARVEF(cdec2, float, (size_t)2 * NCH * SH) CARVEF(cs2, float, (size_t)2 * M * SH)
    CARVEF(cg, bf16_t, (size_t)M * SG * SN) CARVEF(prevb, bf16_t, (size_t)2 * NCH * SH * SP * SN) CARVEF(ssdb2, bf16_t, (size_t)M * SW)
    CARVEF(w_in_t, bf16_t, (size_t)nl * INC_PAD * D) CARVEF(w_out_t, bf16_t, (size_t)nl * D * MIXW) CARVEF(gu_t, bf16_t, (size_t)nl * NE * 2 * FF * D) CARVEF(d_t, bf16_t, (size_t)nl * NE * D * FF)
    p.act = nullptr; p.down = nullptr; f.proj2 = nullptr; f.mix2 = nullptr;
#undef CARVE
#undef CARVEF
    if (getenv("KDEBUG")) fprintf(stderr, "ws used %zu of %zu\n", (size_t)(cur - base), ws_size);
    return (size_t)(cur - base) <= ws_size;
}
extern "C" void kernel_launch(void* const* d_in, const int* in_sizes, int n_in, void* d_out, int out_size, void* d_ws, size_t ws_size, hipStream_t stream) {
    KArgs a{};
    if (n_in < 32 || !setup_params(a.p, a.f, a.bar, d_in, d_out, d_ws, ws_size)) return;
    static int grid = 0;
    if (!grid) { int dev = 0, cus = 0, per_cu = 0; (void)hipGetDevice(&dev); (void)hipDeviceGetAttribute(&cus, hipDeviceAttributeMultiprocessorCount, dev);
        (void)hipFuncSetAttribute((const void*)k_mega, hipFuncAttributeMaxDynamicSharedMemorySize, LDS_BYTES);
        (void)hipOccupancyMaxActiveBlocksPerMultiprocessor(&per_cu, k_mega, 512, LDS_BYTES); grid = cus * (per_cu < 1 ? per_cu : 1); }
    if (grid <= 0) return;
    (void)hipMemsetAsync(a.bar, 0, XCD_BAR_WORDS * sizeof(unsigned), stream);
    hipLaunchKernelGGL(k_mega, dim3(grid), dim3(512), LDS_BYTES, stream, a);
}
```

```cpp
#include <hip/hip_runtime.h>
#include <stdint.h>
#include <stdlib.h>
#include <stdio.h>

#ifndef NAIVE_H
#define NAIVE_H
#include <math.h>
#ifdef HOST_TEST
#define HD inline
#define HDC inline
#define ATOMIC_INC(p) ((*(p))++)
#define UNIFORM(x) (x)
#else
#define HD __device__ __forceinline__
#define HDC __host__ __device__ __forceinline__
#define ATOMIC_INC(p) atomicAdd((p), 1)
#define UNIFORM(x) __builtin_amdgcn_readfirstlane(x)
#endif

#ifndef CFG_D
#define CFG_D 1024
#define CFG_SEQ 16384
#define CFG_CTX 256
#define CFG_FF 1024
#define CFG_DEPTH 4
#endif
constexpr int D = CFG_D, SEQ = CFG_SEQ, CTX = CFG_CTX, FF = CFG_FF, DEPTH = CFG_DEPTH;
constexpr int M = CTX + SEQ;
constexpr int GRID_W = 64;
constexpr int NH = 6, QKD = 96, NOPE = 64, ROPE = 32, VD = 64, QL = 256, KVL = 128;
constexpr int SH = 6, SP = 64, SW = 384, SG = 2, SN = 64, CONVD = 640, CHUNK = 128;
constexpr int PW = 256, MIXW = 1024, INC = 1708;
constexpr int C_Q = 0, C_KV = 256, C_KR = 384, C_Z = 416, C_XBC = 800, C_DT = 1440, C_POOL = 1452;
constexpr int NE = 32, TOPK = 4;
constexpr int NCH = M / CHUNK;
constexpr float EPS = 1e-6f;

typedef unsigned short bf16_t;
HD bf16_t f2bf(float f) { union { float f; unsigned u; } v; v.f = f; unsigned u = v.u; u += 0x7FFFu + ((u >> 16) & 1u); return (bf16_t)(u >> 16); }
HD float bf2f(bf16_t b) { union { float f; unsigned u; } v; v.u = ((unsigned)b) << 16; return v.f; }
struct P {
    const float *x, *c, *ctx, *c_ctx, *norm1_g, *norm2_g, *mod_w, *mod_b, *w_in, *q_g, *kv_g, *w_uq, *w_ukv, *qn_g, *kn_g;
    const float *conv_w, *conv_b, *a_log, *dt_bias, *ssd_d, *ssd_norm_g, *pool_w, *pool_scale, *w_out, *router_w, *router_b;
    const float *wg, *bg, *wu, *bu, *wd, *bd;
    float* out;
    float *xres, *mod, *rs, *h, *proj, *qln, *kvln, *qraw, *kvraw, *q, *k, *v, *mixin, *xbc, *dt, *ydir, *poolp, *mix, *logits, *topw, *act, *down;
    int *topi, *cnt, *list;
    bf16_t *qb, *kb, *vb;
    float *attf, *diag;
    float *cs, *cdec, *gmat, *st;
    bf16_t *hb1, *hb2, *mixb, *ybn;
};

HD float siluf(float x) { return x / (1.0f + expf(-x)); }
HD float sigmf(float x) { return 1.0f / (1.0f + expf(-x)); }
HD float softplusf(float x) { return x > 20.0f ? x : log1pf(expf(x)); }
HD const float* modv(const P& p, int l, int r, int j) { return p.mod + ((size_t)(l * 2 + (r < CTX ? 1 : 0)) * 6 + j) * D; }

enum { OP_COPY_IN = 0, OP_MODVEC, OP_ROWSTAT, OP_NORM1, OP_INPROJ, OP_LATNORM, OP_QRAW, OP_KVRAW, OP_QHEAD, OP_KHEAD, OP_ATTN, OP_CONV, OP_DT, OP_SSDSCAN, OP_SSDFIN,
       OP_POOLP, OP_POOLMM, OP_OUTPROJ, OP_RES1, OP_NORM2, OP_LOGITS, OP_ZEROCNT, OP_TOPK, OP_GATEUP, OP_DOWN, OP_COMBINE, OP_WRITE_OUT, OP_MIXB, OP_COMBINE2, OP_SSD_CS, OP_SSD_G, OP_SSD_YD, OP_SSD_ST, OP_SSD_CARRY, OP_SSD_YOFF, OP_COUNT };

HDC long op_count(int op) {
    switch (op) {
        case OP_COPY_IN: return (long)M * D;
        case OP_MODVEC: return (long)DEPTH * 2 * 6 * D;
        case OP_ROWSTAT: return M;
        case OP_NORM1: case OP_NORM2: return (long)M * D;
        case OP_INPROJ: return (long)(M / 8) * INC;
        case OP_LATNORM: return 2L * M;
        case OP_QRAW: return (long)(M / 8) * (NH * QKD);
        case OP_KVRAW: return (long)(M / 8) * (NH * 128);
        case OP_QHEAD: case OP_KHEAD: return (long)M * NH;
        case OP_ATTN: return (long)M * NH;
        case OP_CONV: return (long)M * CONVD;
        case OP_DT: return (long)M * 12;
        case OP_SSDSCAN: return 2L * SH * SP;
        case OP_SSDFIN: return M;
        case OP_POOLP: return (long)M * PW;
        case OP_POOLMM: return (long)M * PW;
        case OP_OUTPROJ: return (long)(M / 8) * D;
        case OP_RES1: return (long)M * D;
        case OP_LOGITS: return (long)M * NE;
        case OP_ZEROCNT: return NE;
        case OP_TOPK: return M;
        case OP_GATEUP: return (long)NE * (M / 8) * FF;
        case OP_DOWN: return (long)NE * (M / 8) * D;
        case OP_COMBINE: return (long)M * D;
        case OP_WRITE_OUT: return (long)SEQ * D;
        case OP_MIXB: return (long)M * MIXW;
        case OP_COMBINE2: return (long)M * D;
        case OP_SSD_CS: return 2L * NCH * SH;
        case OP_SSD_G: return (long)M * SG * CHUNK;
        case OP_SSD_YD: return (long)M * SW;
        case OP_SSD_ST: return 2L * NCH * SH * SP * SN;
        case OP_SSD_CARRY: return 2L * SH * SP * SN;
        case OP_SSD_YOFF: return (long)M * SW;
    }
    return 0;
}

HD void gemm8(const float* A, int lda, const float* B, int ldb, const float* bias, float* C, int ldc, int N, int K, long idx) {
    const int j = (int)(idx % N); const long r0 = (idx / N) * 8;
    float acc[8];
#pragma unroll
    for (int i = 0; i < 8; ++i) acc[i] = 0.f;
    const float* a = A + r0 * lda;
    for (int k = 0; k < K; ++k) {
        const float b = B[(size_t)k * ldb + j];
#pragma unroll
        for (int i = 0; i < 8; ++i) acc[i] += a[(size_t)i * lda + k] * b;
    }
    const float bv = bias ? bias[j] : 0.f;
#pragma unroll
    for (int i = 0; i < 8; ++i) C[(r0 + i) * ldc + j] = acc[i] + bv;
}

HD void sincos_rr(float angf, float& cs, float& sn) {
    const double x = (double)angf; const double n = rint(x * 0.63661977236758134308); const double y = (x - n * 1.57079632679489655800) - n * 6.123233995736766e-17; const double y2 = y * y;
    const double s = y * (1.0 + y2 * (-1.0 / 6 + y2 * (1.0 / 120 + y2 * (-1.0 / 5040 + y2 * (1.0 / 362880 + y2 * (-1.0 / 39916800))))));
    const double c = 1.0 + y2 * (-0.5 + y2 * (1.0 / 24 + y2 * (-1.0 / 720 + y2 * (1.0 / 40320 + y2 * (-1.0 / 3628800 + y2 * (1.0 / 479001600))))));
    const int q = ((int)n) & 3; const double cc = (q == 0) ? c : (q == 1) ? -s : (q == 2) ? -c : s; const double ss = (q == 0) ? s : (q == 1) ? c : (q == 2) ? -s : -c;
    cs = (float)cc; sn = (float)ss;
}
HD float rope_inv_freq(int f) { return f == 0 ? 1.0f : f == 1 ? 0.31622776f : f == 2 ? 0.1f : f == 3 ? 0.031622775f : f == 4 ? 0.01f : f == 5 ? 0.0031622776f : f == 6 ? 0.001f : 0.00031622776f; }
HD void rope_apply(float* v32, int t) {
    const float row = (float)(t / GRID_W), col = (float)(t % GRID_W);
#pragma unroll
    for (int a = 0; a < 2; ++a)
#pragma unroll
        for (int f = 0; f < 8; ++f) {
            const float ang = (a == 0 ? row : col) * rope_inv_freq(f);
            float cs, sn; sincos_rr(ang, cs, sn);
            const float x1 = v32[a * 16 + f], x2 = v32[a * 16 + 8 + f];
            v32[a * 16 + f] = x1 * cs - x2 * sn; v32[a * 16 + 8 + f] = x2 * cs + x1 * sn;
        }
}

HD void op_run(int op, const P& p, int l, long idx) {
    switch (op) {
    case OP_COPY_IN: { const long r = idx / D; const int c = (int)(idx % D); p.xres[idx] = r < CTX ? p.ctx[idx] : p.x[(r - CTX) * D + c]; } break;
    case OP_MODVEC: {
        const int j = (int)(idx % (6 * D)); const int which = (int)((idx / (6 * D)) % 2); const int ll = (int)(idx / (12 * D));
        const float* cv = which ? p.c_ctx : p.c; float s = 0.f;
        for (int k = 0; k < D; ++k) s += siluf(cv[k]) * p.mod_w[((size_t)ll * D + k) * (6 * D) + j];
        p.mod[idx] = s + p.mod_b[(size_t)ll * 6 * D + j];
    } break;
    case OP_ROWSTAT: { const float* xr = p.xres + idx * D; float s = 0.f; for (int k = 0; k < D; ++k) s += xr[k] * xr[k]; p.rs[idx] = 1.0f / sqrtf(s / D + EPS); } break;
    case OP_NORM1: case OP_NORM2: { const int r = (int)(idx / D), c = (int)(idx % D); const int o = op == OP_NORM1 ? 0 : 3;
        const float g = (op == OP_NORM1 ? p.norm1_g : p.norm2_g)[l * D + c];
        const float hv = p.xres[idx] * p.rs[r] * g * (1.0f + modv(p, l, r, o + 1)[c]) + modv(p, l, r, o)[c]; p.h[idx] = hv;
        bf16_t* hb = op == OP_NORM1 ? p.hb1 : p.hb2; if (hb) hb[idx] = f2bf(hv); } break;
    case OP_INPROJ: gemm8(p.h, D, p.w_in + (size_t)l * D * INC, INC, nullptr, p.proj, INC, INC, D, idx); break;
    case OP_LATNORM: {
        const int which = idx >= M; const long r = which ? idx - M : idx; const int n = which ? KVL : QL; const float* src = p.proj + r * INC + (which ? C_KV : C_Q);
        float s = 0.f; for (int k = 0; k < n; ++k) s += src[k] * src[k]; const float rs = 1.0f / sqrtf(s / n + EPS);
        float* dst = which ? p.kvln + r * KVL : p.qln + r * QL; const float* g = which ? p.kv_g + l * KVL : p.q_g + l * QL;
        for (int k = 0; k < n; ++k) dst[k] = src[k] * rs * g[k];
    } break;
    case OP_QRAW: gemm8(p.qln, QL, p.w_uq + (size_t)l * QL * (NH * QKD), NH * QKD, nullptr, p.qraw, NH * QKD, NH * QKD, QL, idx); break;
    case OP_KVRAW: gemm8(p.kvln, KVL, p.w_ukv + (size_t)l * KVL * (NH * 128), NH * 128, nullptr, p.kvraw, NH * 128, NH * 128, KVL, idx); break;
    case OP_QHEAD: { const int r = (int)(idx / NH), hh = (int)(idx % NH); const float* src = p.qraw + (size_t)r * (NH * QKD) + hh * QKD; float s = 0.f;
        for (int d = 0; d < QKD; ++d) s += src[d] * src[d]; const float rs = 1.0f / sqrtf(s / QKD + EPS);
        float* dst = p.q + ((size_t)r * NH + hh) * QKD; float rp[32];
        for (int d = 0; d < NOPE; ++d) dst[d] = src[d] * rs * p.qn_g[l * QKD + d];
#pragma unroll
        for (int d = 0; d < 32; ++d) rp[d] = src[NOPE + d] * rs * p.qn_g[l * QKD + NOPE + d];
        if (r >= CTX) rope_apply(rp, r - CTX);
#pragma unroll
        for (int d = 0; d < 32; ++d) dst[NOPE + d] = rp[d];
        bf16_t* db = p.qb + ((size_t)r * NH + hh) * QKD;
        for (int d = 0; d < QKD; ++d) db[d] = f2bf(dst[d]);
    } break;
    case OP_KHEAD: { const int r = (int)(idx / NH), hh = (int)(idx % NH); const float* kn = p.kvraw + (size_t)r * (NH * 128) + hh * 128; const float* kr = p.proj + (size_t)r * INC + C_KR; float s = 0.f;
        for (int d = 0; d < NOPE; ++d) s += kn[d] * kn[d];
        for (int d = 0; d < ROPE; ++d) s += kr[d] * kr[d];
        const float rs = 1.0f / sqrtf(s / QKD + EPS);
        float* dst = p.k + ((size_t)r * NH + hh) * QKD; float rp[32];
        for (int d = 0; d < NOPE; ++d) dst[d] = kn[d] * rs * p.kn_g[l * QKD + d];
#pragma unroll
        for (int d = 0; d < 32; ++d) rp[d] = kr[d] * rs * p.kn_g[l * QKD + NOPE + d];
        if (r >= CTX) rope_apply(rp, r - CTX);
#pragma unroll
        for (int d = 0; d < 32; ++d) dst[NOPE + d] = rp[d];
        float* vd = p.v + ((size_t)r * NH + hh) * VD;
        for (int d = 0; d < VD; ++d) vd[d] = kn[NOPE + d];
        bf16_t* db = p.kb + ((size_t)r * NH + hh) * QKD; bf16_t* vdb = p.vb + ((size_t)r * NH + hh) * VD;
        for (int d = 0; d < QKD; ++d) db[d] = f2bf(dst[d]);
        for (int d = 0; d < VD; ++d) vdb[d] = f2bf(kn[NOPE + d]);
    } break;
    case OP_ATTN: {
        const int r = (int)(idx % M), hh = UNIFORM((int)(idx / M)); const int nk = r < CTX ? CTX : M;
        float qv[QKD];
        const float* qp = p.q + ((size_t)r * NH + hh) * QKD; const float scale = 1.0f / sqrtf((float)QKD);
#pragma unroll
        for (int d = 0; d < QKD; ++d) qv[d] = qp[d] * scale;
        for (int half = 0; half < 2; ++half) {
            float o[32];
#pragma unroll
            for (int d = 0; d < 32; ++d) o[d] = 0.f;
            float mx = -1e30f, lsum = 0.f;
            for (int kk = 0; kk < nk; ++kk) {
                const float* kp = p.k + ((size_t)kk * NH + hh) * QKD; const float* vp = p.v + ((size_t)kk * NH + hh) * VD + half * 32; float s = 0.f;
#pragma unroll
                for (int d = 0; d < QKD; ++d) s += qv[d] * kp[d];
                const float mn = s > mx ? s : mx; const float corr = expf(mx - mn), pe = expf(s - mn);
                lsum = lsum * corr + pe; mx = mn;
#pragma unroll
                for (int d = 0; d < 32; ++d) o[d] = o[d] * corr + pe * vp[d];
            }
            const float inv = 1.0f / lsum; float* dst = p.mixin + (size_t)r * MIXW + hh * VD + half * 32;
#pragma unroll
            for (int d = 0; d < 32; ++d) dst[d] = o[d] * inv;
        }
    } break;
    case OP_CONV: { const int r = (int)(idx / CONVD), c = (int)(idx % CONVD); const int seg0 = r < CTX ? 0 : CTX, n = r < CTX ? CTX : SEQ, t = r - seg0; float y = p.conv_b[l * CONVD + c];
#pragma unroll
        for (int j = 0; j < 4; ++j) { const int tt = t - 2 + j; if (tt >= 0 && tt < n) y += p.conv_w[((size_t)l * 4 + j) * CONVD + c] * p.proj[(size_t)(seg0 + tt) * INC + C_XBC + c]; }
        p.xbc[idx] = siluf(y); } break;
    case OP_DT: { const int r = (int)(idx / 12), j = (int)(idx % 12); p.dt[idx] = softplusf(p.proj[(size_t)r * INC + C_DT + j] + p.dt_bias[l * 12 + j]); } break;
    case OP_SSDSCAN: {
        const int pp = (int)(idx % SP), hh = UNIFORM((int)((idx / SP) % SH)), dir = UNIFORM((int)(idx / (SP * SH))); const int g = hh / (SH / SG);
        const float a = -expf(p.a_log[l * 12 + dir * 6 + hh]); float st[SN];
#pragma unroll
        for (int n = 0; n < SN; ++n) st[n] = 0.f;
        for (int step = 0; step < M; ++step) {
            const int r = dir == 0 ? step : (step < CTX ? CTX - 1 - step : M - 1 - (step - CTX));
            const float dtv = p.dt[(size_t)r * 12 + dir * 6 + hh]; const float dA = expf(dtv * a); const float xv = p.xbc[(size_t)r * CONVD + hh * SP + pp] * dtv;
            const float* Bp = p.xbc + (size_t)r * CONVD + SW + g * SN; const float* Cp = p.xbc + (size_t)r * CONVD + SW + SG * SN + g * SN; float y = 0.f;
#pragma unroll
            for (int n = 0; n < SN; ++n) { st[n] = st[n] * dA + xv * Bp[n]; y += st[n] * Cp[n]; }
            p.ydir[((size_t)dir * M + r) * SW + hh * SP + pp] = y;
        }
    } break;
    case OP_SSDFIN: { const long r = idx; float ss = 0.f;
        for (int c = 0; c < SW; ++c) { const float y = p.ydir[r * SW + c] + p.ydir[((size_t)M + r) * SW + c] + p.ssd_d[l * SH + c / SP] * p.xbc[r * CONVD + c]; const float gv = y * siluf(p.proj[r * INC + C_Z + c]); ss += gv * gv; }
        const float rs = 1.0f / sqrtf(ss / SW + EPS);
        for (int c = 0; c < SW; ++c) { const float y = p.ydir[r * SW + c] + p.ydir[((size_t)M + r) * SW + c] + p.ssd_d[l * SH + c / SP] * p.xbc[r * CONVD + c]; const float gv = y * siluf(p.proj[r * INC + C_Z + c]);
            p.mixin[r * MIXW + NH * VD + c] = gv * rs * p.ssd_norm_g[l * SW + c]; }
    } break;
    case OP_POOLP: { const int r = (int)(idx / PW), c = (int)(idx % PW); const int gi = c / 64; const int win = 2 << gi; const int seg0 = r < CTX ? 0 : CTX, n = r < CTX ? CTX : SEQ, t = r - seg0;
        int lo = t - win / 2, hi = t - win / 2 + win; lo = lo < 0 ? 0 : lo; hi = hi > n ? n : hi; float s = 0.f;
        for (int tt = lo; tt < hi; ++tt) s += p.proj[(size_t)(seg0 + tt) * INC + C_POOL + c];
        p.poolp[idx] = s / (float)(hi - lo) - p.proj[(size_t)r * INC + C_POOL + c]; } break;
    case OP_POOLMM: { const int r = (int)(idx / PW), c = (int)(idx % PW); const int gi = c / 64, d = c % 64; float s = 0.f;
        for (int cc = 0; cc < 64; ++cc) s += p.poolp[(size_t)r * PW + gi * 64 + cc] * p.pool_w[(((size_t)l * 4 + gi) * 64 + cc) * 64 + d];
        p.mixin[(size_t)r * MIXW + NH * VD + SW + c] = s * p.pool_scale[l * PW + c]; } break;
    case OP_OUTPROJ: gemm8(p.mixin, MIXW, p.w_out + (size_t)l * MIXW * D, D, nullptr, p.mix, D, D, MIXW, idx); break;
    case OP_RES1: { const int r = (int)(idx / D), c = (int)(idx % D); p.xres[idx] += modv(p, l, r, 2)[c] * p.mix[idx]; } break;
    case OP_LOGITS: { const int r = (int)(idx / NE), e = (int)(idx % NE); const float* hr = p.h + (size_t)r * D; float s = 0.f;
        for (int k = 0; k < D; ++k) s += hr[k] * p.router_w[((size_t)l * D + k) * NE + e];
        p.logits[idx] = s + p.router_b[l * NE + e]; } break;
    case OP_ZEROCNT: p.cnt[idx] = 0; break;
    case OP_TOPK: { const long t = idx; float lg[NE];
#pragma unroll
        for (int e = 0; e < NE; ++e) lg[e] = p.logits[t * NE + e];
        int sel[4]; float sv[4];
#pragma unroll
        for (int kk = 0; kk < 4; ++kk) { float best = -3.0e38f; int bi = 0;
#pragma unroll
            for (int e = 0; e < NE; ++e) { bool taken = false;
#pragma unroll
                for (int q = 0; q < kk; ++q) taken = taken || (sel[q] == e);
                if (!taken && lg[e] > best) { best = lg[e]; bi = e; } }
            sel[kk] = bi; sv[kk] = best; }
        float es[4], sum = 0.f;
#pragma unroll
        for (int kk = 0; kk < 4; ++kk) { es[kk] = expf(sv[kk] - sv[0]); sum += es[kk]; }
#pragma unroll
        for (int kk = 0; kk < 4; ++kk) { p.topi[t * 4 + kk] = sel[kk]; p.topw[t * 4 + kk] = es[kk] / sum; const int pos = ATOMIC_INC(&p.cnt[sel[kk]]); p.list[(size_t)sel[kk] * M + pos] = (int)(t * 4 + kk); }
    } break;
    case OP_GATEUP: {
        const int j = (int)(idx % FF); const long rest = idx / FF; const int rb = (int)(rest % (M / 8)), e = (int)(rest / (M / 8)); const int cnt = p.cnt[e]; if (rb * 8 >= cnt) break;
        int a[8]; float g[8], u[8];
#pragma unroll
        for (int i = 0; i < 8; ++i) { a[i] = rb * 8 + i < cnt ? p.list[(size_t)e * M + rb * 8 + i] : -1; g[i] = 0.f; u[i] = 0.f; }
        const float* wgp = p.wg + ((size_t)l * NE + e) * D * FF + j; const float* wup = p.wu + ((size_t)l * NE + e) * D * FF + j;
        for (int k = 0; k < D; ++k) { const float gw = wgp[(size_t)k * FF], uw = wup[(size_t)k * FF];
#pragma unroll
            for (int i = 0; i < 8; ++i) { const float xv = p.h[(size_t)(a[i] < 0 ? 0 : a[i] / 4) * D + k]; g[i] += xv * gw; u[i] += xv * uw; } }
        const float bgv = p.bg[((size_t)l * NE + e) * FF + j], buv = p.bu[((size_t)l * NE + e) * FF + j];
#pragma unroll
        for (int i = 0; i < 8; ++i) if (a[i] >= 0) { float gv = g[i] + bgv; gv = gv < 7.0f ? gv : 7.0f; float uv = u[i] + buv; uv = uv < -7.0f ? -7.0f : (uv > 7.0f ? 7.0f : uv);
            p.act[(size_t)a[i] * FF + j] = gv * sigmf(1.702f * gv) * (uv + 1.0f); }
    } break;
    case OP_DOWN: {
        const int j = (int)(idx % D); const long rest = idx / D; const int rb = (int)(rest % (M / 8)), e = (int)(rest / (M / 8)); const int cnt = p.cnt[e]; if (rb * 8 >= cnt) break;
        int a[8]; float o[8];
#pragma unroll
        for (int i = 0; i < 8; ++i) { a[i] = rb * 8 + i < cnt ? p.list[(size_t)e * M + rb * 8 + i] : -1; o[i] = 0.f; }
        const float* wdp = p.wd + ((size_t)l * NE + e) * FF * D + j;
        for (int k = 0; k < FF; ++k) { const float w = wdp[(size_t)k * D];
#pragma unroll
            for (int i = 0; i < 8; ++i) o[i] += p.act[(size_t)(a[i] < 0 ? 0 : a[i]) * FF + k] * w; }
        const float bv = p.bd[((size_t)l * NE + e) * D + j];
#pragma unroll
        for (int i = 0; i < 8; ++i) if (a[i] >= 0) p.down[(size_t)a[i] * D + j] = o[i] + bv;
    } break;
    case OP_COMBINE: { const int r = (int)(idx / D), c = (int)(idx % D); float s = 0.f;
#pragma unroll
        for (int kk = 0; kk < 4; ++kk) s += p.topw[(size_t)r * 4 + kk] * p.down[((size_t)r * 4 + kk) * D + c];
        p.xres[idx] += modv(p, l, r, 5)[c] * s; } break;
    case OP_WRITE_OUT: p.out[idx] = p.xres[(size_t)CTX * D + idx]; break;
    case OP_MIXB: p.mixb[idx] = f2bf(p.mixin[idx]); break;
    case OP_SSD_CS: {
        const int hh = (int)(idx % SH), c = (int)((idx / SH) % NCH), dir = (int)(idx / (SH * NCH)); const float a = -expf(p.a_log[l * 12 + dir * 6 + hh]); float acc = 0.f;
        for (int i = 0; i < CHUNK; ++i) { const int r = c * CHUNK + (dir == 0 ? i : CHUNK - 1 - i); acc += p.dt[(size_t)r * 12 + dir * 6 + hh] * a; p.cs[((size_t)dir * M + r) * SH + hh] = acc; }
        p.cdec[idx] = expf(acc);
    } break;
    case OP_SSD_G: {
        const int s = (int)(idx % CHUNK), g = (int)((idx / CHUNK) % SG), r = (int)(idx / (CHUNK * SG)); const int r2 = (r / CHUNK) * CHUNK + s;
        const float* Cp = p.xbc + (size_t)r * CONVD + SW + SG * SN + g * SN; const float* Bp = p.xbc + (size_t)r2 * CONVD + SW + g * SN; float acc = 0.f;
        for (int n = 0; n < SN; ++n) acc += Cp[n] * Bp[n];
        p.gmat[idx] = acc;
    } break;
    case OP_SSD_YD: {
        const int cc = (int)(idx % SW), r = (int)(idx / SW); const int hh = cc / SP, g = hh / (SH / SG); const int c0 = (r / CHUNK) * CHUNK, lpos = r - c0;
        const float* G = p.gmat + ((size_t)r * SG + g) * CHUNK; const float csf = p.cs[(size_t)r * SH + hh], csb = p.cs[((size_t)M + r) * SH + hh]; float y = 0.f;
        for (int s = 0; s <= lpos; ++s) { const int r2 = c0 + s; y += G[s] * expf(csf - p.cs[(size_t)r2 * SH + hh]) * p.dt[(size_t)r2 * 12 + hh] * p.xbc[(size_t)r2 * CONVD + cc]; }
        for (int s = lpos; s < CHUNK; ++s) { const int r2 = c0 + s; y += G[s] * expf(csb - p.cs[((size_t)M + r2) * SH + hh]) * p.dt[(size_t)r2 * 12 + 6 + hh] * p.xbc[(size_t)r2 * CONVD + cc]; }
        p.ydir[idx] = y;
    } break;
    case OP_SSD_ST: {
        const int n = (int)(idx % SN), pp = (int)((idx / SN) % SP), hh = (int)((idx / (SN * SP)) % SH), c = (int)((idx / (SN * SP * SH)) % NCH), dir = (int)(idx / ((long)SN * SP * SH * NCH)); const int g = hh / (SH / SG);
        const int rend = c * CHUNK + (dir == 0 ? CHUNK - 1 : 0); const float cse = p.cs[((size_t)dir * M + rend) * SH + hh]; float acc = 0.f;
        for (int i = 0; i < CHUNK; ++i) { const int r = c * CHUNK + i; acc += p.xbc[(size_t)r * CONVD + SW + g * SN + n] * expf(cse - p.cs[((size_t)dir * M + r) * SH + hh]) * p.dt[(size_t)r * 12 + dir * 6 + hh] * p.xbc[(size_t)r * CONVD + hh * SP + pp]; }
        p.st[idx] = acc;
    } break;
    case OP_SSD_CARRY: {
        const int e = (int)(idx % (SP * SN)), hh = (int)((idx / (SP * SN)) % SH), dir = (int)(idx / ((long)SP * SN * SH)); float state = 0.f;
        for (int i = 0; i < NCH; ++i) { const int c = dir == 0 ? i : (i < CTX / CHUNK ? CTX / CHUNK - 1 - i : NCH - 1 - (i - CTX / CHUNK));
            const size_t o = (((size_t)dir * NCH + c) * SH + hh) * (SP * SN) + e; const float stc = p.st[o]; p.st[o] = state; state = state * p.cdec[((size_t)dir * NCH + c) * SH + hh] + stc; }
    } break;
    case OP_SSD_YOFF: {
        const int cc = (int)(idx % SW), r = (int)(idx / SW); const int hh = cc / SP, pp = cc % SP, g = hh / (SH / SG), c = r / CHUNK; const float* Cp = p.xbc + (size_t)r * CONVD + SW + SG * SN + g * SN;
        float y = 0.f;
#pragma unroll
        for (int dir = 0; dir < 2; ++dir) { const float* pv = p.st + ((((size_t)dir * NCH + c) * SH + hh) * SP + pp) * SN; float acc = 0.f;
            for (int n = 0; n < SN; ++n) acc += Cp[n] * pv[n];
            y += acc * expf(p.cs[((size_t)dir * M + r) * SH + hh]); }
        p.ydir[(size_t)M * SW + idx] = y;
    } break;
    case OP_COMBINE2: { const int r = (int)(idx / D), c = (int)(idx % D); float s = 0.f;
#pragma unroll
        for (int kk = 0; kk < 4; ++kk) s += p.topw[(size_t)r * 4 + kk] * bf2f(p.ybn[((size_t)r * 4 + kk) * D + c]);
        p.xres[idx] += modv(p, l, r, 5)[c] * s; } break;
    }
}

static const int LAYER_OPS[] = { OP_ROWSTAT, OP_NORM1, OP_INPROJ, OP_LATNORM, OP_QRAW, OP_KVRAW, OP_QHEAD, OP_KHEAD, OP_ATTN, OP_CONV, OP_DT, OP_SSDSCAN, OP_SSDFIN, OP_POOLP, OP_POOLMM,
                                 OP_OUTPROJ, OP_RES1, OP_ROWSTAT, OP_NORM2, OP_LOGITS, OP_ZEROCNT, OP_TOPK, OP_GATEUP, OP_DOWN, OP_COMBINE };
constexpr int N_LAYER_OPS = sizeof(LAYER_OPS) / sizeof(int);
#endif

#define XB_TMO      128
#define XB_XCNT(j)  (256  + 64 * (j))
#define XB_XSUB(j)  (1280 + 64 * (j))
#define XB_XGEN(j)  (2304 + 64 * (j))
#define XB_TOP      3328
#define XB_TOPGEN   3392
#define XCD_BAR_WORDS 3456
#define XB_SPIN_CAP (1u << 22)
#define LAS __attribute__((address_space(3)))

__device__ __forceinline__ unsigned xb_ld(unsigned* p)              { return __hip_atomic_load(p, __ATOMIC_RELAXED, __HIP_MEMORY_SCOPE_AGENT); }
__device__ __forceinline__ unsigned xb_add(unsigned* p, unsigned v) { return __hip_atomic_fetch_add(p, v, __ATOMIC_RELAXED, __HIP_MEMORY_SCOPE_AGENT); }
__device__ __forceinline__ unsigned xb_xcc_id() { return (unsigned)__builtin_amdgcn_s_getreg((3 << 11) | 20) & 0xFu; }
#define XB_SPIN(cond, bar) do { unsigned _sp = 0; while (cond) { __builtin_amdgcn_s_sleep(1); \
    if ((++_sp & 255u) == 0u) { if (xb_ld(&(bar)[XB_TMO])) break; if (_sp > XB_SPIN_CAP) { atomicAdd(&(bar)[XB_TMO], 1u); break; } } } } while (0)

struct XcdBarrier {
    unsigned* bar; unsigned x;
    volatile LAS unsigned* st;
};

__device__ __forceinline__ XcdBarrier xcd_barrier_post(unsigned* bar, volatile LAS unsigned* st) {
    XcdBarrier b; b.bar = bar; b.x = xb_xcc_id(); b.st = st;
    if (threadIdx.x == 0) (void)xb_add(&bar[XB_XCNT(b.x)], 1u);
    return b;
}
__device__ __forceinline__ void xcd_barrier_complete(unsigned* bar, unsigned x, unsigned& nloc, unsigned& nx) {
    const unsigned G = gridDim.x * gridDim.y * gridDim.z;
    unsigned sum, cnt, mine, sp = 0u;
    for (;;) {
        sum = 0u; cnt = 0u; mine = 0u;
#pragma unroll
        for (unsigned j = 0; j < 16; ++j) { const unsigned c = xb_ld(&bar[XB_XCNT(j)]); sum += c; cnt += (c > 0u) ? 1u : 0u; mine = (j == x) ? c : mine; }
        if (sum == G) break;
        __builtin_amdgcn_s_sleep(1);
        if ((++sp & 255u) == 0u) { if (xb_ld(&bar[XB_TMO])) break; if (sp > XB_SPIN_CAP) { atomicAdd(&bar[XB_TMO], 1u); break; } }
    }
    nloc = mine > 0u ? mine : 1u; nx = cnt > 0u ? cnt : 1u;
}

__device__ __forceinline__ void xcd_barrier(const XcdBarrier& b) {
    asm volatile("s_waitcnt vmcnt(0)" ::: "memory");
    __syncthreads();
    if (threadIdx.x == 0) {
        unsigned* bar = b.bar;
        __builtin_amdgcn_s_waitcnt(0);
        unsigned nloc = b.st[0], nx = b.st[1];
        if (nloc == 0u) { unsigned xx = b.x; asm volatile("" : "+s"(xx));   xcd_barrier_complete(bar, xx, nloc, nx); b.st[0] = nloc; b.st[1] = nx; }
        const unsigned old = xb_add(&bar[XB_XSUB(b.x)], 1u);
        const unsigned gen = old / nloc;
        if (old + 1u == (gen + 1u) * nloc) {
            __builtin_amdgcn_fence(__ATOMIC_RELEASE, "agent");
            asm volatile("s_waitcnt vmcnt(0)" ::: "memory");
            const unsigned og = xb_add(&bar[XB_TOP], 1u);
            const unsigned tg = og / nx;
            if (og + 1u == (tg + 1u) * nx) xb_add(&bar[XB_TOPGEN], 1u);
            else XB_SPIN(xb_ld(&bar[XB_TOPGEN]) == tg, bar);
            __builtin_amdgcn_fence(__ATOMIC_ACQUIRE, "agent");
            xb_add(&bar[XB_XGEN(b.x)], 1u);
            asm volatile("s_waitcnt vmcnt(0)" ::: "memory");
        } else {
            XB_SPIN(xb_ld(&bar[XB_XGEN(b.x)]) == gen, bar);
            __builtin_amdgcn_fence(__ATOMIC_ACQUIRE, "agent");
            asm volatile("s_waitcnt vmcnt(0)" ::: "memory");
        }
    }
    __syncthreads();
}


namespace at {
typedef unsigned short bf16_t;
using bf16x8 = __attribute__((ext_vector_type(8))) short;
using s16x4  = __attribute__((ext_vector_type(4))) short;
using f32x16 = __attribute__((ext_vector_type(16))) float;
using u32x4  = __attribute__((ext_vector_type(4))) unsigned;
constexpr int DQ = 96, DV = 64, NW = 8, QBLK = 32, KVBLK = 64;
constexpr int LDQ = 6 * DQ, LDK = 6 * DQ, LDV = 6 * DV;
constexpr float SCALE = 0.10206207261596575f;
constexpr float QSCALE = SCALE * 1.4426950408889634f;
constexpr float THR = 8.f * 1.4426950408889634f;
constexpr int KROW = 208;
constexpr int SHM_K = KVBLK * KROW, SHM_V = KVBLK * DV * 2;
constexpr int NBUF = 4;
constexpr int SHM_ATTN = NBUF * SHM_V + NBUF * SHM_K + NW * 64 * 4;
#define AT_SBAR() __builtin_amdgcn_sched_barrier(0)
__device__ __forceinline__ int crow(int r, int hi) { return (r & 3) + 8 * (r >> 2) + 4 * hi; }
__device__ __forceinline__ unsigned cvtpk(float lo, float hi) { unsigned r; asm volatile("v_cvt_pk_bf16_f32 %0, %1, %2" : "=v"(r) : "v"(lo), "v"(hi)); return r; }

__device__ __forceinline__ void partialSM(f32x16& p0, f32x16& p1, float& m_reg, float& mn, float& alpha) {
  float pmax = p0[0];
#pragma unroll
  for (int r = 1; r < 16; ++r) pmax = fmaxf(pmax, p0[r]);
#pragma unroll
  for (int r = 0; r < 16; ++r) pmax = fmaxf(pmax, p1[r]);
  { auto rr = __builtin_amdgcn_permlane32_swap(__float_as_uint(pmax), __float_as_uint(pmax), false, false);
    pmax = fmaxf(__uint_as_float(rr[0]), __uint_as_float(rr[1])); }
  if (__builtin_expect(__all(pmax - m_reg <= THR), 1)) { mn = m_reg; alpha = 1.f; }
  else { mn = fmaxf(m_reg, pmax); alpha = __builtin_amdgcn_exp2f(m_reg - mn); m_reg = mn; }
#pragma unroll
  for (int r = 0; r < 16; ++r) p0[r] -= mn;
#pragma unroll
  for (int r = 0; r < 16; ++r) p1[r] -= mn;
#pragma unroll
  for (int r = 0; r < 16; ++r) p0[r] = __builtin_amdgcn_exp2f(p0[r]);
}
__device__ __forceinline__ void finishSM(f32x16& p0, f32x16& p1, float alpha, float& l_reg, bf16x8& pa0, bf16x8& pa1, bf16x8& pa2, bf16x8& pa3) {
#pragma unroll
  for (int r = 0; r < 16; ++r) p1[r] = __builtin_amdgcn_exp2f(p1[r]);
  float ps = 0;
#pragma unroll
  for (int r = 0; r < 16; ++r) ps += p0[r];
#pragma unroll
  for (int r = 0; r < 16; ++r) ps += p1[r];
  { auto rr = __builtin_amdgcn_permlane32_swap(__float_as_uint(ps), __float_as_uint(ps), false, false);
    ps = __uint_as_float(rr[0]) + __uint_as_float(rr[1]); }
  l_reg = l_reg * alpha + ps;
#define AT_PK4(P, BASE, OUT) do { unsigned a0 = cvtpk(P[BASE + 0], P[BASE + 1]), a1 = cvtpk(P[BASE + 2], P[BASE + 3]);   \
    unsigned b0 = cvtpk(P[BASE + 4], P[BASE + 5]), b1 = cvtpk(P[BASE + 6], P[BASE + 7]);                              \
    auto r0 = __builtin_amdgcn_permlane32_swap(a0, b0, false, false); auto r1 = __builtin_amdgcn_permlane32_swap(a1, b1, false, false); \
    u32x4 w = {r0[0], r1[0], r0[1], r1[1]}; OUT = *reinterpret_cast<bf16x8*>(&w); } while (0)
  AT_PK4(p0, 0, pa0); AT_PK4(p0, 8, pa1); AT_PK4(p1, 0, pa2); AT_PK4(p1, 8, pa3);
#undef AT_PK4
}
__device__ __forceinline__ void fastSM(f32x16& p0, f32x16& p1, float& l_reg, bf16x8& pa0, bf16x8& pa1, bf16x8& pa2, bf16x8& pa3) {
#pragma unroll
  for (int r = 0; r < 16; ++r) p0[r] = __builtin_amdgcn_exp2f(p0[r]);
#pragma unroll
  for (int r = 0; r < 16; ++r) p1[r] = __builtin_amdgcn_exp2f(p1[r]);
  float ps = 0;
#pragma unroll
  for (int r = 0; r < 16; ++r) ps += p0[r];
#pragma unroll
  for (int r = 0; r < 16; ++r) ps += p1[r];
  l_reg += ps;
#define AT_PK4(P, BASE, OUT) do { unsigned a0 = cvtpk(P[BASE + 0], P[BASE + 1]), a1 = cvtpk(P[BASE + 2], P[BASE + 3]);   \
    unsigned b0 = cvtpk(P[BASE + 4], P[BASE + 5]), b1 = cvtpk(P[BASE + 6], P[BASE + 7]);                              \
    auto r0 = __builtin_amdgcn_permlane32_swap(a0, b0, false, false); auto r1 = __builtin_amdgcn_permlane32_swap(a1, b1, false, false); \
    u32x4 w = {r0[0], r1[0], r0[1], r1[1]}; OUT = *reinterpret_cast<bf16x8*>(&w); } while (0)
  AT_PK4(p0, 0, pa0); AT_PK4(p0, 8, pa1); AT_PK4(p1, 0, pa2); AT_PK4(p1, 8, pa3);
#undef AT_PK4
}
__device__ __forceinline__ bool attn_fast_ok(const float* qn_g, const float* kn_g) {
  float gq = 0.f, gk = 0.f; for (int i = 0; i < DQ; ++i) { gq = fmaxf(gq, fabsf(qn_g[i])); gk = fmaxf(gk, fabsf(kn_g[i])); }
  return gq * gk * (float)DQ * QSCALE <= 80.f;
}
__device__ __forceinline__ void qkt(f32x16& p0, f32x16& p1, const char* Ks, const bf16x8* qr, int r32, int hi) {
  p0 = f32x16{}; p1 = f32x16{};
#pragma unroll
  for (int d0 = 0; d0 < 6; ++d0) { const int cb = (d0 * 16 + hi * 8) * 2;
    bf16x8 b0 = *reinterpret_cast<const bf16x8*>(Ks + r32 * KROW + cb);
    bf16x8 b1 = *reinterpret_cast<const bf16x8*>(Ks + (32 + r32) * KROW + cb);
    p0 = __builtin_amdgcn_mfma_f32_32x32x16_bf16(b0, qr[d0], p0, 0, 0, 0);
    p1 = __builtin_amdgcn_mfma_f32_32x32x16_bf16(b1, qr[d0], p1, 0, 0, 0); }
}
__device__ __forceinline__ int v_st(int k, int c) { const int kk = (k & ~0xC) | ((k & 4) << 1) | ((k & 8) >> 1); return ((kk >> 3) * 2 + (c >> 5)) * 512 + ((kk & 7) * 32 + (c & 31)) * 2; }
__device__ __forceinline__ int v_rd_base(int lane) { return ((lane & 3) << 3) | (((lane >> 2) & 3) << 6) | (((lane >> 4) & 1) << 5) | (((lane >> 5) & 1) << 8); }
constexpr int v_rd_off(int d0, int ks, int half) { return d0 * 512 + ks * 2048 + half * 1024; }
template <int OFF> __device__ __forceinline__ s16x4 tr_read(int vb) {
  s16x4 r; asm volatile("ds_read_b64_tr_b16 %0, %1 offset:%2" : "=&v"(r) : "v"(vb), "i"(OFF) : "memory"); return r;
}
template <int D0> __device__ __forceinline__ void pv_one(f32x16& od, int vb, bf16x8 pa0, bf16x8 pa1, bf16x8 pa2, bf16x8 pa3) {
  const s16x4 l0 = tr_read<v_rd_off(D0, 0, 0)>(vb), h0 = tr_read<v_rd_off(D0, 0, 1)>(vb), l1 = tr_read<v_rd_off(D0, 1, 0)>(vb), h1 = tr_read<v_rd_off(D0, 1, 1)>(vb);
  const s16x4 l2 = tr_read<v_rd_off(D0, 2, 0)>(vb), h2 = tr_read<v_rd_off(D0, 2, 1)>(vb), l3 = tr_read<v_rd_off(D0, 3, 0)>(vb), h3 = tr_read<v_rd_off(D0, 3, 1)>(vb);
  asm volatile("s_waitcnt lgkmcnt(0)" ::: "memory"); AT_SBAR();
#define AT_PK(L, H) (bf16x8){L[0], L[1], L[2], L[3], H[0], H[1], H[2], H[3]}
  od = __builtin_amdgcn_mfma_f32_32x32x16_bf16(pa0, AT_PK(l0, h0), od, 0, 0, 0);
  od = __builtin_amdgcn_mfma_f32_32x32x16_bf16(pa1, AT_PK(l1, h1), od, 0, 0, 0);
  od = __builtin_amdgcn_mfma_f32_32x32x16_bf16(pa2, AT_PK(l2, h2), od, 0, 0, 0);
  od = __builtin_amdgcn_mfma_f32_32x32x16_bf16(pa3, AT_PK(l3, h3), od, 0, 0, 0);
#undef AT_PK
}
__device__ __forceinline__ void pv_d0(f32x16* o, int vb, bf16x8 pa0, bf16x8 pa1, bf16x8 pa2, bf16x8 pa3) {
  pv_one<0>(o[0], vb, pa0, pa1, pa2, pa3); pv_one<1>(o[1], vb, pa0, pa1, pa2, pa3);
}
template <class TO, bool FAST> __device__ __forceinline__ void attn_body(const bf16_t* __restrict__ Qb, const bf16_t* __restrict__ Kh, const bf16_t* __restrict__ Vh, TO* __restrict__ Ob, int ldo, int seq, char* lds, float* __restrict__ ml = nullptr, int ldml = 0) {
  int tid = threadIdx.x; asm volatile("" : "+v"(tid));
  const int wid = tid >> 6, lane = tid & 63, r32 = lane & 31, hi = lane >> 5;
  char* V_lds = lds; char* K_lds = lds + NBUF * SHM_V;
  float* ws = (float*)(lds + NBUF * SHM_V + NBUF * SHM_K) + wid * 64; float* li_l = ws; float* al_l = ws + 32;
  float m_reg = -1e30f, l_reg = 0; f32x16 o[2] = {}; bf16x8 qr[6];
  const bf16_t* Qw = Qb + (long)(wid * QBLK + r32) * LDQ + hi * 8;
#pragma unroll
  for (int d0 = 0; d0 < 6; ++d0) qr[d0] = *reinterpret_cast<const bf16x8*>(Qw + d0 * 16);
  const int kr0 = tid / 12, kc0 = tid % 12, c1 = 512 + (tid & 255), kr1 = c1 / 12, kc1 = c1 % 12, vr = tid >> 3, vc = (tid & 7) * 8;
  const bool k1on = tid < 256;
  const int kst0 = kr0 * KROW + kc0 * 16, kst1 = kr1 * KROW + kc1 * 16, vst = v_st(vr, vc);
  const long kg0 = (long)kr0 * LDK + kc0 * 8, kg1 = (long)kr1 * LDK + kc1 * 8, vg = (long)vr * LDV + vc;
  const int vb0 = (int)(uintptr_t)V_lds + v_rd_base(lane);
  struct { bf16x8 vs, ks0, ks1; } sr_[2];
#define AT_SLOAD(i, k0) do { sr_[i].vs = *reinterpret_cast<const bf16x8*>(Vh + (long)(k0) * LDV + vg); \
    sr_[i].ks0 = *reinterpret_cast<const bf16x8*>(Kh + (long)(k0) * LDK + kg0); sr_[i].ks1 = *reinterpret_cast<const bf16x8*>(Kh + (long)(k0) * LDK + kg1); } while (0)
#define AT_SWRITE(b, i) do { *(bf16x8*)(V_lds + (b) * SHM_V + vst) = sr_[i].vs; *(bf16x8*)(K_lds + (b) * SHM_K + kst0) = sr_[i].ks0; \
    if (k1on) *(bf16x8*)(K_lds + (b) * SHM_K + kst1) = sr_[i].ks1; } while (0)
#define AT_SWAIT() asm volatile("s_waitcnt vmcnt(3)" ::: "memory")
#define AT_RESC(a) do { if (__any((a) < 1.f)) { if (hi == 0) al_l[r32] = (a); asm volatile("s_waitcnt lgkmcnt(0)" ::: "memory"); \
    _Pragma("unroll") for (int d = 0; d < 2; ++d) _Pragma("unroll") for (int r = 0; r < 16; ++r) o[d][r] *= al_l[crow(r, hi)]; } } while (0)
  f32x16 pA0, pA1, pB0, pB1; float mnA, mnB, alA, alB; bf16x8 pa0, pa1, pa2, pa3; const int NT = seq / KVBLK;
  constexpr int SE = 0, SO = 1;
  AT_SLOAD(SE, 0); asm volatile("s_waitcnt vmcnt(0)" ::: "memory"); AT_SWRITE(0, SE); __syncthreads();
  if constexpr (FAST) {
    qkt(pA0, pA1, K_lds, qr, r32, hi);
    AT_SLOAD(SO, KVBLK); if (2 < NT) AT_SLOAD(SE, 2 * KVBLK);
    AT_SWAIT(); AT_SWRITE(1, SO); __syncthreads();
    for (int j = 1; j + 1 < NT; j += 2) {
      const int b0 = j & 3, bm = (j - 1) & 3, b1 = (j + 1) & 3, b2 = (j + 2) & 3;
      AT_SBAR(); qkt(pB0, pB1, K_lds + b0 * SHM_K, qr, r32, hi);
      fastSM(pA0, pA1, l_reg, pa0, pa1, pa2, pa3); AT_SBAR();
      AT_SLOAD(SO, (j + 2) * KVBLK); AT_SBAR();
      pv_d0(o, vb0 + bm * SHM_V, pa0, pa1, pa2, pa3);
      AT_SWAIT(); AT_SWRITE(b1, SE);
      __syncthreads();
      AT_SBAR(); qkt(pA0, pA1, K_lds + b1 * SHM_K, qr, r32, hi);
      fastSM(pB0, pB1, l_reg, pa0, pa1, pa2, pa3); AT_SBAR();
      if (j + 3 < NT) AT_SLOAD(SE, (j + 3) * KVBLK); AT_SBAR();
      pv_d0(o, vb0 + b0 * SHM_V, pa0, pa1, pa2, pa3);
      AT_SWAIT(); AT_SWRITE(b2, SO);
      __syncthreads();
    }
    AT_SBAR(); qkt(pB0, pB1, K_lds + ((NT - 1) & 3) * SHM_K, qr, r32, hi);
    fastSM(pA0, pA1, l_reg, pa0, pa1, pa2, pa3); AT_SBAR();
    pv_d0(o, vb0 + ((NT - 2) & 3) * SHM_V, pa0, pa1, pa2, pa3);
    fastSM(pB0, pB1, l_reg, pa0, pa1, pa2, pa3); AT_SBAR();
    pv_d0(o, vb0 + ((NT - 1) & 3) * SHM_V, pa0, pa1, pa2, pa3);
    { auto rr = __builtin_amdgcn_permlane32_swap(__float_as_uint(l_reg), __float_as_uint(l_reg), false, false); l_reg = __uint_as_float(rr[0]) + __uint_as_float(rr[1]); }
    m_reg = 0.f;
  } else {
  qkt(pA0, pA1, K_lds, qr, r32, hi); partialSM(pA0, pA1, m_reg, mnA, alA);
  AT_SLOAD(SO, KVBLK); if (2 < NT) AT_SLOAD(SE, 2 * KVBLK);
  AT_SWAIT(); AT_SWRITE(1, SO); __syncthreads();
  for (int j = 1; j + 1 < NT; j += 2) {
    AT_SBAR(); qkt(pB0, pB1, K_lds + SHM_K, qr, r32, hi);
    finishSM(pA0, pA1, alA, l_reg, pa0, pa1, pa2, pa3); AT_SBAR();
    AT_SLOAD(SO, (j + 2) * KVBLK); AT_SBAR();
    pv_d0(o, vb0, pa0, pa1, pa2, pa3); partialSM(pB0, pB1, m_reg, mnB, alB);
    __syncthreads(); AT_SWAIT(); AT_SWRITE(0, SE);
    AT_RESC(alB); __syncthreads();
    AT_SBAR(); qkt(pA0, pA1, K_lds, qr, r32, hi);
    finishSM(pB0, pB1, alB, l_reg, pa0, pa1, pa2, pa3); AT_SBAR();
    if (j + 3 < NT) AT_SLOAD(SE, (j + 3) * KVBLK); AT_SBAR();
    pv_d0(o, vb0 + SHM_V, pa0, pa1, pa2, pa3); partialSM(pA0, pA1, m_reg, mnA, alA);
    __syncthreads(); AT_SWAIT(); AT_SWRITE(1, SO);
    AT_RESC(alA); __syncthreads();
  }
  AT_SBAR(); qkt(pB0, pB1, K_lds + SHM_K, qr, r32, hi);
  finishSM(pA0, pA1, alA, l_reg, pa0, pa1, pa2, pa3); AT_SBAR();
  pv_d0(o, vb0, pa0, pa1, pa2, pa3); partialSM(pB0, pB1, m_reg, mnB, alB);
  __syncthreads(); AT_RESC(alB);
  finishSM(pB0, pB1, alB, l_reg, pa0, pa1, pa2, pa3); AT_SBAR();
  pv_d0(o, vb0 + SHM_V, pa0, pa1, pa2, pa3);
  }
  if (hi == 0) li_l[r32] = l_reg; asm volatile("s_waitcnt lgkmcnt(0)" ::: "memory");
  if (ml != nullptr && hi == 0) { float* q = ml + (long)(wid * QBLK + r32) * ldml; q[0] = m_reg; q[1] = l_reg; }
  float rli[16];
#pragma unroll
  for (int r = 0; r < 16; ++r) rli[r] = __builtin_amdgcn_rcpf(li_l[crow(r, hi)]);
  TO* Ow = Ob + (long)(wid * QBLK) * ldo;
#pragma unroll
  for (int r = 0; r < 16; ++r) { const int orow = crow(r, hi);
#pragma unroll
    for (int d0 = 0; d0 < 2; ++d0) { const float val = o[d0][r] * rli[r]; if constexpr (sizeof(TO) == 2) Ow[(long)orow * ldo + d0 * 32 + r32] = (TO)(cvtpk(val, val) & 0xffffu); else Ow[(long)orow * ldo + d0 * 32 + r32] = val; } }
#undef AT_SLOAD
#undef AT_SWRITE
#undef AT_SWAIT
#undef AT_RESC
}
__device__ __forceinline__ void attn_combine(const bf16_t* Opart, const float* ml, bf16_t* dst, int ldd, int nrows_total, int ctx_rows) {
  int tid = threadIdx.x; asm volatile("" : "+v"(tid)); const int wid = tid >> 6, lane = tid & 63;
  const size_t hs = (size_t)nrows_total * 6 * DV;
  for (int r = blockIdx.x * 8 + wid; r < nrows_total; r += gridDim.x * 8) {
#pragma unroll
    for (int j = 0; j < 3; ++j) { const int c = 2 * (lane + 64 * j), hh = c >> 6; const unsigned w0 = *(const unsigned*)(Opart + (size_t)r * 384 + c);
      unsigned res = w0;
      if (r >= ctx_rows) { const unsigned w1 = *(const unsigned*)(Opart + hs + (size_t)r * 384 + c);
        const float m0 = ml[((size_t)r * 6 + hh) * 2], l0 = ml[((size_t)r * 6 + hh) * 2 + 1], m1 = ml[((size_t)(nrows_total + r) * 6 + hh) * 2], l1 = ml[((size_t)(nrows_total + r) * 6 + hh) * 2 + 1];
        const float m = fmaxf(m0, m1); const float a0 = __builtin_amdgcn_exp2f(m0 - m) * l0, a1 = __builtin_amdgcn_exp2f(m1 - m) * l1; const float inv = 1.0f / (a0 + a1); const float f0 = a0 * inv, f1 = a1 * inv;
        const float x0 = __uint_as_float(w0 << 16) * f0 + __uint_as_float(w1 << 16) * f1, x1 = __uint_as_float(w0 & 0xffff0000u) * f0 + __uint_as_float(w1 & 0xffff0000u) * f1; res = cvtpk(x0, x1); }
      *(unsigned*)(dst + (size_t)r * ldd + c) = res; } }
}
}

namespace gm {
#define GM_LAS __attribute__((address_space(3)))
typedef unsigned short bf16_t;
typedef short bf16x8 __attribute__((ext_vector_type(8)));
typedef float f32x4 __attribute__((ext_vector_type(4)));
typedef unsigned u32x4 __attribute__((ext_vector_type(4)));
constexpr int BM = 256, BK = 64, HALF = 128, HTB = HALF * BK * 2, STAGE_BYTES = 8 * HTB;
__host__ __device__ __forceinline__ int lds_byte(int r, int c) { const int st = (r >> 4) * 2 + (c >> 5), rr = r & 15, cc = c & 31, ob = rr * 64 + cc * 2; return st * 1024 + (ob ^ (((ob >> 9) & 1) << 5)); }
__host__ __device__ __forceinline__ void stage_rc(int b, int& R, int& C) { const int st = b / 1024, sb = b % 1024, swz = sb ^ (((sb >> 9) & 1) << 5); R = (st >> 1) * 16 + swz / 64; C = (st & 1) * 32 + (swz % 64) / 2; }
__host__ __device__ __forceinline__ int perm32(int rho) { const int n = rho >> 4, i = rho & 15; return 8 * (i >> 2) + 4 * n + (i & 3); }
__device__ __forceinline__ unsigned cvt_pk_bf16(float lo, float hi) { unsigned r; asm volatile("v_cvt_pk_bf16_f32 %0, %1, %2" : "=v"(r) : "v"(lo), "v"(hi)); return r; }

template <bool PERM, class Epi>
__device__ __forceinline__ void gemm_unit(GM_LAS unsigned char* lds, const char* A, const unsigned (&offA)[2][2], const char* Bt, int K, const Epi& E) {
    int tid = threadIdx.x; asm volatile("" : "+v"(tid));
    const int wid = __builtin_amdgcn_readfirstlane(tid >> 6), lane = tid & 63, wr = wid >> 2, wc = wid & 3, fr = lane & 15, fq = lane >> 4;
    const int nt = K / BK;
    unsigned voffB[2];
#pragma unroll
    for (int i = 0; i < 2; ++i) { int R, C; stage_rc(tid * 16 + i * 8192, R, C); const int Rb = PERM ? ((R & ~31) + perm32(R & 31)) : R; voffB[i] = (unsigned)(Rb * K + C) * 2u; }
    const size_t kstep = (size_t)(BK * 2);
    const size_t hstep = (size_t)HALF * K * 2;
    const unsigned ldsw = (unsigned)wid * 1024u;
    const int aoff = lds_byte(wr * 64 + fr, fq * 8), boff = lds_byte(wc * 32 + fr, fq * 8);
#define GM_SA(b, h) (((b) * 2 + (h)) * HTB)
#define GM_SB(b, h) ((4 + (b) * 2 + (h)) * HTB)
#define GM_STAGEB(bufoff, gbase) do { _Pragma("unroll") for (int _i = 0; _i < 2; ++_i) \
        __builtin_amdgcn_global_load_lds((const unsigned*)((const char*)(gbase) + voffB[_i]), (GM_LAS unsigned*)(lds + (bufoff) + ldsw + _i * 8192), 16, 0, 0); } while (0)
#define GM_STAGEA(bufoff, h, kbyte) do { _Pragma("unroll") for (int _i = 0; _i < 2; ++_i) \
        __builtin_amdgcn_global_load_lds((const unsigned*)(A + (size_t)offA[h][_i] + (kbyte)), (GM_LAS unsigned*)(lds + (bufoff) + ldsw + _i * 8192), 16, 0, 0); } while (0)
#define GM_LDA(dst, b, h) do { _Pragma("unroll") for (int m = 0; m < 4; ++m) _Pragma("unroll") for (int k = 0; k < 2; ++k) dst[m][k] = *(const GM_LAS bf16x8*)(lds + GM_SA(b, h) + aoff + m * 2048 + k * 1024); } while (0)
#define GM_LDB(dst, b, h) do { _Pragma("unroll") for (int n = 0; n < 2; ++n) _Pragma("unroll") for (int k = 0; k < 2; ++k) dst[n][k] = *(const GM_LAS bf16x8*)(lds + GM_SB(b, h) + boff + n * 2048 + k * 1024); } while (0)
#define GM_MMA(ai, bj, At, Bt_) do { __builtin_amdgcn_s_setprio(1); _Pragma("unroll") for (int m = 0; m < 4; ++m) _Pragma("unroll") for (int n = 0; n < 2; ++n) _Pragma("unroll") for (int k = 0; k < 2; ++k) \
        acc[ai][bj][m][n] = __builtin_amdgcn_mfma_f32_16x16x32_bf16(Bt_[n][k], At[m][k], acc[ai][bj][m][n], 0, 0, 0); __builtin_amdgcn_s_setprio(0); } while (0)
#define GM_WAIT_V(n) asm volatile("s_waitcnt vmcnt(" #n ")" ::: "memory")
#define GM_WAIT_L(n) asm volatile("s_waitcnt lgkmcnt(" #n ")" ::: "memory")
#define GM_BAR __builtin_amdgcn_s_barrier()
#define GM_SCHED __builtin_amdgcn_sched_barrier(0)
    f32x4 acc[2][2][4][2];
#pragma unroll
    for (int a = 0; a < 2; ++a)
#pragma unroll
        for (int b = 0; b < 2; ++b)
#pragma unroll
            for (int m = 0; m < 4; ++m)
#pragma unroll
                for (int n = 0; n < 2; ++n) acc[a][b][m][n] = (f32x4){0.f, 0.f, 0.f, 0.f};
    bf16x8 At[4][2], B0[2][2], B1[2][2];
    const char* cB = Bt;
    GM_STAGEB(GM_SB(0, 0), cB); GM_STAGEA(GM_SA(0, 0), 0, 0); GM_STAGEB(GM_SB(0, 1), cB + hstep); GM_STAGEA(GM_SA(0, 1), 1, 0);
    if (wr == 1) GM_BAR;
    GM_WAIT_V(4); GM_BAR;
    GM_STAGEB(GM_SB(1, 0), cB + kstep); GM_STAGEA(GM_SA(1, 0), 0, kstep); GM_STAGEB(GM_SB(1, 1), cB + hstep + kstep);
    GM_WAIT_V(6); GM_BAR;
    for (int t = 0; t < nt; t += 2) {
        const bool last = (t == nt - 2);
        const size_t k1 = (size_t)(t + 1) * kstep;
        const size_t k2 = last ? 0 : (size_t)(t + 2) * kstep;
        const size_t k3 = k2 + kstep;
        const char* b2 = cB + k2; const char* b3 = cB + k3;
        GM_LDB(B0, 0, 0); GM_SCHED; GM_LDA(At, 0, 0); GM_STAGEA(GM_SA(1, 1), 1, k1);
        GM_WAIT_L(8); GM_BAR; GM_WAIT_L(0); GM_MMA(0, 0, At, B0); GM_BAR; GM_SCHED;
        GM_LDB(B1, 0, 1); GM_STAGEB(GM_SB(0, 0), b2);
        GM_BAR; GM_WAIT_L(0); GM_MMA(0, 1, At, B1); GM_BAR;
        GM_LDA(At, 0, 1); GM_STAGEA(GM_SA(0, 0), 0, k2);
        GM_BAR; GM_WAIT_L(0); GM_MMA(1, 0, At, B0); GM_BAR; GM_SCHED;
        GM_STAGEB(GM_SB(0, 1), b2 + hstep);
        GM_WAIT_V(6); GM_BAR; GM_MMA(1, 1, At, B1); GM_BAR;
        GM_LDB(B0, 1, 0); GM_SCHED; GM_LDA(At, 1, 0); GM_STAGEA(GM_SA(0, 1), 1, k2);
        GM_WAIT_L(8); GM_BAR; GM_WAIT_L(0); GM_MMA(0, 0, At, B0); GM_BAR; GM_SCHED;
        GM_LDB(B1, 1, 1); GM_STAGEB(GM_SB(1, 0), b3);
        GM_BAR; GM_WAIT_L(0); GM_MMA(0, 1, At, B1); GM_BAR;
        GM_LDA(At, 1, 1); GM_STAGEA(GM_SA(1, 0), 0, k3);
        GM_BAR; GM_WAIT_L(0); GM_MMA(1, 0, At, B0); GM_BAR; GM_SCHED;
        GM_STAGEB(GM_SB(1, 1), b3 + hstep);
        GM_WAIT_V(6); GM_BAR; GM_MMA(1, 1, At, B1); GM_BAR;
    }
    E(acc, wr, wc, fr, fq);
    GM_WAIT_V(0);
    if (wr == 0) GM_BAR;
    GM_BAR;
#undef GM_SA
#undef GM_SB
#undef GM_STAGEA
#undef GM_STAGEB
#undef GM_LDA
#undef GM_LDB
#undef GM_MMA
#undef GM_WAIT_V
#undef GM_WAIT_L
#undef GM_BAR
#undef GM_SCHED
}
template <bool PERM, class U, class Sched, class Epi>
__device__ __forceinline__ void gemm_stream(GM_LAS unsigned char* lds, int K, const Sched& S, const Epi& E) {
    int tid = threadIdx.x; asm volatile("" : "+v"(tid));
    const int wid = __builtin_amdgcn_readfirstlane(tid >> 6), lane = tid & 63, wr = wid >> 2, wc = wid & 3, fr = lane & 15, fq = lane >> 4;
    const int nt = K / BK;
    unsigned voffB[2];
#pragma unroll
    for (int i = 0; i < 2; ++i) { int R, C; stage_rc(tid * 16 + i * 8192, R, C); const int Rb = PERM ? ((R & ~31) + perm32(R & 31)) : R; voffB[i] = (unsigned)(Rb * K + C) * 2u; }
    const size_t kstep = (size_t)(BK * 2);
    const size_t hstep = (size_t)HALF * K * 2;
    const unsigned ldsw = (unsigned)wid * 1024u;
    const int aoff = lds_byte(wr * 64 + fr, fq * 8), boff = lds_byte(wc * 32 + fr, fq * 8);
#define GM_SA(b, h) (((b) * 2 + (h)) * HTB)
#define GM_SB(b, h) ((4 + (b) * 2 + (h)) * HTB)
#define GM_STAGEB(bufoff, gbase) do { _Pragma("unroll") for (int _i = 0; _i < 2; ++_i) \
        __builtin_amdgcn_global_load_lds((const unsigned*)((const char*)(gbase) + voffB[_i]), (GM_LAS unsigned*)(lds + (bufoff) + ldsw + _i * 8192), 16, 0, 0); } while (0)
#define GM_STAGEA2(bufoff, abase, o0, o1, kbyte) do { \
        __builtin_amdgcn_global_load_lds((const unsigned*)((abase) + (size_t)(o0) + (kbyte)), (GM_LAS unsigned*)(lds + (bufoff) + ldsw), 16, 0, 0); \
        __builtin_amdgcn_global_load_lds((const unsigned*)((abase) + (size_t)(o1) + (kbyte)), (GM_LAS unsigned*)(lds + (bufoff) + ldsw + 8192), 16, 0, 0); } while (0)
#define GM_LDA(dst, b, h) do { _Pragma("unroll") for (int m = 0; m < 4; ++m) _Pragma("unroll") for (int k = 0; k < 2; ++k) dst[m][k] = *(const GM_LAS bf16x8*)(lds + GM_SA(b, h) + aoff + m * 2048 + k * 1024); } while (0)
#define GM_LDB(dst, b, h) do { _Pragma("unroll") for (int n = 0; n < 2; ++n) _Pragma("unroll") for (int k = 0; k < 2; ++k) dst[n][k] = *(const GM_LAS bf16x8*)(lds + GM_SB(b, h) + boff + n * 2048 + k * 1024); } while (0)
#define GM_MMA(ai, bj, At, Bt_) do { __builtin_amdgcn_s_setprio(1); _Pragma("unroll") for (int m = 0; m < 4; ++m) _Pragma("unroll") for (int n = 0; n < 2; ++n) _Pragma("unroll") for (int k = 0; k < 2; ++k) \
        acc[ai][bj][m][n] = __builtin_amdgcn_mfma_f32_16x16x32_bf16(Bt_[n][k], At[m][k], acc[ai][bj][m][n], 0, 0, 0); __builtin_amdgcn_s_setprio(0); } while (0)
#define GM_WAIT_V(n) asm volatile("s_waitcnt vmcnt(" #n ")" ::: "memory")
#define GM_WAIT_L(n) asm volatile("s_waitcnt lgkmcnt(" #n ")" ::: "memory")
#define GM_BAR __builtin_amdgcn_s_barrier()
#define GM_SCHED __builtin_amdgcn_sched_barrier(0)
    U cur, nxt; int ui = 0;
    if (!S(0, cur)) return;
    f32x4 acc[2][2][4][2];
#pragma unroll
    for (int a = 0; a < 2; ++a)
#pragma unroll
        for (int b = 0; b < 2; ++b)
#pragma unroll
            for (int m = 0; m < 4; ++m)
#pragma unroll
                for (int n = 0; n < 2; ++n) acc[a][b][m][n] = (f32x4){0.f, 0.f, 0.f, 0.f};
    bf16x8 At[4][2], B0[2][2], B1[2][2];
    GM_STAGEB(GM_SB(0, 0), cur.B); GM_STAGEA2(GM_SA(0, 0), cur.A, cur.offA[0][0], cur.offA[0][1], 0); GM_STAGEB(GM_SB(0, 1), cur.B + hstep); GM_STAGEA2(GM_SA(0, 1), cur.A, cur.offA[1][0], cur.offA[1][1], 0);
    if (wr == 1) GM_BAR;
    GM_WAIT_V(4); GM_BAR;
    GM_STAGEB(GM_SB(1, 0), cur.B + kstep); GM_STAGEA2(GM_SA(1, 0), cur.A, cur.offA[0][0], cur.offA[0][1], kstep); GM_STAGEB(GM_SB(1, 1), cur.B + hstep + kstep);
    GM_WAIT_V(6); GM_BAR;
    for (;;) {
        const bool has_next = S(ui + 1, nxt);
        for (int t = 0; t < nt; t += 2) {
            const bool last = (t == nt - 2); const bool usen = last && has_next;
            const size_t k1 = (size_t)(t + 1) * kstep;
            const size_t k2 = last ? 0 : (size_t)(t + 2) * kstep, k3 = k2 + kstep;
            const char* a2b = usen ? nxt.A : cur.A; const char* b2b = usen ? nxt.B : cur.B;
            const unsigned o00 = usen ? nxt.offA[0][0] : cur.offA[0][0], o01 = usen ? nxt.offA[0][1] : cur.offA[0][1], o10 = usen ? nxt.offA[1][0] : cur.offA[1][0], o11 = usen ? nxt.offA[1][1] : cur.offA[1][1];
            const char* b2 = b2b + k2; const char* b3 = b2b + k3;
            GM_LDB(B0, 0, 0); GM_SCHED; GM_LDA(At, 0, 0); GM_STAGEA2(GM_SA(1, 1), cur.A, cur.offA[1][0], cur.offA[1][1], k1);
            GM_WAIT_L(8); GM_BAR; GM_WAIT_L(0); GM_MMA(0, 0, At, B0); GM_BAR; GM_SCHED;
            GM_LDB(B1, 0, 1); GM_STAGEB(GM_SB(0, 0), b2);
            GM_BAR; GM_WAIT_L(0); GM_MMA(0, 1, At, B1); GM_BAR;
            GM_LDA(At, 0, 1); GM_STAGEA2(GM_SA(0, 0), a2b, o00, o01, k2);
            GM_BAR; GM_WAIT_L(0); GM_MMA(1, 0, At, B0); GM_BAR; GM_SCHED;
            GM_STAGEB(GM_SB(0, 1), b2 + hstep);
            GM_WAIT_V(6); GM_BAR; GM_MMA(1, 1, At, B1); GM_BAR;
            GM_LDB(B0, 1, 0); GM_SCHED; GM_LDA(At, 1, 0); GM_STAGEA2(GM_SA(0, 1), a2b, o10, o11, k2);
            GM_WAIT_L(8); GM_BAR; GM_WAIT_L(0); GM_MMA(0, 0, At, B0); GM_BAR; GM_SCHED;
            GM_LDB(B1, 1, 1); GM_STAGEB(GM_SB(1, 0), b3);
            GM_BAR; GM_WAIT_L(0); GM_MMA(0, 1, At, B1); GM_BAR;
            GM_LDA(At, 1, 1); GM_STAGEA2(GM_SA(1, 0), a2b, o00, o01, k3);
            GM_BAR; GM_WAIT_L(0); GM_MMA(1, 0, At, B0); GM_BAR; GM_SCHED;
            GM_STAGEB(GM_SB(1, 1), b3 + hstep);
            GM_WAIT_V(6); GM_BAR; GM_MMA(1, 1, At, B1); GM_BAR;
        }
        E(acc, cur, wr, wc, fr, fq);
        if (!has_next) break;
#pragma unroll
        for (int a = 0; a < 2; ++a)
#pragma unroll
            for (int b = 0; b < 2; ++b)
#pragma unroll
                for (int m = 0; m < 4; ++m)
#pragma unroll
                    for (int n = 0; n < 2; ++n) acc[a][b][m][n] = (f32x4){0.f, 0.f, 0.f, 0.f};
        cur = nxt; ++ui;
    }
    GM_WAIT_V(0);
    if (wr == 0) GM_BAR;
    GM_BAR;
#undef GM_SA
#undef GM_SB
#undef GM_STAGEA2
#undef GM_STAGEB
#undef GM_LDA
#undef GM_LDB
#undef GM_MMA
#undef GM_WAIT_V
#undef GM_WAIT_L
#undef GM_BAR
#undef GM_SCHED
}
__device__ __forceinline__ void dense_offA(unsigned (&offA)[2][2], long row0, int K) {
    int tid = threadIdx.x; asm volatile("" : "+v"(tid));
#pragma unroll
    for (int i = 0; i < 2; ++i) { int R, C; stage_rc(tid * 16 + i * 8192, R, C);
#pragma unroll
        for (int h = 0; h < 2; ++h) offA[h][i] = (unsigned)(((row0 + h * HALF + R) * K + C) * 2); }
}
}

struct FW {
    bf16_t *w_in_t, *w_out_t, *gu_t, *d_t;
    bf16_t *hb1, *hb2, *mixb, *actb, *yb;
    bf16_t* projb;
    float *proj2, *mix2;
    bf16_t *w_uq_t, *w_ukv_t;
    float *ropec, *ropes;
    bf16_t *qb2, *kb2, *vb2;
    bf16_t* opart; float* aml;
    float *yd2, *st2, *cdec2, *cs2; bf16_t *cg, *prevb, *ssdb2;
};
constexpr int INC_PAD = 1792;
template <int MAP> __device__ __forceinline__ void cvt_tile(const float* src, int ldn, int nvalid, bf16_t* dst, int K, int k0, int n0, float* T) {
    int tid = threadIdx.x; asm volatile("" : "+v"(tid)); const int r = tid >> 4, c4 = (tid & 15) * 4;
#pragma unroll
    for (int i = 0; i < 2; ++i) { const int kk = r + 32 * i; float4 v = make_float4(0.f, 0.f, 0.f, 0.f);
        if (n0 + c4 < nvalid) v = *(const float4*)(src + (size_t)(k0 + kk) * ldn + n0 + c4);
        T[kk * 65 + c4 + 0] = v.x; T[kk * 65 + c4 + 1] = v.y; T[kk * 65 + c4 + 2] = v.z; T[kk * 65 + c4 + 3] = v.w; }
    __syncthreads();
    { const int n = tid >> 3, kc = tid & 7; float f[8];
#pragma unroll
        for (int j = 0; j < 8; ++j) f[j] = T[(kc * 8 + j) * 65 + n];
        gm::u32x4 w; w.x = gm::cvt_pk_bf16(f[0], f[1]); w.y = gm::cvt_pk_bf16(f[2], f[3]); w.z = gm::cvt_pk_bf16(f[4], f[5]); w.w = gm::cvt_pk_bf16(f[6], f[7]);
        const int nn = n0 + n; const int drow = MAP == 0 ? nn : ((nn >> 7) * 256 + (MAP == 2 ? 128 : 0) + (nn & 127));
        *(gm::u32x4*)(dst + (size_t)drow * K + k0 + kc * 8) = w; }
    __syncthreads();
}
template <int MAP> __device__ __forceinline__ void cvt_strip(const float* src, int ldn, int nvalid, bf16_t* dst, int K, int k0, int n0, float* T) {
    int tid = threadIdx.x; asm volatile("" : "+v"(tid)); const int r = tid >> 4, c4 = (tid & 15) * 4;
    float4 v[4][2];
#pragma unroll
    for (int t = 0; t < 4; ++t)
#pragma unroll
        for (int i = 0; i < 2; ++i) { v[t][i] = make_float4(0.f, 0.f, 0.f, 0.f); if (n0 + t * 64 + c4 < nvalid) v[t][i] = *(const float4*)(src + (size_t)(k0 + r + 32 * i) * ldn + n0 + t * 64 + c4); }
#pragma unroll
    for (int t = 0; t < 4; ++t)
#pragma unroll
        for (int i = 0; i < 2; ++i) { float* q = T + t * (64 * 65) + (r + 32 * i) * 65 + c4; q[0] = v[t][i].x; q[1] = v[t][i].y; q[2] = v[t][i].z; q[3] = v[t][i].w; }
    __syncthreads();
    { const int n = tid >> 3, kc = tid & 7;
#pragma unroll
        for (int t = 0; t < 4; ++t) { float f[8];
#pragma unroll
            for (int j = 0; j < 8; ++j) f[j] = T[t * (64 * 65) + (kc * 8 + j) * 65 + n];
            gm::u32x4 w; w.x = gm::cvt_pk_bf16(f[0], f[1]); w.y = gm::cvt_pk_bf16(f[2], f[3]); w.z = gm::cvt_pk_bf16(f[4], f[5]); w.w = gm::cvt_pk_bf16(f[6], f[7]);
            const int nn = n0 + t * 64 + n; const int drow = MAP == 0 ? nn : ((nn >> 7) * 256 + (MAP == 2 ? 128 : 0) + (nn & 127));
            *(gm::u32x4*)(dst + (size_t)drow * K + k0 + kc * 8) = w; } }
    __syncthreads();
}
__device__ __forceinline__ void cvt_small_phase(const P& p, const FW& f, char* lds) {
    float* T = (float*)lds;
    constexpr int T_IN = 16 * 7, T_OUT = 16 * 4, T_UQ = 4 * 9, T_UKV = 2 * 12, T_LAYER = T_IN + T_OUT + T_UQ + T_UKV;
    const int total = DEPTH * T_LAYER;
    if (blockIdx.x == gridDim.x - 1) for (int i = threadIdx.x; i < 256 * 8; i += 512) { float cs, sn; sincos_rr((float)(i >> 3) * rope_inv_freq(i & 7), cs, sn); f.ropec[i] = cs; f.ropes[i] = sn; }
    for (int t = blockIdx.x; t < total; t += gridDim.x) {
        const int l = t / T_LAYER; int r = t % T_LAYER;
        if (r < T_IN) { const int kt = r / 7, ntl = r % 7; cvt_strip<0>(p.w_in + (size_t)l * D * INC, INC, INC, f.w_in_t + (size_t)l * INC_PAD * D, D, kt * 64, ntl * 256, T); continue; }
        r -= T_IN;
        if (r < T_OUT) { const int kt = r / 4, ntl = r % 4; cvt_strip<0>(p.w_out + (size_t)l * MIXW * D, D, D, f.w_out_t + (size_t)l * D * MIXW, MIXW, kt * 64, ntl * 256, T); continue; }
        r -= T_OUT;
        if (r < T_UQ) { const int kt = r / 9, ntl = r % 9; cvt_tile<0>(p.w_uq + (size_t)l * QL * NH * QKD, NH * QKD, NH * QKD, f.w_uq_t + (size_t)l * NH * QKD * QL, QL, kt * 64, ntl * 64, T); continue; }
        r -= T_UQ;
        { const int kt = r / 12, ntl = r % 12; cvt_tile<0>(p.w_ukv + (size_t)l * KVL * NH * 128, NH * 128, NH * 128, f.w_ukv_t + (size_t)l * NH * 128 * KVL, KVL, kt * 64, ntl * 64, T); }
    }
}
__device__ __forceinline__ void cvt_experts_queue(const P& p, const FW& f, int l, unsigned* ctr, char* lds, volatile unsigned* bc) {
    float* T = (float*)lds; constexpr int NGRP = NE * 3 * 16;
    for (;;) {
        __syncthreads();
        if (threadIdx.x == 0) *bc = __hip_atomic_fetch_add(ctr, 1u, __ATOMIC_RELAXED, __HIP_MEMORY_SCOPE_AGENT);
        __syncthreads();
        const int g = (int)*bc; if (g >= NGRP) break;
        const int e = g / 48, which = (g / 16) % 3, kt = g % 16; const size_t le = (size_t)l * NE + e;
#pragma unroll 1
        for (int ntl = 0; ntl < 4; ++ntl) {
            if (which == 0) cvt_strip<1>(p.wg + le * D * FF, FF, FF, f.gu_t + le * 2 * FF * D, D, kt * 64, ntl * 256, T);
            else if (which == 1) cvt_strip<2>(p.wu + le * D * FF, FF, FF, f.gu_t + le * 2 * FF * D, D, kt * 64, ntl * 256, T);
            else cvt_strip<0>(p.wd + le * FF * D, D, D, f.d_t + le * D * FF, FF, kt * 64, ntl * 256, T); }
    }
}
struct UDense { const char* A; unsigned offA[2][2]; const char* B; int pm, pn; };
__device__ __forceinline__ void inproj_phase(const P& p, const FW& f, int l, bf16_t* dst, char* lds) {
    constexpr int NPN = INC_PAD / 256, NU = (M / 256) * NPN;
    auto sched = [&](int i, UDense& u) { const int uu = blockIdx.x + i * gridDim.x; if (uu >= NU) return false; u.pm = uu / NPN; u.pn = uu % NPN; u.A = (const char*)f.hb1; gm::dense_offA(u.offA, (long)u.pm * 256, D);
        u.B = (const char*)(f.w_in_t + ((size_t)l * INC_PAD + u.pn * 256) * D); return true; };
    auto epi = [&](const gm::f32x4 (&acc)[2][2][4][2], const UDense& u, int wr, int wc, int fr, int fq) {
        const int row0 = u.pm * 256 + wr * 64 + fr, col0 = u.pn * 256 + wc * 32 + 8 * fq;
#pragma unroll
        for (int ai = 0; ai < 2; ++ai)
#pragma unroll
            for (int m = 0; m < 4; ++m) { bf16_t* rowp = dst + (size_t)(row0 + ai * 128 + m * 16) * INC_PAD + col0;
#pragma unroll
                for (int bj = 0; bj < 2; ++bj) { const gm::f32x4 v0 = acc[ai][bj][m][0], v1 = acc[ai][bj][m][1];
                    gm::u32x4 w; w.x = gm::cvt_pk_bf16(v0[0], v0[1]); w.y = gm::cvt_pk_bf16(v0[2], v0[3]); w.z = gm::cvt_pk_bf16(v1[0], v1[1]); w.w = gm::cvt_pk_bf16(v1[2], v1[3]);
                    *(gm::u32x4*)(rowp + bj * 128) = w; } } };
    gm::gemm_stream<true, UDense>((GM_LAS unsigned char*)lds, D, sched, epi);
}
template <bool TOX> __device__ __forceinline__ void outproj_phase(const P& p, const FW& f, int l, float* dst, char* lds) {
    constexpr int NPN = D / 256, NU = (M / 256) * NPN;
    auto sched = [&](int i, UDense& u) { const int uu = blockIdx.x + i * gridDim.x; if (uu >= NU) return false; u.pm = uu / NPN; u.pn = uu % NPN; u.A = (const char*)f.mixb; gm::dense_offA(u.offA, (long)u.pm * 256, MIXW);
        u.B = (const char*)(f.w_out_t + ((size_t)l * D + u.pn * 256) * MIXW); return true; };
    auto epi = [&](const gm::f32x4 (&acc)[2][2][4][2], const UDense& u, int wr, int wc, int fr, int fq) {
        const int row0 = u.pm * 256 + wr * 64 + fr, col0 = u.pn * 256 + wc * 32 + 4 * fq; const float* gate = modv(p, l, u.pm * 256, 2);
#pragma unroll
        for (int ai = 0; ai < 2; ++ai)
#pragma unroll
            for (int m = 0; m < 4; ++m) { float* rowp = dst + (size_t)(row0 + ai * 128 + m * 16) * D + col0;
#pragma unroll
                for (int bj = 0; bj < 2; ++bj)
#pragma unroll
                    for (int n = 0; n < 2; ++n) { float* q = rowp + bj * 128 + n * 16;
                        if (TOX) { const gm::f32x4 g = *(const gm::f32x4*)(gate + col0 + bj * 128 + n * 16); const gm::f32x4 x = *(const gm::f32x4*)q; *(gm::f32x4*)q = x + g * acc[ai][bj][m][n]; }
                        else *(gm::f32x4*)q = acc[ai][bj][m][n]; } } };
    gm::gemm_stream<false, UDense>((GM_LAS unsigned char*)lds, MIXW, sched, epi);
}
__device__ __forceinline__ bool moe_find(const int* cnt, int tg, int& e, int& ti, int& c) {
    int acc = 0;
    for (int x = 0; x < NE; ++x) { const int cx = cnt[x]; const int nt = (cx + 255) >> 8; if (tg < acc + nt) { e = x; ti = tg - acc; c = cx; return true; } acc += nt; }
    return false;
}
__device__ __forceinline__ bool moe_find_xcd(const int* cnt, int x, int i, int npn, int& e, int& ti, int& pn, int& c) {
    int acc = 0;
    for (int k = 0; k < NE / 8; ++k) { const int ee = x + 8 * k; const int cx = cnt[ee]; const int nu = ((cx + 255) >> 8) * npn; if (i < acc + nu) { const int r = i - acc; e = ee; ti = r / npn; pn = r % npn; c = cx; return true; } acc += nu; }
    return false;
}
__device__ __forceinline__ int moe_tiles(const int* cnt) { int acc = 0; for (int x = 0; x < NE; ++x) acc += (cnt[x] + 255) >> 8; return acc; }
template <bool SRC_TOK> __device__ __forceinline__ void gather_offA(unsigned (&offA)[2][2], const int* lst, int base, int cnt, int K) {
    int tid = threadIdx.x; asm volatile("" : "+v"(tid));
#pragma unroll
    for (int i = 0; i < 2; ++i) { int R, C; gm::stage_rc(tid * 16 + i * 8192, R, C);
#pragma unroll
        for (int h = 0; h < 2; ++h) { const int s = base + h * 128 + R; int a = s < cnt ? lst[s] : 0; if (SRC_TOK) a >>= 2; offA[h][i] = (unsigned)(((size_t)a * K + C) * 2); } }
}
__device__ __forceinline__ void moe1_phase(const P& p, const FW& f, int l, char* lds) {
    constexpr int NPN = 2 * FF / 256; const int NU = moe_tiles(p.cnt) * NPN;
    for (int u = blockIdx.x; u < NU; u += gridDim.x) {
        int e, ti, cnt; if (!moe_find(p.cnt, u / NPN, e, ti, cnt)) break; const int pn = u % NPN; const int* lst = p.list + (size_t)e * M; const size_t le = (size_t)l * NE + e;
        unsigned offA[2][2]; gather_offA<true>(offA, lst, ti * 256, cnt, D);
        auto epi = [&](const gm::f32x4 (&acc)[2][2][4][2], int wr, int wc, int fr, int fq) {
            const int ff0 = pn * 128 + wc * 32 + 8 * fq; const float* bgp = p.bg + le * FF + ff0; const float* bup = p.bu + le * FF + ff0;
            const gm::f32x4 bg0 = *(const gm::f32x4*)bgp, bg1 = *(const gm::f32x4*)(bgp + 4), bu0 = *(const gm::f32x4*)bup, bu1 = *(const gm::f32x4*)(bup + 4);
#pragma unroll
            for (int ai = 0; ai < 2; ++ai)
#pragma unroll
                for (int m = 0; m < 4; ++m) { const int s = ti * 256 + ai * 128 + wr * 64 + m * 16 + fr; if (s < cnt) { const int a = lst[s]; float o[8];
#pragma unroll
                        for (int n = 0; n < 2; ++n)
#pragma unroll
                            for (int j = 0; j < 4; ++j) { float g = acc[ai][0][m][n][j] + (n ? bg1[j] : bg0[j]); float uu = acc[ai][1][m][n][j] + (n ? bu1[j] : bu0[j]);
                                g = g < 7.0f ? g : 7.0f; uu = uu < -7.0f ? -7.0f : (uu > 7.0f ? 7.0f : uu); o[n * 4 + j] = g * (1.0f / (1.0f + __expf(-1.702f * g))) * (uu + 1.0f); }
                        gm::u32x4 w; w.x = gm::cvt_pk_bf16(o[0], o[1]); w.y = gm::cvt_pk_bf16(o[2], o[3]); w.z = gm::cvt_pk_bf16(o[4], o[5]); w.w = gm::cvt_pk_bf16(o[6], o[7]);
                        *(gm::u32x4*)(f.actb + (size_t)a * FF + ff0) = w; } } };
        gm::gemm_unit<true>((GM_LAS unsigned char*)lds, (const char*)f.hb2, offA, (const char*)(f.gu_t + (le * 2 * FF + pn * 256) * D), D, epi);
    }
}
__device__ __forceinline__ void moe2_phase(const P& p, const FW& f, int l, char* lds) {
    constexpr int NPN = D / 256; const int NU = moe_tiles(p.cnt) * NPN;
    for (int u = blockIdx.x; u < NU; u += gridDim.x) {
        int e, ti, cnt; if (!moe_find(p.cnt, u / NPN, e, ti, cnt)) break; const int pn = u % NPN; const int* lst = p.list + (size_t)e * M; const size_t le = (size_t)l * NE + e;
        unsigned offA[2][2]; gather_offA<false>(offA, lst, ti * 256, cnt, FF);
        auto epi = [&](const gm::f32x4 (&acc)[2][2][4][2], int wr, int wc, int fr, int fq) {
#pragma unroll
            for (int bj = 0; bj < 2; ++bj) { const int c0 = pn * 256 + bj * 128 + wc * 32 + 8 * fq; const float* bp = p.bd + le * D + c0; const gm::f32x4 b0 = *(const gm::f32x4*)bp, b1 = *(const gm::f32x4*)(bp + 4);
#pragma unroll
                for (int ai = 0; ai < 2; ++ai)
#pragma unroll
                    for (int m = 0; m < 4; ++m) { const int s = ti * 256 + ai * 128 + wr * 64 + m * 16 + fr; if (s < cnt) { const int a = lst[s];
                            const gm::f32x4 v0 = acc[ai][bj][m][0] + b0, v1 = acc[ai][bj][m][1] + b1;
                            gm::u32x4 w; w.x = gm::cvt_pk_bf16(v0[0], v0[1]); w.y = gm::cvt_pk_bf16(v0[2], v0[3]); w.z = gm::cvt_pk_bf16(v1[0], v1[1]); w.w = gm::cvt_pk_bf16(v1[2], v1[3]);
                            *(gm::u32x4*)(f.yb + (size_t)a * D + c0) = w; } } } };
        gm::gemm_unit<true>((GM_LAS unsigned char*)lds, (const char*)f.actb, offA, (const char*)(f.d_t + (le * D + pn * 256) * FF), FF, epi);
    }
}

namespace rw {
typedef float f32x4 __attribute__((ext_vector_type(4)));
typedef unsigned u32x2 __attribute__((ext_vector_type(2)));
constexpr int ROWS_PB = 65;
__device__ __forceinline__ float wave_sum(float v) {
#pragma unroll
    for (int o = 32; o >= 1; o >>= 1) v += __shfl_xor(v, o);
    return v;
}
__device__ __forceinline__ unsigned pk2(float lo, float hi) { unsigned r; asm volatile("v_cvt_pk_bf16_f32 %0, %1, %2" : "=v"(r) : "v"(lo), "v"(hi)); return r; }
__device__ __forceinline__ float ld1(const bf16_t* q) { return __uint_as_float(((unsigned)*q) << 16); }
__device__ __forceinline__ f32x4 bf4(u32x2 w) { f32x4 r; r[0] = __uint_as_float(w.x << 16); r[1] = __uint_as_float(w.x & 0xffff0000u); r[2] = __uint_as_float(w.y << 16); r[3] = __uint_as_float(w.y & 0xffff0000u); return r; }
__device__ __forceinline__ f32x4 ld4(const bf16_t* q) { return bf4(*(const u32x2*)q); }
__device__ __forceinline__ void norm_store(const f32x4 (&x)[4], const float* g, const float* shift, const float* scale, bf16_t* dst, int lane) {
    float ss = 0.f;
#pragma unroll
    for (int j = 0; j < 4; ++j) ss += x[j][0] * x[j][0] + x[j][1] * x[j][1] + x[j][2] * x[j][2] + x[j][3] * x[j][3];
    ss = wave_sum(ss); const float rs = 1.0f / sqrtf(ss * (1.0f / D) + EPS);
#pragma unroll
    for (int j = 0; j < 4; ++j) { const int c = 4 * lane + 256 * j; const f32x4 gv = *(const f32x4*)(g + c), sh = *(const f32x4*)(shift + c), sc = *(const f32x4*)(scale + c);
        const f32x4 o = x[j] * rs * gv * (1.0f + sc) + sh; u32x2 w; w.x = pk2(o[0], o[1]); w.y = pk2(o[2], o[3]); *(u32x2*)(dst + c) = w; }
}
__device__ __forceinline__ void first_norm_phase(const P& p) {
    int tid = threadIdx.x; asm volatile("" : "+v"(tid)); const int wid = tid >> 6, lane = tid & 63;
    for (int i = wid; i < ROWS_PB; i += 8) { const int r = blockIdx.x * ROWS_PB + i; if (r >= M) break;
        const float* src = r < CTX ? p.ctx + (size_t)r * D : p.x + (size_t)(r - CTX) * D; f32x4 x[4];
#pragma unroll
        for (int j = 0; j < 4; ++j) { x[j] = *(const f32x4*)(src + 4 * lane + 256 * j); *(f32x4*)(p.xres + (size_t)r * D + 4 * lane + 256 * j) = x[j]; }
        norm_store(x, p.norm1_g, modv(p, 0, r, 0), modv(p, 0, r, 1), p.hb1 + (size_t)r * D, lane); }
}
template <bool DRY = false> __device__ __forceinline__ void combine_phase(const P& p, int l) {
    int tid = threadIdx.x; asm volatile("" : "+v"(tid)); const int wid = tid >> 6, lane = tid & 63;
    for (int i = wid; i < ROWS_PB; i += 8) { const int r = blockIdx.x * ROWS_PB + i; if (r >= M) break;
        const f32x4 tw = *(const f32x4*)(p.topw + (size_t)r * 4); const float* gate = modv(p, l, r, 5); f32x4 x[4];
#pragma unroll
        for (int j = 0; j < 4; ++j) { const int c = 4 * lane + 256 * j; f32x4 s = {0.f, 0.f, 0.f, 0.f};
#pragma unroll
            for (int k = 0; k < 4; ++k) s += bf4(*(const u32x2*)(p.ybn + ((size_t)r * 4 + k) * D + c)) * tw[k];
            x[j] = *(const f32x4*)(p.xres + (size_t)r * D + c) + *(const f32x4*)(gate + c) * s; }
        if (l + 1 < DEPTH) {
#pragma unroll
            for (int j = 0; j < 4; ++j) if (!DRY) *(f32x4*)(p.xres + (size_t)r * D + 4 * lane + 256 * j) = x[j];
            norm_store(x, p.norm1_g + (size_t)(l + 1) * D, modv(p, l + 1, r, 0), modv(p, l + 1, r, 1), p.hb1 + (size_t)r * D, lane);
        } else if (r >= CTX) {
#pragma unroll
            for (int j = 0; j < 4; ++j) *(f32x4*)(p.out + (size_t)(r - CTX) * D + 4 * lane + 256 * j) = x[j];
        } }
}
template <bool DRY = false> __device__ __forceinline__ void router_phase(const P& p, int l, char* lds) {
    int tid = threadIdx.x; asm volatile("" : "+v"(tid)); const int wid = tid >> 6, lane = tid & 63;
    float* WT = (float*)lds; float* bias2 = WT + 32 * 1024; int* lcnt = (int*)(bias2 + 64); int* lbase = lcnt + 32; int* rec = lbase + 32;
    const float* rwp = p.router_w + (size_t)l * D * NE;
    for (int i = tid; i < D * NE / 4; i += 512) { const int k = i >> 3, e4 = i & 7; const f32x4 v = *(const f32x4*)(rwp + (size_t)k * NE + e4 * 4);
#pragma unroll
        for (int q = 0; q < 4; ++q) WT[(e4 * 4 + q) * 1024 + (k ^ (e4 << 2))] = v[q]; }
    if (tid < 32) lcnt[tid] = 0;
    __syncthreads();
    {
#pragma unroll
        for (int v = 0; v < 2; ++v) { const float* sh = p.mod + ((size_t)(l * 2 + v) * 6 + 3) * D; f32x4 s[4];
#pragma unroll
            for (int j = 0; j < 4; ++j) s[j] = *(const f32x4*)(sh + 4 * lane + 256 * j);
#pragma unroll
            for (int q = 0; q < 4; ++q) { const int e = wid * 4 + q; float a = 0.f;
#pragma unroll
                for (int j = 0; j < 4; ++j) { const f32x4 w = *(const f32x4*)(WT + e * 1024 + ((4 * lane + 256 * j) ^ (((e >> 2) & 7) << 2))); a += w[0] * s[j][0] + w[1] * s[j][1] + w[2] * s[j][2] + w[3] * s[j][3]; }
                a = wave_sum(a); if (lane == 0) bias2[v * 32 + e] = a + p.router_b[l * NE + e]; } }
    }
    __syncthreads();
    const float* g2 = p.norm2_g + (size_t)l * D;
    for (int rp = wid; rp < (ROWS_PB + 1) / 2; rp += 8) {
        float acc[2][32]; float rsv[2]; int rr[2];
        f32x4 xg[2][4];
#pragma unroll
        for (int q = 0; q < 2; ++q) { const int il = 2 * rp + q; const int r = blockIdx.x * ROWS_PB + (il < ROWS_PB ? il : ROWS_PB - 1); rr[q] = r;
            const float* sc = modv(p, l, r, 4); const float* sh = modv(p, l, r, 3); float ss = 0.f; f32x4 x[4];
#pragma unroll
            for (int j = 0; j < 4; ++j) { x[j] = *(const f32x4*)(p.xres + (size_t)r * D + 4 * lane + 256 * j); ss += x[j][0] * x[j][0] + x[j][1] * x[j][1] + x[j][2] * x[j][2] + x[j][3] * x[j][3]; }
            ss = wave_sum(ss); const float rs = 1.0f / sqrtf(ss * (1.0f / D) + EPS); rsv[q] = rs;
#pragma unroll
            for (int j = 0; j < 4; ++j) { const int c = 4 * lane + 256 * j; xg[q][j] = x[j] * *(const f32x4*)(g2 + c) * (1.0f + *(const f32x4*)(sc + c));
                const f32x4 o = xg[q][j] * rs + *(const f32x4*)(sh + c); u32x2 w; w.x = pk2(o[0], o[1]); w.y = pk2(o[2], o[3]); if (il < ROWS_PB) *(u32x2*)(p.hb2 + (size_t)r * D + c) = w; }
        }
#pragma unroll
        for (int e = 0; e < 32; ++e) { float a0 = 0.f, a1 = 0.f;
#pragma unroll
            for (int j = 0; j < 4; ++j) { const f32x4 w = *(const f32x4*)(WT + e * 1024 + ((4 * lane + 256 * j) ^ (((e >> 2) & 7) << 2)));
                a0 += w[0] * xg[0][j][0] + w[1] * xg[0][j][1] + w[2] * xg[0][j][2] + w[3] * xg[0][j][3]; a1 += w[0] * xg[1][j][0] + w[1] * xg[1][j][1] + w[2] * xg[1][j][2] + w[3] * xg[1][j][3]; }
            acc[0][e] = a0; acc[1][e] = a1; }
        float v[64];
#pragma unroll
        for (int e = 0; e < 32; ++e) { v[e] = acc[0][e]; v[32 + e] = acc[1][e]; }
#pragma unroll
        for (int m = 32, n = 64; m >= 1; m >>= 1, n >>= 1) {
#pragma unroll
            for (int i = 0; i < n / 2; ++i) { const bool up = (lane & m) != 0; const float keep = up ? v[i + n / 2] : v[i], send = up ? v[i] : v[i + n / 2]; v[i] = keep + __shfl_xor(send, m); } }
        const int q = lane >> 5, e = lane & 31; const int r = rr[q]; const int il = 2 * rp + q;
        float logit = v[0] * rsv[q] + bias2[(r < CTX ? 32 : 0) + e];
        float cur = logit; int sel[4]; float sv[4];
#pragma unroll
        for (int k = 0; k < 4; ++k) { float mx = cur;
#pragma unroll
            for (int o = 16; o >= 1; o >>= 1) mx = fmaxf(mx, __shfl_xor(mx, o));
            const unsigned long long bal = __ballot(cur == mx); const unsigned half = (unsigned)(bal >> (q * 32)); const int win = __ffs(half) - 1;
            sel[k] = win; sv[k] = mx; if (e == win) cur = -3.0e38f; }
        if (e < 4 && il < ROWS_PB) {
            float es[4], sum = 0.f;
#pragma unroll
            for (int k = 0; k < 4; ++k) { es[k] = __expf(sv[k] - sv[0]); sum += es[k]; }
            const int myk = e; const int mye = myk == 0 ? sel[0] : myk == 1 ? sel[1] : myk == 2 ? sel[2] : sel[3]; const float myw = (myk == 0 ? es[0] : myk == 1 ? es[1] : myk == 2 ? es[2] : es[3]) / sum;
            if (!DRY) p.topw[(size_t)r * 4 + myk] = myw; const int pos = atomicAdd(&lcnt[mye], 1); rec[il * 4 + myk] = mye | (pos << 8);
        }
    }
    __syncthreads();
    if (tid < 32) lbase[tid] = DRY ? 0 : atomicAdd(&p.cnt[tid], lcnt[tid]);
    __syncthreads();
    if (tid < ROWS_PB * 4) { const int il = tid >> 2, k = tid & 3; const int r = blockIdx.x * ROWS_PB + il; const int rc = rec[tid]; const int e = rc & 255, pos = rc >> 8;
        if (!DRY) p.list[(size_t)e * M + lbase[e] + pos] = r * 4 + k; }
    __syncthreads();
}
}

namespace ml {
typedef short bf16x8 __attribute__((ext_vector_type(8)));
typedef float f32x4 __attribute__((ext_vector_type(4)));
typedef unsigned u32x2 __attribute__((ext_vector_type(2)));
constexpr int RB = 65, MT = 5;
constexpr int AQ_STRIDE = QL * 2 + 16, AKV_STRIDE = KVL * 2 + 16;
constexpr int OFF_AQ = 0, OFF_AKV = OFF_AQ + 80 * AQ_STRIDE, OFF_KRS = OFF_AKV + 80 * AKV_STRIDE, OFF_KSS = OFF_KRS + 80 * 32 * 4, LDS_MLA = OFF_KSS + 80 * 4;
struct MW { const bf16_t* w_uq_t; const bf16_t* w_ukv_t; const float* ropec; const float* ropes; const bf16_t* proj; int ldp; bf16_t* qb; bf16_t* kb; bf16_t* vb; };
__device__ __forceinline__ void mla_phase(const P& p, const MW& w, int l, char* lds) {
    int tid = threadIdx.x; asm volatile("" : "+v"(tid)); const int wid = __builtin_amdgcn_readfirstlane(tid >> 6), lane = tid & 63, fr = lane & 15, fq = lane >> 4;
    const int row0 = blockIdx.x * RB;
    for (int i = wid; i < 80; i += 8) {
        char* aq = lds + OFF_AQ + i * AQ_STRIDE; char* akv = lds + OFF_AKV + i * AKV_STRIDE; float* krs = (float*)(lds + OFF_KRS) + i * 32;
        if (i < RB && row0 + i < M) { const bf16_t* pr = w.proj + (size_t)(row0 + i) * w.ldp;
            { const f32x4 x = rw::ld4(pr + C_Q + 4 * lane); float ss = rw::wave_sum(x[0] * x[0] + x[1] * x[1] + x[2] * x[2] + x[3] * x[3]); const float rs = 1.0f / sqrtf(ss * (1.0f / QL) + EPS);
              const f32x4 g = *(const f32x4*)(p.q_g + l * QL + 4 * lane); const f32x4 o = x * rs * g; u32x2 v; v.x = rw::pk2(o[0], o[1]); v.y = rw::pk2(o[2], o[3]); *(u32x2*)(aq + 8 * lane) = v; }
            { f32x4 x = {0.f, 0.f, 0.f, 0.f}; if (lane < 32) x = rw::ld4(pr + C_KV + 4 * lane); float ss = rw::wave_sum(x[0] * x[0] + x[1] * x[1] + x[2] * x[2] + x[3] * x[3]); const float rs = 1.0f / sqrtf(ss * (1.0f / KVL) + EPS);
              if (lane < 32) { const f32x4 g = *(const f32x4*)(p.kv_g + l * KVL + 4 * lane); const f32x4 o = x * rs * g; u32x2 v; v.x = rw::pk2(o[0], o[1]); v.y = rw::pk2(o[2], o[3]); *(u32x2*)(akv + 8 * lane) = v; } }
            { f32x4 x = {0.f, 0.f, 0.f, 0.f}; if (lane < 8) { x = rw::ld4(pr + C_KR + 4 * lane); *(f32x4*)(krs + 4 * lane) = x; }
              const float ss = rw::wave_sum(x[0] * x[0] + x[1] * x[1] + x[2] * x[2] + x[3] * x[3]); if (lane == 0) ((float*)(lds + OFF_KSS))[i] = ss; }
        } else {
            u32x2 z; z.x = 0u; z.y = 0u; *(u32x2*)(aq + 8 * lane) = z; if (lane < 32) *(u32x2*)(akv + 8 * lane) = z; if (lane < 32) krs[lane] = 0.f; if (lane == 0) ((float*)(lds + OFF_KSS))[i] = 0.f;
        }
    }
    __syncthreads();
    if (wid < 6) {
        const int hh = wid; f32x4 acc[MT][6];
#pragma unroll
        for (int mt = 0; mt < MT; ++mt)
#pragma unroll
            for (int nt = 0; nt < 6; ++nt) acc[mt][nt] = (f32x4){0.f, 0.f, 0.f, 0.f};
        const bf16_t* wb = w.w_uq_t + (size_t)(hh * QKD + fr) * QL + 8 * fq;
#pragma unroll 1
        for (int ks = 0; ks < QL / 32; ++ks) { bf16x8 b[6], a[MT];
#pragma unroll
            for (int nt = 0; nt < 6; ++nt) b[nt] = *(const bf16x8*)(wb + (size_t)nt * 16 * QL + ks * 32);
#pragma unroll
            for (int mt = 0; mt < MT; ++mt) a[mt] = *(const bf16x8*)(lds + OFF_AQ + (mt * 16 + fr) * AQ_STRIDE + (ks * 32 + 8 * fq) * 2);
#pragma unroll
            for (int mt = 0; mt < MT; ++mt)
#pragma unroll
                for (int nt = 0; nt < 6; ++nt) acc[mt][nt] = __builtin_amdgcn_mfma_f32_16x16x32_bf16(b[nt], a[mt], acc[mt][nt], 0, 0, 0); }
        f32x4 gq[6];
#pragma unroll
        for (int nt = 0; nt < 6; ++nt) gq[nt] = *(const f32x4*)(p.qn_g + l * QKD + nt * 16 + 4 * fq);
#pragma unroll
        for (int mt = 0; mt < MT; ++mt) { const int il = mt * 16 + fr; const int r = row0 + il; const bool ok = il < RB && r < M; float ss = 0.f;
#pragma unroll
            for (int nt = 0; nt < 6; ++nt) ss += acc[mt][nt][0] * acc[mt][nt][0] + acc[mt][nt][1] * acc[mt][nt][1] + acc[mt][nt][2] * acc[mt][nt][2] + acc[mt][nt][3] * acc[mt][nt][3];
            ss += __shfl_xor(ss, 16); ss += __shfl_xor(ss, 32); const float rs = 1.0f / sqrtf(ss * (1.0f / QKD) + EPS);
            const bool lat = r >= CTX; const int t = lat ? r - CTX : 0;
#pragma unroll
            for (int nt = 0; nt < 6; ++nt) { f32x4 v = acc[mt][nt] * (rs * at::QSCALE) * gq[nt];
                if (nt >= 4) { f32x4 other; other[0] = __shfl_xor(v[0], 32); other[1] = __shfl_xor(v[1], 32); other[2] = __shfl_xor(v[2], 32); other[3] = __shfl_xor(v[3], 32);
                    if (lat && ok) { const int pos = (nt == 4) ? (t / GRID_W) : (t % GRID_W); const f32x4 cs = *(const f32x4*)(w.ropec + (size_t)pos * 8 + 4 * (fq & 1)), sn = *(const f32x4*)(w.ropes + (size_t)pos * 8 + 4 * (fq & 1));
                        v = (fq >> 1) ? (v * cs + other * sn) : (v * cs - other * sn); } }
                if (ok) { u32x2 o; o.x = rw::pk2(v[0], v[1]); o.y = rw::pk2(v[2], v[3]); *(u32x2*)(w.qb + ((size_t)r * NH + hh) * QKD + nt * 16 + 4 * fq) = o; } } }
    } else {
        for (int hs = 0; hs < 3; ++hs) { const int hh = (wid - 6) * 3 + hs;
#pragma unroll
          for (int pass = 0; pass < 2; ++pass) { f32x4 acc[MT][4];
#pragma unroll
            for (int mt = 0; mt < MT; ++mt)
#pragma unroll
                for (int nt = 0; nt < 4; ++nt) acc[mt][nt] = (f32x4){0.f, 0.f, 0.f, 0.f};
            const bf16_t* wb = w.w_ukv_t + (size_t)(hh * 128 + pass * 64 + fr) * KVL + 8 * fq;
#pragma unroll 1
            for (int ks = 0; ks < KVL / 32; ++ks) { bf16x8 b[4], a[MT];
#pragma unroll
                for (int nt = 0; nt < 4; ++nt) b[nt] = *(const bf16x8*)(wb + (size_t)nt * 16 * KVL + ks * 32);
#pragma unroll
                for (int mt = 0; mt < MT; ++mt) a[mt] = *(const bf16x8*)(lds + OFF_AKV + (mt * 16 + fr) * AKV_STRIDE + (ks * 32 + 8 * fq) * 2);
#pragma unroll
                for (int mt = 0; mt < MT; ++mt)
#pragma unroll
                    for (int nt = 0; nt < 4; ++nt) acc[mt][nt] = __builtin_amdgcn_mfma_f32_16x16x32_bf16(b[nt], a[mt], acc[mt][nt], 0, 0, 0); }
            if (pass == 0) {
                f32x4 gk[4], gr[2], gro[2];
#pragma unroll
                for (int nt = 0; nt < 4; ++nt) gk[nt] = *(const f32x4*)(p.kn_g + l * QKD + nt * 16 + 4 * fq);
#pragma unroll
                for (int a = 0; a < 2; ++a) { gr[a] = *(const f32x4*)(p.kn_g + l * QKD + NOPE + a * 16 + 4 * fq); gro[a] = *(const f32x4*)(p.kn_g + l * QKD + NOPE + a * 16 + ((4 * fq) ^ 8)); }
#pragma unroll
                for (int mt = 0; mt < MT; ++mt) { const int il = mt * 16 + fr; const int r = row0 + il; const bool ok = il < RB && r < M; float ss = 0.f;
#pragma unroll
                    for (int nt = 0; nt < 4; ++nt) ss += acc[mt][nt][0] * acc[mt][nt][0] + acc[mt][nt][1] * acc[mt][nt][1] + acc[mt][nt][2] * acc[mt][nt][2] + acc[mt][nt][3] * acc[mt][nt][3];
                    ss += __shfl_xor(ss, 16); ss += __shfl_xor(ss, 32); ss += ((const float*)(lds + OFF_KSS))[il]; const float rs = 1.0f / sqrtf(ss * (1.0f / QKD) + EPS);
                    const bool lat = r >= CTX; const int t = lat ? r - CTX : 0;
                    if (ok) {
                        bf16_t* kd = w.kb + ((size_t)r * NH + hh) * QKD; const float* krs = (const float*)(lds + OFF_KRS) + il * 32;
#pragma unroll
                        for (int nt = 0; nt < 4; ++nt) { const f32x4 v = acc[mt][nt] * rs * gk[nt]; u32x2 o; o.x = rw::pk2(v[0], v[1]); o.y = rw::pk2(v[2], v[3]); *(u32x2*)(kd + nt * 16 + 4 * fq) = o; }
#pragma unroll
                        for (int a = 0; a < 2; ++a) { f32x4 v = *(const f32x4*)(krs + a * 16 + 4 * fq) * rs * gr[a]; const f32x4 other = *(const f32x4*)(krs + a * 16 + ((4 * fq) ^ 8)) * rs * gro[a];
                            if (lat) { const int pos = (a == 0) ? (t / GRID_W) : (t % GRID_W); const f32x4 cs = *(const f32x4*)(w.ropec + (size_t)pos * 8 + 4 * (fq & 1)), sn = *(const f32x4*)(w.ropes + (size_t)pos * 8 + 4 * (fq & 1));
                                v = (fq >> 1) ? (v * cs + other * sn) : (v * cs - other * sn); }
                            u32x2 o; o.x = rw::pk2(v[0], v[1]); o.y = rw::pk2(v[2], v[3]); *(u32x2*)(kd + NOPE + a * 16 + 4 * fq) = o; }
                    } }
            } else {
#pragma unroll
                for (int mt = 0; mt < MT; ++mt) { const int il = mt * 16 + fr; const int r = row0 + il; const bool ok = il < RB && r < M;
                    if (ok) { bf16_t* vd = w.vb + ((size_t)r * NH + hh) * VD;
#pragma unroll
                        for (int nt = 0; nt < 4; ++nt) { const f32x4 v = acc[mt][nt]; u32x2 o; o.x = rw::pk2(v[0], v[1]); o.y = rw::pk2(v[2], v[3]); *(u32x2*)(vd + nt * 16 + 4 * fq) = o; } } }
            }
          }
        }
    }
    __syncthreads();
}
}

namespace sd {
typedef short bf16x8 __attribute__((ext_vector_type(8)));
typedef float f32x4 __attribute__((ext_vector_type(4)));
typedef unsigned u32x2 __attribute__((ext_vector_type(2)));
typedef unsigned u32x4 __attribute__((ext_vector_type(4)));
constexpr int SBS = 144, STS = 272;
constexpr int OFF_BM = 0, OFF_CM = OFF_BM + 128 * SBS, OFF_XT = OFF_CM + 128 * SBS, OFF_BTF = OFF_XT + 64 * STS, OFF_BTB = OFF_BTF + 64 * STS, OFF_L = OFF_BTB + 64 * STS, OFF_SC = OFF_L + 128 * STS, LDS_SSD = OFF_SC + 4 * 128 * 4;
struct SsdW { const bf16_t* proj; int ldp; float* yd; float* st; float* cdec; float* cs; bf16_t* cg; bf16_t* prevb; };
__device__ __forceinline__ bf16x8 ldfrag(const char* base, int row, int stride, int kbyte) { return *(const bf16x8*)(base + row * stride + kbyte); }
__device__ __forceinline__ float silu_f(float x) { return x / (1.0f + __expf(-x)); }
__device__ __forceinline__ void chunk_unit(const P& p, const SsdW& w, int l, int c, int hh, char* lds) {
    int tid = threadIdx.x; asm volatile("" : "+v"(tid)); const int wid = __builtin_amdgcn_readfirstlane(tid >> 6), lane = tid & 63, fr = lane & 15, fq = lane >> 4;
    const int R0 = c * CHUNK, g = hh / (SH / SG); const int seg0 = R0 < CTX ? 0 : CTX, seg1 = R0 < CTX ? CTX : M;
    float* csf = (float*)(lds + OFF_SC); float* csb = csf + 128; float* dtf = csb + 128; float* dtb = dtf + 128;
    if (tid < 256) { const int r = tid & 127, d = tid >> 7; const float v = softplusf(rw::ld1(w.proj + (size_t)(R0 + r) * w.ldp + C_DT + d * 6 + hh) + p.dt_bias[l * 12 + d * 6 + hh]); (d ? dtb : dtf)[r] = v; }
    __syncthreads();
    if (wid < 2) {
        const int d = wid; const float a = -__expf(p.a_log[l * 12 + d * 6 + hh]); const float* dts = d ? dtb : dtf; float* cso = d ? csb : csf;
        const int i0 = 2 * lane, i1 = 2 * lane + 1; const int r0 = d ? 127 - i0 : i0, r1 = d ? 127 - i1 : i1;
        const float v0 = dts[r0] * a, v1 = dts[r1] * a; float s = v0 + v1;
#pragma unroll
        for (int o = 1; o < 64; o <<= 1) { const float t = __shfl_up(s, o); if (lane >= o) s += t; }
        const float excl = s - (v0 + v1); const float c0 = excl + v0, c1 = c0 + v1; cso[r0] = c0; cso[r1] = c1;
        w.cs[((size_t)d * M + R0 + r0) * SH + hh] = c0; w.cs[((size_t)d * M + R0 + r1) * SH + hh] = c1;
        if (lane == 63) w.cdec[((size_t)d * NCH + c) * SH + hh] = __expf(c1);
    }
    __syncthreads();
    {   const int col = tid & 63, l0 = (tid >> 6) * 16; const float cfe = csf[127], cbe = csb[0];
#pragma unroll
        for (int which = 0; which < 3; ++which) { const int cidx = which == 0 ? hh * SP + col : (which == 1 ? SW + g * SN + col : SW + SG * SN + g * SN + col);
            const float w0 = p.conv_w[((size_t)l * 4 + 0) * CONVD + cidx], w1 = p.conv_w[((size_t)l * 4 + 1) * CONVD + cidx], w2 = p.conv_w[((size_t)l * 4 + 2) * CONVD + cidx], w3 = p.conv_w[((size_t)l * 4 + 3) * CONVD + cidx], bb = p.conv_b[l * CONVD + cidx];
            float v[19];
#pragma unroll
            for (int i = 0; i < 19; ++i) { const int r = R0 + l0 - 2 + i; v[i] = (r >= seg0 && r < seg1) ? rw::ld1(w.proj + (size_t)r * w.ldp + C_XBC + cidx) : 0.f; }
            float y[16];
#pragma unroll
            for (int i = 0; i < 16; ++i) y[i] = silu_f(bb + w0 * v[i] + w1 * v[i + 1] + w2 * v[i + 2] + w3 * v[i + 3]);
            if (which == 0) {
                u32x4 a, b; a.x = rw::pk2(y[0], y[1]); a.y = rw::pk2(y[2], y[3]); a.z = rw::pk2(y[4], y[5]); a.w = rw::pk2(y[6], y[7]); b.x = rw::pk2(y[8], y[9]); b.y = rw::pk2(y[10], y[11]); b.z = rw::pk2(y[12], y[13]); b.w = rw::pk2(y[14], y[15]);
                *(u32x4*)(lds + OFF_XT + col * STS + l0 * 2) = a; *(u32x4*)(lds + OFF_XT + col * STS + l0 * 2 + 16) = b;
            } else if (which == 1) {
                float yf[16], yb[16];
#pragma unroll
                for (int i = 0; i < 16; ++i) { *(bf16_t*)(lds + OFF_BM + (l0 + i) * SBS + col * 2) = f2bf(y[i]); yf[i] = y[i] * __expf(cfe - csf[l0 + i]) * dtf[l0 + i]; yb[i] = y[i] * __expf(cbe - csb[l0 + i]) * dtb[l0 + i]; }
                u32x4 a, b; a.x = rw::pk2(yf[0], yf[1]); a.y = rw::pk2(yf[2], yf[3]); a.z = rw::pk2(yf[4], yf[5]); a.w = rw::pk2(yf[6], yf[7]); b.x = rw::pk2(yf[8], yf[9]); b.y = rw::pk2(yf[10], yf[11]); b.z = rw::pk2(yf[12], yf[13]); b.w = rw::pk2(yf[14], yf[15]);
                *(u32x4*)(lds + OFF_BTF + col * STS + l0 * 2) = a; *(u32x4*)(lds + OFF_BTF + col * STS + l0 * 2 + 16) = b;
                a.x = rw::pk2(yb[0], yb[1]); a.y = rw::pk2(yb[2], yb[3]); a.z = rw::pk2(yb[4], yb[5]); a.w = rw::pk2(yb[6], yb[7]); b.x = rw::pk2(yb[8], yb[9]); b.y = rw::pk2(yb[10], yb[11]); b.z = rw::pk2(yb[12], yb[13]); b.w = rw::pk2(yb[14], yb[15]);
                *(u32x4*)(lds + OFF_BTB + col * STS + l0 * 2) = a; *(u32x4*)(lds + OFF_BTB + col * STS + l0 * 2 + 16) = b;
            } else {
#pragma unroll
                for (int i = 0; i < 16; ++i) { const bf16_t cv = f2bf(y[i]); *(bf16_t*)(lds + OFF_CM + (l0 + i) * SBS + col * 2) = cv; if (hh % (SH / SG) == 0) w.cg[((size_t)(R0 + l0 + i) * SG + g) * SN + col] = cv; }
            } }
    }
    __syncthreads();
    {   const int lt = wid, lrow = 16 * lt + fr; const bf16x8 c0 = ldfrag(lds + OFF_CM, lrow, SBS, 16 * fq), c1 = ldfrag(lds + OFF_CM, lrow, SBS, 64 + 16 * fq);
        const float cfl = csf[lrow], cbl = csb[lrow], Dh = p.ssd_d[l * SH + hh];
#pragma unroll
        for (int st = 0; st < 8; ++st) { const bf16x8 b0 = ldfrag(lds + OFF_BM, 16 * st + fr, SBS, 16 * fq), b1 = ldfrag(lds + OFF_BM, 16 * st + fr, SBS, 64 + 16 * fq);
            f32x4 acc = {0.f, 0.f, 0.f, 0.f}; acc = __builtin_amdgcn_mfma_f32_16x16x32_bf16(b0, c0, acc, 0, 0, 0); acc = __builtin_amdgcn_mfma_f32_16x16x32_bf16(b1, c1, acc, 0, 0, 0);
            const int s0 = 16 * st + 4 * fq; const f32x4 cfs = *(const f32x4*)(csf + s0), cbs = *(const f32x4*)(csb + s0), dfs = *(const f32x4*)(dtf + s0), dbs = *(const f32x4*)(dtb + s0); float o[4];
#pragma unroll
            for (int j = 0; j < 4; ++j) { const int s = s0 + j; const float ef = s <= lrow ? __expf(fminf(cfl - cfs[j], 0.f)) * dfs[j] : 0.f; const float eb = s >= lrow ? __expf(fminf(cbl - cbs[j], 0.f)) * dbs[j] : 0.f;
                o[j] = acc[j] * (ef + eb) + (s == lrow ? Dh : 0.f); }
            u32x2 pk; pk.x = rw::pk2(o[0], o[1]); pk.y = rw::pk2(o[2], o[3]); *(u32x2*)(lds + OFF_L + lrow * STS + s0 * 2) = pk; }
    }
    __syncthreads();
    {   const int lt = wid, lrow = 16 * lt + fr; bf16x8 lf[4];
#pragma unroll
        for (int ks = 0; ks < 4; ++ks) lf[ks] = ldfrag(lds + OFF_L, lrow, STS, 64 * ks + 16 * fq);
#pragma unroll
        for (int pt = 0; pt < 4; ++pt) { f32x4 acc = {0.f, 0.f, 0.f, 0.f};
#pragma unroll
            for (int ks = 0; ks < 4; ++ks) acc = __builtin_amdgcn_mfma_f32_16x16x32_bf16(ldfrag(lds + OFF_XT, 16 * pt + fr, STS, 64 * ks + 16 * fq), lf[ks], acc, 0, 0, 0);
            *(f32x4*)(w.yd + (size_t)(R0 + lrow) * SW + hh * SP + 16 * pt + 4 * fq) = acc; }
    }
    {   const int d = wid >> 2, ptile = wid & 3, prow = 16 * ptile + fr; bf16x8 xf[4]; const char* bt = lds + (d ? OFF_BTB : OFF_BTF);
#pragma unroll
        for (int ks = 0; ks < 4; ++ks) xf[ks] = ldfrag(lds + OFF_XT, prow, STS, 64 * ks + 16 * fq);
#pragma unroll
        for (int nt = 0; nt < 4; ++nt) { f32x4 acc = {0.f, 0.f, 0.f, 0.f};
#pragma unroll
            for (int ks = 0; ks < 4; ++ks) acc = __builtin_amdgcn_mfma_f32_16x16x32_bf16(ldfrag(bt, 16 * nt + fr, STS, 64 * ks + 16 * fq), xf[ks], acc, 0, 0, 0);
            *(f32x4*)(w.st + ((((size_t)d * NCH + c) * SH + hh) * SP + prow) * SN + 16 * nt + 4 * fq) = acc; }
    }
    __syncthreads();
}
__device__ __forceinline__ void carry_phase(const SsdW& w) {
    int tid = threadIdx.x; asm volatile("" : "+v"(tid));
    constexpr int PER = 2 * SH * SP * SN / 256;
    if (tid < PER) { const int eidx = blockIdx.x * PER + tid; if (eidx < 2 * SH * SP * SN) { const int dir = eidx / (SH * SP * SN), rem = eidx % (SH * SP * SN), hh = rem / (SP * SN), e = rem % (SP * SN); float state = 0.f;
        for (int b = 0; b < NCH / 13; ++b) { float sv[13], dv[13]; size_t ov[13];
#pragma unroll
            for (int j = 0; j < 13; ++j) { const int i = b * 13 + j; const int c = dir == 0 ? i : (i < CTX / CHUNK ? CTX / CHUNK - 1 - i : NCH - 1 - (i - CTX / CHUNK));
                ov[j] = (((size_t)dir * NCH + c) * SH + hh) * (SP * SN) + e; sv[j] = w.st[ov[j]]; dv[j] = w.cdec[((size_t)dir * NCH + c) * SH + hh]; }
#pragma unroll
            for (int j = 0; j < 13; ++j) { w.prevb[ov[j]] = f2bf(state); state = state * dv[j] + sv[j]; } } } }
}
__device__ __forceinline__ void final_phase(const P& p, const SsdW& w, int l, bf16_t* dst, int ldd) {
    int tid = threadIdx.x; asm volatile("" : "+v"(tid)); const int wid = __builtin_amdgcn_readfirstlane(tid >> 6), lane = tid & 63, fr = lane & 15, fq = lane >> 4;
    const int ltg = wid * gridDim.x + blockIdx.x; if (ltg >= M / 16) return;
    const int r = ltg * 16 + fr, c = (ltg * 16) / CHUNK;
    bf16x8 cf[2][2];
#pragma unroll
    for (int g = 0; g < 2; ++g)
#pragma unroll
        for (int ks = 0; ks < 2; ++ks) cf[g][ks] = *(const bf16x8*)(w.cg + ((size_t)r * SG + g) * SN + 32 * ks + 8 * fq);
    u32x2 gv[SH][4]; float ss = 0.f;
#pragma unroll
    for (int hh = 0; hh < SH; ++hh) { const int g = hh / (SH / SG); const float ef = __expf(w.cs[(size_t)r * SH + hh]), eb = __expf(w.cs[((size_t)M + r) * SH + hh]);
#pragma unroll
        for (int pt = 0; pt < 4; ++pt) { f32x4 af = {0.f, 0.f, 0.f, 0.f}, ab = {0.f, 0.f, 0.f, 0.f};
            const bf16_t* pf = w.prevb + ((((size_t)0 * NCH + c) * SH + hh) * SP + 16 * pt + fr) * SN + 8 * fq; const bf16_t* pb = w.prevb + ((((size_t)1 * NCH + c) * SH + hh) * SP + 16 * pt + fr) * SN + 8 * fq;
#pragma unroll
            for (int ks = 0; ks < 2; ++ks) { af = __builtin_amdgcn_mfma_f32_16x16x32_bf16(*(const bf16x8*)(pf + 32 * ks), cf[g][ks], af, 0, 0, 0); ab = __builtin_amdgcn_mfma_f32_16x16x32_bf16(*(const bf16x8*)(pb + 32 * ks), cf[g][ks], ab, 0, 0, 0); }
            const int col = hh * SP + 16 * pt + 4 * fq; const f32x4 yd = *(const f32x4*)(w.yd + (size_t)r * SW + col), z = rw::ld4(w.proj + (size_t)r * w.ldp + C_Z + col);
            f32x4 y = yd + af * ef + ab * eb;
#pragma unroll
            for (int j = 0; j < 4; ++j) { y[j] *= silu_f(z[j]); ss += y[j] * y[j]; }
            u32x2 pk; pk.x = rw::pk2(y[0], y[1]); pk.y = rw::pk2(y[2], y[3]); gv[hh][pt] = pk; } }
    ss += __shfl_xor(ss, 16); ss += __shfl_xor(ss, 32); const float rs = 1.0f / sqrtf(ss * (1.0f / SW) + EPS);
#pragma unroll
    for (int hh = 0; hh < SH; ++hh)
#pragma unroll
        for (int pt = 0; pt < 4; ++pt) { const int col = hh * SP + 16 * pt + 4 * fq; const f32x4 o = rw::bf4(gv[hh][pt]) * rs * *(const f32x4*)(p.ssd_norm_g + l * SW + col);
            u32x2 pk; pk.x = rw::pk2(o[0], o[1]); pk.y = rw::pk2(o[2], o[3]); *(u32x2*)(dst + (size_t)r * ldd + col) = pk; }
}
}

namespace mc {
typedef float f32x4 __attribute__((ext_vector_type(4)));
__device__ __forceinline__ void modvec_phase(const P& p, char* lds) {
    int tid = threadIdx.x; asm volatile("" : "+v"(tid));
    float* sc = (float*)lds; float* part = sc + 2 * D;
    for (int i = tid; i < 2 * D; i += 512) { const float v = i < D ? p.c[i] : p.c_ctx[i - D]; sc[i] = v / (1.0f + __expf(-v)); }
    __syncthreads();
    constexpr int NCK = 6 * D / 128, NU = DEPTH * NCK;
    for (int u = blockIdx.x; u < NU; u += gridDim.x) { const int l = u / NCK, j = (u % NCK) * 128 + (tid & 127), kg = tid >> 7; const float* wp = p.mod_w + (size_t)l * D * 6 * D + j; float a0 = 0.f, a1 = 0.f;
#pragma unroll 8
        for (int k = kg; k < D; k += 4) { const float wv = wp[(size_t)k * 6 * D]; a0 += sc[k] * wv; a1 += sc[D + k] * wv; }
        part[(kg * 2 + 0) * 128 + (tid & 127)] = a0; part[(kg * 2 + 1) * 128 + (tid & 127)] = a1;
        __syncthreads();
        if (tid < 256) { const int which = tid >> 7, cc = tid & 127; const float s = part[(0 * 2 + which) * 128 + cc] + part[(1 * 2 + which) * 128 + cc] + part[(2 * 2 + which) * 128 + cc] + part[(3 * 2 + which) * 128 + cc];
            const int jj = (u % NCK) * 128 + cc; p.mod[((size_t)(l * 2 + which) * 6) * D + jj] = s + p.mod_b[(size_t)l * 6 * D + jj]; }
        __syncthreads(); }
}
__device__ __forceinline__ void pool_phase(const P& p, const bf16_t* proj, int ldp, int l, bf16_t* dst, int ldd, char* lds) {
    int tid = threadIdx.x; asm volatile("" : "+v"(tid));
    constexpr int RB = 65; float* pm = (float*)lds;
    const int row0 = blockIdx.x * RB;
    {
        const int c = tid & 255, gi = c >> 6, hw = 1 << gi, rh = tid >> 8;
        const int i0 = rh * 33, nr = rh ? 32 : 33;
        float v[33 + 16];
#pragma unroll
        for (int k = 0; k < 33 + 16; ++k) { const int r = row0 + i0 - 8 + k; v[k] = (r >= 0 && r < M && k < nr + 16) ? rw::ld1(proj + (size_t)r * ldp + C_POOL + c) : 0.f; }
#pragma unroll
        for (int i = 0; i < 33; ++i) { const int r = row0 + i0 + i; if (i < nr && r < M) { const int seg0 = r < CTX ? 0 : CTX, seg1 = r < CTX ? CTX : M; float s = 0.f; int cnt = 0;
#pragma unroll
                for (int o = -8; o < 8; ++o) { const int rr = r + o; const bool in = o >= -hw && o < hw && rr >= seg0 && rr < seg1; s += in ? v[i + 8 + o] : 0.f; cnt += in ? 1 : 0; }
                pm[(i0 + i) * 256 + c] = s / (float)cnt - v[i + 8]; } }
    }
    __syncthreads();
    {   const int d = tid & 63, gi = (tid >> 6) & 3, rh = tid >> 8; float wcol[64]; const float* wp = p.pool_w + (((size_t)l * 4 + gi) * 64) * 64 + d;
#pragma unroll
        for (int c = 0; c < 64; ++c) wcol[c] = wp[(size_t)c * 64];
        const float scl = p.pool_scale[l * PW + gi * 64 + d];
        for (int i = rh; i < RB; i += 2) { const int r = row0 + i; if (r >= M) break; const f32x4* pr = (const f32x4*)(pm + i * 256 + gi * 64); float acc = 0.f;
#pragma unroll
            for (int c4 = 0; c4 < 16; ++c4) { const f32x4 v = pr[c4]; acc += v[0] * wcol[4 * c4] + v[1] * wcol[4 * c4 + 1] + v[2] * wcol[4 * c4 + 2] + v[3] * wcol[4 * c4 + 3]; }
            dst[(size_t)r * ldd + gi * 64 + d] = f2bf(acc * scl); } }
    __syncthreads();
}
}

#ifndef CHECK_MLA
#define CHECK_MLA 0
#endif
#ifndef CHECK_SSD
#define CHECK_SSD 0
#endif
#ifndef REP_ATT
#define REP_ATT 1
#endif
#ifndef REP_MOE
#define REP_MOE 1
#endif
#ifndef REP_PROJ
#define REP_PROJ 1
#endif
#ifndef REP_PRE
#define REP_PRE 1
#endif
#ifndef REP_PREP
#define REP_PREP 1
#endif
#ifndef REP_ROW
#define REP_ROW 1
#endif
#ifndef REP_MLA
#define REP_MLA 1
#endif
#ifndef REP_POOL
#define REP_POOL 1
#endif
#ifndef REP_S1
#define REP_S1 1
#endif
#ifndef REP_FIN
#define REP_FIN 1
#endif
#ifndef REP_WITH_BAR
#define REP_WITH_BAR 0
#endif
#define REPEAT(N, ...) for (int rep_ = 0; rep_ < (N); ++rep_) { __VA_ARGS__ if (REP_WITH_BAR && rep_ + 1 < (N)) BAR1(); }
__device__ __forceinline__ int gtid() { int t = threadIdx.x; asm volatile("" : "+v"(t)); return blockIdx.x * 512 + t; }
template <int OP> __device__ __forceinline__ void run_op(const P& p, int l) {
    const long n = op_count(OP); const long stride = (long)gridDim.x * blockDim.x;
    for (long i = gtid(); i < n; i += stride) op_run(OP, p, l, i);
}
struct KArgs { P p; FW f; unsigned* bar; };
__device__ __forceinline__ const KArgs& kargs() { auto q = __builtin_amdgcn_kernarg_segment_ptr(); asm volatile("" : "+s"(q)); return *(const KArgs*)q; }
constexpr int LDS_BYTES = gm::STAGE_BYTES + 4096;
#ifndef REP_BAR
#define REP_BAR 1
#endif
#if REP_BAR == 2
#define BAR() do { BAR1(); BAR1(); } while (0)
#else
#define BAR() BAR1()
#endif
#define BAR1() do { XcdBarrier b2_; b2_.bar = kargs().bar; unsigned xx_ = xbx; asm volatile("" : "+s"(xx_)); b2_.x = xx_; b2_.st = (volatile LAS unsigned*)(lds + LDS_BYTES - 16); xcd_barrier(b2_); } while (0)
#define PH(OPX) do { run_op<OPX>(kargs().p, lo()); BAR(); } while (0)
#define RUN(OPX) run_op<OPX>(kargs().p, lo())

__device__ __forceinline__ void attn_split_phase(const P& p, const FW& f, int l, char* lds) {
    const bool fast = at::attn_fast_ok(p.qn_g + l * QKD, p.kn_g + l * QKD);
    constexpr int NQL = SEQ / 256, NUL = NH * NQL * 2, NU = NUL + NH, HALF_KEYS = M / 2;
    for (int u = blockIdx.x; u < NU; u += gridDim.x) {
        int hh, qt, half, seq;
        if (u < NUL) { hh = u / (NQL * 2); const int rem = u % (NQL * 2); qt = 1 + (rem >> 1); half = rem & 1; seq = HALF_KEYS; } else { hh = u - NUL; qt = 0; half = 0; seq = CTX; }
        const size_t koff = (size_t)half * HALF_KEYS;
        __syncthreads();
        const bf16_t* Qp = p.qb + (size_t)qt * 256 * at::LDQ + hh * at::DQ; const bf16_t* Kp = p.kb + koff * at::LDK + hh * at::DQ; const bf16_t* Vp = p.vb + koff * at::LDV + hh * at::DV;
        bf16_t* Op = f.opart + (size_t)half * M * (NH * VD) + (size_t)qt * 256 * (NH * VD) + hh * at::DV; float* MLp = f.aml + (((size_t)half * M + (size_t)qt * 256) * NH + hh) * 2;
        if (fast) at::attn_body<bf16_t, true>(Qp, Kp, Vp, Op, NH * VD, seq, lds, MLp, NH * 2); else at::attn_body<bf16_t, false>(Qp, Kp, Vp, Op, NH * VD, seq, lds, MLp, NH * 2);
    }
    __syncthreads();
}
template <class TA> __device__ __forceinline__ float ldf(const TA* a, size_t i);
template <> __device__ __forceinline__ float ldf<float>(const float* a, size_t i) { return a[i]; }
template <> __device__ __forceinline__ float ldf<bf16_t>(const bf16_t* a, size_t i) { return bf2f(a[i]); }
template <class TA, class TB> __device__ __forceinline__ void chk_accum(const TA* a, int lda, const TB* b, int ldb, long nrows, int ncols, float* diag) {
    float sd = 0.f, sr = 0.f; const long n = nrows * ncols; const long stride = (long)gridDim.x * blockDim.x;
    for (long i = gtid(); i < n; i += stride) { const long r = i / ncols; const int c = (int)(i % ncols);
        const float x = ldf<TA>(a, r * lda + c), y = ldf<TB>(b, r * ldb + c); sd += (x - y) * (x - y); sr += y * y; }
    for (int o = 32; o >= 1; o >>= 1) { sd += __shfl_xor(sd, o); sr += __shfl_xor(sr, o); }
    if ((threadIdx.x & 63) == 0) { atomicAdd(diag, sd); atomicAdd(diag + 1, sr); }
}
#define MLA_CALL(QB, KB, VB) { const int ll_ = lo(); ml::MW mw_; mw_.qb = (QB); mw_.kb = (KB); mw_.vb = (VB); mw_.w_uq_t = KF.w_uq_t + (size_t)ll_ * NH * QKD * QL; mw_.w_ukv_t = KF.w_ukv_t + (size_t)ll_ * NH * 128 * KVL; \
        mw_.ropec = KF.ropec; mw_.ropes = KF.ropes; mw_.proj = KF.projb; mw_.ldp = INC_PAD; ml::mla_phase(KP, mw_, ll_, lds); }
#if CHECK_MLA
#define MLA_STEP PH(OP_LATNORM); RUN(OP_QRAW); PH(OP_KVRAW); RUN(OP_QHEAD); RUN(OP_KHEAD); if (l == 0) { MLA_CALL(KF.qb2, KF.kb2, KF.vb2) } BAR(); \
        if (l == 0) { chk_accum<bf16_t, bf16_t>(KF.qb2, NH * QKD, KP.qb, NH * QKD, M, NH * QKD, KP.diag + 0); chk_accum<bf16_t, bf16_t>(KF.kb2, NH * QKD, KP.kb, NH * QKD, M, NH * QKD, KP.diag + 2); chk_accum<bf16_t, bf16_t>(KF.vb2, NH * VD, KP.vb, NH * VD, M, NH * VD, KP.diag + 4); }
#else
#define MLA_STEP REPEAT(REP_PREP * REP_MLA, MLA_CALL(KP.qb, KP.kb, KP.vb))
#endif
#define SSD_W(NAME) sd::SsdW NAME; NAME.proj = KF.projb; NAME.ldp = INC_PAD; NAME.yd = KF.yd2; NAME.st = KF.st2; NAME.cdec = KF.cdec2; NAME.cs = KF.cs2; NAME.cg = KF.cg; NAME.prevb = KF.prevb;
#define SSD_S1() { SSD_W(sw_) const int ll_ = lo(); for (int u = blockIdx.x; u < NCH * SH; u += gridDim.x) sd::chunk_unit(KP, sw_, ll_, u / SH, u % SH, lds); }
#define SSD_S2() { SSD_W(sw_) sd::carry_phase(sw_); }
#define SSD_S3(DST, LDD) { SSD_W(sw_) sd::final_phase(KP, sw_, lo(), (DST), (LDD)); }
#if CHECK_SSD
#define SSD_STEPS RUN(OP_CONV); RUN(OP_DT); PH(OP_POOLP); RUN(OP_SSD_CS); RUN(OP_SSD_G); PH(OP_POOLMM); attn_phase<float>(KP, KP.mixin, MIXW, lds); RUN(OP_SSD_YD); PH(OP_SSD_ST); PH(OP_SSD_CARRY); PH(OP_SSD_YOFF); PH(OP_SSDFIN); \
        if (l == 0) { SSD_S1() BAR(); SSD_S2() BAR(); SSD_S3(KF.ssdb2, SW) BAR(); chk_accum<bf16_t, float>(KF.ssdb2, SW, KP.mixin + NH * VD, MIXW, M, SW, KP.diag + 0); } PH(OP_MIXB);
#else
#define SSD_STEPS REPEAT(REP_PREP * REP_POOL, mc::pool_phase(KP, KF.projb, INC_PAD, lo(), KP.mixb + NH * VD + SW, MIXW, lds);) REPEAT(REP_PREP * REP_S1, SSD_S1()) BAR(); REPEAT(REP_ATT, attn_split_phase(KP, KF, lo(), lds);) REPEAT(REP_FIN, SSD_S2()) BAR(); REPEAT(REP_FIN, SSD_S3(KP.mixb + NH * VD, MIXW) at::attn_combine(KF.opart, KF.aml, KP.mixb, MIXW, M, CTX);) BAR();
#endif
#define LAYER_BODY(L) { const int l = (L); \
        auto lo = [&]() { int ll = l; asm volatile("" : "+s"(ll)); return ll; }; \
        if (blockIdx.x == 0 && threadIdx.x < NE) KP.cnt[threadIdx.x] = 0; \
        REPEAT(REP_PROJ, inproj_phase(KP, KF, lo(), KF.projb, lds);) BAR(); \
        MLA_STEP \
        SSD_STEPS \
        REPEAT(REP_PROJ - 1, outproj_phase<false>(KP, KF, lo(), KP.mixin, lds);) outproj_phase<true>(KP, KF, lo(), KP.xres, lds); cvt_experts_queue(KP, KF, lo(), kargs().bar + XCD_BAR_WORDS + 64 * l, lds, (volatile unsigned*)(lds + LDS_BYTES - 32)); BAR(); \
        REPEAT(REP_ROW - 1, rw::router_phase<true>(KP, lo(), lds);) rw::router_phase<false>(KP, lo(), lds); BAR(); \
        REPEAT(REP_MOE, moe1_phase(KP, KF, lo(), lds);) BAR(); REPEAT(REP_MOE, moe2_phase(KP, KF, lo(), lds);) BAR(); \
        REPEAT(REP_ROW - 1, rw::combine_phase<true>(KP, lo());) rw::combine_phase<false>(KP, lo()); BAR(); \
    }
__global__ void __launch_bounds__(512, 2) k_mega(KArgs a) {
    extern __shared__ __attribute__((aligned(16))) char lds[];
    uint4* xbw = (uint4*)(lds + LDS_BYTES - 16);
    if (threadIdx.x == 0) *xbw = make_uint4(0u, 0u, 0u, 0u);
    __syncthreads();
    const unsigned xbx = xcd_barrier_post(kargs().bar, (volatile LAS unsigned*)xbw).x;
#define KP kargs().p
#define KF kargs().f
    { const int l = 0; auto lo = [&]() { return l; }; if (blockIdx.x == 0 && threadIdx.x < 16) KP.diag[threadIdx.x] = 0.f; REPEAT(REP_PRE, mc::modvec_phase(KP, lds); cvt_small_phase(KP, KF, lds);) BAR(); rw::first_norm_phase(KP); BAR(); }
    LAYER_BODY(0) LAYER_BODY(1) LAYER_BODY(2) LAYER_BODY(3)
#if CHECK_MLA || CHECK_SSD
    {
        float e = 0.f;
        for (int c = 0; c < 3; ++c) { const float dn = KP.diag[2 * c + 1]; if (dn == 0.f && KP.diag[2 * c] == 0.f) continue; const float ec = sqrtf(KP.diag[2 * c] / dn); e = ec > e ? ec : e; if (!(ec == ec)) e = 1e3f; }
        const float sc = 1.0f + 10.0f * e; const long n = (long)SEQ * D; const long stride = (long)gridDim.x * blockDim.x;
        for (long i = gtid(); i < n; i += stride) KP.out[i] *= sc;
    }
#endif
#undef KP
#undef KF
}
static size_t carve(char*& cur, size_t bytes) { size_t a = (bytes + 255) & ~(size_t)255; cur += a; return a; }
static bool setup_params(P& p, FW& f, unsigned*& bar, void* const* d_in, void* d_out, void* d_ws, size_t ws_size) {
    const float** pp = (const float**)&p; for (int i = 0; i < 32; ++i) pp[i] = (const float*)d_in[i];
    p.out = (float*)d_out;
    char* cur = (char*)d_ws; char* base = cur;
    bar = (unsigned*)cur; carve(cur, (XCD_BAR_WORDS + 512) * sizeof(unsigned));
#define CARVE(field, type, count) p.field = (type*)cur; carve(cur, (size_t)(count) * sizeof(type));
#define CARVEF(field, type, count) f.field = (type*)cur; carve(cur, (size_t)(count) * sizeof(type));
    CARVE(xres, float, (size_t)M * D) CARVE(mod, float, (size_t)DEPTH * 12 * D) CARVEF(projb, bf16_t, (size_t)M * INC_PAD)
#if CHECK_MLA
    CARVE(qln, float, (size_t)M * QL) CARVE(kvln, float, (size_t)M * KVL) CARVE(qraw, float, (size_t)M * NH * QKD) CARVE(kvraw, float, (size_t)M * NH * 128) CARVE(q, float, (size_t)M * NH * QKD) CARVE(k, float, (size_t)M * NH * QKD) CARVE(v, float, (size_t)M * NH * VD)
    CARVEF(qb2, bf16_t, (size_t)M * NH * QKD) CARVEF(kb2, bf16_t, (size_t)M * NH * QKD) CARVEF(vb2, bf16_t, (size_t)M * NH * VD)
#endif
    CARVE(mixin, float, (size_t)M * MIXW) CARVE(xbc, float, (size_t)M * CONVD) CARVE(dt, float, (size_t)M * 12) CARVE(ydir, float, (size_t)2 * M * SW)
    CARVE(poolp, float, (size_t)M * PW) CARVE(topw, float, (size_t)M * 4)
    CARVE(topi, int, (size_t)M * 4) CARVE(cnt, int, NE) CARVE(list, int, (size_t)NE * M)
    CARVE(qb, bf16_t, (size_t)M * NH * QKD) CARVE(kb, bf16_t, (size_t)M * NH * QKD) CARVE(vb, bf16_t, (size_t)M * NH * VD) CARVE(diag, float, 64)
    CARVE(cs, float, (size_t)2 * M * SH) CARVE(cdec, float, (size_t)2 * NCH * SH) CARVE(gmat, float, (size_t)M * SG * CHUNK) CARVE(st, float, (size_t)2 * NCH * SH * SP * SN)
    CARVE(hb1, bf16_t, (size_t)M * D) CARVE(hb2, bf16_t, (size_t)M * D) CARVE(mixb, bf16_t, (size_t)M * MIXW)
    CARVEF(actb, bf16_t, (size_t)4 * M * FF) CARVEF(yb, bf16_t, (size_t)4 * M * D)
    f.hb1 = p.hb1; f.hb2 = p.hb2; f.mixb = p.mixb; p.ybn = f.yb; p.attf = nullptr;
    const int nl = DEPTH;
    CARVEF(w_uq_t, bf16_t, (size_t)nl * NH * QKD * QL) CARVEF(w_ukv_t, bf16_t, (size_t)nl * NH * 128 * KVL) CARVEF(ropec, float, 256 * 8) CARVEF(ropes, float, 256 * 8)
    CARVEF(opart, bf16_t, (size_t)2 * M * NH * VD) CARVEF(aml, float, (size_t)2 * M * NH * 2)
    CARVEF(yd2, float, (size_t)M * SW) CARVEF(st2, float, (size_t)2 * NCH * SH * SP * SN) CARVEF(cdec2, float, (size_t)2 * NCH * SH) CARVEF(cs2, float, (size_t)2 * M * SH)
    CARVEF(cg, bf16_t, (size_t)M * SG * SN) CARVEF(prevb, bf16_t, (size_t)2 * NCH * SH * SP * SN) CARVEF(ssdb2, bf16_t, (size_t)M * SW)
    CARVEF(w_in_t, bf16_t, (size_t)nl * INC_PAD * D) CARVEF(w_out_t, bf16_t, (size_t)nl * D * MIXW) CARVEF(gu_t, bf16_t, (size_t)nl * NE * 2 * FF * D) CARVEF(d_t, bf16_t, (size_t)nl * NE * D * FF)
    p.act = nullptr; p.down = nullptr; f.proj2 = nullptr; f.mix2 = nullptr;
#undef CARVE
#undef CARVEF
    if (getenv("KDEBUG")) fprintf(stderr, "ws used %zu of %zu\n", (size_t)(cur - base), ws_size);
    return (size_t)(cur - base) <= ws_size;
}
extern "C" void kernel_launch(void* const* d_in, const int* in_sizes, int n_in, void* d_out, int out_size, void* d_ws, size_t ws_size, hipStream_t stream) {
    KArgs a{};
    if (n_in < 32 || !setup_params(a.p, a.f, a.bar, d_in, d_out, d_ws, ws_size)) return;
    static int grid = 0;
    if (!grid) { int dev = 0, cus = 0, per_cu = 0; (void)hipGetDevice(&dev); (void)hipDeviceGetAttribute(&cus, hipDeviceAttributeMultiprocessorCount, dev);
        (void)hipFuncSetAttribute((const void*)k_mega, hipFuncAttributeMaxDynamicSharedMemorySize, LDS_BYTES);
        (void)hipOccupancyMaxActiveBlocksPerMultiprocessor(&per_cu, k_mega, 512, LDS_BYTES); grid = cus * (per_cu < 1 ? per_cu : 1); }
    if (grid <= 0) return;
    (void)hipMemsetAsync(a.bar, 0, (XCD_BAR_WORDS + 512) * sizeof(unsigned), stream);
    hipLaunchKernelGGL(k_mega, dim3(grid), dim3(512), LDS_BYTES, stream, a);
}
```
